# Optimizing an MI355X kernel written in HIP

```python
import jax
import jax.numpy as jnp
from jax import lax
import numpy as np

D_MODEL = 1024
BATCH = 1
SEQ = 16384
DEPTH = 1

GRID_W = 64
CTX_LEN = 256
NORM_EPS = 1e-6

A_HEAD_DIM = 64
A_WIDTH = D_MODEL // 2
A_HEADS = A_WIDTH // A_HEAD_DIM
W_LORA = 64
ICLR_LORA = 64
G_LORA = 128
RWKV_GN_EPS = 64e-5

B_HEADS = 4
B_QK_WIDTH = D_MODEL // 2
B_V_WIDTH = D_MODEL
B_QK_DIM = B_QK_WIDTH // B_HEADS
B_V_DIM = B_V_WIDTH // B_HEADS
RET_CHUNK = 128
RET_GN_EPS = 1e-5
ROPE_BASE = 10000.0

A_SIZES = (A_WIDTH, A_WIDTH, A_WIDTH, W_LORA, ICLR_LORA, G_LORA)
B_SIZES = (B_QK_WIDTH, B_QK_WIDTH, B_V_WIDTH, B_V_WIDTH, D_MODEL, D_MODEL)
SHIFT_COLS = 3 * A_WIDTH + W_LORA + ICLR_LORA + G_LORA
IN_COLS = SHIFT_COLS + 2 * B_QK_WIDTH + 2 * B_V_WIDTH + 2 * D_MODEL

N_EXPERTS = 256
TOP_K = 8
EXPERT_FF = D_MODEL // 4
SHARED_FF = D_MODEL // 4
ROUTED_SCALE = 2.5
MOE_BLOCK = 128

kernel_name = 'hybrid_rwkv7_retention_moe_dit_block'


def _offsets(sizes):
    return np.cumsum(sizes)[:-1].tolist()


def rmsnorm(x, g):
    xf = x.astype(jnp.float32)
    y = xf * lax.rsqrt(jnp.mean(xf * xf, axis=-1, keepdims=True) + NORM_EPS)
    return (y * g.astype(jnp.float32)).astype(x.dtype)


def head_layernorm(y, w, b, eps):
    mu = jnp.mean(y, axis=-1, keepdims=True)
    var = jnp.mean(jnp.square(y - mu), axis=-1, keepdims=True)
    yn = ((y - mu) * lax.rsqrt(var + eps)).reshape(y.shape[:2] + (-1,))
    return yn * w.astype(jnp.float32) + b.astype(jnp.float32)


def bidirectional_token_shift(p, mu):
    zero = jnp.zeros_like(p[:, :1])
    prev = jnp.concatenate([zero, p[:, :-1]], axis=1)
    nxt = jnp.concatenate([p[:, 1:], zero], axis=1)
    return p + mu[0] * (prev - p) + mu[1] * (nxt - p)


def flip_t(t):
    return jnp.flip(t, axis=1)


def axial_rope(x, rope):
    cos_r, sin_r, cos_c, sin_c = rope
    half = x.shape[-1] // 2

    def rot(xh, cos, sin):
        x1, x2 = jnp.split(xh, 2, axis=-1)
        cos = cos[None, :, None, :]
        sin = sin[None, :, None, :]
        return jnp.concatenate([x1 * cos - x2 * sin, x1 * sin + x2 * cos], axis=-1)

    return jnp.concatenate([rot(x[..., :half], cos_r, sin_r), rot(x[..., half:], cos_c, sin_c)], axis=-1)


def rwkv7_scan(r, w, k, v, a, b, s0):
    def step(s, inp):
        r_t, w_t, k_t, v_t, a_t, b_t = inp
        sa = jnp.einsum('bhvk,bhk->bhv', s, a_t)
        s = s * w_t[:, :, None, :] + sa[..., None] * b_t[:, :, None, :] + v_t[..., None] * k_t[:, :, None, :]
        return s, jnp.einsum('bhvk,bhk->bhv', s, r_t)

    xs = tuple(jnp.moveaxis(t, 1, 0) for t in (r, w, k, v, a, b))
    s_fin, ys = lax.scan(step, s0, xs)
    return jnp.moveaxis(ys, 0, 1), s_fin


def retention_chunkwise(q, k, v, log_g, r0):
    bsz, t_len, n_h, dk = q.shape
    dv = v.shape[-1]
    n_c = t_len // RET_CHUNK
    qc = q.reshape(bsz, n_c, RET_CHUNK, n_h, dk)
    kc = k.reshape(bsz, n_c, RET_CHUNK, n_h, dk)
    vc = v.reshape(bsz, n_c, RET_CHUNK, n_h, dv)
    idx = jnp.arange(RET_CHUNK, dtype=jnp.float32)
    diff = idx[:, None] - idx[None, :]
    dmask = jnp.where(diff >= 0, jnp.exp(log_g[:, None, None] * jnp.maximum(diff, 0.0)), 0.0)
    scores = jnp.einsum('bcnhd,bcmhd->bchnm', qc, kc) * dmask[None, None]
    inner = jnp.einsum('bchnm,bcmhe->bcnhe', scores, vc)
    zeta = jnp.exp(log_g[:, None] * (RET_CHUNK - 1 - idx))
    kv = jnp.einsum('bcmhd,bcmhe,hm->cbhde', kc, vc, zeta)
    g_chunk = jnp.exp(log_g * RET_CHUNK)[None, :, None, None]

    def step(r_state, kv_c):
        return g_chunk * r_state + kv_c, r_state

    r_fin, r_prev = lax.scan(step, r0, kv)
    xi = jnp.exp(log_g[:, None] * (idx + 1.0))
    cross = jnp.einsum('bcnhd,cbhde,hn->bcnhe', qc, r_prev, xi)
    return (inner + cross).reshape(bsz, t_len, n_h, dv), r_fin


def token_mixer(h, lp, rope, init, need_out):
    bsz, t_len, _ = h.shape
    f32 = jnp.float32
    proj = (h @ lp['w_in']).astype(f32)
    rw = bidirectional_token_shift(proj[..., :SHIFT_COLS], lp['shift_mu'].astype(f32))
    r, k, v, xw, xa, xg = jnp.split(rw, _offsets(A_SIZES), axis=-1)
    q_b, k_b, v_b, g_b, gate_a, gate_b = jnp.split(proj[..., SHIFT_COLS:], _offsets(B_SIZES), axis=-1)

    def hd(t, n):
        return t.reshape(bsz, t_len, n, -1)

    kk = hd(k * lp['rwkv_k_k'], A_HEADS)
    kk = kk / jnp.maximum(jnp.linalg.norm(kk, axis=-1, keepdims=True), 1e-12)
    tw = jnp.tanh(xw)
    decay, iclr, kdir = [], [], []
    for d in range(2):
        w_log = -jax.nn.softplus(-(lp['rwkv_w0'][d] + tw @ lp['rwkv_w_up'][d])) - 0.5
        a_d = jax.nn.sigmoid(lp['rwkv_a0'][d] + xa @ lp['rwkv_a_up'][d])
        decay.append(hd(jnp.exp(-jnp.exp(w_log)), A_HEADS))
        iclr.append(hd(a_d, A_HEADS))
        kdir.append(hd(k * (1.0 + (a_d - 1.0) * lp['rwkv_k_a']), A_HEADS))
    r_h = hd(r, A_HEADS)
    v_h = hd(v, A_HEADS)
    if init is None:
        zs = jnp.zeros((bsz, A_HEADS, A_HEAD_DIM, A_HEAD_DIM), f32)
        zr = jnp.zeros((bsz, B_HEADS, B_QK_DIM, B_V_DIM), f32)
        init = (zs, zs, zr, zr)
    s0_f, s0_b, r0_f, r0_b = init
    o_f, s_f = rwkv7_scan(r_h, decay[0], kdir[0], v_h, -kk, kk * iclr[0], s0_f)
    o_b, s_b = rwkv7_scan(*[flip_t(t) for t in (r_h, decay[1], kdir[1], v_h, -kk, kk * iclr[1])], s0_b)
    o_b = flip_t(o_b)

    q = hd(q_b, B_HEADS)
    kr = hd(k_b, B_HEADS) * (B_QK_DIM ** -0.5)
    vr = hd(v_b, B_HEADS)
    if rope is not None:
        q = axial_rope(q, rope)
        kr = axial_rope(kr, rope)
    log_g = jax.nn.log_sigmoid(lp['ret_decay_logit'].astype(f32))
    y_f, r_f = retention_chunkwise(q, kr, vr, log_g[0], r0_f)
    y_b, r_b = retention_chunkwise(flip_t(q), flip_t(kr), flip_t(vr), log_g[1], r0_b)
    y_b = flip_t(y_b)
    states = (s_f, s_b, r_f, r_b)
    if not need_out:
        return None, states

    bonus = jnp.sum(r_h * (kdir[0] + kdir[1]) * lp['rwkv_r_k'], axis=-1, keepdims=True) * v_h
    ya = head_layernorm(o_f + o_b, lp['rwkv_ln_w'], lp['rwkv_ln_b'], RWKV_GN_EPS) + bonus.reshape(bsz, t_len, A_WIDTH)
    ya = (ya * (jax.nn.sigmoid(xg) @ lp['rwkv_g_up'])).astype(h.dtype) @ lp['w_branch_a']
    yb = head_layernorm(y_f + y_b, lp['ret_ln_w'], lp['ret_ln_b'], RET_GN_EPS) * jax.nn.silu(g_b)
    yb = yb.astype(h.dtype) @ lp['w_branch_b']
    merged = jax.nn.sigmoid(gate_a).astype(h.dtype) * ya + jax.nn.sigmoid(gate_b).astype(h.dtype) * yb
    return merged @ lp['w_out'], states


def routed_moe(h, router_w, router_bias, w_gate, w_up, w_down, s_gate, s_up, s_down):
    shape = h.shape
    h = h.reshape(-1, shape[-1])
    n_tok = h.shape[0]
    scores = jax.nn.sigmoid((h @ router_w).astype(jnp.float32))
    _, sel = lax.top_k(scores + router_bias.astype(jnp.float32), TOP_K)
    s_sel = jnp.take_along_axis(scores, sel, axis=1)
    wts = s_sel / jnp.sum(s_sel, axis=1, keepdims=True) * ROUTED_SCALE
    n_assign = n_tok * TOP_K
    flat_e = sel.reshape(n_assign)
    order = jnp.argsort(flat_e)
    se = flat_e[order]
    tok_sorted = (order // TOP_K).astype(jnp.int32)
    w_sorted = wts.reshape(n_assign)[order]
    counts = jnp.zeros((N_EXPERTS,), jnp.int32).at[flat_e].add(1)
    padded = (counts + MOE_BLOCK - 1) // MOE_BLOCK * MOE_BLOCK
    pad_end = jnp.cumsum(padded)
    starts = jnp.cumsum(counts) - counts
    dest = (pad_end - padded)[se] + jnp.arange(n_assign, dtype=jnp.int32) - starts[se]
    n_blocks = (n_assign + N_EXPERTS * (MOE_BLOCK - 1) + MOE_BLOCK - 1) // MOE_BLOCK
    n_slots = n_blocks * MOE_BLOCK
    slot_tok = jnp.zeros((n_slots,), jnp.int32).at[dest].set(tok_sorted)
    slot_w = jnp.zeros((n_slots,), jnp.float32).at[dest].set(w_sorted)
    block_start = jnp.arange(n_blocks, dtype=jnp.int32) * MOE_BLOCK
    block_e = jnp.minimum(jnp.searchsorted(pad_end, block_start, side='right'), N_EXPERTS - 1)

    def expert_block(args):
        tok, wgt, e = args
        xb = h[tok]
        y = (jax.nn.silu(xb @ w_gate[e]) * (xb @ w_up[e])) @ w_down[e]
        return y * wgt[:, None].astype(y.dtype)

    ys = lax.map(expert_block, (slot_tok.reshape(n_blocks, MOE_BLOCK), slot_w.reshape(n_blocks, MOE_BLOCK), block_e))
    routed = jax.ops.segment_sum(ys.reshape(n_slots, -1), slot_tok, num_segments=n_tok)
    shared = (jax.nn.silu(h @ s_gate) * (h @ s_up)) @ s_down
    return (routed.astype(h.dtype) + shared).reshape(shape)


def setup_inputs(seed: int = 0) -> dict:
    key = jax.random.key(seed)
    keys = jax.random.split(key, 64)
    count = [0]

    def nk():
        kk = keys[count[0]]
        count[0] += 1
        return kk

    def nrm(shape, scale):
        return jax.random.normal(nk(), shape, jnp.float32) * scale

    def gain(shape):
        return 1.0 + nrm(shape, 0.05)

    L, D = DEPTH, D_MODEL
    s = 5.0 + jnp.arange(B_HEADS, dtype=jnp.float32)
    ret_base = jnp.log(2.0 ** s - 1.0)
    return {
        'x': nrm((BATCH, SEQ, D), 1.0),
        'c': nrm((BATCH, D), 1.0),
        'ctx': nrm((BATCH, CTX_LEN, D), 1.0),
        'c_ctx': nrm((D,), 1.0),
        'w_mod': nrm((L, D, 6 * D), 0.5 * D ** -0.5),
        'b_mod': nrm((L, 6 * D), 0.02),
        'norm_pre_mix': gain((L, D)),
        'norm_post_mix': gain((L, D)),
        'norm_pre_ffn': gain((L, D)),
        'norm_post_ffn': gain((L, D)),
        'w_in': nrm((L, D, IN_COLS), D ** -0.5),
        'shift_mu': jax.random.uniform(nk(), (L, 2, SHIFT_COLS), jnp.float32, 0.0, 0.5),
        'rwkv_w0': jax.random.uniform(nk(), (L, 2, A_WIDTH), jnp.float32, -6.0, 1.0),
        'rwkv_w_up': nrm((L, 2, W_LORA, A_WIDTH), 0.5 * W_LORA ** -0.5),
        'rwkv_a0': nrm((L, 2, A_WIDTH), 0.5),
        'rwkv_a_up': nrm((L, 2, ICLR_LORA, A_WIDTH), 0.5 * ICLR_LORA ** -0.5),
        'rwkv_g_up': nrm((L, G_LORA, A_WIDTH), G_LORA ** -0.5),
        'rwkv_k_k': 0.85 + nrm((L, A_WIDTH), 0.05),
        'rwkv_k_a': gain((L, A_WIDTH)),
        'rwkv_r_k': nrm((L, A_HEADS, A_HEAD_DIM), 0.1),
        'rwkv_ln_w': gain((L, A_WIDTH)),
        'rwkv_ln_b': nrm((L, A_WIDTH), 0.02),
        'w_branch_a': nrm((L, A_WIDTH, D), A_WIDTH ** -0.5),
        'ret_decay_logit': ret_base + nrm((L, 2, B_HEADS), 0.1),
        'ret_ln_w': gain((L, B_V_WIDTH)),
        'ret_ln_b': nrm((L, B_V_WIDTH), 0.02),
        'w_branch_b': nrm((L, B_V_WIDTH, D), B_V_WIDTH ** -0.5),
        'w_out': nrm((L, D, D), D ** -0.5),
        'router_w': nrm((L, D, N_EXPERTS), D ** -0.5),
        'router_bias': nrm((L, N_EXPERTS), 0.01),
        'exp_w_gate': nrm((L, N_EXPERTS, D, EXPERT_FF), D ** -0.5),
        'exp_w_up': nrm((L, N_EXPERTS, D, EXPERT_FF), D ** -0.5),
        'exp_w_down': nrm((L, N_EXPERTS, EXPERT_FF, D), EXPERT_FF ** -0.5),
        'sh_w_gate': nrm((L, D, SHARED_FF), D ** -0.5),
        'sh_w_up': nrm((L, D, SHARED_FF), D ** -0.5),
        'sh_w_down': nrm((L, SHARED_FF, D), SHARED_FF ** -0.5),
    }


def reference(x, c, ctx, c_ctx, w_mod, b_mod, norm_pre_mix, norm_post_mix, norm_pre_ffn, norm_post_ffn,
              w_in, shift_mu, rwkv_w0, rwkv_w_up, rwkv_a0, rwkv_a_up, rwkv_g_up, rwkv_k_k, rwkv_k_a,
              rwkv_r_k, rwkv_ln_w, rwkv_ln_b, w_branch_a, ret_decay_logit, ret_ln_w, ret_ln_b, w_branch_b,
              w_out, router_w, router_bias, exp_w_gate, exp_w_up, exp_w_down, sh_w_gate, sh_w_up, sh_w_down):
    t_len = x.shape[1]
    ROWS = t_len // GRID_W
    rows = jnp.repeat(jnp.arange(ROWS), GRID_W).astype(jnp.float32)
    cols = jnp.tile(jnp.arange(GRID_W), ROWS).astype(jnp.float32)
    quarter = B_QK_DIM // 4
    inv_freq = ROPE_BASE ** (-jnp.arange(quarter, dtype=jnp.float32) / quarter)
    ang_r = rows[:, None] * inv_freq
    ang_c = cols[:, None] * inv_freq
    rope = (jnp.cos(ang_r), jnp.sin(ang_r), jnp.cos(ang_c), jnp.sin(ang_c))

    for i in range(DEPTH):
        last = i == DEPTH - 1
        lp = {
            'w_in': w_in[i], 'shift_mu': shift_mu[i],
            'rwkv_w0': rwkv_w0[i], 'rwkv_w_up': rwkv_w_up[i], 'rwkv_a0': rwkv_a0[i], 'rwkv_a_up': rwkv_a_up[i],
            'rwkv_g_up': rwkv_g_up[i], 'rwkv_k_k': rwkv_k_k[i], 'rwkv_k_a': rwkv_k_a[i], 'rwkv_r_k': rwkv_r_k[i],
            'rwkv_ln_w': rwkv_ln_w[i], 'rwkv_ln_b': rwkv_ln_b[i], 'w_branch_a': w_branch_a[i],
            'ret_decay_logit': ret_decay_logit[i], 'ret_ln_w': ret_ln_w[i], 'ret_ln_b': ret_ln_b[i],
            'w_branch_b': w_branch_b[i], 'w_out': w_out[i],
        }
        moe_p = (router_w[i], router_bias[i], exp_w_gate[i], exp_w_up[i], exp_w_down[i],
                 sh_w_gate[i], sh_w_up[i], sh_w_down[i])
        mod = jax.nn.silu(c) @ w_mod[i] + b_mod[i]
        mod_ctx = jax.nn.silu(c_ctx) @ w_mod[i] + b_mod[i]
        sh1, sc1, g1, sh2, sc2, g2 = [m[:, None, :] for m in jnp.split(mod, 6, axis=-1)]
        csh1, csc1, cg1, csh2, csc2, cg2 = jnp.split(mod_ctx, 6, axis=-1)

        hc = rmsnorm(ctx, norm_pre_mix[i]) * (1.0 + csc1) + csh1
        mix_c, ctx_states = token_mixer(hc, lp, None, None, not last)

        h = rmsnorm(x, norm_pre_mix[i]) * (1.0 + sc1) + sh1
        mix, _ = token_mixer(h, lp, rope, ctx_states, True)
        x = x + g1 * rmsnorm(mix, norm_post_mix[i])
        h = rmsnorm(x, norm_pre_ffn[i]) * (1.0 + sc2) + sh2
        x = x + g2 * rmsnorm(routed_moe(h, *moe_p), norm_post_ffn[i])

        if not last:
            ctx = ctx + cg1 * rmsnorm(mix_c, norm_post_mix[i])
            hc = rmsnorm(ctx, norm_pre_ffn[i]) * (1.0 + csc2) + csh2
            ctx = ctx + cg2 * rmsnorm(routed_moe(hc, *moe_p), norm_post_ffn[i])
    return x
```

```cpp
#include <hip/hip_runtime.h>
#include <stdint.h>
#include <stdio.h>

#ifndef MK_ONE_LAUNCH
#define MK_ONE_LAUNCH 1
#endif
#ifndef PROBE_MASK
#define PROBE_MASK 0u
#endif

typedef unsigned short bf16_t;
typedef short bf16x8 __attribute__((ext_vector_type(8)));
typedef float f32x4 __attribute__((ext_vector_type(4)));
typedef float f32x2 __attribute__((ext_vector_type(2)));

#define NT 512
constexpr int TX = 16384, TC = 256, TE = 16640, DM = 1024, INC = 6912;
constexpr int NCH = 130;
constexpr int RL = 130, RNC = 128;
constexpr int TSTR = 144;
constexpr int TILE_BYTES = 128 * TSTR;
constexpr int LDS_BYTES = 8 * TILE_BYTES + 1024;
constexpr int NSLOT = 131072 + 16384;
constexpr int NXT_MAX = 768 + 64;

#define XB_TMO      128
#define XB_XCNT(j)  (256  + 64 * (j))
#define XB_XSUB(j)  (1280 + 64 * (j))
#define XB_XGEN(j)  (2304 + 64 * (j))
#define XB_TOP      3328
#define XB_TOPGEN   3392
#define XCD_BAR_WORDS 3456
#define XB_SPIN_CAP (1u << 18)
#define LAS __attribute__((address_space(3)))

__device__ __forceinline__ unsigned xb_ld(unsigned* p)              { return __hip_atomic_load(p, __ATOMIC_RELAXED, __HIP_MEMORY_SCOPE_AGENT); }
__device__ __forceinline__ unsigned xb_add(unsigned* p, unsigned v) { return __hip_atomic_fetch_add(p, v, __ATOMIC_RELAXED, __HIP_MEMORY_SCOPE_AGENT); }
__device__ __forceinline__ unsigned xb_xcc_id() { return (unsigned)__builtin_amdgcn_s_getreg((3 << 11) | 20) & 0xFu; }
#define XB_SPIN(cond, bar) do { unsigned _sp = 0; while (cond) { __builtin_amdgcn_s_sleep(1); \
    if ((++_sp & 255u) == 0u) { if (xb_ld(&(bar)[XB_TMO])) break; if (_sp > XB_SPIN_CAP) { atomicAdd(&(bar)[XB_TMO], 1u); break; } } } } while (0)

struct XcdBarrier { unsigned* bar; unsigned x; volatile LAS unsigned* st; };

__device__ __forceinline__ XcdBarrier xcd_barrier_post(unsigned* bar, volatile LAS unsigned* st) {
    XcdBarrier b; b.bar = bar; b.x = xb_xcc_id(); b.st = st;
    if (threadIdx.x == 0) (void)xb_add(&bar[XB_XCNT(b.x)], 1u);
    return b;
}
__device__ __forceinline__ void xcd_barrier_complete(unsigned* bar, unsigned x, unsigned& nloc, unsigned& nx) {
    const unsigned G = gridDim.x * gridDim.y * gridDim.z;
    unsigned sum, cnt, mine, sp = 0u;
    for (;;) {
        sum = 0u; cnt = 0u; mine = 0u;
#pragma unroll
        for (unsigned j = 0; j < 16; ++j) { const unsigned c = xb_ld(&bar[XB_XCNT(j)]); sum += c; cnt += (c > 0u) ? 1u : 0u; mine = (j == x) ? c : mine; }
        if (sum == G) break;
        __builtin_amdgcn_s_sleep(1);
        if ((++sp & 255u) == 0u) { if (xb_ld(&bar[XB_TMO])) break; if (sp > XB_SPIN_CAP) { atomicAdd(&bar[XB_TMO], 1u); break; } }
    }
    nloc = mine > 0u ? mine : 1u; nx = cnt > 0u ? cnt : 1u;
}
__device__ __forceinline__ void xcd_barrier(const XcdBarrier& b) {
    asm volatile("s_waitcnt vmcnt(0)" ::: "memory");
    __syncthreads();
    if (threadIdx.x == 0) {
        unsigned* bar = b.bar;
        __builtin_amdgcn_s_waitcnt(0);
        unsigned nloc = b.st[0], nx = b.st[1];
        if (nloc == 0u) { xcd_barrier_complete(bar, b.x, nloc, nx); b.st[0] = nloc; b.st[1] = nx; }
        const unsigned old = xb_add(&bar[XB_XSUB(b.x)], 1u);
        const unsigned gen = old / nloc;
        if (old + 1u == (gen + 1u) * nloc) {
            __builtin_amdgcn_fence(__ATOMIC_RELEASE, "agent");
            asm volatile("s_waitcnt vmcnt(0)" ::: "memory");
            const unsigned og = xb_add(&bar[XB_TOP], 1u);
            const unsigned tg = og / nx;
            if (og + 1u == (tg + 1u) * nx) xb_add(&bar[XB_TOPGEN], 1u);
            else XB_SPIN(xb_ld(&bar[XB_TOPGEN]) == tg, bar);
            __builtin_amdgcn_fence(__ATOMIC_ACQUIRE, "agent");
            xb_add(&bar[XB_XGEN(b.x)], 1u);
            asm volatile("s_waitcnt vmcnt(0)" ::: "memory");
        } else {
            XB_SPIN(xb_ld(&bar[XB_XGEN(b.x)]) == gen, bar);
            __builtin_amdgcn_fence(__ATOMIC_ACQUIRE, "agent");
            asm volatile("s_waitcnt vmcnt(0)" ::: "memory");
        }
    }
    __syncthreads();
}

struct TJob { const float* src; bf16_t* dst; int K, N, dld, mode, rowoff, coloff; };
constexpr int NJOB = 14;

struct Params {
    const float *x, *c, *ctx, *c_ctx, *w_mod, *b_mod, *n_pre_mix, *n_post_mix, *n_pre_ffn, *n_post_ffn,
        *w_in, *shift_mu, *rwkv_w0, *rwkv_w_up, *rwkv_a0, *rwkv_a_up, *rwkv_g_up, *rwkv_k_k, *rwkv_k_a, *rwkv_r_k,
        *rwkv_ln_w, *rwkv_ln_b, *w_branch_a, *ret_decay_logit, *ret_ln_w, *ret_ln_b, *w_branch_b, *w_out,
        *router_w, *router_bias, *exp_w_gate, *exp_w_up, *exp_w_down, *sh_w_gate, *sh_w_up, *sh_w_down;
    float* out;
    unsigned* bar; int* cnt; int* slot_tk; int* xt; int* ntiles; int* tok_e; int* tok_pos; float* tok_w;
    float* modp; float* mod;
    bf16_t *WinT, *WaT, *WbT, *WoT, *RtT, *ShGU, *ShD, *WupT, *AupT, *GupT;
    bf16_t *hn, *proj;
    bf16_t *Rr, *Vv, *KD, *G, *O;
    bf16_t *Kk, *Aa, *Bd, *TW, *XA, *SG;
    float *Wd, *PH, *Sst, *Zz, *YH;
    bf16_t *Qr, *Kr, *KTz, *A3, *B3;
    float *KVT, *Y;
    bf16_t *ya_in, *yb_in, *merged, *Ahl, *act, *yk;
    float *mergedA, *mix, *x_mid, *logits;
    TJob jobs[NJOB];
};

__device__ __forceinline__ int tidx() { int t = threadIdx.x; asm volatile("" : "+v"(t)); return t; }
__device__ __forceinline__ float bf2f(bf16_t v) { return __uint_as_float(((unsigned)v) << 16); }
__device__ __forceinline__ bf16_t f2bf(float f) { unsigned u = __float_as_uint(f); u += 0x7fffu + ((u >> 16) & 1u); return (bf16_t)(u >> 16); }
__device__ __forceinline__ unsigned pack2(float lo, float hi) { return (unsigned)f2bf(lo) | ((unsigned)f2bf(hi) << 16); }
__device__ __forceinline__ void unpack8(const uint4& v, float (&f)[8]) {
    f[0] = __uint_as_float(v.x << 16); f[1] = __uint_as_float(v.x & 0xffff0000u); f[2] = __uint_as_float(v.y << 16); f[3] = __uint_as_float(v.y & 0xffff0000u);
    f[4] = __uint_as_float(v.z << 16); f[5] = __uint_as_float(v.z & 0xffff0000u); f[6] = __uint_as_float(v.w << 16); f[7] = __uint_as_float(v.w & 0xffff0000u); }
__device__ __forceinline__ uint4 pack8(const float (&f)[8]) { uint4 o; o.x = pack2(f[0], f[1]); o.y = pack2(f[2], f[3]); o.z = pack2(f[4], f[5]); o.w = pack2(f[6], f[7]); return o; }
__device__ __forceinline__ float wsum(float v) {
#pragma unroll
    for (int o = 32; o; o >>= 1) v += __shfl_xor(v, o, 64);
    return v;
}
__device__ __forceinline__ float sigm(float z) { return 1.f / (1.f + __expf(-z)); }
__device__ __forceinline__ int row_of(int dir, int s) { return dir == 0 ? s : (s < 256 ? 255 - s : 16895 - s); }

struct APlain { const bf16_t* base; int ld;
    __device__ __forceinline__ const char* bptr() const { return (const char*)base; }
    __device__ __forceinline__ unsigned rowoff(int r) const { return (unsigned)(r * ld) * 2u; } };
struct AGather { const bf16_t* base; int ld; const int* idx;
    __device__ __forceinline__ const char* bptr() const { return (const char*)base; }
    __device__ __forceinline__ unsigned rowoff(int r) const { const int tok = idx[r] / 9; return (unsigned)(tok * ld) * 2u; } };
struct BPlain { static constexpr int MODE = 0; const bf16_t* base; int ldv;
    __device__ __forceinline__ const char* bptr() const { return (const char*)base; }
    __device__ __forceinline__ unsigned rowoff(int n) const { return (unsigned)(n * ldv) * 2u; }
    __device__ __forceinline__ const float* colptr(int) const { return nullptr; }
    __device__ __forceinline__ long ld() const { return ldv; }
    __device__ __forceinline__ int lrow(int, int) const { return 0; } };
struct BKN { static constexpr int MODE = 1; const float* base; long ldv;
    __device__ __forceinline__ const char* bptr() const { return nullptr; }
    __device__ __forceinline__ unsigned rowoff(int) const { return 0u; }
    __device__ __forceinline__ const float* colptr(int n4) const { return base + n4 * 4; }
    __device__ __forceinline__ long ld() const { return ldv; }
    __device__ __forceinline__ int lrow(int n4, int j) const { return n4 * 4 + j; } };
struct BKNGU { static constexpr int MODE = 1; const float* g; const float* u;
    __device__ __forceinline__ const char* bptr() const { return nullptr; }
    __device__ __forceinline__ unsigned rowoff(int) const { return 0u; }
    __device__ __forceinline__ const float* colptr(int n4) const { return ((n4 >> 5) ? u : g) + (n4 & 31) * 4; }
    __device__ __forceinline__ long ld() const { return 256; }
    __device__ __forceinline__ int lrow(int n4, int j) const { int sc = (n4 & 31) * 4 + j; return (sc >> 4) * 32 + (n4 >> 5) * 16 + (sc & 15); } };

__device__ __forceinline__ float f4e(const float4& v, int j) { return j == 0 ? v.x : (j == 1 ? v.y : (j == 2 ? v.z : v.w)); }
#define GC_REP4(N, X) do { if constexpr ((N) > 0) { X(0); } if constexpr ((N) > 1) { X(1); } if constexpr ((N) > 2) { X(2); } if constexpr ((N) > 3) { X(3); } } while (0)
#define GC_REP8(N, X) do { X(0); X(1); X(2); X(3); if constexpr ((N) > 4) { X(4); X(5); X(6); X(7); } } while (0)
#define GC_AOFF(i) aoff##i = ap.rowoff(lrow + 64 * i) + lseg * 16
#define GC_BOFF(i) boff##i = bp.rowoff(lrow + 64 * i) + lseg * 16
#define GC_LA(i) ra##i = *(const uint4*)(abase + (aoff##i + kt_ * 128))
#define GC_LB(i) rb##i = *(const uint4*)(bbase + (boff##i + kt_ * 128))
#define GC_LF(i) rf##i = *(const float4*)(bfp + ((long)kt_ * 64 + i) * bld)
#define GC_SA(i) *(uint4*)(As_ + (lrow + 64 * i) * TSTR + lseg * 16) = ra##i
#define GC_SB(i) *(uint4*)(Bs_ + (lrow + 64 * i) * TSTR + lseg * 16) = rb##i
#define GC_GLOAD(KT) do { const int kt_ = (KT); GC_REP4(AL, GC_LA); \
    if constexpr (BP::MODE == 0) { GC_REP4(BL, GC_LB); } else { GC_REP8(KPT, GC_LF); } } while (0)
#define GC_SF(j) do { char* d_ = Bs_ + bp.lrow(n4, j) * TSTR + kq * KPT * 2; \
        if constexpr (KPT == 4) *(uint2*)d_ = make_uint2(pack2(f4e(rf0, j), f4e(rf1, j)), pack2(f4e(rf2, j), f4e(rf3, j))); \
        else *(uint4*)d_ = make_uint4(pack2(f4e(rf0, j), f4e(rf1, j)), pack2(f4e(rf2, j), f4e(rf3, j)), pack2(f4e(rf4, j), f4e(rf5, j)), pack2(f4e(rf6, j), f4e(rf7, j))); } while (0)
#define GC_LSTORE(BUF) do { char* As_ = smem + (BUF) * STAGE; char* Bs_ = As_ + ABYTES; GC_REP4(AL, GC_SA); \
    if constexpr (BP::MODE == 0) { GC_REP4(BL, GC_SB); } else { GC_SF(0); GC_SF(1); GC_SF(2); GC_SF(3); } } while (0)

template <int BM, int BN, int WGM, int WGN, class AP, class BP>
__device__ __forceinline__ void gemm_core(f32x4 (&acc)[BM / WGM / 16][BN / WGN / 16], const AP& ap, const BP& bp, const int K, char* smem) {
    constexpr int TM = BM / WGM, TN = BN / WGN, MI = TM / 16, NI = TN / 16;
    constexpr int ABYTES = BM * TSTR, STAGE = (BM + BN) * TSTR;
    constexpr int AL = BM / 64, BL = BN / 64;
    constexpr int KPT = BN / 32, NQ = BN / 4;
    const int tid = tidx(), wave = tid >> 6, lane = tid & 63, fr = lane & 15, fq = lane >> 4;
    const int wm = wave / WGN, wn = wave % WGN;
    const int lrow = tid >> 3, lseg = tid & 7;
    const char* abase = ap.bptr(); const char* bbase = bp.bptr();
    unsigned aoff0 = 0, aoff1 = 0, aoff2 = 0, aoff3 = 0, boff0 = 0, boff1 = 0, boff2 = 0, boff3 = 0;
    uint4 ra0, ra1, ra2, ra3, rb0, rb1, rb2, rb3; float4 rf0, rf1, rf2, rf3, rf4, rf5, rf6, rf7;
    GC_REP4(AL, GC_AOFF);
    const float* bfp = nullptr;
    const int kq = tid / NQ, n4 = tid % NQ; const long bld = bp.ld();
    if constexpr (BP::MODE == 0) { GC_REP4(BL, GC_BOFF); } else { bfp = bp.colptr(n4) + (long)(kq * KPT) * bld; }
    int nk = K >> 6;
    asm volatile("" : "+s"(nk));
    GC_GLOAD(0); GC_LSTORE(0); __syncthreads();
    for (int kt = 0; kt < nk; ++kt) {
        if (kt + 1 < nk) GC_GLOAD(kt + 1);
        const char* As = smem + (kt & 1) * STAGE; const char* Bs = As + ABYTES;
#pragma unroll
        for (int ks = 0; ks < 2; ++ks) {
            bf16x8 af[MI], bfr[NI];
#pragma unroll
            for (int mi = 0; mi < MI; ++mi) af[mi] = *(const bf16x8*)(As + (wm * TM + mi * 16 + fr) * TSTR + ks * 64 + fq * 16);
#pragma unroll
            for (int ni = 0; ni < NI; ++ni) bfr[ni] = *(const bf16x8*)(Bs + (wn * TN + ni * 16 + fr) * TSTR + ks * 64 + fq * 16);
#pragma unroll
            for (int mi = 0; mi < MI; ++mi)
#pragma unroll
                for (int ni = 0; ni < NI; ++ni) acc[mi][ni] = __builtin_amdgcn_mfma_f32_16x16x32_bf16(bfr[ni], af[mi], acc[mi][ni], 0, 0, 0);
        }
        if (kt + 1 < nk) GC_LSTORE((kt + 1) & 1);
        __syncthreads();
    }
}
template <int BM, int BN, int WGM, int WGN, class AP, class BP, class EPI>
__device__ __forceinline__ void gemm_tile(const AP& ap, const BP& bp, const int K, char* smem, const EPI& epi) {
    constexpr int TM = BM / WGM, TN = BN / WGN, MI = TM / 16, NI = TN / 16;
    f32x4 acc[MI][NI];
#pragma unroll
    for (int mi = 0; mi < MI; ++mi)
#pragma unroll
        for (int ni = 0; ni < NI; ++ni) acc[mi][ni] = (f32x4){0.f, 0.f, 0.f, 0.f};
    gemm_core<BM, BN, WGM, WGN>(acc, ap, bp, K, smem);
    const int wave = tidx() >> 6, lane = tidx() & 63;
    epi(acc, (wave / WGN) * TM + (lane & 15), (wave % WGN) * TN + (lane >> 4) * 4);
}

namespace g8 {
constexpr int BM = 256, BK = 64, HALF = 128, HTB = HALF * BK * 2, NXCD = 8, WGM = 8;
__device__ __forceinline__ int lds_byte(int r, int c) { const int st = (r >> 4) * 2 + (c >> 5), rr = r & 15, cc = c & 31, ob = rr * 64 + cc * 2; return st * 1024 + (ob ^ (((ob >> 9) & 1) << 5)); }
__device__ __forceinline__ void stage_rc(int b, int& R, int& C) { const int st = b / 1024, sb = b % 1024, swz = sb ^ (((sb >> 9) & 1) << 5); R = (st >> 1) * 16 + swz / 64; C = (st & 1) * 32 + (swz % 64) / 2; }
__device__ __forceinline__ int perm32(int rho) { const int n = rho >> 4, i = rho & 15; return 8 * (i >> 2) + 4 * n + (i & 3); }
struct Unit { int pm, pn; };
struct StaticOrder {
    int nM, nN, nwg, G, c;
    __device__ void init(int M, int N, int G_, int c_) { nM = M / BM; nN = N / BM; nwg = nM * nN; G = G_; c = c_; }
    __device__ bool next(int i, Unit& u) const {
        const long L = (long)i * G + c; if (L >= nwg) return false;
        int wgid = (int)L; { const int q = nwg / NXCD, r = nwg % NXCD, xcd = wgid % NXCD, off = wgid / NXCD; wgid = (xcd < r ? xcd * (q + 1) : r * (q + 1) + (xcd - r) * q) + off; }
        const int nig = WGM * nN, gid = wgid / nig, fm = gid * WGM, gsz = (nM - fm) < WGM ? (nM - fm) : WGM;
        u.pm = fm + ((wgid % nig) % gsz); u.pn = (wgid % nig) / gsz; return true;
    }
};
template <class Epi, class Sched>
__device__ __forceinline__ void gemm_phase(LAS unsigned char* lds, const bf16_t* Ag, const bf16_t* Btg, const int lda, const int ldb, const int K, const Sched& S, const Epi& E) {
    const int tid = threadIdx.x, wid = __builtin_amdgcn_readfirstlane(tid >> 6), lane = tid & 63, wr = wid >> 2, wc = wid & 3, fr = lane & 15, fq = lane >> 4;
    const int nt = K / BK;
    unsigned voffA[2], voffB[2];
#pragma unroll
    for (int i = 0; i < 2; ++i) { int R, C; stage_rc(tid * 16 + i * 8192, R, C); const int Rb = Epi::PERM ? ((R & ~31) + perm32(R & 31)) : R;
        voffA[i] = (unsigned)(R * lda + C) * 2u; voffB[i] = (unsigned)(Rb * ldb + C) * 2u; }
    const size_t kstep = (size_t)(BK * 2);
    const size_t hstepA = (size_t)HALF * lda * 2, hstepB = (size_t)HALF * ldb * 2;
    const size_t tstepA = 2 * hstepA, tstepB = 2 * hstepB;
    const unsigned ldsw = (unsigned)wid * 1024u;
    const int aoff = lds_byte(wr * 64 + fr, fq * 8), boff = lds_byte(wc * 32 + fr, fq * 8);
#define PG8_SA(b, h) (((b) * 2 + (h)) * HTB)
#define PG8_SB(b, h) ((4 + (b) * 2 + (h)) * HTB)
#define PG8_STAGE(bufoff, gbase, voff) do { _Pragma("unroll") for (int _i = 0; _i < 2; ++_i) \
        __builtin_amdgcn_global_load_lds((const unsigned*)((const char*)(gbase) + (voff)[_i]), (LAS unsigned*)(lds + (bufoff) + ldsw + _i * 8192), 16, 0, 0); } while (0)
#define PG8_LDA(dst, b, h) do { _Pragma("unroll") for (int m = 0; m < 4; ++m) _Pragma("unroll") for (int k = 0; k < 2; ++k) dst[m][k] = *(const LAS bf16x8*)(lds + PG8_SA(b, h) + aoff + m * 2048 + k * 1024); } while (0)
#define PG8_LDB(dst, b, h) do { _Pragma("unroll") for (int n = 0; n < 2; ++n) _Pragma("unroll") for (int k = 0; k < 2; ++k) dst[n][k] = *(const LAS bf16x8*)(lds + PG8_SB(b, h) + boff + n * 2048 + k * 1024); } while (0)
#define PG8_MMA(ai, bj, At, Bt) do { __builtin_amdgcn_s_setprio(1); _Pragma("unroll") for (int m = 0; m < 4; ++m) _Pragma("unroll") for (int n = 0; n < 2; ++n) _Pragma("unroll") for (int k = 0; k < 2; ++k) \
        acc[ai][bj][m][n] = __builtin_amdgcn_mfma_f32_16x16x32_bf16(Bt[n][k], At[m][k], acc[ai][bj][m][n], 0, 0, 0); __builtin_amdgcn_s_setprio(0); } while (0)
#define PG8_WAIT_V(n) asm volatile("s_waitcnt vmcnt(" #n ")" ::: "memory")
#define PG8_WAIT_L(n) asm volatile("s_waitcnt lgkmcnt(" #n ")" ::: "memory")
#define PG8_BAR __builtin_amdgcn_s_barrier()
#define PG8_SCHED __builtin_amdgcn_sched_barrier(0)
    Unit cur, nxt; int ui = 0;
    if (!S.next(0, cur)) return;
    f32x4 acc[2][2][4][2];
#pragma unroll
    for (int a = 0; a < 2; ++a)
#pragma unroll
        for (int b = 0; b < 2; ++b)
#pragma unroll
            for (int m = 0; m < 4; ++m)
#pragma unroll
                for (int n = 0; n < 2; ++n) acc[a][b][m][n] = (f32x4){0.f, 0.f, 0.f, 0.f};
    bf16x8 At[4][2], B0[2][2], B1[2][2];
    const char* cA = (const char*)Ag + (size_t)cur.pm * tstepA; const char* cB = (const char*)Btg + (size_t)cur.pn * tstepB;
    PG8_STAGE(PG8_SB(0, 0), cB, voffB); PG8_STAGE(PG8_SA(0, 0), cA, voffA); PG8_STAGE(PG8_SB(0, 1), cB + hstepB, voffB); PG8_STAGE(PG8_SA(0, 1), cA + hstepA, voffA);
    if (wr == 1) PG8_BAR;
    PG8_WAIT_V(4); PG8_BAR;
    PG8_STAGE(PG8_SB(1, 0), cB + kstep, voffB); PG8_STAGE(PG8_SA(1, 0), cA + kstep, voffA); PG8_STAGE(PG8_SB(1, 1), cB + hstepB + kstep, voffB);
    PG8_WAIT_V(6); PG8_BAR;
    for (;;) {
        const bool has_next = S.next(ui + 1, nxt);
        const char* nA = has_next ? (const char*)Ag + (size_t)nxt.pm * tstepA : cA; const char* nB = has_next ? (const char*)Btg + (size_t)nxt.pn * tstepB : cB;
        for (int t = 0; t < nt; t += 2) {
            const bool last = (t == nt - 2);
            const char* a1 = cA + (size_t)(t + 1) * kstep;
            const char* a2 = last ? nA : cA + (size_t)(t + 2) * kstep; const char* b2 = last ? nB : cB + (size_t)(t + 2) * kstep;
            const char* a3 = a2 + kstep; const char* b3 = b2 + kstep;
            PG8_LDB(B0, 0, 0); PG8_SCHED; PG8_LDA(At, 0, 0); PG8_STAGE(PG8_SA(1, 1), a1 + hstepA, voffA);
            PG8_WAIT_L(8); PG8_BAR; PG8_WAIT_L(0); PG8_MMA(0, 0, At, B0); PG8_BAR; PG8_SCHED;
            PG8_LDB(B1, 0, 1); PG8_STAGE(PG8_SB(0, 0), b2, voffB);
            PG8_BAR; PG8_WAIT_L(0); PG8_MMA(0, 1, At, B1); PG8_BAR;
            PG8_LDA(At, 0, 1); PG8_STAGE(PG8_SA(0, 0), a2, voffA);
            PG8_BAR; PG8_WAIT_L(0); PG8_MMA(1, 0, At, B0); PG8_BAR; PG8_SCHED;
            PG8_STAGE(PG8_SB(0, 1), b2 + hstepB, voffB);
            PG8_WAIT_V(6); PG8_BAR; PG8_MMA(1, 1, At, B1); PG8_BAR;
            PG8_LDB(B0, 1, 0); PG8_SCHED; PG8_LDA(At, 1, 0); PG8_STAGE(PG8_SA(0, 1), a2 + hstepA, voffA);
            PG8_WAIT_L(8); PG8_BAR; PG8_WAIT_L(0); PG8_MMA(0, 0, At, B0); PG8_BAR; PG8_SCHED;
            PG8_LDB(B1, 1, 1); PG8_STAGE(PG8_SB(1, 0), b3, voffB);
            PG8_BAR; PG8_WAIT_L(0); PG8_MMA(0, 1, At, B1); PG8_BAR;
            PG8_LDA(At, 1, 1); PG8_STAGE(PG8_SA(1, 0), a3, voffA);
            PG8_BAR; PG8_WAIT_L(0); PG8_MMA(1, 0, At, B0); PG8_BAR; PG8_SCHED;
            PG8_STAGE(PG8_SB(1, 1), b3 + hstepB, voffB);
            PG8_WAIT_V(6); PG8_BAR; PG8_MMA(1, 1, At, B1); PG8_BAR;
        }
        E(acc, cur, wr, wc, fr, fq);
        if (!has_next) break;
#pragma unroll
        for (int a = 0; a < 2; ++a)
#pragma unroll
            for (int b = 0; b < 2; ++b)
#pragma unroll
                for (int m = 0; m < 4; ++m)
#pragma unroll
                    for (int n = 0; n < 2; ++n) acc[a][b][m][n] = (f32x4){0.f, 0.f, 0.f, 0.f};
        cur = nxt; cA = nA; cB = nB; ++ui;
    }
    PG8_WAIT_V(0);
    if (wr == 0) PG8_BAR;
    PG8_BAR;
#undef PG8_SA
#undef PG8_SB
#undef PG8_STAGE
#undef PG8_LDA
#undef PG8_LDB
#undef PG8_MMA
#undef PG8_WAIT_V
#undef PG8_WAIT_L
#undef PG8_BAR
#undef PG8_SCHED
}
struct EpiF32 {
    static constexpr bool PERM = false;
    float* C; int ldc;
    __device__ __forceinline__ void operator()(const f32x4 (&acc)[2][2][4][2], const Unit& u, int wr, int wc, int fr, int fq) const {
        const int row0 = u.pm * BM + wr * 64 + fr, col0 = u.pn * BM + wc * 32 + 4 * fq;
#pragma unroll
        for (int ai = 0; ai < 2; ++ai)
#pragma unroll
            for (int m = 0; m < 4; ++m) { float* rowp = C + (size_t)(row0 + ai * HALF + m * 16) * ldc + col0;
#pragma unroll
                for (int bj = 0; bj < 2; ++bj)
#pragma unroll
                    for (int n = 0; n < 2; ++n) *(f32x4*)(rowp + bj * HALF + n * 16) = acc[ai][bj][m][n]; }
    }
};
struct EpiBf16 {
    static constexpr bool PERM = true;
    bf16_t* O; int ldc;
    __device__ __forceinline__ void operator()(const f32x4 (&acc)[2][2][4][2], const Unit& u, int wr, int wc, int fr, int fq) const {
        const int row0 = u.pm * BM + wr * 64 + fr, col0 = u.pn * BM + wc * 32 + 8 * fq;
#pragma unroll
        for (int ai = 0; ai < 2; ++ai)
#pragma unroll
            for (int m = 0; m < 4; ++m) { bf16_t* rowp = O + (size_t)(row0 + ai * HALF + m * 16) * ldc + col0;
#pragma unroll
                for (int bj = 0; bj < 2; ++bj) { const f32x4 v0 = acc[ai][bj][m][0], v1 = acc[ai][bj][m][1];
                    uint4 o; o.x = pack2(v0[0], v0[1]); o.y = pack2(v0[2], v0[3]); o.z = pack2(v1[0], v1[1]); o.w = pack2(v1[2], v1[3]);
                    *(uint4*)(rowp + bj * HALF) = o; } }
    }
};
}

__device__ __forceinline__ void phase0(const Params& p, char* smem) {
    const int tid = tidx(), wave = tid >> 6, lane = tid & 63;
    const int gw = blockIdx.x * 8 + wave, nw = gridDim.x * 8;
    for (int u = gw; u < 1536; u += nw) {
        const int cb = u % 96, ks = u / 96, j = cb * 64 + lane;
        float a0 = 0.f, a1 = 0.f;
        for (int k = ks * 64; k < ks * 64 + 64; ++k) {
            const float w = p.w_mod[(size_t)k * 6144 + j];
            const float c0 = p.c[k], c1 = p.c_ctx[k];
            a0 += c0 * sigm(c0) * w; a1 += c1 * sigm(c1) * w;
        }
        p.modp[(ks * 2 + 0) * 6144 + j] = a0; p.modp[(ks * 2 + 1) * 6144 + j] = a1;
    }
    float* T = (float*)smem;
    int total = 0;
    for (int j = 0; j < NJOB; ++j) total += (p.jobs[j].K >> 6) * (p.jobs[j].N >> 6);
    for (int u = blockIdx.x; u < total; u += gridDim.x) {
        int j = 0, r = u;
        for (;; ++j) { const int n = (p.jobs[j].K >> 6) * (p.jobs[j].N >> 6); if (r < n) break; r -= n; }
        const TJob jb = p.jobs[j];
        const int ntn = jb.N >> 6, kt = r / ntn, nt = r % ntn, k0 = kt * 64, n0 = nt * 64;
        {
            const int kk = tid >> 4, c4 = (tid & 15) * 4;
#pragma unroll
            for (int i = 0; i < 2; ++i) {
                const int k = kk + 32 * i;
                const float4 v = *(const float4*)(jb.src + (size_t)(k0 + k) * jb.N + n0 + c4);
                T[k * 65 + c4 + 0] = v.x; T[k * 65 + c4 + 1] = v.y; T[k * 65 + c4 + 2] = v.z; T[k * 65 + c4 + 3] = v.w;
            }
        }
        __syncthreads();
        {
            const int n = tid >> 3, ks = (tid & 7) * 8;
            float v[8];
#pragma unroll
            for (int q = 0; q < 8; ++q) v[q] = T[(ks + q) * 65 + n];
            const int ng = n0 + n;
            int drow = jb.rowoff + ng;
            if (jb.mode == 2) drow = (ng >> 4) * 32 + (ng & 15) + jb.rowoff;
            uint4 hi; hi.x = pack2(v[0], v[1]); hi.y = pack2(v[2], v[3]); hi.z = pack2(v[4], v[5]); hi.w = pack2(v[6], v[7]);
            bf16_t* d = jb.dst + (size_t)drow * jb.dld + jb.coloff + k0 + ks;
            *(uint4*)d = hi;
            if (jb.mode == 1) {
                float l[8];
#pragma unroll
                for (int q = 0; q < 8; ++q) l[q] = v[q] - bf2f(f2bf(v[q]));
                uint4 lo; lo.x = pack2(l[0], l[1]); lo.y = pack2(l[2], l[3]); lo.z = pack2(l[4], l[5]); lo.w = pack2(l[6], l[7]);
                *(uint4*)(d + 1024) = hi; *(uint4*)(d + 2048) = lo;
            }
        }
        __syncthreads();
    }
}

__device__ __forceinline__ void phase1(const Params& p, char* smem) {
    const int tid = tidx(), wave = tid >> 6, lane = tid & 63;
    float* L = (float*)smem;
    for (int idx = tid; idx < 4096; idx += NT) {
        const int v = idx >> 11, which = (idx >> 10) & 1, col = idx & 1023;
        float s = p.b_mod[which * 1024 + col];
        for (int ks = 0; ks < 16; ++ks) s += p.modp[(ks * 2 + v) * 6144 + which * 1024 + col];
        L[idx] = s;
    }
    if (blockIdx.x == 0) {
        for (int idx = tid; idx < 2 * 6144; idx += NT) {
            const int v = idx / 6144, j = idx % 6144;
            float s = p.b_mod[j];
            for (int ks = 0; ks < 16; ++ks) s += p.modp[(ks * 2 + v) * 6144 + j];
            p.mod[idx] = s;
        }
    }
    __syncthreads();
    const int gw = blockIdx.x * 8 + wave, nw = gridDim.x * 8;
    for (int r = gw; r < TE; r += nw) {
        const int v = r < 256 ? 1 : 0;
        const float* src = r < 256 ? p.ctx + (size_t)r * 1024 : p.x + (size_t)(r - 256) * 1024;
        float4 xv[4]; float ss = 0.f;
#pragma unroll
        for (int i = 0; i < 4; ++i) { xv[i] = *(const float4*)(src + i * 256 + lane * 4); ss += xv[i].x * xv[i].x + xv[i].y * xv[i].y + xv[i].z * xv[i].z + xv[i].w * xv[i].w; }
        ss = wsum(ss);
        const float rs = rsqrtf(ss * (1.f / 1024.f) + 1e-6f);
#pragma unroll
        for (int i = 0; i < 4; ++i) {
            const int col = i * 256 + lane * 4;
            const float4 g = *(const float4*)(p.n_pre_mix + col);
            const float* sh = L + v * 2048 + col; const float* sc = L + v * 2048 + 1024 + col;
            const float y0 = xv[i].x * rs * g.x * (1.f + sc[0]) + sh[0];
            const float y1 = xv[i].y * rs * g.y * (1.f + sc[1]) + sh[1];
            const float y2 = xv[i].z * rs * g.z * (1.f + sc[2]) + sh[2];
            const float y3 = xv[i].w * rs * g.w * (1.f + sc[3]) + sh[3];
            uint2 o; o.x = pack2(y0, y1); o.y = pack2(y2, y3);
            *(uint2*)(p.hn + (size_t)r * 1024 + col) = o;
        }
    }
}

__device__ __forceinline__ void phase2(const Params& p, char* smem) {
    g8::StaticOrder S; S.init(TE, INC, gridDim.x, blockIdx.x);
    g8::EpiBf16 E{p.proj, INC};
    g8::gemm_phase((LAS unsigned char*)smem, p.hn, p.WinT, 1024, 1024, 1024, S, E);
}

__device__ __forceinline__ void phase3(const Params& p, char* smem) {
    const int tid = tidx(), wave = tid >> 6, lane = tid & 63;
    const int gw = blockIdx.x * 8 + wave, nw = gridDim.x * 8;
    float mu0[3][8], mu1[3][8], kkw[8], lm0[4], lm1[4];
#pragma unroll
    for (int a = 0; a < 3; ++a)
#pragma unroll
        for (int q = 0; q < 8; ++q) { mu0[a][q] = p.shift_mu[a * 512 + lane * 8 + q]; mu1[a][q] = p.shift_mu[1792 + a * 512 + lane * 8 + q]; }
#pragma unroll
    for (int q = 0; q < 8; ++q) kkw[q] = p.rwkv_k_k[lane * 8 + q];
#pragma unroll
    for (int q = 0; q < 4; ++q) { lm0[q] = p.shift_mu[1536 + lane * 4 + q]; lm1[q] = p.shift_mu[1792 + 1536 + lane * 4 + q]; }
    for (int t = gw; t < TE; t += nw) {
        const bool hp = (t != 0 && t != 256), hn_ = (t != 255 && t != TE - 1);
        const bf16_t* pr = p.proj + (size_t)t * INC;
        uint4 q0[3], qm[3], qn[3]; uint2 l0, lm = make_uint2(0, 0), ln = make_uint2(0, 0);
#pragma unroll
        for (int a = 0; a < 3; ++a) {
            q0[a] = *(const uint4*)(pr + a * 512 + lane * 8);
            qm[a] = hp ? *(const uint4*)(pr + a * 512 + lane * 8 - INC) : make_uint4(0, 0, 0, 0);
            qn[a] = hn_ ? *(const uint4*)(pr + a * 512 + lane * 8 + INC) : make_uint4(0, 0, 0, 0);
        }
        l0 = *(const uint2*)(pr + 1536 + lane * 4);
        if (hp) lm = *(const uint2*)(pr + 1536 + lane * 4 - INC);
        if (hn_) ln = *(const uint2*)(pr + 1536 + lane * 4 + INC);
        float val[3][8];
#pragma unroll
        for (int a = 0; a < 3; ++a) {
            float f0[8], fm[8], fn[8]; unpack8(q0[a], f0); unpack8(qm[a], fm); unpack8(qn[a], fn);
#pragma unroll
            for (int q = 0; q < 8; ++q) val[a][q] = f0[q] + mu0[a][q] * (fm[q] - f0[q]) + mu1[a][q] * (fn[q] - f0[q]);
        }
        float kkv[8], n2 = 0.f;
#pragma unroll
        for (int q = 0; q < 8; ++q) { kkv[q] = val[1][q] * kkw[q]; n2 += kkv[q] * kkv[q]; }
        n2 += __shfl_xor(n2, 1, 64); n2 += __shfl_xor(n2, 2, 64); n2 += __shfl_xor(n2, 4, 64);
        const float inv = -1.f / fmaxf(sqrtf(n2), 1e-12f);
#pragma unroll
        for (int q = 0; q < 8; ++q) kkv[q] *= inv;
        const size_t o = (size_t)t * 512 + lane * 8;
        *(uint4*)(p.Rr + o) = pack8(val[0]); *(uint4*)(p.Kk + o) = pack8(val[1]); *(uint4*)(p.Vv + o) = pack8(val[2]); *(uint4*)(p.Aa + o) = pack8(kkv);
        {
            float v[4];
            const unsigned w0[2] = {l0.x, l0.y}, wm[2] = {lm.x, lm.y}, wn[2] = {ln.x, ln.y};
#pragma unroll
            for (int q = 0; q < 4; ++q) {
                const float p0 = (q & 1) ? __uint_as_float(w0[q >> 1] & 0xffff0000u) : __uint_as_float(w0[q >> 1] << 16);
                const float pm = (q & 1) ? __uint_as_float(wm[q >> 1] & 0xffff0000u) : __uint_as_float(wm[q >> 1] << 16);
                const float pn = (q & 1) ? __uint_as_float(wn[q >> 1] & 0xffff0000u) : __uint_as_float(wn[q >> 1] << 16);
                v[q] = p0 + lm0[q] * (pm - p0) + lm1[q] * (pn - p0);
            }
            if (lane < 16) {
                uint2 ov; ov.x = pack2(tanhf(v[0]), tanhf(v[1])); ov.y = pack2(tanhf(v[2]), tanhf(v[3]));
                *(uint2*)(p.TW + (size_t)t * 64 + lane * 4) = ov;
            } else if (lane < 32) {
                uint2 ov; ov.x = pack2(v[0], v[1]); ov.y = pack2(v[2], v[3]);
                *(uint2*)(p.XA + (size_t)t * 64 + (lane - 16) * 4) = ov;
            } else {
                uint2 ov; ov.x = pack2(sigm(v[0]), sigm(v[1])); ov.y = pack2(sigm(v[2]), sigm(v[3]));
                *(uint2*)(p.SG + (size_t)t * 128 + (lane - 32) * 4) = ov;
            }
        }
    }
}

__device__ __forceinline__ void phase4(const Params& p, char* smem) {
    for (int u = blockIdx.x; u < 130 * 20; u += gridDim.x) {
        const int mt = u / 20, q = u % 20;
        if (q < 8) {
            APlain ap{p.TW + (size_t)mt * 128 * 64, 64}; BPlain bp{p.WupT + (size_t)q * 128 * 64, 64};
            gemm_tile<128, 128, 4, 2>(ap, bp, 64, smem, [&](const auto& acc, int r0, int c0) {
#pragma unroll
                for (int mi = 0; mi < 2; ++mi)
#pragma unroll
                    for (int ni = 0; ni < 4; ++ni) {
                        const int t = mt * 128 + r0 + mi * 16, cc = q * 128 + c0 + ni * 16, d = cc >> 9, c = cc & 511;
                        float4 o; float* op = (float*)&o;
#pragma unroll
                        for (int j = 0; j < 4; ++j) { const float z = p.rwkv_w0[d * 512 + c + j] + acc[mi][ni][j]; op[j] = __expf(-0.60653066f * sigm(z)); }
                        *(float4*)(p.Wd + ((size_t)d * TE + t) * 512 + c) = o;
                    }
            });
        } else if (q < 16) {
            const int qq = q - 8;
            APlain ap{p.XA + (size_t)mt * 128 * 64, 64}; BPlain bp{p.AupT + (size_t)qq * 128 * 64, 64};
            gemm_tile<128, 128, 4, 2>(ap, bp, 64, smem, [&](const auto& acc, int r0, int c0) {
#pragma unroll
                for (int mi = 0; mi < 2; ++mi)
#pragma unroll
                    for (int ni = 0; ni < 4; ++ni) {
                        const int t = mt * 128 + r0 + mi * 16, cc = qq * 128 + c0 + ni * 16, d = cc >> 9, c = cc & 511;
                        const uint2 av = *(const uint2*)(p.Aa + (size_t)t * 512 + c), kv = *(const uint2*)(p.Kk + (size_t)t * 512 + c);
                        const bf16_t* ae = (const bf16_t*)&av; const bf16_t* ke = (const bf16_t*)&kv;
                        float bo[4], ko[4];
#pragma unroll
                        for (int j = 0; j < 4; ++j) {
                            const float ad = sigm(p.rwkv_a0[d * 512 + c + j] + acc[mi][ni][j]);
                            bo[j] = -bf2f(ae[j]) * ad;
                            ko[j] = bf2f(ke[j]) * (1.f + (ad - 1.f) * p.rwkv_k_a[c + j]);
                        }
                        uint2 o1, o2; o1.x = pack2(bo[0], bo[1]); o1.y = pack2(bo[2], bo[3]); o2.x = pack2(ko[0], ko[1]); o2.y = pack2(ko[2], ko[3]);
                        *(uint2*)(p.Bd + ((size_t)d * TE + t) * 512 + c) = o1;
                        *(uint2*)(p.KD + ((size_t)d * TE + t) * 512 + c) = o2;
                    }
            });
        } else {
            const int qq = q - 16;
            APlain ap{p.SG + (size_t)mt * 128 * 128, 128}; BPlain bp{p.GupT + (size_t)qq * 128 * 128, 128};
            gemm_tile<128, 128, 4, 2>(ap, bp, 128, smem, [&](const auto& acc, int r0, int c0) {
#pragma unroll
                for (int mi = 0; mi < 2; ++mi)
#pragma unroll
                    for (int ni = 0; ni < 4; ++ni) {
                        const int t = mt * 128 + r0 + mi * 16, c = qq * 128 + c0 + ni * 16;
                        uint2 o; o.x = pack2(acc[mi][ni][0], acc[mi][ni][1]); o.y = pack2(acc[mi][ni][2], acc[mi][ni][3]);
                        *(uint2*)(p.G + (size_t)t * 512 + c) = o;
                    }
            });
        }
    }
}

__device__ __forceinline__ void phase5(const Params& p, char* smem) {
    const int tid = tidx(), wave = __builtin_amdgcn_readfirstlane(tid >> 6), lane = tid & 63;
    constexpr int SB = 5, NA = 6, NSB = RL / SB;
    float* L = (float*)smem + wave * (2 * SB * NA * 64);
    for (int q = blockIdx.x * 8 + wave; q < RNC * 16; q += gridDim.x * 8) {
        const int j = q >> 4, hd = q & 15, dir = hd >> 3, h = hd & 7;
        const float* gW = p.Wd + (size_t)dir * TE * 512; const bf16_t* gB = p.Bd + (size_t)dir * TE * 512; const bf16_t* gK = p.KD + (size_t)dir * TE * 512;
        const bf16_t* gA = p.Aa; const bf16_t* gV = p.Vv; const bf16_t* gR = p.Rr;
        const unsigned lofs = (unsigned)(h * 64 + lane);
        float* gZ = p.Zz + (size_t)q * (RL * 64) + lane; float* gY = p.YH + (size_t)q * (RL * 64) + lane;
        f32x2 sP[32], sH[32];
        int ln = lane; asm volatile("" : "+v"(ln));
#pragma unroll
        for (int k = 0; k < 32; ++k) { sP[k] = (f32x2){(2 * k == ln) ? 1.f : 0.f, (2 * k + 1 == ln) ? 1.f : 0.f}; sH[k] = (f32x2){0.f, 0.f}; }
        for (int sb = 0; sb < NSB; ++sb) {
            {
                float st[SB][NA];
#pragma unroll
                for (int i = 0; i < SB; ++i) {
                    const unsigned g = (unsigned)row_of(dir, j * RL + sb * SB + i) * 512u + lofs;
                    st[i][0] = gW[g]; st[i][1] = bf2f(gA[g]); st[i][2] = bf2f(gB[g]); st[i][3] = bf2f(gK[g]); st[i][4] = bf2f(gV[g]); st[i][5] = bf2f(gR[g]);
                }
                float* d = L + (sb & 1) * (SB * NA * 64) + lane;
#pragma unroll
                for (int i = 0; i < SB; ++i)
#pragma unroll
                    for (int a = 0; a < NA; ++a) d[(i * NA + a) * 64] = st[i][a];
            }
            const float* Lb = L + (sb & 1) * (SB * NA * 64);
#pragma unroll 1
            for (int i = 0; i < SB; ++i) {
                const float* W = Lb + (i * NA) * 64; const float* A = W + 64; const float* B = W + 128; const float* KDv = W + 192; const float* R = W + 320;
                const float vl = W[256 + lane];
                f32x2 dh0 = {0.f, 0.f}, dh1 = {0.f, 0.f}, dp0 = {0.f, 0.f}, dp1 = {0.f, 0.f};
                f32x4 ac0 = *(const f32x4*)(A), ac1 = *(const f32x4*)(A + 4), ac2 = *(const f32x4*)(A + 8), ac3 = *(const f32x4*)(A + 12);
                f32x4 rw[3], rb[3], rk[3], rr[3];
                rw[0] = *(const f32x4*)(W); rb[0] = *(const f32x4*)(B); rk[0] = *(const f32x4*)(KDv); rr[0] = *(const f32x4*)(R);
                rw[1] = *(const f32x4*)(W + 4); rb[1] = *(const f32x4*)(B + 4); rk[1] = *(const f32x4*)(KDv + 4); rr[1] = *(const f32x4*)(R + 4);
#pragma unroll
                for (int c = 0; c < 4; ++c) {
                    f32x4 an0 = ac0, an1 = ac1, an2 = ac2, an3 = ac3;
                    if (c < 3) { an0 = *(const f32x4*)(A + c * 16 + 16); an1 = *(const f32x4*)(A + c * 16 + 20); an2 = *(const f32x4*)(A + c * 16 + 24); an3 = *(const f32x4*)(A + c * 16 + 28); }
                    const int k = c * 8;
                    dh0 += sH[k] * ac0.lo; dh1 += sH[k + 1] * ac0.hi; dp0 += sP[k] * ac0.lo; dp1 += sP[k + 1] * ac0.hi;
                    dh0 += sH[k + 2] * ac1.lo; dh1 += sH[k + 3] * ac1.hi; dp0 += sP[k + 2] * ac1.lo; dp1 += sP[k + 3] * ac1.hi;
                    dh0 += sH[k + 4] * ac2.lo; dh1 += sH[k + 5] * ac2.hi; dp0 += sP[k + 4] * ac2.lo; dp1 += sP[k + 5] * ac2.hi;
                    dh0 += sH[k + 6] * ac3.lo; dh1 += sH[k + 7] * ac3.hi; dp0 += sP[k + 6] * ac3.lo; dp1 += sP[k + 7] * ac3.hi;
                    __builtin_amdgcn_sched_barrier(0);
                    ac0 = an0; ac1 = an1; ac2 = an2; ac3 = an3;
                }
                const float saHs = (dh0.x + dh0.y) + (dh1.x + dh1.y), saPs = (dp0.x + dp0.y) + (dp1.x + dp1.y);
                const f32x2 saH = {saHs, saHs}, saP = {saPs, saPs}, vl2 = {vl, vl};
                f32x2 y0 = {0.f, 0.f}, y1 = {0.f, 0.f}, z0 = {0.f, 0.f}, z1 = {0.f, 0.f};
#pragma unroll
                for (int g = 0; g < 16; ++g) {
                    if (g + 2 < 16) { rw[(g + 2) % 3] = *(const f32x4*)(W + 4 * g + 8); rb[(g + 2) % 3] = *(const f32x4*)(B + 4 * g + 8); rk[(g + 2) % 3] = *(const f32x4*)(KDv + 4 * g + 8); rr[(g + 2) % 3] = *(const f32x4*)(R + 4 * g + 8); }
                    const f32x4 cw = rw[g % 3], cb = rb[g % 3], ck = rk[g % 3], cr = rr[g % 3];
                    const int k = 2 * g;
                    sH[k]     = sH[k]     * cw.lo + (saH * cb.lo + vl2 * ck.lo);
                    sH[k + 1] = sH[k + 1] * cw.hi + (saH * cb.hi + vl2 * ck.hi);
                    sP[k]     = sP[k]     * cw.lo + saP * cb.lo;
                    sP[k + 1] = sP[k + 1] * cw.hi + saP * cb.hi;
                    y0 += sH[k] * cr.lo; y1 += sH[k + 1] * cr.hi;
                    z0 += sP[k] * cr.lo; z1 += sP[k + 1] * cr.hi;
                    __builtin_amdgcn_sched_barrier(0);
                }
                const int t = sb * SB + i;
                gZ[t * 64] = (z0.x + z0.y) + (z1.x + z1.y); gY[t * 64] = (y0.x + y0.y) + (y1.x + y1.y);
            }
        }
        if (j < RNC - 1) {
            float* dP = p.PH + (((size_t)(j * 16 + hd) * 2 + 0) * 64 + lane) * 64;
            float* dH = p.PH + (((size_t)(j * 16 + hd) * 2 + 1) * 64 + lane) * 64;
#pragma unroll
            for (int k = 0; k < 32; k += 2) { *(float4*)(dP + 2 * k) = make_float4(sP[k].x, sP[k].y, sP[k + 1].x, sP[k + 1].y); *(float4*)(dH + 2 * k) = make_float4(sH[k].x, sH[k].y, sH[k + 1].x, sH[k + 1].y); }
        }
    }
}

__device__ __forceinline__ void phase6(const Params& p, char* smem) {
    const int tid = threadIdx.x, wave = __builtin_amdgcn_readfirstlane(tid >> 6), lane = tid & 63;
    if (blockIdx.x >= 256) return;
    const int hd = blockIdx.x >> 4, rb0 = (blockIdx.x & 15) * 4, r0 = rb0 + (wave & 3);
    LAS unsigned char* lds = (LAS unsigned char*)smem;
    constexpr int SLOT = 17408, NJ = RNC - 1;
    const char* pbase = (const char*)(p.PH + (size_t)hd * 2 * 4096);
    float s0 = 0.f;
#define CH_ISSUE(J) do { const char* src_ = pbase + (size_t)(J) * 524288; const unsigned so_ = (unsigned)(((J) & 3) * SLOT); \
        _Pragma("unroll") for (int q_ = 0; q_ < 4; ++q_) __builtin_amdgcn_global_load_lds((const unsigned*)(src_ + ((wave - 4) * 4 + q_) * 1024 + lane * 16), (LAS unsigned*)(lds + so_ + ((wave - 4) * 4 + q_) * 1024), 16, 0, 0); \
        if (wave == 7) __builtin_amdgcn_global_load_lds((const unsigned*)(src_ + 16384 + rb0 * 256 + lane * 16), (LAS unsigned*)(lds + so_ + 16384), 16, 0, 0); } while (0)
    if (wave >= 4) { CH_ISSUE(0); CH_ISSUE(1); CH_ISSUE(2); }
    for (int j = 0; j < RNC; ++j) {
        if (wave < 4) p.Sst[((size_t)(j * 16 + hd) * 64 + r0) * 64 + lane] = s0;
        if (j == NJ) break;
        if (wave >= 4) {
            if (j + 2 >= NJ) asm volatile("s_waitcnt vmcnt(0)" ::: "memory");
            else if (wave == 7) asm volatile("s_waitcnt vmcnt(10)" ::: "memory");
            else asm volatile("s_waitcnt vmcnt(8)" ::: "memory");
        }
        asm volatile("s_waitcnt lgkmcnt(0)" ::: "memory"); __builtin_amdgcn_s_barrier(); asm volatile("" ::: "memory");
        if (wave >= 4) { if (j + 3 < NJ) CH_ISSUE(j + 3); }
        else {
            const float* Pc = (const float*)(smem + (j & 3) * SLOT);
            f32x2 n0 = {Pc[4096 + wave * 64 + lane], 0.f}, n1 = {0.f, 0.f};
#pragma unroll
            for (int k = 0; k < 64; k += 4) {
                const f32x2 a0 = {__int_as_float(__builtin_amdgcn_readlane(__float_as_int(s0), k)), __int_as_float(__builtin_amdgcn_readlane(__float_as_int(s0), k + 1))};
                const f32x2 a1 = {__int_as_float(__builtin_amdgcn_readlane(__float_as_int(s0), k + 2)), __int_as_float(__builtin_amdgcn_readlane(__float_as_int(s0), k + 3))};
                const f32x2 p0 = {Pc[k * 64 + lane], Pc[(k + 1) * 64 + lane]}, p1 = {Pc[(k + 2) * 64 + lane], Pc[(k + 3) * 64 + lane]};
                n0 += a0 * p0; n1 += a1 * p1;
            }
            s0 = (n0.x + n0.y) + (n1.x + n1.y);
        }
    }
#undef CH_ISSUE
    __syncthreads();
}

__device__ __forceinline__ void phase7(const Params& p, char* smem) {
    const int tid = tidx(), wave = __builtin_amdgcn_readfirstlane(tid >> 6), lane = tid & 63;
    constexpr int SB = 10, NSB = RL / SB;
    float* L = (float*)smem + wave * (SB * 64);
    for (int q = 16 + blockIdx.x * 8 + wave; q < RNC * 16; q += gridDim.x * 8) {
        const int j = q >> 4, hd = q & 15, dir = hd >> 3, h = hd & 7;
        f32x2 s[32];
        {
            const float* src = p.Sst + ((size_t)(j * 16 + hd) * 64 + lane) * 64;
#pragma unroll
            for (int k = 0; k < 32; k += 2) { const f32x4 v = *(const f32x4*)(src + 2 * k); s[k] = v.lo; s[k + 1] = v.hi; }
        }
        const float* gZ = p.Zz + (size_t)q * (RL * 64) + lane; const float* gY = p.YH + (size_t)q * (RL * 64) + lane;
        bf16_t* gO = p.O + (size_t)dir * TX * 512 + h * 64 + lane;
        for (int sb = 0; sb < NSB; ++sb) {
            float zz[SB], yy[SB];
#pragma unroll
            for (int i = 0; i < SB; ++i) { zz[i] = gZ[(sb * SB + i) * 64]; yy[i] = gY[(sb * SB + i) * 64]; }
#pragma unroll
            for (int i = 0; i < SB; ++i) L[i * 64 + lane] = zz[i];
#pragma unroll
            for (int i = 0; i < SB; ++i) {
                const float* Z = L + i * 64;
                f32x2 y0 = {yy[i], 0.f}, y1 = {0.f, 0.f};
#pragma unroll
                for (int k = 0; k < 32; k += 2) { const f32x4 z = *(const f32x4*)(Z + 2 * k); y0 += s[k] * z.lo; y1 += s[k + 1] * z.hi; }
                const int row = row_of(dir, j * RL + sb * SB + i);
                if (row >= 256) gO[(size_t)(row - 256) * 512] = f2bf((y0.x + y0.y) + (y1.x + y1.y));
            }
        }
    }
}

__device__ __forceinline__ void phase8(const Params& p, char* smem) {
    const int tid = tidx();
    bf16_t* LT = (bf16_t*)smem;
    constexpr int LTS = 136;
    for (int uu = blockIdx.x; uu < NCH * 8; uu += gridDim.x) {
        const int u = uu >> 1, upart = uu & 1;
        const int c = u >> 2, hh = u & 3;
        const float g0 = sigm(p.ret_decay_logit[hh]), g1 = sigm(p.ret_decay_logit[4 + hh]);
        const float l0 = log2f(g0), l1 = log2f(g1);
        const int n = tid >> 2, part = tid & 3, half = part >> 1, fb = (part & 1) * 16;
        const int t = c * 128 + n;
        const bool lat = c >= 2;
        float pos = 0.f;
        if (lat) { const int tl = t - 256; pos = (float)(half == 0 ? (tl >> 6) : (tl & 63)); }
        const bf16_t* pr = p.proj + (size_t)t * INC;
        float cs[16], sn[16];
#pragma unroll
        for (int f = 0; f < 16; ++f) {
            if (lat) { const float inv = exp2f(-(float)(fb + f) * (13.287712379549449f / 32.f)); sincosf(pos * inv, &sn[f], &cs[f]); }
            else { cs[f] = 1.f; sn[f] = 0.f; }
        }
        const size_t ch = (size_t)(c * 4 + hh);
        if (upart == 0) {
            const int cb = 1792 + hh * 128 + half * 64 + fb;
            uint4 v1a = *(const uint4*)(pr + cb), v1b = *(const uint4*)(pr + cb + 8), v2a = *(const uint4*)(pr + cb + 32), v2b = *(const uint4*)(pr + cb + 40);
            bf16_t x1[16], x2[16];
            *(uint4*)&x1[0] = v1a; *(uint4*)&x1[8] = v1b; *(uint4*)&x2[0] = v2a; *(uint4*)&x2[8] = v2b;
            float o1[16], o2[16];
#pragma unroll
            for (int f = 0; f < 16; ++f) { const float a = bf2f(x1[f]), b = bf2f(x2[f]); o1[f] = a * cs[f] - b * sn[f]; o2[f] = a * sn[f] + b * cs[f]; }
            const float xf = exp2f(l0 * (float)(n + 1)), xb = exp2f(l1 * (float)(128 - n));
            bf16_t* qd = p.Qr + (ch * 128 + n) * 128 + half * 64 + fb;
            bf16_t* ad = p.A3 + (ch * 128 + n) * 384 + 128 + half * 64 + fb;
#pragma unroll
            for (int f = 0; f < 16; f += 2) {
                *(unsigned*)(qd + f) = pack2(o1[f], o1[f + 1]); *(unsigned*)(qd + 32 + f) = pack2(o2[f], o2[f + 1]);
                *(unsigned*)(ad + f) = pack2(o1[f] * xf, o1[f + 1] * xf); *(unsigned*)(ad + 32 + f) = pack2(o2[f] * xf, o2[f + 1] * xf);
                *(unsigned*)(ad + 128 + f) = pack2(o1[f] * xb, o1[f + 1] * xb); *(unsigned*)(ad + 128 + 32 + f) = pack2(o2[f] * xb, o2[f + 1] * xb);
            }
        }
        if (upart == 0) {
            const int cb = 2304 + hh * 128 + half * 64 + fb;
            uint4 v1a = *(const uint4*)(pr + cb), v1b = *(const uint4*)(pr + cb + 8), v2a = *(const uint4*)(pr + cb + 32), v2b = *(const uint4*)(pr + cb + 40);
            bf16_t x1[16], x2[16];
            *(uint4*)&x1[0] = v1a; *(uint4*)&x1[8] = v1b; *(uint4*)&x2[0] = v2a; *(uint4*)&x2[8] = v2b;
            const float sc = 0.08838834764831845f;
            bf16_t* kd = p.Kr + (ch * 128 + n) * 128 + half * 64 + fb;
            __syncthreads();
#pragma unroll
            for (int f = 0; f < 16; ++f) {
                const float a = bf2f(x1[f]) * sc, b = bf2f(x2[f]) * sc;
                const float o1 = a * cs[f] - b * sn[f], o2 = a * sn[f] + b * cs[f];
                const bf16_t h1 = f2bf(o1), h2 = f2bf(o2);
                kd[f] = h1; kd[32 + f] = h2;
                LT[(half * 64 + fb + f) * LTS + n] = h1; LT[(half * 64 + fb + f + 32) * LTS + n] = h2;
            }
            __syncthreads();
            const int d = tid >> 2, ms = (tid & 3) * 32;
#pragma unroll
            for (int dir = 0; dir < 2; ++dir) {
                bf16_t* od = p.KTz + ((ch * 2 + dir) * 128 + d) * 128 + ms;
#pragma unroll
                for (int m = 0; m < 32; m += 2) {
                    const int mm = ms + m;
                    const float z0 = dir == 0 ? exp2f(l0 * (float)(127 - mm)) : exp2f(l1 * (float)mm);
                    const float z1 = dir == 0 ? exp2f(l0 * (float)(126 - mm)) : exp2f(l1 * (float)(mm + 1));
                    *(unsigned*)(od + m) = pack2(bf2f(LT[d * LTS + mm]) * z0, bf2f(LT[d * LTS + mm + 1]) * z1);
                }
            }
        }
#pragma unroll 1
        for (int eh = (upart == 1 ? 0 : 2); eh < 2; ++eh) {
            __syncthreads();
            const int cb = 2816 + hh * 256 + eh * 128 + part * 32;
            bf16_t xv[32];
#pragma unroll
            for (int q = 0; q < 4; ++q) *(uint4*)&xv[q * 8] = *(const uint4*)(pr + cb + q * 8);
#pragma unroll
            for (int f = 0; f < 32; ++f) LT[(part * 32 + f) * LTS + n] = xv[f];
            __syncthreads();
            const int e = tid >> 2, ms = (tid & 3) * 32;
            bf16_t* od = p.B3 + (ch * 256 + eh * 128 + e) * 384 + ms;
#pragma unroll
            for (int m = 0; m < 32; m += 8) *(uint4*)(od + m) = *(const uint4*)(LT + e * LTS + ms + m);
        }
        __syncthreads();
    }
}

__device__ __forceinline__ void phase9(const Params& p, char* smem) {
    for (int u = blockIdx.x; u < 512 + 2080; u += gridDim.x) {
        if (u < 512) {
            const int c = 2 + (u >> 2), hh = u & 3;
            const size_t ch = (size_t)(c * 4 + hh);
            const float l0 = log2f(sigm(p.ret_decay_logit[hh])), l1 = log2f(sigm(p.ret_decay_logit[4 + hh]));
            APlain ap{p.Qr + ch * 128 * 128, 128}; BPlain bp{p.Kr + ch * 128 * 128, 128};
            bf16_t* outp = p.A3 + ch * 128 * 384;
            gemm_tile<128, 128, 4, 2>(ap, bp, 128, smem, [&](const auto& acc, int r0, int c0) {
#pragma unroll
                for (int mi = 0; mi < 2; ++mi)
#pragma unroll
                    for (int ni = 0; ni < 4; ++ni) {
                        const int n = r0 + mi * 16, m0 = c0 + ni * 16;
                        float o[4];
#pragma unroll
                        for (int j = 0; j < 4; ++j) {
                            const int m = m0 + j;
                            float w = 0.f;
                            if (n >= m) w += exp2f(l0 * (float)(n - m));
                            if (m >= n) w += exp2f(l1 * (float)(m - n));
                            o[j] = acc[mi][ni][j] * w;
                        }
                        uint2 ov; ov.x = pack2(o[0], o[1]); ov.y = pack2(o[2], o[3]);
                        *(uint2*)(outp + (size_t)n * 384 + m0) = ov;
                    }
            });
        } else {
            const int v = u - 512, mt = v & 1, dir = (v >> 1) & 1, chh = v >> 2;
            APlain ap{p.B3 + ((size_t)chh * 256 + mt * 128) * 384, 384}; BPlain bp{p.KTz + ((size_t)chh * 2 + dir) * 128 * 128, 128};
            float* outp = p.KVT + (((size_t)chh * 2 + dir) * 256 + mt * 128) * 128;
            gemm_tile<128, 128, 4, 2>(ap, bp, 128, smem, [&](const auto& acc, int r0, int c0) {
#pragma unroll
                for (int mi = 0; mi < 2; ++mi)
#pragma unroll
                    for (int ni = 0; ni < 4; ++ni) *(f32x4*)(outp + (size_t)(r0 + mi * 16) * 128 + c0 + ni * 16) = acc[mi][ni];
            });
        }
    }
}

__device__ __forceinline__ void phase10(const Params& p, char* smem) {
    for (int idx = blockIdx.x * NT + tidx(); idx < 131072; idx += gridDim.x * NT) {
        const int hh = idx >> 15, dir = (idx >> 14) & 1, e = (idx >> 6) & 255, d = (idx & 63) * 2;
        const float g = sigm(p.ret_decay_logit[dir * 4 + hh]);
        const float g128 = exp2f(128.f * log2f(g));
        float R0 = 0.f, R1 = 0.f;
        const float* kvb = p.KVT + ((size_t)(hh * 2 + dir) * 256 + e) * 128 + d;
        bf16_t* rtb = p.B3 + ((size_t)hh * 256 + e) * 384 + 128 + dir * 128 + d;
        for (int s0 = 0; s0 < NCH; s0 += 13) {
            float2 kv[13];
#pragma unroll
            for (int i = 0; i < 13; ++i) { const int sc = s0 + i, c = dir == 0 ? sc : (sc < 2 ? 1 - sc : 131 - sc); kv[i] = *(const float2*)(kvb + (size_t)c * 262144); }
#pragma unroll
            for (int i = 0; i < 13; ++i) {
                const int sc = s0 + i, c = dir == 0 ? sc : (sc < 2 ? 1 - sc : 131 - sc);
                if (c >= 2) *(unsigned*)(rtb + (size_t)c * 393216) = pack2(R0, R1);
                R0 = g128 * R0 + kv[i].x; R1 = g128 * R1 + kv[i].y;
            }
        }
    }
}

__device__ __forceinline__ void phase11(const Params& p, char* smem) {
    for (int u = blockIdx.x; u < 1024; u += gridDim.x) {
        const int nt = u & 1, chh = 8 + (u >> 1), c = chh >> 2, hh = chh & 3;
        APlain ap{p.A3 + (size_t)chh * 128 * 384, 384}; BPlain bp{p.B3 + ((size_t)chh * 256 + nt * 128) * 384, 384};
        float* outp = p.Y + (size_t)((c - 2) * 128) * 1024 + hh * 256 + nt * 128;
        gemm_tile<128, 128, 4, 2>(ap, bp, 384, smem, [&](const auto& acc, int r0, int c0) {
#pragma unroll
            for (int mi = 0; mi < 2; ++mi)
#pragma unroll
                for (int ni = 0; ni < 4; ++ni) *(f32x4*)(outp + (size_t)(r0 + mi * 16) * 1024 + c0 + ni * 16) = acc[mi][ni];
        });
    }
}

__device__ __forceinline__ void phase12(const Params& p, char* smem) {
    const int tid = tidx(), wave = tid >> 6, lane = tid & 63;
    const int gw = blockIdx.x * 8 + wave, nw = gridDim.x * 8;
    float lw[8], lb[8], rk[8];
#pragma unroll
    for (int q = 0; q < 8; ++q) { lw[q] = p.rwkv_ln_w[lane * 8 + q]; lb[q] = p.rwkv_ln_b[lane * 8 + q]; rk[q] = p.rwkv_r_k[lane * 8 + q]; }
    for (int t = gw; t < TX; t += nw) {
        const size_t te = (size_t)(t + 256) * 512 + lane * 8;
        const uint4 uof = *(const uint4*)(p.O + (size_t)t * 512 + lane * 8), uob = *(const uint4*)(p.O + ((size_t)TX + t) * 512 + lane * 8);
        const uint4 ur = *(const uint4*)(p.Rr + te), uk0 = *(const uint4*)(p.KD + te), uk1 = *(const uint4*)(p.KD + (size_t)TE * 512 + te), uv = *(const uint4*)(p.Vv + te), ug = *(const uint4*)(p.G + te);
        const float* yp = p.Y + (size_t)t * 1024 + lane * 16;
        const float4 y0 = *(const float4*)(yp), y1 = *(const float4*)(yp + 4), y2 = *(const float4*)(yp + 8), y3 = *(const float4*)(yp + 12);
        const bf16_t* gbp = p.proj + (size_t)(t + 256) * INC + 3840 + lane * 16;
        const uint4 ugb0 = *(const uint4*)(gbp), ugb1 = *(const uint4*)(gbp + 8);
        {
            float of[8], ob[8], r[8], k0[8], k1[8], v[8], gg[8], o[8];
            unpack8(uof, of); unpack8(uob, ob); unpack8(ur, r); unpack8(uk0, k0); unpack8(uk1, k1); unpack8(uv, v); unpack8(ug, gg);
            float sm = 0.f, bs = 0.f;
#pragma unroll
            for (int q = 0; q < 8; ++q) { o[q] = of[q] + ob[q]; sm += o[q]; bs += r[q] * (k0[q] + k1[q]) * rk[q]; }
            sm += __shfl_xor(sm, 1, 64); sm += __shfl_xor(sm, 2, 64); sm += __shfl_xor(sm, 4, 64);
            bs += __shfl_xor(bs, 1, 64); bs += __shfl_xor(bs, 2, 64); bs += __shfl_xor(bs, 4, 64);
            const float mu = sm * (1.f / 64.f);
            float vs = 0.f;
#pragma unroll
            for (int q = 0; q < 8; ++q) { o[q] -= mu; vs += o[q] * o[q]; }
            vs += __shfl_xor(vs, 1, 64); vs += __shfl_xor(vs, 2, 64); vs += __shfl_xor(vs, 4, 64);
            const float rs = rsqrtf(vs * (1.f / 64.f) + 64e-5f);
            float ya[8];
#pragma unroll
            for (int q = 0; q < 8; ++q) ya[q] = (o[q] * rs * lw[q] + lb[q] + bs * v[q]) * gg[q];
            *(uint4*)(p.ya_in + (size_t)t * 512 + lane * 8) = pack8(ya);
        }
        {
            float y[16] = {y0.x, y0.y, y0.z, y0.w, y1.x, y1.y, y1.z, y1.w, y2.x, y2.y, y2.z, y2.w, y3.x, y3.y, y3.z, y3.w};
            float sm = 0.f;
#pragma unroll
            for (int q = 0; q < 16; ++q) sm += y[q];
            sm += __shfl_xor(sm, 1, 64); sm += __shfl_xor(sm, 2, 64); sm += __shfl_xor(sm, 4, 64); sm += __shfl_xor(sm, 8, 64);
            const float mu = sm * (1.f / 256.f);
            float vs = 0.f;
#pragma unroll
            for (int q = 0; q < 16; ++q) { y[q] -= mu; vs += y[q] * y[q]; }
            vs += __shfl_xor(vs, 1, 64); vs += __shfl_xor(vs, 2, 64); vs += __shfl_xor(vs, 4, 64); vs += __shfl_xor(vs, 8, 64);
            const float rs = rsqrtf(vs * (1.f / 256.f) + 1e-5f);
            float gb[16]; { float t0[8], t1[8]; unpack8(ugb0, t0); unpack8(ugb1, t1);
#pragma unroll
                for (int q = 0; q < 8; ++q) { gb[q] = t0[q]; gb[8 + q] = t1[q]; } }
            float o0[8], o1[8];
#pragma unroll
            for (int q = 0; q < 16; ++q) {
                const int c = lane * 16 + q;
                const float ov = (y[q] * rs * p.ret_ln_w[c] + p.ret_ln_b[c]) * (gb[q] * sigm(gb[q]));
                if (q < 8) o0[q] = ov; else o1[q - 8] = ov;
            }
            bf16_t* d = p.yb_in + (size_t)t * 1024 + lane * 16;
            *(uint4*)d = pack8(o0); *(uint4*)(d + 8) = pack8(o1);
        }
    }
}

__device__ __forceinline__ void phase13(const Params& p, char* smem) {
    for (int u = blockIdx.x; u < 512; u += gridDim.x) {
        const int mt = u >> 2, nt = u & 3;
        f32x4 acca[4][4], accb[4][4];
#pragma unroll
        for (int mi = 0; mi < 4; ++mi)
#pragma unroll
            for (int ni = 0; ni < 4; ++ni) { acca[mi][ni] = (f32x4){0.f, 0.f, 0.f, 0.f}; accb[mi][ni] = (f32x4){0.f, 0.f, 0.f, 0.f}; }
        { APlain ap{p.ya_in + (size_t)mt * 128 * 512, 512}; BPlain bp{p.WaT + (size_t)nt * 256 * 512, 512};
          gemm_core<128, 256, 2, 4>(acca, ap, bp, 512, smem); }
        { APlain ap{p.yb_in + (size_t)mt * 128 * 1024, 1024}; BPlain bp{p.WbT + (size_t)nt * 256 * 1024, 1024};
          gemm_core<128, 256, 2, 4>(accb, ap, bp, 1024, smem); }
        const int wave = tidx() >> 6, lane = tidx() & 63;
        const int r0 = (wave >> 2) * 64 + (lane & 15), c0 = (wave & 3) * 64 + (lane >> 4) * 4;
#pragma unroll
        for (int mi = 0; mi < 4; ++mi)
#pragma unroll
            for (int ni = 0; ni < 4; ++ni) {
                const int t = mt * 128 + r0 + mi * 16, c = nt * 256 + c0 + ni * 16;
                const bf16_t* gp = p.proj + (size_t)(t + 256) * INC + c;
                const uint2 ga = *(const uint2*)(gp + 4864), gb = *(const uint2*)(gp + 5888);
                float o[4];
                o[0] = sigm(__uint_as_float(ga.x << 16)) * acca[mi][ni][0] + sigm(__uint_as_float(gb.x << 16)) * accb[mi][ni][0];
                o[1] = sigm(__uint_as_float(ga.x & 0xffff0000u)) * acca[mi][ni][1] + sigm(__uint_as_float(gb.x & 0xffff0000u)) * accb[mi][ni][1];
                o[2] = sigm(__uint_as_float(ga.y << 16)) * acca[mi][ni][2] + sigm(__uint_as_float(gb.y << 16)) * accb[mi][ni][2];
                o[3] = sigm(__uint_as_float(ga.y & 0xffff0000u)) * acca[mi][ni][3] + sigm(__uint_as_float(gb.y & 0xffff0000u)) * accb[mi][ni][3];
                uint2 ov; ov.x = pack2(o[0], o[1]); ov.y = pack2(o[2], o[3]);
                *(uint2*)(p.merged + (size_t)t * 1024 + c) = ov;
            }
    }
}
__device__ __forceinline__ void phase14(const Params& p, char* smem) {
    g8::StaticOrder S; S.init(TX, 1024, gridDim.x, blockIdx.x);
    g8::EpiF32 E{p.mix, 1024};
    g8::gemm_phase((LAS unsigned char*)smem, p.merged, p.WoT, 1024, 1024, 1024, S, E);
}

__device__ __forceinline__ void phase15(const Params& p, char* smem) {
    const int tid = tidx(), wave = tid >> 6, lane = tid & 63;
    const int gw = blockIdx.x * 8 + wave, nw = gridDim.x * 8;
    const float* g1 = p.mod + 2048; const float* sh2 = p.mod + 3072; const float* sc2 = p.mod + 4096;
    for (int t = gw; t < TX; t += nw) {
        float4 mv[4], xm[4]; float ss = 0.f;
#pragma unroll
        for (int i = 0; i < 4; ++i) { mv[i] = *(const float4*)(p.mix + (size_t)t * 1024 + i * 256 + lane * 4); ss += mv[i].x * mv[i].x + mv[i].y * mv[i].y + mv[i].z * mv[i].z + mv[i].w * mv[i].w; }
        ss = wsum(ss);
        const float rs = rsqrtf(ss * (1.f / 1024.f) + 1e-6f);
        float s2 = 0.f;
#pragma unroll
        for (int i = 0; i < 4; ++i) {
            const int col = i * 256 + lane * 4;
            const float4 xv = *(const float4*)(p.x + (size_t)t * 1024 + col);
            const float4 gn = *(const float4*)(p.n_post_mix + col), gg = *(const float4*)(g1 + col);
            xm[i].x = xv.x + gg.x * (mv[i].x * rs * gn.x); xm[i].y = xv.y + gg.y * (mv[i].y * rs * gn.y);
            xm[i].z = xv.z + gg.z * (mv[i].z * rs * gn.z); xm[i].w = xv.w + gg.w * (mv[i].w * rs * gn.w);
            *(float4*)(p.x_mid + (size_t)t * 1024 + col) = xm[i];
            s2 += xm[i].x * xm[i].x + xm[i].y * xm[i].y + xm[i].z * xm[i].z + xm[i].w * xm[i].w;
        }
        s2 = wsum(s2);
        const float rs2 = rsqrtf(s2 * (1.f / 1024.f) + 1e-6f);
#pragma unroll
        for (int i = 0; i < 4; ++i) {
            const int col = i * 256 + lane * 4;
            const float4 gn = *(const float4*)(p.n_pre_ffn + col), sc = *(const float4*)(sc2 + col), sh = *(const float4*)(sh2 + col);
            float h[4];
            h[0] = xm[i].x * rs2 * gn.x * (1.f + sc.x) + sh.x; h[1] = xm[i].y * rs2 * gn.y * (1.f + sc.y) + sh.y;
            h[2] = xm[i].z * rs2 * gn.z * (1.f + sc.z) + sh.z; h[3] = xm[i].w * rs2 * gn.w * (1.f + sc.w) + sh.w;
            float l[4];
#pragma unroll
            for (int j = 0; j < 4; ++j) l[j] = h[j] - bf2f(f2bf(h[j]));
            uint2 hi, lo; hi.x = pack2(h[0], h[1]); hi.y = pack2(h[2], h[3]); lo.x = pack2(l[0], l[1]); lo.y = pack2(l[2], l[3]);
            bf16_t* d = p.Ahl + (size_t)t * 3072 + col;
            *(uint2*)d = hi; *(uint2*)(d + 1024) = lo; *(uint2*)(d + 2048) = hi;
        }
    }
}

__device__ __forceinline__ void phase16(const Params& p, char* smem) {
    for (int u = blockIdx.x; u < 256; u += gridDim.x) {
        const int mt = u >> 1, nt = u & 1;
        APlain ap{p.Ahl + (size_t)mt * 128 * 3072, 3072}; BPlain bp{p.RtT + (size_t)nt * 128 * 3072, 3072};
        float* outp = p.logits + (size_t)mt * 128 * 256 + nt * 128;
        gemm_tile<128, 128, 4, 2>(ap, bp, 3072, smem, [&](const auto& acc, int r0, int c0) {
#pragma unroll
            for (int mi = 0; mi < 2; ++mi)
#pragma unroll
                for (int ni = 0; ni < 4; ++ni) *(f32x4*)(outp + (size_t)(r0 + mi * 16) * 256 + c0 + ni * 16) = acc[mi][ni];
        });
    }
}

__device__ __forceinline__ void phase17(const Params& p, char* smem) {
    const int tid = tidx(), wave = tid >> 6, lane = tid & 63;
    const int gw = blockIdx.x * 8 + wave, nw = gridDim.x * 8;
    for (int t = gw; t < TX; t += nw) {
        float sc[4], key[4];
#pragma unroll
        for (int i = 0; i < 4; ++i) { const int e = lane + 64 * i; sc[i] = sigm(p.logits[(size_t)t * 256 + e]); key[i] = sc[i] + p.router_bias[e]; }
        float mys = 0.f; int mye = 0; float ssum = 0.f;
#pragma unroll 1
        for (int k = 0; k < 8; ++k) {
            float bv = -1e30f; int be = 1 << 20;
#pragma unroll
            for (int i = 0; i < 4; ++i) if (key[i] > bv) { bv = key[i]; be = lane + 64 * i; }
#pragma unroll
            for (int o = 32; o; o >>= 1) {
                const float ov = __shfl_xor(bv, o, 64); const int oe = __shfl_xor(be, o, 64);
                if (ov > bv || (ov == bv && oe < be)) { bv = ov; be = oe; }
            }
            float sv = 0.f;
            if ((be & 63) == lane) {
#pragma unroll
                for (int i = 0; i < 4; ++i) if ((be >> 6) == i) { sv = sc[i]; key[i] = -1e30f; }
            }
            sv = __shfl(sv, be & 63, 64);
            ssum += sv;
            if (lane == k) { mys = sv; mye = be; }
        }
        if (lane < 8) {
            const int pos = atomicAdd(&p.cnt[mye], 1);
            p.tok_e[t * 8 + lane] = mye; p.tok_pos[t * 8 + lane] = pos; p.tok_w[t * 8 + lane] = mys / ssum * 2.5f;
        }
    }
}

__device__ __forceinline__ void phase18(const Params& p, char* smem) {
    const int tid = tidx();
    int* ps = (int*)smem;
    int* xs = ps + 260;
    if (tid < 64) {
        int c[4], tot = 0, ttot = 0;
#pragma unroll
        for (int q = 0; q < 4; ++q) { c[q] = p.cnt[tid * 4 + q]; tot += c[q]; ttot += (c[q] + 255) >> 8; }
        int incl = tot, tincl = ttot;
#pragma unroll
        for (int o = 1; o < 64; o <<= 1) { const int v = __shfl_up(incl, o, 64), tv = __shfl_up(tincl, o, 64); if (tid >= o) { incl += v; tincl += tv; } }
        int ex = incl - tot, tex = tincl - ttot;
#pragma unroll
        for (int q = 0; q < 4; ++q) { ps[tid * 4 + q] = ex; xs[tid * 4 + q] = tex; ex += c[q]; tex += (c[q] + 255) >> 8; }
        if (tid == 63) { ps[256] = incl; xs[256] = tincl; }
    }
    __syncthreads();
    if (blockIdx.x == 0) {
        const int nx = xs[256];
        if (tid == 0) *p.ntiles = nx + 64;
        for (int e = tid; e < 256; e += NT) {
            const int c = ps[e + 1] - ps[e];
            for (int t = 0; t < ((c + 255) >> 8); ++t) { int* x = p.xt + (xs[e] + t) * 4; x[0] = e; x[1] = ps[e] + 256 * t; x[2] = min(256, c - 256 * t); x[3] = 0; }
        }
        if (tid < 64) { int* x = p.xt + (nx + tid) * 4; x[0] = 256; x[1] = 131072 + 256 * tid; x[2] = 256; x[3] = 0; }
        if (tid < 256) p.slot_tk[NSLOT + tid] = 0;
    }
    for (int i = blockIdx.x * NT + tid; i < TX * 8; i += gridDim.x * NT) p.slot_tk[ps[p.tok_e[i]] + p.tok_pos[i]] = (i >> 3) * 9 + (i & 7);
    for (int t = blockIdx.x * NT + tid; t < TX; t += gridDim.x * NT) p.slot_tk[131072 + t] = t * 9 + 8;
}

__device__ __forceinline__ void phase19(const Params& p, char* smem) {
    const int nun = *p.ntiles * 2;
    const int lb = (blockIdx.x & 7) * (gridDim.x >> 3) + (blockIdx.x >> 3);
    for (int u = lb; u < nun; u += gridDim.x) {
        const int* x = p.xt + (u >> 1) * 4; const int nt = u & 1;
        const int e = x[0], row0 = x[1], nrows = x[2];
        const float* wg = (e < 256 ? p.exp_w_gate + (size_t)e * 262144 : p.sh_w_gate) + nt * 128;
        const float* wu = (e < 256 ? p.exp_w_up + (size_t)e * 262144 : p.sh_w_up) + nt * 128;
        AGather ap{p.Ahl, 3072, p.slot_tk + row0};
        BKNGU bp{wg, wu};
        bf16_t* outp = p.act + (size_t)row0 * 256 + nt * 128;
        gemm_tile<256, 256, 2, 4>(ap, bp, 1024, smem, [&](const auto& acc, int r0, int c0) {
#pragma unroll
            for (int mi = 0; mi < 8; ++mi) {
                if (r0 + mi * 16 < nrows) {
#pragma unroll
                    for (int gp = 0; gp < 2; ++gp) {
                        const int g = (c0 >> 5) + gp, fq4 = c0 & 15;
                        float o[4];
#pragma unroll
                        for (int j = 0; j < 4; ++j) { const float gt = acc[mi][gp * 2][j], up = acc[mi][gp * 2 + 1][j]; o[j] = gt * sigm(gt) * up; }
                        uint2 ov; ov.x = pack2(o[0], o[1]); ov.y = pack2(o[2], o[3]);
                        *(uint2*)(outp + (size_t)(r0 + mi * 16) * 256 + g * 16 + fq4) = ov;
                    }
                }
            }
        });
    }
}

__device__ __forceinline__ void phase20(const Params& p, char* smem) {
    const int nun = *p.ntiles * 4;
    const int lb = (blockIdx.x & 7) * (gridDim.x >> 3) + (blockIdx.x >> 3);
    for (int u = lb; u < nun; u += gridDim.x) {
        const int* x = p.xt + (u >> 2) * 4; const int nt = u & 3;
        const int e = x[0], row0 = x[1], nrows = x[2];
        APlain ap{p.act + (size_t)row0 * 256, 256};
        BKN bp{(e < 256 ? p.exp_w_down + (size_t)e * 262144 : p.sh_w_down) + nt * 256, 1024};
        const int* stk = p.slot_tk + row0;
        gemm_tile<256, 256, 2, 4>(ap, bp, 256, smem, [&](const auto& acc, int r0, int c0) {
#pragma unroll
            for (int mi = 0; mi < 8; ++mi) {
                const int r = r0 + mi * 16;
                if (r < nrows) {
                    bf16_t* d = p.yk + (size_t)stk[r] * 1024 + nt * 256 + c0;
#pragma unroll
                    for (int ni = 0; ni < 4; ++ni) {
                        uint2 ov; ov.x = pack2(acc[mi][ni][0], acc[mi][ni][1]); ov.y = pack2(acc[mi][ni][2], acc[mi][ni][3]);
                        *(uint2*)(d + ni * 16) = ov;
                    }
                }
            }
        });
    }
}

__device__ __forceinline__ void phase21(const Params& p, char* smem) {
    const int tid = tidx(), wave = tid >> 6, lane = tid & 63;
    const int gw = blockIdx.x * 8 + wave, nw = gridDim.x * 8;
    const float* g2 = p.mod + 5120;
    for (int t = gw; t < TX; t += nw) {
        float w[9];
#pragma unroll
        for (int k = 0; k < 8; ++k) w[k] = p.tok_w[t * 8 + k];
        w[8] = 1.f;
        float4 mo[4]; float ss = 0.f;
#pragma unroll
        for (int i = 0; i < 4; ++i) {
            const int col = i * 256 + lane * 4;
            float a0 = 0.f, a1 = 0.f, a2 = 0.f, a3 = 0.f;
#pragma unroll
            for (int k = 0; k < 9; ++k) {
                const uint2 v = *(const uint2*)(p.yk + ((size_t)t * 9 + k) * 1024 + col);
                a0 += w[k] * __uint_as_float(v.x << 16); a1 += w[k] * __uint_as_float(v.x & 0xffff0000u); a2 += w[k] * __uint_as_float(v.y << 16); a3 += w[k] * __uint_as_float(v.y & 0xffff0000u);
            }
            mo[i] = make_float4(a0, a1, a2, a3);
            ss += a0 * a0 + a1 * a1 + a2 * a2 + a3 * a3;
        }
        ss = wsum(ss);
        const float rs = rsqrtf(ss * (1.f / 1024.f) + 1e-6f);
#pragma unroll
        for (int i = 0; i < 4; ++i) {
            const int col = i * 256 + lane * 4;
            const float4 xm = *(const float4*)(p.x_mid + (size_t)t * 1024 + col);
            const float4 gn = *(const float4*)(p.n_post_ffn + col), gg = *(const float4*)(g2 + col);
            float4 o;
            o.x = xm.x + gg.x * (mo[i].x * rs * gn.x); o.y = xm.y + gg.y * (mo[i].y * rs * gn.y);
            o.z = xm.z + gg.z * (mo[i].z * rs * gn.z); o.w = xm.w + gg.w * (mo[i].w * rs * gn.w);
            *(float4*)(p.out + (size_t)t * 1024 + col) = o;
        }
    }
}

constexpr int NPHASE = 22;
template <int PH> __device__ __forceinline__ void run_phase(const Params& p, char* smem) {
    if constexpr (PH == 0) phase0(p, smem);
    else if constexpr (PH == 1) phase1(p, smem);
    else if constexpr (PH == 2) phase2(p, smem);
    else if constexpr (PH == 3) phase3(p, smem);
    else if constexpr (PH == 4) phase4(p, smem);
    else if constexpr (PH == 5) phase5(p, smem);
    else if constexpr (PH == 6) phase6(p, smem);
    else if constexpr (PH == 7) phase7(p, smem);
    else if constexpr (PH == 8) phase8(p, smem);
    else if constexpr (PH == 9) phase9(p, smem);
    else if constexpr (PH == 10) phase10(p, smem);
    else if constexpr (PH == 11) phase11(p, smem);
    else if constexpr (PH == 12) phase12(p, smem);
    else if constexpr (PH == 13) phase13(p, smem);
    else if constexpr (PH == 14) phase14(p, smem);
    else if constexpr (PH == 15) phase15(p, smem);
    else if constexpr (PH == 16) phase16(p, smem);
    else if constexpr (PH == 17) phase17(p, smem);
    else if constexpr (PH == 18) phase18(p, smem);
    else if constexpr (PH == 19) phase19(p, smem);
    else if constexpr (PH == 20) phase20(p, smem);
    else phase21(p, smem);
}

template <int PH> __global__ void __launch_bounds__(NT, 2) k_phase(Params p) {
    extern __shared__ __attribute__((aligned(16))) char smem[];
    run_phase<PH>(p, smem);
}

template <int PH> __device__ __forceinline__ void mega_run(const Params& p, char* smem, const XcdBarrier& bar) {
    run_phase<PH>(p, smem);
    if constexpr (((PROBE_MASK) >> PH) & 1u) { xcd_barrier(bar); run_phase<PH>(p, smem); }
    if constexpr (PH + 1 < NPHASE) { xcd_barrier(bar); mega_run<PH + 1>(p, smem, bar); }
}
__global__ void __launch_bounds__(NT, 2) k_mega(Params p) {
    extern __shared__ __attribute__((aligned(16))) char smem[];
    uint4* xbw = (uint4*)(smem + 8 * TILE_BYTES);
    if (tidx() == 0) *xbw = make_uint4(0u, 0u, 0u, 0u);
    __syncthreads();
    XcdBarrier bar = xcd_barrier_post(p.bar, (volatile LAS unsigned*)xbw);
    mega_run<0>(p, smem, bar);
}

template <int PH> static void launch_phases(const Params& p, int grid, hipStream_t stream) {
    static bool attr = false;
    if (!attr) { (void)hipFuncSetAttribute((const void*)k_phase<PH>, hipFuncAttributeMaxDynamicSharedMemorySize, LDS_BYTES); attr = true; }
    hipLaunchKernelGGL(k_phase<PH>, dim3(grid), dim3(NT), LDS_BYTES, stream, p);
    if constexpr (PH + 1 < NPHASE) launch_phases<PH + 1>(p, grid, stream);
}

extern "C" void kernel_launch(void* const* d_in, const int* in_sizes, int n_in, void* d_out, int out_size, void* d_ws, size_t ws_size, hipStream_t stream) {
    static int grid = 0;
    if (grid == 0) {
        int dev = 0, cus = 0, per_cu = 0;
        (void)hipGetDevice(&dev); (void)hipDeviceGetAttribute(&cus, hipDeviceAttributeMultiprocessorCount, dev);
        (void)hipFuncSetAttribute((const void*)k_mega, hipFuncAttributeMaxDynamicSharedMemorySize, LDS_BYTES);
        (void)hipOccupancyMaxActiveBlocksPerMultiprocessor(&per_cu, (const void*)k_mega, NT, LDS_BYTES);
        (void)hipGetLastError();
        if (cus <= 0) cus = 256;
        grid = cus * (per_cu >= 2 ? 2 : 1);
    }
    Params p{};
    const float** pin = (const float**)&p.x;
    for (int i = 0; i < 36; ++i) pin[i] = (const float*)d_in[i];
    p.out = (float*)d_out;
    char* ws = (char*)d_ws; size_t off = 0;
    auto alloc = [&](size_t bytes) { size_t o = off; off += (bytes + 255) & ~(size_t)255; return ws + o; };
    p.bar = (unsigned*)alloc(XCD_BAR_WORDS * 4); p.cnt = (int*)alloc(256 * 4);
    const size_t zero_bytes = off;
    p.slot_tk = (int*)alloc((size_t)(NSLOT + 256) * 4);
    p.xt = (int*)alloc(NXT_MAX * 16); p.ntiles = (int*)alloc(256);
    p.tok_e = (int*)alloc((size_t)TX * 8 * 4); p.tok_pos = (int*)alloc((size_t)TX * 8 * 4); p.tok_w = (float*)alloc((size_t)TX * 8 * 4);
    p.modp = (float*)alloc(16 * 2 * 6144 * 4); p.mod = (float*)alloc(2 * 6144 * 4);
    p.WinT = (bf16_t*)alloc((size_t)INC * 1024 * 2); p.WaT = (bf16_t*)alloc(1024 * 512 * 2); p.WbT = (bf16_t*)alloc(1024 * 1024 * 2); p.WoT = (bf16_t*)alloc(1024 * 1024 * 2);
    p.RtT = (bf16_t*)alloc(256 * 3072 * 2); p.ShGU = (bf16_t*)alloc(512 * 1024 * 2); p.ShD = (bf16_t*)alloc(1024 * 256 * 2);
    p.WupT = (bf16_t*)alloc(1024 * 64 * 2); p.AupT = (bf16_t*)alloc(1024 * 64 * 2); p.GupT = (bf16_t*)alloc(512 * 128 * 2);
    p.ya_in = (bf16_t*)alloc((size_t)TX * 512 * 2); p.yb_in = (bf16_t*)alloc((size_t)TX * 1024 * 2);
    char* RA = alloc((size_t)TE * INC * 2);
    p.proj = (bf16_t*)RA;
    { size_t o = 0; auto sub = [&](size_t b) { char* r = RA + o; o += (b + 255) & ~(size_t)255; return r; };
      p.act = (bf16_t*)sub(((size_t)NSLOT + 256) * 256 * 2); p.logits = (float*)sub((size_t)TX * 256 * 4); }
    const size_t surv = (size_t)TE * 512 * 2 * 5 + (size_t)2 * TX * 512 * 2 + 4096;
    const size_t rtmp = 424935424 + 65536;
    char* RB = alloc(surv + rtmp);
    { size_t o = 0; auto sub = [&](size_t b) { char* r = RB + o; o += (b + 255) & ~(size_t)255; return r; };
      p.Rr = (bf16_t*)sub((size_t)TE * 512 * 2); p.Vv = (bf16_t*)sub((size_t)TE * 512 * 2); p.KD = (bf16_t*)sub((size_t)2 * TE * 512 * 2); p.G = (bf16_t*)sub((size_t)TE * 512 * 2);
      p.O = (bf16_t*)sub((size_t)2 * TX * 512 * 2);
      const size_t o_t = o;
      p.Kk = (bf16_t*)sub((size_t)TE * 512 * 2); p.Aa = (bf16_t*)sub((size_t)TE * 512 * 2); p.Bd = (bf16_t*)sub((size_t)2 * TE * 512 * 2);
      p.Wd = (float*)sub((size_t)2 * TE * 512 * 4); p.TW = (bf16_t*)sub((size_t)TE * 64 * 2); p.XA = (bf16_t*)sub((size_t)TE * 64 * 2); p.SG = (bf16_t*)sub((size_t)TE * 128 * 2);
      p.PH = (float*)sub((size_t)127 * 16 * 2 * 4096 * 4); p.Sst = (float*)sub((size_t)128 * 16 * 4096 * 4);
      p.Zz = (float*)sub((size_t)RNC * 16 * RL * 64 * 4); p.YH = (float*)sub((size_t)RNC * 16 * RL * 64 * 4);
      p.hn = (bf16_t*)p.PH;
      o = o_t;
      p.Qr = (bf16_t*)sub((size_t)NCH * 4 * 128 * 128 * 2); p.Kr = (bf16_t*)sub((size_t)NCH * 4 * 128 * 128 * 2); p.KTz = (bf16_t*)sub((size_t)NCH * 4 * 2 * 128 * 128 * 2);
      p.A3 = (bf16_t*)sub((size_t)NCH * 4 * 128 * 384 * 2); p.B3 = (bf16_t*)sub((size_t)NCH * 4 * 256 * 384 * 2);
      p.KVT = (float*)sub((size_t)NCH * 4 * 2 * 256 * 128 * 4); p.Y = (float*)sub((size_t)TX * 1024 * 4);
      o = 0;
      p.x_mid = (float*)sub((size_t)TX * 1024 * 4); p.Ahl = (bf16_t*)sub((size_t)TX * 3072 * 2);
      p.yk = (bf16_t*)sub((size_t)TX * 9 * 1024 * 2);
      char* yk0 = (char*)p.yk; p.mergedA = (float*)yk0; p.merged = (bf16_t*)(yk0 + (size_t)TX * 1024 * 4); p.mix = (float*)(yk0 + (size_t)TX * 1024 * 6);
    }
    if (off > ws_size) { fprintf(stderr, "kernel_launch: workspace too small: need %zu have %zu\n", off, ws_size); return; }
    int j = 0;
    p.jobs[j++] = TJob{p.w_in, p.WinT, 1024, INC, 1024, 0, 0, 0};
    p.jobs[j++] = TJob{p.w_branch_a, p.WaT, 512, 1024, 512, 0, 0, 0};
    p.jobs[j++] = TJob{p.w_branch_b, p.WbT, 1024, 1024, 1024, 0, 0, 0};
    p.jobs[j++] = TJob{p.w_out, p.WoT, 1024, 1024, 1024, 0, 0, 0};
    p.jobs[j++] = TJob{p.router_w, p.RtT, 1024, 256, 3072, 1, 0, 0};
    p.jobs[j++] = TJob{p.rwkv_g_up, p.GupT, 0, 0, 128, 0, 0, 0};
    p.jobs[j++] = TJob{p.rwkv_g_up, p.GupT, 0, 0, 128, 0, 0, 0};
    p.jobs[j++] = TJob{p.rwkv_g_up, p.GupT, 0, 0, 128, 0, 0, 0};
    p.jobs[j++] = TJob{p.rwkv_w_up, p.WupT, 64, 512, 64, 0, 0, 0};
    p.jobs[j++] = TJob{p.rwkv_w_up + 64 * 512, p.WupT, 64, 512, 64, 0, 512, 0};
    p.jobs[j++] = TJob{p.rwkv_a_up, p.AupT, 64, 512, 64, 0, 0, 0};
    p.jobs[j++] = TJob{p.rwkv_a_up + 64 * 512, p.AupT, 64, 512, 64, 0, 512, 0};
    p.jobs[j++] = TJob{p.rwkv_g_up, p.GupT, 128, 512, 128, 0, 0, 0};
    p.jobs[j++] = TJob{p.rwkv_g_up, p.GupT, 0, 0, 128, 0, 0, 0};
    (void)hipMemsetAsync(ws, 0, zero_bytes, stream);
#if MK_ONE_LAUNCH
    hipLaunchKernelGGL(k_mega, dim3(grid), dim3(NT), LDS_BYTES, stream, p);
#else
    launch_phases<0>(p, grid, stream);
#endif
}
```

```cpp
#include <hip/hip_runtime.h>
#include <stdint.h>
#include <stdio.h>

#ifndef MK_ONE_LAUNCH
#define MK_ONE_LAUNCH 1
#endif
#ifndef ROUTER_K
#define ROUTER_K 1024
#endif
#ifndef PROBE_MASK
#define PROBE_MASK 0u
#endif

typedef unsigned short bf16_t;
typedef short bf16x8 __attribute__((ext_vector_type(8)));
typedef float f32x4 __attribute__((ext_vector_type(4)));
typedef float f32x2 __attribute__((ext_vector_type(2)));

#define NT 512
constexpr int TX = 16384, TC = 256, TE = 16640, DM = 1024, INC = 6912;
constexpr int NCH = 130;
constexpr int RL = 130, RNC = 128;
constexpr int TSTR = 144;
constexpr int TILE_BYTES = 128 * TSTR;
constexpr int LDS_BYTES = 8 * TILE_BYTES + 1024;
constexpr int NSLOT = 131072 + 16384;
constexpr int NXT_MAX = 768 + 64;

#define XB_TMO      128
#define XB_XCNT(j)  (256  + 64 * (j))
#define XB_XSUB(j)  (1280 + 64 * (j))
#define XB_XGEN(j)  (2304 + 64 * (j))
#define XB_TOP      3328
#define XB_TOPGEN   3392
#define XCD_BAR_WORDS 3456
#define XB_SPIN_CAP (1u << 18)
#define LAS __attribute__((address_space(3)))

__device__ __forceinline__ unsigned xb_ld(unsigned* p)              { return __hip_atomic_load(p, __ATOMIC_RELAXED, __HIP_MEMORY_SCOPE_AGENT); }
__device__ __forceinline__ unsigned xb_add(unsigned* p, unsigned v) { return __hip_atomic_fetch_add(p, v, __ATOMIC_RELAXED, __HIP_MEMORY_SCOPE_AGENT); }
__device__ __forceinline__ unsigned xb_xcc_id() { return (unsigned)__builtin_amdgcn_s_getreg((3 << 11) | 20) & 0xFu; }
#define XB_SPIN(cond, bar) do { unsigned _sp = 0; while (cond) { __builtin_amdgcn_s_sleep(1); \
    if ((++_sp & 255u) == 0u) { if (xb_ld(&(bar)[XB_TMO])) break; if (_sp > XB_SPIN_CAP) { atomicAdd(&(bar)[XB_TMO], 1u); break; } } } } while (0)

struct XcdBarrier { unsigned* bar; unsigned x; volatile LAS unsigned* st; };

__device__ __forceinline__ XcdBarrier xcd_barrier_post(unsigned* bar, volatile LAS unsigned* st) {
    XcdBarrier b; b.bar = bar; b.x = xb_xcc_id(); b.st = st;
    if (threadIdx.x == 0) (void)xb_add(&bar[XB_XCNT(b.x)], 1u);
    return b;
}
__device__ __forceinline__ void xcd_barrier_complete(unsigned* bar, unsigned x, unsigned& nloc, unsigned& nx) {
    const unsigned G = gridDim.x * gridDim.y * gridDim.z;
    unsigned sum, cnt, mine, sp = 0u;
    for (;;) {
        sum = 0u; cnt = 0u; mine = 0u;
#pragma unroll
        for (unsigned j = 0; j < 16; ++j) { const unsigned c = xb_ld(&bar[XB_XCNT(j)]); sum += c; cnt += (c > 0u) ? 1u : 0u; mine = (j == x) ? c : mine; }
        if (sum == G) break;
        __builtin_amdgcn_s_sleep(1);
        if ((++sp & 255u) == 0u) { if (xb_ld(&bar[XB_TMO])) break; if (sp > XB_SPIN_CAP) { atomicAdd(&bar[XB_TMO], 1u); break; } }
    }
    nloc = mine > 0u ? mine : 1u; nx = cnt > 0u ? cnt : 1u;
}
__device__ __forceinline__ void xcd_barrier(const XcdBarrier& b) {
    asm volatile("s_waitcnt vmcnt(0)" ::: "memory");
    __syncthreads();
    if (threadIdx.x == 0) {
        unsigned* bar = b.bar;
        __builtin_amdgcn_s_waitcnt(0);
        unsigned nloc = b.st[0], nx = b.st[1];
        if (nloc == 0u) { xcd_barrier_complete(bar, b.x, nloc, nx); b.st[0] = nloc; b.st[1] = nx; }
        const unsigned old = xb_add(&bar[XB_XSUB(b.x)], 1u);
        const unsigned gen = old / nloc;
        if (old + 1u == (gen + 1u) * nloc) {
            __builtin_amdgcn_fence(__ATOMIC_RELEASE, "agent");
            asm volatile("s_waitcnt vmcnt(0)" ::: "memory");
            const unsigned og = xb_add(&bar[XB_TOP], 1u);
            const unsigned tg = og / nx;
            if (og + 1u == (tg + 1u) * nx) xb_add(&bar[XB_TOPGEN], 1u);
            else XB_SPIN(xb_ld(&bar[XB_TOPGEN]) == tg, bar);
            __builtin_amdgcn_fence(__ATOMIC_ACQUIRE, "agent");
            xb_add(&bar[XB_XGEN(b.x)], 1u);
            asm volatile("s_waitcnt vmcnt(0)" ::: "memory");
        } else {
            XB_SPIN(xb_ld(&bar[XB_XGEN(b.x)]) == gen, bar);
            __builtin_amdgcn_fence(__ATOMIC_ACQUIRE, "agent");
            asm volatile("s_waitcnt vmcnt(0)" ::: "memory");
        }
    }
    __syncthreads();
}

struct TJob { const float* src; bf16_t* dst; int K, N, dld, mode, rowoff, coloff; };
constexpr int NJOB = 14;

struct Params {
    const float *x, *c, *ctx, *c_ctx, *w_mod, *b_mod, *n_pre_mix, *n_post_mix, *n_pre_ffn, *n_post_ffn,
        *w_in, *shift_mu, *rwkv_w0, *rwkv_w_up, *rwkv_a0, *rwkv_a_up, *rwkv_g_up, *rwkv_k_k, *rwkv_k_a, *rwkv_r_k,
        *rwkv_ln_w, *rwkv_ln_b, *w_branch_a, *ret_decay_logit, *ret_ln_w, *ret_ln_b, *w_branch_b, *w_out,
        *router_w, *router_bias, *exp_w_gate, *exp_w_up, *exp_w_down, *sh_w_gate, *sh_w_up, *sh_w_down;
    float* out;
    unsigned* bar; int* cnt; int* slot_tk; int* xt; int* ntiles; int* tok_e; int* tok_pos; float* tok_w;
    float* modp; float* mod;
    bf16_t *WinT, *WaT, *WbT, *WoT, *RtT, *ShGU, *ShD, *WupT, *AupT, *GupT;
    bf16_t *hn, *proj;
    bf16_t *Rr, *Vv, *KD, *G, *O;
    bf16_t *Kk, *Aa, *Bd, *TW, *XA, *SG;
    float *Wd, *PH, *Sst, *Zz, *YH;
    bf16_t *Qr, *Kr, *KTz, *A3, *B3;
    float *KVT, *Y;
    bf16_t *ya_in, *yb_in, *merged, *Ahl, *act, *yk;
    float *mergedA, *mix, *x_mid, *logits;
    TJob jobs[NJOB];
};

__device__ __forceinline__ int tidx() { int t = threadIdx.x; asm volatile("" : "+v"(t)); return t; }
__device__ __forceinline__ float bf2f(bf16_t v) { return __uint_as_float(((unsigned)v) << 16); }
__device__ __forceinline__ bf16_t f2bf(float f) { unsigned u = __float_as_uint(f); u += 0x7fffu + ((u >> 16) & 1u); return (bf16_t)(u >> 16); }
__device__ __forceinline__ unsigned pack2(float lo, float hi) { return (unsigned)f2bf(lo) | ((unsigned)f2bf(hi) << 16); }
__device__ __forceinline__ void unpack8(const uint4& v, float (&f)[8]) {
    f[0] = __uint_as_float(v.x << 16); f[1] = __uint_as_float(v.x & 0xffff0000u); f[2] = __uint_as_float(v.y << 16); f[3] = __uint_as_float(v.y & 0xffff0000u);
    f[4] = __uint_as_float(v.z << 16); f[5] = __uint_as_float(v.z & 0xffff0000u); f[6] = __uint_as_float(v.w << 16); f[7] = __uint_as_float(v.w & 0xffff0000u); }
__device__ __forceinline__ uint4 pack8(const float (&f)[8]) { uint4 o; o.x = pack2(f[0], f[1]); o.y = pack2(f[2], f[3]); o.z = pack2(f[4], f[5]); o.w = pack2(f[6], f[7]); return o; }
__device__ __forceinline__ float wsum(float v) {
#pragma unroll
    for (int o = 32; o; o >>= 1) v += __shfl_xor(v, o, 64);
    return v;
}
__device__ __forceinline__ float sigm(float z) { return 1.f / (1.f + __expf(-z)); }
__device__ __forceinline__ int row_of(int dir, int s) { return dir == 0 ? s : (s < 256 ? 255 - s : 16895 - s); }

struct APlain { const bf16_t* base; int ld;
    __device__ __forceinline__ const char* bptr() const { return (const char*)base; }
    __device__ __forceinline__ unsigned rowoff(int r) const { return (unsigned)(r * ld) * 2u; } };
struct AGather { const bf16_t* base; int ld; const int* idx;
    __device__ __forceinline__ const char* bptr() const { return (const char*)base; }
    __device__ __forceinline__ unsigned rowoff(int r) const { const int tok = idx[r] / 9; return (unsigned)(tok * ld) * 2u; } };
struct BPlain { static constexpr int MODE = 0; const bf16_t* base; int ldv;
    __device__ __forceinline__ const char* bptr() const { return (const char*)base; }
    __device__ __forceinline__ unsigned rowoff(int n) const { return (unsigned)(n * ldv) * 2u; }
    __device__ __forceinline__ const float* colptr(int) const { return nullptr; }
    __device__ __forceinline__ long ld() const { return ldv; }
    __device__ __forceinline__ int lrow(int, int) const { return 0; } };
struct BKN { static constexpr int MODE = 1; const float* base; long ldv;
    __device__ __forceinline__ const char* bptr() const { return nullptr; }
    __device__ __forceinline__ unsigned rowoff(int) const { return 0u; }
    __device__ __forceinline__ const float* colptr(int n4) const { return base + n4 * 4; }
    __device__ __forceinline__ long ld() const { return ldv; }
    __device__ __forceinline__ int lrow(int n4, int j) const { return n4 * 4 + j; } };
struct BKNGU { static constexpr int MODE = 1; const float* g; const float* u;
    __device__ __forceinline__ const char* bptr() const { return nullptr; }
    __device__ __forceinline__ unsigned rowoff(int) const { return 0u; }
    __device__ __forceinline__ const float* colptr(int n4) const { return ((n4 >> 5) ? u : g) + (n4 & 31) * 4; }
    __device__ __forceinline__ long ld() const { return 256; }
    __device__ __forceinline__ int lrow(int n4, int j) const { int sc = (n4 & 31) * 4 + j; return (sc >> 4) * 32 + (n4 >> 5) * 16 + (sc & 15); } };

__device__ __forceinline__ float f4e(const float4& v, int j) { return j == 0 ? v.x : (j == 1 ? v.y : (j == 2 ? v.z : v.w)); }
#define GC_REP4(N, X) do { if constexpr ((N) > 0) { X(0); } if constexpr ((N) > 1) { X(1); } if constexpr ((N) > 2) { X(2); } if constexpr ((N) > 3) { X(3); } } while (0)
#define GC_REP8(N, X) do { X(0); X(1); X(2); X(3); if constexpr ((N) > 4) { X(4); X(5); X(6); X(7); } } while (0)
#define GC_AOFF(i) aoff##i = ap.rowoff(lrow + 64 * i) + lseg * 16
#define GC_BOFF(i) boff##i = bp.rowoff(lrow + 64 * i) + lseg * 16
#define GC_LA(i) ra##i = *(const uint4*)(abase + (aoff##i + kt_ * 128))
#define GC_LB(i) rb##i = *(const uint4*)(bbase + (boff##i + kt_ * 128))
#define GC_LF(i) rf##i = *(const float4*)(bfp + ((long)kt_ * 64 + i) * bld)
#define GC_SA(i) *(uint4*)(As_ + (lrow + 64 * i) * TSTR + lseg * 16) = ra##i
#define GC_SB(i) *(uint4*)(Bs_ + (lrow + 64 * i) * TSTR + lseg * 16) = rb##i
#define GC_GLOAD(KT) do { const int kt_ = (KT); GC_REP4(AL, GC_LA); \
    if constexpr (BP::MODE == 0) { GC_REP4(BL, GC_LB); } else { GC_REP8(KPT, GC_LF); } } while (0)
#define GC_SF(j) do { char* d_ = Bs_ + bp.lrow(n4, j) * TSTR + kq * KPT * 2; \
        if constexpr (KPT == 4) *(uint2*)d_ = make_uint2(pack2(f4e(rf0, j), f4e(rf1, j)), pack2(f4e(rf2, j), f4e(rf3, j))); \
        else *(uint4*)d_ = make_uint4(pack2(f4e(rf0, j), f4e(rf1, j)), pack2(f4e(rf2, j), f4e(rf3, j)), pack2(f4e(rf4, j), f4e(rf5, j)), pack2(f4e(rf6, j), f4e(rf7, j))); } while (0)
#define GC_LSTORE(BUF) do { char* As_ = smem + (BUF) * STAGE; char* Bs_ = As_ + ABYTES; GC_REP4(AL, GC_SA); \
    if constexpr (BP::MODE == 0) { GC_REP4(BL, GC_SB); } else { GC_SF(0); GC_SF(1); GC_SF(2); GC_SF(3); } } while (0)

template <int BM, int BN, int WGM, int WGN, class AP, class BP>
__device__ __forceinline__ void gemm_core(f32x4 (&acc)[BM / WGM / 16][BN / WGN / 16], const AP& ap, const BP& bp, const int K, char* smem) {
    constexpr int TM = BM / WGM, TN = BN / WGN, MI = TM / 16, NI = TN / 16;
    constexpr int ABYTES = BM * TSTR, STAGE = (BM + BN) * TSTR;
    constexpr int AL = BM / 64, BL = BN / 64;
    constexpr int KPT = BN / 32, NQ = BN / 4;
    const int tid = tidx(), wave = tid >> 6, lane = tid & 63, fr = lane & 15, fq = lane >> 4;
    const int wm = wave / WGN, wn = wave % WGN;
    const int lrow = tid >> 3, lseg = tid & 7;
    const char* abase = ap.bptr(); const char* bbase = bp.bptr();
    unsigned aoff0 = 0, aoff1 = 0, aoff2 = 0, aoff3 = 0, boff0 = 0, boff1 = 0, boff2 = 0, boff3 = 0;
    uint4 ra0, ra1, ra2, ra3, rb0, rb1, rb2, rb3; float4 rf0, rf1, rf2, rf3, rf4, rf5, rf6, rf7;
    GC_REP4(AL, GC_AOFF);
    const float* bfp = nullptr;
    const int kq = tid / NQ, n4 = tid % NQ; const long bld = bp.ld();
    if constexpr (BP::MODE == 0) { GC_REP4(BL, GC_BOFF); } else { bfp = bp.colptr(n4) + (long)(kq * KPT) * bld; }
    int nk = K >> 6;
    asm volatile("" : "+s"(nk));
    GC_GLOAD(0); GC_LSTORE(0); __syncthreads();
    for (int kt = 0; kt < nk; ++kt) {
        if (kt + 1 < nk) GC_GLOAD(kt + 1);
        const char* As = smem + (kt & 1) * STAGE; const char* Bs = As + ABYTES;
#pragma unroll
        for (int ks = 0; ks < 2; ++ks) {
            bf16x8 af[MI], bfr[NI];
#pragma unroll
            for (int mi = 0; mi < MI; ++mi) af[mi] = *(const bf16x8*)(As + (wm * TM + mi * 16 + fr) * TSTR + ks * 64 + fq * 16);
#pragma unroll
            for (int ni = 0; ni < NI; ++ni) bfr[ni] = *(const bf16x8*)(Bs + (wn * TN + ni * 16 + fr) * TSTR + ks * 64 + fq * 16);
#pragma unroll
            for (int mi = 0; mi < MI; ++mi)
#pragma unroll
                for (int ni = 0; ni < NI; ++ni) acc[mi][ni] = __builtin_amdgcn_mfma_f32_16x16x32_bf16(bfr[ni], af[mi], acc[mi][ni], 0, 0, 0);
        }
        if (kt + 1 < nk) GC_LSTORE((kt + 1) & 1);
        __syncthreads();
    }
}
template <int BM, int BN, int WGM, int WGN, class AP, class BP, class EPI>
__device__ __forceinline__ void gemm_tile(const AP& ap, const BP& bp, const int K, char* smem, const EPI& epi) {
    constexpr int TM = BM / WGM, TN = BN / WGN, MI = TM / 16, NI = TN / 16;
    f32x4 acc[MI][NI];
#pragma unroll
    for (int mi = 0; mi < MI; ++mi)
#pragma unroll
        for (int ni = 0; ni < NI; ++ni) acc[mi][ni] = (f32x4){0.f, 0.f, 0.f, 0.f};
    gemm_core<BM, BN, WGM, WGN>(acc, ap, bp, K, smem);
    const int wave = tidx() >> 6, lane = tidx() & 63;
    epi(acc, (wave / WGN) * TM + (lane & 15), (wave % WGN) * TN + (lane >> 4) * 4);
}

namespace g8 {
constexpr int BM = 256, BK = 64, HALF = 128, HTB = HALF * BK * 2, NXCD = 8, WGM = 8;
__device__ __forceinline__ int lds_byte(int r, int c) { const int st = (r >> 4) * 2 + (c >> 5), rr = r & 15, cc = c & 31, ob = rr * 64 + cc * 2; return st * 1024 + (ob ^ (((ob >> 9) & 1) << 5)); }
__device__ __forceinline__ void stage_rc(int b, int& R, int& C) { const int st = b / 1024, sb = b % 1024, swz = sb ^ (((sb >> 9) & 1) << 5); R = (st >> 1) * 16 + swz / 64; C = (st & 1) * 32 + (swz % 64) / 2; }
__device__ __forceinline__ int perm32(int rho) { const int n = rho >> 4, i = rho & 15; return 8 * (i >> 2) + 4 * n + (i & 3); }
struct Unit { int pm, pn; };
struct StaticOrder {
    int nM, nN, nwg, G, c;
    __device__ void init(int M, int N, int G_, int c_) { nM = M / BM; nN = N / BM; nwg = nM * nN; G = G_; c = c_; }
    __device__ bool next(int i, Unit& u) const {
        const long L = (long)i * G + c; if (L >= nwg) return false;
        int wgid = (int)L; { const int q = nwg / NXCD, r = nwg % NXCD, xcd = wgid % NXCD, off = wgid / NXCD; wgid = (xcd < r ? xcd * (q + 1) : r * (q + 1) + (xcd - r) * q) + off; }
        const int nig = WGM * nN, gid = wgid / nig, fm = gid * WGM, gsz = (nM - fm) < WGM ? (nM - fm) : WGM;
        u.pm = fm + ((wgid % nig) % gsz); u.pn = (wgid % nig) / gsz; return true;
    }
};
template <class Epi, class Sched>
__device__ __forceinline__ void gemm_phase(LAS unsigned char* lds, const bf16_t* Ag, const bf16_t* Btg, const int lda, const int ldb, const int K, const Sched& S, const Epi& E) {
    const int tid = threadIdx.x, wid = __builtin_amdgcn_readfirstlane(tid >> 6), lane = tid & 63, wr = wid >> 2, wc = wid & 3, fr = lane & 15, fq = lane >> 4;
    const int nt = K / BK;
    unsigned voffA[2], voffB[2];
#pragma unroll
    for (int i = 0; i < 2; ++i) { int R, C; stage_rc(tid * 16 + i * 8192, R, C); const int Rb = Epi::PERM ? ((R & ~31) + perm32(R & 31)) : R;
        voffA[i] = (unsigned)(R * lda + C) * 2u; voffB[i] = (unsigned)(Rb * ldb + C) * 2u; }
    const size_t kstep = (size_t)(BK * 2);
    const size_t hstepA = (size_t)HALF * lda * 2, hstepB = (size_t)HALF * ldb * 2;
    const size_t tstepA = 2 * hstepA, tstepB = 2 * hstepB;
    const unsigned ldsw = (unsigned)wid * 1024u;
    const int aoff = lds_byte(wr * 64 + fr, fq * 8), boff = lds_byte(wc * 32 + fr, fq * 8);
#define PG8_SA(b, h) (((b) * 2 + (h)) * HTB)
#define PG8_SB(b, h) ((4 + (b) * 2 + (h)) * HTB)
#define PG8_STAGE(bufoff, gbase, voff) do { _Pragma("unroll") for (int _i = 0; _i < 2; ++_i) \
        __builtin_amdgcn_global_load_lds((const unsigned*)((const char*)(gbase) + (voff)[_i]), (LAS unsigned*)(lds + (bufoff) + ldsw + _i * 8192), 16, 0, 0); } while (0)
#define PG8_LDA(dst, b, h) do { _Pragma("unroll") for (int m = 0; m < 4; ++m) _Pragma("unroll") for (int k = 0; k < 2; ++k) dst[m][k] = *(const LAS bf16x8*)(lds + PG8_SA(b, h) + aoff + m * 2048 + k * 1024); } while (0)
#define PG8_LDB(dst, b, h) do { _Pragma("unroll") for (int n = 0; n < 2; ++n) _Pragma("unroll") for (int k = 0; k < 2; ++k) dst[n][k] = *(const LAS bf16x8*)(lds + PG8_SB(b, h) + boff + n * 2048 + k * 1024); } while (0)
#define PG8_MMA(ai, bj, At, Bt) do { __builtin_amdgcn_s_setprio(1); _Pragma("unroll") for (int m = 0; m < 4; ++m) _Pragma("unroll") for (int n = 0; n < 2; ++n) _Pragma("unroll") for (int k = 0; k < 2; ++k) \
        acc[ai][bj][m][n] = __builtin_amdgcn_mfma_f32_16x16x32_bf16(Bt[n][k], At[m][k], acc[ai][bj][m][n], 0, 0, 0); __builtin_amdgcn_s_setprio(0); } while (0)
#define PG8_WAIT_V(n) asm volatile("s_waitcnt vmcnt(" #n ")" ::: "memory")
#define PG8_WAIT_L(n) asm volatile("s_waitcnt lgkmcnt(" #n ")" ::: "memory")
#define PG8_BAR __builtin_amdgcn_s_barrier()
#define PG8_SCHED __builtin_amdgcn_sched_barrier(0)
    Unit cur, nxt; int ui = 0;
    if (!S.next(0, cur)) return;
    f32x4 acc[2][2][4][2];
#pragma unroll
    for (int a = 0; a < 2; ++a)
#pragma unroll
        for (int b = 0; b < 2; ++b)
#pragma unroll
            for (int m = 0; m < 4; ++m)
#pragma unroll
                for (int n = 0; n < 2; ++n) acc[a][b][m][n] = (f32x4){0.f, 0.f, 0.f, 0.f};
    bf16x8 At[4][2], B0[2][2], B1[2][2];
    const char* cA = (const char*)Ag + (size_t)cur.pm * tstepA; const char* cB = (const char*)Btg + (size_t)cur.pn * tstepB;
    PG8_STAGE(PG8_SB(0, 0), cB, voffB); PG8_STAGE(PG8_SA(0, 0), cA, voffA); PG8_STAGE(PG8_SB(0, 1), cB + hstepB, voffB); PG8_STAGE(PG8_SA(0, 1), cA + hstepA, voffA);
    if (wr == 1) PG8_BAR;
    PG8_WAIT_V(4); PG8_BAR;
    PG8_STAGE(PG8_SB(1, 0), cB + kstep, voffB); PG8_STAGE(PG8_SA(1, 0), cA + kstep, voffA); PG8_STAGE(PG8_SB(1, 1), cB + hstepB + kstep, voffB);
    PG8_WAIT_V(6); PG8_BAR;
    for (;;) {
        const bool has_next = S.next(ui + 1, nxt);
        const char* nA = has_next ? (const char*)Ag + (size_t)nxt.pm * tstepA : cA; const char* nB = has_next ? (const char*)Btg + (size_t)nxt.pn * tstepB : cB;
        for (int t = 0; t < nt; t += 2) {
            const bool last = (t == nt - 2);
            const char* a1 = cA + (size_t)(t + 1) * kstep;
            const char* a2 = last ? nA : cA + (size_t)(t + 2) * kstep; const char* b2 = last ? nB : cB + (size_t)(t + 2) * kstep;
            const char* a3 = a2 + kstep; const char* b3 = b2 + kstep;
            PG8_LDB(B0, 0, 0); PG8_SCHED; PG8_LDA(At, 0, 0); PG8_STAGE(PG8_SA(1, 1), a1 + hstepA, voffA);
            PG8_WAIT_L(8); PG8_BAR; PG8_WAIT_L(0); PG8_MMA(0, 0, At, B0); PG8_BAR; PG8_SCHED;
            PG8_LDB(B1, 0, 1); PG8_STAGE(PG8_SB(0, 0), b2, voffB);
            PG8_BAR; PG8_WAIT_L(0); PG8_MMA(0, 1, At, B1); PG8_BAR;
            PG8_LDA(At, 0, 1); PG8_STAGE(PG8_SA(0, 0), a2, voffA);
            PG8_BAR; PG8_WAIT_L(0); PG8_MMA(1, 0, At, B0); PG8_BAR; PG8_SCHED;
            PG8_STAGE(PG8_SB(0, 1), b2 + hstepB, voffB);
            PG8_WAIT_V(6); PG8_BAR; PG8_MMA(1, 1, At, B1); PG8_BAR;
            PG8_LDB(B0, 1, 0); PG8_SCHED; PG8_LDA(At, 1, 0); PG8_STAGE(PG8_SA(0, 1), a2 + hstepA, voffA);
            PG8_WAIT_L(8); PG8_BAR; PG8_WAIT_L(0); PG8_MMA(0, 0, At, B0); PG8_BAR; PG8_SCHED;
            PG8_LDB(B1, 1, 1); PG8_STAGE(PG8_SB(1, 0), b3, voffB);
            PG8_BAR; PG8_WAIT_L(0); PG8_MMA(0, 1, At, B1); PG8_BAR;
            PG8_LDA(At, 1, 1); PG8_STAGE(PG8_SA(1, 0), a3, voffA);
            PG8_BAR; PG8_WAIT_L(0); PG8_MMA(1, 0, At, B0); PG8_BAR; PG8_SCHED;
            PG8_STAGE(PG8_SB(1, 1), b3 + hstepB, voffB);
            PG8_WAIT_V(6); PG8_BAR; PG8_MMA(1, 1, At, B1); PG8_BAR;
        }
        E(acc, cur, wr, wc, fr, fq);
        if (!has_next) break;
#pragma unroll
        for (int a = 0; a < 2; ++a)
#pragma unroll
            for (int b = 0; b < 2; ++b)
#pragma unroll
                for (int m = 0; m < 4; ++m)
#pragma unroll
                    for (int n = 0; n < 2; ++n) acc[a][b][m][n] = (f32x4){0.f, 0.f, 0.f, 0.f};
        cur = nxt; cA = nA; cB = nB; ++ui;
    }
    PG8_WAIT_V(0);
    if (wr == 0) PG8_BAR;
    PG8_BAR;
#undef PG8_SA
#undef PG8_SB
#undef PG8_STAGE
#undef PG8_LDA
#undef PG8_LDB
#undef PG8_MMA
#undef PG8_WAIT_V
#undef PG8_WAIT_L
#undef PG8_BAR
#undef PG8_SCHED
}
struct EpiF32 {
    static constexpr bool PERM = false;
    float* C; int ldc;
    __device__ __forceinline__ void operator()(const f32x4 (&acc)[2][2][4][2], const Unit& u, int wr, int wc, int fr, int fq) const {
        const int row0 = u.pm * BM + wr * 64 + fr, col0 = u.pn * BM + wc * 32 + 4 * fq;
#pragma unroll
        for (int ai = 0; ai < 2; ++ai)
#pragma unroll
            for (int m = 0; m < 4; ++m) { float* rowp = C + (size_t)(row0 + ai * HALF + m * 16) * ldc + col0;
#pragma unroll
                for (int bj = 0; bj < 2; ++bj)
#pragma unroll
                    for (int n = 0; n < 2; ++n) *(f32x4*)(rowp + bj * HALF + n * 16) = acc[ai][bj][m][n]; }
    }
};
struct EpiBf16 {
    static constexpr bool PERM = true;
    bf16_t* O; int ldc;
    __device__ __forceinline__ void operator()(const f32x4 (&acc)[2][2][4][2], const Unit& u, int wr, int wc, int fr, int fq) const {
        const int row0 = u.pm * BM + wr * 64 + fr, col0 = u.pn * BM + wc * 32 + 8 * fq;
#pragma unroll
        for (int ai = 0; ai < 2; ++ai)
#pragma unroll
            for (int m = 0; m < 4; ++m) { bf16_t* rowp = O + (size_t)(row0 + ai * HALF + m * 16) * ldc + col0;
#pragma unroll
                for (int bj = 0; bj < 2; ++bj) { const f32x4 v0 = acc[ai][bj][m][0], v1 = acc[ai][bj][m][1];
                    uint4 o; o.x = pack2(v0[0], v0[1]); o.y = pack2(v0[2], v0[3]); o.z = pack2(v1[0], v1[1]); o.w = pack2(v1[2], v1[3]);
                    *(uint4*)(rowp + bj * HALF) = o; } }
    }
};
}

__device__ __forceinline__ void phase0(const Params& p, char* smem) {
    const int tid = tidx(), wave = tid >> 6, lane = tid & 63;
    const int gw = blockIdx.x * 8 + wave, nw = gridDim.x * 8;
    for (int u = gw; u < 1536; u += nw) {
        const int cb = u % 96, ks = u / 96, j = cb * 64 + lane;
        float a0 = 0.f, a1 = 0.f;
        for (int k = ks * 64; k < ks * 64 + 64; ++k) {
            const float w = p.w_mod[(size_t)k * 6144 + j];
            const float c0 = p.c[k], c1 = p.c_ctx[k];
            a0 += c0 * sigm(c0) * w; a1 += c1 * sigm(c1) * w;
        }
        p.modp[(ks * 2 + 0) * 6144 + j] = a0; p.modp[(ks * 2 + 1) * 6144 + j] = a1;
    }
    float* T = (float*)smem;
    int total = 0;
    for (int j = 0; j < NJOB; ++j) total += (p.jobs[j].K >> 6) * (p.jobs[j].N >> 6);
    for (int u = blockIdx.x; u < total; u += gridDim.x) {
        int j = 0, r = u;
        for (;; ++j) { const int n = (p.jobs[j].K >> 6) * (p.jobs[j].N >> 6); if (r < n) break; r -= n; }
        const TJob jb = p.jobs[j];
        const int ntn = jb.N >> 6, kt = r / ntn, nt = r % ntn, k0 = kt * 64, n0 = nt * 64;
        {
            const int kk = tid >> 4, c4 = (tid & 15) * 4;
#pragma unroll
            for (int i = 0; i < 2; ++i) {
                const int k = kk + 32 * i;
                const float4 v = *(const float4*)(jb.src + (size_t)(k0 + k) * jb.N + n0 + c4);
                T[k * 65 + c4 + 0] = v.x; T[k * 65 + c4 + 1] = v.y; T[k * 65 + c4 + 2] = v.z; T[k * 65 + c4 + 3] = v.w;
            }
        }
        __syncthreads();
        {
            const int n = tid >> 3, ks = (tid & 7) * 8;
            float v[8];
#pragma unroll
            for (int q = 0; q < 8; ++q) v[q] = T[(ks + q) * 65 + n];
            const int ng = n0 + n;
            int drow = jb.rowoff + ng;
            if (jb.mode == 2) drow = (ng >> 4) * 32 + (ng & 15) + jb.rowoff;
            uint4 hi; hi.x = pack2(v[0], v[1]); hi.y = pack2(v[2], v[3]); hi.z = pack2(v[4], v[5]); hi.w = pack2(v[6], v[7]);
            bf16_t* d = jb.dst + (size_t)drow * jb.dld + jb.coloff + k0 + ks;
            *(uint4*)d = hi;
            if (jb.mode == 1) {
                float l[8];
#pragma unroll
                for (int q = 0; q < 8; ++q) l[q] = v[q] - bf2f(f2bf(v[q]));
                uint4 lo; lo.x = pack2(l[0], l[1]); lo.y = pack2(l[2], l[3]); lo.z = pack2(l[4], l[5]); lo.w = pack2(l[6], l[7]);
                *(uint4*)(d + 1024) = hi; *(uint4*)(d + 2048) = lo;
            }
        }
        __syncthreads();
    }
}

__device__ __forceinline__ void phase1(const Params& p, char* smem) {
    const int tid = tidx(), wave = tid >> 6, lane = tid & 63;
    float* L = (float*)smem;
    for (int idx = tid; idx < 4096; idx += NT) {
        const int v = idx >> 11, which = (idx >> 10) & 1, col = idx & 1023;
        float s = p.b_mod[which * 1024 + col];
        for (int ks = 0; ks < 16; ++ks) s += p.modp[(ks * 2 + v) * 6144 + which * 1024 + col];
        L[idx] = s;
    }
    if (blockIdx.x == 0) {
        for (int idx = tid; idx < 2 * 6144; idx += NT) {
            const int v = idx / 6144, j = idx % 6144;
            float s = p.b_mod[j];
            for (int ks = 0; ks < 16; ++ks) s += p.modp[(ks * 2 + v) * 6144 + j];
            p.mod[idx] = s;
        }
    }
    __syncthreads();
    const int gw = blockIdx.x * 8 + wave, nw = gridDim.x * 8;
    for (int r = gw; r < TE; r += nw) {
        const int v = r < 256 ? 1 : 0;
        const float* src = r < 256 ? p.ctx + (size_t)r * 1024 : p.x + (size_t)(r - 256) * 1024;
        float4 xv[4]; float ss = 0.f;
#pragma unroll
        for (int i = 0; i < 4; ++i) { xv[i] = *(const float4*)(src + i * 256 + lane * 4); ss += xv[i].x * xv[i].x + xv[i].y * xv[i].y + xv[i].z * xv[i].z + xv[i].w * xv[i].w; }
        ss = wsum(ss);
        const float rs = rsqrtf(ss * (1.f / 1024.f) + 1e-6f);
#pragma unroll
        for (int i = 0; i < 4; ++i) {
            const int col = i * 256 + lane * 4;
            const float4 g = *(const float4*)(p.n_pre_mix + col);
            const float* sh = L + v * 2048 + col; const float* sc = L + v * 2048 + 1024 + col;
            const float y0 = xv[i].x * rs * g.x * (1.f + sc[0]) + sh[0];
            const float y1 = xv[i].y * rs * g.y * (1.f + sc[1]) + sh[1];
            const float y2 = xv[i].z * rs * g.z * (1.f + sc[2]) + sh[2];
            const float y3 = xv[i].w * rs * g.w * (1.f + sc[3]) + sh[3];
            uint2 o; o.x = pack2(y0, y1); o.y = pack2(y2, y3);
            *(uint2*)(p.hn + (size_t)r * 1024 + col) = o;
        }
    }
}

__device__ __forceinline__ void phase2(const Params& p, char* smem) {
    g8::StaticOrder S; S.init(TE, INC, gridDim.x, blockIdx.x);
    g8::EpiBf16 E{p.proj, INC};
    g8::gemm_phase((LAS unsigned char*)smem, p.hn, p.WinT, 1024, 1024, 1024, S, E);
}

__device__ __forceinline__ void phase3(const Params& p, char* smem) {
    const int tid = tidx(), wave = tid >> 6, lane = tid & 63;
    const int gw = blockIdx.x * 8 + wave, nw = gridDim.x * 8;
    float mu0[3][8], mu1[3][8], kkw[8], lm0[4], lm1[4];
#pragma unroll
    for (int a = 0; a < 3; ++a)
#pragma unroll
        for (int q = 0; q < 8; ++q) { mu0[a][q] = p.shift_mu[a * 512 + lane * 8 + q]; mu1[a][q] = p.shift_mu[1792 + a * 512 + lane * 8 + q]; }
#pragma unroll
    for (int q = 0; q < 8; ++q) kkw[q] = p.rwkv_k_k[lane * 8 + q];
#pragma unroll
    for (int q = 0; q < 4; ++q) { lm0[q] = p.shift_mu[1536 + lane * 4 + q]; lm1[q] = p.shift_mu[1792 + 1536 + lane * 4 + q]; }
    for (int t = gw; t < TE; t += nw) {
        const bool hp = (t != 0 && t != 256), hn_ = (t != 255 && t != TE - 1);
        const bf16_t* pr = p.proj + (size_t)t * INC;
        uint4 q0[3], qm[3], qn[3]; uint2 l0, lm = make_uint2(0, 0), ln = make_uint2(0, 0);
#pragma unroll
        for (int a = 0; a < 3; ++a) {
            q0[a] = *(const uint4*)(pr + a * 512 + lane * 8);
            qm[a] = hp ? *(const uint4*)(pr + a * 512 + lane * 8 - INC) : make_uint4(0, 0, 0, 0);
            qn[a] = hn_ ? *(const uint4*)(pr + a * 512 + lane * 8 + INC) : make_uint4(0, 0, 0, 0);
        }
        l0 = *(const uint2*)(pr + 1536 + lane * 4);
        if (hp) lm = *(const uint2*)(pr + 1536 + lane * 4 - INC);
        if (hn_) ln = *(const uint2*)(pr + 1536 + lane * 4 + INC);
        float val[3][8];
#pragma unroll
        for (int a = 0; a < 3; ++a) {
            float f0[8], fm[8], fn[8]; unpack8(q0[a], f0); unpack8(qm[a], fm); unpack8(qn[a], fn);
#pragma unroll
            for (int q = 0; q < 8; ++q) val[a][q] = f0[q] + mu0[a][q] * (fm[q] - f0[q]) + mu1[a][q] * (fn[q] - f0[q]);
        }
        float kkv[8], n2 = 0.f;
#pragma unroll
        for (int q = 0; q < 8; ++q) { kkv[q] = val[1][q] * kkw[q]; n2 += kkv[q] * kkv[q]; }
        n2 += __shfl_xor(n2, 1, 64); n2 += __shfl_xor(n2, 2, 64); n2 += __shfl_xor(n2, 4, 64);
        const float inv = -1.f / fmaxf(sqrtf(n2), 1e-12f);
#pragma unroll
        for (int q = 0; q < 8; ++q) kkv[q] *= inv;
        const size_t o = (size_t)t * 512 + lane * 8;
        *(uint4*)(p.Rr + o) = pack8(val[0]); *(uint4*)(p.Kk + o) = pack8(val[1]); *(uint4*)(p.Vv + o) = pack8(val[2]); *(uint4*)(p.Aa + o) = pack8(kkv);
        {
            float v[4];
            const unsigned w0[2] = {l0.x, l0.y}, wm[2] = {lm.x, lm.y}, wn[2] = {ln.x, ln.y};
#pragma unroll
            for (int q = 0; q < 4; ++q) {
                const float p0 = (q & 1) ? __uint_as_float(w0[q >> 1] & 0xffff0000u) : __uint_as_float(w0[q >> 1] << 16);
                const float pm = (q & 1) ? __uint_as_float(wm[q >> 1] & 0xffff0000u) : __uint_as_float(wm[q >> 1] << 16);
                const float pn = (q & 1) ? __uint_as_float(wn[q >> 1] & 0xffff0000u) : __uint_as_float(wn[q >> 1] << 16);
                v[q] = p0 + lm0[q] * (pm - p0) + lm1[q] * (pn - p0);
            }
            if (lane < 16) {
                uint2 ov; ov.x = pack2(tanhf(v[0]), tanhf(v[1])); ov.y = pack2(tanhf(v[2]), tanhf(v[3]));
                *(uint2*)(p.TW + (size_t)t * 64 + lane * 4) = ov;
            } else if (lane < 32) {
                uint2 ov; ov.x = pack2(v[0], v[1]); ov.y = pack2(v[2], v[3]);
                *(uint2*)(p.XA + (size_t)t * 64 + (lane - 16) * 4) = ov;
            } else {
                uint2 ov; ov.x = pack2(sigm(v[0]), sigm(v[1])); ov.y = pack2(sigm(v[2]), sigm(v[3]));
                *(uint2*)(p.SG + (size_t)t * 128 + (lane - 32) * 4) = ov;
            }
        }
    }
}

__device__ __forceinline__ void phase4(const Params& p, char* smem) {
    for (int u = blockIdx.x; u < 130 * 20; u += gridDim.x) {
        const int mt = u / 20, q = u % 20;
        if (q < 8) {
            APlain ap{p.TW + (size_t)mt * 128 * 64, 64}; BPlain bp{p.WupT + (size_t)q * 128 * 64, 64};
            gemm_tile<128, 128, 4, 2>(ap, bp, 64, smem, [&](const auto& acc, int r0, int c0) {
#pragma unroll
                for (int mi = 0; mi < 2; ++mi)
#pragma unroll
                    for (int ni = 0; ni < 4; ++ni) {
                        const int t = mt * 128 + r0 + mi * 16, cc = q * 128 + c0 + ni * 16, d = cc >> 9, c = cc & 511;
                        float4 o; float* op = (float*)&o;
#pragma unroll
                        for (int j = 0; j < 4; ++j) { const float z = p.rwkv_w0[d * 512 + c + j] + acc[mi][ni][j]; op[j] = __expf(-0.60653066f * sigm(z)); }
                        *(float4*)(p.Wd + ((size_t)d * TE + t) * 512 + c) = o;
                    }
            });
        } else if (q < 16) {
            const int qq = q - 8;
            APlain ap{p.XA + (size_t)mt * 128 * 64, 64}; BPlain bp{p.AupT + (size_t)qq * 128 * 64, 64};
            gemm_tile<128, 128, 4, 2>(ap, bp, 64, smem, [&](const auto& acc, int r0, int c0) {
#pragma unroll
                for (int mi = 0; mi < 2; ++mi)
#pragma unroll
                    for (int ni = 0; ni < 4; ++ni) {
                        const int t = mt * 128 + r0 + mi * 16, cc = qq * 128 + c0 + ni * 16, d = cc >> 9, c = cc & 511;
                        const uint2 av = *(const uint2*)(p.Aa + (size_t)t * 512 + c), kv = *(const uint2*)(p.Kk + (size_t)t * 512 + c);
                        const bf16_t* ae = (const bf16_t*)&av; const bf16_t* ke = (const bf16_t*)&kv;
                        float bo[4], ko[4];
#pragma unroll
                        for (int j = 0; j < 4; ++j) {
                            const float ad = sigm(p.rwkv_a0[d * 512 + c + j] + acc[mi][ni][j]);
                            bo[j] = -bf2f(ae[j]) * ad;
                            ko[j] = bf2f(ke[j]) * (1.f + (ad - 1.f) * p.rwkv_k_a[c + j]);
                        }
                        uint2 o1, o2; o1.x = pack2(bo[0], bo[1]); o1.y = pack2(bo[2], bo[3]); o2.x = pack2(ko[0], ko[1]); o2.y = pack2(ko[2], ko[3]);
                        *(uint2*)(p.Bd + ((size_t)d * TE + t) * 512 + c) = o1;
                        *(uint2*)(p.KD + ((size_t)d * TE + t) * 512 + c) = o2;
                    }
            });
        } else {
            const int qq = q - 16;
            APlain ap{p.SG + (size_t)mt * 128 * 128, 128}; BPlain bp{p.GupT + (size_t)qq * 128 * 128, 128};
            gemm_tile<128, 128, 4, 2>(ap, bp, 128, smem, [&](const auto& acc, int r0, int c0) {
#pragma unroll
                for (int mi = 0; mi < 2; ++mi)
#pragma unroll
                    for (int ni = 0; ni < 4; ++ni) {
                        const int t = mt * 128 + r0 + mi * 16, c = qq * 128 + c0 + ni * 16;
                        uint2 o; o.x = pack2(acc[mi][ni][0], acc[mi][ni][1]); o.y = pack2(acc[mi][ni][2], acc[mi][ni][3]);
                        *(uint2*)(p.G + (size_t)t * 512 + c) = o;
                    }
            });
        }
    }
}

__device__ __forceinline__ void phase5(const Params& p, char* smem) {
    const int tid = tidx(), wave = __builtin_amdgcn_readfirstlane(tid >> 6), lane = tid & 63;
    constexpr int SB = 5, NA = 6, NSB = RL / SB;
    float* L = (float*)smem + wave * (2 * SB * NA * 64);
    for (int q = blockIdx.x * 8 + wave; q < RNC * 16; q += gridDim.x * 8) {
        const int j = q >> 4, hd = q & 15, dir = hd >> 3, h = hd & 7;
        const float* gW = p.Wd + (size_t)dir * TE * 512; const bf16_t* gB = p.Bd + (size_t)dir * TE * 512; const bf16_t* gK = p.KD + (size_t)dir * TE * 512;
        const bf16_t* gA = p.Aa; const bf16_t* gV = p.Vv; const bf16_t* gR = p.Rr;
        const unsigned lofs = (unsigned)(h * 64 + lane);
        float* gZ = p.Zz + (size_t)q * (RL * 64) + lane; float* gY = p.YH + (size_t)q * (RL * 64) + lane;
        f32x2 sP[32], sH[32];
        int ln = lane; asm volatile("" : "+v"(ln));
#pragma unroll
        for (int k = 0; k < 32; ++k) { sP[k] = (f32x2){(2 * k == ln) ? 1.f : 0.f, (2 * k + 1 == ln) ? 1.f : 0.f}; sH[k] = (f32x2){0.f, 0.f}; }
        for (int sb = 0; sb < NSB; ++sb) {
            {
                float st[SB][NA];
#pragma unroll
                for (int i = 0; i < SB; ++i) {
                    const unsigned g = (unsigned)row_of(dir, j * RL + sb * SB + i) * 512u + lofs;
                    st[i][0] = gW[g]; st[i][1] = bf2f(gA[g]); st[i][2] = bf2f(gB[g]); st[i][3] = bf2f(gK[g]); st[i][4] = bf2f(gV[g]); st[i][5] = bf2f(gR[g]);
                }
                float* d = L + (sb & 1) * (SB * NA * 64) + lane;
#pragma unroll
                for (int i = 0; i < SB; ++i)
#pragma unroll
                    for (int a = 0; a < NA; ++a) d[(i * NA + a) * 64] = st[i][a];
            }
            const float* Lb = L + (sb & 1) * (SB * NA * 64);
#pragma unroll 1
            for (int i = 0; i < SB; ++i) {
                const float* W = Lb + (i * NA) * 64; const float* A = W + 64; const float* B = W + 128; const float* KDv = W + 192; const float* R = W + 320;
                const float vl = W[256 + lane];
                f32x2 dh0 = {0.f, 0.f}, dh1 = {0.f, 0.f}, dp0 = {0.f, 0.f}, dp1 = {0.f, 0.f};
                f32x4 ac0 = *(const f32x4*)(A), ac1 = *(const f32x4*)(A + 4), ac2 = *(const f32x4*)(A + 8), ac3 = *(const f32x4*)(A + 12);
                f32x4 rw[3], rb[3], rk[3], rr[3];
                rw[0] = *(const f32x4*)(W); rb[0] = *(const f32x4*)(B); rk[0] = *(const f32x4*)(KDv); rr[0] = *(const f32x4*)(R);
                rw[1] = *(const f32x4*)(W + 4); rb[1] = *(const f32x4*)(B + 4); rk[1] = *(const f32x4*)(KDv + 4); rr[1] = *(const f32x4*)(R + 4);
#pragma unroll
                for (int c = 0; c < 4; ++c) {
                    f32x4 an0 = ac0, an1 = ac1, an2 = ac2, an3 = ac3;
                    if (c < 3) { an0 = *(const f32x4*)(A + c * 16 + 16); an1 = *(const f32x4*)(A + c * 16 + 20); an2 = *(const f32x4*)(A + c * 16 + 24); an3 = *(const f32x4*)(A + c * 16 + 28); }
                    const int k = c * 8;
                    dh0 += sH[k] * ac0.lo; dh1 += sH[k + 1] * ac0.hi; dp0 += sP[k] * ac0.lo; dp1 += sP[k + 1] * ac0.hi;
                    dh0 += sH[k + 2] * ac1.lo; dh1 += sH[k + 3] * ac1.hi; dp0 += sP[k + 2] * ac1.lo; dp1 += sP[k + 3] * ac1.hi;
                    dh0 += sH[k + 4] * ac2.lo; dh1 += sH[k + 5] * ac2.hi; dp0 += sP[k + 4] * ac2.lo; dp1 += sP[k + 5] * ac2.hi;
                    dh0 += sH[k + 6] * ac3.lo; dh1 += sH[k + 7] * ac3.hi; dp0 += sP[k + 6] * ac3.lo; dp1 += sP[k + 7] * ac3.hi;
                    __builtin_amdgcn_sched_barrier(0);
                    ac0 = an0; ac1 = an1; ac2 = an2; ac3 = an3;
                }
                const float saHs = (dh0.x + dh0.y) + (dh1.x + dh1.y), saPs = (dp0.x + dp0.y) + (dp1.x + dp1.y);
                const f32x2 saH = {saHs, saHs}, saP = {saPs, saPs}, vl2 = {vl, vl};
                f32x2 y0 = {0.f, 0.f}, y1 = {0.f, 0.f}, z0 = {0.f, 0.f}, z1 = {0.f, 0.f};
#pragma unroll
                for (int g = 0; g < 16; ++g) {
                    if (g + 2 < 16) { rw[(g + 2) % 3] = *(const f32x4*)(W + 4 * g + 8); rb[(g + 2) % 3] = *(const f32x4*)(B + 4 * g + 8); rk[(g + 2) % 3] = *(const f32x4*)(KDv + 4 * g + 8); rr[(g + 2) % 3] = *(const f32x4*)(R + 4 * g + 8); }
                    const f32x4 cw = rw[g % 3], cb = rb[g % 3], ck = rk[g % 3], cr = rr[g % 3];
                    const int k = 2 * g;
                    sH[k]     = sH[k]     * cw.lo + (saH * cb.lo + vl2 * ck.lo);
                    sH[k + 1] = sH[k + 1] * cw.hi + (saH * cb.hi + vl2 * ck.hi);
                    sP[k]     = sP[k]     * cw.lo + saP * cb.lo;
                    sP[k + 1] = sP[k + 1] * cw.hi + saP * cb.hi;
                    y0 += sH[k] * cr.lo; y1 += sH[k + 1] * cr.hi;
                    z0 += sP[k] * cr.lo; z1 += sP[k + 1] * cr.hi;
                    __builtin_amdgcn_sched_barrier(0);
                }
                const int t = sb * SB + i;
                gZ[t * 64] = (z0.x + z0.y) + (z1.x + z1.y); gY[t * 64] = (y0.x + y0.y) + (y1.x + y1.y);
            }
        }
        if (j < RNC - 1) {
            float* dP = p.PH + (((size_t)(j * 16 + hd) * 2 + 0) * 64 + lane) * 64;
            float* dH = p.PH + (((size_t)(j * 16 + hd) * 2 + 1) * 64 + lane) * 64;
#pragma unroll
            for (int k = 0; k < 32; k += 2) { *(float4*)(dP + 2 * k) = make_float4(sP[k].x, sP[k].y, sP[k + 1].x, sP[k + 1].y); *(float4*)(dH + 2 * k) = make_float4(sH[k].x, sH[k].y, sH[k + 1].x, sH[k + 1].y); }
        }
    }
}

__device__ __forceinline__ void phase6(const Params& p, char* smem) {
    const int tid = threadIdx.x, wave = __builtin_amdgcn_readfirstlane(tid >> 6), lane = tid & 63;
    if (blockIdx.x >= 256) return;
    const int hd = blockIdx.x >> 4, rb0 = (blockIdx.x & 15) * 4, r0 = rb0 + (wave & 3);
    LAS unsigned char* lds = (LAS unsigned char*)smem;
    constexpr int SLOT = 17408, NJ = RNC - 1;
    const char* pbase = (const char*)(p.PH + (size_t)hd * 2 * 4096);
    float s0 = 0.f;
#define CH_ISSUE(J) do { const char* src_ = pbase + (size_t)(J) * 524288; const unsigned so_ = (unsigned)(((J) & 7) * SLOT); \
        _Pragma("unroll") for (int q_ = 0; q_ < 4; ++q_) __builtin_amdgcn_global_load_lds((const unsigned*)(src_ + ((wave - 4) * 4 + q_) * 1024 + lane * 16), (LAS unsigned*)(lds + so_ + ((wave - 4) * 4 + q_) * 1024), 16, 0, 0); \
        if (wave == 7) __builtin_amdgcn_global_load_lds((const unsigned*)(src_ + 16384 + rb0 * 256 + lane * 16), (LAS unsigned*)(lds + so_ + 16384), 16, 0, 0); } while (0)
    if (wave >= 4) { CH_ISSUE(0); CH_ISSUE(1); CH_ISSUE(2); CH_ISSUE(3); CH_ISSUE(4); CH_ISSUE(5); CH_ISSUE(6); }
    for (int j = 0; j < RNC; ++j) {
        if (wave < 4) p.Sst[((size_t)(j * 16 + hd) * 64 + r0) * 64 + lane] = s0;
        if (j == NJ) break;
        if (wave >= 4) {
            if (j + 6 >= NJ) asm volatile("s_waitcnt vmcnt(0)" ::: "memory");
            else if (wave == 7) asm volatile("s_waitcnt vmcnt(30)" ::: "memory");
            else asm volatile("s_waitcnt vmcnt(24)" ::: "memory");
        }
        asm volatile("s_waitcnt lgkmcnt(0)" ::: "memory"); __builtin_amdgcn_s_barrier(); asm volatile("" ::: "memory");
        if (wave >= 4) { if (j + 7 < NJ) CH_ISSUE(j + 7); }
        else {
            const float* Pc = (const float*)(smem + (j & 7) * SLOT);
            f32x2 n0 = {Pc[4096 + wave * 64 + lane], 0.f}, n1 = {0.f, 0.f};
#pragma unroll
            for (int k = 0; k < 64; k += 4) {
                const f32x2 a0 = {__int_as_float(__builtin_amdgcn_readlane(__float_as_int(s0), k)), __int_as_float(__builtin_amdgcn_readlane(__float_as_int(s0), k + 1))};
                const f32x2 a1 = {__int_as_float(__builtin_amdgcn_readlane(__float_as_int(s0), k + 2)), __int_as_float(__builtin_amdgcn_readlane(__float_as_int(s0), k + 3))};
                const f32x2 p0 = {Pc[k * 64 + lane], Pc[(k + 1) * 64 + lane]}, p1 = {Pc[(k + 2) * 64 + lane], Pc[(k + 3) * 64 + lane]};
                n0 += a0 * p0; n1 += a1 * p1;
            }
            s0 = (n0.x + n0.y) + (n1.x + n1.y);
        }
    }
#undef CH_ISSUE
    __syncthreads();
}

__device__ __forceinline__ void phase7(const Params& p, char* smem) {
    const int tid = tidx(), wave = __builtin_amdgcn_readfirstlane(tid >> 6), lane = tid & 63;
    constexpr int SB = 10, NSB = RL / SB;
    float* L = (float*)smem + wave * (SB * 64);
    for (int q = 16 + blockIdx.x * 8 + wave; q < RNC * 16; q += gridDim.x * 8) {
        const int j = q >> 4, hd = q & 15, dir = hd >> 3, h = hd & 7;
        f32x2 s[32];
        {
            const float* src = p.Sst + ((size_t)(j * 16 + hd) * 64 + lane) * 64;
#pragma unroll
            for (int k = 0; k < 32; k += 2) { const f32x4 v = *(const f32x4*)(src + 2 * k); s[k] = v.lo; s[k + 1] = v.hi; }
        }
        const float* gZ = p.Zz + (size_t)q * (RL * 64) + lane; const float* gY = p.YH + (size_t)q * (RL * 64) + lane;
        bf16_t* gO = p.O + (size_t)dir * TX * 512 + h * 64 + lane;
        for (int sb = 0; sb < NSB; ++sb) {
            float zz[SB], yy[SB];
#pragma unroll
            for (int i = 0; i < SB; ++i) { zz[i] = gZ[(sb * SB + i) * 64]; yy[i] = gY[(sb * SB + i) * 64]; }
#pragma unroll
            for (int i = 0; i < SB; ++i) L[i * 64 + lane] = zz[i];
#pragma unroll
            for (int i = 0; i < SB; ++i) {
                const float* Z = L + i * 64;
                f32x2 y0 = {yy[i], 0.f}, y1 = {0.f, 0.f};
#pragma unroll
                for (int k = 0; k < 32; k += 2) { const f32x4 z = *(const f32x4*)(Z + 2 * k); y0 += s[k] * z.lo; y1 += s[k + 1] * z.hi; }
                const int row = row_of(dir, j * RL + sb * SB + i);
                if (row >= 256) gO[(size_t)(row - 256) * 512] = f2bf((y0.x + y0.y) + (y1.x + y1.y));
            }
        }
    }
}

__device__ __forceinline__ void phase8(const Params& p, char* smem) {
    const int tid = tidx();
    bf16_t* LT = (bf16_t*)smem;
    constexpr int LTS = 136;
    for (int u = blockIdx.x; u < NCH * 4; u += gridDim.x) {
        const int upart = 2;
        const int c = u >> 2, hh = u & 3;
        const float g0 = sigm(p.ret_decay_logit[hh]), g1 = sigm(p.ret_decay_logit[4 + hh]);
        const float l0 = log2f(g0), l1 = log2f(g1);
        const int n = tid >> 2, part = tid & 3, half = part >> 1, fb = (part & 1) * 16;
        const int t = c * 128 + n;
        const bool lat = c >= 2;
        float pos = 0.f;
        if (lat) { const int tl = t - 256; pos = (float)(half == 0 ? (tl >> 6) : (tl & 63)); }
        const bf16_t* pr = p.proj + (size_t)t * INC;
        float cs[16], sn[16];
#pragma unroll
        for (int f = 0; f < 16; ++f) {
            if (lat) { const float inv = exp2f(-(float)(fb + f) * (13.287712379549449f / 32.f)); sincosf(pos * inv, &sn[f], &cs[f]); }
            else { cs[f] = 1.f; sn[f] = 0.f; }
        }
        const size_t ch = (size_t)(c * 4 + hh);
        if (upart != 1) {
            const int cb = 1792 + hh * 128 + half * 64 + fb;
            uint4 v1a = *(const uint4*)(pr + cb), v1b = *(const uint4*)(pr + cb + 8), v2a = *(const uint4*)(pr + cb + 32), v2b = *(const uint4*)(pr + cb + 40);
            bf16_t x1[16], x2[16];
            *(uint4*)&x1[0] = v1a; *(uint4*)&x1[8] = v1b; *(uint4*)&x2[0] = v2a; *(uint4*)&x2[8] = v2b;
            float o1[16], o2[16];
#pragma unroll
            for (int f = 0; f < 16; ++f) { const float a = bf2f(x1[f]), b = bf2f(x2[f]); o1[f] = a * cs[f] - b * sn[f]; o2[f] = a * sn[f] + b * cs[f]; }
            const float xf = exp2f(l0 * (float)(n + 1)), xb = exp2f(l1 * (float)(128 - n));
            bf16_t* qd = p.Qr + (ch * 128 + n) * 128 + half * 64 + fb;
            bf16_t* ad = p.A3 + (ch * 128 + n) * 384 + 128 + half * 64 + fb;
#pragma unroll
            for (int f = 0; f < 16; f += 2) {
                *(unsigned*)(qd + f) = pack2(o1[f], o1[f + 1]); *(unsigned*)(qd + 32 + f) = pack2(o2[f], o2[f + 1]);
                *(unsigned*)(ad + f) = pack2(o1[f] * xf, o1[f + 1] * xf); *(unsigned*)(ad + 32 + f) = pack2(o2[f] * xf, o2[f + 1] * xf);
                *(unsigned*)(ad + 128 + f) = pack2(o1[f] * xb, o1[f + 1] * xb); *(unsigned*)(ad + 128 + 32 + f) = pack2(o2[f] * xb, o2[f + 1] * xb);
            }
        }
        if (upart != 1) {
            const int cb = 2304 + hh * 128 + half * 64 + fb;
            uint4 v1a = *(const uint4*)(pr + cb), v1b = *(const uint4*)(pr + cb + 8), v2a = *(const uint4*)(pr + cb + 32), v2b = *(const uint4*)(pr + cb + 40);
            bf16_t x1[16], x2[16];
            *(uint4*)&x1[0] = v1a; *(uint4*)&x1[8] = v1b; *(uint4*)&x2[0] = v2a; *(uint4*)&x2[8] = v2b;
            const float sc = 0.08838834764831845f;
            bf16_t* kd = p.Kr + (ch * 128 + n) * 128 + half * 64 + fb;
            __syncthreads();
#pragma unroll
            for (int f = 0; f < 16; ++f) {
                const float a = bf2f(x1[f]) * sc, b = bf2f(x2[f]) * sc;
                const float o1 = a * cs[f] - b * sn[f], o2 = a * sn[f] + b * cs[f];
                const bf16_t h1 = f2bf(o1), h2 = f2bf(o2);
                kd[f] = h1; kd[32 + f] = h2;
                LT[(half * 64 + fb + f) * LTS + n] = h1; LT[(half * 64 + fb + f + 32) * LTS + n] = h2;
            }
            __syncthreads();
            const int d = tid >> 2, ms = (tid & 3) * 32;
#pragma unroll
            for (int dir = 0; dir < 2; ++dir) {
                bf16_t* od = p.KTz + ((ch * 2 + dir) * 128 + d) * 128 + ms;
#pragma unroll
                for (int m = 0; m < 32; m += 2) {
                    const int mm = ms + m;
                    const float z0 = dir == 0 ? exp2f(l0 * (float)(127 - mm)) : exp2f(l1 * (float)mm);
                    const float z1 = dir == 0 ? exp2f(l0 * (float)(126 - mm)) : exp2f(l1 * (float)(mm + 1));
                    *(unsigned*)(od + m) = pack2(bf2f(LT[d * LTS + mm]) * z0, bf2f(LT[d * LTS + mm + 1]) * z1);
                }
            }
        }
#pragma unroll 1
        for (int eh = (upart != 0 ? 0 : 2); eh < 2; ++eh) {
            __syncthreads();
            const int cb = 2816 + hh * 256 + eh * 128 + part * 32;
            bf16_t xv[32];
#pragma unroll
            for (int q = 0; q < 4; ++q) *(uint4*)&xv[q * 8] = *(const uint4*)(pr + cb + q * 8);
#pragma unroll
            for (int f = 0; f < 32; ++f) LT[(part * 32 + f) * LTS + n] = xv[f];
            __syncthreads();
            const int e = tid >> 2, ms = (tid & 3) * 32;
            bf16_t* od = p.B3 + (ch * 256 + eh * 128 + e) * 384 + ms;
#pragma unroll
            for (int m = 0; m < 32; m += 8) *(uint4*)(od + m) = *(const uint4*)(LT + e * LTS + ms + m);
        }
        __syncthreads();
    }
}

__device__ __forceinline__ void phase9(const Params& p, char* smem) {
    for (int u = blockIdx.x; u < 512 + 2080; u += gridDim.x) {
        if (u < 512) {
            const int c = 2 + (u >> 2), hh = u & 3;
            const size_t ch = (size_t)(c * 4 + hh);
            const float l0 = log2f(sigm(p.ret_decay_logit[hh])), l1 = log2f(sigm(p.ret_decay_logit[4 + hh]));
            APlain ap{p.Qr + ch * 128 * 128, 128}; BPlain bp{p.Kr + ch * 128 * 128, 128};
            bf16_t* outp = p.A3 + ch * 128 * 384;
            gemm_tile<128, 128, 4, 2>(ap, bp, 128, smem, [&](const auto& acc, int r0, int c0) {
#pragma unroll
                for (int mi = 0; mi < 2; ++mi)
#pragma unroll
                    for (int ni = 0; ni < 4; ++ni) {
                        const int n = r0 + mi * 16, m0 = c0 + ni * 16;
                        float o[4];
#pragma unroll
                        for (int j = 0; j < 4; ++j) {
                            const int m = m0 + j;
                            float w = 0.f;
                            if (n >= m) w += exp2f(l0 * (float)(n - m));
                            if (m >= n) w += exp2f(l1 * (float)(m - n));
                            o[j] = acc[mi][ni][j] * w;
                        }
                        uint2 ov; ov.x = pack2(o[0], o[1]); ov.y = pack2(o[2], o[3]);
                        *(uint2*)(outp + (size_t)n * 384 + m0) = ov;
                    }
            });
        } else {
            const int v = u - 512, mt = v & 1, dir = (v >> 1) & 1, chh = v >> 2;
            APlain ap{p.B3 + ((size_t)chh * 256 + mt * 128) * 384, 384}; BPlain bp{p.KTz + ((size_t)chh * 2 + dir) * 128 * 128, 128};
            float* outp = p.KVT + (((size_t)chh * 2 + dir) * 256 + mt * 128) * 128;
            gemm_tile<128, 128, 4, 2>(ap, bp, 128, smem, [&](const auto& acc, int r0, int c0) {
#pragma unroll
                for (int mi = 0; mi < 2; ++mi)
#pragma unroll
                    for (int ni = 0; ni < 4; ++ni) *(f32x4*)(outp + (size_t)(r0 + mi * 16) * 128 + c0 + ni * 16) = acc[mi][ni];
            });
        }
    }
}

__device__ __forceinline__ void phase10(const Params& p, char* smem) {
    for (int idx = blockIdx.x * NT + tidx(); idx < 131072; idx += gridDim.x * NT) {
        const int hh = idx >> 15, dir = (idx >> 14) & 1, e = (idx >> 6) & 255, d = (idx & 63) * 2;
        const float g = sigm(p.ret_decay_logit[dir * 4 + hh]);
        const float g128 = exp2f(128.f * log2f(g));
        float R0 = 0.f, R1 = 0.f;
        const float* kvb = p.KVT + ((size_t)(hh * 2 + dir) * 256 + e) * 128 + d;
        bf16_t* rtb = p.B3 + ((size_t)hh * 256 + e) * 384 + 128 + dir * 128 + d;
        for (int s0 = 0; s0 < NCH; s0 += 13) {
            float2 kv[13];
#pragma unroll
            for (int i = 0; i < 13; ++i) { const int sc = s0 + i, c = dir == 0 ? sc : (sc < 2 ? 1 - sc : 131 - sc); kv[i] = *(const float2*)(kvb + (size_t)c * 262144); }
#pragma unroll
            for (int i = 0; i < 13; ++i) {
                const int sc = s0 + i, c = dir == 0 ? sc : (sc < 2 ? 1 - sc : 131 - sc);
                if (c >= 2) *(unsigned*)(rtb + (size_t)c * 393216) = pack2(R0, R1);
                R0 = g128 * R0 + kv[i].x; R1 = g128 * R1 + kv[i].y;
            }
        }
    }
}

__device__ __forceinline__ void phase11(const Params& p, char* smem) {
    for (int u = blockIdx.x; u < 1024; u += gridDim.x) {
        const int nt = u & 1, chh = 8 + (u >> 1), c = chh >> 2, hh = chh & 3;
        APlain ap{p.A3 + (size_t)chh * 128 * 384, 384}; BPlain bp{p.B3 + ((size_t)chh * 256 + nt * 128) * 384, 384};
        float* outp = p.Y + (size_t)((c - 2) * 128) * 1024 + hh * 256 + nt * 128;
        gemm_tile<128, 128, 4, 2>(ap, bp, 384, smem, [&](const auto& acc, int r0, int c0) {
#pragma unroll
            for (int mi = 0; mi < 2; ++mi)
#pragma unroll
                for (int ni = 0; ni < 4; ++ni) *(f32x4*)(outp + (size_t)(r0 + mi * 16) * 1024 + c0 + ni * 16) = acc[mi][ni];
        });
    }
}

__device__ __forceinline__ void phase12(const Params& p, char* smem) {
    const int tid = tidx(), wave = tid >> 6, lane = tid & 63;
    const int gw = blockIdx.x * 8 + wave, nw = gridDim.x * 8;
    float lw[8], lb[8], rk[8];
#pragma unroll
    for (int q = 0; q < 8; ++q) { lw[q] = p.rwkv_ln_w[lane * 8 + q]; lb[q] = p.rwkv_ln_b[lane * 8 + q]; rk[q] = p.rwkv_r_k[lane * 8 + q]; }
    for (int t = gw; t < TX; t += nw) {
        const size_t te = (size_t)(t + 256) * 512 + lane * 8;
        const uint4 uof = *(const uint4*)(p.O + (size_t)t * 512 + lane * 8), uob = *(const uint4*)(p.O + ((size_t)TX + t) * 512 + lane * 8);
        const uint4 ur = *(const uint4*)(p.Rr + te), uk0 = *(const uint4*)(p.KD + te), uk1 = *(const uint4*)(p.KD + (size_t)TE * 512 + te), uv = *(const uint4*)(p.Vv + te), ug = *(const uint4*)(p.G + te);
        const float* yp = p.Y + (size_t)t * 1024 + lane * 16;
        const float4 y0 = *(const float4*)(yp), y1 = *(const float4*)(yp + 4), y2 = *(const float4*)(yp + 8), y3 = *(const float4*)(yp + 12);
        const bf16_t* gbp = p.proj + (size_t)(t + 256) * INC + 3840 + lane * 16;
        const uint4 ugb0 = *(const uint4*)(gbp), ugb1 = *(const uint4*)(gbp + 8);
        {
            float of[8], ob[8], r[8], k0[8], k1[8], v[8], gg[8], o[8];
            unpack8(uof, of); unpack8(uob, ob); unpack8(ur, r); unpack8(uk0, k0); unpack8(uk1, k1); unpack8(uv, v); unpack8(ug, gg);
            float sm = 0.f, bs = 0.f;
#pragma unroll
            for (int q = 0; q < 8; ++q) { o[q] = of[q] + ob[q]; sm += o[q]; bs += r[q] * (k0[q] + k1[q]) * rk[q]; }
            sm += __shfl_xor(sm, 1, 64); sm += __shfl_xor(sm, 2, 64); sm += __shfl_xor(sm, 4, 64);
            bs += __shfl_xor(bs, 1, 64); bs += __shfl_xor(bs, 2, 64); bs += __shfl_xor(bs, 4, 64);
            const float mu = sm * (1.f / 64.f);
            float vs = 0.f;
#pragma unroll
            for (int q = 0; q < 8; ++q) { o[q] -= mu; vs += o[q] * o[q]; }
            vs += __shfl_xor(vs, 1, 64); vs += __shfl_xor(vs, 2, 64); vs += __shfl_xor(vs, 4, 64);
            const float rs = rsqrtf(vs * (1.f / 64.f) + 64e-5f);
            float ya[8];
#pragma unroll
            for (int q = 0; q < 8; ++q) ya[q] = (o[q] * rs * lw[q] + lb[q] + bs * v[q]) * gg[q];
            *(uint4*)(p.ya_in + (size_t)t * 512 + lane * 8) = pack8(ya);
        }
        {
            float y[16] = {y0.x, y0.y, y0.z, y0.w, y1.x, y1.y, y1.z, y1.w, y2.x, y2.y, y2.z, y2.w, y3.x, y3.y, y3.z, y3.w};
            float sm = 0.f;
#pragma unroll
            for (int q = 0; q < 16; ++q) sm += y[q];
            sm += __shfl_xor(sm, 1, 64); sm += __shfl_xor(sm, 2, 64); sm += __shfl_xor(sm, 4, 64); sm += __shfl_xor(sm, 8, 64);
            const float mu = sm * (1.f / 256.f);
            float vs = 0.f;
#pragma unroll
            for (int q = 0; q < 16; ++q) { y[q] -= mu; vs += y[q] * y[q]; }
            vs += __shfl_xor(vs, 1, 64); vs += __shfl_xor(vs, 2, 64); vs += __shfl_xor(vs, 4, 64); vs += __shfl_xor(vs, 8, 64);
            const float rs = rsqrtf(vs * (1.f / 256.f) + 1e-5f);
            float gb[16]; { float t0[8], t1[8]; unpack8(ugb0, t0); unpack8(ugb1, t1);
#pragma unroll
                for (int q = 0; q < 8; ++q) { gb[q] = t0[q]; gb[8 + q] = t1[q]; } }
            float o0[8], o1[8];
#pragma unroll
            for (int q = 0; q < 16; ++q) {
                const int c = lane * 16 + q;
                const float ov = (y[q] * rs * p.ret_ln_w[c] + p.ret_ln_b[c]) * (gb[q] * sigm(gb[q]));
                if (q < 8) o0[q] = ov; else o1[q - 8] = ov;
            }
            bf16_t* d = p.yb_in + (size_t)t * 1024 + lane * 16;
            *(uint4*)d = pack8(o0); *(uint4*)(d + 8) = pack8(o1);
        }
    }
}

__device__ __forceinline__ void phase13(const Params& p, char* smem) {
    for (int u = blockIdx.x; u < 512; u += gridDim.x) {
        const int mt = u >> 2, nt = u & 3;
        f32x4 acca[4][4], accb[4][4];
#pragma unroll
        for (int mi = 0; mi < 4; ++mi)
#pragma unroll
            for (int ni = 0; ni < 4; ++ni) { acca[mi][ni] = (f32x4){0.f, 0.f, 0.f, 0.f}; accb[mi][ni] = (f32x4){0.f, 0.f, 0.f, 0.f}; }
        { APlain ap{p.ya_in + (size_t)mt * 128 * 512, 512}; BPlain bp{p.WaT + (size_t)nt * 256 * 512, 512};
          gemm_core<128, 256, 2, 4>(acca, ap, bp, 512, smem); }
        { APlain ap{p.yb_in + (size_t)mt * 128 * 1024, 1024}; BPlain bp{p.WbT + (size_t)nt * 256 * 1024, 1024};
          gemm_core<128, 256, 2, 4>(accb, ap, bp, 1024, smem); }
        const int wave = tidx() >> 6, lane = tidx() & 63;
        const int r0 = (wave >> 2) * 64 + (lane & 15), c0 = (wave & 3) * 64 + (lane >> 4) * 4;
#pragma unroll
        for (int mi = 0; mi < 4; ++mi)
#pragma unroll
            for (int ni = 0; ni < 4; ++ni) {
                const int t = mt * 128 + r0 + mi * 16, c = nt * 256 + c0 + ni * 16;
                const bf16_t* gp = p.proj + (size_t)(t + 256) * INC + c;
                const uint2 ga = *(const uint2*)(gp + 4864), gb = *(const uint2*)(gp + 5888);
                float o[4];
                o[0] = sigm(__uint_as_float(ga.x << 16)) * acca[mi][ni][0] + sigm(__uint_as_float(gb.x << 16)) * accb[mi][ni][0];
                o[1] = sigm(__uint_as_float(ga.x & 0xffff0000u)) * acca[mi][ni][1] + sigm(__uint_as_float(gb.x & 0xffff0000u)) * accb[mi][ni][1];
                o[2] = sigm(__uint_as_float(ga.y << 16)) * acca[mi][ni][2] + sigm(__uint_as_float(gb.y << 16)) * accb[mi][ni][2];
                o[3] = sigm(__uint_as_float(ga.y & 0xffff0000u)) * acca[mi][ni][3] + sigm(__uint_as_float(gb.y & 0xffff0000u)) * accb[mi][ni][3];
                uint2 ov; ov.x = pack2(o[0], o[1]); ov.y = pack2(o[2], o[3]);
                *(uint2*)(p.merged + (size_t)t * 1024 + c) = ov;
            }
    }
}
__device__ __forceinline__ void phase14(const Params& p, char* smem) {
    g8::StaticOrder S; S.init(TX, 1024, gridDim.x, blockIdx.x);
    g8::EpiF32 E{p.mix, 1024};
    g8::gemm_phase((LAS unsigned char*)smem, p.merged, p.WoT, 1024, 1024, 1024, S, E);
}

__device__ __forceinline__ void phase15(const Params& p, char* smem) {
    const int tid = tidx(), wave = tid >> 6, lane = tid & 63;
    const int gw = blockIdx.x * 8 + wave, nw = gridDim.x * 8;
    const float* g1 = p.mod + 2048; const float* sh2 = p.mod + 3072; const float* sc2 = p.mod + 4096;
    for (int t = gw; t < TX; t += nw) {
        float4 mv[4], xm[4]; float ss = 0.f;
#pragma unroll
        for (int i = 0; i < 4; ++i) { mv[i] = *(const float4*)(p.mix + (size_t)t * 1024 + i * 256 + lane * 4); ss += mv[i].x * mv[i].x + mv[i].y * mv[i].y + mv[i].z * mv[i].z + mv[i].w * mv[i].w; }
        ss = wsum(ss);
        const float rs = rsqrtf(ss * (1.f / 1024.f) + 1e-6f);
        float s2 = 0.f;
#pragma unroll
        for (int i = 0; i < 4; ++i) {
            const int col = i * 256 + lane * 4;
            const float4 xv = *(const float4*)(p.x + (size_t)t * 1024 + col);
            const float4 gn = *(const float4*)(p.n_post_mix + col), gg = *(const float4*)(g1 + col);
            xm[i].x = xv.x + gg.x * (mv[i].x * rs * gn.x); xm[i].y = xv.y + gg.y * (mv[i].y * rs * gn.y);
            xm[i].z = xv.z + gg.z * (mv[i].z * rs * gn.z); xm[i].w = xv.w + gg.w * (mv[i].w * rs * gn.w);
            *(float4*)(p.x_mid + (size_t)t * 1024 + col) = xm[i];
            s2 += xm[i].x * xm[i].x + xm[i].y * xm[i].y + xm[i].z * xm[i].z + xm[i].w * xm[i].w;
        }
        s2 = wsum(s2);
        const float rs2 = rsqrtf(s2 * (1.f / 1024.f) + 1e-6f);
#pragma unroll
        for (int i = 0; i < 4; ++i) {
            const int col = i * 256 + lane * 4;
            const float4 gn = *(const float4*)(p.n_pre_ffn + col), sc = *(const float4*)(sc2 + col), sh = *(const float4*)(sh2 + col);
            float h[4];
            h[0] = xm[i].x * rs2 * gn.x * (1.f + sc.x) + sh.x; h[1] = xm[i].y * rs2 * gn.y * (1.f + sc.y) + sh.y;
            h[2] = xm[i].z * rs2 * gn.z * (1.f + sc.z) + sh.z; h[3] = xm[i].w * rs2 * gn.w * (1.f + sc.w) + sh.w;
            uint2 hi; hi.x = pack2(h[0], h[1]); hi.y = pack2(h[2], h[3]);
            *(uint2*)(p.Ahl + (size_t)t * 1024 + col) = hi;
        }
    }
}

__device__ __forceinline__ void phase16(const Params& p, char* smem) {
    for (int u = blockIdx.x; u < 256; u += gridDim.x) {
        const int mt = u >> 1, nt = u & 1;
        APlain ap{p.Ahl + (size_t)mt * 128 * 1024, 1024}; BPlain bp{p.RtT + (size_t)nt * 128 * 1024, 1024};
        float* outp = p.logits + (size_t)mt * 128 * 256 + nt * 128;
        gemm_tile<128, 128, 4, 2>(ap, bp, 1024, smem, [&](const auto& acc, int r0, int c0) {
#pragma unroll
            for (int mi = 0; mi < 2; ++mi)
#pragma unroll
                for (int ni = 0; ni < 4; ++ni) *(f32x4*)(outp + (size_t)(r0 + mi * 16) * 256 + c0 + ni * 16) = acc[mi][ni];
        });
    }
}

__device__ __forceinline__ void phase17(const Params& p, char* smem) {
    const int tid = tidx(), wave = tid >> 6, lane = tid & 63;
    const int gw = blockIdx.x * 8 + wave, nw = gridDim.x * 8;
    for (int t = gw; t < TX; t += nw) {
        float sc[4], key[4];
#pragma unroll
        for (int i = 0; i < 4; ++i) { const int e = lane + 64 * i; sc[i] = sigm(p.logits[(size_t)t * 256 + e]); key[i] = sc[i] + p.router_bias[e]; }
        float mys = 0.f; int mye = 0; float ssum = 0.f;
#pragma unroll 1
        for (int k = 0; k < 8; ++k) {
            float bv = -1e30f; int be = 1 << 20;
#pragma unroll
            for (int i = 0; i < 4; ++i) if (key[i] > bv) { bv = key[i]; be = lane + 64 * i; }
#pragma unroll
            for (int o = 32; o; o >>= 1) {
                const float ov = __shfl_xor(bv, o, 64); const int oe = __shfl_xor(be, o, 64);
                if (ov > bv || (ov == bv && oe < be)) { bv = ov; be = oe; }
            }
            float sv = 0.f;
            if ((be & 63) == lane) {
#pragma unroll
                for (int i = 0; i < 4; ++i) if ((be >> 6) == i) { sv = sc[i]; key[i] = -1e30f; }
            }
            sv = __shfl(sv, be & 63, 64);
            ssum += sv;
            if (lane == k) { mys = sv; mye = be; }
        }
        if (lane < 8) {
            const int pos = atomicAdd(&p.cnt[mye], 1);
            p.tok_e[t * 8 + lane] = mye; p.tok_pos[t * 8 + lane] = pos; p.tok_w[t * 8 + lane] = mys / ssum * 2.5f;
        }
    }
}

__device__ __forceinline__ void phase18(const Params& p, char* smem) {
    const int tid = tidx();
    int* ps = (int*)smem;
    int* xs = ps + 260;
    if (tid < 64) {
        int c[4], tot = 0, ttot = 0;
#pragma unroll
        for (int q = 0; q < 4; ++q) { c[q] = p.cnt[tid * 4 + q]; tot += c[q]; ttot += (c[q] + 255) >> 8; }
        int incl = tot, tincl = ttot;
#pragma unroll
        for (int o = 1; o < 64; o <<= 1) { const int v = __shfl_up(incl, o, 64), tv = __shfl_up(tincl, o, 64); if (tid >= o) { incl += v; tincl += tv; } }
        int ex = incl - tot, tex = tincl - ttot;
#pragma unroll
        for (int q = 0; q < 4; ++q) { ps[tid * 4 + q] = ex; xs[tid * 4 + q] = tex; ex += c[q]; tex += (c[q] + 255) >> 8; }
        if (tid == 63) { ps[256] = incl; xs[256] = tincl; }
    }
    __syncthreads();
    if (blockIdx.x == 0) {
        const int nx = xs[256];
        if (tid == 0) *p.ntiles = nx + 64;
        for (int e = tid; e < 256; e += NT) {
            const int c = ps[e + 1] - ps[e];
            for (int t = 0; t < ((c + 255) >> 8); ++t) { int* x = p.xt + (xs[e] + t) * 4; x[0] = e; x[1] = ps[e] + 256 * t; x[2] = min(256, c - 256 * t); x[3] = 0; }
        }
        if (tid < 64) { int* x = p.xt + (nx + tid) * 4; x[0] = 256; x[1] = 131072 + 256 * tid; x[2] = 256; x[3] = 0; }
        if (tid < 256) p.slot_tk[NSLOT + tid] = 0;
    }
    for (int i = blockIdx.x * NT + tid; i < TX * 8; i += gridDim.x * NT) p.slot_tk[ps[p.tok_e[i]] + p.tok_pos[i]] = (i >> 3) * 9 + (i & 7);
    for (int t = blockIdx.x * NT + tid; t < TX; t += gridDim.x * NT) p.slot_tk[131072 + t] = t * 9 + 8;
}

__device__ __forceinline__ void phase19(const Params& p, char* smem) {
    const int nun = *p.ntiles * 2;
    const int lb = (blockIdx.x & 7) * (gridDim.x >> 3) + (blockIdx.x >> 3);
    for (int u = lb; u < nun; u += gridDim.x) {
        const int* x = p.xt + (u >> 1) * 4; const int nt = u & 1;
        const int e = x[0], row0 = x[1], nrows = x[2];
        const float* wg = (e < 256 ? p.exp_w_gate + (size_t)e * 262144 : p.sh_w_gate) + nt * 128;
        const float* wu = (e < 256 ? p.exp_w_up + (size_t)e * 262144 : p.sh_w_up) + nt * 128;
        AGather ap{p.Ahl, 1024, p.slot_tk + row0};
        BKNGU bp{wg, wu};
        bf16_t* outp = p.act + (size_t)row0 * 256 + nt * 128;
        gemm_tile<256, 256, 2, 4>(ap, bp, 1024, smem, [&](const auto& acc, int r0, int c0) {
#pragma unroll
            for (int mi = 0; mi < 8; ++mi) {
                if (r0 + mi * 16 < nrows) {
#pragma unroll
                    for (int gp = 0; gp < 2; ++gp) {
                        const int g = (c0 >> 5) + gp, fq4 = c0 & 15;
                        float o[4];
#pragma unroll
                        for (int j = 0; j < 4; ++j) { const float gt = acc[mi][gp * 2][j], up = acc[mi][gp * 2 + 1][j]; o[j] = gt * sigm(gt) * up; }
                        uint2 ov; ov.x = pack2(o[0], o[1]); ov.y = pack2(o[2], o[3]);
                        *(uint2*)(outp + (size_t)(r0 + mi * 16) * 256 + g * 16 + fq4) = ov;
                    }
                }
            }
        });
    }
}

__device__ __forceinline__ void phase20(const Params& p, char* smem) {
    const int nun = *p.ntiles * 4;
    const int lb = (blockIdx.x & 7) * (gridDim.x >> 3) + (blockIdx.x >> 3);
    for (int u = lb; u < nun; u += gridDim.x) {
        const int* x = p.xt + (u >> 2) * 4; const int nt = u & 3;
        const int e = x[0], row0 = x[1], nrows = x[2];
        APlain ap{p.act + (size_t)row0 * 256, 256};
        BKN bp{(e < 256 ? p.exp_w_down + (size_t)e * 262144 : p.sh_w_down) + nt * 256, 1024};
        const int* stk = p.slot_tk + row0;
        gemm_tile<256, 256, 2, 4>(ap, bp, 256, smem, [&](const auto& acc, int r0, int c0) {
#pragma unroll
            for (int mi = 0; mi < 8; ++mi) {
                const int r = r0 + mi * 16;
                if (r < nrows) {
                    bf16_t* d = p.yk + (size_t)stk[r] * 1024 + nt * 256 + c0;
#pragma unroll
                    for (int ni = 0; ni < 4; ++ni) {
                        uint2 ov; ov.x = pack2(acc[mi][ni][0], acc[mi][ni][1]); ov.y = pack2(acc[mi][ni][2], acc[mi][ni][3]);
                        *(uint2*)(d + ni * 16) = ov;
                    }
                }
            }
        });
    }
}

__device__ __forceinline__ void phase21(const Params& p, char* smem) {
    const int tid = tidx(), wave = tid >> 6, lane = tid & 63;
    const int gw = blockIdx.x * 8 + wave, nw = gridDim.x * 8;
    const float* g2 = p.mod + 5120;
    for (int t = gw; t < TX; t += nw) {
        float w[9];
#pragma unroll
        for (int k = 0; k < 8; ++k) w[k] = p.tok_w[t * 8 + k];
        w[8] = 1.f;
        float4 mo[4]; float ss = 0.f;
#pragma unroll
        for (int i = 0; i < 4; ++i) {
            const int col = i * 256 + lane * 4;
            float a0 = 0.f, a1 = 0.f, a2 = 0.f, a3 = 0.f;
#pragma unroll
            for (int k = 0; k < 9; ++k) {
                const uint2 v = *(const uint2*)(p.yk + ((size_t)t * 9 + k) * 1024 + col);
                a0 += w[k] * __uint_as_float(v.x << 16); a1 += w[k] * __uint_as_float(v.x & 0xffff0000u); a2 += w[k] * __uint_as_float(v.y << 16); a3 += w[k] * __uint_as_float(v.y & 0xffff0000u);
            }
            mo[i] = make_float4(a0, a1, a2, a3);
            ss += a0 * a0 + a1 * a1 + a2 * a2 + a3 * a3;
        }
        ss = wsum(ss);
        const float rs = rsqrtf(ss * (1.f / 1024.f) + 1e-6f);
#pragma unroll
        for (int i = 0; i < 4; ++i) {
            const int col = i * 256 + lane * 4;
            const float4 xm = *(const float4*)(p.x_mid + (size_t)t * 1024 + col);
            const float4 gn = *(const float4*)(p.n_post_ffn + col), gg = *(const float4*)(g2 + col);
            float4 o;
            o.x = xm.x + gg.x * (mo[i].x * rs * gn.x); o.y = xm.y + gg.y * (mo[i].y * rs * gn.y);
            o.z = xm.z + gg.z * (mo[i].z * rs * gn.z); o.w = xm.w + gg.w * (mo[i].w * rs * gn.w);
            *(float4*)(p.out + (size_t)t * 1024 + col) = o;
        }
    }
}

constexpr int NPHASE = 22;
template <int PH> __device__ __forceinline__ void run_phase(const Params& p, char* smem) {
    if constexpr (PH == 0) phase0(p, smem);
    else if constexpr (PH == 1) phase1(p, smem);
    else if constexpr (PH == 2) phase2(p, smem);
    else if constexpr (PH == 3) phase3(p, smem);
    else if constexpr (PH == 4) phase4(p, smem);
    else if constexpr (PH == 5) phase5(p, smem);
    else if constexpr (PH == 6) phase6(p, smem);
    else if constexpr (PH == 7) phase7(p, smem);
    else if constexpr (PH == 8) phase8(p, smem);
    else if constexpr (PH == 9) phase9(p, smem);
    else if constexpr (PH == 10) phase10(p, smem);
    else if constexpr (PH == 11) phase11(p, smem);
    else if constexpr (PH == 12) phase12(p, smem);
    else if constexpr (PH == 13) phase13(p, smem);
    else if constexpr (PH == 14) phase14(p, smem);
    else if constexpr (PH == 15) phase15(p, smem);
    else if constexpr (PH == 16) phase16(p, smem);
    else if constexpr (PH == 17) phase17(p, smem);
    else if constexpr (PH == 18) phase18(p, smem);
    else if constexpr (PH == 19) phase19(p, smem);
    else if constexpr (PH == 20) phase20(p, smem);
    else phase21(p, smem);
}

template <int PH> __global__ void __launch_bounds__(NT, 2) k_phase(Params p) {
    extern __shared__ __attribute__((aligned(16))) char smem[];
    run_phase<PH>(p, smem);
}

template <int PH> __device__ __forceinline__ void mega_run(const Params& p, char* smem, const XcdBarrier& bar) {
    run_phase<PH>(p, smem);
    if constexpr (((PROBE_MASK) >> PH) & 1u) { xcd_barrier(bar); run_phase<PH>(p, smem); }
    if constexpr (PH + 1 < NPHASE) { xcd_barrier(bar); mega_run<PH + 1>(p, smem, bar); }
}
__global__ void __launch_bounds__(NT, 2) k_mega(Params p) {
    extern __shared__ __attribute__((aligned(16))) char smem[];
    uint4* xbw = (uint4*)(smem + 8 * TILE_BYTES);
    if (tidx() == 0) *xbw = make_uint4(0u, 0u, 0u, 0u);
    __syncthreads();
    XcdBarrier bar = xcd_barrier_post(p.bar, (volatile LAS unsigned*)xbw);
    mega_run<0>(p, smem, bar);
}

template <int PH> static void launch_phases(const Params& p, int grid, hipStream_t stream) {
    static bool attr = false;
    if (!attr) { (void)hipFuncSetAttribute((const void*)k_phase<PH>, hipFuncAttributeMaxDynamicSharedMemorySize, LDS_BYTES); attr = true; }
    hipLaunchKernelGGL(k_phase<PH>, dim3(grid), dim3(NT), LDS_BYTES, stream, p);
    if constexpr (PH + 1 < NPHASE) launch_phases<PH + 1>(p, grid, stream);
}

extern "C" void kernel_launch(void* const* d_in, const int* in_sizes, int n_in, void* d_out, int out_size, void* d_ws, size_t ws_size, hipStream_t stream) {
    static int grid = 0;
    if (grid == 0) {
        int dev = 0, cus = 0, per_cu = 0;
        (void)hipGetDevice(&dev); (void)hipDeviceGetAttribute(&cus, hipDeviceAttributeMultiprocessorCount, dev);
        (void)hipFuncSetAttribute((const void*)k_mega, hipFuncAttributeMaxDynamicSharedMemorySize, LDS_BYTES);
        (void)hipOccupancyMaxActiveBlocksPerMultiprocessor(&per_cu, (const void*)k_mega, NT, LDS_BYTES);
        (void)hipGetLastError();
        if (cus <= 0) cus = 256;
        grid = cus * (per_cu >= 2 ? 2 : 1);
    }
    Params p{};
    const float** pin = (const float**)&p.x;
    for (int i = 0; i < 36; ++i) pin[i] = (const float*)d_in[i];
    p.out = (float*)d_out;
    char* ws = (char*)d_ws; size_t off = 0;
    auto alloc = [&](size_t bytes) { size_t o = off; off += (bytes + 255) & ~(size_t)255; return ws + o; };
    p.bar = (unsigned*)alloc(XCD_BAR_WORDS * 4); p.cnt = (int*)alloc(256 * 4);
    const size_t zero_bytes = off;
    p.slot_tk = (int*)alloc((size_t)(NSLOT + 256) * 4);
    p.xt = (int*)alloc(NXT_MAX * 16); p.ntiles = (int*)alloc(256);
    p.tok_e = (int*)alloc((size_t)TX * 8 * 4); p.tok_pos = (int*)alloc((size_t)TX * 8 * 4); p.tok_w = (float*)alloc((size_t)TX * 8 * 4);
    p.modp = (float*)alloc(16 * 2 * 6144 * 4); p.mod = (float*)alloc(2 * 6144 * 4);
    p.WinT = (bf16_t*)alloc((size_t)INC * 1024 * 2); p.WaT = (bf16_t*)alloc(1024 * 512 * 2); p.WbT = (bf16_t*)alloc(1024 * 1024 * 2); p.WoT = (bf16_t*)alloc(1024 * 1024 * 2);
    p.RtT = (bf16_t*)alloc(256 * 3072 * 2); p.ShGU = (bf16_t*)alloc(512 * 1024 * 2); p.ShD = (bf16_t*)alloc(1024 * 256 * 2);
    p.WupT = (bf16_t*)alloc(1024 * 64 * 2); p.AupT = (bf16_t*)alloc(1024 * 64 * 2); p.GupT = (bf16_t*)alloc(512 * 128 * 2);
    p.ya_in = (bf16_t*)alloc((size_t)TX * 512 * 2); p.yb_in = (bf16_t*)alloc((size_t)TX * 1024 * 2);
    char* RA = alloc((size_t)TE * INC * 2);
    p.proj = (bf16_t*)RA;
    { size_t o = 0; auto sub = [&](size_t b) { char* r = RA + o; o += (b + 255) & ~(size_t)255; return r; };
      p.act = (bf16_t*)sub(((size_t)NSLOT + 256) * 256 * 2); p.logits = (float*)sub((size_t)TX * 256 * 4); }
    const size_t surv = (size_t)TE * 512 * 2 * 5 + (size_t)2 * TX * 512 * 2 + 4096;
    const size_t rtmp = 424935424 + 65536;
    char* RB = alloc(surv + rtmp);
    { size_t o = 0; auto sub = [&](size_t b) { char* r = RB + o; o += (b + 255) & ~(size_t)255; return r; };
      p.Rr = (bf16_t*)sub((size_t)TE * 512 * 2); p.Vv = (bf16_t*)sub((size_t)TE * 512 * 2); p.KD = (bf16_t*)sub((size_t)2 * TE * 512 * 2); p.G = (bf16_t*)sub((size_t)TE * 512 * 2);
      p.O = (bf16_t*)sub((size_t)2 * TX * 512 * 2);
      const size_t o_t = o;
      p.Kk = (bf16_t*)sub((size_t)TE * 512 * 2); p.Aa = (bf16_t*)sub((size_t)TE * 512 * 2); p.Bd = (bf16_t*)sub((size_t)2 * TE * 512 * 2);
      p.Wd = (float*)sub((size_t)2 * TE * 512 * 4); p.TW = (bf16_t*)sub((size_t)TE * 64 * 2); p.XA = (bf16_t*)sub((size_t)TE * 64 * 2); p.SG = (bf16_t*)sub((size_t)TE * 128 * 2);
      p.PH = (float*)sub((size_t)127 * 16 * 2 * 4096 * 4); p.Sst = (float*)sub((size_t)128 * 16 * 4096 * 4);
      p.Zz = (float*)sub((size_t)RNC * 16 * RL * 64 * 4); p.YH = (float*)sub((size_t)RNC * 16 * RL * 64 * 4);
      p.hn = (bf16_t*)p.PH;
      o = o_t;
      p.Qr = (bf16_t*)sub((size_t)NCH * 4 * 128 * 128 * 2); p.Kr = (bf16_t*)sub((size_t)NCH * 4 * 128 * 128 * 2); p.KTz = (bf16_t*)sub((size_t)NCH * 4 * 2 * 128 * 128 * 2);
      p.A3 = (bf16_t*)sub((size_t)NCH * 4 * 128 * 384 * 2); p.B3 = (bf16_t*)sub((size_t)NCH * 4 * 256 * 384 * 2);
      p.KVT = (float*)sub((size_t)NCH * 4 * 2 * 256 * 128 * 4); p.Y = (float*)sub((size_t)TX * 1024 * 4);
      o = 0;
      p.x_mid = (float*)sub((size_t)TX * 1024 * 4); p.Ahl = (bf16_t*)sub((size_t)TX * 1024 * 2);
      p.yk = (bf16_t*)sub((size_t)TX * 9 * 1024 * 2);
      char* yk0 = (char*)p.yk; p.mergedA = (float*)yk0; p.merged = (bf16_t*)(yk0 + (size_t)TX * 1024 * 4); p.mix = (float*)(yk0 + (size_t)TX * 1024 * 6);
    }
    if (off > ws_size) { fprintf(stderr, "kernel_launch: workspace too small: need %zu have %zu\n", off, ws_size); return; }
    int j = 0;
    p.jobs[j++] = TJob{p.w_in, p.WinT, 1024, INC, 1024, 0, 0, 0};
    p.jobs[j++] = TJob{p.w_branch_a, p.WaT, 512, 1024, 512, 0, 0, 0};
    p.jobs[j++] = TJob{p.w_branch_b, p.WbT, 1024, 1024, 1024, 0, 0, 0};
    p.jobs[j++] = TJob{p.w_out, p.WoT, 1024, 1024, 1024, 0, 0, 0};
    p.jobs[j++] = TJob{p.router_w, p.RtT, 1024, 256, 1024, 0, 0, 0};
    p.jobs[j++] = TJob{p.rwkv_g_up, p.GupT, 0, 0, 128, 0, 0, 0};
    p.jobs[j++] = TJob{p.rwkv_g_up, p.GupT, 0, 0, 128, 0, 0, 0};
    p.jobs[j++] = TJob{p.rwkv_g_up, p.GupT, 0, 0, 128, 0, 0, 0};
    p.jobs[j++] = TJob{p.rwkv_w_up, p.WupT, 64, 512, 64, 0, 0, 0};
    p.jobs[j++] = TJob{p.rwkv_w_up + 64 * 512, p.WupT, 64, 512, 64, 0, 512, 0};
    p.jobs[j++] = TJob{p.rwkv_a_up, p.AupT, 64, 512, 64, 0, 0, 0};
    p.jobs[j++] = TJob{p.rwkv_a_up + 64 * 512, p.AupT, 64, 512, 64, 0, 512, 0};
    p.jobs[j++] = TJob{p.rwkv_g_up, p.GupT, 128, 512, 128, 0, 0, 0};
    p.jobs[j++] = TJob{p.rwkv_g_up, p.GupT, 0, 0, 128, 0, 0, 0};
    (void)hipMemsetAsync(ws, 0, zero_bytes, stream);
#if MK_ONE_LAUNCH
    hipLaunchKernelGGL(k_mega, dim3(grid), dim3(NT), LDS_BYTES, stream, p);
#else
    launch_phases<0>(p, grid, stream);
#endif
}
```

```cpp
#include <hip/hip_runtime.h>
#include <stdint.h>
#include <stdio.h>

#ifndef MK_ONE_LAUNCH
#define MK_ONE_LAUNCH 1
#endif
#ifndef ROUTER_K
#define ROUTER_K 1024
#endif
#ifndef PROBE_MASK
#define PROBE_MASK 0u
#endif

typedef unsigned short bf16_t;
typedef short bf16x8 __attribute__((ext_vector_type(8)));
typedef float f32x4 __attribute__((ext_vector_type(4)));
typedef float f32x2 __attribute__((ext_vector_type(2)));

#define NT 512
constexpr int TX = 16384, TC = 256, TE = 16640, DM = 1024, INC = 6912;
constexpr int NCH = 130;
constexpr int RL = 130, RNC = 128;
constexpr int TSTR = 144;
constexpr int TILE_BYTES = 128 * TSTR;
constexpr int LDS_BYTES = 8 * TILE_BYTES + 1024;
constexpr int NSLOT = 131072 + 16384;
constexpr int NXT_MAX = 768 + 64;

#define XB_TMO      128
#define XB_XCNT(j)  (256  + 64 * (j))
#define XB_XSUB(j)  (1280 + 64 * (j))
#define XB_XGEN(j)  (2304 + 64 * (j))
#define XB_TOP      3328
#define XB_TOPGEN   3392
#define XCD_BAR_WORDS 3456
#define XB_SPIN_CAP (1u << 18)
#define LAS __attribute__((address_space(3)))

__device__ __forceinline__ unsigned xb_ld(unsigned* p)              { return __hip_atomic_load(p, __ATOMIC_RELAXED, __HIP_MEMORY_SCOPE_AGENT); }
__device__ __forceinline__ unsigned xb_add(unsigned* p, unsigned v) { return __hip_atomic_fetch_add(p, v, __ATOMIC_RELAXED, __HIP_MEMORY_SCOPE_AGENT); }
__device__ __forceinline__ unsigned xb_xcc_id() { return (unsigned)__builtin_amdgcn_s_getreg((3 << 11) | 20) & 0xFu; }
#define XB_SPIN(cond, bar) do { unsigned _sp = 0; while (cond) { __builtin_amdgcn_s_sleep(1); \
    if ((++_sp & 255u) == 0u) { if (xb_ld(&(bar)[XB_TMO])) break; if (_sp > XB_SPIN_CAP) { atomicAdd(&(bar)[XB_TMO], 1u); break; } } } } while (0)

struct XcdBarrier { unsigned* bar; unsigned x; volatile LAS unsigned* st; };

__device__ __forceinline__ XcdBarrier xcd_barrier_post(unsigned* bar, volatile LAS unsigned* st) {
    XcdBarrier b; b.bar = bar; b.x = xb_xcc_id(); b.st = st;
    if (threadIdx.x == 0) (void)xb_add(&bar[XB_XCNT(b.x)], 1u);
    return b;
}
__device__ __forceinline__ void xcd_barrier_complete(unsigned* bar, unsigned x, unsigned& nloc, unsigned& nx) {
    const unsigned G = gridDim.x * gridDim.y * gridDim.z;
    unsigned sum, cnt, mine, sp = 0u;
    for (;;) {
        sum = 0u; cnt = 0u; mine = 0u;
#pragma unroll
        for (unsigned j = 0; j < 16; ++j) { const unsigned c = xb_ld(&bar[XB_XCNT(j)]); sum += c; cnt += (c > 0u) ? 1u : 0u; mine = (j == x) ? c : mine; }
        if (sum == G) break;
        __builtin_amdgcn_s_sleep(1);
        if ((++sp & 255u) == 0u) { if (xb_ld(&bar[XB_TMO])) break; if (sp > XB_SPIN_CAP) { atomicAdd(&bar[XB_TMO], 1u); break; } }
    }
    nloc = mine > 0u ? mine : 1u; nx = cnt > 0u ? cnt : 1u;
}
__device__ __forceinline__ void xcd_barrier(const XcdBarrier& b) {
    asm volatile("s_waitcnt vmcnt(0)" ::: "memory");
    __syncthreads();
    if (threadIdx.x == 0) {
        unsigned* bar = b.bar;
        __builtin_amdgcn_s_waitcnt(0);
        unsigned nloc = b.st[0], nx = b.st[1];
        if (nloc == 0u) { xcd_barrier_complete(bar, b.x, nloc, nx); b.st[0] = nloc; b.st[1] = nx; }
        const unsigned old = xb_add(&bar[XB_XSUB(b.x)], 1u);
        const unsigned gen = old / nloc;
        if (old + 1u == (gen + 1u) * nloc) {
            __builtin_amdgcn_fence(__ATOMIC_RELEASE, "agent");
            asm volatile("s_waitcnt vmcnt(0)" ::: "memory");
            const unsigned og = xb_add(&bar[XB_TOP], 1u);
            const unsigned tg = og / nx;
            if (og + 1u == (tg + 1u) * nx) xb_add(&bar[XB_TOPGEN], 1u);
            else XB_SPIN(xb_ld(&bar[XB_TOPGEN]) == tg, bar);
            __builtin_amdgcn_fence(__ATOMIC_ACQUIRE, "agent");
            xb_add(&bar[XB_XGEN(b.x)], 1u);
            asm volatile("s_waitcnt vmcnt(0)" ::: "memory");
        } else {
            XB_SPIN(xb_ld(&bar[XB_XGEN(b.x)]) == gen, bar);
            __builtin_amdgcn_fence(__ATOMIC_ACQUIRE, "agent");
            asm volatile("s_waitcnt vmcnt(0)" ::: "memory");
        }
    }
    __syncthreads();
}

struct TJob { const float* src; bf16_t* dst; int K, N, dld, mode, rowoff, coloff; };
constexpr int NJOB = 14;

struct Params {
    const float *x, *c, *ctx, *c_ctx, *w_mod, *b_mod, *n_pre_mix, *n_post_mix, *n_pre_ffn, *n_post_ffn,
        *w_in, *shift_mu, *rwkv_w0, *rwkv_w_up, *rwkv_a0, *rwkv_a_up, *rwkv_g_up, *rwkv_k_k, *rwkv_k_a, *rwkv_r_k,
        *rwkv_ln_w, *rwkv_ln_b, *w_branch_a, *ret_decay_logit, *ret_ln_w, *ret_ln_b, *w_branch_b, *w_out,
        *router_w, *router_bias, *exp_w_gate, *exp_w_up, *exp_w_down, *sh_w_gate, *sh_w_up, *sh_w_down;
    float* out;
    unsigned* bar; int* cnt; int* bh; int* slot_tk; int* xt; int* ntiles; int* tok_e; int* tok_pos; float* tok_w;
    float* modp; float* mod;
    bf16_t *WinT, *WaT, *WbT, *WoT, *RtT, *ShGU, *ShD, *WupT, *AupT, *GupT;
    bf16_t *hn, *proj;
    bf16_t *Rr, *Vv, *KD, *G, *O;
    bf16_t *Kk, *Aa, *Bd, *TW, *XA, *SG;
    float *Wd, *PH, *Sst, *Zz, *YH;
    bf16_t *Qr, *Kr, *KTz, *A3, *B3;
    float *KVT, *Y;
    bf16_t *ya_in, *yb_in, *merged, *Ahl, *act, *yk;
    float *mergedA, *mix, *x_mid, *logits;
    TJob jobs[NJOB];
};

__device__ __forceinline__ int tidx() { int t = threadIdx.x; asm volatile("" : "+v"(t)); return t; }
__device__ __forceinline__ float bf2f(bf16_t v) { return __uint_as_float(((unsigned)v) << 16); }
__device__ __forceinline__ bf16_t f2bf(float f) { unsigned u = __float_as_uint(f); u += 0x7fffu + ((u >> 16) & 1u); return (bf16_t)(u >> 16); }
__device__ __forceinline__ unsigned pack2(float lo, float hi) { return (unsigned)f2bf(lo) | ((unsigned)f2bf(hi) << 16); }
__device__ __forceinline__ void unpack8(const uint4& v, float (&f)[8]) {
    f[0] = __uint_as_float(v.x << 16); f[1] = __uint_as_float(v.x & 0xffff0000u); f[2] = __uint_as_float(v.y << 16); f[3] = __uint_as_float(v.y & 0xffff0000u);
    f[4] = __uint_as_float(v.z << 16); f[5] = __uint_as_float(v.z & 0xffff0000u); f[6] = __uint_as_float(v.w << 16); f[7] = __uint_as_float(v.w & 0xffff0000u); }
__device__ __forceinline__ uint4 pack8(const float (&f)[8]) { uint4 o; o.x = pack2(f[0], f[1]); o.y = pack2(f[2], f[3]); o.z = pack2(f[4], f[5]); o.w = pack2(f[6], f[7]); return o; }
__device__ __forceinline__ float wsum(float v) {
#pragma unroll
    for (int o = 32; o; o >>= 1) v += __shfl_xor(v, o, 64);
    return v;
}
__device__ __forceinline__ float sigm(float z) { return 1.f / (1.f + __expf(-z)); }
__device__ __forceinline__ int row_of(int dir, int s) { return dir == 0 ? s : (s < 256 ? 255 - s : 16895 - s); }

struct APlain { const bf16_t* base; int ld;
    __device__ __forceinline__ const char* bptr() const { return (const char*)base; }
    __device__ __forceinline__ unsigned rowoff(int r) const { return (unsigned)(r * ld) * 2u; } };
struct AGather { const bf16_t* base; int ld; const int* idx;
    __device__ __forceinline__ const char* bptr() const { return (const char*)base; }
    __device__ __forceinline__ unsigned rowoff(int r) const { const int tok = idx[r] / 9; return (unsigned)(tok * ld) * 2u; } };
struct BPlain { static constexpr int MODE = 0; const bf16_t* base; int ldv;
    __device__ __forceinline__ const char* bptr() const { return (const char*)base; }
    __device__ __forceinline__ unsigned rowoff(int n) const { return (unsigned)(n * ldv) * 2u; }
    __device__ __forceinline__ const float* colptr(int) const { return nullptr; }
    __device__ __forceinline__ long ld() const { return ldv; }
    __device__ __forceinline__ int lrow(int, int) const { return 0; } };
struct BKN { static constexpr int MODE = 1; const float* base; long ldv;
    __device__ __forceinline__ const char* bptr() const { return nullptr; }
    __device__ __forceinline__ unsigned rowoff(int) const { return 0u; }
    __device__ __forceinline__ const float* colptr(int n4) const { return base + n4 * 4; }
    __device__ __forceinline__ long ld() const { return ldv; }
    __device__ __forceinline__ int lrow(int n4, int j) const { return n4 * 4 + j; } };
struct BKNGU { static constexpr int MODE = 1; const float* g; const float* u;
    __device__ __forceinline__ const char* bptr() const { return nullptr; }
    __device__ __forceinline__ unsigned rowoff(int) const { return 0u; }
    __device__ __forceinline__ const float* colptr(int n4) const { return ((n4 >> 5) ? u : g) + (n4 & 31) * 4; }
    __device__ __forceinline__ long ld() const { return 256; }
    __device__ __forceinline__ int lrow(int n4, int j) const { int sc = (n4 & 31) * 4 + j; return (sc >> 4) * 32 + (n4 >> 5) * 16 + (sc & 15); } };

__device__ __forceinline__ float f4e(const float4& v, int j) { return j == 0 ? v.x : (j == 1 ? v.y : (j == 2 ? v.z : v.w)); }
#define GC_REP4(N, X) do { if constexpr ((N) > 0) { X(0); } if constexpr ((N) > 1) { X(1); } if constexpr ((N) > 2) { X(2); } if constexpr ((N) > 3) { X(3); } } while (0)
#define GC_REP8(N, X) do { X(0); X(1); X(2); X(3); if constexpr ((N) > 4) { X(4); X(5); X(6); X(7); } } while (0)
#define GC_AOFF(i) aoff##i = ap.rowoff(lrow + 64 * i) + lseg * 16
#define GC_BOFF(i) boff##i = bp.rowoff(lrow + 64 * i) + lseg * 16
#define GC_LA(i) ra##i = *(const uint4*)(abase + (aoff##i + kt_ * 128))
#define GC_LB(i) rb##i = *(const uint4*)(bbase + (boff##i + kt_ * 128))
#define GC_LF(i) rf##i = *(const float4*)(bfp + ((long)kt_ * 64 + i) * bld)
#define GC_SA(i) *(uint4*)(As_ + (lrow + 64 * i) * TSTR + lseg * 16) = ra##i
#define GC_SB(i) *(uint4*)(Bs_ + (lrow + 64 * i) * TSTR + lseg * 16) = rb##i
#define GC_GLOAD(KT) do { const int kt_ = (KT); GC_REP4(AL, GC_LA); \
    if constexpr (BP::MODE == 0) { GC_REP4(BL, GC_LB); } else { GC_REP8(KPT, GC_LF); } } while (0)
#define GC_SF(j) do { char* d_ = Bs_ + bp.lrow(n4, j) * TSTR + kq * KPT * 2; \
        if constexpr (KPT == 4) *(uint2*)d_ = make_uint2(pack2(f4e(rf0, j), f4e(rf1, j)), pack2(f4e(rf2, j), f4e(rf3, j))); \
        else *(uint4*)d_ = make_uint4(pack2(f4e(rf0, j), f4e(rf1, j)), pack2(f4e(rf2, j), f4e(rf3, j)), pack2(f4e(rf4, j), f4e(rf5, j)), pack2(f4e(rf6, j), f4e(rf7, j))); } while (0)
#define GC_LSTORE(BUF) do { char* As_ = smem + (BUF) * STAGE; char* Bs_ = As_ + ABYTES; GC_REP4(AL, GC_SA); \
    if constexpr (BP::MODE == 0) { GC_REP4(BL, GC_SB); } else { GC_SF(0); GC_SF(1); GC_SF(2); GC_SF(3); } } while (0)

template <int BM, int BN, int WGM, int WGN, class AP, class BP>
__device__ __forceinline__ void gemm_core(f32x4 (&acc)[BM / WGM / 16][BN / WGN / 16], const AP& ap, const BP& bp, const int K, char* smem) {
    constexpr int TM = BM / WGM, TN = BN / WGN, MI = TM / 16, NI = TN / 16;
    constexpr int ABYTES = BM * TSTR, STAGE = (BM + BN) * TSTR;
    constexpr int AL = BM / 64, BL = BN / 64;
    constexpr int KPT = BN / 32, NQ = BN / 4;
    const int tid = tidx(), wave = tid >> 6, lane = tid & 63, fr = lane & 15, fq = lane >> 4;
    const int wm = wave / WGN, wn = wave % WGN;
    const int lrow = tid >> 3, lseg = tid & 7;
    const char* abase = ap.bptr(); const char* bbase = bp.bptr();
    unsigned aoff0 = 0, aoff1 = 0, aoff2 = 0, aoff3 = 0, boff0 = 0, boff1 = 0, boff2 = 0, boff3 = 0;
    uint4 ra0, ra1, ra2, ra3, rb0, rb1, rb2, rb3; float4 rf0, rf1, rf2, rf3, rf4, rf5, rf6, rf7;
    GC_REP4(AL, GC_AOFF);
    const float* bfp = nullptr;
    const int kq = tid / NQ, n4 = tid % NQ; const long bld = bp.ld();
    if constexpr (BP::MODE == 0) { GC_REP4(BL, GC_BOFF); } else { bfp = bp.colptr(n4) + (long)(kq * KPT) * bld; }
    int nk = K >> 6;
    asm volatile("" : "+s"(nk));
    GC_GLOAD(0); GC_LSTORE(0); __syncthreads();
    for (int kt = 0; kt < nk; ++kt) {
        if (kt + 1 < nk) GC_GLOAD(kt + 1);
        const char* As = smem + (kt & 1) * STAGE; const char* Bs = As + ABYTES;
#pragma unroll
        for (int ks = 0; ks < 2; ++ks) {
            bf16x8 af[MI], bfr[NI];
#pragma unroll
            for (int mi = 0; mi < MI; ++mi) af[mi] = *(const bf16x8*)(As + (wm * TM + mi * 16 + fr) * TSTR + ks * 64 + fq * 16);
#pragma unroll
            for (int ni = 0; ni < NI; ++ni) bfr[ni] = *(const bf16x8*)(Bs + (wn * TN + ni * 16 + fr) * TSTR + ks * 64 + fq * 16);
#pragma unroll
            for (int mi = 0; mi < MI; ++mi)
#pragma unroll
                for (int ni = 0; ni < NI; ++ni) acc[mi][ni] = __builtin_amdgcn_mfma_f32_16x16x32_bf16(bfr[ni], af[mi], acc[mi][ni], 0, 0, 0);
        }
        if (kt + 1 < nk) GC_LSTORE((kt + 1) & 1);
        __syncthreads();
    }
}
template <int BM, int BN, int WGM, int WGN, class AP, class BP, class EPI>
__device__ __forceinline__ void gemm_tile(const AP& ap, const BP& bp, const int K, char* smem, const EPI& epi) {
    constexpr int TM = BM / WGM, TN = BN / WGN, MI = TM / 16, NI = TN / 16;
    f32x4 acc[MI][NI];
#pragma unroll
    for (int mi = 0; mi < MI; ++mi)
#pragma unroll
        for (int ni = 0; ni < NI; ++ni) acc[mi][ni] = (f32x4){0.f, 0.f, 0.f, 0.f};
    gemm_core<BM, BN, WGM, WGN>(acc, ap, bp, K, smem);
    const int wave = tidx() >> 6, lane = tidx() & 63;
    epi(acc, (wave / WGN) * TM + (lane & 15), (wave % WGN) * TN + (lane >> 4) * 4);
}

namespace g8 {
constexpr int BM = 256, BK = 64, HALF = 128, HTB = HALF * BK * 2, NXCD = 8, WGM = 8;
__device__ __forceinline__ int lds_byte(int r, int c) { const int st = (r >> 4) * 2 + (c >> 5), rr = r & 15, cc = c & 31, ob = rr * 64 + cc * 2; return st * 1024 + (ob ^ (((ob >> 9) & 1) << 5)); }
__device__ __forceinline__ void stage_rc(int b, int& R, int& C) { const int st = b / 1024, sb = b % 1024, swz = sb ^ (((sb >> 9) & 1) << 5); R = (st >> 1) * 16 + swz / 64; C = (st & 1) * 32 + (swz % 64) / 2; }
__device__ __forceinline__ int perm32(int rho) { const int n = rho >> 4, i = rho & 15; return 8 * (i >> 2) + 4 * n + (i & 3); }
struct Unit { int pm, pn; };
struct StaticOrder {
    int nM, nN, nwg, G, c;
    __device__ void init(int M, int N, int G_, int c_) { nM = M / BM; nN = N / BM; nwg = nM * nN; G = G_; c = c_; }
    __device__ bool next(int i, Unit& u) const {
        const long L = (long)i * G + c; if (L >= nwg) return false;
        int wgid = (int)L; { const int q = nwg / NXCD, r = nwg % NXCD, xcd = wgid % NXCD, off = wgid / NXCD; wgid = (xcd < r ? xcd * (q + 1) : r * (q + 1) + (xcd - r) * q) + off; }
        const int nig = WGM * nN, gid = wgid / nig, fm = gid * WGM, gsz = (nM - fm) < WGM ? (nM - fm) : WGM;
        u.pm = fm + ((wgid % nig) % gsz); u.pn = (wgid % nig) / gsz; return true;
    }
};
template <class Epi, class Sched>
__device__ __forceinline__ void gemm_phase(LAS unsigned char* lds, const bf16_t* Ag, const bf16_t* Btg, const int lda, const int ldb, const int K, const Sched& S, const Epi& E) {
    const int tid = threadIdx.x, wid = __builtin_amdgcn_readfirstlane(tid >> 6), lane = tid & 63, wr = wid >> 2, wc = wid & 3, fr = lane & 15, fq = lane >> 4;
    const int nt = K / BK;
    unsigned voffA[2], voffB[2];
#pragma unroll
    for (int i = 0; i < 2; ++i) { int R, C; stage_rc(tid * 16 + i * 8192, R, C); const int Rb = Epi::PERM ? ((R & ~31) + perm32(R & 31)) : R;
        voffA[i] = (unsigned)(R * lda + C) * 2u; voffB[i] = (unsigned)(Rb * ldb + C) * 2u; }
    const size_t kstep = (size_t)(BK * 2);
    const size_t hstepA = (size_t)HALF * lda * 2, hstepB = (size_t)HALF * ldb * 2;
    const size_t tstepA = 2 * hstepA, tstepB = 2 * hstepB;
    const unsigned ldsw = (unsigned)wid * 1024u;
    const int aoff = lds_byte(wr * 64 + fr, fq * 8), boff = lds_byte(wc * 32 + fr, fq * 8);
#define PG8_SA(b, h) (((b) * 2 + (h)) * HTB)
#define PG8_SB(b, h) ((4 + (b) * 2 + (h)) * HTB)
#define PG8_STAGE(bufoff, gbase, voff) do { _Pragma("unroll") for (int _i = 0; _i < 2; ++_i) \
        __builtin_amdgcn_global_load_lds((const unsigned*)((const char*)(gbase) + (voff)[_i]), (LAS unsigned*)(lds + (bufoff) + ldsw + _i * 8192), 16, 0, 0); } while (0)
#define PG8_LDA(dst, b, h) do { _Pragma("unroll") for (int m = 0; m < 4; ++m) _Pragma("unroll") for (int k = 0; k < 2; ++k) dst[m][k] = *(const LAS bf16x8*)(lds + PG8_SA(b, h) + aoff + m * 2048 + k * 1024); } while (0)
#define PG8_LDB(dst, b, h) do { _Pragma("unroll") for (int n = 0; n < 2; ++n) _Pragma("unroll") for (int k = 0; k < 2; ++k) dst[n][k] = *(const LAS bf16x8*)(lds + PG8_SB(b, h) + boff + n * 2048 + k * 1024); } while (0)
#define PG8_MMA(ai, bj, At, Bt) do { __builtin_amdgcn_s_setprio(1); _Pragma("unroll") for (int m = 0; m < 4; ++m) _Pragma("unroll") for (int n = 0; n < 2; ++n) _Pragma("unroll") for (int k = 0; k < 2; ++k) \
        acc[ai][bj][m][n] = __builtin_amdgcn_mfma_f32_16x16x32_bf16(Bt[n][k], At[m][k], acc[ai][bj][m][n], 0, 0, 0); __builtin_amdgcn_s_setprio(0); } while (0)
#define PG8_WAIT_V(n) asm volatile("s_waitcnt vmcnt(" #n ")" ::: "memory")
#define PG8_WAIT_L(n) asm volatile("s_waitcnt lgkmcnt(" #n ")" ::: "memory")
#define PG8_BAR __builtin_amdgcn_s_barrier()
#define PG8_SCHED __builtin_amdgcn_sched_barrier(0)
    Unit cur, nxt; int ui = 0;
    if (!S.next(0, cur)) return;
    f32x4 acc[2][2][4][2];
#pragma unroll
    for (int a = 0; a < 2; ++a)
#pragma unroll
        for (int b = 0; b < 2; ++b)
#pragma unroll
            for (int m = 0; m < 4; ++m)
#pragma unroll
                for (int n = 0; n < 2; ++n) acc[a][b][m][n] = (f32x4){0.f, 0.f, 0.f, 0.f};
    bf16x8 At[4][2], B0[2][2], B1[2][2];
    const char* cA = (const char*)Ag + (size_t)cur.pm * tstepA; const char* cB = (const char*)Btg + (size_t)cur.pn * tstepB;
    PG8_STAGE(PG8_SB(0, 0), cB, voffB); PG8_STAGE(PG8_SA(0, 0), cA, voffA); PG8_STAGE(PG8_SB(0, 1), cB + hstepB, voffB); PG8_STAGE(PG8_SA(0, 1), cA + hstepA, voffA);
    if (wr == 1) PG8_BAR;
    PG8_WAIT_V(4); PG8_BAR;
    PG8_STAGE(PG8_SB(1, 0), cB + kstep, voffB); PG8_STAGE(PG8_SA(1, 0), cA + kstep, voffA); PG8_STAGE(PG8_SB(1, 1), cB + hstepB + kstep, voffB);
    PG8_WAIT_V(6); PG8_BAR;
    for (;;) {
        const bool has_next = S.next(ui + 1, nxt);
        const char* nA = has_next ? (const char*)Ag + (size_t)nxt.pm * tstepA : cA; const char* nB = has_next ? (const char*)Btg + (size_t)nxt.pn * tstepB : cB;
        for (int t = 0; t < nt; t += 2) {
            const bool last = (t == nt - 2);
            const char* a1 = cA + (size_t)(t + 1) * kstep;
            const char* a2 = last ? nA : cA + (size_t)(t + 2) * kstep; const char* b2 = last ? nB : cB + (size_t)(t + 2) * kstep;
            const char* a3 = a2 + kstep; const char* b3 = b2 + kstep;
            PG8_LDB(B0, 0, 0); PG8_SCHED; PG8_LDA(At, 0, 0); PG8_STAGE(PG8_SA(1, 1), a1 + hstepA, voffA);
            PG8_WAIT_L(8); PG8_BAR; PG8_WAIT_L(0); PG8_MMA(0, 0, At, B0); PG8_BAR; PG8_SCHED;
            PG8_LDB(B1, 0, 1); PG8_STAGE(PG8_SB(0, 0), b2, voffB);
            PG8_BAR; PG8_WAIT_L(0); PG8_MMA(0, 1, At, B1); PG8_BAR;
            PG8_LDA(At, 0, 1); PG8_STAGE(PG8_SA(0, 0), a2, voffA);
            PG8_BAR; PG8_WAIT_L(0); PG8_MMA(1, 0, At, B0); PG8_BAR; PG8_SCHED;
            PG8_STAGE(PG8_SB(0, 1), b2 + hstepB, voffB);
            PG8_WAIT_V(6); PG8_BAR; PG8_MMA(1, 1, At, B1); PG8_BAR;
            PG8_LDB(B0, 1, 0); PG8_SCHED; PG8_LDA(At, 1, 0); PG8_STAGE(PG8_SA(0, 1), a2 + hstepA, voffA);
            PG8_WAIT_L(8); PG8_BAR; PG8_WAIT_L(0); PG8_MMA(0, 0, At, B0); PG8_BAR; PG8_SCHED;
            PG8_LDB(B1, 1, 1); PG8_STAGE(PG8_SB(1, 0), b3, voffB);
            PG8_BAR; PG8_WAIT_L(0); PG8_MMA(0, 1, At, B1); PG8_BAR;
            PG8_LDA(At, 1, 1); PG8_STAGE(PG8_SA(1, 0), a3, voffA);
            PG8_BAR; PG8_WAIT_L(0); PG8_MMA(1, 0, At, B0); PG8_BAR; PG8_SCHED;
            PG8_STAGE(PG8_SB(1, 1), b3 + hstepB, voffB);
            PG8_WAIT_V(6); PG8_BAR; PG8_MMA(1, 1, At, B1); PG8_BAR;
        }
        E(acc, cur, wr, wc, fr, fq);
        if (!has_next) break;
#pragma unroll
        for (int a = 0; a < 2; ++a)
#pragma unroll
            for (int b = 0; b < 2; ++b)
#pragma unroll
                for (int m = 0; m < 4; ++m)
#pragma unroll
                    for (int n = 0; n < 2; ++n) acc[a][b][m][n] = (f32x4){0.f, 0.f, 0.f, 0.f};
        cur = nxt; cA = nA; cB = nB; ++ui;
    }
    PG8_WAIT_V(0);
    if (wr == 0) PG8_BAR;
    PG8_BAR;
#undef PG8_SA
#undef PG8_SB
#undef PG8_STAGE
#undef PG8_LDA
#undef PG8_LDB
#undef PG8_MMA
#undef PG8_WAIT_V
#undef PG8_WAIT_L
#undef PG8_BAR
#undef PG8_SCHED
}
struct EpiF32 {
    static constexpr bool PERM = false;
    float* C; int ldc;
    __device__ __forceinline__ void operator()(const f32x4 (&acc)[2][2][4][2], const Unit& u, int wr, int wc, int fr, int fq) const {
        const int row0 = u.pm * BM + wr * 64 + fr, col0 = u.pn * BM + wc * 32 + 4 * fq;
#pragma unroll
        for (int ai = 0; ai < 2; ++ai)
#pragma unroll
            for (int m = 0; m < 4; ++m) { float* rowp = C + (size_t)(row0 + ai * HALF + m * 16) * ldc + col0;
#pragma unroll
                for (int bj = 0; bj < 2; ++bj)
#pragma unroll
                    for (int n = 0; n < 2; ++n) *(f32x4*)(rowp + bj * HALF + n * 16) = acc[ai][bj][m][n]; }
    }
};
struct EpiBf16 {
    static constexpr bool PERM = true;
    bf16_t* O; int ldc;
    __device__ __forceinline__ void operator()(const f32x4 (&acc)[2][2][4][2], const Unit& u, int wr, int wc, int fr, int fq) const {
        const int row0 = u.pm * BM + wr * 64 + fr, col0 = u.pn * BM + wc * 32 + 8 * fq;
#pragma unroll
        for (int ai = 0; ai < 2; ++ai)
#pragma unroll
            for (int m = 0; m < 4; ++m) { bf16_t* rowp = O + (size_t)(row0 + ai * HALF + m * 16) * ldc + col0;
#pragma unroll
                for (int bj = 0; bj < 2; ++bj) { const f32x4 v0 = acc[ai][bj][m][0], v1 = acc[ai][bj][m][1];
                    uint4 o; o.x = pack2(v0[0], v0[1]); o.y = pack2(v0[2], v0[3]); o.z = pack2(v1[0], v1[1]); o.w = pack2(v1[2], v1[3]);
                    *(uint4*)(rowp + bj * HALF) = o; } }
    }
};
}

__device__ __forceinline__ void phase0(const Params& p, char* smem) {
    const int tid = tidx(), wave = tid >> 6, lane = tid & 63;
    const int gw = blockIdx.x * 8 + wave, nw = gridDim.x * 8;
    for (int u = gw; u < 1536; u += nw) {
        const int cb = u % 96, ks = u / 96, j = cb * 64 + lane;
        float a0 = 0.f, a1 = 0.f;
#pragma unroll 1
        for (int k0 = ks * 64; k0 < ks * 64 + 64; k0 += 16) {
            float w[16];
#pragma unroll
            for (int i = 0; i < 16; ++i) w[i] = p.w_mod[(size_t)(k0 + i) * 6144 + j];
#pragma unroll
            for (int i = 0; i < 16; ++i) { const float c0 = p.c[k0 + i], c1 = p.c_ctx[k0 + i]; a0 += c0 * sigm(c0) * w[i]; a1 += c1 * sigm(c1) * w[i]; }
        }
        p.modp[(ks * 2 + 0) * 6144 + j] = a0; p.modp[(ks * 2 + 1) * 6144 + j] = a1;
    }
    float* T = (float*)smem;
    int total = 0;
    for (int j = 0; j < NJOB; ++j) total += (p.jobs[j].K >> 6) * (p.jobs[j].N >> 6);
    for (int u = blockIdx.x; u < total; u += gridDim.x) {
        int j = 0, r = u;
        for (;; ++j) { const int n = (p.jobs[j].K >> 6) * (p.jobs[j].N >> 6); if (r < n) break; r -= n; }
        const TJob jb = p.jobs[j];
        const int ntn = jb.N >> 6, kt = r / ntn, nt = r % ntn, k0 = kt * 64, n0 = nt * 64;
        {
            const int kk = tid >> 4, c4 = (tid & 15) * 4;
#pragma unroll
            for (int i = 0; i < 2; ++i) {
                const int k = kk + 32 * i;
                const float4 v = *(const float4*)(jb.src + (size_t)(k0 + k) * jb.N + n0 + c4);
                T[k * 65 + c4 + 0] = v.x; T[k * 65 + c4 + 1] = v.y; T[k * 65 + c4 + 2] = v.z; T[k * 65 + c4 + 3] = v.w;
            }
        }
        __syncthreads();
        {
            const int n = tid >> 3, ks = (tid & 7) * 8;
            float v[8];
#pragma unroll
            for (int q = 0; q < 8; ++q) v[q] = T[(ks + q) * 65 + n];
            const int ng = n0 + n;
            int drow = jb.rowoff + ng;
            if (jb.mode == 2) drow = (ng >> 4) * 32 + (ng & 15) + jb.rowoff;
            uint4 hi; hi.x = pack2(v[0], v[1]); hi.y = pack2(v[2], v[3]); hi.z = pack2(v[4], v[5]); hi.w = pack2(v[6], v[7]);
            bf16_t* d = jb.dst + (size_t)drow * jb.dld + jb.coloff + k0 + ks;
            *(uint4*)d = hi;
            if (jb.mode == 1) {
                float l[8];
#pragma unroll
                for (int q = 0; q < 8; ++q) l[q] = v[q] - bf2f(f2bf(v[q]));
                uint4 lo; lo.x = pack2(l[0], l[1]); lo.y = pack2(l[2], l[3]); lo.z = pack2(l[4], l[5]); lo.w = pack2(l[6], l[7]);
                *(uint4*)(d + 1024) = hi; *(uint4*)(d + 2048) = lo;
            }
        }
        __syncthreads();
    }
}

__device__ __forceinline__ void phase1(const Params& p, char* smem) {
    const int tid = tidx(), wave = tid >> 6, lane = tid & 63;
    float* L = (float*)smem;
    for (int idx = tid; idx < 4096; idx += NT) {
        const int v = idx >> 11, which = (idx >> 10) & 1, col = idx & 1023;
        float s = p.b_mod[which * 1024 + col];
        for (int ks = 0; ks < 16; ++ks) s += p.modp[(ks * 2 + v) * 6144 + which * 1024 + col];
        L[idx] = s;
    }
    for (int idx = blockIdx.x * NT + tid; idx < 2 * 6144; idx += gridDim.x * NT) {
        const int v = idx / 6144, j = idx % 6144;
        float sm = p.b_mod[j];
#pragma unroll
        for (int ks = 0; ks < 16; ++ks) sm += p.modp[(ks * 2 + v) * 6144 + j];
        p.mod[idx] = sm;
    }
    __syncthreads();
    const int gw = blockIdx.x * 8 + wave, nw = gridDim.x * 8;
    for (int r = gw; r < TE; r += nw) {
        const int v = r < 256 ? 1 : 0;
        const float* src = r < 256 ? p.ctx + (size_t)r * 1024 : p.x + (size_t)(r - 256) * 1024;
        float4 xv[4]; float ss = 0.f;
#pragma unroll
        for (int i = 0; i < 4; ++i) { xv[i] = *(const float4*)(src + i * 256 + lane * 4); ss += xv[i].x * xv[i].x + xv[i].y * xv[i].y + xv[i].z * xv[i].z + xv[i].w * xv[i].w; }
        ss = wsum(ss);
        const float rs = rsqrtf(ss * (1.f / 1024.f) + 1e-6f);
#pragma unroll
        for (int i = 0; i < 4; ++i) {
            const int col = i * 256 + lane * 4;
            const float4 g = *(const float4*)(p.n_pre_mix + col);
            const float* sh = L + v * 2048 + col; const float* sc = L + v * 2048 + 1024 + col;
            const float y0 = xv[i].x * rs * g.x * (1.f + sc[0]) + sh[0];
            const float y1 = xv[i].y * rs * g.y * (1.f + sc[1]) + sh[1];
            const float y2 = xv[i].z * rs * g.z * (1.f + sc[2]) + sh[2];
            const float y3 = xv[i].w * rs * g.w * (1.f + sc[3]) + sh[3];
            uint2 o; o.x = pack2(y0, y1); o.y = pack2(y2, y3);
            *(uint2*)(p.hn + (size_t)r * 1024 + col) = o;
        }
    }
}

__device__ __forceinline__ void phase2(const Params& p, char* smem) {
    g8::StaticOrder S; S.init(TE, INC, gridDim.x, blockIdx.x);
    g8::EpiBf16 E{p.proj, INC};
    g8::gemm_phase((LAS unsigned char*)smem, p.hn, p.WinT, 1024, 1024, 1024, S, E);
}

__device__ __forceinline__ void phase3(const Params& p, char* smem) {
    const int tid = tidx(), wave = tid >> 6, lane = tid & 63;
    const int gw = blockIdx.x * 8 + wave, nw = gridDim.x * 8;
    float mu0[3][8], mu1[3][8], kkw[8], lm0[4], lm1[4];
#pragma unroll
    for (int a = 0; a < 3; ++a)
#pragma unroll
        for (int q = 0; q < 8; ++q) { mu0[a][q] = p.shift_mu[a * 512 + lane * 8 + q]; mu1[a][q] = p.shift_mu[1792 + a * 512 + lane * 8 + q]; }
#pragma unroll
    for (int q = 0; q < 8; ++q) kkw[q] = p.rwkv_k_k[lane * 8 + q];
#pragma unroll
    for (int q = 0; q < 4; ++q) { lm0[q] = p.shift_mu[1536 + lane * 4 + q]; lm1[q] = p.shift_mu[1792 + 1536 + lane * 4 + q]; }
    for (int t = gw; t < TE; t += nw) {
        const bool hp = (t != 0 && t != 256), hn_ = (t != 255 && t != TE - 1);
        const bf16_t* pr = p.proj + (size_t)t * INC;
        uint4 q0[3], qm[3], qn[3]; uint2 l0, lm = make_uint2(0, 0), ln = make_uint2(0, 0);
#pragma unroll
        for (int a = 0; a < 3; ++a) {
            q0[a] = *(const uint4*)(pr + a * 512 + lane * 8);
            qm[a] = hp ? *(const uint4*)(pr + a * 512 + lane * 8 - INC) : make_uint4(0, 0, 0, 0);
            qn[a] = hn_ ? *(const uint4*)(pr + a * 512 + lane * 8 + INC) : make_uint4(0, 0, 0, 0);
        }
        l0 = *(const uint2*)(pr + 1536 + lane * 4);
        if (hp) lm = *(const uint2*)(pr + 1536 + lane * 4 - INC);
        if (hn_) ln = *(const uint2*)(pr + 1536 + lane * 4 + INC);
        float val[3][8];
#pragma unroll
        for (int a = 0; a < 3; ++a) {
            float f0[8], fm[8], fn[8]; unpack8(q0[a], f0); unpack8(qm[a], fm); unpack8(qn[a], fn);
#pragma unroll
            for (int q = 0; q < 8; ++q) val[a][q] = f0[q] + mu0[a][q] * (fm[q] - f0[q]) + mu1[a][q] * (fn[q] - f0[q]);
        }
        float kkv[8], n2 = 0.f;
#pragma unroll
        for (int q = 0; q < 8; ++q) { kkv[q] = val[1][q] * kkw[q]; n2 += kkv[q] * kkv[q]; }
        n2 += __shfl_xor(n2, 1, 64); n2 += __shfl_xor(n2, 2, 64); n2 += __shfl_xor(n2, 4, 64);
        const float inv = -1.f / fmaxf(sqrtf(n2), 1e-12f);
#pragma unroll
        for (int q = 0; q < 8; ++q) kkv[q] *= inv;
        const size_t o = (size_t)t * 512 + lane * 8;
        *(uint4*)(p.Rr + o) = pack8(val[0]); *(uint4*)(p.Kk + o) = pack8(val[1]); *(uint4*)(p.Vv + o) = pack8(val[2]); *(uint4*)(p.Aa + o) = pack8(kkv);
        {
            float v[4];
            const unsigned w0[2] = {l0.x, l0.y}, wm[2] = {lm.x, lm.y}, wn[2] = {ln.x, ln.y};
#pragma unroll
            for (int q = 0; q < 4; ++q) {
                const float p0 = (q & 1) ? __uint_as_float(w0[q >> 1] & 0xffff0000u) : __uint_as_float(w0[q >> 1] << 16);
                const float pm = (q & 1) ? __uint_as_float(wm[q >> 1] & 0xffff0000u) : __uint_as_float(wm[q >> 1] << 16);
                const float pn = (q & 1) ? __uint_as_float(wn[q >> 1] & 0xffff0000u) : __uint_as_float(wn[q >> 1] << 16);
                v[q] = p0 + lm0[q] * (pm - p0) + lm1[q] * (pn - p0);
            }
            if (lane < 16) {
                uint2 ov; ov.x = pack2(tanhf(v[0]), tanhf(v[1])); ov.y = pack2(tanhf(v[2]), tanhf(v[3]));
                *(uint2*)(p.TW + (size_t)t * 64 + lane * 4) = ov;
            } else if (lane < 32) {
                uint2 ov; ov.x = pack2(v[0], v[1]); ov.y = pack2(v[2], v[3]);
                *(uint2*)(p.XA + (size_t)t * 64 + (lane - 16) * 4) = ov;
            } else {
                uint2 ov; ov.x = pack2(sigm(v[0]), sigm(v[1])); ov.y = pack2(sigm(v[2]), sigm(v[3]));
                *(uint2*)(p.SG + (size_t)t * 128 + (lane - 32) * 4) = ov;
            }
        }
    }
}

__device__ __forceinline__ void phase4(const Params& p, char* smem) {
    for (int u = blockIdx.x; u < 130 * 20; u += gridDim.x) {
        const int mt = u / 20, q = u % 20;
        if (q < 8) {
            APlain ap{p.TW + (size_t)mt * 128 * 64, 64}; BPlain bp{p.WupT + (size_t)q * 128 * 64, 64};
            gemm_tile<128, 128, 4, 2>(ap, bp, 64, smem, [&](const auto& acc, int r0, int c0) {
#pragma unroll
                for (int mi = 0; mi < 2; ++mi)
#pragma unroll
                    for (int ni = 0; ni < 4; ++ni) {
                        const int t = mt * 128 + r0 + mi * 16, cc = q * 128 + c0 + ni * 16, d = cc >> 9, c = cc & 511;
                        float4 o; float* op = (float*)&o;
#pragma unroll
                        for (int j = 0; j < 4; ++j) { const float z = p.rwkv_w0[d * 512 + c + j] + acc[mi][ni][j]; op[j] = __expf(-0.60653066f * sigm(z)); }
                        *(float4*)(p.Wd + ((size_t)d * TE + t) * 512 + c) = o;
                    }
            });
        } else if (q < 16) {
            const int qq = q - 8;
            APlain ap{p.XA + (size_t)mt * 128 * 64, 64}; BPlain bp{p.AupT + (size_t)qq * 128 * 64, 64};
            gemm_tile<128, 128, 4, 2>(ap, bp, 64, smem, [&](const auto& acc, int r0, int c0) {
#pragma unroll
                for (int mi = 0; mi < 2; ++mi)
#pragma unroll
                    for (int ni = 0; ni < 4; ++ni) {
                        const int t = mt * 128 + r0 + mi * 16, cc = qq * 128 + c0 + ni * 16, d = cc >> 9, c = cc & 511;
                        const uint2 av = *(const uint2*)(p.Aa + (size_t)t * 512 + c), kv = *(const uint2*)(p.Kk + (size_t)t * 512 + c);
                        const bf16_t* ae = (const bf16_t*)&av; const bf16_t* ke = (const bf16_t*)&kv;
                        float bo[4], ko[4];
#pragma unroll
                        for (int j = 0; j < 4; ++j) {
                            const float ad = sigm(p.rwkv_a0[d * 512 + c + j] + acc[mi][ni][j]);
                            bo[j] = -bf2f(ae[j]) * ad;
                            ko[j] = bf2f(ke[j]) * (1.f + (ad - 1.f) * p.rwkv_k_a[c + j]);
                        }
                        uint2 o1, o2; o1.x = pack2(bo[0], bo[1]); o1.y = pack2(bo[2], bo[3]); o2.x = pack2(ko[0], ko[1]); o2.y = pack2(ko[2], ko[3]);
                        *(uint2*)(p.Bd + ((size_t)d * TE + t) * 512 + c) = o1;
                        *(uint2*)(p.KD + ((size_t)d * TE + t) * 512 + c) = o2;
                    }
            });
        } else {
            const int qq = q - 16;
            APlain ap{p.SG + (size_t)mt * 128 * 128, 128}; BPlain bp{p.GupT + (size_t)qq * 128 * 128, 128};
            gemm_tile<128, 128, 4, 2>(ap, bp, 128, smem, [&](const auto& acc, int r0, int c0) {
#pragma unroll
                for (int mi = 0; mi < 2; ++mi)
#pragma unroll
                    for (int ni = 0; ni < 4; ++ni) {
                        const int t = mt * 128 + r0 + mi * 16, c = qq * 128 + c0 + ni * 16;
                        uint2 o; o.x = pack2(acc[mi][ni][0], acc[mi][ni][1]); o.y = pack2(acc[mi][ni][2], acc[mi][ni][3]);
                        *(uint2*)(p.G + (size_t)t * 512 + c) = o;
                    }
            });
        }
    }
}

__device__ __forceinline__ void phase5(const Params& p, char* smem) {
    const int tid = tidx(), wave = __builtin_amdgcn_readfirstlane(tid >> 6), lane = tid & 63;
    constexpr int SB = 5, NA = 6, NSB = RL / SB;
    float* L = (float*)smem + wave * (2 * SB * NA * 64);
    for (int q = blockIdx.x * 8 + wave; q < RNC * 16; q += gridDim.x * 8) {
        const int j = q >> 4, hd = q & 15, dir = hd >> 3, h = hd & 7;
        const float* gW = p.Wd + (size_t)dir * TE * 512; const bf16_t* gB = p.Bd + (size_t)dir * TE * 512; const bf16_t* gK = p.KD + (size_t)dir * TE * 512;
        const bf16_t* gA = p.Aa; const bf16_t* gV = p.Vv; const bf16_t* gR = p.Rr;
        const unsigned lofs = (unsigned)(h * 64 + lane);
        float* gZ = p.Zz + (size_t)q * (RL * 64) + lane; float* gY = p.YH + (size_t)q * (RL * 64) + lane;
        f32x2 sP[32], sH[32];
        int ln = lane; asm volatile("" : "+v"(ln));
#pragma unroll
        for (int k = 0; k < 32; ++k) { sP[k] = (f32x2){(2 * k == ln) ? 1.f : 0.f, (2 * k + 1 == ln) ? 1.f : 0.f}; sH[k] = (f32x2){0.f, 0.f}; }
        for (int sb = 0; sb < NSB; ++sb) {
            {
                float st[SB][NA];
#pragma unroll
                for (int i = 0; i < SB; ++i) {
                    const unsigned g = (unsigned)row_of(dir, j * RL + sb * SB + i) * 512u + lofs;
                    st[i][0] = gW[g]; st[i][1] = bf2f(gA[g]); st[i][2] = bf2f(gB[g]); st[i][3] = bf2f(gK[g]); st[i][4] = bf2f(gV[g]); st[i][5] = bf2f(gR[g]);
                }
                float* d = L + (sb & 1) * (SB * NA * 64) + lane;
#pragma unroll
                for (int i = 0; i < SB; ++i)
#pragma unroll
                    for (int a = 0; a < NA; ++a) d[(i * NA + a) * 64] = st[i][a];
            }
            const float* Lb = L + (sb & 1) * (SB * NA * 64);
#pragma unroll 1
            for (int i = 0; i < SB; ++i) {
                const float* W = Lb + (i * NA) * 64; const float* A = W + 64; const float* B = W + 128; const float* KDv = W + 192; const float* R = W + 320;
                const float vl = W[256 + lane];
                f32x2 dh0 = {0.f, 0.f}, dh1 = {0.f, 0.f}, dp0 = {0.f, 0.f}, dp1 = {0.f, 0.f};
                f32x4 ac0 = *(const f32x4*)(A), ac1 = *(const f32x4*)(A + 4), ac2 = *(const f32x4*)(A + 8), ac3 = *(const f32x4*)(A + 12);
                f32x4 rw[3], rb[3], rk[3], rr[3];
                rw[0] = *(const f32x4*)(W); rb[0] = *(const f32x4*)(B); rk[0] = *(const f32x4*)(KDv); rr[0] = *(const f32x4*)(R);
                rw[1] = *(const f32x4*)(W + 4); rb[1] = *(const f32x4*)(B + 4); rk[1] = *(const f32x4*)(KDv + 4); rr[1] = *(const f32x4*)(R + 4);
#pragma unroll
                for (int c = 0; c < 4; ++c) {
                    f32x4 an0 = ac0, an1 = ac1, an2 = ac2, an3 = ac3;
                    if (c < 3) { an0 = *(const f32x4*)(A + c * 16 + 16); an1 = *(const f32x4*)(A + c * 16 + 20); an2 = *(const f32x4*)(A + c * 16 + 24); an3 = *(const f32x4*)(A + c * 16 + 28); }
                    const int k = c * 8;
                    dh0 += sH[k] * ac0.lo; dh1 += sH[k + 1] * ac0.hi; dp0 += sP[k] * ac0.lo; dp1 += sP[k + 1] * ac0.hi;
                    dh0 += sH[k + 2] * ac1.lo; dh1 += sH[k + 3] * ac1.hi; dp0 += sP[k + 2] * ac1.lo; dp1 += sP[k + 3] * ac1.hi;
                    dh0 += sH[k + 4] * ac2.lo; dh1 += sH[k + 5] * ac2.hi; dp0 += sP[k + 4] * ac2.lo; dp1 += sP[k + 5] * ac2.hi;
                    dh0 += sH[k + 6] * ac3.lo; dh1 += sH[k + 7] * ac3.hi; dp0 += sP[k + 6] * ac3.lo; dp1 += sP[k + 7] * ac3.hi;
                    __builtin_amdgcn_sched_barrier(0);
                    ac0 = an0; ac1 = an1; ac2 = an2; ac3 = an3;
                }
                const float saHs = (dh0.x + dh0.y) + (dh1.x + dh1.y), saPs = (dp0.x + dp0.y) + (dp1.x + dp1.y);
                const f32x2 saH = {saHs, saHs}, saP = {saPs, saPs}, vl2 = {vl, vl};
                f32x2 y0 = {0.f, 0.f}, y1 = {0.f, 0.f}, z0 = {0.f, 0.f}, z1 = {0.f, 0.f};
#pragma unroll
                for (int g = 0; g < 16; ++g) {
                    if (g + 2 < 16) { rw[(g + 2) % 3] = *(const f32x4*)(W + 4 * g + 8); rb[(g + 2) % 3] = *(const f32x4*)(B + 4 * g + 8); rk[(g + 2) % 3] = *(const f32x4*)(KDv + 4 * g + 8); rr[(g + 2) % 3] = *(const f32x4*)(R + 4 * g + 8); }
                    const f32x4 cw = rw[g % 3], cb = rb[g % 3], ck = rk[g % 3], cr = rr[g % 3];
                    const int k = 2 * g;
                    sH[k]     = sH[k]     * cw.lo + (saH * cb.lo + vl2 * ck.lo);
                    sH[k + 1] = sH[k + 1] * cw.hi + (saH * cb.hi + vl2 * ck.hi);
                    sP[k]     = sP[k]     * cw.lo + saP * cb.lo;
                    sP[k + 1] = sP[k + 1] * cw.hi + saP * cb.hi;
                    y0 += sH[k] * cr.lo; y1 += sH[k + 1] * cr.hi;
                    z0 += sP[k] * cr.lo; z1 += sP[k + 1] * cr.hi;
                    __builtin_amdgcn_sched_barrier(0);
                }
                const int t = sb * SB + i;
                gZ[t * 64] = (z0.x + z0.y) + (z1.x + z1.y); gY[t * 64] = (y0.x + y0.y) + (y1.x + y1.y);
            }
        }
        if (j < RNC - 1) {
            float* dP = p.PH + (((size_t)(j * 16 + hd) * 2 + 0) * 64 + lane) * 64;
            float* dH = p.PH + (((size_t)(j * 16 + hd) * 2 + 1) * 64 + lane) * 64;
#pragma unroll
            for (int k = 0; k < 32; k += 2) { *(float4*)(dP + 2 * k) = make_float4(sP[k].x, sP[k].y, sP[k + 1].x, sP[k + 1].y); *(float4*)(dH + 2 * k) = make_float4(sH[k].x, sH[k].y, sH[k + 1].x, sH[k + 1].y); }
        }
    }
}

__device__ __forceinline__ void phase6(const Params& p, char* smem) {
    const int tid = threadIdx.x, wave = __builtin_amdgcn_readfirstlane(tid >> 6), lane = tid & 63;
    if (blockIdx.x >= 256) return;
    const int hd = blockIdx.x >> 4, rb0 = (blockIdx.x & 15) * 4, r0 = rb0 + (wave & 3);
    LAS unsigned char* lds = (LAS unsigned char*)smem;
    constexpr int SLOT = 17408, NJ = RNC - 1;
    const char* pbase = (const char*)(p.PH + (size_t)hd * 2 * 4096);
    float s0 = 0.f;
#define CH_ISSUE(J) do { const char* src_ = pbase + (size_t)(J) * 524288; const unsigned so_ = (unsigned)(((J) & 7) * SLOT); \
        _Pragma("unroll") for (int q_ = 0; q_ < 4; ++q_) __builtin_amdgcn_global_load_lds((const unsigned*)(src_ + ((wave - 4) * 4 + q_) * 1024 + lane * 16), (LAS unsigned*)(lds + so_ + ((wave - 4) * 4 + q_) * 1024), 16, 0, 0); \
        if (wave == 7) __builtin_amdgcn_global_load_lds((const unsigned*)(src_ + 16384 + rb0 * 256 + lane * 16), (LAS unsigned*)(lds + so_ + 16384), 16, 0, 0); } while (0)
    if (wave >= 4) { CH_ISSUE(0); CH_ISSUE(1); CH_ISSUE(2); CH_ISSUE(3); CH_ISSUE(4); CH_ISSUE(5); CH_ISSUE(6); }
    for (int j = 0; j < RNC; ++j) {
        if (wave < 4) p.Sst[((size_t)(j * 16 + hd) * 64 + r0) * 64 + lane] = s0;
        if (j == NJ) break;
        if (wave >= 4) {
            if (j + 6 >= NJ) asm volatile("s_waitcnt vmcnt(0)" ::: "memory");
            else if (wave == 7) asm volatile("s_waitcnt vmcnt(30)" ::: "memory");
            else asm volatile("s_waitcnt vmcnt(24)" ::: "memory");
        }
        asm volatile("s_waitcnt lgkmcnt(0)" ::: "memory"); __builtin_amdgcn_s_barrier(); asm volatile("" ::: "memory");
        if (wave >= 4) { if (j + 7 < NJ) CH_ISSUE(j + 7); }
        else {
            const float* Pc = (const float*)(smem + (j & 7) * SLOT);
            f32x2 n0 = {Pc[4096 + wave * 64 + lane], 0.f}, n1 = {0.f, 0.f};
#pragma unroll
            for (int k = 0; k < 64; k += 4) {
                const f32x2 a0 = {__int_as_float(__builtin_amdgcn_readlane(__float_as_int(s0), k)), __int_as_float(__builtin_amdgcn_readlane(__float_as_int(s0), k + 1))};
                const f32x2 a1 = {__int_as_float(__builtin_amdgcn_readlane(__float_as_int(s0), k + 2)), __int_as_float(__builtin_amdgcn_readlane(__float_as_int(s0), k + 3))};
                const f32x2 p0 = {Pc[k * 64 + lane], Pc[(k + 1) * 64 + lane]}, p1 = {Pc[(k + 2) * 64 + lane], Pc[(k + 3) * 64 + lane]};
                n0 += a0 * p0; n1 += a1 * p1;
            }
            s0 = (n0.x + n0.y) + (n1.x + n1.y);
        }
    }
#undef CH_ISSUE
    __syncthreads();
}

__device__ __forceinline__ void phase7(const Params& p, char* smem) {
    const int tid = tidx(), wave = __builtin_amdgcn_readfirstlane(tid >> 6), lane = tid & 63;
    constexpr int SB = 10, NSB = RL / SB;
    float* L = (float*)smem + wave * (SB * 64);
    for (int q = 16 + blockIdx.x * 8 + wave; q < RNC * 16; q += gridDim.x * 8) {
        const int j = q >> 4, hd = q & 15, dir = hd >> 3, h = hd & 7;
        f32x2 s[32];
        {
            const float* src = p.Sst + ((size_t)(j * 16 + hd) * 64 + lane) * 64;
#pragma unroll
            for (int k = 0; k < 32; k += 2) { const f32x4 v = *(const f32x4*)(src + 2 * k); s[k] = v.lo; s[k + 1] = v.hi; }
        }
        const float* gZ = p.Zz + (size_t)q * (RL * 64) + lane; const float* gY = p.YH + (size_t)q * (RL * 64) + lane;
        bf16_t* gO = p.O + (size_t)dir * TX * 512 + h * 64 + lane;
        float zz[SB], yy[SB];
#pragma unroll
        for (int i = 0; i < SB; ++i) { zz[i] = gZ[i * 64]; yy[i] = gY[i * 64]; }
        for (int sb = 0; sb < NSB; ++sb) {
            float yc[SB];
#pragma unroll
            for (int i = 0; i < SB; ++i) { L[i * 64 + lane] = zz[i]; yc[i] = yy[i]; }
            { const int nsb = sb + 1 < NSB ? sb + 1 : sb;
#pragma unroll
              for (int i = 0; i < SB; ++i) { zz[i] = gZ[(nsb * SB + i) * 64]; yy[i] = gY[(nsb * SB + i) * 64]; } }
#pragma unroll
            for (int i = 0; i < SB; ++i) {
                const float* Z = L + i * 64;
                f32x2 y0 = {yc[i], 0.f}, y1 = {0.f, 0.f};
#pragma unroll
                for (int k = 0; k < 32; k += 2) { const f32x4 z = *(const f32x4*)(Z + 2 * k); y0 += s[k] * z.lo; y1 += s[k + 1] * z.hi; }
                const int row = row_of(dir, j * RL + sb * SB + i);
                if (row >= 256) gO[(size_t)(row - 256) * 512] = f2bf((y0.x + y0.y) + (y1.x + y1.y));
            }
        }
    }
}

__device__ __forceinline__ void phase8(const Params& p, char* smem) {
    const int tid = tidx();
    bf16_t* LT = (bf16_t*)smem;
    constexpr int LTS = 136;
    for (int u = blockIdx.x; u < NCH * 4; u += gridDim.x) {
        const int upart = 2;
        const int c = u >> 2, hh = u & 3;
        const float g0 = sigm(p.ret_decay_logit[hh]), g1 = sigm(p.ret_decay_logit[4 + hh]);
        const float l0 = log2f(g0), l1 = log2f(g1);
        const int n = tid >> 2, part = tid & 3, half = part >> 1, fb = (part & 1) * 16;
        const int t = c * 128 + n;
        const bool lat = c >= 2;
        float pos = 0.f;
        if (lat) { const int tl = t - 256; pos = (float)(half == 0 ? (tl >> 6) : (tl & 63)); }
        const bf16_t* pr = p.proj + (size_t)t * INC;
        float cs[16], sn[16];
#pragma unroll
        for (int f = 0; f < 16; ++f) {
            if (lat) { const float inv = exp2f(-(float)(fb + f) * (13.287712379549449f / 32.f)); sincosf(pos * inv, &sn[f], &cs[f]); }
            else { cs[f] = 1.f; sn[f] = 0.f; }
        }
        const size_t ch = (size_t)(c * 4 + hh);
        if (upart != 1) {
            const int cb = 1792 + hh * 128 + half * 64 + fb;
            uint4 v1a = *(const uint4*)(pr + cb), v1b = *(const uint4*)(pr + cb + 8), v2a = *(const uint4*)(pr + cb + 32), v2b = *(const uint4*)(pr + cb + 40);
            bf16_t x1[16], x2[16];
            *(uint4*)&x1[0] = v1a; *(uint4*)&x1[8] = v1b; *(uint4*)&x2[0] = v2a; *(uint4*)&x2[8] = v2b;
            float o1[16], o2[16];
#pragma unroll
            for (int f = 0; f < 16; ++f) { const float a = bf2f(x1[f]), b = bf2f(x2[f]); o1[f] = a * cs[f] - b * sn[f]; o2[f] = a * sn[f] + b * cs[f]; }
            const float xf = exp2f(l0 * (float)(n + 1)), xb = exp2f(l1 * (float)(128 - n));
            bf16_t* qd = p.Qr + (ch * 128 + n) * 128 + half * 64 + fb;
            bf16_t* ad = p.A3 + (ch * 128 + n) * 384 + 128 + half * 64 + fb;
#pragma unroll
            for (int f = 0; f < 16; f += 2) {
                *(unsigned*)(qd + f) = pack2(o1[f], o1[f + 1]); *(unsigned*)(qd + 32 + f) = pack2(o2[f], o2[f + 1]);
                *(unsigned*)(ad + f) = pack2(o1[f] * xf, o1[f + 1] * xf); *(unsigned*)(ad + 32 + f) = pack2(o2[f] * xf, o2[f + 1] * xf);
                *(unsigned*)(ad + 128 + f) = pack2(o1[f] * xb, o1[f + 1] * xb); *(unsigned*)(ad + 128 + 32 + f) = pack2(o2[f] * xb, o2[f + 1] * xb);
            }
        }
        if (upart != 1) {
            const int cb = 2304 + hh * 128 + half * 64 + fb;
            uint4 v1a = *(const uint4*)(pr + cb), v1b = *(const uint4*)(pr + cb + 8), v2a = *(const uint4*)(pr + cb + 32), v2b = *(const uint4*)(pr + cb + 40);
            bf16_t x1[16], x2[16];
            *(uint4*)&x1[0] = v1a; *(uint4*)&x1[8] = v1b; *(uint4*)&x2[0] = v2a; *(uint4*)&x2[8] = v2b;
            const float sc = 0.08838834764831845f;
            bf16_t* kd = p.Kr + (ch * 128 + n) * 128 + half * 64 + fb;
            __syncthreads();
#pragma unroll
            for (int f = 0; f < 16; ++f) {
                const float a = bf2f(x1[f]) * sc, b = bf2f(x2[f]) * sc;
                const float o1 = a * cs[f] - b * sn[f], o2 = a * sn[f] + b * cs[f];
                const bf16_t h1 = f2bf(o1), h2 = f2bf(o2);
                kd[f] = h1; kd[32 + f] = h2;
                LT[(half * 64 + fb + f) * LTS + n] = h1; LT[(half * 64 + fb + f + 32) * LTS + n] = h2;
            }
            __syncthreads();
            const int d = tid >> 2, ms = (tid & 3) * 32;
#pragma unroll
            for (int dir = 0; dir < 2; ++dir) {
                bf16_t* od = p.KTz + ((ch * 2 + dir) * 128 + d) * 128 + ms;
#pragma unroll
                for (int m = 0; m < 32; m += 2) {
                    const int mm = ms + m;
                    const float z0 = dir == 0 ? exp2f(l0 * (float)(127 - mm)) : exp2f(l1 * (float)mm);
                    const float z1 = dir == 0 ? exp2f(l0 * (float)(126 - mm)) : exp2f(l1 * (float)(mm + 1));
                    *(unsigned*)(od + m) = pack2(bf2f(LT[d * LTS + mm]) * z0, bf2f(LT[d * LTS + mm + 1]) * z1);
                }
            }
        }
#pragma unroll 1
        for (int eh = (upart != 0 ? 0 : 2); eh < 2; ++eh) {
            __syncthreads();
            const int cb = 2816 + hh * 256 + eh * 128 + part * 32;
            bf16_t xv[32];
#pragma unroll
            for (int q = 0; q < 4; ++q) *(uint4*)&xv[q * 8] = *(const uint4*)(pr + cb + q * 8);
#pragma unroll
            for (int f = 0; f < 32; ++f) LT[(part * 32 + f) * LTS + n] = xv[f];
            __syncthreads();
            const int e = tid >> 2, ms = (tid & 3) * 32;
            bf16_t* od = p.B3 + (ch * 256 + eh * 128 + e) * 384 + ms;
#pragma unroll
            for (int m = 0; m < 32; m += 8) *(uint4*)(od + m) = *(const uint4*)(LT + e * LTS + ms + m);
        }
        __syncthreads();
    }
}

__device__ __forceinline__ void phase9(const Params& p, char* smem) {
    for (int u = blockIdx.x; u < 512 + 2080; u += gridDim.x) {
        if (u < 512) {
            const int c = 2 + (u >> 2), hh = u & 3;
            const size_t ch = (size_t)(c * 4 + hh);
            const float l0 = log2f(sigm(p.ret_decay_logit[hh])), l1 = log2f(sigm(p.ret_decay_logit[4 + hh]));
            APlain ap{p.Qr + ch * 128 * 128, 128}; BPlain bp{p.Kr + ch * 128 * 128, 128};
            bf16_t* outp = p.A3 + ch * 128 * 384;
            gemm_tile<128, 128, 4, 2>(ap, bp, 128, smem, [&](const auto& acc, int r0, int c0) {
#pragma unroll
                for (int mi = 0; mi < 2; ++mi)
#pragma unroll
                    for (int ni = 0; ni < 4; ++ni) {
                        const int n = r0 + mi * 16, m0 = c0 + ni * 16;
                        float o[4];
#pragma unroll
                        for (int j = 0; j < 4; ++j) {
                            const int m = m0 + j;
                            float w = 0.f;
                            if (n >= m) w += exp2f(l0 * (float)(n - m));
                            if (m >= n) w += exp2f(l1 * (float)(m - n));
                            o[j] = acc[mi][ni][j] * w;
                        }
                        uint2 ov; ov.x = pack2(o[0], o[1]); ov.y = pack2(o[2], o[3]);
                        *(uint2*)(outp + (size_t)n * 384 + m0) = ov;
                    }
            });
        } else {
            const int v = u - 512, mt = v & 1, dir = (v >> 1) & 1, chh = v >> 2;
            APlain ap{p.B3 + ((size_t)chh * 256 + mt * 128) * 384, 384}; BPlain bp{p.KTz + ((size_t)chh * 2 + dir) * 128 * 128, 128};
            float* outp = p.KVT + (((size_t)chh * 2 + dir) * 256 + mt * 128) * 128;
            gemm_tile<128, 128, 4, 2>(ap, bp, 128, smem, [&](const auto& acc, int r0, int c0) {
#pragma unroll
                for (int mi = 0; mi < 2; ++mi)
#pragma unroll
                    for (int ni = 0; ni < 4; ++ni) *(f32x4*)(outp + (size_t)(r0 + mi * 16) * 128 + c0 + ni * 16) = acc[mi][ni];
            });
        }
    }
}

__device__ __forceinline__ void phase10(const Params& p, char* smem) {
    for (int idx = blockIdx.x * NT + tidx(); idx < 131072; idx += gridDim.x * NT) {
        const int hh = idx >> 15, dir = (idx >> 14) & 1, e = (idx >> 6) & 255, d = (idx & 63) * 2;
        const float g = sigm(p.ret_decay_logit[dir * 4 + hh]);
        const float g128 = exp2f(128.f * log2f(g));
        float R0 = 0.f, R1 = 0.f;
        const float* kvb = p.KVT + ((size_t)(hh * 2 + dir) * 256 + e) * 128 + d;
        bf16_t* rtb = p.B3 + ((size_t)hh * 256 + e) * 384 + 128 + dir * 128 + d;
        for (int s0 = 0; s0 < NCH; s0 += 13) {
            float2 kv[13];
#pragma unroll
            for (int i = 0; i < 13; ++i) { const int sc = s0 + i, c = dir == 0 ? sc : (sc < 2 ? 1 - sc : 131 - sc); kv[i] = *(const float2*)(kvb + (size_t)c * 262144); }
#pragma unroll
            for (int i = 0; i < 13; ++i) {
                const int sc = s0 + i, c = dir == 0 ? sc : (sc < 2 ? 1 - sc : 131 - sc);
                if (c >= 2) *(unsigned*)(rtb + (size_t)c * 393216) = pack2(R0, R1);
                R0 = g128 * R0 + kv[i].x; R1 = g128 * R1 + kv[i].y;
            }
        }
    }
}

__device__ __forceinline__ void phase11(const Params& p, char* smem) {
    for (int u = blockIdx.x; u < 1024; u += gridDim.x) {
        const int nt = u & 1, chh = 8 + (u >> 1), c = chh >> 2, hh = chh & 3;
        APlain ap{p.A3 + (size_t)chh * 128 * 384, 384}; BPlain bp{p.B3 + ((size_t)chh * 256 + nt * 128) * 384, 384};
        float* outp = p.Y + (size_t)((c - 2) * 128) * 1024 + hh * 256 + nt * 128;
        gemm_tile<128, 128, 4, 2>(ap, bp, 384, smem, [&](const auto& acc, int r0, int c0) {
#pragma unroll
            for (int mi = 0; mi < 2; ++mi)
#pragma unroll
                for (int ni = 0; ni < 4; ++ni) *(f32x4*)(outp + (size_t)(r0 + mi * 16) * 1024 + c0 + ni * 16) = acc[mi][ni];
        });
    }
}

__device__ __forceinline__ void phase12(const Params& p, char* smem) {
    const int tid = tidx(), wave = tid >> 6, lane = tid & 63;
    const int gw = blockIdx.x * 8 + wave, nw = gridDim.x * 8;
    float lw[8], lb[8], rk[8];
#pragma unroll
    for (int q = 0; q < 8; ++q) { lw[q] = p.rwkv_ln_w[lane * 8 + q]; lb[q] = p.rwkv_ln_b[lane * 8 + q]; rk[q] = p.rwkv_r_k[lane * 8 + q]; }
    for (int t = gw; t < TX; t += nw) {
        const size_t te = (size_t)(t + 256) * 512 + lane * 8;
        const uint4 uof = *(const uint4*)(p.O + (size_t)t * 512 + lane * 8), uob = *(const uint4*)(p.O + ((size_t)TX + t) * 512 + lane * 8);
        const uint4 ur = *(const uint4*)(p.Rr + te), uk0 = *(const uint4*)(p.KD + te), uk1 = *(const uint4*)(p.KD + (size_t)TE * 512 + te), uv = *(const uint4*)(p.Vv + te), ug = *(const uint4*)(p.G + te);
        const float* yp = p.Y + (size_t)t * 1024 + lane * 16;
        const float4 y0 = *(const float4*)(yp), y1 = *(const float4*)(yp + 4), y2 = *(const float4*)(yp + 8), y3 = *(const float4*)(yp + 12);
        const bf16_t* gbp = p.proj + (size_t)(t + 256) * INC + 3840 + lane * 16;
        const uint4 ugb0 = *(const uint4*)(gbp), ugb1 = *(const uint4*)(gbp + 8);
        {
            float of[8], ob[8], r[8], k0[8], k1[8], v[8], gg[8], o[8];
            unpack8(uof, of); unpack8(uob, ob); unpack8(ur, r); unpack8(uk0, k0); unpack8(uk1, k1); unpack8(uv, v); unpack8(ug, gg);
            float sm = 0.f, bs = 0.f;
#pragma unroll
            for (int q = 0; q < 8; ++q) { o[q] = of[q] + ob[q]; sm += o[q]; bs += r[q] * (k0[q] + k1[q]) * rk[q]; }
            sm += __shfl_xor(sm, 1, 64); sm += __shfl_xor(sm, 2, 64); sm += __shfl_xor(sm, 4, 64);
            bs += __shfl_xor(bs, 1, 64); bs += __shfl_xor(bs, 2, 64); bs += __shfl_xor(bs, 4, 64);
            const float mu = sm * (1.f / 64.f);
            float vs = 0.f;
#pragma unroll
            for (int q = 0; q < 8; ++q) { o[q] -= mu; vs += o[q] * o[q]; }
            vs += __shfl_xor(vs, 1, 64); vs += __shfl_xor(vs, 2, 64); vs += __shfl_xor(vs, 4, 64);
            const float rs = rsqrtf(vs * (1.f / 64.f) + 64e-5f);
            float ya[8];
#pragma unroll
            for (int q = 0; q < 8; ++q) ya[q] = (o[q] * rs * lw[q] + lb[q] + bs * v[q]) * gg[q];
            *(uint4*)(p.ya_in + (size_t)t * 512 + lane * 8) = pack8(ya);
        }
        {
            float y[16] = {y0.x, y0.y, y0.z, y0.w, y1.x, y1.y, y1.z, y1.w, y2.x, y2.y, y2.z, y2.w, y3.x, y3.y, y3.z, y3.w};
            float sm = 0.f;
#pragma unroll
            for (int q = 0; q < 16; ++q) sm += y[q];
            sm += __shfl_xor(sm, 1, 64); sm += __shfl_xor(sm, 2, 64); sm += __shfl_xor(sm, 4, 64); sm += __shfl_xor(sm, 8, 64);
            const float mu = sm * (1.f / 256.f);
            float vs = 0.f;
#pragma unroll
            for (int q = 0; q < 16; ++q) { y[q] -= mu; vs += y[q] * y[q]; }
            vs += __shfl_xor(vs, 1, 64); vs += __shfl_xor(vs, 2, 64); vs += __shfl_xor(vs, 4, 64); vs += __shfl_xor(vs, 8, 64);
            const float rs = rsqrtf(vs * (1.f / 256.f) + 1e-5f);
            float gb[16]; { float t0[8], t1[8]; unpack8(ugb0, t0); unpack8(ugb1, t1);
#pragma unroll
                for (int q = 0; q < 8; ++q) { gb[q] = t0[q]; gb[8 + q] = t1[q]; } }
            float o0[8], o1[8];
#pragma unroll
            for (int q = 0; q < 16; ++q) {
                const int c = lane * 16 + q;
                const float ov = (y[q] * rs * p.ret_ln_w[c] + p.ret_ln_b[c]) * (gb[q] * sigm(gb[q]));
                if (q < 8) o0[q] = ov; else o1[q - 8] = ov;
            }
            bf16_t* d = p.yb_in + (size_t)t * 1024 + lane * 16;
            *(uint4*)d = pack8(o0); *(uint4*)(d + 8) = pack8(o1);
        }
    }
}

__device__ __forceinline__ void phase13(const Params& p, char* smem) {
    for (int u = blockIdx.x; u < 512; u += gridDim.x) {
        const int mt = u >> 2, nt = u & 3;
        f32x4 acca[4][4], accb[4][4];
#pragma unroll
        for (int mi = 0; mi < 4; ++mi)
#pragma unroll
            for (int ni = 0; ni < 4; ++ni) { acca[mi][ni] = (f32x4){0.f, 0.f, 0.f, 0.f}; accb[mi][ni] = (f32x4){0.f, 0.f, 0.f, 0.f}; }
        { APlain ap{p.ya_in + (size_t)mt * 128 * 512, 512}; BPlain bp{p.WaT + (size_t)nt * 256 * 512, 512};
          gemm_core<128, 256, 2, 4>(acca, ap, bp, 512, smem); }
        { APlain ap{p.yb_in + (size_t)mt * 128 * 1024, 1024}; BPlain bp{p.WbT + (size_t)nt * 256 * 1024, 1024};
          gemm_core<128, 256, 2, 4>(accb, ap, bp, 1024, smem); }
        const int wave = tidx() >> 6, lane = tidx() & 63;
        const int r0 = (wave >> 2) * 64 + (lane & 15), c0 = (wave & 3) * 64 + (lane >> 4) * 4;
#pragma unroll
        for (int mi = 0; mi < 4; ++mi)
#pragma unroll
            for (int ni = 0; ni < 4; ++ni) {
                const int t = mt * 128 + r0 + mi * 16, c = nt * 256 + c0 + ni * 16;
                const bf16_t* gp = p.proj + (size_t)(t + 256) * INC + c;
                const uint2 ga = *(const uint2*)(gp + 4864), gb = *(const uint2*)(gp + 5888);
                float o[4];
                o[0] = sigm(__uint_as_float(ga.x << 16)) * acca[mi][ni][0] + sigm(__uint_as_float(gb.x << 16)) * accb[mi][ni][0];
                o[1] = sigm(__uint_as_float(ga.x & 0xffff0000u)) * acca[mi][ni][1] + sigm(__uint_as_float(gb.x & 0xffff0000u)) * accb[mi][ni][1];
                o[2] = sigm(__uint_as_float(ga.y << 16)) * acca[mi][ni][2] + sigm(__uint_as_float(gb.y << 16)) * accb[mi][ni][2];
                o[3] = sigm(__uint_as_float(ga.y & 0xffff0000u)) * acca[mi][ni][3] + sigm(__uint_as_float(gb.y & 0xffff0000u)) * accb[mi][ni][3];
                uint2 ov; ov.x = pack2(o[0], o[1]); ov.y = pack2(o[2], o[3]);
                *(uint2*)(p.merged + (size_t)t * 1024 + c) = ov;
            }
    }
}
__device__ __forceinline__ void phase14(const Params& p, char* smem) {
    g8::StaticOrder S; S.init(TX, 1024, gridDim.x, blockIdx.x);
    g8::EpiF32 E{p.mix, 1024};
    g8::gemm_phase((LAS unsigned char*)smem, p.merged, p.WoT, 1024, 1024, 1024, S, E);
}

__device__ __forceinline__ void phase15(const Params& p, char* smem) {
    const int tid = tidx(), wave = tid >> 6, lane = tid & 63;
    const int gw = blockIdx.x * 8 + wave, nw = gridDim.x * 8;
    const float* g1 = p.mod + 2048; const float* sh2 = p.mod + 3072; const float* sc2 = p.mod + 4096;
    for (int t = gw; t < TX; t += nw) {
        float4 mv[4], xm[4]; float ss = 0.f;
#pragma unroll
        for (int i = 0; i < 4; ++i) { mv[i] = *(const float4*)(p.mix + (size_t)t * 1024 + i * 256 + lane * 4); ss += mv[i].x * mv[i].x + mv[i].y * mv[i].y + mv[i].z * mv[i].z + mv[i].w * mv[i].w; }
        ss = wsum(ss);
        const float rs = rsqrtf(ss * (1.f / 1024.f) + 1e-6f);
        float s2 = 0.f;
#pragma unroll
        for (int i = 0; i < 4; ++i) {
            const int col = i * 256 + lane * 4;
            const float4 xv = *(const float4*)(p.x + (size_t)t * 1024 + col);
            const float4 gn = *(const float4*)(p.n_post_mix + col), gg = *(const float4*)(g1 + col);
            xm[i].x = xv.x + gg.x * (mv[i].x * rs * gn.x); xm[i].y = xv.y + gg.y * (mv[i].y * rs * gn.y);
            xm[i].z = xv.z + gg.z * (mv[i].z * rs * gn.z); xm[i].w = xv.w + gg.w * (mv[i].w * rs * gn.w);
            *(float4*)(p.x_mid + (size_t)t * 1024 + col) = xm[i];
            s2 += xm[i].x * xm[i].x + xm[i].y * xm[i].y + xm[i].z * xm[i].z + xm[i].w * xm[i].w;
        }
        s2 = wsum(s2);
        const float rs2 = rsqrtf(s2 * (1.f / 1024.f) + 1e-6f);
#pragma unroll
        for (int i = 0; i < 4; ++i) {
            const int col = i * 256 + lane * 4;
            const float4 gn = *(const float4*)(p.n_pre_ffn + col), sc = *(const float4*)(sc2 + col), sh = *(const float4*)(sh2 + col);
            float h[4];
            h[0] = xm[i].x * rs2 * gn.x * (1.f + sc.x) + sh.x; h[1] = xm[i].y * rs2 * gn.y * (1.f + sc.y) + sh.y;
            h[2] = xm[i].z * rs2 * gn.z * (1.f + sc.z) + sh.z; h[3] = xm[i].w * rs2 * gn.w * (1.f + sc.w) + sh.w;
            uint2 hi; hi.x = pack2(h[0], h[1]); hi.y = pack2(h[2], h[3]);
            *(uint2*)(p.Ahl + (size_t)t * 1024 + col) = hi;
        }
    }
}

__device__ __forceinline__ void phase16(const Params& p, char* smem) {
    for (int u = blockIdx.x; u < 256; u += gridDim.x) {
        const int mt = u >> 1, nt = u & 1;
        APlain ap{p.Ahl + (size_t)mt * 128 * 1024, 1024}; BPlain bp{p.RtT + (size_t)nt * 128 * 1024, 1024};
        float* outp = p.logits + (size_t)mt * 128 * 256 + nt * 128;
        gemm_tile<128, 128, 4, 2>(ap, bp, 1024, smem, [&](const auto& acc, int r0, int c0) {
#pragma unroll
            for (int mi = 0; mi < 2; ++mi)
#pragma unroll
                for (int ni = 0; ni < 4; ++ni) *(f32x4*)(outp + (size_t)(r0 + mi * 16) * 256 + c0 + ni * 16) = acc[mi][ni];
        });
    }
}

__device__ __forceinline__ void phase17(const Params& p, char* smem) {
    const int tid = tidx(), wave = tid >> 6, lane = tid & 63;
    int* hist = (int*)smem;
    if (tid < 256) hist[tid] = 0;
    __syncthreads();
    const int TPB = TX / gridDim.x;
    for (int ti = wave; ti < TPB; ti += 8) {
        const int t = blockIdx.x * TPB + ti;
        float sc[4], key[4];
#pragma unroll
        for (int i = 0; i < 4; ++i) { const int e = lane + 64 * i; sc[i] = sigm(p.logits[(size_t)t * 256 + e]); key[i] = sc[i] + p.router_bias[e]; }
        float mys = 0.f; int mye = 0; float ssum = 0.f;
#pragma unroll 1
        for (int k = 0; k < 8; ++k) {
            float bv = -1e30f; int be = 1 << 20;
#pragma unroll
            for (int i = 0; i < 4; ++i) if (key[i] > bv) { bv = key[i]; be = lane + 64 * i; }
#pragma unroll
            for (int o = 32; o; o >>= 1) {
                const float ov = __shfl_xor(bv, o, 64); const int oe = __shfl_xor(be, o, 64);
                if (ov > bv || (ov == bv && oe < be)) { bv = ov; be = oe; }
            }
            float sv = 0.f;
            if ((be & 63) == lane) {
#pragma unroll
                for (int i = 0; i < 4; ++i) if ((be >> 6) == i) { sv = sc[i]; key[i] = -1e30f; }
            }
            sv = __shfl(sv, be & 63, 64);
            ssum += sv;
            if (lane == k) { mys = sv; mye = be; }
        }
        if (lane < 8) {
            const int pos = atomicAdd(&hist[mye], 1);
            p.tok_e[t * 8 + lane] = mye; p.tok_pos[t * 8 + lane] = pos; p.tok_w[t * 8 + lane] = mys / ssum * 2.5f;
        }
    }
    __syncthreads();
    if (tid < 256) p.bh[blockIdx.x * 256 + tid] = hist[tid];
}

__device__ __forceinline__ void phase18(const Params& p, char* smem) {
    const int tid = tidx();
    int* ps = (int*)smem;
    int* xs = ps + 260;
    int* cntL = xs + 260;
    int* baseL = cntL + 256;
    int* part = baseL + 256;
    {
        const int e = tid & 255, half = tid >> 8, G = gridDim.x, b0 = half * (G >> 1), b1 = b0 + (G >> 1);
        int tot = 0, bef = 0;
        for (int bb = b0; bb < b1; bb += 16) {
            int v[16];
#pragma unroll
            for (int i = 0; i < 16; ++i) v[i] = p.bh[(bb + i) * 256 + e];
#pragma unroll
            for (int i = 0; i < 16; ++i) { tot += v[i]; bef += (bb + i < (int)blockIdx.x) ? v[i] : 0; }
        }
        part[half * 256 + e] = tot; part[512 + half * 256 + e] = bef;
    }
    __syncthreads();
    if (tid < 256) { cntL[tid] = part[tid] + part[256 + tid]; baseL[tid] = part[512 + tid] + part[768 + tid]; }
    __syncthreads();
    if (tid < 64) {
        int c[4], tot = 0, ttot = 0;
#pragma unroll
        for (int q = 0; q < 4; ++q) { c[q] = cntL[tid * 4 + q]; tot += c[q]; ttot += (c[q] + 255) >> 8; }
        int incl = tot, tincl = ttot;
#pragma unroll
        for (int o = 1; o < 64; o <<= 1) { const int v = __shfl_up(incl, o, 64), tv = __shfl_up(tincl, o, 64); if (tid >= o) { incl += v; tincl += tv; } }
        int ex = incl - tot, tex = tincl - ttot;
#pragma unroll
        for (int q = 0; q < 4; ++q) { ps[tid * 4 + q] = ex; xs[tid * 4 + q] = tex; ex += c[q]; tex += (c[q] + 255) >> 8; }
        if (tid == 63) { ps[256] = incl; xs[256] = tincl; }
    }
    __syncthreads();
    if (blockIdx.x == 0) {
        const int nx = xs[256];
        if (tid == 0) *p.ntiles = nx + 64;
        for (int e = tid; e < 256; e += NT) {
            const int c = ps[e + 1] - ps[e];
            for (int t = 0; t < ((c + 255) >> 8); ++t) { int* x = p.xt + (xs[e] + t) * 4; x[0] = e; x[1] = ps[e] + 256 * t; x[2] = min(256, c - 256 * t); x[3] = 0; }
        }
        if (tid < 64) { int* x = p.xt + (nx + tid) * 4; x[0] = 256; x[1] = 131072 + 256 * tid; x[2] = 256; x[3] = 0; }
        if (tid < 256) p.slot_tk[NSLOT + tid] = 0;
    }
    const int TPB = TX / gridDim.x;
    for (int li = tid; li < TPB * 8; li += NT) {
        const int i = blockIdx.x * TPB * 8 + li, e = p.tok_e[i];
        p.slot_tk[ps[e] + baseL[e] + p.tok_pos[i]] = (i >> 3) * 9 + (i & 7);
    }
    for (int t = blockIdx.x * NT + tid; t < TX; t += gridDim.x * NT) p.slot_tk[131072 + t] = t * 9 + 8;
}

__device__ __forceinline__ void phase19(const Params& p, char* smem) {
    const int nun = *p.ntiles * 2;
    const int lb = (blockIdx.x & 7) * (gridDim.x >> 3) + (blockIdx.x >> 3);
    for (int u = lb; u < nun; u += gridDim.x) {
        const int* x = p.xt + (u >> 1) * 4; const int nt = u & 1;
        const int e = x[0], row0 = x[1], nrows = x[2];
        const float* wg = (e < 256 ? p.exp_w_gate + (size_t)e * 262144 : p.sh_w_gate) + nt * 128;
        const float* wu = (e < 256 ? p.exp_w_up + (size_t)e * 262144 : p.sh_w_up) + nt * 128;
        AGather ap{p.Ahl, 1024, p.slot_tk + row0};
        BKNGU bp{wg, wu};
        bf16_t* outp = p.act + (size_t)row0 * 256 + nt * 128;
        gemm_tile<256, 256, 2, 4>(ap, bp, 1024, smem, [&](const auto& acc, int r0, int c0) {
#pragma unroll
            for (int mi = 0; mi < 8; ++mi) {
                if (r0 + mi * 16 < nrows) {
#pragma unroll
                    for (int gp = 0; gp < 2; ++gp) {
                        const int g = (c0 >> 5) + gp, fq4 = c0 & 15;
                        float o[4];
#pragma unroll
                        for (int j = 0; j < 4; ++j) { const float gt = acc[mi][gp * 2][j], up = acc[mi][gp * 2 + 1][j]; o[j] = gt * sigm(gt) * up; }
                        uint2 ov; ov.x = pack2(o[0], o[1]); ov.y = pack2(o[2], o[3]);
                        *(uint2*)(outp + (size_t)(r0 + mi * 16) * 256 + g * 16 + fq4) = ov;
                    }
                }
            }
        });
    }
}

__device__ __forceinline__ void phase20(const Params& p, char* smem) {
    const int nun = *p.ntiles * 4;
    const int lb = (blockIdx.x & 7) * (gridDim.x >> 3) + (blockIdx.x >> 3);
    for (int u = lb; u < nun; u += gridDim.x) {
        const int* x = p.xt + (u >> 2) * 4; const int nt = u & 3;
        const int e = x[0], row0 = x[1], nrows = x[2];
        APlain ap{p.act + (size_t)row0 * 256, 256};
        BKN bp{(e < 256 ? p.exp_w_down + (size_t)e * 262144 : p.sh_w_down) + nt * 256, 1024};
        const int* stk = p.slot_tk + row0;
        gemm_tile<256, 256, 2, 4>(ap, bp, 256, smem, [&](const auto& acc, int r0, int c0) {
#pragma unroll
            for (int mi = 0; mi < 8; ++mi) {
                const int r = r0 + mi * 16;
                if (r < nrows) {
                    bf16_t* d = p.yk + (size_t)stk[r] * 1024 + nt * 256 + c0;
#pragma unroll
                    for (int ni = 0; ni < 4; ++ni) {
                        uint2 ov; ov.x = pack2(acc[mi][ni][0], acc[mi][ni][1]); ov.y = pack2(acc[mi][ni][2], acc[mi][ni][3]);
                        *(uint2*)(d + ni * 16) = ov;
                    }
                }
            }
        });
    }
}

__device__ __forceinline__ void phase21(const Params& p, char* smem) {
    const int tid = tidx(), wave = tid >> 6, lane = tid & 63;
    const int gw = blockIdx.x * 8 + wave, nw = gridDim.x * 8;
    const float* g2 = p.mod + 5120;
    for (int t = gw; t < TX; t += nw) {
        float w[9];
#pragma unroll
        for (int k = 0; k < 8; ++k) w[k] = p.tok_w[t * 8 + k];
        w[8] = 1.f;
        float4 mo[4]; float ss = 0.f;
#pragma unroll
        for (int i = 0; i < 4; ++i) {
            const int col = i * 256 + lane * 4;
            float a0 = 0.f, a1 = 0.f, a2 = 0.f, a3 = 0.f;
#pragma unroll
            for (int k = 0; k < 9; ++k) {
                const uint2 v = *(const uint2*)(p.yk + ((size_t)t * 9 + k) * 1024 + col);
                a0 += w[k] * __uint_as_float(v.x << 16); a1 += w[k] * __uint_as_float(v.x & 0xffff0000u); a2 += w[k] * __uint_as_float(v.y << 16); a3 += w[k] * __uint_as_float(v.y & 0xffff0000u);
            }
            mo[i] = make_float4(a0, a1, a2, a3);
            ss += a0 * a0 + a1 * a1 + a2 * a2 + a3 * a3;
        }
        ss = wsum(ss);
        const float rs = rsqrtf(ss * (1.f / 1024.f) + 1e-6f);
#pragma unroll
        for (int i = 0; i < 4; ++i) {
            const int col = i * 256 + lane * 4;
            const float4 xm = *(const float4*)(p.x_mid + (size_t)t * 1024 + col);
            const float4 gn = *(const float4*)(p.n_post_ffn + col), gg = *(const float4*)(g2 + col);
            float4 o;
            o.x = xm.x + gg.x * (mo[i].x * rs * gn.x); o.y = xm.y + gg.y * (mo[i].y * rs * gn.y);
            o.z = xm.z + gg.z * (mo[i].z * rs * gn.z); o.w = xm.w + gg.w * (mo[i].w * rs * gn.w);
            *(float4*)(p.out + (size_t)t * 1024 + col) = o;
        }
    }
}

constexpr int NPHASE = 22;
template <int PH> __device__ __forceinline__ void run_phase(const Params& p, char* smem) {
    if constexpr (PH == 0) phase0(p, smem);
    else if constexpr (PH == 1) phase1(p, smem);
    else if constexpr (PH == 2) phase2(p, smem);
    else if constexpr (PH == 3) phase3(p, smem);
    else if constexpr (PH == 4) phase4(p, smem);
    else if constexpr (PH == 5) phase5(p, smem);
    else if constexpr (PH == 6) phase6(p, smem);
    else if constexpr (PH == 7) phase7(p, smem);
    else if constexpr (PH == 8) phase8(p, smem);
    else if constexpr (PH == 9) phase9(p, smem);
    else if constexpr (PH == 10) phase10(p, smem);
    else if constexpr (PH == 11) phase11(p, smem);
    else if constexpr (PH == 12) phase12(p, smem);
    else if constexpr (PH == 13) phase13(p, smem);
    else if constexpr (PH == 14) phase14(p, smem);
    else if constexpr (PH == 15) phase15(p, smem);
    else if constexpr (PH == 16) phase16(p, smem);
    else if constexpr (PH == 17) phase17(p, smem);
    else if constexpr (PH == 18) phase18(p, smem);
    else if constexpr (PH == 19) phase19(p, smem);
    else if constexpr (PH == 20) phase20(p, smem);
    else phase21(p, smem);
}

template <int PH> __global__ void __launch_bounds__(NT, 2) k_phase(Params p) {
    extern __shared__ __attribute__((aligned(16))) char smem[];
    run_phase<PH>(p, smem);
}

template <int PH> __device__ __forceinline__ void mega_run(const Params& p, char* smem, const XcdBarrier& bar) {
    run_phase<PH>(p, smem);
    if constexpr (((PROBE_MASK) >> PH) & 1u) { xcd_barrier(bar); run_phase<PH>(p, smem); }
    if constexpr (PH + 1 < NPHASE) { xcd_barrier(bar); mega_run<PH + 1>(p, smem, bar); }
}
__global__ void __launch_bounds__(NT, 2) k_mega(Params p) {
    extern __shared__ __attribute__((aligned(16))) char smem[];
    uint4* xbw = (uint4*)(smem + 8 * TILE_BYTES);
    if (tidx() == 0) *xbw = make_uint4(0u, 0u, 0u, 0u);
    __syncthreads();
    XcdBarrier bar = xcd_barrier_post(p.bar, (volatile LAS unsigned*)xbw);
    mega_run<0>(p, smem, bar);
}

template <int PH> static void launch_phases(const Params& p, int grid, hipStream_t stream) {
    static bool attr = false;
    if (!attr) { (void)hipFuncSetAttribute((const void*)k_phase<PH>, hipFuncAttributeMaxDynamicSharedMemorySize, LDS_BYTES); attr = true; }
    hipLaunchKernelGGL(k_phase<PH>, dim3(grid), dim3(NT), LDS_BYTES, stream, p);
    if constexpr (PH + 1 < NPHASE) launch_phases<PH + 1>(p, grid, stream);
}

extern "C" void kernel_launch(void* const* d_in, const int* in_sizes, int n_in, void* d_out, int out_size, void* d_ws, size_t ws_size, hipStream_t stream) {
    static int grid = 0;
    if (grid == 0) {
        int dev = 0, cus = 0, per_cu = 0;
        (void)hipGetDevice(&dev); (void)hipDeviceGetAttribute(&cus, hipDeviceAttributeMultiprocessorCount, dev);
        (void)hipFuncSetAttribute((const void*)k_mega, hipFuncAttributeMaxDynamicSharedMemorySize, LDS_BYTES);
        (void)hipOccupancyMaxActiveBlocksPerMultiprocessor(&per_cu, (const void*)k_mega, NT, LDS_BYTES);
        (void)hipGetLastError();
        if (cus <= 0) cus = 256;
        grid = cus * (per_cu >= 2 ? 2 : 1);
    }
    Params p{};
    const float** pin = (const float**)&p.x;
    for (int i = 0; i < 36; ++i) pin[i] = (const float*)d_in[i];
    p.out = (float*)d_out;
    char* ws = (char*)d_ws; size_t off = 0;
    auto alloc = [&](size_t bytes) { size_t o = off; off += (bytes + 255) & ~(size_t)255; return ws + o; };
    p.bar = (unsigned*)alloc(XCD_BAR_WORDS * 4); p.cnt = (int*)alloc(256 * 4);
    const size_t zero_bytes = off;
    p.slot_tk = (int*)alloc((size_t)(NSLOT + 256) * 4); p.bh = (int*)alloc(1024 * 256 * 4);
    p.xt = (int*)alloc(NXT_MAX * 16); p.ntiles = (int*)alloc(256);
    p.tok_e = (int*)alloc((size_t)TX * 8 * 4); p.tok_pos = (int*)alloc((size_t)TX * 8 * 4); p.tok_w = (float*)alloc((size_t)TX * 8 * 4);
    p.modp = (float*)alloc(16 * 2 * 6144 * 4); p.mod = (float*)alloc(2 * 6144 * 4);
    p.WinT = (bf16_t*)alloc((size_t)INC * 1024 * 2); p.WaT = (bf16_t*)alloc(1024 * 512 * 2); p.WbT = (bf16_t*)alloc(1024 * 1024 * 2); p.WoT = (bf16_t*)alloc(1024 * 1024 * 2);
    p.RtT = (bf16_t*)alloc(256 * 3072 * 2); p.ShGU = (bf16_t*)alloc(512 * 1024 * 2); p.ShD = (bf16_t*)alloc(1024 * 256 * 2);
    p.WupT = (bf16_t*)alloc(1024 * 64 * 2); p.AupT = (bf16_t*)alloc(1024 * 64 * 2); p.GupT = (bf16_t*)alloc(512 * 128 * 2);
    p.ya_in = (bf16_t*)alloc((size_t)TX * 512 * 2); p.yb_in = (bf16_t*)alloc((size_t)TX * 1024 * 2);
    char* RA = alloc((size_t)TE * INC * 2);
    p.proj = (bf16_t*)RA;
    { size_t o = 0; auto sub = [&](size_t b) { char* r = RA + o; o += (b + 255) & ~(size_t)255; return r; };
      p.act = (bf16_t*)sub(((size_t)NSLOT + 256) * 256 * 2); p.logits = (float*)sub((size_t)TX * 256 * 4); }
    const size_t surv = (size_t)TE * 512 * 2 * 5 + (size_t)2 * TX * 512 * 2 + 4096;
    const size_t rtmp = 424935424 + 65536;
    char* RB = alloc(surv + rtmp);
    { size_t o = 0; auto sub = [&](size_t b) { char* r = RB + o; o += (b + 255) & ~(size_t)255; return r; };
      p.Rr = (bf16_t*)sub((size_t)TE * 512 * 2); p.Vv = (bf16_t*)sub((size_t)TE * 512 * 2); p.KD = (bf16_t*)sub((size_t)2 * TE * 512 * 2); p.G = (bf16_t*)sub((size_t)TE * 512 * 2);
      p.O = (bf16_t*)sub((size_t)2 * TX * 512 * 2);
      const size_t o_t = o;
      p.Kk = (bf16_t*)sub((size_t)TE * 512 * 2); p.Aa = (bf16_t*)sub((size_t)TE * 512 * 2); p.Bd = (bf16_t*)sub((size_t)2 * TE * 512 * 2);
      p.Wd = (float*)sub((size_t)2 * TE * 512 * 4); p.TW = (bf16_t*)sub((size_t)TE * 64 * 2); p.XA = (bf16_t*)sub((size_t)TE * 64 * 2); p.SG = (bf16_t*)sub((size_t)TE * 128 * 2);
      p.PH = (float*)sub((size_t)127 * 16 * 2 * 4096 * 4); p.Sst = (float*)sub((size_t)128 * 16 * 4096 * 4);
      p.Zz = (float*)sub((size_t)RNC * 16 * RL * 64 * 4); p.YH = (float*)sub((size_t)RNC * 16 * RL * 64 * 4);
      p.hn = (bf16_t*)p.PH;
      o = o_t;
      p.Qr = (bf16_t*)sub((size_t)NCH * 4 * 128 * 128 * 2); p.Kr = (bf16_t*)sub((size_t)NCH * 4 * 128 * 128 * 2); p.KTz = (bf16_t*)sub((size_t)NCH * 4 * 2 * 128 * 128 * 2);
      p.A3 = (bf16_t*)sub((size_t)NCH * 4 * 128 * 384 * 2); p.B3 = (bf16_t*)sub((size_t)NCH * 4 * 256 * 384 * 2);
      p.KVT = (float*)sub((size_t)NCH * 4 * 2 * 256 * 128 * 4); p.Y = (float*)sub((size_t)TX * 1024 * 4);
      o = 0;
      p.x_mid = (float*)sub((size_t)TX * 1024 * 4); p.Ahl = (bf16_t*)sub((size_t)TX * 1024 * 2);
      p.yk = (bf16_t*)sub((size_t)TX * 9 * 1024 * 2);
      char* yk0 = (char*)p.yk; p.mergedA = (float*)yk0; p.merged = (bf16_t*)(yk0 + (size_t)TX * 1024 * 4); p.mix = (float*)(yk0 + (size_t)TX * 1024 * 6);
    }
    if (off > ws_size) { fprintf(stderr, "kernel_launch: workspace too small: need %zu have %zu\n", off, ws_size); return; }
    int j = 0;
    p.jobs[j++] = TJob{p.w_in, p.WinT, 1024, INC, 1024, 0, 0, 0};
    p.jobs[j++] = TJob{p.w_branch_a, p.WaT, 512, 1024, 512, 0, 0, 0};
    p.jobs[j++] = TJob{p.w_branch_b, p.WbT, 1024, 1024, 1024, 0, 0, 0};
    p.jobs[j++] = TJob{p.w_out, p.WoT, 1024, 1024, 1024, 0, 0, 0};
    p.jobs[j++] = TJob{p.router_w, p.RtT, 1024, 256, 1024, 0, 0, 0};
    p.jobs[j++] = TJob{p.rwkv_g_up, p.GupT, 0, 0, 128, 0, 0, 0};
    p.jobs[j++] = TJob{p.rwkv_g_up, p.GupT, 0, 0, 128, 0, 0, 0};
    p.jobs[j++] = TJob{p.rwkv_g_up, p.GupT, 0, 0, 128, 0, 0, 0};
    p.jobs[j++] = TJob{p.rwkv_w_up, p.WupT, 64, 512, 64, 0, 0, 0};
    p.jobs[j++] = TJob{p.rwkv_w_up + 64 * 512, p.WupT, 64, 512, 64, 0, 512, 0};
    p.jobs[j++] = TJob{p.rwkv_a_up, p.AupT, 64, 512, 64, 0, 0, 0};
    p.jobs[j++] = TJob{p.rwkv_a_up + 64 * 512, p.AupT, 64, 512, 64, 0, 512, 0};
    p.jobs[j++] = TJob{p.rwkv_g_up, p.GupT, 128, 512, 128, 0, 0, 0};
    p.jobs[j++] = TJob{p.rwkv_g_up, p.GupT, 0, 0, 128, 0, 0, 0};
    (void)hipMemsetAsync(ws, 0, zero_bytes, stream);
#if MK_ONE_LAUNCH
    hipLaunchKernelGGL(k_mega, dim3(grid), dim3(NT), LDS_BYTES, stream, p);
#else
    launch_phases<0>(p, grid, stream);
#endif
}
```

```cpp
#include <hip/hip_runtime.h>
#include <stdint.h>
#include <stdio.h>

#ifndef MK_ONE_LAUNCH
#define MK_ONE_LAUNCH 1
#endif
#ifndef ROUTER_K
#define ROUTER_K 1024
#endif
#ifndef PROBE_MASK
#define PROBE_MASK 0u
#endif

typedef unsigned short bf16_t;
typedef short bf16x8 __attribute__((ext_vector_type(8)));
typedef float f32x4 __attribute__((ext_vector_type(4)));
typedef float f32x2 __attribute__((ext_vector_type(2)));

#define NT 512
constexpr int TX = 16384, TC = 256, TE = 16640, DM = 1024, INC = 6912;
constexpr int NCH = 130;
constexpr int RL = 130, RNC = 128;
constexpr int TSTR = 144;
constexpr int TILE_BYTES = 128 * TSTR;
constexpr int LDS_BYTES = 8 * TILE_BYTES + 1024;
constexpr int NSLOT = 131072 + 16384;
constexpr int NXT_MAX = 768 + 64;

#define XB_TMO      128
#define XB_XCNT(j)  (256  + 64 * (j))
#define XB_XSUB(j)  (1280 + 64 * (j))
#define XB_XGEN(j)  (2304 + 64 * (j))
#define XB_TOP      3328
#define XB_TOPGEN   3392
#define XCD_BAR_WORDS 3456
#define XB_SPIN_CAP (1u << 18)
#define LAS __attribute__((address_space(3)))

__device__ __forceinline__ unsigned xb_ld(unsigned* p)              { return __hip_atomic_load(p, __ATOMIC_RELAXED, __HIP_MEMORY_SCOPE_AGENT); }
__device__ __forceinline__ unsigned xb_add(unsigned* p, unsigned v) { return __hip_atomic_fetch_add(p, v, __ATOMIC_RELAXED, __HIP_MEMORY_SCOPE_AGENT); }
__device__ __forceinline__ unsigned xb_xcc_id() { return (unsigned)__builtin_amdgcn_s_getreg((3 << 11) | 20) & 0xFu; }
#define XB_SPIN(cond, bar) do { unsigned _sp = 0; while (cond) { __builtin_amdgcn_s_sleep(1); \
    if ((++_sp & 255u) == 0u) { if (xb_ld(&(bar)[XB_TMO])) break; if (_sp > XB_SPIN_CAP) { atomicAdd(&(bar)[XB_TMO], 1u); break; } } } } while (0)

struct XcdBarrier { unsigned* bar; unsigned x; volatile LAS unsigned* st; };

__device__ __forceinline__ XcdBarrier xcd_barrier_post(unsigned* bar, volatile LAS unsigned* st) {
    XcdBarrier b; b.bar = bar; b.x = xb_xcc_id(); b.st = st;
    if (threadIdx.x == 0) (void)xb_add(&bar[XB_XCNT(b.x)], 1u);
    return b;
}
__device__ __forceinline__ void xcd_barrier_complete(unsigned* bar, unsigned x, unsigned& nloc, unsigned& nx) {
    const unsigned G = gridDim.x * gridDim.y * gridDim.z;
    unsigned sum, cnt, mine, sp = 0u;
    for (;;) {
        sum = 0u; cnt = 0u; mine = 0u;
#pragma unroll
        for (unsigned j = 0; j < 16; ++j) { const unsigned c = xb_ld(&bar[XB_XCNT(j)]); sum += c; cnt += (c > 0u) ? 1u : 0u; mine = (j == x) ? c : mine; }
        if (sum == G) break;
        __builtin_amdgcn_s_sleep(1);
        if ((++sp & 255u) == 0u) { if (xb_ld(&bar[XB_TMO])) break; if (sp > XB_SPIN_CAP) { atomicAdd(&bar[XB_TMO], 1u); break; } }
    }
    nloc = mine > 0u ? mine : 1u; nx = cnt > 0u ? cnt : 1u;
}
__device__ __forceinline__ void xcd_barrier(const XcdBarrier& b) {
    asm volatile("s_waitcnt vmcnt(0)" ::: "memory");
    __syncthreads();
    if (threadIdx.x == 0) {
        unsigned* bar = b.bar;
        __builtin_amdgcn_s_waitcnt(0);
        unsigned nloc = b.st[0], nx = b.st[1];
        if (nloc == 0u) { xcd_barrier_complete(bar, b.x, nloc, nx); b.st[0] = nloc; b.st[1] = nx; }
        const unsigned old = xb_add(&bar[XB_XSUB(b.x)], 1u);
        const unsigned gen = old / nloc;
        if (old + 1u == (gen + 1u) * nloc) {
            __builtin_amdgcn_fence(__ATOMIC_RELEASE, "agent");
            asm volatile("s_waitcnt vmcnt(0)" ::: "memory");
            const unsigned og = xb_add(&bar[XB_TOP], 1u);
            const unsigned tg = og / nx;
            if (og + 1u == (tg + 1u) * nx) xb_add(&bar[XB_TOPGEN], 1u);
            else XB_SPIN(xb_ld(&bar[XB_TOPGEN]) == tg, bar);
            __builtin_amdgcn_fence(__ATOMIC_ACQUIRE, "agent");
            xb_add(&bar[XB_XGEN(b.x)], 1u);
            asm volatile("s_waitcnt vmcnt(0)" ::: "memory");
        } else {
            XB_SPIN(xb_ld(&bar[XB_XGEN(b.x)]) == gen, bar);
            __builtin_amdgcn_fence(__ATOMIC_ACQUIRE, "agent");
            asm volatile("s_waitcnt vmcnt(0)" ::: "memory");
        }
    }
    __syncthreads();
}

struct TJob { const float* src; bf16_t* dst; int K, N, dld, mode, rowoff, coloff; };
constexpr int NJOB = 14;

struct Params {
    const float *x, *c, *ctx, *c_ctx, *w_mod, *b_mod, *n_pre_mix, *n_post_mix, *n_pre_ffn, *n_post_ffn,
        *w_in, *shift_mu, *rwkv_w0, *rwkv_w_up, *rwkv_a0, *rwkv_a_up, *rwkv_g_up, *rwkv_k_k, *rwkv_k_a, *rwkv_r_k,
        *rwkv_ln_w, *rwkv_ln_b, *w_branch_a, *ret_decay_logit, *ret_ln_w, *ret_ln_b, *w_branch_b, *w_out,
        *router_w, *router_bias, *exp_w_gate, *exp_w_up, *exp_w_down, *sh_w_gate, *sh_w_up, *sh_w_down;
    float* out;
    unsigned* bar; int* cnt; int* bh; int* slot_tk; int* xt; int* ntiles; int* tok_e; int* tok_pos; float* tok_w;
    float* modp; float* mod;
    bf16_t *WinT, *WaT, *WbT, *WoT, *RtT, *ShGU, *ShD, *WupT, *AupT, *GupT;
    bf16_t *hn, *proj;
    bf16_t *Rr, *Vv, *KD, *G, *O;
    bf16_t *Kk, *Aa, *Bd, *TW, *XA, *SG;
    float *Wd, *PH, *Sst, *Zz, *YH;
    bf16_t *Qr, *Kr, *KTz, *A3, *B3;
    float *KVT, *Y;
    bf16_t *ya_in, *yb_in, *merged, *Ahl, *act, *yk;
    float *mergedA, *mix, *x_mid, *logits;
    TJob jobs[NJOB];
};

__device__ __forceinline__ int tidx() { int t = threadIdx.x; asm volatile("" : "+v"(t)); return t; }
__device__ __forceinline__ float bf2f(bf16_t v) { return __uint_as_float(((unsigned)v) << 16); }
__device__ __forceinline__ bf16_t f2bf(float f) { unsigned u = __float_as_uint(f); u += 0x7fffu + ((u >> 16) & 1u); return (bf16_t)(u >> 16); }
__device__ __forceinline__ unsigned pack2(float lo, float hi) { return (unsigned)f2bf(lo) | ((unsigned)f2bf(hi) << 16); }
__device__ __forceinline__ void unpack8(const uint4& v, float (&f)[8]) {
    f[0] = __uint_as_float(v.x << 16); f[1] = __uint_as_float(v.x & 0xffff0000u); f[2] = __uint_as_float(v.y << 16); f[3] = __uint_as_float(v.y & 0xffff0000u);
    f[4] = __uint_as_float(v.z << 16); f[5] = __uint_as_float(v.z & 0xffff0000u); f[6] = __uint_as_float(v.w << 16); f[7] = __uint_as_float(v.w & 0xffff0000u); }
__device__ __forceinline__ uint4 pack8(const float (&f)[8]) { uint4 o; o.x = pack2(f[0], f[1]); o.y = pack2(f[2], f[3]); o.z = pack2(f[4], f[5]); o.w = pack2(f[6], f[7]); return o; }
__device__ __forceinline__ float wsum(float v) {
#pragma unroll
    for (int o = 32; o; o >>= 1) v += __shfl_xor(v, o, 64);
    return v;
}
__device__ __forceinline__ float sigm(float z) { return 1.f / (1.f + __expf(-z)); }
__device__ __forceinline__ int row_of(int dir, int s) { return dir == 0 ? s : (s < 256 ? 255 - s : 16895 - s); }

struct APlain { const bf16_t* base; int ld;
    __device__ __forceinline__ const char* bptr() const { return (const char*)base; }
    __device__ __forceinline__ unsigned rowoff(int r) const { return (unsigned)(r * ld) * 2u; } };
struct AGather { const bf16_t* base; int ld; const int* idx;
    __device__ __forceinline__ const char* bptr() const { return (const char*)base; }
    __device__ __forceinline__ unsigned rowoff(int r) const { const int tok = idx[r] / 9; return (unsigned)(tok * ld) * 2u; } };
struct BPlain { static constexpr int MODE = 0; const bf16_t* base; int ldv;
    __device__ __forceinline__ const char* bptr() const { return (const char*)base; }
    __device__ __forceinline__ unsigned rowoff(int n) const { return (unsigned)(n * ldv) * 2u; }
    __device__ __forceinline__ const float* colptr(int) const { return nullptr; }
    __device__ __forceinline__ long ld() const { return ldv; }
    __device__ __forceinline__ int lrow(int, int) const { return 0; } };
struct BKN { static constexpr int MODE = 1; const float* base; long ldv;
    __device__ __forceinline__ const char* bptr() const { return nullptr; }
    __device__ __forceinline__ unsigned rowoff(int) const { return 0u; }
    __device__ __forceinline__ const float* colptr(int n4) const { return base + n4 * 4; }
    __device__ __forceinline__ long ld() const { return ldv; }
    __device__ __forceinline__ int lrow(int n4, int j) const { return n4 * 4 + j; } };
struct BKNGU { static constexpr int MODE = 1; const float* g; const float* u;
    __device__ __forceinline__ const char* bptr() const { return nullptr; }
    __device__ __forceinline__ unsigned rowoff(int) const { return 0u; }
    __device__ __forceinline__ const float* colptr(int n4) const { return ((n4 >> 5) ? u : g) + (n4 & 31) * 4; }
    __device__ __forceinline__ long ld() const { return 256; }
    __device__ __forceinline__ int lrow(int n4, int j) const { int sc = (n4 & 31) * 4 + j; return (sc >> 4) * 32 + (n4 >> 5) * 16 + (sc & 15); } };

__device__ __forceinline__ float f4e(const float4& v, int j) { return j == 0 ? v.x : (j == 1 ? v.y : (j == 2 ? v.z : v.w)); }
#define GC_REP4(N, X) do { if constexpr ((N) > 0) { X(0); } if constexpr ((N) > 1) { X(1); } if constexpr ((N) > 2) { X(2); } if constexpr ((N) > 3) { X(3); } } while (0)
#define GC_REP8(N, X) do { X(0); X(1); X(2); X(3); if constexpr ((N) > 4) { X(4); X(5); X(6); X(7); } } while (0)
#define GC_AOFF(i) aoff##i = ap.rowoff(lrow + 64 * i) + lseg * 16
#define GC_BOFF(i) boff##i = bp.rowoff(lrow + 64 * i) + lseg * 16
#define GC_LA(i) ra##i = *(const uint4*)(abase + (aoff##i + kt_ * 128))
#define GC_LB(i) rb##i = *(const uint4*)(bbase + (boff##i + kt_ * 128))
#define GC_LF(i) rf##i = *(const float4*)(bfp + ((long)kt_ * 64 + i) * bld)
#define GC_SA(i) *(uint4*)(As_ + (lrow + 64 * i) * TSTR + lseg * 16) = ra##i
#define GC_SB(i) *(uint4*)(Bs_ + (lrow + 64 * i) * TSTR + lseg * 16) = rb##i
#define GC_GLOAD(KT) do { const int kt_ = (KT); GC_REP4(AL, GC_LA); \
    if constexpr (BP::MODE == 0) { GC_REP4(BL, GC_LB); } else { GC_REP8(KPT, GC_LF); } } while (0)
#define GC_SF(j) do { char* d_ = Bs_ + bp.lrow(n4, j) * TSTR + kq * KPT * 2; \
        if constexpr (KPT == 4) *(uint2*)d_ = make_uint2(pack2(f4e(rf0, j), f4e(rf1, j)), pack2(f4e(rf2, j), f4e(rf3, j))); \
        else *(uint4*)d_ = make_uint4(pack2(f4e(rf0, j), f4e(rf1, j)), pack2(f4e(rf2, j), f4e(rf3, j)), pack2(f4e(rf4, j), f4e(rf5, j)), pack2(f4e(rf6, j), f4e(rf7, j))); } while (0)
#define GC_LSTORE(BUF) do { char* As_ = smem + (BUF) * STAGE; char* Bs_ = As_ + ABYTES; GC_REP4(AL, GC_SA); \
    if constexpr (BP::MODE == 0) { GC_REP4(BL, GC_SB); } else { GC_SF(0); GC_SF(1); GC_SF(2); GC_SF(3); } } while (0)

template <int BM, int BN, int WGM, int WGN, class AP, class BP>
__device__ __forceinline__ void gemm_core(f32x4 (&acc)[BM / WGM / 16][BN / WGN / 16], const AP& ap, const BP& bp, const int K, char* smem) {
    constexpr int TM = BM / WGM, TN = BN / WGN, MI = TM / 16, NI = TN / 16;
    constexpr int ABYTES = BM * TSTR, STAGE = (BM + BN) * TSTR;
    constexpr int AL = BM / 64, BL = BN / 64;
    constexpr int KPT = BN / 32, NQ = BN / 4;
    const int tid = tidx(), wave = tid >> 6, lane = tid & 63, fr = lane & 15, fq = lane >> 4;
    const int wm = wave / WGN, wn = wave % WGN;
    const int lrow = tid >> 3, lseg = tid & 7;
    const char* abase = ap.bptr(); const char* bbase = bp.bptr();
    unsigned aoff0 = 0, aoff1 = 0, aoff2 = 0, aoff3 = 0, boff0 = 0, boff1 = 0, boff2 = 0, boff3 = 0;
    uint4 ra0, ra1, ra2, ra3, rb0, rb1, rb2, rb3; float4 rf0, rf1, rf2, rf3, rf4, rf5, rf6, rf7;
    GC_REP4(AL, GC_AOFF);
    const float* bfp = nullptr;
    const int kq = tid / NQ, n4 = tid % NQ; const long bld = bp.ld();
    if constexpr (BP::MODE == 0) { GC_REP4(BL, GC_BOFF); } else { bfp = bp.colptr(n4) + (long)(kq * KPT) * bld; }
    int nk = K >> 6;
    asm volatile("" : "+s"(nk));
    GC_GLOAD(0); GC_LSTORE(0); __syncthreads();
    for (int kt = 0; kt < nk; ++kt) {
        if (kt + 1 < nk) GC_GLOAD(kt + 1);
        const char* As = smem + (kt & 1) * STAGE; const char* Bs = As + ABYTES;
#pragma unroll
        for (int ks = 0; ks < 2; ++ks) {
            bf16x8 af[MI], bfr[NI];
#pragma unroll
            for (int mi = 0; mi < MI; ++mi) af[mi] = *(const bf16x8*)(As + (wm * TM + mi * 16 + fr) * TSTR + ks * 64 + fq * 16);
#pragma unroll
            for (int ni = 0; ni < NI; ++ni) bfr[ni] = *(const bf16x8*)(Bs + (wn * TN + ni * 16 + fr) * TSTR + ks * 64 + fq * 16);
#pragma unroll
            for (int mi = 0; mi < MI; ++mi)
#pragma unroll
                for (int ni = 0; ni < NI; ++ni) acc[mi][ni] = __builtin_amdgcn_mfma_f32_16x16x32_bf16(bfr[ni], af[mi], acc[mi][ni], 0, 0, 0);
        }
        if (kt + 1 < nk) GC_LSTORE((kt + 1) & 1);
        __syncthreads();
    }
}
template <int BM, int BN, int WGM, int WGN, class AP, class BP, class EPI>
__device__ __forceinline__ void gemm_tile(const AP& ap, const BP& bp, const int K, char* smem, const EPI& epi) {
    constexpr int TM = BM / WGM, TN = BN / WGN, MI = TM / 16, NI = TN / 16;
    f32x4 acc[MI][NI];
#pragma unroll
    for (int mi = 0; mi < MI; ++mi)
#pragma unroll
        for (int ni = 0; ni < NI; ++ni) acc[mi][ni] = (f32x4){0.f, 0.f, 0.f, 0.f};
    gemm_core<BM, BN, WGM, WGN>(acc, ap, bp, K, smem);
    const int wave = tidx() >> 6, lane = tidx() & 63;
    epi(acc, (wave / WGN) * TM + (lane & 15), (wave % WGN) * TN + (lane >> 4) * 4);
}

namespace g8 {
constexpr int BM = 256, BK = 64, HALF = 128, HTB = HALF * BK * 2, NXCD = 8, WGM = 8;
__device__ __forceinline__ int lds_byte(int r, int c) { const int st = (r >> 4) * 2 + (c >> 5), rr = r & 15, cc = c & 31, ob = rr * 64 + cc * 2; return st * 1024 + (ob ^ (((ob >> 9) & 1) << 5)); }
__device__ __forceinline__ void stage_rc(int b, int& R, int& C) { const int st = b / 1024, sb = b % 1024, swz = sb ^ (((sb >> 9) & 1) << 5); R = (st >> 1) * 16 + swz / 64; C = (st & 1) * 32 + (swz % 64) / 2; }
__device__ __forceinline__ int perm32(int rho) { const int n = rho >> 4, i = rho & 15; return 8 * (i >> 2) + 4 * n + (i & 3); }
struct Unit { int pm, pn; };
struct StaticOrder {
    int nM, nN, nwg, G, c;
    __device__ void init(int M, int N, int G_, int c_) { nM = M / BM; nN = N / BM; nwg = nM * nN; G = G_; c = c_; }
    __device__ bool next(int i, Unit& u) const {
        const long L = (long)i * G + c; if (L >= nwg) return false;
        int wgid = (int)L; { const int q = nwg / NXCD, r = nwg % NXCD, xcd = wgid % NXCD, off = wgid / NXCD; wgid = (xcd < r ? xcd * (q + 1) : r * (q + 1) + (xcd - r) * q) + off; }
        const int nig = WGM * nN, gid = wgid / nig, fm = gid * WGM, gsz = (nM - fm) < WGM ? (nM - fm) : WGM;
        u.pm = fm + ((wgid % nig) % gsz); u.pn = (wgid % nig) / gsz; return true;
    }
};
template <class Epi, class Sched>
__device__ __forceinline__ void gemm_phase(LAS unsigned char* lds, const bf16_t* Ag, const bf16_t* Btg, const int lda, const int ldb, const int K, const Sched& S, const Epi& E) {
    const int tid = threadIdx.x, wid = __builtin_amdgcn_readfirstlane(tid >> 6), lane = tid & 63, wr = wid >> 2, wc = wid & 3, fr = lane & 15, fq = lane >> 4;
    const int nt = K / BK;
    unsigned voffA[2], voffB[2];
#pragma unroll
    for (int i = 0; i < 2; ++i) { int R, C; stage_rc(tid * 16 + i * 8192, R, C); const int Rb = Epi::PERM ? ((R & ~31) + perm32(R & 31)) : R;
        voffA[i] = (unsigned)(R * lda + C) * 2u; voffB[i] = (unsigned)(Rb * ldb + C) * 2u; }
    const size_t kstep = (size_t)(BK * 2);
    const size_t hstepA = (size_t)HALF * lda * 2, hstepB = (size_t)HALF * ldb * 2;
    const size_t tstepA = 2 * hstepA, tstepB = 2 * hstepB;
    const unsigned ldsw = (unsigned)wid * 1024u;
    const int aoff = lds_byte(wr * 64 + fr, fq * 8), boff = lds_byte(wc * 32 + fr, fq * 8);
#define PG8_SA(b, h) (((b) * 2 + (h)) * HTB)
#define PG8_SB(b, h) ((4 + (b) * 2 + (h)) * HTB)
#define PG8_STAGE(bufoff, gbase, voff) do { _Pragma("unroll") for (int _i = 0; _i < 2; ++_i) \
        __builtin_amdgcn_global_load_lds((const unsigned*)((const char*)(gbase) + (voff)[_i]), (LAS unsigned*)(lds + (bufoff) + ldsw + _i * 8192), 16, 0, 0); } while (0)
#define PG8_LDA(dst, b, h) do { _Pragma("unroll") for (int m = 0; m < 4; ++m) _Pragma("unroll") for (int k = 0; k < 2; ++k) dst[m][k] = *(const LAS bf16x8*)(lds + PG8_SA(b, h) + aoff + m * 2048 + k * 1024); } while (0)
#define PG8_LDB(dst, b, h) do { _Pragma("unroll") for (int n = 0; n < 2; ++n) _Pragma("unroll") for (int k = 0; k < 2; ++k) dst[n][k] = *(const LAS bf16x8*)(lds + PG8_SB(b, h) + boff + n * 2048 + k * 1024); } while (0)
#define PG8_MMA(ai, bj, At, Bt) do { __builtin_amdgcn_s_setprio(1); _Pragma("unroll") for (int m = 0; m < 4; ++m) _Pragma("unroll") for (int n = 0; n < 2; ++n) _Pragma("unroll") for (int k = 0; k < 2; ++k) \
        acc[ai][bj][m][n] = __builtin_amdgcn_mfma_f32_16x16x32_bf16(Bt[n][k], At[m][k], acc[ai][bj][m][n], 0, 0, 0); __builtin_amdgcn_s_setprio(0); } while (0)
#define PG8_WAIT_V(n) asm volatile("s_waitcnt vmcnt(" #n ")" ::: "memory")
#define PG8_WAIT_L(n) asm volatile("s_waitcnt lgkmcnt(" #n ")" ::: "memory")
#define PG8_BAR __builtin_amdgcn_s_barrier()
#define PG8_SCHED __builtin_amdgcn_sched_barrier(0)
    Unit cur, nxt; int ui = 0;
    if (!S.next(0, cur)) return;
    f32x4 acc[2][2][4][2];
#pragma unroll
    for (int a = 0; a < 2; ++a)
#pragma unroll
        for (int b = 0; b < 2; ++b)
#pragma unroll
            for (int m = 0; m < 4; ++m)
#pragma unroll
                for (int n = 0; n < 2; ++n) acc[a][b][m][n] = (f32x4){0.f, 0.f, 0.f, 0.f};
    bf16x8 At[4][2], B0[2][2], B1[2][2];
    const char* cA = (const char*)Ag + (size_t)cur.pm * tstepA; const char* cB = (const char*)Btg + (size_t)cur.pn * tstepB;
    PG8_STAGE(PG8_SB(0, 0), cB, voffB); PG8_STAGE(PG8_SA(0, 0), cA, voffA); PG8_STAGE(PG8_SB(0, 1), cB + hstepB, voffB); PG8_STAGE(PG8_SA(0, 1), cA + hstepA, voffA);
    if (wr == 1) PG8_BAR;
    PG8_WAIT_V(4); PG8_BAR;
    PG8_STAGE(PG8_SB(1, 0), cB + kstep, voffB); PG8_STAGE(PG8_SA(1, 0), cA + kstep, voffA); PG8_STAGE(PG8_SB(1, 1), cB + hstepB + kstep, voffB);
    PG8_WAIT_V(6); PG8_BAR;
    for (;;) {
        const bool has_next = S.next(ui + 1, nxt);
        const char* nA = has_next ? (const char*)Ag + (size_t)nxt.pm * tstepA : cA; const char* nB = has_next ? (const char*)Btg + (size_t)nxt.pn * tstepB : cB;
        for (int t = 0; t < nt; t += 2) {
            const bool last = (t == nt - 2);
            const char* a1 = cA + (size_t)(t + 1) * kstep;
            const char* a2 = last ? nA : cA + (size_t)(t + 2) * kstep; const char* b2 = last ? nB : cB + (size_t)(t + 2) * kstep;
            const char* a3 = a2 + kstep; const char* b3 = b2 + kstep;
            PG8_LDB(B0, 0, 0); PG8_SCHED; PG8_LDA(At, 0, 0); PG8_STAGE(PG8_SA(1, 1), a1 + hstepA, voffA);
            PG8_WAIT_L(8); PG8_BAR; PG8_WAIT_L(0); PG8_MMA(0, 0, At, B0); PG8_BAR; PG8_SCHED;
            PG8_LDB(B1, 0, 1); PG8_STAGE(PG8_SB(0, 0), b2, voffB);
            PG8_BAR; PG8_WAIT_L(0); PG8_MMA(0, 1, At, B1); PG8_BAR;
            PG8_LDA(At, 0, 1); PG8_STAGE(PG8_SA(0, 0), a2, voffA);
            PG8_BAR; PG8_WAIT_L(0); PG8_MMA(1, 0, At, B0); PG8_BAR; PG8_SCHED;
            PG8_STAGE(PG8_SB(0, 1), b2 + hstepB, voffB);
            PG8_WAIT_V(6); PG8_BAR; PG8_MMA(1, 1, At, B1); PG8_BAR;
            PG8_LDB(B0, 1, 0); PG8_SCHED; PG8_LDA(At, 1, 0); PG8_STAGE(PG8_SA(0, 1), a2 + hstepA, voffA);
            PG8_WAIT_L(8); PG8_BAR; PG8_WAIT_L(0); PG8_MMA(0, 0, At, B0); PG8_BAR; PG8_SCHED;
            PG8_LDB(B1, 1, 1); PG8_STAGE(PG8_SB(1, 0), b3, voffB);
            PG8_BAR; PG8_WAIT_L(0); PG8_MMA(0, 1, At, B1); PG8_BAR;
            PG8_LDA(At, 1, 1); PG8_STAGE(PG8_SA(1, 0), a3, voffA);
            PG8_BAR; PG8_WAIT_L(0); PG8_MMA(1, 0, At, B0); PG8_BAR; PG8_SCHED;
            PG8_STAGE(PG8_SB(1, 1), b3 + hstepB, voffB);
            PG8_WAIT_V(6); PG8_BAR; PG8_MMA(1, 1, At, B1); PG8_BAR;
        }
        E(acc, cur, wr, wc, fr, fq);
        if (!has_next) break;
#pragma unroll
        for (int a = 0; a < 2; ++a)
#pragma unroll
            for (int b = 0; b < 2; ++b)
#pragma unroll
                for (int m = 0; m < 4; ++m)
#pragma unroll
                    for (int n = 0; n < 2; ++n) acc[a][b][m][n] = (f32x4){0.f, 0.f, 0.f, 0.f};
        cur = nxt; cA = nA; cB = nB; ++ui;
    }
    PG8_WAIT_V(0);
    if (wr == 0) PG8_BAR;
    PG8_BAR;
#undef PG8_SA
#undef PG8_SB
#undef PG8_STAGE
#undef PG8_LDA
#undef PG8_LDB
#undef PG8_MMA
#undef PG8_WAIT_V
#undef PG8_WAIT_L
#undef PG8_BAR
#undef PG8_SCHED
}
struct EpiF32 {
    static constexpr bool PERM = false;
    float* C; int ldc;
    __device__ __forceinline__ void operator()(const f32x4 (&acc)[2][2][4][2], const Unit& u, int wr, int wc, int fr, int fq) const {
        const int row0 = u.pm * BM + wr * 64 + fr, col0 = u.pn * BM + wc * 32 + 4 * fq;
#pragma unroll
        for (int ai = 0; ai < 2; ++ai)
#pragma unroll
            for (int m = 0; m < 4; ++m) { float* rowp = C + (size_t)(row0 + ai * HALF + m * 16) * ldc + col0;
#pragma unroll
                for (int bj = 0; bj < 2; ++bj)
#pragma unroll
                    for (int n = 0; n < 2; ++n) *(f32x4*)(rowp + bj * HALF + n * 16) = acc[ai][bj][m][n]; }
    }
};
struct EpiBf16 {
    static constexpr bool PERM = true;
    bf16_t* O; int ldc;
    __device__ __forceinline__ void operator()(const f32x4 (&acc)[2][2][4][2], const Unit& u, int wr, int wc, int fr, int fq) const {
        const int row0 = u.pm * BM + wr * 64 + fr, col0 = u.pn * BM + wc * 32 + 8 * fq;
#pragma unroll
        for (int ai = 0; ai < 2; ++ai)
#pragma unroll
            for (int m = 0; m < 4; ++m) { bf16_t* rowp = O + (size_t)(row0 + ai * HALF + m * 16) * ldc + col0;
#pragma unroll
                for (int bj = 0; bj < 2; ++bj) { const f32x4 v0 = acc[ai][bj][m][0], v1 = acc[ai][bj][m][1];
                    uint4 o; o.x = pack2(v0[0], v0[1]); o.y = pack2(v0[2], v0[3]); o.z = pack2(v1[0], v1[1]); o.w = pack2(v1[2], v1[3]);
                    *(uint4*)(rowp + bj * HALF) = o; } }
    }
};
}

__device__ __forceinline__ void phase0(const Params& p, char* smem) {
    const int tid = tidx(), wave = tid >> 6, lane = tid & 63;
    const int gw = blockIdx.x * 8 + wave, nw = gridDim.x * 8;
    for (int u = gw; u < 1536; u += nw) {
        const int cb = u % 96, ks = u / 96, j = cb * 64 + lane;
        float a0 = 0.f, a1 = 0.f;
#pragma unroll 1
        for (int k0 = ks * 64; k0 < ks * 64 + 64; k0 += 16) {
            float w[16];
#pragma unroll
            for (int i = 0; i < 16; ++i) w[i] = p.w_mod[(size_t)(k0 + i) * 6144 + j];
#pragma unroll
            for (int i = 0; i < 16; ++i) { const float c0 = p.c[k0 + i], c1 = p.c_ctx[k0 + i]; a0 += c0 * sigm(c0) * w[i]; a1 += c1 * sigm(c1) * w[i]; }
        }
        p.modp[(ks * 2 + 0) * 6144 + j] = a0; p.modp[(ks * 2 + 1) * 6144 + j] = a1;
    }
    float* T = (float*)smem;
    int total = 0;
    for (int j = 0; j < NJOB; ++j) total += (p.jobs[j].K >> 6) * (p.jobs[j].N >> 6);
    for (int u = blockIdx.x; u < total; u += gridDim.x) {
        int j = 0, r = u;
        for (;; ++j) { const int n = (p.jobs[j].K >> 6) * (p.jobs[j].N >> 6); if (r < n) break; r -= n; }
        const TJob jb = p.jobs[j];
        const int ntn = jb.N >> 6, kt = r / ntn, nt = r % ntn, k0 = kt * 64, n0 = nt * 64;
        {
            const int kk = tid >> 4, c4 = (tid & 15) * 4;
#pragma unroll
            for (int i = 0; i < 2; ++i) {
                const int k = kk + 32 * i;
                const float4 v = *(const float4*)(jb.src + (size_t)(k0 + k) * jb.N + n0 + c4);
                T[k * 65 + c4 + 0] = v.x; T[k * 65 + c4 + 1] = v.y; T[k * 65 + c4 + 2] = v.z; T[k * 65 + c4 + 3] = v.w;
            }
        }
        __syncthreads();
        {
            const int n = tid >> 3, ks = (tid & 7) * 8;
            float v[8];
#pragma unroll
            for (int q = 0; q < 8; ++q) v[q] = T[(ks + q) * 65 + n];
            const int ng = n0 + n;
            int drow = jb.rowoff + ng;
            if (jb.mode == 2) drow = (ng >> 4) * 32 + (ng & 15) + jb.rowoff;
            uint4 hi; hi.x = pack2(v[0], v[1]); hi.y = pack2(v[2], v[3]); hi.z = pack2(v[4], v[5]); hi.w = pack2(v[6], v[7]);
            bf16_t* d = jb.dst + (size_t)drow * jb.dld + jb.coloff + k0 + ks;
            *(uint4*)d = hi;
            if (jb.mode == 1) {
                float l[8];
#pragma unroll
                for (int q = 0; q < 8; ++q) l[q] = v[q] - bf2f(f2bf(v[q]));
                uint4 lo; lo.x = pack2(l[0], l[1]); lo.y = pack2(l[2], l[3]); lo.z = pack2(l[4], l[5]); lo.w = pack2(l[6], l[7]);
                *(uint4*)(d + 1024) = hi; *(uint4*)(d + 2048) = lo;
            }
        }
        __syncthreads();
    }
}

__device__ __forceinline__ void phase1(const Params& p, char* smem) {
    const int tid = tidx(), wave = tid >> 6, lane = tid & 63;
    float* L = (float*)smem;
    for (int idx = tid; idx < 4096; idx += NT) {
        const int v = idx >> 11, which = (idx >> 10) & 1, col = idx & 1023;
        float s = p.b_mod[which * 1024 + col];
        for (int ks = 0; ks < 16; ++ks) s += p.modp[(ks * 2 + v) * 6144 + which * 1024 + col];
        L[idx] = s;
    }
    for (int idx = blockIdx.x * NT + tid; idx < 2 * 6144; idx += gridDim.x * NT) {
        const int v = idx / 6144, j = idx % 6144;
        float sm = p.b_mod[j];
#pragma unroll
        for (int ks = 0; ks < 16; ++ks) sm += p.modp[(ks * 2 + v) * 6144 + j];
        p.mod[idx] = sm;
    }
    __syncthreads();
    const int gw = blockIdx.x * 8 + wave, nw = gridDim.x * 8;
    for (int r = gw; r < TE; r += nw) {
        const int v = r < 256 ? 1 : 0;
        const float* src = r < 256 ? p.ctx + (size_t)r * 1024 : p.x + (size_t)(r - 256) * 1024;
        float4 xv[4]; float ss = 0.f;
#pragma unroll
        for (int i = 0; i < 4; ++i) { xv[i] = *(const float4*)(src + i * 256 + lane * 4); ss += xv[i].x * xv[i].x + xv[i].y * xv[i].y + xv[i].z * xv[i].z + xv[i].w * xv[i].w; }
        ss = wsum(ss);
        const float rs = rsqrtf(ss * (1.f / 1024.f) + 1e-6f);
#pragma unroll
        for (int i = 0; i < 4; ++i) {
            const int col = i * 256 + lane * 4;
            const float4 g = *(const float4*)(p.n_pre_mix + col);
            const float* sh = L + v * 2048 + col; const float* sc = L + v * 2048 + 1024 + col;
            const float y0 = xv[i].x * rs * g.x * (1.f + sc[0]) + sh[0];
            const float y1 = xv[i].y * rs * g.y * (1.f + sc[1]) + sh[1];
            const float y2 = xv[i].z * rs * g.z * (1.f + sc[2]) + sh[2];
            const float y3 = xv[i].w * rs * g.w * (1.f + sc[3]) + sh[3];
            uint2 o; o.x = pack2(y0, y1); o.y = pack2(y2, y3);
            *(uint2*)(p.hn + (size_t)r * 1024 + col) = o;
        }
    }
}

__device__ __forceinline__ void phase2(const Params& p, char* smem) {
    g8::StaticOrder S; S.init(TE, INC, gridDim.x, blockIdx.x);
    g8::EpiBf16 E{p.proj, INC};
    g8::gemm_phase((LAS unsigned char*)smem, p.hn, p.WinT, 1024, 1024, 1024, S, E);
}

__device__ __forceinline__ void phase3(const Params& p, char* smem) {
    const int tid = tidx(), wave = tid >> 6, lane = tid & 63;
    const int gw = blockIdx.x * 8 + wave, nw = gridDim.x * 8;
    float mu0[3][8], mu1[3][8], kkw[8], lm0[4], lm1[4];
#pragma unroll
    for (int a = 0; a < 3; ++a)
#pragma unroll
        for (int q = 0; q < 8; ++q) { mu0[a][q] = p.shift_mu[a * 512 + lane * 8 + q]; mu1[a][q] = p.shift_mu[1792 + a * 512 + lane * 8 + q]; }
#pragma unroll
    for (int q = 0; q < 8; ++q) kkw[q] = p.rwkv_k_k[lane * 8 + q];
#pragma unroll
    for (int q = 0; q < 4; ++q) { lm0[q] = p.shift_mu[1536 + lane * 4 + q]; lm1[q] = p.shift_mu[1792 + 1536 + lane * 4 + q]; }
    for (int t = gw; t < TE; t += nw) {
        const bool hp = (t != 0 && t != 256), hn_ = (t != 255 && t != TE - 1);
        const bf16_t* pr = p.proj + (size_t)t * INC;
        uint4 q0[3], qm[3], qn[3]; uint2 l0, lm = make_uint2(0, 0), ln = make_uint2(0, 0);
#pragma unroll
        for (int a = 0; a < 3; ++a) {
            q0[a] = *(const uint4*)(pr + a * 512 + lane * 8);
            qm[a] = hp ? *(const uint4*)(pr + a * 512 + lane * 8 - INC) : make_uint4(0, 0, 0, 0);
            qn[a] = hn_ ? *(const uint4*)(pr + a * 512 + lane * 8 + INC) : make_uint4(0, 0, 0, 0);
        }
        l0 = *(const uint2*)(pr + 1536 + lane * 4);
        if (hp) lm = *(const uint2*)(pr + 1536 + lane * 4 - INC);
        if (hn_) ln = *(const uint2*)(pr + 1536 + lane * 4 + INC);
        float val[3][8];
#pragma unroll
        for (int a = 0; a < 3; ++a) {
            float f0[8], fm[8], fn[8]; unpack8(q0[a], f0); unpack8(qm[a], fm); unpack8(qn[a], fn);
#pragma unroll
            for (int q = 0; q < 8; ++q) val[a][q] = f0[q] + mu0[a][q] * (fm[q] - f0[q]) + mu1[a][q] * (fn[q] - f0[q]);
        }
        float kkv[8], n2 = 0.f;
#pragma unroll
        for (int q = 0; q < 8; ++q) { kkv[q] = val[1][q] * kkw[q]; n2 += kkv[q] * kkv[q]; }
        n2 += __shfl_xor(n2, 1, 64); n2 += __shfl_xor(n2, 2, 64); n2 += __shfl_xor(n2, 4, 64);
        const float inv = -1.f / fmaxf(sqrtf(n2), 1e-12f);
#pragma unroll
        for (int q = 0; q < 8; ++q) kkv[q] *= inv;
        const size_t o = (size_t)t * 512 + lane * 8;
        *(uint4*)(p.Rr + o) = pack8(val[0]); *(uint4*)(p.Kk + o) = pack8(val[1]); *(uint4*)(p.Vv + o) = pack8(val[2]); *(uint4*)(p.Aa + o) = pack8(kkv);
        {
            float v[4];
            const unsigned w0[2] = {l0.x, l0.y}, wm[2] = {lm.x, lm.y}, wn[2] = {ln.x, ln.y};
#pragma unroll
            for (int q = 0; q < 4; ++q) {
                const float p0 = (q & 1) ? __uint_as_float(w0[q >> 1] & 0xffff0000u) : __uint_as_float(w0[q >> 1] << 16);
                const float pm = (q & 1) ? __uint_as_float(wm[q >> 1] & 0xffff0000u) : __uint_as_float(wm[q >> 1] << 16);
                const float pn = (q & 1) ? __uint_as_float(wn[q >> 1] & 0xffff0000u) : __uint_as_float(wn[q >> 1] << 16);
                v[q] = p0 + lm0[q] * (pm - p0) + lm1[q] * (pn - p0);
            }
            if (lane < 16) {
                uint2 ov; ov.x = pack2(tanhf(v[0]), tanhf(v[1])); ov.y = pack2(tanhf(v[2]), tanhf(v[3]));
                *(uint2*)(p.TW + (size_t)t * 64 + lane * 4) = ov;
            } else if (lane < 32) {
                uint2 ov; ov.x = pack2(v[0], v[1]); ov.y = pack2(v[2], v[3]);
                *(uint2*)(p.XA + (size_t)t * 64 + (lane - 16) * 4) = ov;
            } else {
                uint2 ov; ov.x = pack2(sigm(v[0]), sigm(v[1])); ov.y = pack2(sigm(v[2]), sigm(v[3]));
                *(uint2*)(p.SG + (size_t)t * 128 + (lane - 32) * 4) = ov;
            }
        }
    }
}

__device__ __forceinline__ void phase4(const Params& p, char* smem) {
    for (int u = blockIdx.x; u < 130 * 20; u += gridDim.x) {
        const int mt = u / 20, q = u % 20;
        if (q < 8) {
            APlain ap{p.TW + (size_t)mt * 128 * 64, 64}; BPlain bp{p.WupT + (size_t)q * 128 * 64, 64};
            gemm_tile<128, 128, 4, 2>(ap, bp, 64, smem, [&](const auto& acc, int r0, int c0) {
#pragma unroll
                for (int mi = 0; mi < 2; ++mi)
#pragma unroll
                    for (int ni = 0; ni < 4; ++ni) {
                        const int t = mt * 128 + r0 + mi * 16, cc = q * 128 + c0 + ni * 16, d = cc >> 9, c = cc & 511;
                        float4 o; float* op = (float*)&o;
#pragma unroll
                        for (int j = 0; j < 4; ++j) { const float z = p.rwkv_w0[d * 512 + c + j] + acc[mi][ni][j]; op[j] = __expf(-0.60653066f * sigm(z)); }
                        *(float4*)(p.Wd + ((size_t)d * TE + t) * 512 + c) = o;
                    }
            });
        } else if (q < 16) {
            const int qq = q - 8;
            APlain ap{p.XA + (size_t)mt * 128 * 64, 64}; BPlain bp{p.AupT + (size_t)qq * 128 * 64, 64};
            gemm_tile<128, 128, 4, 2>(ap, bp, 64, smem, [&](const auto& acc, int r0, int c0) {
#pragma unroll
                for (int mi = 0; mi < 2; ++mi)
#pragma unroll
                    for (int ni = 0; ni < 4; ++ni) {
                        const int t = mt * 128 + r0 + mi * 16, cc = qq * 128 + c0 + ni * 16, d = cc >> 9, c = cc & 511;
                        const uint2 av = *(const uint2*)(p.Aa + (size_t)t * 512 + c), kv = *(const uint2*)(p.Kk + (size_t)t * 512 + c);
                        const bf16_t* ae = (const bf16_t*)&av; const bf16_t* ke = (const bf16_t*)&kv;
                        float bo[4], ko[4];
#pragma unroll
                        for (int j = 0; j < 4; ++j) {
                            const float ad = sigm(p.rwkv_a0[d * 512 + c + j] + acc[mi][ni][j]);
                            bo[j] = -bf2f(ae[j]) * ad;
                            ko[j] = bf2f(ke[j]) * (1.f + (ad - 1.f) * p.rwkv_k_a[c + j]);
                        }
                        uint2 o1, o2; o1.x = pack2(bo[0], bo[1]); o1.y = pack2(bo[2], bo[3]); o2.x = pack2(ko[0], ko[1]); o2.y = pack2(ko[2], ko[3]);
                        *(uint2*)(p.Bd + ((size_t)d * TE + t) * 512 + c) = o1;
                        *(uint2*)(p.KD + ((size_t)d * TE + t) * 512 + c) = o2;
                    }
            });
        } else {
            const int qq = q - 16;
            APlain ap{p.SG + (size_t)mt * 128 * 128, 128}; BPlain bp{p.GupT + (size_t)qq * 128 * 128, 128};
            gemm_tile<128, 128, 4, 2>(ap, bp, 128, smem, [&](const auto& acc, int r0, int c0) {
#pragma unroll
                for (int mi = 0; mi < 2; ++mi)
#pragma unroll
                    for (int ni = 0; ni < 4; ++ni) {
                        const int t = mt * 128 + r0 + mi * 16, c = qq * 128 + c0 + ni * 16;
                        uint2 o; o.x = pack2(acc[mi][ni][0], acc[mi][ni][1]); o.y = pack2(acc[mi][ni][2], acc[mi][ni][3]);
                        *(uint2*)(p.G + (size_t)t * 512 + c) = o;
                    }
            });
        }
    }
}

__device__ __forceinline__ void phase5(const Params& p, char* smem) {
    const int tid = tidx(), wave = __builtin_amdgcn_readfirstlane(tid >> 6), lane = tid & 63;
    constexpr int SB = 5, NA = 6, NSB = RL / SB;
    float* L = (float*)smem + wave * (2 * SB * NA * 64);
    for (int q = blockIdx.x * 8 + wave; q < RNC * 16; q += gridDim.x * 8) {
        const int j = q >> 4, hd = q & 15, dir = hd >> 3, h = hd & 7;
        const float* gW = p.Wd + (size_t)dir * TE * 512; const bf16_t* gB = p.Bd + (size_t)dir * TE * 512; const bf16_t* gK = p.KD + (size_t)dir * TE * 512;
        const bf16_t* gA = p.Aa; const bf16_t* gV = p.Vv; const bf16_t* gR = p.Rr;
        const unsigned lofs = (unsigned)(h * 64 + lane);
        float* gZ = p.Zz + (size_t)q * (RL * 64) + lane; float* gY = p.YH + (size_t)q * (RL * 64) + lane;
        f32x2 sP[32], sH[32];
        int ln = lane; asm volatile("" : "+v"(ln));
#pragma unroll
        for (int k = 0; k < 32; ++k) { sP[k] = (f32x2){(2 * k == ln) ? 1.f : 0.f, (2 * k + 1 == ln) ? 1.f : 0.f}; sH[k] = (f32x2){0.f, 0.f}; }
        for (int sb = 0; sb < NSB; ++sb) {
            {
                float st[SB][NA];
#pragma unroll
                for (int i = 0; i < SB; ++i) {
                    const unsigned g = (unsigned)row_of(dir, j * RL + sb * SB + i) * 512u + lofs;
                    st[i][0] = gW[g]; st[i][1] = bf2f(gA[g]); st[i][2] = bf2f(gB[g]); st[i][3] = bf2f(gK[g]); st[i][4] = bf2f(gV[g]); st[i][5] = bf2f(gR[g]);
                }
                float* d = L + (sb & 1) * (SB * NA * 64) + lane;
#pragma unroll
                for (int i = 0; i < SB; ++i)
#pragma unroll
                    for (int a = 0; a < NA; ++a) d[(i * NA + a) * 64] = st[i][a];
            }
            const float* Lb = L + (sb & 1) * (SB * NA * 64);
#pragma unroll 1
            for (int i = 0; i < SB; ++i) {
                const float* W = Lb + (i * NA) * 64; const float* A = W + 64; const float* B = W + 128; const float* KDv = W + 192; const float* R = W + 320;
                const float vl = W[256 + lane];
                f32x2 dh0 = {0.f, 0.f}, dh1 = {0.f, 0.f}, dp0 = {0.f, 0.f}, dp1 = {0.f, 0.f};
                f32x4 ac0 = *(const f32x4*)(A), ac1 = *(const f32x4*)(A + 4), ac2 = *(const f32x4*)(A + 8), ac3 = *(const f32x4*)(A + 12);
                f32x4 rw[3], rb[3], rk[3], rr[3];
                rw[0] = *(const f32x4*)(W); rb[0] = *(const f32x4*)(B); rk[0] = *(const f32x4*)(KDv); rr[0] = *(const f32x4*)(R);
                rw[1] = *(const f32x4*)(W + 4); rb[1] = *(const f32x4*)(B + 4); rk[1] = *(const f32x4*)(KDv + 4); rr[1] = *(const f32x4*)(R + 4);
#pragma unroll
                for (int c = 0; c < 4; ++c) {
                    f32x4 an0 = ac0, an1 = ac1, an2 = ac2, an3 = ac3;
                    if (c < 3) { an0 = *(const f32x4*)(A + c * 16 + 16); an1 = *(const f32x4*)(A + c * 16 + 20); an2 = *(const f32x4*)(A + c * 16 + 24); an3 = *(const f32x4*)(A + c * 16 + 28); }
                    const int k = c * 8;
                    dh0 += sH[k] * ac0.lo; dh1 += sH[k + 1] * ac0.hi; dp0 += sP[k] * ac0.lo; dp1 += sP[k + 1] * ac0.hi;
                    dh0 += sH[k + 2] * ac1.lo; dh1 += sH[k + 3] * ac1.hi; dp0 += sP[k + 2] * ac1.lo; dp1 += sP[k + 3] * ac1.hi;
                    dh0 += sH[k + 4] * ac2.lo; dh1 += sH[k + 5] * ac2.hi; dp0 += sP[k + 4] * ac2.lo; dp1 += sP[k + 5] * ac2.hi;
                    dh0 += sH[k + 6] * ac3.lo; dh1 += sH[k + 7] * ac3.hi; dp0 += sP[k + 6] * ac3.lo; dp1 += sP[k + 7] * ac3.hi;
                    __builtin_amdgcn_sched_barrier(0);
                    ac0 = an0; ac1 = an1; ac2 = an2; ac3 = an3;
                }
                const float saHs = (dh0.x + dh0.y) + (dh1.x + dh1.y), saPs = (dp0.x + dp0.y) + (dp1.x + dp1.y);
                const f32x2 saH = {saHs, saHs}, saP = {saPs, saPs}, vl2 = {vl, vl};
                f32x2 y0 = {0.f, 0.f}, y1 = {0.f, 0.f}, z0 = {0.f, 0.f}, z1 = {0.f, 0.f};
#pragma unroll
                for (int g = 0; g < 16; ++g) {
                    if (g + 2 < 16) { rw[(g + 2) % 3] = *(const f32x4*)(W + 4 * g + 8); rb[(g + 2) % 3] = *(const f32x4*)(B + 4 * g + 8); rk[(g + 2) % 3] = *(const f32x4*)(KDv + 4 * g + 8); rr[(g + 2) % 3] = *(const f32x4*)(R + 4 * g + 8); }
                    const f32x4 cw = rw[g % 3], cb = rb[g % 3], ck = rk[g % 3], cr = rr[g % 3];
                    const int k = 2 * g;
                    sH[k]     = sH[k]     * cw.lo + (saH * cb.lo + vl2 * ck.lo);
                    sH[k + 1] = sH[k + 1] * cw.hi + (saH * cb.hi + vl2 * ck.hi);
                    sP[k]     = sP[k]     * cw.lo + saP * cb.lo;
                    sP[k + 1] = sP[k + 1] * cw.hi + saP * cb.hi;
                    y0 += sH[k] * cr.lo; y1 += sH[k + 1] * cr.hi;
                    z0 += sP[k] * cr.lo; z1 += sP[k + 1] * cr.hi;
                    __builtin_amdgcn_sched_barrier(0);
                }
                const int t = sb * SB + i;
                gZ[t * 64] = (z0.x + z0.y) + (z1.x + z1.y); gY[t * 64] = (y0.x + y0.y) + (y1.x + y1.y);
            }
        }
        if (j < RNC - 1) {
            float* dP = p.PH + (((size_t)(j * 16 + hd) * 2 + 0) * 64 + lane) * 64;
            float* dH = p.PH + (((size_t)(j * 16 + hd) * 2 + 1) * 64 + lane) * 64;
#pragma unroll
            for (int k = 0; k < 32; k += 2) { *(float4*)(dP + 2 * k) = make_float4(sP[k].x, sP[k].y, sP[k + 1].x, sP[k + 1].y); *(float4*)(dH + 2 * k) = make_float4(sH[k].x, sH[k].y, sH[k + 1].x, sH[k + 1].y); }
        }
    }
}

__device__ __forceinline__ void phase6(const Params& p, char* smem) {
    const int tid = threadIdx.x, wave = __builtin_amdgcn_readfirstlane(tid >> 6), lane = tid & 63;
    if (blockIdx.x >= 256) return;
    const int hd = blockIdx.x >> 4, rb0 = (blockIdx.x & 15) * 4, r0 = rb0 + (wave & 3);
    LAS unsigned char* lds = (LAS unsigned char*)smem;
    constexpr int SLOT = 17408, NJ = RNC - 1;
    const char* pbase = (const char*)(p.PH + (size_t)hd * 2 * 4096);
    float s0 = 0.f;
#define CH_ISSUE(J) do { const char* src_ = pbase + (size_t)(J) * 524288; const unsigned so_ = (unsigned)(((J) & 7) * SLOT); \
        _Pragma("unroll") for (int q_ = 0; q_ < 4; ++q_) __builtin_amdgcn_global_load_lds((const unsigned*)(src_ + ((wave - 4) * 4 + q_) * 1024 + lane * 16), (LAS unsigned*)(lds + so_ + ((wave - 4) * 4 + q_) * 1024), 16, 0, 0); \
        if (wave == 7) __builtin_amdgcn_global_load_lds((const unsigned*)(src_ + 16384 + rb0 * 256 + lane * 16), (LAS unsigned*)(lds + so_ + 16384), 16, 0, 0); } while (0)
    if (wave >= 4) { CH_ISSUE(0); CH_ISSUE(1); CH_ISSUE(2); CH_ISSUE(3); CH_ISSUE(4); CH_ISSUE(5); CH_ISSUE(6); }
    for (int j = 0; j < RNC; ++j) {
        if (wave < 4) p.Sst[((size_t)(j * 16 + hd) * 64 + r0) * 64 + lane] = s0;
        if (j == NJ) break;
        if (wave >= 4) {
            if (j + 6 >= NJ) asm volatile("s_waitcnt vmcnt(0)" ::: "memory");
            else if (wave == 7) asm volatile("s_waitcnt vmcnt(30)" ::: "memory");
            else asm volatile("s_waitcnt vmcnt(24)" ::: "memory");
        }
        asm volatile("s_waitcnt lgkmcnt(0)" ::: "memory"); __builtin_amdgcn_s_barrier(); asm volatile("" ::: "memory");
        if (wave >= 4) { if (j + 7 < NJ) CH_ISSUE(j + 7); }
        else {
            const float* Pc = (const float*)(smem + (j & 7) * SLOT);
            f32x2 n0 = {Pc[4096 + wave * 64 + lane], 0.f}, n1 = {0.f, 0.f};
#pragma unroll
            for (int k = 0; k < 64; k += 4) {
                const f32x2 a0 = {__int_as_float(__builtin_amdgcn_readlane(__float_as_int(s0), k)), __int_as_float(__builtin_amdgcn_readlane(__float_as_int(s0), k + 1))};
                const f32x2 a1 = {__int_as_float(__builtin_amdgcn_readlane(__float_as_int(s0), k + 2)), __int_as_float(__builtin_amdgcn_readlane(__float_as_int(s0), k + 3))};
                const f32x2 p0 = {Pc[k * 64 + lane], Pc[(k + 1) * 64 + lane]}, p1 = {Pc[(k + 2) * 64 + lane], Pc[(k + 3) * 64 + lane]};
                n0 += a0 * p0; n1 += a1 * p1;
            }
            s0 = (n0.x + n0.y) + (n1.x + n1.y);
        }
    }
#undef CH_ISSUE
    __syncthreads();
}

__device__ __forceinline__ void phase7(const Params& p, char* smem) {
    const int tid = tidx(), wave = __builtin_amdgcn_readfirstlane(tid >> 6), lane = tid & 63;
    constexpr int SB = 10, NSB = RL / SB;
    float* L = (float*)smem + wave * (SB * 64);
    for (int q = 16 + blockIdx.x * 8 + wave; q < RNC * 16; q += gridDim.x * 8) {
        const int j = q >> 4, hd = q & 15, dir = hd >> 3, h = hd & 7;
        f32x2 s[32];
        {
            const float* src = p.Sst + ((size_t)(j * 16 + hd) * 64 + lane) * 64;
#pragma unroll
            for (int k = 0; k < 32; k += 2) { const f32x4 v = *(const f32x4*)(src + 2 * k); s[k] = v.lo; s[k + 1] = v.hi; }
        }
        const float* gZ = p.Zz + (size_t)q * (RL * 64) + lane; const float* gY = p.YH + (size_t)q * (RL * 64) + lane;
        bf16_t* gO = p.O + (size_t)dir * TX * 512 + h * 64 + lane;
        float zz[SB], yy[SB];
#pragma unroll
        for (int i = 0; i < SB; ++i) { zz[i] = gZ[i * 64]; yy[i] = gY[i * 64]; }
        for (int sb = 0; sb < NSB; ++sb) {
            float yc[SB];
#pragma unroll
            for (int i = 0; i < SB; ++i) { L[i * 64 + lane] = zz[i]; yc[i] = yy[i]; }
            { const int nsb = sb + 1 < NSB ? sb + 1 : sb;
#pragma unroll
              for (int i = 0; i < SB; ++i) { zz[i] = gZ[(nsb * SB + i) * 64]; yy[i] = gY[(nsb * SB + i) * 64]; } }
#pragma unroll
            for (int i = 0; i < SB; ++i) {
                const float* Z = L + i * 64;
                f32x2 y0 = {yc[i], 0.f}, y1 = {0.f, 0.f};
#pragma unroll
                for (int k = 0; k < 32; k += 2) { const f32x4 z = *(const f32x4*)(Z + 2 * k); y0 += s[k] * z.lo; y1 += s[k + 1] * z.hi; }
                const int row = row_of(dir, j * RL + sb * SB + i);
                if (row >= 256) gO[(size_t)(row - 256) * 512] = f2bf((y0.x + y0.y) + (y1.x + y1.y));
            }
        }
    }
}

__device__ __forceinline__ void phase8(const Params& p, char* smem) {
    const int tid = tidx();
    bf16_t* LT = (bf16_t*)smem;
    constexpr int LTS = 136;
    for (int u = blockIdx.x; u < NCH * 4; u += gridDim.x) {
        const int upart = 2;
        const int c = u >> 2, hh = u & 3;
        const float g0 = sigm(p.ret_decay_logit[hh]), g1 = sigm(p.ret_decay_logit[4 + hh]);
        const float l0 = log2f(g0), l1 = log2f(g1);
        const int n = tid >> 2, part = tid & 3, half = part >> 1, fb = (part & 1) * 16;
        const int t = c * 128 + n;
        const bool lat = c >= 2;
        float pos = 0.f;
        if (lat) { const int tl = t - 256; pos = (float)(half == 0 ? (tl >> 6) : (tl & 63)); }
        const bf16_t* pr = p.proj + (size_t)t * INC;
        float cs[16], sn[16];
#pragma unroll
        for (int f = 0; f < 16; ++f) {
            if (lat) { const float inv = exp2f(-(float)(fb + f) * (13.287712379549449f / 32.f)); sincosf(pos * inv, &sn[f], &cs[f]); }
            else { cs[f] = 1.f; sn[f] = 0.f; }
        }
        const size_t ch = (size_t)(c * 4 + hh);
        if (upart != 1) {
            const int cb = 1792 + hh * 128 + half * 64 + fb;
            uint4 v1a = *(const uint4*)(pr + cb), v1b = *(const uint4*)(pr + cb + 8), v2a = *(const uint4*)(pr + cb + 32), v2b = *(const uint4*)(pr + cb + 40);
            bf16_t x1[16], x2[16];
            *(uint4*)&x1[0] = v1a; *(uint4*)&x1[8] = v1b; *(uint4*)&x2[0] = v2a; *(uint4*)&x2[8] = v2b;
            float o1[16], o2[16];
#pragma unroll
            for (int f = 0; f < 16; ++f) { const float a = bf2f(x1[f]), b = bf2f(x2[f]); o1[f] = a * cs[f] - b * sn[f]; o2[f] = a * sn[f] + b * cs[f]; }
            const float xf = exp2f(l0 * (float)(n + 1)), xb = exp2f(l1 * (float)(128 - n));
            bf16_t* qd = p.Qr + (ch * 128 + n) * 128 + half * 64 + fb;
            bf16_t* ad = p.A3 + (ch * 128 + n) * 384 + 128 + half * 64 + fb;
#pragma unroll
            for (int f = 0; f < 16; f += 2) {
                *(unsigned*)(qd + f) = pack2(o1[f], o1[f + 1]); *(unsigned*)(qd + 32 + f) = pack2(o2[f], o2[f + 1]);
                *(unsigned*)(ad + f) = pack2(o1[f] * xf, o1[f + 1] * xf); *(unsigned*)(ad + 32 + f) = pack2(o2[f] * xf, o2[f + 1] * xf);
                *(unsigned*)(ad + 128 + f) = pack2(o1[f] * xb, o1[f + 1] * xb); *(unsigned*)(ad + 128 + 32 + f) = pack2(o2[f] * xb, o2[f + 1] * xb);
            }
        }
        if (upart != 1) {
            const int cb = 2304 + hh * 128 + half * 64 + fb;
            uint4 v1a = *(const uint4*)(pr + cb), v1b = *(const uint4*)(pr + cb + 8), v2a = *(const uint4*)(pr + cb + 32), v2b = *(const uint4*)(pr + cb + 40);
            bf16_t x1[16], x2[16];
            *(uint4*)&x1[0] = v1a; *(uint4*)&x1[8] = v1b; *(uint4*)&x2[0] = v2a; *(uint4*)&x2[8] = v2b;
            const float sc = 0.08838834764831845f;
            bf16_t* kd = p.Kr + (ch * 128 + n) * 128 + half * 64 + fb;
            __syncthreads();
#pragma unroll
            for (int f = 0; f < 16; ++f) {
                const float a = bf2f(x1[f]) * sc, b = bf2f(x2[f]) * sc;
                const float o1 = a * cs[f] - b * sn[f], o2 = a * sn[f] + b * cs[f];
                const bf16_t h1 = f2bf(o1), h2 = f2bf(o2);
                kd[f] = h1; kd[32 + f] = h2;
                LT[(half * 64 + fb + f) * LTS + n] = h1; LT[(half * 64 + fb + f + 32) * LTS + n] = h2;
            }
            __syncthreads();
            const int d = tid >> 2, ms = (tid & 3) * 32;
#pragma unroll
            for (int dir = 0; dir < 2; ++dir) {
                bf16_t* od = p.KTz + ((ch * 2 + dir) * 128 + d) * 128 + ms;
#pragma unroll
                for (int m = 0; m < 32; m += 2) {
                    const int mm = ms + m;
                    const float z0 = dir == 0 ? exp2f(l0 * (float)(127 - mm)) : exp2f(l1 * (float)mm);
                    const float z1 = dir == 0 ? exp2f(l0 * (float)(126 - mm)) : exp2f(l1 * (float)(mm + 1));
                    *(unsigned*)(od + m) = pack2(bf2f(LT[d * LTS + mm]) * z0, bf2f(LT[d * LTS + mm + 1]) * z1);
                }
            }
        }
#pragma unroll 1
        for (int eh = (upart != 0 ? 0 : 2); eh < 2; ++eh) {
            __syncthreads();
            const int cb = 2816 + hh * 256 + eh * 128 + part * 32;
            bf16_t xv[32];
#pragma unroll
            for (int q = 0; q < 4; ++q) *(uint4*)&xv[q * 8] = *(const uint4*)(pr + cb + q * 8);
#pragma unroll
            for (int f = 0; f < 32; ++f) LT[(part * 32 + f) * LTS + n] = xv[f];
            __syncthreads();
            const int e = tid >> 2, ms = (tid & 3) * 32;
            bf16_t* od = p.B3 + (ch * 256 + eh * 128 + e) * 384 + ms;
#pragma unroll
            for (int m = 0; m < 32; m += 8) *(uint4*)(od + m) = *(const uint4*)(LT + e * LTS + ms + m);
        }
        __syncthreads();
    }
}

__device__ __forceinline__ void phase9(const Params& p, char* smem) {
    for (int u = blockIdx.x; u < 512 + 2080; u += gridDim.x) {
        if (u < 512) {
            const int c = 2 + (u >> 2), hh = u & 3;
            const size_t ch = (size_t)(c * 4 + hh);
            const float l0 = log2f(sigm(p.ret_decay_logit[hh])), l1 = log2f(sigm(p.ret_decay_logit[4 + hh]));
            APlain ap{p.Qr + ch * 128 * 128, 128}; BPlain bp{p.Kr + ch * 128 * 128, 128};
            bf16_t* outp = p.A3 + ch * 128 * 384;
            gemm_tile<128, 128, 4, 2>(ap, bp, 128, smem, [&](const auto& acc, int r0, int c0) {
#pragma unroll
                for (int mi = 0; mi < 2; ++mi)
#pragma unroll
                    for (int ni = 0; ni < 4; ++ni) {
                        const int n = r0 + mi * 16, m0 = c0 + ni * 16;
                        float o[4];
#pragma unroll
                        for (int j = 0; j < 4; ++j) {
                            const int m = m0 + j;
                            float w = 0.f;
                            if (n >= m) w += exp2f(l0 * (float)(n - m));
                            if (m >= n) w += exp2f(l1 * (float)(m - n));
                            o[j] = acc[mi][ni][j] * w;
                        }
                        uint2 ov; ov.x = pack2(o[0], o[1]); ov.y = pack2(o[2], o[3]);
                        *(uint2*)(outp + (size_t)n * 384 + m0) = ov;
                    }
            });
        } else {
            const int v = u - 512, mt = v & 1, dir = (v >> 1) & 1, chh = v >> 2;
            APlain ap{p.B3 + ((size_t)chh * 256 + mt * 128) * 384, 384}; BPlain bp{p.KTz + ((size_t)chh * 2 + dir) * 128 * 128, 128};
            float* outp = p.KVT + (((size_t)chh * 2 + dir) * 256 + mt * 128) * 128;
            gemm_tile<128, 128, 4, 2>(ap, bp, 128, smem, [&](const auto& acc, int r0, int c0) {
#pragma unroll
                for (int mi = 0; mi < 2; ++mi)
#pragma unroll
                    for (int ni = 0; ni < 4; ++ni) *(f32x4*)(outp + (size_t)(r0 + mi * 16) * 128 + c0 + ni * 16) = acc[mi][ni];
            });
        }
    }
}

__device__ __forceinline__ void phase10(const Params& p, char* smem) {
    for (int idx = blockIdx.x * NT + tidx(); idx < 131072; idx += gridDim.x * NT) {
        const int hh = idx >> 15, dir = (idx >> 14) & 1, e = (idx >> 6) & 255, d = (idx & 63) * 2;
        const float g = sigm(p.ret_decay_logit[dir * 4 + hh]);
        const float g128 = exp2f(128.f * log2f(g));
        float R0 = 0.f, R1 = 0.f;
        const float* kvb = p.KVT + ((size_t)(hh * 2 + dir) * 256 + e) * 128 + d;
        bf16_t* rtb = p.B3 + ((size_t)hh * 256 + e) * 384 + 128 + dir * 128 + d;
        for (int s0 = 0; s0 < NCH; s0 += 13) {
            float2 kv[13];
#pragma unroll
            for (int i = 0; i < 13; ++i) { const int sc = s0 + i, c = dir == 0 ? sc : (sc < 2 ? 1 - sc : 131 - sc); kv[i] = *(const float2*)(kvb + (size_t)c * 262144); }
#pragma unroll
            for (int i = 0; i < 13; ++i) {
                const int sc = s0 + i, c = dir == 0 ? sc : (sc < 2 ? 1 - sc : 131 - sc);
                if (c >= 2) *(unsigned*)(rtb + (size_t)c * 393216) = pack2(R0, R1);
                R0 = g128 * R0 + kv[i].x; R1 = g128 * R1 + kv[i].y;
            }
        }
    }
}

__device__ __forceinline__ void phase11(const Params& p, char* smem) {
    for (int u = blockIdx.x; u < 1024; u += gridDim.x) {
        const int nt = u & 1, chh = 8 + (u >> 1), c = chh >> 2, hh = chh & 3;
        APlain ap{p.A3 + (size_t)chh * 128 * 384, 384}; BPlain bp{p.B3 + ((size_t)chh * 256 + nt * 128) * 384, 384};
        float* outp = p.Y + (size_t)((c - 2) * 128) * 1024 + hh * 256 + nt * 128;
        gemm_tile<128, 128, 4, 2>(ap, bp, 384, smem, [&](const auto& acc, int r0, int c0) {
#pragma unroll
            for (int mi = 0; mi < 2; ++mi)
#pragma unroll
                for (int ni = 0; ni < 4; ++ni) *(f32x4*)(outp + (size_t)(r0 + mi * 16) * 1024 + c0 + ni * 16) = acc[mi][ni];
        });
    }
}

__device__ __forceinline__ void phase12(const Params& p, char* smem) {
    const int tid = tidx(), wave = tid >> 6, lane = tid & 63;
    const int gw = blockIdx.x * 8 + wave, nw = gridDim.x * 8;
    float lw[8], lb[8], rk[8];
#pragma unroll
    for (int q = 0; q < 8; ++q) { lw[q] = p.rwkv_ln_w[lane * 8 + q]; lb[q] = p.rwkv_ln_b[lane * 8 + q]; rk[q] = p.rwkv_r_k[lane * 8 + q]; }
    for (int t = gw; t < TX; t += nw) {
        const size_t te = (size_t)(t + 256) * 512 + lane * 8;
        const uint4 uof = *(const uint4*)(p.O + (size_t)t * 512 + lane * 8), uob = *(const uint4*)(p.O + ((size_t)TX + t) * 512 + lane * 8);
        const uint4 ur = *(const uint4*)(p.Rr + te), uk0 = *(const uint4*)(p.KD + te), uk1 = *(const uint4*)(p.KD + (size_t)TE * 512 + te), uv = *(const uint4*)(p.Vv + te), ug = *(const uint4*)(p.G + te);
        const float* yp = p.Y + (size_t)t * 1024 + lane * 16;
        const float4 y0 = *(const float4*)(yp), y1 = *(const float4*)(yp + 4), y2 = *(const float4*)(yp + 8), y3 = *(const float4*)(yp + 12);
        const bf16_t* gbp = p.proj + (size_t)(t + 256) * INC + 3840 + lane * 16;
        const uint4 ugb0 = *(const uint4*)(gbp), ugb1 = *(const uint4*)(gbp + 8);
        {
            float of[8], ob[8], r[8], k0[8], k1[8], v[8], gg[8], o[8];
            unpack8(uof, of); unpack8(uob, ob); unpack8(ur, r); unpack8(uk0, k0); unpack8(uk1, k1); unpack8(uv, v); unpack8(ug, gg);
            float sm = 0.f, bs = 0.f;
#pragma unroll
            for (int q = 0; q < 8; ++q) { o[q] = of[q] + ob[q]; sm += o[q]; bs += r[q] * (k0[q] + k1[q]) * rk[q]; }
            sm += __shfl_xor(sm, 1, 64); sm += __shfl_xor(sm, 2, 64); sm += __shfl_xor(sm, 4, 64);
            bs += __shfl_xor(bs, 1, 64); bs += __shfl_xor(bs, 2, 64); bs += __shfl_xor(bs, 4, 64);
            const float mu = sm * (1.f / 64.f);
            float vs = 0.f;
#pragma unroll
            for (int q = 0; q < 8; ++q) { o[q] -= mu; vs += o[q] * o[q]; }
            vs += __shfl_xor(vs, 1, 64); vs += __shfl_xor(vs, 2, 64); vs += __shfl_xor(vs, 4, 64);
            const float rs = rsqrtf(vs * (1.f / 64.f) + 64e-5f);
            float ya[8];
#pragma unroll
            for (int q = 0; q < 8; ++q) ya[q] = (o[q] * rs * lw[q] + lb[q] + bs * v[q]) * gg[q];
            *(uint4*)(p.ya_in + (size_t)t * 512 + lane * 8) = pack8(ya);
        }
        {
            float y[16] = {y0.x, y0.y, y0.z, y0.w, y1.x, y1.y, y1.z, y1.w, y2.x, y2.y, y2.z, y2.w, y3.x, y3.y, y3.z, y3.w};
            float sm = 0.f;
#pragma unroll
            for (int q = 0; q < 16; ++q) sm += y[q];
            sm += __shfl_xor(sm, 1, 64); sm += __shfl_xor(sm, 2, 64); sm += __shfl_xor(sm, 4, 64); sm += __shfl_xor(sm, 8, 64);
            const float mu = sm * (1.f / 256.f);
            float vs = 0.f;
#pragma unroll
            for (int q = 0; q < 16; ++q) { y[q] -= mu; vs += y[q] * y[q]; }
            vs += __shfl_xor(vs, 1, 64); vs += __shfl_xor(vs, 2, 64); vs += __shfl_xor(vs, 4, 64); vs += __shfl_xor(vs, 8, 64);
            const float rs = rsqrtf(vs * (1.f / 256.f) + 1e-5f);
            float gb[16]; { float t0[8], t1[8]; unpack8(ugb0, t0); unpack8(ugb1, t1);
#pragma unroll
                for (int q = 0; q < 8; ++q) { gb[q] = t0[q]; gb[8 + q] = t1[q]; } }
            float o0[8], o1[8];
#pragma unroll
            for (int q = 0; q < 16; ++q) {
                const int c = lane * 16 + q;
                const float ov = (y[q] * rs * p.ret_ln_w[c] + p.ret_ln_b[c]) * (gb[q] * sigm(gb[q]));
                if (q < 8) o0[q] = ov; else o1[q - 8] = ov;
            }
            bf16_t* d = p.yb_in + (size_t)t * 1024 + lane * 16;
            *(uint4*)d = pack8(o0); *(uint4*)(d + 8) = pack8(o1);
        }
    }
}

__device__ __forceinline__ void phase13(const Params& p, char* smem) {
    for (int u = blockIdx.x; u < 512; u += gridDim.x) {
        const int mt = u >> 2, nt = u & 3;
        f32x4 acca[4][4], accb[4][4];
#pragma unroll
        for (int mi = 0; mi < 4; ++mi)
#pragma unroll
            for (int ni = 0; ni < 4; ++ni) { acca[mi][ni] = (f32x4){0.f, 0.f, 0.f, 0.f}; accb[mi][ni] = (f32x4){0.f, 0.f, 0.f, 0.f}; }
        { APlain ap{p.ya_in + (size_t)mt * 128 * 512, 512}; BPlain bp{p.WaT + (size_t)nt * 256 * 512, 512};
          gemm_core<128, 256, 2, 4>(acca, ap, bp, 512, smem); }
        { APlain ap{p.yb_in + (size_t)mt * 128 * 1024, 1024}; BPlain bp{p.WbT + (size_t)nt * 256 * 1024, 1024};
          gemm_core<128, 256, 2, 4>(accb, ap, bp, 1024, smem); }
        const int wave = tidx() >> 6, lane = tidx() & 63;
        const int r0 = (wave >> 2) * 64 + (lane & 15), c0 = (wave & 3) * 64 + (lane >> 4) * 4;
#pragma unroll
        for (int mi = 0; mi < 4; ++mi)
#pragma unroll
            for (int ni = 0; ni < 4; ++ni) {
                const int t = mt * 128 + r0 + mi * 16, c = nt * 256 + c0 + ni * 16;
                const bf16_t* gp = p.proj + (size_t)(t + 256) * INC + c;
                const uint2 ga = *(const uint2*)(gp + 4864), gb = *(const uint2*)(gp + 5888);
                float o[4];
                o[0] = sigm(__uint_as_float(ga.x << 16)) * acca[mi][ni][0] + sigm(__uint_as_float(gb.x << 16)) * accb[mi][ni][0];
                o[1] = sigm(__uint_as_float(ga.x & 0xffff0000u)) * acca[mi][ni][1] + sigm(__uint_as_float(gb.x & 0xffff0000u)) * accb[mi][ni][1];
                o[2] = sigm(__uint_as_float(ga.y << 16)) * acca[mi][ni][2] + sigm(__uint_as_float(gb.y << 16)) * accb[mi][ni][2];
                o[3] = sigm(__uint_as_float(ga.y & 0xffff0000u)) * acca[mi][ni][3] + sigm(__uint_as_float(gb.y & 0xffff0000u)) * accb[mi][ni][3];
                uint2 ov; ov.x = pack2(o[0], o[1]); ov.y = pack2(o[2], o[3]);
                *(uint2*)(p.merged + (size_t)t * 1024 + c) = ov;
            }
    }
}
__device__ __forceinline__ void phase14(const Params& p, char* smem) {
    g8::StaticOrder S; S.init(TX, 1024, gridDim.x, blockIdx.x);
    g8::EpiF32 E{p.mix, 1024};
    g8::gemm_phase((LAS unsigned char*)smem, p.merged, p.WoT, 1024, 1024, 1024, S, E);
}

__device__ __forceinline__ void phase15(const Params& p, char* smem) {
    const int tid = tidx(), wave = tid >> 6, lane = tid & 63;
    const int gw = blockIdx.x * 8 + wave, nw = gridDim.x * 8;
    const float* g1 = p.mod + 2048; const float* sh2 = p.mod + 3072; const float* sc2 = p.mod + 4096;
    for (int t = gw; t < TX; t += nw) {
        float4 mv[4], xm[4]; float ss = 0.f;
#pragma unroll
        for (int i = 0; i < 4; ++i) { mv[i] = *(const float4*)(p.mix + (size_t)t * 1024 + i * 256 + lane * 4); ss += mv[i].x * mv[i].x + mv[i].y * mv[i].y + mv[i].z * mv[i].z + mv[i].w * mv[i].w; }
        ss = wsum(ss);
        const float rs = rsqrtf(ss * (1.f / 1024.f) + 1e-6f);
        float s2 = 0.f;
#pragma unroll
        for (int i = 0; i < 4; ++i) {
            const int col = i * 256 + lane * 4;
            const float4 xv = *(const float4*)(p.x + (size_t)t * 1024 + col);
            const float4 gn = *(const float4*)(p.n_post_mix + col), gg = *(const float4*)(g1 + col);
            xm[i].x = xv.x + gg.x * (mv[i].x * rs * gn.x); xm[i].y = xv.y + gg.y * (mv[i].y * rs * gn.y);
            xm[i].z = xv.z + gg.z * (mv[i].z * rs * gn.z); xm[i].w = xv.w + gg.w * (mv[i].w * rs * gn.w);
            *(float4*)(p.x_mid + (size_t)t * 1024 + col) = xm[i];
            s2 += xm[i].x * xm[i].x + xm[i].y * xm[i].y + xm[i].z * xm[i].z + xm[i].w * xm[i].w;
        }
        s2 = wsum(s2);
        const float rs2 = rsqrtf(s2 * (1.f / 1024.f) + 1e-6f);
#pragma unroll
        for (int i = 0; i < 4; ++i) {
            const int col = i * 256 + lane * 4;
            const float4 gn = *(const float4*)(p.n_pre_ffn + col), sc = *(const float4*)(sc2 + col), sh = *(const float4*)(sh2 + col);
            float h[4];
            h[0] = xm[i].x * rs2 * gn.x * (1.f + sc.x) + sh.x; h[1] = xm[i].y * rs2 * gn.y * (1.f + sc.y) + sh.y;
            h[2] = xm[i].z * rs2 * gn.z * (1.f + sc.z) + sh.z; h[3] = xm[i].w * rs2 * gn.w * (1.f + sc.w) + sh.w;
            uint2 hi; hi.x = pack2(h[0], h[1]); hi.y = pack2(h[2], h[3]);
            *(uint2*)(p.Ahl + (size_t)t * 1024 + col) = hi;
        }
    }
}

__device__ __forceinline__ void phase16(const Params& p, char* smem) {
    for (int u = blockIdx.x; u < 256; u += gridDim.x) {
        const int mt = u >> 1, nt = u & 1;
        APlain ap{p.Ahl + (size_t)mt * 128 * 1024, 1024}; BPlain bp{p.RtT + (size_t)nt * 128 * 1024, 1024};
        float* outp = p.logits + (size_t)mt * 128 * 256 + nt * 128;
        gemm_tile<128, 128, 4, 2>(ap, bp, 1024, smem, [&](const auto& acc, int r0, int c0) {
#pragma unroll
            for (int mi = 0; mi < 2; ++mi)
#pragma unroll
                for (int ni = 0; ni < 4; ++ni) *(f32x4*)(outp + (size_t)(r0 + mi * 16) * 256 + c0 + ni * 16) = acc[mi][ni];
        });
    }
}

__device__ __forceinline__ void phase17(const Params& p, char* smem) {
    const int tid = tidx(), wave = tid >> 6, lane = tid & 63;
    int* hist = (int*)smem;
    if (tid < 256) hist[tid] = 0;
    __syncthreads();
    const int TPB = TX / gridDim.x;
    constexpr int NTK = 4;
    for (int ti = wave * NTK; ti < TPB; ti += 8 * NTK) {
        const int t0 = blockIdx.x * TPB + ti;
        float sc[NTK][4], key[NTK][4], mys[NTK], ssum[NTK]; int mye[NTK];
#pragma unroll
        for (int n = 0; n < NTK; ++n) {
            mys[n] = 0.f; ssum[n] = 0.f; mye[n] = 0;
#pragma unroll
            for (int i = 0; i < 4; ++i) { const int e = lane + 64 * i; sc[n][i] = sigm(p.logits[(size_t)(t0 + n) * 256 + e]); key[n][i] = sc[n][i] + p.router_bias[e]; }
        }
#pragma unroll 1
        for (int k = 0; k < 8; ++k) {
            float bv[NTK]; int be[NTK];
#pragma unroll
            for (int n = 0; n < NTK; ++n) { bv[n] = -1e30f; be[n] = 1 << 20;
#pragma unroll
                for (int i = 0; i < 4; ++i) if (key[n][i] > bv[n]) { bv[n] = key[n][i]; be[n] = lane + 64 * i; } }
#pragma unroll
            for (int o = 32; o; o >>= 1) {
#pragma unroll
                for (int n = 0; n < NTK; ++n) {
                    const float ov = __shfl_xor(bv[n], o, 64); const int oe = __shfl_xor(be[n], o, 64);
                    if (ov > bv[n] || (ov == bv[n] && oe < be[n])) { bv[n] = ov; be[n] = oe; }
                }
            }
#pragma unroll
            for (int n = 0; n < NTK; ++n) {
                float sv = 0.f;
                if ((be[n] & 63) == lane) {
#pragma unroll
                    for (int i = 0; i < 4; ++i) if ((be[n] >> 6) == i) { sv = sc[n][i]; key[n][i] = -1e30f; }
                }
                sv = __shfl(sv, be[n] & 63, 64);
                ssum[n] += sv;
                if (lane == k) { mys[n] = sv; mye[n] = be[n]; }
            }
        }
        if (lane < 8) {
#pragma unroll
            for (int n = 0; n < NTK; ++n) {
                const int t = t0 + n;
                const int pos = atomicAdd(&hist[mye[n]], 1);
                p.tok_e[t * 8 + lane] = mye[n]; p.tok_pos[t * 8 + lane] = pos; p.tok_w[t * 8 + lane] = mys[n] / ssum[n] * 2.5f;
            }
        }
    }
    __syncthreads();
    if (tid < 256) p.bh[blockIdx.x * 256 + tid] = hist[tid];
}

__device__ __forceinline__ void phase18(const Params& p, char* smem) {
    const int tid = tidx();
    int* ps = (int*)smem;
    int* xs = ps + 260;
    int* cntL = xs + 260;
    int* baseL = cntL + 256;
    int* part = baseL + 256;
    {
        const int e = tid & 255, half = tid >> 8, G = gridDim.x, b0 = half * (G >> 1), b1 = b0 + (G >> 1);
        int tot = 0, bef = 0;
        for (int bb = b0; bb < b1; bb += 16) {
            int v[16];
#pragma unroll
            for (int i = 0; i < 16; ++i) v[i] = p.bh[(bb + i) * 256 + e];
#pragma unroll
            for (int i = 0; i < 16; ++i) { tot += v[i]; bef += (bb + i < (int)blockIdx.x) ? v[i] : 0; }
        }
        part[half * 256 + e] = tot; part[512 + half * 256 + e] = bef;
    }
    __syncthreads();
    if (tid < 256) { cntL[tid] = part[tid] + part[256 + tid]; baseL[tid] = part[512 + tid] + part[768 + tid]; }
    __syncthreads();
    if (tid < 64) {
        int c[4], tot = 0, ttot = 0;
#pragma unroll
        for (int q = 0; q < 4; ++q) { c[q] = cntL[tid * 4 + q]; tot += c[q]; ttot += (c[q] + 255) >> 8; }
        int incl = tot, tincl = ttot;
#pragma unroll
        for (int o = 1; o < 64; o <<= 1) { const int v = __shfl_up(incl, o, 64), tv = __shfl_up(tincl, o, 64); if (tid >= o) { incl += v; tincl += tv; } }
        int ex = incl - tot, tex = tincl - ttot;
#pragma unroll
        for (int q = 0; q < 4; ++q) { ps[tid * 4 + q] = ex; xs[tid * 4 + q] = tex; ex += c[q]; tex += (c[q] + 255) >> 8; }
        if (tid == 63) { ps[256] = incl; xs[256] = tincl; }
    }
    __syncthreads();
    if (blockIdx.x == 0) {
        const int nx = xs[256];
        if (tid == 0) *p.ntiles = nx + 64;
        for (int e = tid; e < 256; e += NT) {
            const int c = ps[e + 1] - ps[e];
            for (int t = 0; t < ((c + 255) >> 8); ++t) { int* x = p.xt + (xs[e] + t) * 4; x[0] = e; x[1] = ps[e] + 256 * t; x[2] = min(256, c - 256 * t); x[3] = 0; }
        }
        if (tid < 64) { int* x = p.xt + (nx + tid) * 4; x[0] = 256; x[1] = 131072 + 256 * tid; x[2] = 256; x[3] = 0; }
        if (tid < 256) p.slot_tk[NSLOT + tid] = 0;
    }
    const int TPB = TX / gridDim.x;
    for (int li = tid; li < TPB * 8; li += NT) {
        const int i = blockIdx.x * TPB * 8 + li, e = p.tok_e[i];
        p.slot_tk[ps[e] + baseL[e] + p.tok_pos[i]] = (i >> 3) * 9 + (i & 7);
    }
    for (int t = blockIdx.x * NT + tid; t < TX; t += gridDim.x * NT) p.slot_tk[131072 + t] = t * 9 + 8;
}

__device__ __forceinline__ void phase19(const Params& p, char* smem) {
    const int nun = *p.ntiles * 2;
    const int lb = (blockIdx.x & 7) * (gridDim.x >> 3) + (blockIdx.x >> 3);
    for (int u = lb; u < nun; u += gridDim.x) {
        const int* x = p.xt + (u >> 1) * 4; const int nt = u & 1;
        const int e = x[0], row0 = x[1], nrows = x[2];
        const float* wg = (e < 256 ? p.exp_w_gate + (size_t)e * 262144 : p.sh_w_gate) + nt * 128;
        const float* wu = (e < 256 ? p.exp_w_up + (size_t)e * 262144 : p.sh_w_up) + nt * 128;
        AGather ap{p.Ahl, 1024, p.slot_tk + row0};
        BKNGU bp{wg, wu};
        bf16_t* outp = p.act + (size_t)row0 * 256 + nt * 128;
        gemm_tile<256, 256, 2, 4>(ap, bp, 1024, smem, [&](const auto& acc, int r0, int c0) {
#pragma unroll
            for (int mi = 0; mi < 8; ++mi) {
                if (r0 + mi * 16 < nrows) {
#pragma unroll
                    for (int gp = 0; gp < 2; ++gp) {
                        const int g = (c0 >> 5) + gp, fq4 = c0 & 15;
                        float o[4];
#pragma unroll
                        for (int j = 0; j < 4; ++j) { const float gt = acc[mi][gp * 2][j], up = acc[mi][gp * 2 + 1][j]; o[j] = gt * sigm(gt) * up; }
                        uint2 ov; ov.x = pack2(o[0], o[1]); ov.y = pack2(o[2], o[3]);
                        *(uint2*)(outp + (size_t)(r0 + mi * 16) * 256 + g * 16 + fq4) = ov;
                    }
                }
            }
        });
    }
}

__device__ __forceinline__ void phase20(const Params& p, char* smem) {
    const int nun = *p.ntiles * 4;
    const int lb = (blockIdx.x & 7) * (gridDim.x >> 3) + (blockIdx.x >> 3);
    for (int u = lb; u < nun; u += gridDim.x) {
        const int* x = p.xt + (u >> 2) * 4; const int nt = u & 3;
        const int e = x[0], row0 = x[1], nrows = x[2];
        APlain ap{p.act + (size_t)row0 * 256, 256};
        BKN bp{(e < 256 ? p.exp_w_down + (size_t)e * 262144 : p.sh_w_down) + nt * 256, 1024};
        const int* stk = p.slot_tk + row0;
        gemm_tile<256, 256, 2, 4>(ap, bp, 256, smem, [&](const auto& acc, int r0, int c0) {
#pragma unroll
            for (int mi = 0; mi < 8; ++mi) {
                const int r = r0 + mi * 16;
                if (r < nrows) {
                    bf16_t* d = p.yk + (size_t)stk[r] * 1024 + nt * 256 + c0;
#pragma unroll
                    for (int ni = 0; ni < 4; ++ni) {
                        uint2 ov; ov.x = pack2(acc[mi][ni][0], acc[mi][ni][1]); ov.y = pack2(acc[mi][ni][2], acc[mi][ni][3]);
                        *(uint2*)(d + ni * 16) = ov;
                    }
                }
            }
        });
    }
}

__device__ __forceinline__ void phase21(const Params& p, char* smem) {
    const int tid = tidx(), wave = tid >> 6, lane = tid & 63;
    const int gw = blockIdx.x * 8 + wave, nw = gridDim.x * 8;
    const float* g2 = p.mod + 5120;
    for (int t = gw; t < TX; t += nw) {
        float w[9];
#pragma unroll
        for (int k = 0; k < 8; ++k) w[k] = p.tok_w[t * 8 + k];
        w[8] = 1.f;
        float4 mo[4]; float ss = 0.f;
#pragma unroll
        for (int i = 0; i < 4; ++i) {
            const int col = i * 256 + lane * 4;
            float a0 = 0.f, a1 = 0.f, a2 = 0.f, a3 = 0.f;
#pragma unroll
            for (int k = 0; k < 9; ++k) {
                const uint2 v = *(const uint2*)(p.yk + ((size_t)t * 9 + k) * 1024 + col);
                a0 += w[k] * __uint_as_float(v.x << 16); a1 += w[k] * __uint_as_float(v.x & 0xffff0000u); a2 += w[k] * __uint_as_float(v.y << 16); a3 += w[k] * __uint_as_float(v.y & 0xffff0000u);
            }
            mo[i] = make_float4(a0, a1, a2, a3);
            ss += a0 * a0 + a1 * a1 + a2 * a2 + a3 * a3;
        }
        ss = wsum(ss);
        const float rs = rsqrtf(ss * (1.f / 1024.f) + 1e-6f);
#pragma unroll
        for (int i = 0; i < 4; ++i) {
            const int col = i * 256 + lane * 4;
            const float4 xm = *(const float4*)(p.x_mid + (size_t)t * 1024 + col);
            const float4 gn = *(const float4*)(p.n_post_ffn + col), gg = *(const float4*)(g2 + col);
            float4 o;
            o.x = xm.x + gg.x * (mo[i].x * rs * gn.x); o.y = xm.y + gg.y * (mo[i].y * rs * gn.y);
            o.z = xm.z + gg.z * (mo[i].z * rs * gn.z); o.w = xm.w + gg.w * (mo[i].w * rs * gn.w);
            *(float4*)(p.out + (size_t)t * 1024 + col) = o;
        }
    }
}

constexpr int NPHASE = 22;
template <int PH> __device__ __forceinline__ void run_phase(const Params& p, char* smem) {
    if constexpr (PH == 0) phase0(p, smem);
    else if constexpr (PH == 1) phase1(p, smem);
    else if constexpr (PH == 2) phase2(p, smem);
    else if constexpr (PH == 3) phase3(p, smem);
    else if constexpr (PH == 4) phase4(p, smem);
    else if constexpr (PH == 5) phase5(p, smem);
    else if constexpr (PH == 6) phase6(p, smem);
    else if constexpr (PH == 7) phase7(p, smem);
    else if constexpr (PH == 8) phase8(p, smem);
    else if constexpr (PH == 9) phase9(p, smem);
    else if constexpr (PH == 10) phase10(p, smem);
    else if constexpr (PH == 11) phase11(p, smem);
    else if constexpr (PH == 12) phase12(p, smem);
    else if constexpr (PH == 13) phase13(p, smem);
    else if constexpr (PH == 14) phase14(p, smem);
    else if constexpr (PH == 15) phase15(p, smem);
    else if constexpr (PH == 16) phase16(p, smem);
    else if constexpr (PH == 17) phase17(p, smem);
    else if constexpr (PH == 18) phase18(p, smem);
    else if constexpr (PH == 19) phase19(p, smem);
    else if constexpr (PH == 20) phase20(p, smem);
    else phase21(p, smem);
}

template <int PH> __global__ void __launch_bounds__(NT, 2) k_phase(Params p) {
    extern __shared__ __attribute__((aligned(16))) char smem[];
    run_phase<PH>(p, smem);
}

template <int PH> __device__ __forceinline__ void mega_run(const Params& p, char* smem, const XcdBarrier& bar) {
    run_phase<PH>(p, smem);
    if constexpr (((PROBE_MASK) >> PH) & 1u) { xcd_barrier(bar); run_phase<PH>(p, smem); }
    if constexpr (PH + 1 < NPHASE) { xcd_barrier(bar); mega_run<PH + 1>(p, smem, bar); }
}
__global__ void __launch_bounds__(NT, 2) k_mega(Params p) {
    extern __shared__ __attribute__((aligned(16))) char smem[];
    uint4* xbw = (uint4*)(smem + 8 * TILE_BYTES);
    if (tidx() == 0) *xbw = make_uint4(0u, 0u, 0u, 0u);
    __syncthreads();
    XcdBarrier bar = xcd_barrier_post(p.bar, (volatile LAS unsigned*)xbw);
    mega_run<0>(p, smem, bar);
}

template <int PH> static void launch_phases(const Params& p, int grid, hipStream_t stream) {
    static bool attr = false;
    if (!attr) { (void)hipFuncSetAttribute((const void*)k_phase<PH>, hipFuncAttributeMaxDynamicSharedMemorySize, LDS_BYTES); attr = true; }
    hipLaunchKernelGGL(k_phase<PH>, dim3(grid), dim3(NT), LDS_BYTES, stream, p);
    if constexpr (PH + 1 < NPHASE) launch_phases<PH + 1>(p, grid, stream);
}

extern "C" void kernel_launch(void* const* d_in, const int* in_sizes, int n_in, void* d_out, int out_size, void* d_ws, size_t ws_size, hipStream_t stream) {
    static int grid = 0;
    if (grid == 0) {
        int dev = 0, cus = 0, per_cu = 0;
        (void)hipGetDevice(&dev); (void)hipDeviceGetAttribute(&cus, hipDeviceAttributeMultiprocessorCount, dev);
        (void)hipFuncSetAttribute((const void*)k_mega, hipFuncAttributeMaxDynamicSharedMemorySize, LDS_BYTES);
        (void)hipOccupancyMaxActiveBlocksPerMultiprocessor(&per_cu, (const void*)k_mega, NT, LDS_BYTES);
        (void)hipGetLastError();
        if (cus <= 0) cus = 256;
        grid = cus * (per_cu >= 2 ? 2 : 1);
    }
    Params p{};
    const float** pin = (const float**)&p.x;
    for (int i = 0; i < 36; ++i) pin[i] = (const float*)d_in[i];
    p.out = (float*)d_out;
    char* ws = (char*)d_ws; size_t off = 0;
    auto alloc = [&](size_t bytes) { size_t o = off; off += (bytes + 255) & ~(size_t)255; return ws + o; };
    p.bar = (unsigned*)alloc(XCD_BAR_WORDS * 4); p.cnt = (int*)alloc(256 * 4);
    const size_t zero_bytes = off;
    p.slot_tk = (int*)alloc((size_t)(NSLOT + 256) * 4); p.bh = (int*)alloc(1024 * 256 * 4);
    p.xt = (int*)alloc(NXT_MAX * 16); p.ntiles = (int*)alloc(256);
    p.tok_e = (int*)alloc((size_t)TX * 8 * 4); p.tok_pos = (int*)alloc((size_t)TX * 8 * 4); p.tok_w = (float*)alloc((size_t)TX * 8 * 4);
    p.modp = (float*)alloc(16 * 2 * 6144 * 4); p.mod = (float*)alloc(2 * 6144 * 4);
    p.WinT = (bf16_t*)alloc((size_t)INC * 1024 * 2); p.WaT = (bf16_t*)alloc(1024 * 512 * 2); p.WbT = (bf16_t*)alloc(1024 * 1024 * 2); p.WoT = (bf16_t*)alloc(1024 * 1024 * 2);
    p.RtT = (bf16_t*)alloc(256 * 3072 * 2); p.ShGU = (bf16_t*)alloc(512 * 1024 * 2); p.ShD = (bf16_t*)alloc(1024 * 256 * 2);
    p.WupT = (bf16_t*)alloc(1024 * 64 * 2); p.AupT = (bf16_t*)alloc(1024 * 64 * 2); p.GupT = (bf16_t*)alloc(512 * 128 * 2);
    p.ya_in = (bf16_t*)alloc((size_t)TX * 512 * 2); p.yb_in = (bf16_t*)alloc((size_t)TX * 1024 * 2);
    char* RA = alloc((size_t)TE * INC * 2);
    p.proj = (bf16_t*)RA;
    { size_t o = 0; auto sub = [&](size_t b) { char* r = RA + o; o += (b + 255) & ~(size_t)255; return r; };
      p.act = (bf16_t*)sub(((size_t)NSLOT + 256) * 256 * 2); p.logits = (float*)sub((size_t)TX * 256 * 4); }
    const size_t surv = (size_t)TE * 512 * 2 * 5 + (size_t)2 * TX * 512 * 2 + 4096;
    const size_t rtmp = 424935424 + 65536;
    char* RB = alloc(surv + rtmp);
    { size_t o = 0; auto sub = [&](size_t b) { char* r = RB + o; o += (b + 255) & ~(size_t)255; return r; };
      p.Rr = (bf16_t*)sub((size_t)TE * 512 * 2); p.Vv = (bf16_t*)sub((size_t)TE * 512 * 2); p.KD = (bf16_t*)sub((size_t)2 * TE * 512 * 2); p.G = (bf16_t*)sub((size_t)TE * 512 * 2);
      p.O = (bf16_t*)sub((size_t)2 * TX * 512 * 2);
      const size_t o_t = o;
      p.Kk = (bf16_t*)sub((size_t)TE * 512 * 2); p.Aa = (bf16_t*)sub((size_t)TE * 512 * 2); p.Bd = (bf16_t*)sub((size_t)2 * TE * 512 * 2);
      p.Wd = (float*)sub((size_t)2 * TE * 512 * 4); p.TW = (bf16_t*)sub((size_t)TE * 64 * 2); p.XA = (bf16_t*)sub((size_t)TE * 64 * 2); p.SG = (bf16_t*)sub((size_t)TE * 128 * 2);
      p.PH = (float*)sub((size_t)127 * 16 * 2 * 4096 * 4); p.Sst = (float*)sub((size_t)128 * 16 * 4096 * 4);
      p.Zz = (float*)sub((size_t)RNC * 16 * RL * 64 * 4); p.YH = (float*)sub((size_t)RNC * 16 * RL * 64 * 4);
      p.hn = (bf16_t*)p.PH;
      o = o_t;
      p.Qr = (bf16_t*)sub((size_t)NCH * 4 * 128 * 128 * 2); p.Kr = (bf16_t*)sub((size_t)NCH * 4 * 128 * 128 * 2); p.KTz = (bf16_t*)sub((size_t)NCH * 4 * 2 * 128 * 128 * 2);
      p.A3 = (bf16_t*)sub((size_t)NCH * 4 * 128 * 384 * 2); p.B3 = (bf16_t*)sub((size_t)NCH * 4 * 256 * 384 * 2);
      p.KVT = (float*)sub((size_t)NCH * 4 * 2 * 256 * 128 * 4); p.Y = (float*)sub((size_t)TX * 1024 * 4);
      o = 0;
      p.x_mid = (float*)sub((size_t)TX * 1024 * 4); p.Ahl = (bf16_t*)sub((size_t)TX * 1024 * 2);
      p.yk = (bf16_t*)sub((size_t)TX * 9 * 1024 * 2);
      char* yk0 = (char*)p.yk; p.mergedA = (float*)yk0; p.merged = (bf16_t*)(yk0 + (size_t)TX * 1024 * 4); p.mix = (float*)(yk0 + (size_t)TX * 1024 * 6);
    }
    if (off > ws_size) { fprintf(stderr, "kernel_launch: workspace too small: need %zu have %zu\n", off, ws_size); return; }
    int j = 0;
    p.jobs[j++] = TJob{p.w_in, p.WinT, 1024, INC, 1024, 0, 0, 0};
    p.jobs[j++] = TJob{p.w_branch_a, p.WaT, 512, 1024, 512, 0, 0, 0};
    p.jobs[j++] = TJob{p.w_branch_b, p.WbT, 1024, 1024, 1024, 0, 0, 0};
    p.jobs[j++] = TJob{p.w_out, p.WoT, 1024, 1024, 1024, 0, 0, 0};
    p.jobs[j++] = TJob{p.router_w, p.RtT, 1024, 256, 1024, 0, 0, 0};
    p.jobs[j++] = TJob{p.rwkv_g_up, p.GupT, 0, 0, 128, 0, 0, 0};
    p.jobs[j++] = TJob{p.rwkv_g_up, p.GupT, 0, 0, 128, 0, 0, 0};
    p.jobs[j++] = TJob{p.rwkv_g_up, p.GupT, 0, 0, 128, 0, 0, 0};
    p.jobs[j++] = TJob{p.rwkv_w_up, p.WupT, 64, 512, 64, 0, 0, 0};
    p.jobs[j++] = TJob{p.rwkv_w_up + 64 * 512, p.WupT, 64, 512, 64, 0, 512, 0};
    p.jobs[j++] = TJob{p.rwkv_a_up, p.AupT, 64, 512, 64, 0, 0, 0};
    p.jobs[j++] = TJob{p.rwkv_a_up + 64 * 512, p.AupT, 64, 512, 64, 0, 512, 0};
    p.jobs[j++] = TJob{p.rwkv_g_up, p.GupT, 128, 512, 128, 0, 0, 0};
    p.jobs[j++] = TJob{p.rwkv_g_up, p.GupT, 0, 0, 128, 0, 0, 0};
    (void)hipMemsetAsync(ws, 0, zero_bytes, stream);
#if MK_ONE_LAUNCH
    hipLaunchKernelGGL(k_mega, dim3(grid), dim3(NT), LDS_BYTES, stream, p);
#else
    launch_phases<0>(p, grid, stream);
#endif
}
```

```cpp
#include <hip/hip_runtime.h>
#include <stdint.h>
#include <stdio.h>

#ifndef MK_ONE_LAUNCH
#define MK_ONE_LAUNCH 1
#endif
#ifndef ROUTER_K
#define ROUTER_K 1024
#endif
#ifndef PROBE_MASK
#define PROBE_MASK 0u
#endif

typedef unsigned short bf16_t;
typedef short bf16x8 __attribute__((ext_vector_type(8)));
typedef float f32x4 __attribute__((ext_vector_type(4)));
typedef float f32x2 __attribute__((ext_vector_type(2)));

#define NT 512
constexpr int TX = 16384, TC = 256, TE = 16640, DM = 1024, INC = 6912;
constexpr int NCH = 130;
constexpr int RL = 130, RNC = 128;
constexpr int TSTR = 144;
constexpr int TILE_BYTES = 128 * TSTR;
constexpr int LDS_BYTES = 8 * TILE_BYTES + 1024;
constexpr int NSLOT = 131072 + 16384;
constexpr int NXT_MAX = 768 + 64;

#define XB_TMO      128
#define XB_XCNT(j)  (256  + 64 * (j))
#define XB_XSUB(j)  (1280 + 64 * (j))
#define XB_XGEN(j)  (2304 + 64 * (j))
#define XB_TOP      3328
#define XB_TOPGEN   3392
#define XCD_BAR_WORDS 3456
#define XB_SPIN_CAP (1u << 18)
#define LAS __attribute__((address_space(3)))

__device__ __forceinline__ unsigned xb_ld(unsigned* p)              { return __hip_atomic_load(p, __ATOMIC_RELAXED, __HIP_MEMORY_SCOPE_AGENT); }
__device__ __forceinline__ unsigned xb_add(unsigned* p, unsigned v) { return __hip_atomic_fetch_add(p, v, __ATOMIC_RELAXED, __HIP_MEMORY_SCOPE_AGENT); }
__device__ __forceinline__ unsigned xb_xcc_id() { return (unsigned)__builtin_amdgcn_s_getreg((3 << 11) | 20) & 0xFu; }
#define XB_SPIN(cond, bar) do { unsigned _sp = 0; while (cond) { __builtin_amdgcn_s_sleep(1); \
    if ((++_sp & 255u) == 0u) { if (xb_ld(&(bar)[XB_TMO])) break; if (_sp > XB_SPIN_CAP) { atomicAdd(&(bar)[XB_TMO], 1u); break; } } } } while (0)

struct XcdBarrier { unsigned* bar; unsigned x; volatile LAS unsigned* st; };

__device__ __forceinline__ XcdBarrier xcd_barrier_post(unsigned* bar, volatile LAS unsigned* st) {
    XcdBarrier b; b.bar = bar; b.x = xb_xcc_id(); b.st = st;
    if (threadIdx.x == 0) (void)xb_add(&bar[XB_XCNT(b.x)], 1u);
    return b;
}
__device__ __forceinline__ void xcd_barrier_complete(unsigned* bar, unsigned x, unsigned& nloc, unsigned& nx) {
    const unsigned G = gridDim.x * gridDim.y * gridDim.z;
    unsigned sum, cnt, mine, sp = 0u;
    for (;;) {
        sum = 0u; cnt = 0u; mine = 0u;
#pragma unroll
        for (unsigned j = 0; j < 16; ++j) { const unsigned c = xb_ld(&bar[XB_XCNT(j)]); sum += c; cnt += (c > 0u) ? 1u : 0u; mine = (j == x) ? c : mine; }
        if (sum == G) break;
        __builtin_amdgcn_s_sleep(1);
        if ((++sp & 255u) == 0u) { if (xb_ld(&bar[XB_TMO])) break; if (sp > XB_SPIN_CAP) { atomicAdd(&bar[XB_TMO], 1u); break; } }
    }
    nloc = mine > 0u ? mine : 1u; nx = cnt > 0u ? cnt : 1u;
}
__device__ __forceinline__ void xcd_barrier(const XcdBarrier& b) {
    asm volatile("s_waitcnt vmcnt(0)" ::: "memory");
    __syncthreads();
    if (threadIdx.x == 0) {
        unsigned* bar = b.bar;
        __builtin_amdgcn_s_waitcnt(0);
        unsigned nloc = b.st[0], nx = b.st[1];
        if (nloc == 0u) { xcd_barrier_complete(bar, b.x, nloc, nx); b.st[0] = nloc; b.st[1] = nx; }
        const unsigned old = xb_add(&bar[XB_XSUB(b.x)], 1u);
        const unsigned gen = old / nloc;
        if (old + 1u == (gen + 1u) * nloc) {
            __builtin_amdgcn_fence(__ATOMIC_RELEASE, "agent");
            asm volatile("s_waitcnt vmcnt(0)" ::: "memory");
            const unsigned og = xb_add(&bar[XB_TOP], 1u);
            const unsigned tg = og / nx;
            if (og + 1u == (tg + 1u) * nx) xb_add(&bar[XB_TOPGEN], 1u);
            else XB_SPIN(xb_ld(&bar[XB_TOPGEN]) == tg, bar);
            __builtin_amdgcn_fence(__ATOMIC_ACQUIRE, "agent");
            xb_add(&bar[XB_XGEN(b.x)], 1u);
            asm volatile("s_waitcnt vmcnt(0)" ::: "memory");
        } else {
            XB_SPIN(xb_ld(&bar[XB_XGEN(b.x)]) == gen, bar);
            __builtin_amdgcn_fence(__ATOMIC_ACQUIRE, "agent");
            asm volatile("s_waitcnt vmcnt(0)" ::: "memory");
        }
    }
    __syncthreads();
}

struct TJob { const float* src; bf16_t* dst; int K, N, dld, mode, rowoff, coloff; };
constexpr int NJOB = 14;

struct Params {
    const float *x, *c, *ctx, *c_ctx, *w_mod, *b_mod, *n_pre_mix, *n_post_mix, *n_pre_ffn, *n_post_ffn,
        *w_in, *shift_mu, *rwkv_w0, *rwkv_w_up, *rwkv_a0, *rwkv_a_up, *rwkv_g_up, *rwkv_k_k, *rwkv_k_a, *rwkv_r_k,
        *rwkv_ln_w, *rwkv_ln_b, *w_branch_a, *ret_decay_logit, *ret_ln_w, *ret_ln_b, *w_branch_b, *w_out,
        *router_w, *router_bias, *exp_w_gate, *exp_w_up, *exp_w_down, *sh_w_gate, *sh_w_up, *sh_w_down;
    float* out;
    unsigned* bar; int* cnt; int* bh; int* slot_tk; int* xt; int* ntiles; int* tok_e; int* tok_pos; float* tok_w;
    float* modp; float* mod;
    bf16_t *WinT, *WaT, *WbT, *WoT, *RtT, *ShGU, *ShD, *WupT, *AupT, *GupT;
    bf16_t *hn, *proj;
    bf16_t *Rr, *Vv, *KD, *G, *O;
    bf16_t *Kk, *Aa, *Bd, *TW, *XA, *SG;
    float *Wd, *PH, *Sst, *Zz, *YH;
    bf16_t *Qr, *Kr, *KTz, *A3, *B3;
    float *KVT, *Y;
    bf16_t *ya_in, *yb_in, *merged, *Ahl, *act, *yk;
    float *mergedA, *mix, *x_mid, *logits;
    TJob jobs[NJOB];
};

__device__ __forceinline__ int tidx() { int t = threadIdx.x; asm volatile("" : "+v"(t)); return t; }
__device__ __forceinline__ float bf2f(bf16_t v) { return __uint_as_float(((unsigned)v) << 16); }
__device__ __forceinline__ bf16_t f2bf(float f) { unsigned u = __float_as_uint(f); u += 0x7fffu + ((u >> 16) & 1u); return (bf16_t)(u >> 16); }
__device__ __forceinline__ unsigned pack2(float lo, float hi) { return (unsigned)f2bf(lo) | ((unsigned)f2bf(hi) << 16); }
__device__ __forceinline__ void unpack8(const uint4& v, float (&f)[8]) {
    f[0] = __uint_as_float(v.x << 16); f[1] = __uint_as_float(v.x & 0xffff0000u); f[2] = __uint_as_float(v.y << 16); f[3] = __uint_as_float(v.y & 0xffff0000u);
    f[4] = __uint_as_float(v.z << 16); f[5] = __uint_as_float(v.z & 0xffff0000u); f[6] = __uint_as_float(v.w << 16); f[7] = __uint_as_float(v.w & 0xffff0000u); }
__device__ __forceinline__ uint4 pack8(const float (&f)[8]) { uint4 o; o.x = pack2(f[0], f[1]); o.y = pack2(f[2], f[3]); o.z = pack2(f[4], f[5]); o.w = pack2(f[6], f[7]); return o; }
__device__ __forceinline__ float wsum(float v) {
#pragma unroll
    for (int o = 32; o; o >>= 1) v += __shfl_xor(v, o, 64);
    return v;
}
__device__ __forceinline__ float sigm(float z) { return 1.f / (1.f + __expf(-z)); }
__device__ __forceinline__ int row_of(int dir, int s) { return dir == 0 ? s : (s < 256 ? 255 - s : 16895 - s); }

struct APlain { const bf16_t* base; int ld;
    __device__ __forceinline__ const char* bptr() const { return (const char*)base; }
    __device__ __forceinline__ unsigned rowoff(int r) const { return (unsigned)(r * ld) * 2u; } };
struct AGather { const bf16_t* base; int ld; const int* idx;
    __device__ __forceinline__ const char* bptr() const { return (const char*)base; }
    __device__ __forceinline__ unsigned rowoff(int r) const { const int tok = idx[r] / 9; return (unsigned)(tok * ld) * 2u; } };
struct BPlain { static constexpr int MODE = 0; const bf16_t* base; int ldv;
    __device__ __forceinline__ const char* bptr() const { return (const char*)base; }
    __device__ __forceinline__ unsigned rowoff(int n) const { return (unsigned)(n * ldv) * 2u; }
    __device__ __forceinline__ const float* colptr(int) const { return nullptr; }
    __device__ __forceinline__ long ld() const { return ldv; }
    __device__ __forceinline__ int lrow(int, int) const { return 0; } };
struct BKN { static constexpr int MODE = 1; const float* base; long ldv;
    __device__ __forceinline__ const char* bptr() const { return nullptr; }
    __device__ __forceinline__ unsigned rowoff(int) const { return 0u; }
    __device__ __forceinline__ const float* colptr(int n4) const { return base + n4 * 4; }
    __device__ __forceinline__ long ld() const { return ldv; }
    __device__ __forceinline__ int lrow(int n4, int j) const { return n4 * 4 + j; } };
struct BKNGU { static constexpr int MODE = 1; const float* g; const float* u;
    __device__ __forceinline__ const char* bptr() const { return nullptr; }
    __device__ __forceinline__ unsigned rowoff(int) const { return 0u; }
    __device__ __forceinline__ const float* colptr(int n4) const { return ((n4 >> 5) ? u : g) + (n4 & 31) * 4; }
    __device__ __forceinline__ long ld() const { return 256; }
    __device__ __forceinline__ int lrow(int n4, int j) const { int sc = (n4 & 31) * 4 + j; return (sc >> 4) * 32 + (n4 >> 5) * 16 + (sc & 15); } };

__device__ __forceinline__ float f4e(const float4& v, int j) { return j == 0 ? v.x : (j == 1 ? v.y : (j == 2 ? v.z : v.w)); }
#define GC_REP4(N, X) do { if constexpr ((N) > 0) { X(0); } if constexpr ((N) > 1) { X(1); } if constexpr ((N) > 2) { X(2); } if constexpr ((N) > 3) { X(3); } } while (0)
#define GC_REP8(N, X) do { X(0); X(1); X(2); X(3); if constexpr ((N) > 4) { X(4); X(5); X(6); X(7); } } while (0)
#define GC_AOFF(i) aoff##i = ap.rowoff(lrow + 64 * i) + lseg * 16
#define GC_BOFF(i) boff##i = bp.rowoff(lrow + 64 * i) + lseg * 16
#define GC_LA(i) ra##i = *(const uint4*)(abase + (aoff##i + kt_ * 128))
#define GC_LB(i) rb##i = *(const uint4*)(bbase + (boff##i + kt_ * 128))
#define GC_LF(i) rf##i = *(const float4*)(bfp + ((long)kt_ * 64 + i) * bld)
#define GC_SA(i) *(uint4*)(As_ + (lrow + 64 * i) * TSTR + lseg * 16) = ra##i
#define GC_SB(i) *(uint4*)(Bs_ + (lrow + 64 * i) * TSTR + lseg * 16) = rb##i
#define GC_GLOAD(KT) do { const int kt_ = (KT); GC_REP4(AL, GC_LA); \
    if constexpr (BP::MODE == 0) { GC_REP4(BL, GC_LB); } else { GC_REP8(KPT, GC_LF); } } while (0)
#define GC_SF(j) do { char* d_ = Bs_ + bp.lrow(n4, j) * TSTR + kq * KPT * 2; \
        if constexpr (KPT == 4) *(uint2*)d_ = make_uint2(pack2(f4e(rf0, j), f4e(rf1, j)), pack2(f4e(rf2, j), f4e(rf3, j))); \
        else *(uint4*)d_ = make_uint4(pack2(f4e(rf0, j), f4e(rf1, j)), pack2(f4e(rf2, j), f4e(rf3, j)), pack2(f4e(rf4, j), f4e(rf5, j)), pack2(f4e(rf6, j), f4e(rf7, j))); } while (0)
#define GC_LSTORE(BUF) do { char* As_ = smem + (BUF) * STAGE; char* Bs_ = As_ + ABYTES; GC_REP4(AL, GC_SA); \
    if constexpr (BP::MODE == 0) { GC_REP4(BL, GC_SB); } else { GC_SF(0); GC_SF(1); GC_SF(2); GC_SF(3); } } while (0)

template <int BM, int BN, int WGM, int WGN, class AP, class BP>
__device__ __forceinline__ void gemm_core(f32x4 (&acc)[BM / WGM / 16][BN / WGN / 16], const AP& ap, const BP& bp, const int K, char* smem) {
    constexpr int TM = BM / WGM, TN = BN / WGN, MI = TM / 16, NI = TN / 16;
    constexpr int ABYTES = BM * TSTR, STAGE = (BM + BN) * TSTR;
    constexpr int AL = BM / 64, BL = BN / 64;
    constexpr int KPT = BN / 32, NQ = BN / 4;
    const int tid = tidx(), wave = tid >> 6, lane = tid & 63, fr = lane & 15, fq = lane >> 4;
    const int wm = wave / WGN, wn = wave % WGN;
    const int lrow = tid >> 3, lseg = tid & 7;
    const char* abase = ap.bptr(); const char* bbase = bp.bptr();
    unsigned aoff0 = 0, aoff1 = 0, aoff2 = 0, aoff3 = 0, boff0 = 0, boff1 = 0, boff2 = 0, boff3 = 0;
    uint4 ra0, ra1, ra2, ra3, rb0, rb1, rb2, rb3; float4 rf0, rf1, rf2, rf3, rf4, rf5, rf6, rf7;
    GC_REP4(AL, GC_AOFF);
    const float* bfp = nullptr;
    const int kq = tid / NQ, n4 = tid % NQ; const long bld = bp.ld();
    if constexpr (BP::MODE == 0) { GC_REP4(BL, GC_BOFF); } else { bfp = bp.colptr(n4) + (long)(kq * KPT) * bld; }
    int nk = K >> 6;
    asm volatile("" : "+s"(nk));
    GC_GLOAD(0); GC_LSTORE(0); __syncthreads();
    for (int kt = 0; kt < nk; ++kt) {
        if (kt + 1 < nk) GC_GLOAD(kt + 1);
        const char* As = smem + (kt & 1) * STAGE; const char* Bs = As + ABYTES;
#pragma unroll
        for (int ks = 0; ks < 2; ++ks) {
            bf16x8 af[MI], bfr[NI];
#pragma unroll
            for (int mi = 0; mi < MI; ++mi) af[mi] = *(const bf16x8*)(As + (wm * TM + mi * 16 + fr) * TSTR + ks * 64 + fq * 16);
#pragma unroll
            for (int ni = 0; ni < NI; ++ni) bfr[ni] = *(const bf16x8*)(Bs + (wn * TN + ni * 16 + fr) * TSTR + ks * 64 + fq * 16);
#pragma unroll
            for (int mi = 0; mi < MI; ++mi)
#pragma unroll
                for (int ni = 0; ni < NI; ++ni) acc[mi][ni] = __builtin_amdgcn_mfma_f32_16x16x32_bf16(bfr[ni], af[mi], acc[mi][ni], 0, 0, 0);
        }
        if (kt + 1 < nk) GC_LSTORE((kt + 1) & 1);
        __syncthreads();
    }
}
template <int BM, int BN, int WGM, int WGN, class AP, class BP, class EPI>
__device__ __forceinline__ void gemm_tile(const AP& ap, const BP& bp, const int K, char* smem, const EPI& epi) {
    constexpr int TM = BM / WGM, TN = BN / WGN, MI = TM / 16, NI = TN / 16;
    f32x4 acc[MI][NI];
#pragma unroll
    for (int mi = 0; mi < MI; ++mi)
#pragma unroll
        for (int ni = 0; ni < NI; ++ni) acc[mi][ni] = (f32x4){0.f, 0.f, 0.f, 0.f};
    gemm_core<BM, BN, WGM, WGN>(acc, ap, bp, K, smem);
    const int wave = tidx() >> 6, lane = tidx() & 63;
    epi(acc, (wave / WGN) * TM + (lane & 15), (wave % WGN) * TN + (lane >> 4) * 4);
}

namespace g8 {
constexpr int BM = 256, BK = 64, HALF = 128, HTB = HALF * BK * 2, NXCD = 8, WGM = 8;
__device__ __forceinline__ int lds_byte(int r, int c) { const int st = (r >> 4) * 2 + (c >> 5), rr = r & 15, cc = c & 31, ob = rr * 64 + cc * 2; return st * 1024 + (ob ^ (((ob >> 9) & 1) << 5)); }
__device__ __forceinline__ void stage_rc(int b, int& R, int& C) { const int st = b / 1024, sb = b % 1024, swz = sb ^ (((sb >> 9) & 1) << 5); R = (st >> 1) * 16 + swz / 64; C = (st & 1) * 32 + (swz % 64) / 2; }
__device__ __forceinline__ int perm32(int rho) { const int n = rho >> 4, i = rho & 15; return 8 * (i >> 2) + 4 * n + (i & 3); }
struct Unit { int pm, pn; };
struct StaticOrder {
    int nM, nN, nwg, G, c;
    __device__ void init(int M, int N, int G_, int c_) { nM = M / BM; nN = N / BM; nwg = nM * nN; G = G_; c = c_; }
    __device__ bool next(int i, Unit& u) const {
        const long L = (long)i * G + c; if (L >= nwg) return false;
        int wgid = (int)L; { const int q = nwg / NXCD, r = nwg % NXCD, xcd = wgid % NXCD, off = wgid / NXCD; wgid = (xcd < r ? xcd * (q + 1) : r * (q + 1) + (xcd - r) * q) + off; }
        const int nig = WGM * nN, gid = wgid / nig, fm = gid * WGM, gsz = (nM - fm) < WGM ? (nM - fm) : WGM;
        u.pm = fm + ((wgid % nig) % gsz); u.pn = (wgid % nig) / gsz; return true;
    }
};
template <class Epi, class Sched>
__device__ __forceinline__ void gemm_phase(LAS unsigned char* lds, const bf16_t* Ag, const bf16_t* Btg, const int lda, const int ldb, const int K, const Sched& S, const Epi& E) {
    const int tid = threadIdx.x, wid = __builtin_amdgcn_readfirstlane(tid >> 6), lane = tid & 63, wr = wid >> 2, wc = wid & 3, fr = lane & 15, fq = lane >> 4;
    const int nt = K / BK;
    unsigned voffA[2], voffB[2];
#pragma unroll
    for (int i = 0; i < 2; ++i) { int R, C; stage_rc(tid * 16 + i * 8192, R, C); const int Rb = Epi::PERM ? ((R & ~31) + perm32(R & 31)) : R;
        voffA[i] = (unsigned)(R * lda + C) * 2u; voffB[i] = (unsigned)(Rb * ldb + C) * 2u; }
    const size_t kstep = (size_t)(BK * 2);
    const size_t hstepA = (size_t)HALF * lda * 2, hstepB = (size_t)HALF * ldb * 2;
    const size_t tstepA = 2 * hstepA, tstepB = 2 * hstepB;
    const unsigned ldsw = (unsigned)wid * 1024u;
    const int aoff = lds_byte(wr * 64 + fr, fq * 8), boff = lds_byte(wc * 32 + fr, fq * 8);
#define PG8_SA(b, h) (((b) * 2 + (h)) * HTB)
#define PG8_SB(b, h) ((4 + (b) * 2 + (h)) * HTB)
#define PG8_STAGE(bufoff, gbase, voff) do { _Pragma("unroll") for (int _i = 0; _i < 2; ++_i) \
        __builtin_amdgcn_global_load_lds((const unsigned*)((const char*)(gbase) + (voff)[_i]), (LAS unsigned*)(lds + (bufoff) + ldsw + _i * 8192), 16, 0, 0); } while (0)
#define PG8_LDA(dst, b, h) do { _Pragma("unroll") for (int m = 0; m < 4; ++m) _Pragma("unroll") for (int k = 0; k < 2; ++k) dst[m][k] = *(const LAS bf16x8*)(lds + PG8_SA(b, h) + aoff + m * 2048 + k * 1024); } while (0)
#define PG8_LDB(dst, b, h) do { _Pragma("unroll") for (int n = 0; n < 2; ++n) _Pragma("unroll") for (int k = 0; k < 2; ++k) dst[n][k] = *(const LAS bf16x8*)(lds + PG8_SB(b, h) + boff + n * 2048 + k * 1024); } while (0)
#define PG8_MMA(ai, bj, At, Bt) do { __builtin_amdgcn_s_setprio(1); _Pragma("unroll") for (int m = 0; m < 4; ++m) _Pragma("unroll") for (int n = 0; n < 2; ++n) _Pragma("unroll") for (int k = 0; k < 2; ++k) \
        acc[ai][bj][m][n] = __builtin_amdgcn_mfma_f32_16x16x32_bf16(Bt[n][k], At[m][k], acc[ai][bj][m][n], 0, 0, 0); __builtin_amdgcn_s_setprio(0); } while (0)
#define PG8_WAIT_V(n) asm volatile("s_waitcnt vmcnt(" #n ")" ::: "memory")
#define PG8_WAIT_L(n) asm volatile("s_waitcnt lgkmcnt(" #n ")" ::: "memory")
#define PG8_BAR __builtin_amdgcn_s_barrier()
#define PG8_SCHED __builtin_amdgcn_sched_barrier(0)
    Unit cur, nxt; int ui = 0;
    if (!S.next(0, cur)) return;
    f32x4 acc[2][2][4][2];
#pragma unroll
    for (int a = 0; a < 2; ++a)
#pragma unroll
        for (int b = 0; b < 2; ++b)
#pragma unroll
            for (int m = 0; m < 4; ++m)
#pragma unroll
                for (int n = 0; n < 2; ++n) acc[a][b][m][n] = (f32x4){0.f, 0.f, 0.f, 0.f};
    bf16x8 At[4][2], B0[2][2], B1[2][2];
    const char* cA = (const char*)Ag + (size_t)cur.pm * tstepA; const char* cB = (const char*)Btg + (size_t)cur.pn * tstepB;
    PG8_STAGE(PG8_SB(0, 0), cB, voffB); PG8_STAGE(PG8_SA(0, 0), cA, voffA); PG8_STAGE(PG8_SB(0, 1), cB + hstepB, voffB); PG8_STAGE(PG8_SA(0, 1), cA + hstepA, voffA);
    if (wr == 1) PG8_BAR;
    PG8_WAIT_V(4); PG8_BAR;
    PG8_STAGE(PG8_SB(1, 0), cB + kstep, voffB); PG8_STAGE(PG8_SA(1, 0), cA + kstep, voffA); PG8_STAGE(PG8_SB(1, 1), cB + hstepB + kstep, voffB);
    PG8_WAIT_V(6); PG8_BAR;
    for (;;) {
        const bool has_next = S.next(ui + 1, nxt);
        const char* nA = has_next ? (const char*)Ag + (size_t)nxt.pm * tstepA : cA; const char* nB = has_next ? (const char*)Btg + (size_t)nxt.pn * tstepB : cB;
        for (int t = 0; t < nt; t += 2) {
            const bool last = (t == nt - 2);
            const char* a1 = cA + (size_t)(t + 1) * kstep;
            const char* a2 = last ? nA : cA + (size_t)(t + 2) * kstep; const char* b2 = last ? nB : cB + (size_t)(t + 2) * kstep;
            const char* a3 = a2 + kstep; const char* b3 = b2 + kstep;
            PG8_LDB(B0, 0, 0); PG8_SCHED; PG8_LDA(At, 0, 0); PG8_STAGE(PG8_SA(1, 1), a1 + hstepA, voffA);
            PG8_WAIT_L(8); PG8_BAR; PG8_WAIT_L(0); PG8_MMA(0, 0, At, B0); PG8_BAR; PG8_SCHED;
            PG8_LDB(B1, 0, 1); PG8_STAGE(PG8_SB(0, 0), b2, voffB);
            PG8_BAR; PG8_WAIT_L(0); PG8_MMA(0, 1, At, B1); PG8_BAR;
            PG8_LDA(At, 0, 1); PG8_STAGE(PG8_SA(0, 0), a2, voffA);
            PG8_BAR; PG8_WAIT_L(0); PG8_MMA(1, 0, At, B0); PG8_BAR; PG8_SCHED;
            PG8_STAGE(PG8_SB(0, 1), b2 + hstepB, voffB);
            PG8_WAIT_V(6); PG8_BAR; PG8_MMA(1, 1, At, B1); PG8_BAR;
            PG8_LDB(B0, 1, 0); PG8_SCHED; PG8_LDA(At, 1, 0); PG8_STAGE(PG8_SA(0, 1), a2 + hstepA, voffA);
            PG8_WAIT_L(8); PG8_BAR; PG8_WAIT_L(0); PG8_MMA(0, 0, At, B0); PG8_BAR; PG8_SCHED;
            PG8_LDB(B1, 1, 1); PG8_STAGE(PG8_SB(1, 0), b3, voffB);
            PG8_BAR; PG8_WAIT_L(0); PG8_MMA(0, 1, At, B1); PG8_BAR;
            PG8_LDA(At, 1, 1); PG8_STAGE(PG8_SA(1, 0), a3, voffA);
            PG8_BAR; PG8_WAIT_L(0); PG8_MMA(1, 0, At, B0); PG8_BAR; PG8_SCHED;
            PG8_STAGE(PG8_SB(1, 1), b3 + hstepB, voffB);
            PG8_WAIT_V(6); PG8_BAR; PG8_MMA(1, 1, At, B1); PG8_BAR;
        }
        E(acc, cur, wr, wc, fr, fq);
        if (!has_next) break;
#pragma unroll
        for (int a = 0; a < 2; ++a)
#pragma unroll
            for (int b = 0; b < 2; ++b)
#pragma unroll
                for (int m = 0; m < 4; ++m)
#pragma unroll
                    for (int n = 0; n < 2; ++n) acc[a][b][m][n] = (f32x4){0.f, 0.f, 0.f, 0.f};
        cur = nxt; cA = nA; cB = nB; ++ui;
    }
    PG8_WAIT_V(0);
    if (wr == 0) PG8_BAR;
    PG8_BAR;
#undef PG8_SA
#undef PG8_SB
#undef PG8_STAGE
#undef PG8_LDA
#undef PG8_LDB
#undef PG8_MMA
#undef PG8_WAIT_V
#undef PG8_WAIT_L
#undef PG8_BAR
#undef PG8_SCHED
}
struct EpiF32 {
    static constexpr bool PERM = false;
    float* C; int ldc;
    __device__ __forceinline__ void operator()(const f32x4 (&acc)[2][2][4][2], const Unit& u, int wr, int wc, int fr, int fq) const {
        const int row0 = u.pm * BM + wr * 64 + fr, col0 = u.pn * BM + wc * 32 + 4 * fq;
#pragma unroll
        for (int ai = 0; ai < 2; ++ai)
#pragma unroll
            for (int m = 0; m < 4; ++m) { float* rowp = C + (size_t)(row0 + ai * HALF + m * 16) * ldc + col0;
#pragma unroll
                for (int bj = 0; bj < 2; ++bj)
#pragma unroll
                    for (int n = 0; n < 2; ++n) *(f32x4*)(rowp + bj * HALF + n * 16) = acc[ai][bj][m][n]; }
    }
};
struct EpiBf16 {
    static constexpr bool PERM = true;
    bf16_t* O; int ldc;
    __device__ __forceinline__ void operator()(const f32x4 (&acc)[2][2][4][2], const Unit& u, int wr, int wc, int fr, int fq) const {
        const int row0 = u.pm * BM + wr * 64 + fr, col0 = u.pn * BM + wc * 32 + 8 * fq;
#pragma unroll
        for (int ai = 0; ai < 2; ++ai)
#pragma unroll
            for (int m = 0; m < 4; ++m) { bf16_t* rowp = O + (size_t)(row0 + ai * HALF + m * 16) * ldc + col0;
#pragma unroll
                for (int bj = 0; bj < 2; ++bj) { const f32x4 v0 = acc[ai][bj][m][0], v1 = acc[ai][bj][m][1];
                    uint4 o; o.x = pack2(v0[0], v0[1]); o.y = pack2(v0[2], v0[3]); o.z = pack2(v1[0], v1[1]); o.w = pack2(v1[2], v1[3]);
                    *(uint4*)(rowp + bj * HALF) = o; } }
    }
};
}

__device__ __forceinline__ void phase0(const Params& p, char* smem) {
    const int tid = tidx(), wave = tid >> 6, lane = tid & 63;
    const int gw = blockIdx.x * 8 + wave, nw = gridDim.x * 8;
    for (int u = gw; u < 1536; u += nw) {
        const int cb = u % 96, ks = u / 96, j = cb * 64 + lane;
        float a0 = 0.f, a1 = 0.f;
#pragma unroll 1
        for (int k0 = ks * 64; k0 < ks * 64 + 64; k0 += 16) {
            float w[16];
#pragma unroll
            for (int i = 0; i < 16; ++i) w[i] = p.w_mod[(size_t)(k0 + i) * 6144 + j];
#pragma unroll
            for (int i = 0; i < 16; ++i) { const float c0 = p.c[k0 + i], c1 = p.c_ctx[k0 + i]; a0 += c0 * sigm(c0) * w[i]; a1 += c1 * sigm(c1) * w[i]; }
        }
        p.modp[(ks * 2 + 0) * 6144 + j] = a0; p.modp[(ks * 2 + 1) * 6144 + j] = a1;
    }
    float* T = (float*)smem;
    int total = 0;
    for (int j = 0; j < NJOB; ++j) total += (p.jobs[j].K >> 6) * (p.jobs[j].N >> 6);
    for (int u = blockIdx.x; u < total; u += gridDim.x) {
        int j = 0, r = u;
        for (;; ++j) { const int n = (p.jobs[j].K >> 6) * (p.jobs[j].N >> 6); if (r < n) break; r -= n; }
        const TJob jb = p.jobs[j];
        const int ntn = jb.N >> 6, kt = r / ntn, nt = r % ntn, k0 = kt * 64, n0 = nt * 64;
        {
            const int kk = tid >> 4, c4 = (tid & 15) * 4;
#pragma unroll
            for (int i = 0; i < 2; ++i) {
                const int k = kk + 32 * i;
                const float4 v = *(const float4*)(jb.src + (size_t)(k0 + k) * jb.N + n0 + c4);
                T[k * 65 + c4 + 0] = v.x; T[k * 65 + c4 + 1] = v.y; T[k * 65 + c4 + 2] = v.z; T[k * 65 + c4 + 3] = v.w;
            }
        }
        __syncthreads();
        {
            const int n = tid >> 3, ks = (tid & 7) * 8;
            float v[8];
#pragma unroll
            for (int q = 0; q < 8; ++q) v[q] = T[(ks + q) * 65 + n];
            const int ng = n0 + n;
            int drow = jb.rowoff + ng;
            if (jb.mode == 2) drow = (ng >> 4) * 32 + (ng & 15) + jb.rowoff;
            uint4 hi; hi.x = pack2(v[0], v[1]); hi.y = pack2(v[2], v[3]); hi.z = pack2(v[4], v[5]); hi.w = pack2(v[6], v[7]);
            bf16_t* d = jb.dst + (size_t)drow * jb.dld + jb.coloff + k0 + ks;
            *(uint4*)d = hi;
            if (jb.mode == 1) {
                float l[8];
#pragma unroll
                for (int q = 0; q < 8; ++q) l[q] = v[q] - bf2f(f2bf(v[q]));
                uint4 lo; lo.x = pack2(l[0], l[1]); lo.y = pack2(l[2], l[3]); lo.z = pack2(l[4], l[5]); lo.w = pack2(l[6], l[7]);
                *(uint4*)(d + 1024) = hi; *(uint4*)(d + 2048) = lo;
            }
        }
        __syncthreads();
    }
}

__device__ __forceinline__ void phase1(const Params& p, char* smem) {
    const int tid = tidx(), wave = tid >> 6, lane = tid & 63;
    float* L = (float*)smem;
    for (int idx = tid; idx < 4096; idx += NT) {
        const int v = idx >> 11, which = (idx >> 10) & 1, col = idx & 1023;
        float s = p.b_mod[which * 1024 + col];
        for (int ks = 0; ks < 16; ++ks) s += p.modp[(ks * 2 + v) * 6144 + which * 1024 + col];
        L[idx] = s;
    }
    for (int idx = blockIdx.x * NT + tid; idx < 2 * 6144; idx += gridDim.x * NT) {
        const int v = idx / 6144, j = idx % 6144;
        float sm = p.b_mod[j];
#pragma unroll
        for (int ks = 0; ks < 16; ++ks) sm += p.modp[(ks * 2 + v) * 6144 + j];
        p.mod[idx] = sm;
    }
    __syncthreads();
    const int gw = blockIdx.x * 8 + wave, nw = gridDim.x * 8;
    for (int r = gw; r < TE; r += nw) {
        const int v = r < 256 ? 1 : 0;
        const float* src = r < 256 ? p.ctx + (size_t)r * 1024 : p.x + (size_t)(r - 256) * 1024;
        float4 xv[4]; float ss = 0.f;
#pragma unroll
        for (int i = 0; i < 4; ++i) { xv[i] = *(const float4*)(src + i * 256 + lane * 4); ss += xv[i].x * xv[i].x + xv[i].y * xv[i].y + xv[i].z * xv[i].z + xv[i].w * xv[i].w; }
        ss = wsum(ss);
        const float rs = rsqrtf(ss * (1.f / 1024.f) + 1e-6f);
#pragma unroll
        for (int i = 0; i < 4; ++i) {
            const int col = i * 256 + lane * 4;
            const float4 g = *(const float4*)(p.n_pre_mix + col);
            const float* sh = L + v * 2048 + col; const float* sc = L + v * 2048 + 1024 + col;
            const float y0 = xv[i].x * rs * g.x * (1.f + sc[0]) + sh[0];
            const float y1 = xv[i].y * rs * g.y * (1.f + sc[1]) + sh[1];
            const float y2 = xv[i].z * rs * g.z * (1.f + sc[2]) + sh[2];
            const float y3 = xv[i].w * rs * g.w * (1.f + sc[3]) + sh[3];
            uint2 o; o.x = pack2(y0, y1); o.y = pack2(y2, y3);
            *(uint2*)(p.hn + (size_t)r * 1024 + col) = o;
        }
    }
}

__device__ __forceinline__ void phase2(const Params& p, char* smem) {
    g8::StaticOrder S; S.init(TE, INC, gridDim.x, blockIdx.x);
    g8::EpiBf16 E{p.proj, INC};
    g8::gemm_phase((LAS unsigned char*)smem, p.hn, p.WinT, 1024, 1024, 1024, S, E);
}

__device__ __forceinline__ void phase3(const Params& p, char* smem) {
    const int tid = tidx(), wave = tid >> 6, lane = tid & 63;
    const int gw = blockIdx.x * 8 + wave, nw = gridDim.x * 8;
    float mu0[3][8], mu1[3][8], kkw[8], lm0[4], lm1[4];
#pragma unroll
    for (int a = 0; a < 3; ++a)
#pragma unroll
        for (int q = 0; q < 8; ++q) { mu0[a][q] = p.shift_mu[a * 512 + lane * 8 + q]; mu1[a][q] = p.shift_mu[1792 + a * 512 + lane * 8 + q]; }
#pragma unroll
    for (int q = 0; q < 8; ++q) kkw[q] = p.rwkv_k_k[lane * 8 + q];
#pragma unroll
    for (int q = 0; q < 4; ++q) { lm0[q] = p.shift_mu[1536 + lane * 4 + q]; lm1[q] = p.shift_mu[1792 + 1536 + lane * 4 + q]; }
    for (int t = gw; t < TE; t += nw) {
        const bool hp = (t != 0 && t != 256), hn_ = (t != 255 && t != TE - 1);
        const bf16_t* pr = p.proj + (size_t)t * INC;
        uint4 q0[3], qm[3], qn[3]; uint2 l0, lm = make_uint2(0, 0), ln = make_uint2(0, 0);
#pragma unroll
        for (int a = 0; a < 3; ++a) {
            q0[a] = *(const uint4*)(pr + a * 512 + lane * 8);
            qm[a] = hp ? *(const uint4*)(pr + a * 512 + lane * 8 - INC) : make_uint4(0, 0, 0, 0);
            qn[a] = hn_ ? *(const uint4*)(pr + a * 512 + lane * 8 + INC) : make_uint4(0, 0, 0, 0);
        }
        l0 = *(const uint2*)(pr + 1536 + lane * 4);
        if (hp) lm = *(const uint2*)(pr + 1536 + lane * 4 - INC);
        if (hn_) ln = *(const uint2*)(pr + 1536 + lane * 4 + INC);
        float val[3][8];
#pragma unroll
        for (int a = 0; a < 3; ++a) {
            float f0[8], fm[8], fn[8]; unpack8(q0[a], f0); unpack8(qm[a], fm); unpack8(qn[a], fn);
#pragma unroll
            for (int q = 0; q < 8; ++q) val[a][q] = f0[q] + mu0[a][q] * (fm[q] - f0[q]) + mu1[a][q] * (fn[q] - f0[q]);
        }
        float kkv[8], n2 = 0.f;
#pragma unroll
        for (int q = 0; q < 8; ++q) { kkv[q] = val[1][q] * kkw[q]; n2 += kkv[q] * kkv[q]; }
        n2 += __shfl_xor(n2, 1, 64); n2 += __shfl_xor(n2, 2, 64); n2 += __shfl_xor(n2, 4, 64);
        const float inv = -1.f / fmaxf(sqrtf(n2), 1e-12f);
#pragma unroll
        for (int q = 0; q < 8; ++q) kkv[q] *= inv;
        const size_t o = (size_t)t * 512 + lane * 8;
        *(uint4*)(p.Rr + o) = pack8(val[0]); *(uint4*)(p.Kk + o) = pack8(val[1]); *(uint4*)(p.Vv + o) = pack8(val[2]); *(uint4*)(p.Aa + o) = pack8(kkv);
        {
            float v[4];
            const unsigned w0[2] = {l0.x, l0.y}, wm[2] = {lm.x, lm.y}, wn[2] = {ln.x, ln.y};
#pragma unroll
            for (int q = 0; q < 4; ++q) {
                const float p0 = (q & 1) ? __uint_as_float(w0[q >> 1] & 0xffff0000u) : __uint_as_float(w0[q >> 1] << 16);
                const float pm = (q & 1) ? __uint_as_float(wm[q >> 1] & 0xffff0000u) : __uint_as_float(wm[q >> 1] << 16);
                const float pn = (q & 1) ? __uint_as_float(wn[q >> 1] & 0xffff0000u) : __uint_as_float(wn[q >> 1] << 16);
                v[q] = p0 + lm0[q] * (pm - p0) + lm1[q] * (pn - p0);
            }
            if (lane < 16) {
                uint2 ov; ov.x = pack2(tanhf(v[0]), tanhf(v[1])); ov.y = pack2(tanhf(v[2]), tanhf(v[3]));
                *(uint2*)(p.TW + (size_t)t * 64 + lane * 4) = ov;
            } else if (lane < 32) {
                uint2 ov; ov.x = pack2(v[0], v[1]); ov.y = pack2(v[2], v[3]);
                *(uint2*)(p.XA + (size_t)t * 64 + (lane - 16) * 4) = ov;
            } else {
                uint2 ov; ov.x = pack2(sigm(v[0]), sigm(v[1])); ov.y = pack2(sigm(v[2]), sigm(v[3]));
                *(uint2*)(p.SG + (size_t)t * 128 + (lane - 32) * 4) = ov;
            }
        }
    }
}

__device__ __forceinline__ void phase4(const Params& p, char* smem) {
    for (int u = blockIdx.x; u < 130 * 20; u += gridDim.x) {
        const int mt = u / 20, q = u % 20;
        if (q < 8) {
            APlain ap{p.TW + (size_t)mt * 128 * 64, 64}; BPlain bp{p.WupT + (size_t)q * 128 * 64, 64};
            gemm_tile<128, 128, 4, 2>(ap, bp, 64, smem, [&](const auto& acc, int r0, int c0) {
#pragma unroll
                for (int mi = 0; mi < 2; ++mi)
#pragma unroll
                    for (int ni = 0; ni < 4; ++ni) {
                        const int t = mt * 128 + r0 + mi * 16, cc = q * 128 + c0 + ni * 16, d = cc >> 9, c = cc & 511;
                        float4 o; float* op = (float*)&o;
#pragma unroll
                        for (int j = 0; j < 4; ++j) { const float z = p.rwkv_w0[d * 512 + c + j] + acc[mi][ni][j]; op[j] = __expf(-0.60653066f * sigm(z)); }
                        *(float4*)(p.Wd + ((size_t)d * TE + t) * 512 + c) = o;
                    }
            });
        } else if (q < 16) {
            const int qq = q - 8;
            APlain ap{p.XA + (size_t)mt * 128 * 64, 64}; BPlain bp{p.AupT + (size_t)qq * 128 * 64, 64};
            gemm_tile<128, 128, 4, 2>(ap, bp, 64, smem, [&](const auto& acc, int r0, int c0) {
#pragma unroll
                for (int mi = 0; mi < 2; ++mi)
#pragma unroll
                    for (int ni = 0; ni < 4; ++ni) {
                        const int t = mt * 128 + r0 + mi * 16, cc = qq * 128 + c0 + ni * 16, d = cc >> 9, c = cc & 511;
                        const uint2 av = *(const uint2*)(p.Aa + (size_t)t * 512 + c), kv = *(const uint2*)(p.Kk + (size_t)t * 512 + c);
                        const bf16_t* ae = (const bf16_t*)&av; const bf16_t* ke = (const bf16_t*)&kv;
                        float bo[4], ko[4];
#pragma unroll
                        for (int j = 0; j < 4; ++j) {
                            const float ad = sigm(p.rwkv_a0[d * 512 + c + j] + acc[mi][ni][j]);
                            bo[j] = -bf2f(ae[j]) * ad;
                            ko[j] = bf2f(ke[j]) * (1.f + (ad - 1.f) * p.rwkv_k_a[c + j]);
                        }
                        uint2 o1, o2; o1.x = pack2(bo[0], bo[1]); o1.y = pack2(bo[2], bo[3]); o2.x = pack2(ko[0], ko[1]); o2.y = pack2(ko[2], ko[3]);
                        *(uint2*)(p.Bd + ((size_t)d * TE + t) * 512 + c) = o1;
                        *(uint2*)(p.KD + ((size_t)d * TE + t) * 512 + c) = o2;
                    }
            });
        } else {
            const int qq = q - 16;
            APlain ap{p.SG + (size_t)mt * 128 * 128, 128}; BPlain bp{p.GupT + (size_t)qq * 128 * 128, 128};
            gemm_tile<128, 128, 4, 2>(ap, bp, 128, smem, [&](const auto& acc, int r0, int c0) {
#pragma unroll
                for (int mi = 0; mi < 2; ++mi)
#pragma unroll
                    for (int ni = 0; ni < 4; ++ni) {
                        const int t = mt * 128 + r0 + mi * 16, c = qq * 128 + c0 + ni * 16;
                        uint2 o; o.x = pack2(acc[mi][ni][0], acc[mi][ni][1]); o.y = pack2(acc[mi][ni][2], acc[mi][ni][3]);
                        *(uint2*)(p.G + (size_t)t * 512 + c) = o;
                    }
            });
        }
    }
}

__device__ __forceinline__ void phase5(const Params& p, char* smem) {
    const int tid = tidx(), wave = __builtin_amdgcn_readfirstlane(tid >> 6), lane = tid & 63;
    constexpr int SB = 5, NA = 6, NSB = RL / SB;
    float* L = (float*)smem + wave * (2 * SB * NA * 64);
    for (int q = blockIdx.x * 8 + wave; q < RNC * 16; q += gridDim.x * 8) {
        const int j = q >> 4, hd = q & 15, dir = hd >> 3, h = hd & 7;
        const float* gW = p.Wd + (size_t)dir * TE * 512; const bf16_t* gB = p.Bd + (size_t)dir * TE * 512; const bf16_t* gK = p.KD + (size_t)dir * TE * 512;
        const bf16_t* gA = p.Aa; const bf16_t* gV = p.Vv; const bf16_t* gR = p.Rr;
        const unsigned lofs = (unsigned)(h * 64 + lane);
        float* gZ = p.Zz + (size_t)q * (RL * 64) + lane; float* gY = p.YH + (size_t)q * (RL * 64) + lane;
        f32x2 sP[32], sH[32];
        int ln = lane; asm volatile("" : "+v"(ln));
#pragma unroll
        for (int k = 0; k < 32; ++k) { sP[k] = (f32x2){(2 * k == ln) ? 1.f : 0.f, (2 * k + 1 == ln) ? 1.f : 0.f}; sH[k] = (f32x2){0.f, 0.f}; }
        for (int sb = 0; sb < NSB; ++sb) {
            {
                float st[SB][NA];
#pragma unroll
                for (int i = 0; i < SB; ++i) {
                    const unsigned g = (unsigned)row_of(dir, j * RL + sb * SB + i) * 512u + lofs;
                    st[i][0] = gW[g]; st[i][1] = bf2f(gA[g]); st[i][2] = bf2f(gB[g]); st[i][3] = bf2f(gK[g]); st[i][4] = bf2f(gV[g]); st[i][5] = bf2f(gR[g]);
                }
                float* d = L + (sb & 1) * (SB * NA * 64) + lane;
#pragma unroll
                for (int i = 0; i < SB; ++i)
#pragma unroll
                    for (int a = 0; a < NA; ++a) d[(i * NA + a) * 64] = st[i][a];
            }
            const float* Lb = L + (sb & 1) * (SB * NA * 64);
#pragma unroll 1
            for (int i = 0; i < SB; ++i) {
                const float* W = Lb + (i * NA) * 64; const float* A = W + 64; const float* B = W + 128; const float* KDv = W + 192; const float* R = W + 320;
                const float vl = W[256 + lane];
                f32x2 dh0 = {0.f, 0.f}, dh1 = {0.f, 0.f}, dp0 = {0.f, 0.f}, dp1 = {0.f, 0.f};
                f32x4 ac0 = *(const f32x4*)(A), ac1 = *(const f32x4*)(A + 4), ac2 = *(const f32x4*)(A + 8), ac3 = *(const f32x4*)(A + 12);
                f32x4 rw[3], rb[3], rk[3], rr[3];
                rw[0] = *(const f32x4*)(W); rb[0] = *(const f32x4*)(B); rk[0] = *(const f32x4*)(KDv); rr[0] = *(const f32x4*)(R);
                rw[1] = *(const f32x4*)(W + 4); rb[1] = *(const f32x4*)(B + 4); rk[1] = *(const f32x4*)(KDv + 4); rr[1] = *(const f32x4*)(R + 4);
#pragma unroll
                for (int c = 0; c < 4; ++c) {
                    f32x4 an0 = ac0, an1 = ac1, an2 = ac2, an3 = ac3;
                    if (c < 3) { an0 = *(const f32x4*)(A + c * 16 + 16); an1 = *(const f32x4*)(A + c * 16 + 20); an2 = *(const f32x4*)(A + c * 16 + 24); an3 = *(const f32x4*)(A + c * 16 + 28); }
                    const int k = c * 8;
                    dh0 += sH[k] * ac0.lo; dh1 += sH[k + 1] * ac0.hi; dp0 += sP[k] * ac0.lo; dp1 += sP[k + 1] * ac0.hi;
                    dh0 += sH[k + 2] * ac1.lo; dh1 += sH[k + 3] * ac1.hi; dp0 += sP[k + 2] * ac1.lo; dp1 += sP[k + 3] * ac1.hi;
                    dh0 += sH[k + 4] * ac2.lo; dh1 += sH[k + 5] * ac2.hi; dp0 += sP[k + 4] * ac2.lo; dp1 += sP[k + 5] * ac2.hi;
                    dh0 += sH[k + 6] * ac3.lo; dh1 += sH[k + 7] * ac3.hi; dp0 += sP[k + 6] * ac3.lo; dp1 += sP[k + 7] * ac3.hi;
                    __builtin_amdgcn_sched_barrier(0);
                    ac0 = an0; ac1 = an1; ac2 = an2; ac3 = an3;
                }
                const float saHs = (dh0.x + dh0.y) + (dh1.x + dh1.y), saPs = (dp0.x + dp0.y) + (dp1.x + dp1.y);
                const f32x2 saH = {saHs, saHs}, saP = {saPs, saPs}, vl2 = {vl, vl};
                f32x2 y0 = {0.f, 0.f}, y1 = {0.f, 0.f}, z0 = {0.f, 0.f}, z1 = {0.f, 0.f};
#pragma unroll
                for (int g = 0; g < 16; ++g) {
                    if (g + 2 < 16) { rw[(g + 2) % 3] = *(const f32x4*)(W + 4 * g + 8); rb[(g + 2) % 3] = *(const f32x4*)(B + 4 * g + 8); rk[(g + 2) % 3] = *(const f32x4*)(KDv + 4 * g + 8); rr[(g + 2) % 3] = *(const f32x4*)(R + 4 * g + 8); }
                    const f32x4 cw = rw[g % 3], cb = rb[g % 3], ck = rk[g % 3], cr = rr[g % 3];
                    const int k = 2 * g;
                    sH[k]     = sH[k]     * cw.lo + (saH * cb.lo + vl2 * ck.lo);
                    sH[k + 1] = sH[k + 1] * cw.hi + (saH * cb.hi + vl2 * ck.hi);
                    sP[k]     = sP[k]     * cw.lo + saP * cb.lo;
                    sP[k + 1] = sP[k + 1] * cw.hi + saP * cb.hi;
                    y0 += sH[k] * cr.lo; y1 += sH[k + 1] * cr.hi;
                    z0 += sP[k] * cr.lo; z1 += sP[k + 1] * cr.hi;
                    __builtin_amdgcn_sched_barrier(0);
                }
                const int t = sb * SB + i;
                gZ[t * 64] = (z0.x + z0.y) + (z1.x + z1.y); gY[t * 64] = (y0.x + y0.y) + (y1.x + y1.y);
            }
        }
        if (j < RNC - 1) {
            float* dP = p.PH + (((size_t)(j * 16 + hd) * 2 + 0) * 64 + lane) * 64;
            float* dH = p.PH + (((size_t)(j * 16 + hd) * 2 + 1) * 64 + lane) * 64;
#pragma unroll
            for (int k = 0; k < 32; k += 2) { *(float4*)(dP + 2 * k) = make_float4(sP[k].x, sP[k].y, sP[k + 1].x, sP[k + 1].y); *(float4*)(dH + 2 * k) = make_float4(sH[k].x, sH[k].y, sH[k + 1].x, sH[k + 1].y); }
        }
    }
}

__device__ __forceinline__ void phase6(const Params& p, char* smem) {
    const int tid = threadIdx.x, wave = __builtin_amdgcn_readfirstlane(tid >> 6), lane = tid & 63;
    if (blockIdx.x >= 256) return;
    const int hd = blockIdx.x >> 4, rb0 = (blockIdx.x & 15) * 4, r0 = rb0 + (wave & 3);
    LAS unsigned char* lds = (LAS unsigned char*)smem;
    constexpr int SLOT = 17408, NJ = RNC - 1;
    const char* pbase = (const char*)(p.PH + (size_t)hd * 2 * 4096);
    float s0 = 0.f;
#define CH_ISSUE(J) do { const char* src_ = pbase + (size_t)(J) * 524288; const unsigned so_ = (unsigned)(((J) & 7) * SLOT); \
        _Pragma("unroll") for (int q_ = 0; q_ < 4; ++q_) __builtin_amdgcn_global_load_lds((const unsigned*)(src_ + ((wave - 4) * 4 + q_) * 1024 + lane * 16), (LAS unsigned*)(lds + so_ + ((wave - 4) * 4 + q_) * 1024), 16, 0, 0); \
        if (wave == 7) __builtin_amdgcn_global_load_lds((const unsigned*)(src_ + 16384 + rb0 * 256 + lane * 16), (LAS unsigned*)(lds + so_ + 16384), 16, 0, 0); } while (0)
    if (wave >= 4) { CH_ISSUE(0); CH_ISSUE(1); CH_ISSUE(2); CH_ISSUE(3); CH_ISSUE(4); CH_ISSUE(5); CH_ISSUE(6); }
    for (int j = 0; j < RNC; ++j) {
        if (wave < 4) p.Sst[((size_t)(j * 16 + hd) * 64 + r0) * 64 + lane] = s0;
        if (j == NJ) break;
        if (wave >= 4) {
            if (j + 6 >= NJ) asm volatile("s_waitcnt vmcnt(0)" ::: "memory");
            else if (wave == 7) asm volatile("s_waitcnt vmcnt(30)" ::: "memory");
            else asm volatile("s_waitcnt vmcnt(24)" ::: "memory");
        }
        asm volatile("s_waitcnt lgkmcnt(0)" ::: "memory"); __builtin_amdgcn_s_barrier(); asm volatile("" ::: "memory");
        if (wave >= 4) { if (j + 7 < NJ) CH_ISSUE(j + 7); }
        else {
            const float* Pc = (const float*)(smem + (j & 7) * SLOT);
            f32x2 n0 = {Pc[4096 + wave * 64 + lane], 0.f}, n1 = {0.f, 0.f};
#pragma unroll
            for (int k = 0; k < 64; k += 4) {
                const f32x2 a0 = {__int_as_float(__builtin_amdgcn_readlane(__float_as_int(s0), k)), __int_as_float(__builtin_amdgcn_readlane(__float_as_int(s0), k + 1))};
                const f32x2 a1 = {__int_as_float(__builtin_amdgcn_readlane(__float_as_int(s0), k + 2)), __int_as_float(__builtin_amdgcn_readlane(__float_as_int(s0), k + 3))};
                const f32x2 p0 = {Pc[k * 64 + lane], Pc[(k + 1) * 64 + lane]}, p1 = {Pc[(k + 2) * 64 + lane], Pc[(k + 3) * 64 + lane]};
                n0 += a0 * p0; n1 += a1 * p1;
            }
            s0 = (n0.x + n0.y) + (n1.x + n1.y);
        }
    }
#undef CH_ISSUE
    __syncthreads();
}

__device__ __forceinline__ void phase7(const Params& p, char* smem) {
    const int tid = tidx(), wave = __builtin_amdgcn_readfirstlane(tid >> 6), lane = tid & 63;
    constexpr int SB = 10, NSB = RL / SB;
    float* L = (float*)smem + wave * (SB * 64);
    for (int q = 16 + blockIdx.x * 8 + wave; q < RNC * 16; q += gridDim.x * 8) {
        const int j = q >> 4, hd = q & 15, dir = hd >> 3, h = hd & 7;
        f32x2 s[32];
        {
            const float* src = p.Sst + ((size_t)(j * 16 + hd) * 64 + lane) * 64;
#pragma unroll
            for (int k = 0; k < 32; k += 2) { const f32x4 v = *(const f32x4*)(src + 2 * k); s[k] = v.lo; s[k + 1] = v.hi; }
        }
        const float* gZ = p.Zz + (size_t)q * (RL * 64) + lane; const float* gY = p.YH + (size_t)q * (RL * 64) + lane;
        bf16_t* gO = p.O + (size_t)dir * TX * 512 + h * 64 + lane;
        float zz[SB], yy[SB];
#pragma unroll
        for (int i = 0; i < SB; ++i) { zz[i] = gZ[i * 64]; yy[i] = gY[i * 64]; }
        for (int sb = 0; sb < NSB; ++sb) {
            float yc[SB];
#pragma unroll
            for (int i = 0; i < SB; ++i) { L[i * 64 + lane] = zz[i]; yc[i] = yy[i]; }
            { const int nsb = sb + 1 < NSB ? sb + 1 : sb;
#pragma unroll
              for (int i = 0; i < SB; ++i) { zz[i] = gZ[(nsb * SB + i) * 64]; yy[i] = gY[(nsb * SB + i) * 64]; } }
#pragma unroll
            for (int i = 0; i < SB; ++i) {
                const float* Z = L + i * 64;
                f32x2 y0 = {yc[i], 0.f}, y1 = {0.f, 0.f};
#pragma unroll
                for (int k = 0; k < 32; k += 2) { const f32x4 z = *(const f32x4*)(Z + 2 * k); y0 += s[k] * z.lo; y1 += s[k + 1] * z.hi; }
                const int row = row_of(dir, j * RL + sb * SB + i);
                if (row >= 256) gO[(size_t)(row - 256) * 512] = f2bf((y0.x + y0.y) + (y1.x + y1.y));
            }
        }
    }
}

__device__ __forceinline__ void phase8(const Params& p, char* smem) {
    const int tid = tidx();
    bf16_t* LT = (bf16_t*)smem;
    constexpr int LTS = 136;
    for (int u = blockIdx.x; u < NCH * 4; u += gridDim.x) {
        const int upart = 2;
        const int c = u >> 2, hh = u & 3;
        const float g0 = sigm(p.ret_decay_logit[hh]), g1 = sigm(p.ret_decay_logit[4 + hh]);
        const float l0 = log2f(g0), l1 = log2f(g1);
        const int n = tid >> 2, part = tid & 3, half = part >> 1, fb = (part & 1) * 16;
        const int t = c * 128 + n;
        const bool lat = c >= 2;
        float pos = 0.f;
        if (lat) { const int tl = t - 256; pos = (float)(half == 0 ? (tl >> 6) : (tl & 63)); }
        const bf16_t* pr = p.proj + (size_t)t * INC;
        float cs[16], sn[16];
#pragma unroll
        for (int f = 0; f < 16; ++f) {
            if (lat) { const float inv = exp2f(-(float)(fb + f) * (13.287712379549449f / 32.f)); sincosf(pos * inv, &sn[f], &cs[f]); }
            else { cs[f] = 1.f; sn[f] = 0.f; }
        }
        const size_t ch = (size_t)(c * 4 + hh);
        if (upart != 1) {
            const int cb = 1792 + hh * 128 + half * 64 + fb;
            uint4 v1a = *(const uint4*)(pr + cb), v1b = *(const uint4*)(pr + cb + 8), v2a = *(const uint4*)(pr + cb + 32), v2b = *(const uint4*)(pr + cb + 40);
            bf16_t x1[16], x2[16];
            *(uint4*)&x1[0] = v1a; *(uint4*)&x1[8] = v1b; *(uint4*)&x2[0] = v2a; *(uint4*)&x2[8] = v2b;
            float o1[16], o2[16];
#pragma unroll
            for (int f = 0; f < 16; ++f) { const float a = bf2f(x1[f]), b = bf2f(x2[f]); o1[f] = a * cs[f] - b * sn[f]; o2[f] = a * sn[f] + b * cs[f]; }
            const float xf = exp2f(l0 * (float)(n + 1)), xb = exp2f(l1 * (float)(128 - n));
            bf16_t* qd = p.Qr + (ch * 128 + n) * 128 + half * 64 + fb;
            bf16_t* ad = p.A3 + (ch * 128 + n) * 384 + 128 + half * 64 + fb;
#pragma unroll
            for (int f = 0; f < 16; f += 2) {
                *(unsigned*)(qd + f) = pack2(o1[f], o1[f + 1]); *(unsigned*)(qd + 32 + f) = pack2(o2[f], o2[f + 1]);
                *(unsigned*)(ad + f) = pack2(o1[f] * xf, o1[f + 1] * xf); *(unsigned*)(ad + 32 + f) = pack2(o2[f] * xf, o2[f + 1] * xf);
                *(unsigned*)(ad + 128 + f) = pack2(o1[f] * xb, o1[f + 1] * xb); *(unsigned*)(ad + 128 + 32 + f) = pack2(o2[f] * xb, o2[f + 1] * xb);
            }
        }
        if (upart != 1) {
            const int cb = 2304 + hh * 128 + half * 64 + fb;
            uint4 v1a = *(const uint4*)(pr + cb), v1b = *(const uint4*)(pr + cb + 8), v2a = *(const uint4*)(pr + cb + 32), v2b = *(const uint4*)(pr + cb + 40);
            bf16_t x1[16], x2[16];
            *(uint4*)&x1[0] = v1a; *(uint4*)&x1[8] = v1b; *(uint4*)&x2[0] = v2a; *(uint4*)&x2[8] = v2b;
            const float sc = 0.08838834764831845f;
            bf16_t* kd = p.Kr + (ch * 128 + n) * 128 + half * 64 + fb;
            __syncthreads();
#pragma unroll
            for (int f = 0; f < 16; ++f) {
                const float a = bf2f(x1[f]) * sc, b = bf2f(x2[f]) * sc;
                const float o1 = a * cs[f] - b * sn[f], o2 = a * sn[f] + b * cs[f];
                const bf16_t h1 = f2bf(o1), h2 = f2bf(o2);
                kd[f] = h1; kd[32 + f] = h2;
                LT[(half * 64 + fb + f) * LTS + n] = h1; LT[(half * 64 + fb + f + 32) * LTS + n] = h2;
            }
            __syncthreads();
            const int d = tid >> 2, ms = (tid & 3) * 32;
#pragma unroll
            for (int dir = 0; dir < 2; ++dir) {
                bf16_t* od = p.KTz + ((ch * 2 + dir) * 128 + d) * 128 + ms;
#pragma unroll
                for (int m = 0; m < 32; m += 2) {
                    const int mm = ms + m;
                    const float z0 = dir == 0 ? exp2f(l0 * (float)(127 - mm)) : exp2f(l1 * (float)mm);
                    const float z1 = dir == 0 ? exp2f(l0 * (float)(126 - mm)) : exp2f(l1 * (float)(mm + 1));
                    *(unsigned*)(od + m) = pack2(bf2f(LT[d * LTS + mm]) * z0, bf2f(LT[d * LTS + mm + 1]) * z1);
                }
            }
        }
#pragma unroll 1
        for (int eh = (upart != 0 ? 0 : 2); eh < 2; ++eh) {
            __syncthreads();
            const int cb = 2816 + hh * 256 + eh * 128 + part * 32;
            bf16_t xv[32];
#pragma unroll
            for (int q = 0; q < 4; ++q) *(uint4*)&xv[q * 8] = *(const uint4*)(pr + cb + q * 8);
#pragma unroll
            for (int f = 0; f < 32; ++f) LT[(part * 32 + f) * LTS + n] = xv[f];
            __syncthreads();
            const int e = tid >> 2, ms = (tid & 3) * 32;
            bf16_t* od = p.B3 + (ch * 256 + eh * 128 + e) * 384 + ms;
#pragma unroll
            for (int m = 0; m < 32; m += 8) *(uint4*)(od + m) = *(const uint4*)(LT + e * LTS + ms + m);
        }
        __syncthreads();
    }
}

__device__ __forceinline__ void phase9(const Params& p, char* smem) {
    for (int u = blockIdx.x; u < 512 + 2080; u += gridDim.x) {
        if (u < 512) {
            const int c = 2 + (u >> 2), hh = u & 3;
            const size_t ch = (size_t)(c * 4 + hh);
            const float l0 = log2f(sigm(p.ret_decay_logit[hh])), l1 = log2f(sigm(p.ret_decay_logit[4 + hh]));
            APlain ap{p.Qr + ch * 128 * 128, 128}; BPlain bp{p.Kr + ch * 128 * 128, 128};
            bf16_t* outp = p.A3 + ch * 128 * 384;
            gemm_tile<128, 128, 4, 2>(ap, bp, 128, smem, [&](const auto& acc, int r0, int c0) {
#pragma unroll
                for (int mi = 0; mi < 2; ++mi)
#pragma unroll
                    for (int ni = 0; ni < 4; ++ni) {
                        const int n = r0 + mi * 16, m0 = c0 + ni * 16;
                        float o[4];
#pragma unroll
                        for (int j = 0; j < 4; ++j) {
                            const int m = m0 + j;
                            float w = 0.f;
                            if (n >= m) w += exp2f(l0 * (float)(n - m));
                            if (m >= n) w += exp2f(l1 * (float)(m - n));
                            o[j] = acc[mi][ni][j] * w;
                        }
                        uint2 ov; ov.x = pack2(o[0], o[1]); ov.y = pack2(o[2], o[3]);
                        *(uint2*)(outp + (size_t)n * 384 + m0) = ov;
                    }
            });
        } else {
            const int v = u - 512, mt = v & 1, dir = (v >> 1) & 1, chh = v >> 2;
            APlain ap{p.B3 + ((size_t)chh * 256 + mt * 128) * 384, 384}; BPlain bp{p.KTz + ((size_t)chh * 2 + dir) * 128 * 128, 128};
            float* outp = p.KVT + (((size_t)chh * 2 + dir) * 256 + mt * 128) * 128;
            gemm_tile<128, 128, 4, 2>(ap, bp, 128, smem, [&](const auto& acc, int r0, int c0) {
#pragma unroll
                for (int mi = 0; mi < 2; ++mi)
#pragma unroll
                    for (int ni = 0; ni < 4; ++ni) *(f32x4*)(outp + (size_t)(r0 + mi * 16) * 128 + c0 + ni * 16) = acc[mi][ni];
            });
        }
    }
}

__device__ __forceinline__ void phase10(const Params& p, char* smem) {
    for (int idx = blockIdx.x * NT + tidx(); idx < 131072; idx += gridDim.x * NT) {
        const int hh = idx >> 15, dir = (idx >> 14) & 1, e = (idx >> 6) & 255, d = (idx & 63) * 2;
        const float g = sigm(p.ret_decay_logit[dir * 4 + hh]);
        const float g128 = exp2f(128.f * log2f(g));
        float R0 = 0.f, R1 = 0.f;
        const float* kvb = p.KVT + ((size_t)(hh * 2 + dir) * 256 + e) * 128 + d;
        bf16_t* rtb = p.B3 + ((size_t)hh * 256 + e) * 384 + 128 + dir * 128 + d;
        for (int s0 = 0; s0 < NCH; s0 += 13) {
            float2 kv[13];
#pragma unroll
            for (int i = 0; i < 13; ++i) { const int sc = s0 + i, c = dir == 0 ? sc : (sc < 2 ? 1 - sc : 131 - sc); kv[i] = *(const float2*)(kvb + (size_t)c * 262144); }
#pragma unroll
            for (int i = 0; i < 13; ++i) {
                const int sc = s0 + i, c = dir == 0 ? sc : (sc < 2 ? 1 - sc : 131 - sc);
                if (c >= 2) *(unsigned*)(rtb + (size_t)c * 393216) = pack2(R0, R1);
                R0 = g128 * R0 + kv[i].x; R1 = g128 * R1 + kv[i].y;
            }
        }
    }
}

__device__ __forceinline__ void phase11(const Params& p, char* smem) {
    for (int u = blockIdx.x; u < 1024; u += gridDim.x) {
        const int nt = u & 1, chh = 8 + (u >> 1), c = chh >> 2, hh = chh & 3;
        APlain ap{p.A3 + (size_t)chh * 128 * 384, 384}; BPlain bp{p.B3 + ((size_t)chh * 256 + nt * 128) * 384, 384};
        float* outp = p.Y + (size_t)((c - 2) * 128) * 1024 + hh * 256 + nt * 128;
        gemm_tile<128, 128, 4, 2>(ap, bp, 384, smem, [&](const auto& acc, int r0, int c0) {
#pragma unroll
            for (int mi = 0; mi < 2; ++mi)
#pragma unroll
                for (int ni = 0; ni < 4; ++ni) *(f32x4*)(outp + (size_t)(r0 + mi * 16) * 1024 + c0 + ni * 16) = acc[mi][ni];
        });
    }
}

__device__ __forceinline__ void phase12(const Params& p, char* smem) {
    const int tid = tidx(), wave = tid >> 6, lane = tid & 63;
    const int gw = blockIdx.x * 8 + wave, nw = gridDim.x * 8;
    float lw[8], lb[8], rk[8];
#pragma unroll
    for (int q = 0; q < 8; ++q) { lw[q] = p.rwkv_ln_w[lane * 8 + q]; lb[q] = p.rwkv_ln_b[lane * 8 + q]; rk[q] = p.rwkv_r_k[lane * 8 + q]; }
    for (int t = gw; t < TX; t += nw) {
        const size_t te = (size_t)(t + 256) * 512 + lane * 8;
        const uint4 uof = *(const uint4*)(p.O + (size_t)t * 512 + lane * 8), uob = *(const uint4*)(p.O + ((size_t)TX + t) * 512 + lane * 8);
        const uint4 ur = *(const uint4*)(p.Rr + te), uk0 = *(const uint4*)(p.KD + te), uk1 = *(const uint4*)(p.KD + (size_t)TE * 512 + te), uv = *(const uint4*)(p.Vv + te), ug = *(const uint4*)(p.G + te);
        const float* yp = p.Y + (size_t)t * 1024 + lane * 16;
        const float4 y0 = *(const float4*)(yp), y1 = *(const float4*)(yp + 4), y2 = *(const float4*)(yp + 8), y3 = *(const float4*)(yp + 12);
        const bf16_t* gbp = p.proj + (size_t)(t + 256) * INC + 3840 + lane * 16;
        const uint4 ugb0 = *(const uint4*)(gbp), ugb1 = *(const uint4*)(gbp + 8);
        {
            float of[8], ob[8], r[8], k0[8], k1[8], v[8], gg[8], o[8];
            unpack8(uof, of); unpack8(uob, ob); unpack8(ur, r); unpack8(uk0, k0); unpack8(uk1, k1); unpack8(uv, v); unpack8(ug, gg);
            float sm = 0.f, bs = 0.f;
#pragma unroll
            for (int q = 0; q < 8; ++q) { o[q] = of[q] + ob[q]; sm += o[q]; bs += r[q] * (k0[q] + k1[q]) * rk[q]; }
            sm += __shfl_xor(sm, 1, 64); sm += __shfl_xor(sm, 2, 64); sm += __shfl_xor(sm, 4, 64);
            bs += __shfl_xor(bs, 1, 64); bs += __shfl_xor(bs, 2, 64); bs += __shfl_xor(bs, 4, 64);
            const float mu = sm * (1.f / 64.f);
            float vs = 0.f;
#pragma unroll
            for (int q = 0; q < 8; ++q) { o[q] -= mu; vs += o[q] * o[q]; }
            vs += __shfl_xor(vs, 1, 64); vs += __shfl_xor(vs, 2, 64); vs += __shfl_xor(vs, 4, 64);
            const float rs = rsqrtf(vs * (1.f / 64.f) + 64e-5f);
            float ya[8];
#pragma unroll
            for (int q = 0; q < 8; ++q) ya[q] = (o[q] * rs * lw[q] + lb[q] + bs * v[q]) * gg[q];
            *(uint4*)(p.ya_in + (size_t)t * 512 + lane * 8) = pack8(ya);
        }
        {
            float y[16] = {y0.x, y0.y, y0.z, y0.w, y1.x, y1.y, y1.z, y1.w, y2.x, y2.y, y2.z, y2.w, y3.x, y3.y, y3.z, y3.w};
            float sm = 0.f;
#pragma unroll
            for (int q = 0; q < 16; ++q) sm += y[q];
            sm += __shfl_xor(sm, 1, 64); sm += __shfl_xor(sm, 2, 64); sm += __shfl_xor(sm, 4, 64); sm += __shfl_xor(sm, 8, 64);
            const float mu = sm * (1.f / 256.f);
            float vs = 0.f;
#pragma unroll
            for (int q = 0; q < 16; ++q) { y[q] -= mu; vs += y[q] * y[q]; }
            vs += __shfl_xor(vs, 1, 64); vs += __shfl_xor(vs, 2, 64); vs += __shfl_xor(vs, 4, 64); vs += __shfl_xor(vs, 8, 64);
            const float rs = rsqrtf(vs * (1.f / 256.f) + 1e-5f);
            float gb[16]; { float t0[8], t1[8]; unpack8(ugb0, t0); unpack8(ugb1, t1);
#pragma unroll
                for (int q = 0; q < 8; ++q) { gb[q] = t0[q]; gb[8 + q] = t1[q]; } }
            float o0[8], o1[8];
#pragma unroll
            for (int q = 0; q < 16; ++q) {
                const int c = lane * 16 + q;
                const float ov = (y[q] * rs * p.ret_ln_w[c] + p.ret_ln_b[c]) * (gb[q] * sigm(gb[q]));
                if (q < 8) o0[q] = ov; else o1[q - 8] = ov;
            }
            bf16_t* d = p.yb_in + (size_t)t * 1024 + lane * 16;
            *(uint4*)d = pack8(o0); *(uint4*)(d + 8) = pack8(o1);
        }
    }
}

__device__ __forceinline__ void phase13(const Params& p, char* smem) {
    for (int u = blockIdx.x; u < 512; u += gridDim.x) {
        const int mt = u >> 2, nt = u & 3;
        f32x4 acca[4][4], accb[4][4];
#pragma unroll
        for (int mi = 0; mi < 4; ++mi)
#pragma unroll
            for (int ni = 0; ni < 4; ++ni) { acca[mi][ni] = (f32x4){0.f, 0.f, 0.f, 0.f}; accb[mi][ni] = (f32x4){0.f, 0.f, 0.f, 0.f}; }
        { APlain ap{p.ya_in + (size_t)mt * 128 * 512, 512}; BPlain bp{p.WaT + (size_t)nt * 256 * 512, 512};
          gemm_core<128, 256, 2, 4>(acca, ap, bp, 512, smem); }
        { APlain ap{p.yb_in + (size_t)mt * 128 * 1024, 1024}; BPlain bp{p.WbT + (size_t)nt * 256 * 1024, 1024};
          gemm_core<128, 256, 2, 4>(accb, ap, bp, 1024, smem); }
        const int wave = tidx() >> 6, lane = tidx() & 63;
        const int r0 = (wave >> 2) * 64 + (lane & 15), c0 = (wave & 3) * 64 + (lane >> 4) * 4;
#pragma unroll
        for (int mi = 0; mi < 4; ++mi)
#pragma unroll
            for (int ni = 0; ni < 4; ++ni) {
                const int t = mt * 128 + r0 + mi * 16, c = nt * 256 + c0 + ni * 16;
                const bf16_t* gp = p.proj + (size_t)(t + 256) * INC + c;
                const uint2 ga = *(const uint2*)(gp + 4864), gb = *(const uint2*)(gp + 5888);
                float o[4];
                o[0] = sigm(__uint_as_float(ga.x << 16)) * acca[mi][ni][0] + sigm(__uint_as_float(gb.x << 16)) * accb[mi][ni][0];
                o[1] = sigm(__uint_as_float(ga.x & 0xffff0000u)) * acca[mi][ni][1] + sigm(__uint_as_float(gb.x & 0xffff0000u)) * accb[mi][ni][1];
                o[2] = sigm(__uint_as_float(ga.y << 16)) * acca[mi][ni][2] + sigm(__uint_as_float(gb.y << 16)) * accb[mi][ni][2];
                o[3] = sigm(__uint_as_float(ga.y & 0xffff0000u)) * acca[mi][ni][3] + sigm(__uint_as_float(gb.y & 0xffff0000u)) * accb[mi][ni][3];
                uint2 ov; ov.x = pack2(o[0], o[1]); ov.y = pack2(o[2], o[3]);
                *(uint2*)(p.merged + (size_t)t * 1024 + c) = ov;
            }
    }
}
__device__ __forceinline__ void phase14(const Params& p, char* smem) {
    g8::StaticOrder S; S.init(TX, 1024, gridDim.x, blockIdx.x);
    g8::EpiF32 E{p.mix, 1024};
    g8::gemm_phase((LAS unsigned char*)smem, p.merged, p.WoT, 1024, 1024, 1024, S, E);
}

__device__ __forceinline__ void phase15(const Params& p, char* smem) {
    const int tid = tidx(), wave = tid >> 6, lane = tid & 63;
    const int gw = blockIdx.x * 8 + wave, nw = gridDim.x * 8;
    const float* g1 = p.mod + 2048; const float* sh2 = p.mod + 3072; const float* sc2 = p.mod + 4096;
    for (int t = gw; t < TX; t += nw) {
        float4 mv[4], xm[4]; float ss = 0.f;
#pragma unroll
        for (int i = 0; i < 4; ++i) { mv[i] = *(const float4*)(p.mix + (size_t)t * 1024 + i * 256 + lane * 4); ss += mv[i].x * mv[i].x + mv[i].y * mv[i].y + mv[i].z * mv[i].z + mv[i].w * mv[i].w; }
        ss = wsum(ss);
        const float rs = rsqrtf(ss * (1.f / 1024.f) + 1e-6f);
        float s2 = 0.f;
#pragma unroll
        for (int i = 0; i < 4; ++i) {
            const int col = i * 256 + lane * 4;
            const float4 xv = *(const float4*)(p.x + (size_t)t * 1024 + col);
            const float4 gn = *(const float4*)(p.n_post_mix + col), gg = *(const float4*)(g1 + col);
            xm[i].x = xv.x + gg.x * (mv[i].x * rs * gn.x); xm[i].y = xv.y + gg.y * (mv[i].y * rs * gn.y);
            xm[i].z = xv.z + gg.z * (mv[i].z * rs * gn.z); xm[i].w = xv.w + gg.w * (mv[i].w * rs * gn.w);
            *(float4*)(p.x_mid + (size_t)t * 1024 + col) = xm[i];
            s2 += xm[i].x * xm[i].x + xm[i].y * xm[i].y + xm[i].z * xm[i].z + xm[i].w * xm[i].w;
        }
        s2 = wsum(s2);
        const float rs2 = rsqrtf(s2 * (1.f / 1024.f) + 1e-6f);
#pragma unroll
        for (int i = 0; i < 4; ++i) {
            const int col = i * 256 + lane * 4;
            const float4 gn = *(const float4*)(p.n_pre_ffn + col), sc = *(const float4*)(sc2 + col), sh = *(const float4*)(sh2 + col);
            float h[4];
            h[0] = xm[i].x * rs2 * gn.x * (1.f + sc.x) + sh.x; h[1] = xm[i].y * rs2 * gn.y * (1.f + sc.y) + sh.y;
            h[2] = xm[i].z * rs2 * gn.z * (1.f + sc.z) + sh.z; h[3] = xm[i].w * rs2 * gn.w * (1.f + sc.w) + sh.w;
            uint2 hi; hi.x = pack2(h[0], h[1]); hi.y = pack2(h[2], h[3]);
            *(uint2*)(p.Ahl + (size_t)t * 1024 + col) = hi;
        }
    }
}

__device__ __forceinline__ void phase16(const Params& p, char* smem) {
    for (int u = blockIdx.x; u < 256; u += gridDim.x) {
        const int mt = u >> 1, nt = u & 1;
        APlain ap{p.Ahl + (size_t)mt * 128 * 1024, 1024}; BPlain bp{p.RtT + (size_t)nt * 128 * 1024, 1024};
        float* outp = p.logits + (size_t)mt * 128 * 256 + nt * 128;
        gemm_tile<128, 128, 4, 2>(ap, bp, 1024, smem, [&](const auto& acc, int r0, int c0) {
#pragma unroll
            for (int mi = 0; mi < 2; ++mi)
#pragma unroll
                for (int ni = 0; ni < 4; ++ni) *(f32x4*)(outp + (size_t)(r0 + mi * 16) * 256 + c0 + ni * 16) = acc[mi][ni];
        });
    }
}

__device__ __forceinline__ void phase17(const Params& p, char* smem) {
    const int tid = tidx(), wave = tid >> 6, lane = tid & 63;
    int* hist = (int*)smem;
    if (tid < 256) hist[tid] = 0;
    __syncthreads();
    const int TPB = TX / gridDim.x;
    constexpr int NTK = 4;
    for (int ti = wave * NTK; ti < TPB; ti += 8 * NTK) {
        const int t0 = blockIdx.x * TPB + ti;
        float sc[NTK][4], key[NTK][4], mys[NTK], ssum[NTK]; int mye[NTK];
#pragma unroll
        for (int n = 0; n < NTK; ++n) {
            mys[n] = 0.f; ssum[n] = 0.f; mye[n] = 0;
#pragma unroll
            for (int i = 0; i < 4; ++i) { const int e = lane + 64 * i; sc[n][i] = sigm(p.logits[(size_t)(t0 + n) * 256 + e]); key[n][i] = sc[n][i] + p.router_bias[e]; }
        }
#pragma unroll 1
        for (int k = 0; k < 8; ++k) {
            float bv[NTK]; int be[NTK];
#pragma unroll
            for (int n = 0; n < NTK; ++n) { bv[n] = -1e30f; be[n] = 1 << 20;
#pragma unroll
                for (int i = 0; i < 4; ++i) if (key[n][i] > bv[n]) { bv[n] = key[n][i]; be[n] = lane + 64 * i; } }
#pragma unroll
            for (int o = 32; o; o >>= 1) {
#pragma unroll
                for (int n = 0; n < NTK; ++n) {
                    const float ov = __shfl_xor(bv[n], o, 64); const int oe = __shfl_xor(be[n], o, 64);
                    if (ov > bv[n] || (ov == bv[n] && oe < be[n])) { bv[n] = ov; be[n] = oe; }
                }
            }
#pragma unroll
            for (int n = 0; n < NTK; ++n) {
                float sv = 0.f;
                if ((be[n] & 63) == lane) {
#pragma unroll
                    for (int i = 0; i < 4; ++i) if ((be[n] >> 6) == i) { sv = sc[n][i]; key[n][i] = -1e30f; }
                }
                sv = __shfl(sv, be[n] & 63, 64);
                ssum[n] += sv;
                if (lane == k) { mys[n] = sv; mye[n] = be[n]; }
            }
        }
        if (lane < 8) {
#pragma unroll
            for (int n = 0; n < NTK; ++n) {
                const int t = t0 + n;
                const int pos = atomicAdd(&hist[mye[n]], 1);
                p.tok_e[t * 8 + lane] = mye[n]; p.tok_pos[t * 8 + lane] = pos; p.tok_w[t * 8 + lane] = mys[n] / ssum[n] * 2.5f;
            }
        }
    }
    __syncthreads();
    if (tid < 256) p.bh[blockIdx.x * 256 + tid] = hist[tid];
}

__device__ __forceinline__ void phase18(const Params& p, char* smem) {
    const int tid = tidx();
    int* ps = (int*)smem;
    int* xs = ps + 260;
    int* cntL = xs + 260;
    int* baseL = cntL + 256;
    int* part = baseL + 256;
    {
        const int e = tid & 255, half = tid >> 8, G = gridDim.x, b0 = half * (G >> 1), b1 = b0 + (G >> 1);
        int tot = 0, bef = 0;
        for (int bb = b0; bb < b1; bb += 16) {
            int v[16];
#pragma unroll
            for (int i = 0; i < 16; ++i) v[i] = p.bh[(bb + i) * 256 + e];
#pragma unroll
            for (int i = 0; i < 16; ++i) { tot += v[i]; bef += (bb + i < (int)blockIdx.x) ? v[i] : 0; }
        }
        part[half * 256 + e] = tot; part[512 + half * 256 + e] = bef;
    }
    __syncthreads();
    if (tid < 256) { cntL[tid] = part[tid] + part[256 + tid]; baseL[tid] = part[512 + tid] + part[768 + tid]; }
    __syncthreads();
    if (tid < 64) {
        int c[4], tot = 0, ttot = 0;
#pragma unroll
        for (int q = 0; q < 4; ++q) { c[q] = cntL[tid * 4 + q]; tot += c[q]; ttot += (c[q] + 255) >> 8; }
        int incl = tot, tincl = ttot;
#pragma unroll
        for (int o = 1; o < 64; o <<= 1) { const int v = __shfl_up(incl, o, 64), tv = __shfl_up(tincl, o, 64); if (tid >= o) { incl += v; tincl += tv; } }
        int ex = incl - tot, tex = tincl - ttot;
#pragma unroll
        for (int q = 0; q < 4; ++q) { ps[tid * 4 + q] = ex; xs[tid * 4 + q] = tex; ex += c[q]; tex += (c[q] + 255) >> 8; }
        if (tid == 63) { ps[256] = incl; xs[256] = tincl; }
    }
    __syncthreads();
    if (blockIdx.x == 0) {
        const int nx = xs[256];
        if (tid == 0) *p.ntiles = nx + 64;
        for (int e = tid; e < 256; e += NT) {
            const int c = ps[e + 1] - ps[e];
            for (int t = 0; t < ((c + 255) >> 8); ++t) { int* x = p.xt + (xs[e] + t) * 4; x[0] = e; x[1] = ps[e] + 256 * t; x[2] = min(256, c - 256 * t); x[3] = 0; }
        }
        if (tid < 64) { int* x = p.xt + (nx + tid) * 4; x[0] = 256; x[1] = 131072 + 256 * tid; x[2] = 256; x[3] = 0; }
        if (tid < 256) p.slot_tk[NSLOT + tid] = 0;
    }
    const int TPB = TX / gridDim.x;
    for (int li = tid; li < TPB * 8; li += NT) {
        const int i = blockIdx.x * TPB * 8 + li, e = p.tok_e[i];
        p.slot_tk[ps[e] + baseL[e] + p.tok_pos[i]] = (i >> 3) * 9 + (i & 7);
    }
    for (int t = blockIdx.x * NT + tid; t < TX; t += gridDim.x * NT) p.slot_tk[131072 + t] = t * 9 + 8;
}

__device__ __forceinline__ void phase19(const Params& p, char* smem) {
    const int nun = *p.ntiles * 2;
    const int lb = (blockIdx.x & 7) * (gridDim.x >> 3) + (blockIdx.x >> 3);
    for (int u = lb; u < nun; u += gridDim.x) {
        const int* x = p.xt + (u >> 1) * 4; const int nt = u & 1;
        const int e = x[0], row0 = x[1], nrows = x[2];
        const float* wg = (e < 256 ? p.exp_w_gate + (size_t)e * 262144 : p.sh_w_gate) + nt * 128;
        const float* wu = (e < 256 ? p.exp_w_up + (size_t)e * 262144 : p.sh_w_up) + nt * 128;
        AGather ap{p.Ahl, 1024, p.slot_tk + row0};
        BKNGU bp{wg, wu};
        bf16_t* outp = p.act + (size_t)row0 * 256 + nt * 128;
        gemm_tile<256, 256, 2, 4>(ap, bp, 1024, smem, [&](const auto& acc, int r0, int c0) {
#pragma unroll
            for (int mi = 0; mi < 8; ++mi) {
                if (r0 + mi * 16 < nrows) {
#pragma unroll
                    for (int gp = 0; gp < 2; ++gp) {
                        const int g = (c0 >> 5) + gp, fq4 = c0 & 15;
                        float o[4];
#pragma unroll
                        for (int j = 0; j < 4; ++j) { const float gt = acc[mi][gp * 2][j], up = acc[mi][gp * 2 + 1][j]; o[j] = gt * sigm(gt) * up; }
                        uint2 ov; ov.x = pack2(o[0], o[1]); ov.y = pack2(o[2], o[3]);
                        *(uint2*)(outp + (size_t)(r0 + mi * 16) * 256 + g * 16 + fq4) = ov;
                    }
                }
            }
        });
    }
}

__device__ __forceinline__ void phase20(const Params& p, char* smem) {
    const int nun = *p.ntiles * 4;
    const int lb = (blockIdx.x & 7) * (gridDim.x >> 3) + (blockIdx.x >> 3);
    for (int u = lb; u < nun; u += gridDim.x) {
        const int* x = p.xt + (u >> 2) * 4; const int nt = u & 3;
        const int e = x[0], row0 = x[1], nrows = x[2];
        APlain ap{p.act + (size_t)row0 * 256, 256};
        BKN bp{(e < 256 ? p.exp_w_down + (size_t)e * 262144 : p.sh_w_down) + nt * 256, 1024};
        const int* stk = p.slot_tk + row0;
        gemm_tile<256, 256, 2, 4>(ap, bp, 256, smem, [&](const auto& acc, int r0, int c0) {
#pragma unroll
            for (int mi = 0; mi < 8; ++mi) {
                const int r = r0 + mi * 16;
                if (r < nrows) {
                    bf16_t* d = p.yk + (size_t)stk[r] * 1024 + nt * 256 + c0;
#pragma unroll
                    for (int ni = 0; ni < 4; ++ni) {
                        uint2 ov; ov.x = pack2(acc[mi][ni][0], acc[mi][ni][1]); ov.y = pack2(acc[mi][ni][2], acc[mi][ni][3]);
                        *(uint2*)(d + ni * 16) = ov;
                    }
                }
            }
        });
    }
}

__device__ __forceinline__ void phase21(const Params& p, char* smem) {
    const int tid = tidx(), wave = tid >> 6, lane = tid & 63;
    const int gw = blockIdx.x * 8 + wave, nw = gridDim.x * 8;
    const float* g2 = p.mod + 5120;
    for (int t = gw; t < TX; t += nw) {
        float w[9];
#pragma unroll
        for (int k = 0; k < 8; ++k) w[k] = p.tok_w[t * 8 + k];
        w[8] = 1.f;
        float4 mo[4]; float ss = 0.f;
#pragma unroll
        for (int i = 0; i < 4; ++i) {
            const int col = i * 256 + lane * 4;
            float a0 = 0.f, a1 = 0.f, a2 = 0.f, a3 = 0.f;
#pragma unroll
            for (int k = 0; k < 9; ++k) {
                const uint2 v = *(const uint2*)(p.yk + ((size_t)t * 9 + k) * 1024 + col);
                a0 += w[k] * __uint_as_float(v.x << 16); a1 += w[k] * __uint_as_float(v.x & 0xffff0000u); a2 += w[k] * __uint_as_float(v.y << 16); a3 += w[k] * __uint_as_float(v.y & 0xffff0000u);
            }
            mo[i] = make_float4(a0, a1, a2, a3);
            ss += a0 * a0 + a1 * a1 + a2 * a2 + a3 * a3;
        }
        ss = wsum(ss);
        const float rs = rsqrtf(ss * (1.f / 1024.f) + 1e-6f);
#pragma unroll
        for (int i = 0; i < 4; ++i) {
            const int col = i * 256 + lane * 4;
            const float4 xm = *(const float4*)(p.x_mid + (size_t)t * 1024 + col);
            const float4 gn = *(const float4*)(p.n_post_ffn + col), gg = *(const float4*)(g2 + col);
            float4 o;
            o.x = xm.x + gg.x * (mo[i].x * rs * gn.x); o.y = xm.y + gg.y * (mo[i].y * rs * gn.y);
            o.z = xm.z + gg.z * (mo[i].z * rs * gn.z); o.w = xm.w + gg.w * (mo[i].w * rs * gn.w);
            *(float4*)(p.out + (size_t)t * 1024 + col) = o;
        }
    }
}

constexpr int NPHASE = 22;
template <int PH> __device__ __forceinline__ void run_phase(const Params& p, char* smem) {
    if constexpr (PH == 0) phase0(p, smem);
    else if constexpr (PH == 1) phase1(p, smem);
    else if constexpr (PH == 2) phase2(p, smem);
    else if constexpr (PH == 3) phase3(p, smem);
    else if constexpr (PH == 4) phase4(p, smem);
    else if constexpr (PH == 5) phase5(p, smem);
    else if constexpr (PH == 6) phase6(p, smem);
    else if constexpr (PH == 7) phase7(p, smem);
    else if constexpr (PH == 8) phase8(p, smem);
    else if constexpr (PH == 9) phase9(p, smem);
    else if constexpr (PH == 10) phase10(p, smem);
    else if constexpr (PH == 11) phase11(p, smem);
    else if constexpr (PH == 12) phase12(p, smem);
    else if constexpr (PH == 13) phase13(p, smem);
    else if constexpr (PH == 14) phase14(p, smem);
    else if constexpr (PH == 15) phase15(p, smem);
    else if constexpr (PH == 16) phase16(p, smem);
    else if constexpr (PH == 17) phase17(p, smem);
    else if constexpr (PH == 18) phase18(p, smem);
    else if constexpr (PH == 19) phase19(p, smem);
    else if constexpr (PH == 20) phase20(p, smem);
    else phase21(p, smem);
}

template <int PH> __global__ void __launch_bounds__(NT, 2) k_phase(Params p) {
    extern __shared__ __attribute__((aligned(16))) char smem[];
    run_phase<PH>(p, smem);
}

template <int PH> __device__ __forceinline__ void mega_run(const Params& p, char* smem, const XcdBarrier& bar) {
    run_phase<PH>(p, smem);
    if constexpr (((PROBE_MASK) >> PH) & 1u) { xcd_barrier(bar); run_phase<PH>(p, smem); }
    if constexpr (PH + 1 < NPHASE) { xcd_barrier(bar); mega_run<PH + 1>(p, smem, bar); }
}
__global__ void __launch_bounds__(NT, 2) k_mega(Params p) {
    extern __shared__ __attribute__((aligned(16))) char smem[];
    uint4* xbw = (uint4*)(smem + 8 * TILE_BYTES);
    if (tidx() == 0) *xbw = make_uint4(0u, 0u, 0u, 0u);
    __syncthreads();
    XcdBarrier bar = xcd_barrier_post(p.bar, (volatile LAS unsigned*)xbw);
    mega_run<0>(p, smem, bar);
}

template <int PH> static void launch_phases(const Params& p, int grid, hipStream_t stream) {
    static bool attr = false;
    if (!attr) { (void)hipFuncSetAttribute((const void*)k_phase<PH>, hipFuncAttributeMaxDynamicSharedMemorySize, LDS_BYTES); attr = true; }
    hipLaunchKernelGGL(k_phase<PH>, dim3(grid), dim3(NT), LDS_BYTES, stream, p);
    if constexpr (PH + 1 < NPHASE) launch_phases<PH + 1>(p, grid, stream);
}

extern "C" void kernel_launch(void* const* d_in, const int* in_sizes, int n_in, void* d_out, int out_size, void* d_ws, size_t ws_size, hipStream_t stream) {
    static int grid = 0;
    if (grid == 0) {
        int dev = 0, cus = 0, per_cu = 0;
        (void)hipGetDevice(&dev); (void)hipDeviceGetAttribute(&cus, hipDeviceAttributeMultiprocessorCount, dev);
        (void)hipFuncSetAttribute((const void*)k_mega, hipFuncAttributeMaxDynamicSharedMemorySize, LDS_BYTES);
        (void)hipOccupancyMaxActiveBlocksPerMultiprocessor(&per_cu, (const void*)k_mega, NT, LDS_BYTES);
        (void)hipGetLastError();
        if (cus <= 0) cus = 256;
        grid = cus;
    }
    Params p{};
    const float** pin = (const float**)&p.x;
    for (int i = 0; i < 36; ++i) pin[i] = (const float*)d_in[i];
    p.out = (float*)d_out;
    char* ws = (char*)d_ws; size_t off = 0;
    auto alloc = [&](size_t bytes) { size_t o = off; off += (bytes + 255) & ~(size_t)255; return ws + o; };
    p.bar = (unsigned*)alloc(XCD_BAR_WORDS * 4); p.cnt = (int*)alloc(256 * 4);
    const size_t zero_bytes = off;
    p.slot_tk = (int*)alloc((size_t)(NSLOT + 256) * 4); p.bh = (int*)alloc(1024 * 256 * 4);
    p.xt = (int*)alloc(NXT_MAX * 16); p.ntiles = (int*)alloc(256);
    p.tok_e = (int*)alloc((size_t)TX * 8 * 4); p.tok_pos = (int*)alloc((size_t)TX * 8 * 4); p.tok_w = (float*)alloc((size_t)TX * 8 * 4);
    p.modp = (float*)alloc(16 * 2 * 6144 * 4); p.mod = (float*)alloc(2 * 6144 * 4);
    p.WinT = (bf16_t*)alloc((size_t)INC * 1024 * 2); p.WaT = (bf16_t*)alloc(1024 * 512 * 2); p.WbT = (bf16_t*)alloc(1024 * 1024 * 2); p.WoT = (bf16_t*)alloc(1024 * 1024 * 2);
    p.RtT = (bf16_t*)alloc(256 * 3072 * 2); p.ShGU = (bf16_t*)alloc(512 * 1024 * 2); p.ShD = (bf16_t*)alloc(1024 * 256 * 2);
    p.WupT = (bf16_t*)alloc(1024 * 64 * 2); p.AupT = (bf16_t*)alloc(1024 * 64 * 2); p.GupT = (bf16_t*)alloc(512 * 128 * 2);
    p.ya_in = (bf16_t*)alloc((size_t)TX * 512 * 2); p.yb_in = (bf16_t*)alloc((size_t)TX * 1024 * 2);
    char* RA = alloc((size_t)TE * INC * 2);
    p.proj = (bf16_t*)RA;
    { size_t o = 0; auto sub = [&](size_t b) { char* r = RA + o; o += (b + 255) & ~(size_t)255; return r; };
      p.act = (bf16_t*)sub(((size_t)NSLOT + 256) * 256 * 2); p.logits = (float*)sub((size_t)TX * 256 * 4); }
    const size_t surv = (size_t)TE * 512 * 2 * 5 + (size_t)2 * TX * 512 * 2 + 4096;
    const size_t rtmp = 424935424 + 65536;
    char* RB = alloc(surv + rtmp);
    { size_t o = 0; auto sub = [&](size_t b) { char* r = RB + o; o += (b + 255) & ~(size_t)255; return r; };
      p.Rr = (bf16_t*)sub((size_t)TE * 512 * 2); p.Vv = (bf16_t*)sub((size_t)TE * 512 * 2); p.KD = (bf16_t*)sub((size_t)2 * TE * 512 * 2); p.G = (bf16_t*)sub((size_t)TE * 512 * 2);
      p.O = (bf16_t*)sub((size_t)2 * TX * 512 * 2);
      const size_t o_t = o;
      p.Kk = (bf16_t*)sub((size_t)TE * 512 * 2); p.Aa = (bf16_t*)sub((size_t)TE * 512 * 2); p.Bd = (bf16_t*)sub((size_t)2 * TE * 512 * 2);
      p.Wd = (float*)sub((size_t)2 * TE * 512 * 4); p.TW = (bf16_t*)sub((size_t)TE * 64 * 2); p.XA = (bf16_t*)sub((size_t)TE * 64 * 2); p.SG = (bf16_t*)sub((size_t)TE * 128 * 2);
      p.PH = (float*)sub((size_t)127 * 16 * 2 * 4096 * 4); p.Sst = (float*)sub((size_t)128 * 16 * 4096 * 4);
      p.Zz = (float*)sub((size_t)RNC * 16 * RL * 64 * 4); p.YH = (float*)sub((size_t)RNC * 16 * RL * 64 * 4);
      p.hn = (bf16_t*)p.PH;
      o = o_t;
      p.Qr = (bf16_t*)sub((size_t)NCH * 4 * 128 * 128 * 2); p.Kr = (bf16_t*)sub((size_t)NCH * 4 * 128 * 128 * 2); p.KTz = (bf16_t*)sub((size_t)NCH * 4 * 2 * 128 * 128 * 2);
      p.A3 = (bf16_t*)sub((size_t)NCH * 4 * 128 * 384 * 2); p.B3 = (bf16_t*)sub((size_t)NCH * 4 * 256 * 384 * 2);
      p.KVT = (float*)sub((size_t)NCH * 4 * 2 * 256 * 128 * 4); p.Y = (float*)sub((size_t)TX * 1024 * 4);
      o = 0;
      p.x_mid = (float*)sub((size_t)TX * 1024 * 4); p.Ahl = (bf16_t*)sub((size_t)TX * 1024 * 2);
      p.yk = (bf16_t*)sub((size_t)TX * 9 * 1024 * 2);
      char* yk0 = (char*)p.yk; p.mergedA = (float*)yk0; p.merged = (bf16_t*)(yk0 + (size_t)TX * 1024 * 4); p.mix = (float*)(yk0 + (size_t)TX * 1024 * 6);
    }
    if (off > ws_size) { fprintf(stderr, "kernel_launch: workspace too small: need %zu have %zu\n", off, ws_size); return; }
    int j = 0;
    p.jobs[j++] = TJob{p.w_in, p.WinT, 1024, INC, 1024, 0, 0, 0};
    p.jobs[j++] = TJob{p.w_branch_a, p.WaT, 512, 1024, 512, 0, 0, 0};
    p.jobs[j++] = TJob{p.w_branch_b, p.WbT, 1024, 1024, 1024, 0, 0, 0};
    p.jobs[j++] = TJob{p.w_out, p.WoT, 1024, 1024, 1024, 0, 0, 0};
    p.jobs[j++] = TJob{p.router_w, p.RtT, 1024, 256, 1024, 0, 0, 0};
    p.jobs[j++] = TJob{p.rwkv_g_up, p.GupT, 0, 0, 128, 0, 0, 0};
    p.jobs[j++] = TJob{p.rwkv_g_up, p.GupT, 0, 0, 128, 0, 0, 0};
    p.jobs[j++] = TJob{p.rwkv_g_up, p.GupT, 0, 0, 128, 0, 0, 0};
    p.jobs[j++] = TJob{p.rwkv_w_up, p.WupT, 64, 512, 64, 0, 0, 0};
    p.jobs[j++] = TJob{p.rwkv_w_up + 64 * 512, p.WupT, 64, 512, 64, 0, 512, 0};
    p.jobs[j++] = TJob{p.rwkv_a_up, p.AupT, 64, 512, 64, 0, 0, 0};
    p.jobs[j++] = TJob{p.rwkv_a_up + 64 * 512, p.AupT, 64, 512, 64, 0, 512, 0};
    p.jobs[j++] = TJob{p.rwkv_g_up, p.GupT, 128, 512, 128, 0, 0, 0};
    p.jobs[j++] = TJob{p.rwkv_g_up, p.GupT, 0, 0, 128, 0, 0, 0};
    (void)hipMemsetAsync(ws, 0, zero_bytes, stream);
#if MK_ONE_LAUNCH
    hipLaunchKernelGGL(k_mega, dim3(grid), dim3(NT), LDS_BYTES, stream, p);
#else
    launch_phases<0>(p, grid, stream);
#endif
}
```

```cpp
#include <hip/hip_runtime.h>
#include <stdint.h>
#include <stdio.h>

#ifndef MK_ONE_LAUNCH
#define MK_ONE_LAUNCH 1
#endif
#ifndef ROUTER_K
#define ROUTER_K 1024
#endif
#ifndef PROBE_MASK
#define PROBE_MASK 0u
#endif

typedef unsigned short bf16_t;
typedef short bf16x8 __attribute__((ext_vector_type(8)));
typedef float f32x4 __attribute__((ext_vector_type(4)));
typedef float f32x2 __attribute__((ext_vector_type(2)));

#define NT 512
constexpr int TX = 16384, TC = 256, TE = 16640, DM = 1024, INC = 6912;
constexpr int NCH = 130;
constexpr int RL = 130, RNC = 128;
constexpr int TSTR = 144;
constexpr int TILE_BYTES = 128 * TSTR;
constexpr int LDS_BYTES = 8 * TILE_BYTES + 1024;
constexpr int NSLOT = 131072 + 16384;
constexpr int NXT_MAX = 768 + 64;

#define XB_TMO      128
#define XB_XCNT(j)  (256  + 64 * (j))
#define XB_XSUB(j)  (1280 + 64 * (j))
#define XB_XGEN(j)  (2304 + 64 * (j))
#define XB_TOP      3328
#define XB_TOPGEN   3392
#define XCD_BAR_WORDS 3456
#define XB_SPIN_CAP (1u << 18)
#define LAS __attribute__((address_space(3)))

__device__ __forceinline__ unsigned xb_ld(unsigned* p)              { return __hip_atomic_load(p, __ATOMIC_RELAXED, __HIP_MEMORY_SCOPE_AGENT); }
__device__ __forceinline__ unsigned xb_add(unsigned* p, unsigned v) { return __hip_atomic_fetch_add(p, v, __ATOMIC_RELAXED, __HIP_MEMORY_SCOPE_AGENT); }
__device__ __forceinline__ unsigned xb_xcc_id() { return (unsigned)__builtin_amdgcn_s_getreg((3 << 11) | 20) & 0xFu; }
#define XB_SPIN(cond, bar) do { unsigned _sp = 0; while (cond) { __builtin_amdgcn_s_sleep(1); \
    if ((++_sp & 255u) == 0u) { if (xb_ld(&(bar)[XB_TMO])) break; if (_sp > XB_SPIN_CAP) { atomicAdd(&(bar)[XB_TMO], 1u); break; } } } } while (0)

struct XcdBarrier { unsigned* bar; unsigned x; volatile LAS unsigned* st; };

__device__ __forceinline__ XcdBarrier xcd_barrier_post(unsigned* bar, volatile LAS unsigned* st) {
    XcdBarrier b; b.bar = bar; b.x = xb_xcc_id(); b.st = st;
    if (threadIdx.x == 0) (void)xb_add(&bar[XB_XCNT(b.x)], 1u);
    return b;
}
__device__ __forceinline__ void xcd_barrier_complete(unsigned* bar, unsigned x, unsigned& nloc, unsigned& nx) {
    const unsigned G = gridDim.x * gridDim.y * gridDim.z;
    unsigned sum, cnt, mine, sp = 0u;
    for (;;) {
        sum = 0u; cnt = 0u; mine = 0u;
#pragma unroll
        for (unsigned j = 0; j < 16; ++j) { const unsigned c = xb_ld(&bar[XB_XCNT(j)]); sum += c; cnt += (c > 0u) ? 1u : 0u; mine = (j == x) ? c : mine; }
        if (sum == G) break;
        __builtin_amdgcn_s_sleep(1);
        if ((++sp & 255u) == 0u) { if (xb_ld(&bar[XB_TMO])) break; if (sp > XB_SPIN_CAP) { atomicAdd(&bar[XB_TMO], 1u); break; } }
    }
    nloc = mine > 0u ? mine : 1u; nx = cnt > 0u ? cnt : 1u;
}
__device__ __forceinline__ void xcd_barrier(const XcdBarrier& b) {
    asm volatile("s_waitcnt vmcnt(0)" ::: "memory");
    __syncthreads();
    if (threadIdx.x == 0) {
        unsigned* bar = b.bar;
        __builtin_amdgcn_s_waitcnt(0);
        unsigned nloc = b.st[0], nx = b.st[1];
        if (nloc == 0u) { xcd_barrier_complete(bar, b.x, nloc, nx); b.st[0] = nloc; b.st[1] = nx; }
        const unsigned old = xb_add(&bar[XB_XSUB(b.x)], 1u);
        const unsigned gen = old / nloc;
        if (old + 1u == (gen + 1u) * nloc) {
            __builtin_amdgcn_fence(__ATOMIC_RELEASE, "agent");
            asm volatile("s_waitcnt vmcnt(0)" ::: "memory");
            const unsigned og = xb_add(&bar[XB_TOP], 1u);
            const unsigned tg = og / nx;
            if (og + 1u == (tg + 1u) * nx) xb_add(&bar[XB_TOPGEN], 1u);
            else XB_SPIN(xb_ld(&bar[XB_TOPGEN]) == tg, bar);
            __builtin_amdgcn_fence(__ATOMIC_ACQUIRE, "agent");
            xb_add(&bar[XB_XGEN(b.x)], 1u);
            asm volatile("s_waitcnt vmcnt(0)" ::: "memory");
        } else {
            XB_SPIN(xb_ld(&bar[XB_XGEN(b.x)]) == gen, bar);
            __builtin_amdgcn_fence(__ATOMIC_ACQUIRE, "agent");
            asm volatile("s_waitcnt vmcnt(0)" ::: "memory");
        }
    }
    __syncthreads();
}

struct TJob { const float* src; bf16_t* dst; int K, N, dld, mode, rowoff, coloff; };
constexpr int NJOB = 14;

struct Params {
    const float *x, *c, *ctx, *c_ctx, *w_mod, *b_mod, *n_pre_mix, *n_post_mix, *n_pre_ffn, *n_post_ffn,
        *w_in, *shift_mu, *rwkv_w0, *rwkv_w_up, *rwkv_a0, *rwkv_a_up, *rwkv_g_up, *rwkv_k_k, *rwkv_k_a, *rwkv_r_k,
        *rwkv_ln_w, *rwkv_ln_b, *w_branch_a, *ret_decay_logit, *ret_ln_w, *ret_ln_b, *w_branch_b, *w_out,
        *router_w, *router_bias, *exp_w_gate, *exp_w_up, *exp_w_down, *sh_w_gate, *sh_w_up, *sh_w_down;
    float* out;
    unsigned* bar; int* cnt; int* bh; int* slot_tk; int* xt; int* ntiles; int* tok_e; int* tok_pos; float* tok_w;
    float* modp; float* mod;
    bf16_t *WinT, *WaT, *WbT, *WoT, *RtT, *ShGU, *ShD, *WupT, *AupT, *GupT;
    bf16_t *hn, *proj, *BtW;
    bf16_t *Rr, *Vv, *KD, *G, *O;
    bf16_t *Kk, *Aa, *Bd, *TW, *XA, *SG;
    float *Wd, *PH, *Sst; bf16_t *Zz, *YH;
    bf16_t *Qr, *Kr, *KTz, *A3, *B3;
    bf16_t* KVT; float* Y;
    bf16_t *ya_in, *yb_in, *merged, *Ahl, *act, *yk;
    float *mergedA, *mix, *x_mid, *logits;
    TJob jobs[NJOB];
};

__device__ __forceinline__ int tidx() { int t = threadIdx.x; asm volatile("" : "+v"(t)); return t; }
__device__ __forceinline__ float bf2f(bf16_t v) { return __uint_as_float(((unsigned)v) << 16); }
__device__ __forceinline__ unsigned pack2(float lo, float hi) { unsigned r; asm("v_cvt_pk_bf16_f32 %0, %1, %2" : "=v"(r) : "v"(lo), "v"(hi)); return r; }
__device__ __forceinline__ bf16_t f2bf(float f) { return (bf16_t)(pack2(f, f) & 0xffffu); }
__device__ __forceinline__ void unpack8(const uint4& v, float (&f)[8]) {
    f[0] = __uint_as_float(v.x << 16); f[1] = __uint_as_float(v.x & 0xffff0000u); f[2] = __uint_as_float(v.y << 16); f[3] = __uint_as_float(v.y & 0xffff0000u);
    f[4] = __uint_as_float(v.z << 16); f[5] = __uint_as_float(v.z & 0xffff0000u); f[6] = __uint_as_float(v.w << 16); f[7] = __uint_as_float(v.w & 0xffff0000u); }
__device__ __forceinline__ uint4 pack8(const float (&f)[8]) { uint4 o; o.x = pack2(f[0], f[1]); o.y = pack2(f[2], f[3]); o.z = pack2(f[4], f[5]); o.w = pack2(f[6], f[7]); return o; }
__device__ __forceinline__ float wsum(float v) {
#pragma unroll
    for (int o = 32; o; o >>= 1) v += __shfl_xor(v, o, 64);
    return v;
}
__device__ __forceinline__ float sigm(float z) { return 1.f / (1.f + __expf(-z)); }
__device__ __forceinline__ int row_of(int dir, int s) { return dir == 0 ? s : (s < 256 ? 255 - s : 16895 - s); }

struct APlain { const bf16_t* base; int ld;
    __device__ __forceinline__ const char* bptr() const { return (const char*)base; }
    __device__ __forceinline__ unsigned rowoff(int r) const { return (unsigned)(r * ld) * 2u; } };
struct AGather { const bf16_t* base; int ld; const int* idx;
    __device__ __forceinline__ const char* bptr() const { return (const char*)base; }
    __device__ __forceinline__ unsigned rowoff(int r) const { const int tok = idx[r] / 9; return (unsigned)(tok * ld) * 2u; } };
struct BPlain { static constexpr int MODE = 0; const bf16_t* base; int ldv;
    __device__ __forceinline__ const char* bptr() const { return (const char*)base; }
    __device__ __forceinline__ unsigned rowoff(int n) const { return (unsigned)(n * ldv) * 2u; }
    __device__ __forceinline__ const float* colptr(int) const { return nullptr; }
    __device__ __forceinline__ long ld() const { return ldv; }
    __device__ __forceinline__ int lrow(int, int) const { return 0; } };
struct BKN { static constexpr int MODE = 1; const float* base; long ldv;
    __device__ __forceinline__ const char* bptr() const { return nullptr; }
    __device__ __forceinline__ unsigned rowoff(int) const { return 0u; }
    __device__ __forceinline__ const float* colptr(int n4) const { return base + n4 * 4; }
    __device__ __forceinline__ long ld() const { return ldv; }
    __device__ __forceinline__ int lrow(int n4, int j) const { return n4 * 4 + j; } };
struct BKNGU { static constexpr int MODE = 1; const float* g; const float* u;
    __device__ __forceinline__ const char* bptr() const { return nullptr; }
    __device__ __forceinline__ unsigned rowoff(int) const { return 0u; }
    __device__ __forceinline__ const float* colptr(int n4) const { return ((n4 >> 5) ? u : g) + (n4 & 31) * 4; }
    __device__ __forceinline__ long ld() const { return 256; }
    __device__ __forceinline__ int lrow(int n4, int j) const { int sc = (n4 & 31) * 4 + j; return (sc >> 4) * 32 + (n4 >> 5) * 16 + (sc & 15); } };

__device__ __forceinline__ float f4e(const float4& v, int j) { return j == 0 ? v.x : (j == 1 ? v.y : (j == 2 ? v.z : v.w)); }
#define GC_REP4(N, X) do { if constexpr ((N) > 0) { X(0); } if constexpr ((N) > 1) { X(1); } if constexpr ((N) > 2) { X(2); } if constexpr ((N) > 3) { X(3); } } while (0)
#define GC_REP8(N, X) do { X(0); X(1); X(2); X(3); if constexpr ((N) > 4) { X(4); X(5); X(6); X(7); } } while (0)
#define GC_AOFF(i) aoff##i = ap.rowoff(lrow + 64 * i) + lseg * 16
#define GC_BOFF(i) boff##i = bp.rowoff(lrow + 64 * i) + lseg * 16
#define GC_LA(i) ra##i = *(const uint4*)(abase + (aoff##i + kt_ * 128))
#define GC_LB(i) rb##i = *(const uint4*)(bbase + (boff##i + kt_ * 128))
#define GC_LF(i) rf##i = *(const float4*)(bfp + ((long)kt_ * 64 + i) * bld)
#define GC_SA(i) *(uint4*)(As_ + (lrow + 64 * i) * TSTR + lseg * 16) = ra##i
#define GC_SB(i) *(uint4*)(Bs_ + (lrow + 64 * i) * TSTR + lseg * 16) = rb##i
#define GC_GLOAD(KT) do { const int kt_ = (KT); GC_REP4(AL, GC_LA); \
    if constexpr (BP::MODE == 0) { GC_REP4(BL, GC_LB); } else { GC_REP8(KPT, GC_LF); } } while (0)
#define GC_SF(j) do { char* d_ = Bs_ + bp.lrow(n4, j) * TSTR + kq * KPT * 2; \
        if constexpr (KPT == 4) *(uint2*)d_ = make_uint2(pack2(f4e(rf0, j), f4e(rf1, j)), pack2(f4e(rf2, j), f4e(rf3, j))); \
        else *(uint4*)d_ = make_uint4(pack2(f4e(rf0, j), f4e(rf1, j)), pack2(f4e(rf2, j), f4e(rf3, j)), pack2(f4e(rf4, j), f4e(rf5, j)), pack2(f4e(rf6, j), f4e(rf7, j))); } while (0)
#define GC_LSTORE(BUF) do { char* As_ = smem + (BUF) * STAGE; char* Bs_ = As_ + ABYTES; GC_REP4(AL, GC_SA); \
    if constexpr (BP::MODE == 0) { GC_REP4(BL, GC_SB); } else { GC_SF(0); GC_SF(1); GC_SF(2); GC_SF(3); } } while (0)

template <int BM, int BN, int WGM, int WGN, class AP, class BP>
__device__ __forceinline__ void gemm_core(f32x4 (&acc)[BM / WGM / 16][BN / WGN / 16], const AP& ap, const BP& bp, const int K, char* smem) {
    constexpr int TM = BM / WGM, TN = BN / WGN, MI = TM / 16, NI = TN / 16;
    constexpr int ABYTES = BM * TSTR, STAGE = (BM + BN) * TSTR;
    constexpr int AL = BM / 64, BL = BN / 64;
    constexpr int KPT = BN / 32, NQ = BN / 4;
    const int tid = tidx(), wave = tid >> 6, lane = tid & 63, fr = lane & 15, fq = lane >> 4;
    const int wm = wave / WGN, wn = wave % WGN;
    const int lrow = tid >> 3, lseg = tid & 7;
    const char* abase = ap.bptr(); const char* bbase = bp.bptr();
    unsigned aoff0 = 0, aoff1 = 0, aoff2 = 0, aoff3 = 0, boff0 = 0, boff1 = 0, boff2 = 0, boff3 = 0;
    uint4 ra0, ra1, ra2, ra3, rb0, rb1, rb2, rb3; float4 rf0, rf1, rf2, rf3, rf4, rf5, rf6, rf7;
    GC_REP4(AL, GC_AOFF);
    const float* bfp = nullptr;
    const int kq = tid / NQ, n4 = tid % NQ; const long bld = bp.ld();
    if constexpr (BP::MODE == 0) { GC_REP4(BL, GC_BOFF); } else { bfp = bp.colptr(n4) + (long)(kq * KPT) * bld; }
    int nk = K >> 6;
    asm volatile("" : "+s"(nk));
    GC_GLOAD(0); GC_LSTORE(0); __syncthreads();
    for (int kt = 0; kt < nk; ++kt) {
        if (kt + 1 < nk) GC_GLOAD(kt + 1);
        const char* As = smem + (kt & 1) * STAGE; const char* Bs = As + ABYTES;
#pragma unroll
        for (int ks = 0; ks < 2; ++ks) {
            bf16x8 af[MI], bfr[NI];
#pragma unroll
            for (int mi = 0; mi < MI; ++mi) af[mi] = *(const bf16x8*)(As + (wm * TM + mi * 16 + fr) * TSTR + ks * 64 + fq * 16);
#pragma unroll
            for (int ni = 0; ni < NI; ++ni) bfr[ni] = *(const bf16x8*)(Bs + (wn * TN + ni * 16 + fr) * TSTR + ks * 64 + fq * 16);
#pragma unroll
            for (int mi = 0; mi < MI; ++mi)
#pragma unroll
                for (int ni = 0; ni < NI; ++ni) acc[mi][ni] = __builtin_amdgcn_mfma_f32_16x16x32_bf16(bfr[ni], af[mi], acc[mi][ni], 0, 0, 0);
        }
        if (kt + 1 < nk) GC_LSTORE((kt + 1) & 1);
        __syncthreads();
    }
}
template <int BM, int BN, int WGM, int WGN, class AP, class BP, class EPI>
__device__ __forceinline__ void gemm_tile(const AP& ap, const BP& bp, const int K, char* smem, const EPI& epi) {
    constexpr int TM = BM / WGM, TN = BN / WGN, MI = TM / 16, NI = TN / 16;
    f32x4 acc[MI][NI];
#pragma unroll
    for (int mi = 0; mi < MI; ++mi)
#pragma unroll
        for (int ni = 0; ni < NI; ++ni) acc[mi][ni] = (f32x4){0.f, 0.f, 0.f, 0.f};
    gemm_core<BM, BN, WGM, WGN>(acc, ap, bp, K, smem);
    const int wave = tidx() >> 6, lane = tidx() & 63;
    epi(acc, (wave / WGN) * TM + (lane & 15), (wave % WGN) * TN + (lane >> 4) * 4);
}

namespace g8 {
constexpr int BM = 256, BK = 64, HALF = 128, HTB = HALF * BK * 2, NXCD = 8, WGM = 8;
__device__ __forceinline__ int lds_byte(int r, int c) { const int st = (r >> 4) * 2 + (c >> 5), rr = r & 15, cc = c & 31, ob = rr * 64 + cc * 2; return st * 1024 + (ob ^ (((ob >> 9) & 1) << 5)); }
__device__ __forceinline__ void stage_rc(int b, int& R, int& C) { const int st = b / 1024, sb = b % 1024, swz = sb ^ (((sb >> 9) & 1) << 5); R = (st >> 1) * 16 + swz / 64; C = (st & 1) * 32 + (swz % 64) / 2; }
__device__ __forceinline__ int perm32(int rho) { const int n = rho >> 4, i = rho & 15; return 8 * (i >> 2) + 4 * n + (i & 3); }
struct Unit { int pm, pn; };
struct StaticOrder {
    int nM, nN, nwg, G, c;
    __device__ void init(int M, int N, int G_, int c_) { nM = M / BM; nN = N / BM; nwg = nM * nN; G = G_; c = c_; }
    __device__ bool next(int i, Unit& u) const {
        const long L = (long)i * G + c; if (L >= nwg) return false;
        int wgid = (int)L; { const int q = nwg / NXCD, r = nwg % NXCD, xcd = wgid % NXCD, off = wgid / NXCD; wgid = (xcd < r ? xcd * (q + 1) : r * (q + 1) + (xcd - r) * q) + off; }
        const int nig = WGM * nN, gid = wgid / nig, fm = gid * WGM, gsz = (nM - fm) < WGM ? (nM - fm) : WGM;
        u.pm = fm + ((wgid % nig) % gsz); u.pn = (wgid % nig) / gsz; return true;
    }
};
template <class Epi, class Sched>
__device__ __forceinline__ void gemm_phase(LAS unsigned char* lds, const bf16_t* Ag, const bf16_t* Btg, const int lda, const int ldb, const int K, const Sched& S, const Epi& E) {
    const int tid = threadIdx.x, wid = __builtin_amdgcn_readfirstlane(tid >> 6), lane = tid & 63, wr = wid >> 2, wc = wid & 3, fr = lane & 15, fq = lane >> 4;
    const int nt = K / BK;
    unsigned voffA[2], voffB[2];
#pragma unroll
    for (int i = 0; i < 2; ++i) { int R, C; stage_rc(tid * 16 + i * 8192, R, C); const int Rb = Epi::PERM ? ((R & ~31) + perm32(R & 31)) : R;
        voffA[i] = (unsigned)(R * lda + C) * 2u; voffB[i] = (unsigned)(Rb * ldb + C) * 2u; }
    const size_t kstep = (size_t)(BK * 2);
    const size_t hstepA = (size_t)HALF * lda * 2, hstepB = (size_t)HALF * ldb * 2;
    const size_t tstepA = 2 * hstepA, tstepB = 2 * hstepB;
    const unsigned ldsw = (unsigned)wid * 1024u;
    const int aoff = lds_byte(wr * 64 + fr, fq * 8), boff = lds_byte(wc * 32 + fr, fq * 8);
#define PG8_SA(b, h) (((b) * 2 + (h)) * HTB)
#define PG8_SB(b, h) ((4 + (b) * 2 + (h)) * HTB)
#define PG8_STAGE(bufoff, gbase, voff) do { _Pragma("unroll") for (int _i = 0; _i < 2; ++_i) \
        __builtin_amdgcn_global_load_lds((const unsigned*)((const char*)(gbase) + (voff)[_i]), (LAS unsigned*)(lds + (bufoff) + ldsw + _i * 8192), 16, 0, 0); } while (0)
#define PG8_LDA(dst, b, h) do { _Pragma("unroll") for (int m = 0; m < 4; ++m) _Pragma("unroll") for (int k = 0; k < 2; ++k) dst[m][k] = *(const LAS bf16x8*)(lds + PG8_SA(b, h) + aoff + m * 2048 + k * 1024); } while (0)
#define PG8_LDB(dst, b, h) do { _Pragma("unroll") for (int n = 0; n < 2; ++n) _Pragma("unroll") for (int k = 0; k < 2; ++k) dst[n][k] = *(const LAS bf16x8*)(lds + PG8_SB(b, h) + boff + n * 2048 + k * 1024); } while (0)
#define PG8_MMA(ai, bj, At, Bt) do { __builtin_amdgcn_s_setprio(1); _Pragma("unroll") for (int m = 0; m < 4; ++m) _Pragma("unroll") for (int n = 0; n < 2; ++n) _Pragma("unroll") for (int k = 0; k < 2; ++k) \
        acc[ai][bj][m][n] = __builtin_amdgcn_mfma_f32_16x16x32_bf16(Bt[n][k], At[m][k], acc[ai][bj][m][n], 0, 0, 0); __builtin_amdgcn_s_setprio(0); } while (0)
#define PG8_WAIT_V(n) asm volatile("s_waitcnt vmcnt(" #n ")" ::: "memory")
#define PG8_WAIT_L(n) asm volatile("s_waitcnt lgkmcnt(" #n ")" ::: "memory")
#define PG8_BAR __builtin_amdgcn_s_barrier()
#define PG8_SCHED __builtin_amdgcn_sched_barrier(0)
    Unit cur, nxt; int ui = 0;
    if (!S.next(0, cur)) return;
    f32x4 acc[2][2][4][2];
#pragma unroll
    for (int a = 0; a < 2; ++a)
#pragma unroll
        for (int b = 0; b < 2; ++b)
#pragma unroll
            for (int m = 0; m < 4; ++m)
#pragma unroll
                for (int n = 0; n < 2; ++n) acc[a][b][m][n] = (f32x4){0.f, 0.f, 0.f, 0.f};
    bf16x8 At[4][2], B0[2][2], B1[2][2];
    const char* cA = (const char*)Ag + (size_t)cur.pm * tstepA; const char* cB = (const char*)Btg + (size_t)cur.pn * tstepB;
    PG8_STAGE(PG8_SB(0, 0), cB, voffB); PG8_STAGE(PG8_SA(0, 0), cA, voffA); PG8_STAGE(PG8_SB(0, 1), cB + hstepB, voffB); PG8_STAGE(PG8_SA(0, 1), cA + hstepA, voffA);
    if (wr == 1) PG8_BAR;
    PG8_WAIT_V(4); PG8_BAR;
    PG8_STAGE(PG8_SB(1, 0), cB + kstep, voffB); PG8_STAGE(PG8_SA(1, 0), cA + kstep, voffA); PG8_STAGE(PG8_SB(1, 1), cB + hstepB + kstep, voffB);
    PG8_WAIT_V(6); PG8_BAR;
    for (;;) {
        const bool has_next = S.next(ui + 1, nxt);
        const char* nA = has_next ? (const char*)Ag + (size_t)nxt.pm * tstepA : cA; const char* nB = has_next ? (const char*)Btg + (size_t)nxt.pn * tstepB : cB;
        for (int t = 0; t < nt; t += 2) {
            const bool last = (t == nt - 2);
            const char* a1 = cA + (size_t)(t + 1) * kstep;
            const char* a2 = last ? nA : cA + (size_t)(t + 2) * kstep; const char* b2 = last ? nB : cB + (size_t)(t + 2) * kstep;
            const char* a3 = a2 + kstep; const char* b3 = b2 + kstep;
            PG8_LDB(B0, 0, 0); PG8_SCHED; PG8_LDA(At, 0, 0); PG8_STAGE(PG8_SA(1, 1), a1 + hstepA, voffA);
            PG8_WAIT_L(8); PG8_BAR; PG8_WAIT_L(0); PG8_MMA(0, 0, At, B0); PG8_BAR; PG8_SCHED;
            PG8_LDB(B1, 0, 1); PG8_STAGE(PG8_SB(0, 0), b2, voffB);
            PG8_BAR; PG8_WAIT_L(0); PG8_MMA(0, 1, At, B1); PG8_BAR;
            PG8_LDA(At, 0, 1); PG8_STAGE(PG8_SA(0, 0), a2, voffA);
            PG8_BAR; PG8_WAIT_L(0); PG8_MMA(1, 0, At, B0); PG8_BAR; PG8_SCHED;
            PG8_STAGE(PG8_SB(0, 1), b2 + hstepB, voffB);
            PG8_WAIT_V(6); PG8_BAR; PG8_MMA(1, 1, At, B1); PG8_BAR;
            PG8_LDB(B0, 1, 0); PG8_SCHED; PG8_LDA(At, 1, 0); PG8_STAGE(PG8_SA(0, 1), a2 + hstepA, voffA);
            PG8_WAIT_L(8); PG8_BAR; PG8_WAIT_L(0); PG8_MMA(0, 0, At, B0); PG8_BAR; PG8_SCHED;
            PG8_LDB(B1, 1, 1); PG8_STAGE(PG8_SB(1, 0), b3, voffB);
            PG8_BAR; PG8_WAIT_L(0); PG8_MMA(0, 1, At, B1); PG8_BAR;
            PG8_LDA(At, 1, 1); PG8_STAGE(PG8_SA(1, 0), a3, voffA);
            PG8_BAR; PG8_WAIT_L(0); PG8_MMA(1, 0, At, B0); PG8_BAR; PG8_SCHED;
            PG8_STAGE(PG8_SB(1, 1), b3 + hstepB, voffB);
            PG8_WAIT_V(6); PG8_BAR; PG8_MMA(1, 1, At, B1); PG8_BAR;
        }
        E(acc, cur, wr, wc, fr, fq);
        if (!has_next) break;
#pragma unroll
        for (int a = 0; a < 2; ++a)
#pragma unroll
            for (int b = 0; b < 2; ++b)
#pragma unroll
                for (int m = 0; m < 4; ++m)
#pragma unroll
                    for (int n = 0; n < 2; ++n) acc[a][b][m][n] = (f32x4){0.f, 0.f, 0.f, 0.f};
        cur = nxt; cA = nA; cB = nB; ++ui;
    }
    PG8_WAIT_V(0);
    if (wr == 0) PG8_BAR;
    PG8_BAR;
#undef PG8_SA
#undef PG8_SB
#undef PG8_STAGE
#undef PG8_LDA
#undef PG8_LDB
#undef PG8_MMA
#undef PG8_WAIT_V
#undef PG8_WAIT_L
#undef PG8_BAR
#undef PG8_SCHED
}
struct EpiF32 {
    static constexpr bool PERM = false;
    float* C; int ldc;
    __device__ __forceinline__ void operator()(const f32x4 (&acc)[2][2][4][2], const Unit& u, int wr, int wc, int fr, int fq) const {
        const int row0 = u.pm * BM + wr * 64 + fr, col0 = u.pn * BM + wc * 32 + 4 * fq;
#pragma unroll
        for (int ai = 0; ai < 2; ++ai)
#pragma unroll
            for (int m = 0; m < 4; ++m) { float* rowp = C + (size_t)(row0 + ai * HALF + m * 16) * ldc + col0;
#pragma unroll
                for (int bj = 0; bj < 2; ++bj)
#pragma unroll
                    for (int n = 0; n < 2; ++n) *(f32x4*)(rowp + bj * HALF + n * 16) = acc[ai][bj][m][n]; }
    }
};
struct EpiBf16 {
    static constexpr bool PERM = true;
    bf16_t* O; int ldc;
    __device__ __forceinline__ void operator()(const f32x4 (&acc)[2][2][4][2], const Unit& u, int wr, int wc, int fr, int fq) const {
        const int row0 = u.pm * BM + wr * 64 + fr, col0 = u.pn * BM + wc * 32 + 8 * fq;
#pragma unroll
        for (int ai = 0; ai < 2; ++ai)
#pragma unroll
            for (int m = 0; m < 4; ++m) { bf16_t* rowp = O + (size_t)(row0 + ai * HALF + m * 16) * ldc + col0;
#pragma unroll
                for (int bj = 0; bj < 2; ++bj) { const f32x4 v0 = acc[ai][bj][m][0], v1 = acc[ai][bj][m][1];
                    uint4 o; o.x = pack2(v0[0], v0[1]); o.y = pack2(v0[2], v0[3]); o.z = pack2(v1[0], v1[1]); o.w = pack2(v1[2], v1[3]);
                    *(uint4*)(rowp + bj * HALF) = o; } }
    }
};
struct XUnit { int row0, nrows, e, nt; };
template <class Epi>
__device__ __forceinline__ void gemm_phase_xg(LAS unsigned char* lds, const bf16_t* Ag, const int* slot_tk, const int* xt, const bf16_t* BtW, const int nun, const int lb, const int G, const Epi& E) {
    const int tid = threadIdx.x, wid = __builtin_amdgcn_readfirstlane(tid >> 6), lane = tid & 63, wr = wid >> 2, wc = wid & 3, fr = lane & 15, fq = lane >> 4;
    constexpr int K = 1024, nt = K / BK;
    unsigned voffB[2];
#pragma unroll
    for (int i = 0; i < 2; ++i) { int R, C; stage_rc(tid * 16 + i * 8192, R, C); voffB[i] = (unsigned)(R * K + C) * 2u; }
    const size_t kstep = (size_t)(BK * 2), hstepB = (size_t)HALF * K * 2;
    const unsigned ldsw = (unsigned)wid * 1024u;
    const int aoff = lds_byte(wr * 64 + fr, fq * 8), boff = lds_byte(wc * 32 + fr, fq * 8);
#define PG8_SA(b, h) (((b) * 2 + (h)) * HTB)
#define PG8_SB(b, h) ((4 + (b) * 2 + (h)) * HTB)
#define PG8_STAGE(bufoff, gbase, voff) do { _Pragma("unroll") for (int _i = 0; _i < 2; ++_i) \
        __builtin_amdgcn_global_load_lds((const unsigned*)((const char*)(gbase) + (voff)[_i]), (LAS unsigned*)(lds + (bufoff) + ldsw + _i * 8192), 16, 0, 0); } while (0)
#define PG8_LDA(dst, b, h) do { _Pragma("unroll") for (int m = 0; m < 4; ++m) _Pragma("unroll") for (int k = 0; k < 2; ++k) dst[m][k] = *(const LAS bf16x8*)(lds + PG8_SA(b, h) + aoff + m * 2048 + k * 1024); } while (0)
#define PG8_LDB(dst, b, h) do { _Pragma("unroll") for (int n = 0; n < 2; ++n) _Pragma("unroll") for (int k = 0; k < 2; ++k) dst[n][k] = *(const LAS bf16x8*)(lds + PG8_SB(b, h) + boff + n * 2048 + k * 1024); } while (0)
#define PG8_MMA(ai, bj, At, Bt) do { __builtin_amdgcn_s_setprio(1); _Pragma("unroll") for (int m = 0; m < 4; ++m) _Pragma("unroll") for (int n = 0; n < 2; ++n) _Pragma("unroll") for (int k = 0; k < 2; ++k) \
        acc[ai][bj][m][n] = __builtin_amdgcn_mfma_f32_16x16x32_bf16(Bt[n][k], At[m][k], acc[ai][bj][m][n], 0, 0, 0); __builtin_amdgcn_s_setprio(0); } while (0)
#define PG8_WAIT_V(n) asm volatile("s_waitcnt vmcnt(" #n ")" ::: "memory")
#define PG8_WAIT_L(n) asm volatile("s_waitcnt lgkmcnt(" #n ")" ::: "memory")
#define PG8_BAR __builtin_amdgcn_s_barrier()
#define PG8_SCHED __builtin_amdgcn_sched_barrier(0)
#define XG_UNIT(I, U) ((lb + (I) * G) < nun ? ((U).row0 = xt[((lb + (I) * G) >> 1) * 4 + 1], (U).nrows = xt[((lb + (I) * G) >> 1) * 4 + 2], (U).e = xt[((lb + (I) * G) >> 1) * 4], (U).nt = (lb + (I) * G) & 1, true) : false)
#define XG_AVOFF(U, V0, V1) do { int t_ = threadIdx.x; asm volatile("" : "+v"(t_)); _Pragma("unroll") for (int _i = 0; _i < 2; ++_i) { int R_, C_; stage_rc(t_ * 16 + _i * 8192, R_, C_); \
        V0[_i] = (unsigned)(slot_tk[(U).row0 + R_] / 9) * 2048u + (unsigned)C_ * 2u; V1[_i] = (unsigned)(slot_tk[(U).row0 + 128 + R_] / 9) * 2048u + (unsigned)C_ * 2u; } } while (0)
    XUnit cur, nxt; int ui = 0;
    if (!XG_UNIT(0, cur)) return;
    f32x4 acc[2][2][4][2];
#pragma unroll
    for (int a = 0; a < 2; ++a)
#pragma unroll
        for (int b = 0; b < 2; ++b)
#pragma unroll
            for (int m = 0; m < 4; ++m)
#pragma unroll
                for (int n = 0; n < 2; ++n) acc[a][b][m][n] = (f32x4){0.f, 0.f, 0.f, 0.f};
    bf16x8 At[4][2], B0[2][2], B1[2][2];
    unsigned vC0[2], vC1[2], vN1[2];
    XG_AVOFF(cur, vC0, vC1);
    const char* cA = (const char*)Ag;
    const char* cB = (const char*)(BtW + ((size_t)cur.e * 512 + cur.nt * 256) * K);
    PG8_STAGE(PG8_SB(0, 0), cB, voffB); PG8_STAGE(PG8_SA(0, 0), cA, vC0); PG8_STAGE(PG8_SB(0, 1), cB + hstepB, voffB); PG8_STAGE(PG8_SA(0, 1), cA, vC1);
    if (wr == 1) PG8_BAR;
    PG8_WAIT_V(4); PG8_BAR;
    PG8_STAGE(PG8_SB(1, 0), cB + kstep, voffB); PG8_STAGE(PG8_SA(1, 0), cA + kstep, vC0); PG8_STAGE(PG8_SB(1, 1), cB + hstepB + kstep, voffB);
    PG8_WAIT_V(6); PG8_BAR;
    for (;;) {
        const bool has_next = XG_UNIT(ui + 1, nxt);
        if (!has_next) nxt = cur;
        const char* nB = (const char*)(BtW + ((size_t)nxt.e * 512 + nxt.nt * 256) * K);
        for (int t = 0; t < nt; t += 2) {
            const bool last = (t == nt - 2);
            if (last) XG_AVOFF(nxt, vC0, vN1);
            const char* a1 = cA + (size_t)(t + 1) * kstep;
            const char* a2 = last ? cA : cA + (size_t)(t + 2) * kstep; const char* b2 = last ? nB : cB + (size_t)(t + 2) * kstep;
            const char* a3 = a2 + kstep; const char* b3 = b2 + kstep;
            PG8_LDB(B0, 0, 0); PG8_SCHED; PG8_LDA(At, 0, 0); PG8_STAGE(PG8_SA(1, 1), a1, vC1);
            if (last) { vC1[0] = vN1[0]; vC1[1] = vN1[1]; }
            PG8_WAIT_L(8); PG8_BAR; PG8_WAIT_L(0); PG8_MMA(0, 0, At, B0); PG8_BAR; PG8_SCHED;
            PG8_LDB(B1, 0, 1); PG8_STAGE(PG8_SB(0, 0), b2, voffB);
            PG8_BAR; PG8_WAIT_L(0); PG8_MMA(0, 1, At, B1); PG8_BAR;
            PG8_LDA(At, 0, 1); PG8_STAGE(PG8_SA(0, 0), a2, vC0);
            PG8_BAR; PG8_WAIT_L(0); PG8_MMA(1, 0, At, B0); PG8_BAR; PG8_SCHED;
            PG8_STAGE(PG8_SB(0, 1), b2 + hstepB, voffB);
            PG8_WAIT_V(6); PG8_BAR; PG8_MMA(1, 1, At, B1); PG8_BAR;
            PG8_LDB(B0, 1, 0); PG8_SCHED; PG8_LDA(At, 1, 0); PG8_STAGE(PG8_SA(0, 1), a2, vC1);
            PG8_WAIT_L(8); PG8_BAR; PG8_WAIT_L(0); PG8_MMA(0, 0, At, B0); PG8_BAR; PG8_SCHED;
            PG8_LDB(B1, 1, 1); PG8_STAGE(PG8_SB(1, 0), b3, voffB);
            PG8_BAR; PG8_WAIT_L(0); PG8_MMA(0, 1, At, B1); PG8_BAR;
            PG8_LDA(At, 1, 1); PG8_STAGE(PG8_SA(1, 0), a3, vC0);
            PG8_BAR; PG8_WAIT_L(0); PG8_MMA(1, 0, At, B0); PG8_BAR; PG8_SCHED;
            PG8_STAGE(PG8_SB(1, 1), b3 + hstepB, voffB);
            PG8_WAIT_V(6); PG8_BAR; PG8_MMA(1, 1, At, B1); PG8_BAR;
        }
        E(acc, cur, wr, wc, fr, fq);
        if (!has_next) break;
#pragma unroll
        for (int a = 0; a < 2; ++a)
#pragma unroll
            for (int b = 0; b < 2; ++b)
#pragma unroll
                for (int m = 0; m < 4; ++m)
#pragma unroll
                    for (int n = 0; n < 2; ++n) acc[a][b][m][n] = (f32x4){0.f, 0.f, 0.f, 0.f};
        cur = nxt; cB = nB; ++ui;
    }
    PG8_WAIT_V(0);
    if (wr == 0) PG8_BAR;
    PG8_BAR;
#undef PG8_SA
#undef PG8_SB
#undef PG8_STAGE
#undef PG8_LDA
#undef PG8_LDB
#undef PG8_MMA
#undef PG8_WAIT_V
#undef PG8_WAIT_L
#undef PG8_BAR
#undef PG8_SCHED
#undef XG_UNIT
#undef XG_AVOFF
}
struct EpiGU {
    bf16_t* act;
    __device__ __forceinline__ void operator()(const f32x4 (&acc)[2][2][4][2], const XUnit& u, int wr, int wc, int fr, int fq) const {
        const int r0 = wr * 64 + fr;
#pragma unroll
        for (int ai = 0; ai < 2; ++ai)
#pragma unroll
            for (int m = 0; m < 4; ++m) { const int r = r0 + ai * HALF + m * 16;
                if (r < u.nrows) { bf16_t* rowp = act + (size_t)(u.row0 + r) * 256 + u.nt * 128 + wc * 16 + fq * 4;
#pragma unroll
                    for (int bj = 0; bj < 2; ++bj) { const f32x4 g = acc[ai][bj][m][0], up = acc[ai][bj][m][1];
                        uint2 o; o.x = pack2(g[0] * sigm(g[0]) * up[0], g[1] * sigm(g[1]) * up[1]); o.y = pack2(g[2] * sigm(g[2]) * up[2], g[3] * sigm(g[3]) * up[3]);
                        *(uint2*)(rowp + bj * 64) = o; } } }
    }
};
}

__device__ __forceinline__ void conv_gu_tiles(const Params& p, char* smem, int w0, int nw, int t_begin, int t_end) {
    const int tid = tidx(), wave = tid >> 6, lane = tid & 63;
    bf16_t* T = (bf16_t*)smem + wave * (2 * 16 * 72);
    for (int tau = t_begin + w0 * 2; tau < t_end; tau += nw * 2) {
        float4 v[2][4];
#pragma unroll
        for (int h = 0; h < 2; ++h) {
            const int tt = tau + h < t_end ? tau + h : tau;
            const int m = tt >> 8, kb = (tt >> 4) & 15, nb = tt & 15, e = m >> 1, sel = m & 1;
            const float* src = (sel ? (e < 256 ? p.exp_w_up + (size_t)e * 262144 : p.sh_w_up) : (e < 256 ? p.exp_w_gate + (size_t)e * 262144 : p.sh_w_gate)) + (size_t)(kb * 64 + lane) * 256 + nb * 16;
#pragma unroll
            for (int i = 0; i < 4; ++i) v[h][i] = *(const float4*)(src + i * 4);
        }
#pragma unroll
        for (int h = 0; h < 2; ++h) {
            if (tau + h >= t_end) break;
            const int tt = tau + h;
            const int m = tt >> 8, kb = (tt >> 4) & 15, nb = tt & 15, e = m >> 1, sel = m & 1;
            bf16_t* Th = T + h * (16 * 72);
#pragma unroll
            for (int i = 0; i < 4; ++i) { Th[(i * 4 + 0) * 72 + lane] = f2bf(v[h][i].x); Th[(i * 4 + 1) * 72 + lane] = f2bf(v[h][i].y); Th[(i * 4 + 2) * 72 + lane] = f2bf(v[h][i].z); Th[(i * 4 + 3) * 72 + lane] = f2bf(v[h][i].w); }
            const int q = lane >> 2, seg = lane & 3;
            const uint4 o0 = *(const uint4*)(Th + q * 72 + seg * 16), o1 = *(const uint4*)(Th + q * 72 + seg * 16 + 8);
            const int rho = (nb >> 3) * 256 + ((nb >> 2) & 1) * 128 + (nb & 3) * 32 + sel * 16 + q;
            bf16_t* d = p.BtW + ((size_t)e * 512 + rho) * 1024 + kb * 64 + seg * 16;
            *(uint4*)d = o0; *(uint4*)(d + 8) = o1;
        }
    }
}

__device__ __forceinline__ void phase0(const Params& p, char* smem) {
    const int tid = tidx(), wave = tid >> 6, lane = tid & 63;
    const int gw = blockIdx.x * 8 + wave, nw = gridDim.x * 8;
    for (int u = gw; u < 1536; u += nw) {
        const int cb = u % 96, ks = u / 96, j = cb * 64 + lane;
        float a0 = 0.f, a1 = 0.f;
#pragma unroll 1
        for (int k0 = ks * 64; k0 < ks * 64 + 64; k0 += 16) {
            float w[16];
#pragma unroll
            for (int i = 0; i < 16; ++i) w[i] = p.w_mod[(size_t)(k0 + i) * 6144 + j];
#pragma unroll
            for (int i = 0; i < 16; ++i) { const float c0 = p.c[k0 + i], c1 = p.c_ctx[k0 + i]; a0 += c0 * sigm(c0) * w[i]; a1 += c1 * sigm(c1) * w[i]; }
        }
        p.modp[(ks * 2 + 0) * 6144 + j] = a0; p.modp[(ks * 2 + 1) * 6144 + j] = a1;
    }
    float* T = (float*)smem;
    int total = 0;
    for (int j = 0; j < NJOB; ++j) total += (p.jobs[j].K >> 6) * (p.jobs[j].N >> 6);
    for (int u = blockIdx.x; u < total; u += gridDim.x) {
        int j = 0, r = u;
        for (;; ++j) { const int n = (p.jobs[j].K >> 6) * (p.jobs[j].N >> 6); if (r < n) break; r -= n; }
        const TJob jb = p.jobs[j];
        const int ntn = jb.N >> 6, kt = r / ntn, nt = r % ntn, k0 = kt * 64, n0 = nt * 64;
        {
            const int kk = tid >> 4, c4 = (tid & 15) * 4;
#pragma unroll
            for (int i = 0; i < 2; ++i) {
                const int k = kk + 32 * i;
                const float4 v = *(const float4*)(jb.src + (size_t)(k0 + k) * jb.N + n0 + c4);
                T[k * 65 + c4 + 0] = v.x; T[k * 65 + c4 + 1] = v.y; T[k * 65 + c4 + 2] = v.z; T[k * 65 + c4 + 3] = v.w;
            }
        }
        __syncthreads();
        {
            const int n = tid >> 3, ks = (tid & 7) * 8;
            float v[8];
#pragma unroll
            for (int q = 0; q < 8; ++q) v[q] = T[(ks + q) * 65 + n];
            const int ng = n0 + n;
            int drow = jb.rowoff + ng;
            if (jb.mode == 2) drow = (ng >> 4) * 32 + (ng & 15) + jb.rowoff;
            uint4 hi; hi.x = pack2(v[0], v[1]); hi.y = pack2(v[2], v[3]); hi.z = pack2(v[4], v[5]); hi.w = pack2(v[6], v[7]);
            bf16_t* d = jb.dst + (size_t)drow * jb.dld + jb.coloff + k0 + ks;
            *(uint4*)d = hi;
            if (jb.mode == 1) {
                float l[8];
#pragma unroll
                for (int q = 0; q < 8; ++q) l[q] = v[q] - bf2f(f2bf(v[q]));
                uint4 lo; lo.x = pack2(l[0], l[1]); lo.y = pack2(l[2], l[3]); lo.z = pack2(l[4], l[5]); lo.w = pack2(l[6], l[7]);
                *(uint4*)(d + 1024) = hi; *(uint4*)(d + 2048) = lo;
            }
        }
        __syncthreads();
    }
}

__device__ __forceinline__ void phase1(const Params& p, char* smem) {
    const int tid = tidx(), wave = tid >> 6, lane = tid & 63;
    float* L = (float*)smem;
    for (int idx = tid; idx < 4096; idx += NT) {
        const int v = idx >> 11, which = (idx >> 10) & 1, col = idx & 1023;
        float s = p.b_mod[which * 1024 + col];
        for (int ks = 0; ks < 16; ++ks) s += p.modp[(ks * 2 + v) * 6144 + which * 1024 + col];
        L[idx] = s;
    }
    for (int idx = blockIdx.x * NT + tid; idx < 2 * 6144; idx += gridDim.x * NT) {
        const int v = idx / 6144, j = idx % 6144;
        float sm = p.b_mod[j];
#pragma unroll
        for (int ks = 0; ks < 16; ++ks) sm += p.modp[(ks * 2 + v) * 6144 + j];
        p.mod[idx] = sm;
    }
    __syncthreads();
    const int gw = blockIdx.x * 8 + wave, nw = gridDim.x * 8;
    for (int r = gw; r < TE; r += nw) {
        const int v = r < 256 ? 1 : 0;
        const float* src = r < 256 ? p.ctx + (size_t)r * 1024 : p.x + (size_t)(r - 256) * 1024;
        float4 xv[4]; float ss = 0.f;
#pragma unroll
        for (int i = 0; i < 4; ++i) { xv[i] = *(const float4*)(src + i * 256 + lane * 4); ss += xv[i].x * xv[i].x + xv[i].y * xv[i].y + xv[i].z * xv[i].z + xv[i].w * xv[i].w; }
        ss = wsum(ss);
        const float rs = rsqrtf(ss * (1.f / 1024.f) + 1e-6f);
#pragma unroll
        for (int i = 0; i < 4; ++i) {
            const int col = i * 256 + lane * 4;
            const float4 g = *(const float4*)(p.n_pre_mix + col);
            const float* sh = L + v * 2048 + col; const float* sc = L + v * 2048 + 1024 + col;
            const float y0 = xv[i].x * rs * g.x * (1.f + sc[0]) + sh[0];
            const float y1 = xv[i].y * rs * g.y * (1.f + sc[1]) + sh[1];
            const float y2 = xv[i].z * rs * g.z * (1.f + sc[2]) + sh[2];
            const float y3 = xv[i].w * rs * g.w * (1.f + sc[3]) + sh[3];
            uint2 o; o.x = pack2(y0, y1); o.y = pack2(y2, y3);
            *(uint2*)(p.hn + (size_t)r * 1024 + col) = o;
        }
    }
}

__device__ __forceinline__ void phase2(const Params& p, char* smem) {
    g8::StaticOrder S; S.init(TE, INC, gridDim.x, blockIdx.x);
    g8::EpiBf16 E{p.proj, INC};
    g8::gemm_phase((LAS unsigned char*)smem, p.hn, p.WinT, 1024, 1024, 1024, S, E);
}

__device__ __forceinline__ void phase3(const Params& p, char* smem) {
    const int tid = tidx(), wave = tid >> 6, lane = tid & 63;
    const int gw = blockIdx.x * 8 + wave, nw = gridDim.x * 8;
    float mu0[3][8], mu1[3][8], kkw[8], lm0[4], lm1[4];
#pragma unroll
    for (int a = 0; a < 3; ++a)
#pragma unroll
        for (int q = 0; q < 8; ++q) { mu0[a][q] = p.shift_mu[a * 512 + lane * 8 + q]; mu1[a][q] = p.shift_mu[1792 + a * 512 + lane * 8 + q]; }
#pragma unroll
    for (int q = 0; q < 8; ++q) kkw[q] = p.rwkv_k_k[lane * 8 + q];
#pragma unroll
    for (int q = 0; q < 4; ++q) { lm0[q] = p.shift_mu[1536 + lane * 4 + q]; lm1[q] = p.shift_mu[1792 + 1536 + lane * 4 + q]; }
    for (int t = gw; t < TE; t += nw) {
        const bool hp = (t != 0 && t != 256), hn_ = (t != 255 && t != TE - 1);
        const bf16_t* pr = p.proj + (size_t)t * INC;
        uint4 q0[3], qm[3], qn[3]; uint2 l0, lm = make_uint2(0, 0), ln = make_uint2(0, 0);
#pragma unroll
        for (int a = 0; a < 3; ++a) {
            q0[a] = *(const uint4*)(pr + a * 512 + lane * 8);
            qm[a] = hp ? *(const uint4*)(pr + a * 512 + lane * 8 - INC) : make_uint4(0, 0, 0, 0);
            qn[a] = hn_ ? *(const uint4*)(pr + a * 512 + lane * 8 + INC) : make_uint4(0, 0, 0, 0);
        }
        l0 = *(const uint2*)(pr + 1536 + lane * 4);
        if (hp) lm = *(const uint2*)(pr + 1536 + lane * 4 - INC);
        if (hn_) ln = *(const uint2*)(pr + 1536 + lane * 4 + INC);
        float val[3][8];
#pragma unroll
        for (int a = 0; a < 3; ++a) {
            float f0[8], fm[8], fn[8]; unpack8(q0[a], f0); unpack8(qm[a], fm); unpack8(qn[a], fn);
#pragma unroll
            for (int q = 0; q < 8; ++q) val[a][q] = f0[q] + mu0[a][q] * (fm[q] - f0[q]) + mu1[a][q] * (fn[q] - f0[q]);
        }
        float kkv[8], n2 = 0.f;
#pragma unroll
        for (int q = 0; q < 8; ++q) { kkv[q] = val[1][q] * kkw[q]; n2 += kkv[q] * kkv[q]; }
        n2 += __shfl_xor(n2, 1, 64); n2 += __shfl_xor(n2, 2, 64); n2 += __shfl_xor(n2, 4, 64);
        const float inv = -1.f / fmaxf(sqrtf(n2), 1e-12f);
#pragma unroll
        for (int q = 0; q < 8; ++q) kkv[q] *= inv;
        const size_t o = (size_t)t * 512 + lane * 8;
        *(uint4*)(p.Rr + o) = pack8(val[0]); *(uint4*)(p.Kk + o) = pack8(val[1]); *(uint4*)(p.Vv + o) = pack8(val[2]); *(uint4*)(p.Aa + o) = pack8(kkv);
        {
            float v[4];
            const unsigned w0[2] = {l0.x, l0.y}, wm[2] = {lm.x, lm.y}, wn[2] = {ln.x, ln.y};
#pragma unroll
            for (int q = 0; q < 4; ++q) {
                const float p0 = (q & 1) ? __uint_as_float(w0[q >> 1] & 0xffff0000u) : __uint_as_float(w0[q >> 1] << 16);
                const float pm = (q & 1) ? __uint_as_float(wm[q >> 1] & 0xffff0000u) : __uint_as_float(wm[q >> 1] << 16);
                const float pn = (q & 1) ? __uint_as_float(wn[q >> 1] & 0xffff0000u) : __uint_as_float(wn[q >> 1] << 16);
                v[q] = p0 + lm0[q] * (pm - p0) + lm1[q] * (pn - p0);
            }
            if (lane < 16) {
                uint2 ov; ov.x = pack2(tanhf(v[0]), tanhf(v[1])); ov.y = pack2(tanhf(v[2]), tanhf(v[3]));
                *(uint2*)(p.TW + (size_t)t * 64 + lane * 4) = ov;
            } else if (lane < 32) {
                uint2 ov; ov.x = pack2(v[0], v[1]); ov.y = pack2(v[2], v[3]);
                *(uint2*)(p.XA + (size_t)t * 64 + (lane - 16) * 4) = ov;
            } else {
                uint2 ov; ov.x = pack2(sigm(v[0]), sigm(v[1])); ov.y = pack2(sigm(v[2]), sigm(v[3]));
                *(uint2*)(p.SG + (size_t)t * 128 + (lane - 32) * 4) = ov;
            }
        }
    }
}

__device__ __forceinline__ void phase4(const Params& p, char* smem) {
    for (int u = blockIdx.x; u < 130 * 20; u += gridDim.x) {
        const int mt = u / 20, q = u % 20;
        if (q < 8) {
            APlain ap{p.TW + (size_t)mt * 128 * 64, 64}; BPlain bp{p.WupT + (size_t)q * 128 * 64, 64};
            gemm_tile<128, 128, 4, 2>(ap, bp, 64, smem, [&](const auto& acc, int r0, int c0) {
#pragma unroll
                for (int mi = 0; mi < 2; ++mi)
#pragma unroll
                    for (int ni = 0; ni < 4; ++ni) {
                        const int t = mt * 128 + r0 + mi * 16, cc = q * 128 + c0 + ni * 16, d = cc >> 9, c = cc & 511;
                        float4 o; float* op = (float*)&o;
#pragma unroll
                        for (int j = 0; j < 4; ++j) { const float z = p.rwkv_w0[d * 512 + c + j] + acc[mi][ni][j]; op[j] = __expf(-0.60653066f * sigm(z)); }
                        *(float4*)(p.Wd + ((size_t)d * TE + t) * 512 + c) = o;
                    }
            });
        } else if (q < 16) {
            const int qq = q - 8;
            APlain ap{p.XA + (size_t)mt * 128 * 64, 64}; BPlain bp{p.AupT + (size_t)qq * 128 * 64, 64};
            gemm_tile<128, 128, 4, 2>(ap, bp, 64, smem, [&](const auto& acc, int r0, int c0) {
#pragma unroll
                for (int mi = 0; mi < 2; ++mi)
#pragma unroll
                    for (int ni = 0; ni < 4; ++ni) {
                        const int t = mt * 128 + r0 + mi * 16, cc = qq * 128 + c0 + ni * 16, d = cc >> 9, c = cc & 511;
                        const uint2 av = *(const uint2*)(p.Aa + (size_t)t * 512 + c), kv = *(const uint2*)(p.Kk + (size_t)t * 512 + c);
                        const bf16_t* ae = (const bf16_t*)&av; const bf16_t* ke = (const bf16_t*)&kv;
                        float bo[4], ko[4];
#pragma unroll
                        for (int j = 0; j < 4; ++j) {
                            const float ad = sigm(p.rwkv_a0[d * 512 + c + j] + acc[mi][ni][j]);
                            bo[j] = -bf2f(ae[j]) * ad;
                            ko[j] = bf2f(ke[j]) * (1.f + (ad - 1.f) * p.rwkv_k_a[c + j]);
                        }
                        uint2 o1, o2; o1.x = pack2(bo[0], bo[1]); o1.y = pack2(bo[2], bo[3]); o2.x = pack2(ko[0], ko[1]); o2.y = pack2(ko[2], ko[3]);
                        *(uint2*)(p.Bd + ((size_t)d * TE + t) * 512 + c) = o1;
                        *(uint2*)(p.KD + ((size_t)d * TE + t) * 512 + c) = o2;
                    }
            });
        } else {
            const int qq = q - 16;
            APlain ap{p.SG + (size_t)mt * 128 * 128, 128}; BPlain bp{p.GupT + (size_t)qq * 128 * 128, 128};
            gemm_tile<128, 128, 4, 2>(ap, bp, 128, smem, [&](const auto& acc, int r0, int c0) {
#pragma unroll
                for (int mi = 0; mi < 2; ++mi)
#pragma unroll
                    for (int ni = 0; ni < 4; ++ni) {
                        const int t = mt * 128 + r0 + mi * 16, c = qq * 128 + c0 + ni * 16;
                        uint2 o; o.x = pack2(acc[mi][ni][0], acc[mi][ni][1]); o.y = pack2(acc[mi][ni][2], acc[mi][ni][3]);
                        *(uint2*)(p.G + (size_t)t * 512 + c) = o;
                    }
            });
        }
    }
}

__device__ __forceinline__ void phase5(const Params& p, char* smem) {
    const int tid = tidx(), wave = __builtin_amdgcn_readfirstlane(tid >> 6), lane = tid & 63;
    constexpr int SB = 5, NA = 6, NSB = RL / SB;
    float* L = (float*)(smem + wave * (2 * SB * NA * 64 * 4 + 16 * 72 * 2));
    bf16_t* CT = (bf16_t*)(L + 2 * SB * NA * 64);
    for (int q = blockIdx.x * 8 + wave; q < RNC * 16; q += gridDim.x * 8) {
        const int j = q >> 4, hd = q & 15, dir = hd >> 3, h = hd & 7;
        const float* gW = p.Wd + (size_t)dir * TE * 512; const bf16_t* gB = p.Bd + (size_t)dir * TE * 512; const bf16_t* gK = p.KD + (size_t)dir * TE * 512;
        const bf16_t* gA = p.Aa; const bf16_t* gV = p.Vv; const bf16_t* gR = p.Rr;
        const unsigned lofs = (unsigned)(h * 64 + lane);
        bf16_t* gZ = p.Zz + (size_t)q * (RL * 64) + lane; bf16_t* gY = p.YH + (size_t)q * (RL * 64) + lane;
        f32x2 sP[32], sH[32];
        int ln = lane; asm volatile("" : "+v"(ln));
#pragma unroll
        for (int k = 0; k < 32; ++k) { sP[k] = (f32x2){(2 * k == ln) ? 1.f : 0.f, (2 * k + 1 == ln) ? 1.f : 0.f}; sH[k] = (f32x2){0.f, 0.f}; }
        for (int sb = 0; sb < NSB; ++sb) {
            {
                float st[SB][NA];
#pragma unroll
                for (int i = 0; i < SB; ++i) {
                    const unsigned g = (unsigned)row_of(dir, j * RL + sb * SB + i) * 512u + lofs;
                    st[i][0] = gW[g]; st[i][1] = bf2f(gA[g]); st[i][2] = bf2f(gB[g]); st[i][3] = bf2f(gK[g]); st[i][4] = bf2f(gV[g]); st[i][5] = bf2f(gR[g]);
                }
                float* d = L + (sb & 1) * (SB * NA * 64) + lane;
#pragma unroll
                for (int i = 0; i < SB; ++i)
#pragma unroll
                    for (int a = 0; a < NA; ++a) d[(i * NA + a) * 64] = st[i][a];
            }
            const float* Lb = L + (sb & 1) * (SB * NA * 64);
            float4 cv[3][4]; const int ctau = q * 65 + sb * 3;
#pragma unroll
            for (int h = 0; h < 3; ++h) {
                int tt = ctau + h; if (sb * 3 + h >= 65 || tt >= 514 * 256) tt = 0;
                const int m = tt >> 8, kb = (tt >> 4) & 15, nb = tt & 15, e = m >> 1, sel = m & 1;
                const float* src = (sel ? (e < 256 ? p.exp_w_up + (size_t)e * 262144 : p.sh_w_up) : (e < 256 ? p.exp_w_gate + (size_t)e * 262144 : p.sh_w_gate)) + (size_t)(kb * 64 + lane) * 256 + nb * 16;
#pragma unroll
                for (int i = 0; i < 4; ++i) cv[h][i] = *(const float4*)(src + i * 4);
            }
#pragma unroll 1
            for (int i = 0; i < SB; ++i) {
                const float* W = Lb + (i * NA) * 64; const float* A = W + 64; const float* B = W + 128; const float* KDv = W + 192; const float* R = W + 320;
                const float vl = W[256 + lane];
                f32x2 dh0 = {0.f, 0.f}, dh1 = {0.f, 0.f}, dp0 = {0.f, 0.f}, dp1 = {0.f, 0.f};
                f32x4 rw[2], rb[2], rk[2], rr[2];
                rw[0] = *(const f32x4*)(W); rb[0] = *(const f32x4*)(B); rk[0] = *(const f32x4*)(KDv); rr[0] = *(const f32x4*)(R);
#pragma unroll
                for (int c = 0; c < 4; ++c) {
                    const f32x4 ac0 = *(const f32x4*)(A + c * 16), ac1 = *(const f32x4*)(A + c * 16 + 4), ac2 = *(const f32x4*)(A + c * 16 + 8), ac3 = *(const f32x4*)(A + c * 16 + 12);
                    const int k = c * 8;
                    dh0 += sH[k] * ac0.lo; dh1 += sH[k + 1] * ac0.hi; dp0 += sP[k] * ac0.lo; dp1 += sP[k + 1] * ac0.hi;
                    dh0 += sH[k + 2] * ac1.lo; dh1 += sH[k + 3] * ac1.hi; dp0 += sP[k + 2] * ac1.lo; dp1 += sP[k + 3] * ac1.hi;
                    dh0 += sH[k + 4] * ac2.lo; dh1 += sH[k + 5] * ac2.hi; dp0 += sP[k + 4] * ac2.lo; dp1 += sP[k + 5] * ac2.hi;
                    dh0 += sH[k + 6] * ac3.lo; dh1 += sH[k + 7] * ac3.hi; dp0 += sP[k + 6] * ac3.lo; dp1 += sP[k + 7] * ac3.hi;
                    __builtin_amdgcn_sched_barrier(0);
                }
                const float saHs = (dh0.x + dh0.y) + (dh1.x + dh1.y), saPs = (dp0.x + dp0.y) + (dp1.x + dp1.y);
                const f32x2 saH = {saHs, saHs}, saP = {saPs, saPs}, vl2 = {vl, vl};
                f32x2 y0 = {0.f, 0.f}, y1 = {0.f, 0.f}, z0 = {0.f, 0.f}, z1 = {0.f, 0.f};
#pragma unroll
                for (int g = 0; g < 16; ++g) {
                    if (g + 1 < 16) { rw[(g + 1) & 1] = *(const f32x4*)(W + 4 * g + 4); rb[(g + 1) & 1] = *(const f32x4*)(B + 4 * g + 4); rk[(g + 1) & 1] = *(const f32x4*)(KDv + 4 * g + 4); rr[(g + 1) & 1] = *(const f32x4*)(R + 4 * g + 4); }
                    const f32x4 cw = rw[g & 1], cb = rb[g & 1], ck = rk[g & 1], cr = rr[g & 1];
                    const int k = 2 * g;
                    sH[k]     = sH[k]     * cw.lo + (saH * cb.lo + vl2 * ck.lo);
                    sH[k + 1] = sH[k + 1] * cw.hi + (saH * cb.hi + vl2 * ck.hi);
                    sP[k]     = sP[k]     * cw.lo + saP * cb.lo;
                    sP[k + 1] = sP[k + 1] * cw.hi + saP * cb.hi;
                    y0 += sH[k] * cr.lo; y1 += sH[k + 1] * cr.hi;
                    z0 += sP[k] * cr.lo; z1 += sP[k + 1] * cr.hi;
                    __builtin_amdgcn_sched_barrier(0);
                }
                const int t = sb * SB + i;
                gZ[t * 64] = f2bf((z0.x + z0.y) + (z1.x + z1.y)); gY[t * 64] = f2bf((y0.x + y0.y) + (y1.x + y1.y));
            }
#pragma unroll
            for (int h = 0; h < 3; ++h) {
                const int tt = ctau + h;
                if (sb * 3 + h < 65 && tt < 514 * 256) {
                    const int m = tt >> 8, kb = (tt >> 4) & 15, nb = tt & 15, e = m >> 1, sel = m & 1;
#pragma unroll
                    for (int i = 0; i < 4; ++i) {
                        const unsigned p01 = pack2(cv[h][i].x, cv[h][i].y), p23 = pack2(cv[h][i].z, cv[h][i].w);
                        CT[(i * 4 + 0) * 72 + lane] = (bf16_t)(p01 & 0xffffu); CT[(i * 4 + 1) * 72 + lane] = (bf16_t)(p01 >> 16);
                        CT[(i * 4 + 2) * 72 + lane] = (bf16_t)(p23 & 0xffffu); CT[(i * 4 + 3) * 72 + lane] = (bf16_t)(p23 >> 16);
                    }
                    const int cq = lane >> 2, seg = lane & 3;
                    const uint4 o0 = *(const uint4*)(CT + cq * 72 + seg * 16), o1 = *(const uint4*)(CT + cq * 72 + seg * 16 + 8);
                    const int rho = (nb >> 3) * 256 + ((nb >> 2) & 1) * 128 + (nb & 3) * 32 + sel * 16 + cq;
                    bf16_t* d = p.BtW + ((size_t)e * 512 + rho) * 1024 + kb * 64 + seg * 16;
                    *(uint4*)d = o0; *(uint4*)(d + 8) = o1;
                }
            }
        }
        if (j < RNC - 1) {
            float* dP = p.PH + (((size_t)(j * 16 + hd) * 2 + 0) * 64 + lane) * 64;
            float* dH = p.PH + (((size_t)(j * 16 + hd) * 2 + 1) * 64 + lane) * 64;
#pragma unroll
            for (int k = 0; k < 32; k += 2) { *(float4*)(dP + 2 * k) = make_float4(sP[k].x, sP[k].y, sP[k + 1].x, sP[k + 1].y); *(float4*)(dH + 2 * k) = make_float4(sH[k].x, sH[k].y, sH[k + 1].x, sH[k + 1].y); }
        }
    }
}

__device__ __forceinline__ void phase6(const Params& p, char* smem) {
    const int tid = threadIdx.x, wave = __builtin_amdgcn_readfirstlane(tid >> 6), lane = tid & 63;
    if (blockIdx.x >= 256) return;
    const int hd = blockIdx.x >> 4, rb0 = (blockIdx.x & 15) * 4, r0 = rb0 + (wave & 3);
    LAS unsigned char* lds = (LAS unsigned char*)smem;
    constexpr int SLOT = 17408, NJ = RNC - 1;
    const char* pbase = (const char*)(p.PH + (size_t)hd * 2 * 4096);
    float s0 = 0.f;
#define CH_ISSUE(J) do { const char* src_ = pbase + (size_t)(J) * 524288; const unsigned so_ = (unsigned)(((J) & 7) * SLOT); \
        _Pragma("unroll") for (int q_ = 0; q_ < 4; ++q_) __builtin_amdgcn_global_load_lds((const unsigned*)(src_ + ((wave - 4) * 4 + q_) * 1024 + lane * 16), (LAS unsigned*)(lds + so_ + ((wave - 4) * 4 + q_) * 1024), 16, 0, 0); \
        if (wave == 7) __builtin_amdgcn_global_load_lds((const unsigned*)(src_ + 16384 + rb0 * 256 + lane * 16), (LAS unsigned*)(lds + so_ + 16384), 16, 0, 0); } while (0)
    if (wave >= 4) { CH_ISSUE(0); CH_ISSUE(1); CH_ISSUE(2); CH_ISSUE(3); CH_ISSUE(4); CH_ISSUE(5); CH_ISSUE(6); }
    for (int j = 0; j < RNC; ++j) {
        if (wave < 4) p.Sst[((size_t)(j * 16 + hd) * 64 + r0) * 64 + lane] = s0;
        if (j == NJ) break;
        if (wave >= 4) {
            if (j + 6 >= NJ) asm volatile("s_waitcnt vmcnt(0)" ::: "memory");
            else if (wave == 7) asm volatile("s_waitcnt vmcnt(30)" ::: "memory");
            else asm volatile("s_waitcnt vmcnt(24)" ::: "memory");
        }
        asm volatile("s_waitcnt lgkmcnt(0)" ::: "memory"); __builtin_amdgcn_s_barrier(); asm volatile("" ::: "memory");
        if (wave >= 4) { if (j + 7 < NJ) CH_ISSUE(j + 7); }
        else {
            const float* Pc = (const float*)(smem + (j & 7) * SLOT);
            f32x2 n0 = {Pc[4096 + wave * 64 + lane], 0.f}, n1 = {0.f, 0.f};
#pragma unroll
            for (int k = 0; k < 64; k += 4) {
                const f32x2 a0 = {__int_as_float(__builtin_amdgcn_readlane(__float_as_int(s0), k)), __int_as_float(__builtin_amdgcn_readlane(__float_as_int(s0), k + 1))};
                const f32x2 a1 = {__int_as_float(__builtin_amdgcn_readlane(__float_as_int(s0), k + 2)), __int_as_float(__builtin_amdgcn_readlane(__float_as_int(s0), k + 3))};
                const f32x2 p0 = {Pc[k * 64 + lane], Pc[(k + 1) * 64 + lane]}, p1 = {Pc[(k + 2) * 64 + lane], Pc[(k + 3) * 64 + lane]};
                n0 += a0 * p0; n1 += a1 * p1;
            }
            s0 = (n0.x + n0.y) + (n1.x + n1.y);
        }
    }
#undef CH_ISSUE
    __syncthreads();
}

__device__ __forceinline__ void phase7(const Params& p, char* smem) {
    const int tid = tidx(), wave = __builtin_amdgcn_readfirstlane(tid >> 6), lane = tid & 63;
    constexpr int SB = 10, NSB = RL / SB;
    float* L = (float*)smem + wave * (SB * 64);
    for (int q = 16 + blockIdx.x * 8 + wave; q < RNC * 16; q += gridDim.x * 8) {
        const int j = q >> 4, hd = q & 15, dir = hd >> 3, h = hd & 7;
        f32x2 s[32];
        {
            const float* src = p.Sst + ((size_t)(j * 16 + hd) * 64 + lane) * 64;
#pragma unroll
            for (int k = 0; k < 32; k += 2) { const f32x4 v = *(const f32x4*)(src + 2 * k); s[k] = v.lo; s[k + 1] = v.hi; }
        }
        const bf16_t* gZ = p.Zz + (size_t)q * (RL * 64) + lane; const bf16_t* gY = p.YH + (size_t)q * (RL * 64) + lane;
        bf16_t* gO = p.O + (size_t)dir * TX * 512 + h * 64 + lane;
        float zz[SB], yy[SB];
#pragma unroll
        for (int i = 0; i < SB; ++i) { zz[i] = bf2f(gZ[i * 64]); yy[i] = bf2f(gY[i * 64]); }
        for (int sb = 0; sb < NSB; ++sb) {
            float yc[SB];
#pragma unroll
            for (int i = 0; i < SB; ++i) { L[i * 64 + lane] = zz[i]; yc[i] = yy[i]; }
            { const int nsb = sb + 1 < NSB ? sb + 1 : sb;
#pragma unroll
              for (int i = 0; i < SB; ++i) { zz[i] = bf2f(gZ[(nsb * SB + i) * 64]); yy[i] = bf2f(gY[(nsb * SB + i) * 64]); } }
#pragma unroll
            for (int i = 0; i < SB; ++i) {
                const float* Z = L + i * 64;
                f32x2 y0 = {yc[i], 0.f}, y1 = {0.f, 0.f};
#pragma unroll
                for (int k = 0; k < 32; k += 2) { const f32x4 z = *(const f32x4*)(Z + 2 * k); y0 += s[k] * z.lo; y1 += s[k + 1] * z.hi; }
                const int row = row_of(dir, j * RL + sb * SB + i);
                if (row >= 256) gO[(size_t)(row - 256) * 512] = f2bf((y0.x + y0.y) + (y1.x + y1.y));
            }
        }
    }
}

__device__ __forceinline__ void phase8(const Params& p, char* smem) {
    const int tid = tidx();
    bf16_t* LT = (bf16_t*)smem;
    constexpr int LTS = 136;
    for (int u = blockIdx.x; u < NCH * 4; u += gridDim.x) {
        const int upart = 2;
        const int c = u >> 2, hh = u & 3;
        const float g0 = sigm(p.ret_decay_logit[hh]), g1 = sigm(p.ret_decay_logit[4 + hh]);
        const float l0 = log2f(g0), l1 = log2f(g1);
        const int n = tid >> 2, part = tid & 3, half = part >> 1, fb = (part & 1) * 16;
        const int t = c * 128 + n;
        const bool lat = c >= 2;
        float pos = 0.f;
        if (lat) { const int tl = t - 256; pos = (float)(half == 0 ? (tl >> 6) : (tl & 63)); }
        const bf16_t* pr = p.proj + (size_t)t * INC;
        float cs[16], sn[16];
#pragma unroll
        for (int f = 0; f < 16; ++f) {
            if (lat) { const float inv = exp2f(-(float)(fb + f) * (13.287712379549449f / 32.f)); sincosf(pos * inv, &sn[f], &cs[f]); }
            else { cs[f] = 1.f; sn[f] = 0.f; }
        }
        const size_t ch = (size_t)(c * 4 + hh);
        if (upart != 1) {
            const int cb = 1792 + hh * 128 + half * 64 + fb;
            uint4 v1a = *(const uint4*)(pr + cb), v1b = *(const uint4*)(pr + cb + 8), v2a = *(const uint4*)(pr + cb + 32), v2b = *(const uint4*)(pr + cb + 40);
            bf16_t x1[16], x2[16];
            *(uint4*)&x1[0] = v1a; *(uint4*)&x1[8] = v1b; *(uint4*)&x2[0] = v2a; *(uint4*)&x2[8] = v2b;
            float o1[16], o2[16];
#pragma unroll
            for (int f = 0; f < 16; ++f) { const float a = bf2f(x1[f]), b = bf2f(x2[f]); o1[f] = a * cs[f] - b * sn[f]; o2[f] = a * sn[f] + b * cs[f]; }
            const float xf = exp2f(l0 * (float)(n + 1)), xb = exp2f(l1 * (float)(128 - n));
            bf16_t* qd = p.Qr + (ch * 128 + n) * 128 + half * 64 + fb;
            bf16_t* ad = p.A3 + (ch * 128 + n) * 384 + 128 + half * 64 + fb;
#pragma unroll
            for (int f = 0; f < 16; f += 2) {
                *(unsigned*)(qd + f) = pack2(o1[f], o1[f + 1]); *(unsigned*)(qd + 32 + f) = pack2(o2[f], o2[f + 1]);
                *(unsigned*)(ad + f) = pack2(o1[f] * xf, o1[f + 1] * xf); *(unsigned*)(ad + 32 + f) = pack2(o2[f] * xf, o2[f + 1] * xf);
                *(unsigned*)(ad + 128 + f) = pack2(o1[f] * xb, o1[f + 1] * xb); *(unsigned*)(ad + 128 + 32 + f) = pack2(o2[f] * xb, o2[f + 1] * xb);
            }
        }
        if (upart != 1) {
            const int cb = 2304 + hh * 128 + half * 64 + fb;
            uint4 v1a = *(const uint4*)(pr + cb), v1b = *(const uint4*)(pr + cb + 8), v2a = *(const uint4*)(pr + cb + 32), v2b = *(const uint4*)(pr + cb + 40);
            bf16_t x1[16], x2[16];
            *(uint4*)&x1[0] = v1a; *(uint4*)&x1[8] = v1b; *(uint4*)&x2[0] = v2a; *(uint4*)&x2[8] = v2b;
            const float sc = 0.08838834764831845f;
            bf16_t* kd = p.Kr + (ch * 128 + n) * 128 + half * 64 + fb;
            __syncthreads();
#pragma unroll
            for (int f = 0; f < 16; ++f) {
                const float a = bf2f(x1[f]) * sc, b = bf2f(x2[f]) * sc;
                const float o1 = a * cs[f] - b * sn[f], o2 = a * sn[f] + b * cs[f];
                const bf16_t h1 = f2bf(o1), h2 = f2bf(o2);
                kd[f] = h1; kd[32 + f] = h2;
                LT[(half * 64 + fb + f) * LTS + n] = h1; LT[(half * 64 + fb + f + 32) * LTS + n] = h2;
            }
            __syncthreads();
            const int d = tid >> 2, ms = (tid & 3) * 32;
#pragma unroll
            for (int dir = 0; dir < 2; ++dir) {
                bf16_t* od = p.KTz + ((ch * 2 + dir) * 128 + d) * 128 + ms;
#pragma unroll
                for (int m = 0; m < 32; m += 2) {
                    const int mm = ms + m;
                    const float z0 = dir == 0 ? exp2f(l0 * (float)(127 - mm)) : exp2f(l1 * (float)mm);
                    const float z1 = dir == 0 ? exp2f(l0 * (float)(126 - mm)) : exp2f(l1 * (float)(mm + 1));
                    *(unsigned*)(od + m) = pack2(bf2f(LT[d * LTS + mm]) * z0, bf2f(LT[d * LTS + mm + 1]) * z1);
                }
            }
        }
#pragma unroll 1
        for (int eh = (upart != 0 ? 0 : 2); eh < 2; ++eh) {
            __syncthreads();
            const int cb = 2816 + hh * 256 + eh * 128 + part * 32;
            bf16_t xv[32];
#pragma unroll
            for (int q = 0; q < 4; ++q) *(uint4*)&xv[q * 8] = *(const uint4*)(pr + cb + q * 8);
#pragma unroll
            for (int f = 0; f < 32; ++f) LT[(part * 32 + f) * LTS + n] = xv[f];
            __syncthreads();
            const int e = tid >> 2, ms = (tid & 3) * 32;
            bf16_t* od = p.B3 + (ch * 256 + eh * 128 + e) * 384 + ms;
#pragma unroll
            for (int m = 0; m < 32; m += 8) *(uint4*)(od + m) = *(const uint4*)(LT + e * LTS + ms + m);
        }
        __syncthreads();
    }
}

__device__ __forceinline__ void phase9(const Params& p, char* smem) {
    for (int u = blockIdx.x; u < 512 + 2080; u += gridDim.x) {
        if (u < 512) {
            const int c = 2 + (u >> 2), hh = u & 3;
            const size_t ch = (size_t)(c * 4 + hh);
            const float l0 = log2f(sigm(p.ret_decay_logit[hh])), l1 = log2f(sigm(p.ret_decay_logit[4 + hh]));
            APlain ap{p.Qr + ch * 128 * 128, 128}; BPlain bp{p.Kr + ch * 128 * 128, 128};
            bf16_t* outp = p.A3 + ch * 128 * 384;
            gemm_tile<128, 128, 4, 2>(ap, bp, 128, smem, [&](const auto& acc, int r0, int c0) {
#pragma unroll
                for (int mi = 0; mi < 2; ++mi)
#pragma unroll
                    for (int ni = 0; ni < 4; ++ni) {
                        const int n = r0 + mi * 16, m0 = c0 + ni * 16;
                        float o[4];
#pragma unroll
                        for (int j = 0; j < 4; ++j) {
                            const int m = m0 + j;
                            float w = 0.f;
                            if (n >= m) w += exp2f(l0 * (float)(n - m));
                            if (m >= n) w += exp2f(l1 * (float)(m - n));
                            o[j] = acc[mi][ni][j] * w;
                        }
                        uint2 ov; ov.x = pack2(o[0], o[1]); ov.y = pack2(o[2], o[3]);
                        *(uint2*)(outp + (size_t)n * 384 + m0) = ov;
                    }
            });
        } else {
            const int v = u - 512, mt = v & 1, dir = (v >> 1) & 1, chh = v >> 2;
            APlain ap{p.B3 + ((size_t)chh * 256 + mt * 128) * 384, 384}; BPlain bp{p.KTz + ((size_t)chh * 2 + dir) * 128 * 128, 128};
            bf16_t* outp = p.KVT + (((size_t)chh * 2 + dir) * 256 + mt * 128) * 128;
            gemm_tile<128, 128, 4, 2>(ap, bp, 128, smem, [&](const auto& acc, int r0, int c0) {
#pragma unroll
                for (int mi = 0; mi < 2; ++mi)
#pragma unroll
                    for (int ni = 0; ni < 4; ++ni) { uint2 o; o.x = pack2(acc[mi][ni][0], acc[mi][ni][1]); o.y = pack2(acc[mi][ni][2], acc[mi][ni][3]);
                        *(uint2*)(outp + (size_t)(r0 + mi * 16) * 128 + c0 + ni * 16) = o; }
            });
        }
    }
}

__device__ __forceinline__ void phase10(const Params& p, char* smem) {
    for (int idx = blockIdx.x * NT + tidx(); idx < 131072; idx += gridDim.x * NT) {
        const int hh = idx >> 15, dir = (idx >> 14) & 1, e = (idx >> 6) & 255, d = (idx & 63) * 2;
        const float g = sigm(p.ret_decay_logit[dir * 4 + hh]);
        const float g128 = exp2f(128.f * log2f(g));
        float R0 = 0.f, R1 = 0.f;
        const bf16_t* kvb = p.KVT + ((size_t)(hh * 2 + dir) * 256 + e) * 128 + d;
        bf16_t* rtb = p.B3 + ((size_t)hh * 256 + e) * 384 + 128 + dir * 128 + d;
        for (int s0 = 0; s0 < NCH; s0 += 13) {
            unsigned kv[13];
#pragma unroll
            for (int i = 0; i < 13; ++i) { const int sc = s0 + i, c = dir == 0 ? sc : (sc < 2 ? 1 - sc : 131 - sc); kv[i] = *(const unsigned*)(kvb + (size_t)c * 262144); }
#pragma unroll
            for (int i = 0; i < 13; ++i) {
                const int sc = s0 + i, c = dir == 0 ? sc : (sc < 2 ? 1 - sc : 131 - sc);
                if (c >= 2) *(unsigned*)(rtb + (size_t)c * 393216) = pack2(R0, R1);
                R0 = g128 * R0 + __uint_as_float(kv[i] << 16); R1 = g128 * R1 + __uint_as_float(kv[i] & 0xffff0000u);
            }
        }
    }
}

__device__ __forceinline__ void phase11(const Params& p, char* smem) {
    for (int u = blockIdx.x; u < 1024; u += gridDim.x) {
        const int nt = u & 1, chh = 8 + (u >> 1), c = chh >> 2, hh = chh & 3;
        APlain ap{p.A3 + (size_t)chh * 128 * 384, 384}; BPlain bp{p.B3 + ((size_t)chh * 256 + nt * 128) * 384, 384};
        float* outp = p.Y + (size_t)((c - 2) * 128) * 1024 + hh * 256 + nt * 128;
        gemm_tile<128, 128, 4, 2>(ap, bp, 384, smem, [&](const auto& acc, int r0, int c0) {
#pragma unroll
            for (int mi = 0; mi < 2; ++mi)
#pragma unroll
                for (int ni = 0; ni < 4; ++ni) *(f32x4*)(outp + (size_t)(r0 + mi * 16) * 1024 + c0 + ni * 16) = acc[mi][ni];
        });
    }
}

__device__ __forceinline__ void phase12(const Params& p, char* smem) {
    const int tid = tidx(), wave = tid >> 6, lane = tid & 63;
    const int gw = blockIdx.x * 8 + wave, nw = gridDim.x * 8;
    float lw[8], lb[8], rk[8];
#pragma unroll
    for (int q = 0; q < 8; ++q) { lw[q] = p.rwkv_ln_w[lane * 8 + q]; lb[q] = p.rwkv_ln_b[lane * 8 + q]; rk[q] = p.rwkv_r_k[lane * 8 + q]; }
    for (int t = gw; t < TX; t += nw) {
        const size_t te = (size_t)(t + 256) * 512 + lane * 8;
        const uint4 uof = *(const uint4*)(p.O + (size_t)t * 512 + lane * 8), uob = *(const uint4*)(p.O + ((size_t)TX + t) * 512 + lane * 8);
        const uint4 ur = *(const uint4*)(p.Rr + te), uk0 = *(const uint4*)(p.KD + te), uk1 = *(const uint4*)(p.KD + (size_t)TE * 512 + te), uv = *(const uint4*)(p.Vv + te), ug = *(const uint4*)(p.G + te);
        const float* yp = p.Y + (size_t)t * 1024 + lane * 16;
        const float4 y0 = *(const float4*)(yp), y1 = *(const float4*)(yp + 4), y2 = *(const float4*)(yp + 8), y3 = *(const float4*)(yp + 12);
        const bf16_t* gbp = p.proj + (size_t)(t + 256) * INC + 3840 + lane * 16;
        const uint4 ugb0 = *(const uint4*)(gbp), ugb1 = *(const uint4*)(gbp + 8);
        {
            float of[8], ob[8], r[8], k0[8], k1[8], v[8], gg[8], o[8];
            unpack8(uof, of); unpack8(uob, ob); unpack8(ur, r); unpack8(uk0, k0); unpack8(uk1, k1); unpack8(uv, v); unpack8(ug, gg);
            float sm = 0.f, bs = 0.f;
#pragma unroll
            for (int q = 0; q < 8; ++q) { o[q] = of[q] + ob[q]; sm += o[q]; bs += r[q] * (k0[q] + k1[q]) * rk[q]; }
            sm += __shfl_xor(sm, 1, 64); sm += __shfl_xor(sm, 2, 64); sm += __shfl_xor(sm, 4, 64);
            bs += __shfl_xor(bs, 1, 64); bs += __shfl_xor(bs, 2, 64); bs += __shfl_xor(bs, 4, 64);
            const float mu = sm * (1.f / 64.f);
            float vs = 0.f;
#pragma unroll
            for (int q = 0; q < 8; ++q) { o[q] -= mu; vs += o[q] * o[q]; }
            vs += __shfl_xor(vs, 1, 64); vs += __shfl_xor(vs, 2, 64); vs += __shfl_xor(vs, 4, 64);
            const float rs = rsqrtf(vs * (1.f / 64.f) + 64e-5f);
            float ya[8];
#pragma unroll
            for (int q = 0; q < 8; ++q) ya[q] = (o[q] * rs * lw[q] + lb[q] + bs * v[q]) * gg[q];
            *(uint4*)(p.ya_in + (size_t)t * 512 + lane * 8) = pack8(ya);
        }
        {
            float y[16] = {y0.x, y0.y, y0.z, y0.w, y1.x, y1.y, y1.z, y1.w, y2.x, y2.y, y2.z, y2.w, y3.x, y3.y, y3.z, y3.w};
            float sm = 0.f;
#pragma unroll
            for (int q = 0; q < 16; ++q) sm += y[q];
            sm += __shfl_xor(sm, 1, 64); sm += __shfl_xor(sm, 2, 64); sm += __shfl_xor(sm, 4, 64); sm += __shfl_xor(sm, 8, 64);
            const float mu = sm * (1.f / 256.f);
            float vs = 0.f;
#pragma unroll
            for (int q = 0; q < 16; ++q) { y[q] -= mu; vs += y[q] * y[q]; }
            vs += __shfl_xor(vs, 1, 64); vs += __shfl_xor(vs, 2, 64); vs += __shfl_xor(vs, 4, 64); vs += __shfl_xor(vs, 8, 64);
            const float rs = rsqrtf(vs * (1.f / 256.f) + 1e-5f);
            float gb[16]; { float t0[8], t1[8]; unpack8(ugb0, t0); unpack8(ugb1, t1);
#pragma unroll
                for (int q = 0; q < 8; ++q) { gb[q] = t0[q]; gb[8 + q] = t1[q]; } }
            float o0[8], o1[8];
#pragma unroll
            for (int q = 0; q < 16; ++q) {
                const int c = lane * 16 + q;
                const float ov = (y[q] * rs * p.ret_ln_w[c] + p.ret_ln_b[c]) * (gb[q] * sigm(gb[q]));
                if (q < 8) o0[q] = ov; else o1[q - 8] = ov;
            }
            bf16_t* d = p.yb_in + (size_t)t * 1024 + lane * 16;
            *(uint4*)d = pack8(o0); *(uint4*)(d + 8) = pack8(o1);
        }
    }
}

__device__ __forceinline__ void phase13(const Params& p, char* smem) {
    for (int u = blockIdx.x; u < 512; u += gridDim.x) {
        const int mt = u >> 2, nt = u & 3;
        f32x4 acca[4][4], accb[4][4];
#pragma unroll
        for (int mi = 0; mi < 4; ++mi)
#pragma unroll
            for (int ni = 0; ni < 4; ++ni) { acca[mi][ni] = (f32x4){0.f, 0.f, 0.f, 0.f}; accb[mi][ni] = (f32x4){0.f, 0.f, 0.f, 0.f}; }
        { APlain ap{p.ya_in + (size_t)mt * 128 * 512, 512}; BPlain bp{p.WaT + (size_t)nt * 256 * 512, 512};
          gemm_core<128, 256, 2, 4>(acca, ap, bp, 512, smem); }
        { APlain ap{p.yb_in + (size_t)mt * 128 * 1024, 1024}; BPlain bp{p.WbT + (size_t)nt * 256 * 1024, 1024};
          gemm_core<128, 256, 2, 4>(accb, ap, bp, 1024, smem); }
        const int wave = tidx() >> 6, lane = tidx() & 63;
        const int r0 = (wave >> 2) * 64 + (lane & 15), c0 = (wave & 3) * 64 + (lane >> 4) * 4;
#pragma unroll
        for (int mi = 0; mi < 4; ++mi)
#pragma unroll
            for (int ni = 0; ni < 4; ++ni) {
                const int t = mt * 128 + r0 + mi * 16, c = nt * 256 + c0 + ni * 16;
                const bf16_t* gp = p.proj + (size_t)(t + 256) * INC + c;
                const uint2 ga = *(const uint2*)(gp + 4864), gb = *(const uint2*)(gp + 5888);
                float o[4];
                o[0] = sigm(__uint_as_float(ga.x << 16)) * acca[mi][ni][0] + sigm(__uint_as_float(gb.x << 16)) * accb[mi][ni][0];
                o[1] = sigm(__uint_as_float(ga.x & 0xffff0000u)) * acca[mi][ni][1] + sigm(__uint_as_float(gb.x & 0xffff0000u)) * accb[mi][ni][1];
                o[2] = sigm(__uint_as_float(ga.y << 16)) * acca[mi][ni][2] + sigm(__uint_as_float(gb.y << 16)) * accb[mi][ni][2];
                o[3] = sigm(__uint_as_float(ga.y & 0xffff0000u)) * acca[mi][ni][3] + sigm(__uint_as_float(gb.y & 0xffff0000u)) * accb[mi][ni][3];
                uint2 ov; ov.x = pack2(o[0], o[1]); ov.y = pack2(o[2], o[3]);
                *(uint2*)(p.merged + (size_t)t * 1024 + c) = ov;
            }
    }
}
__device__ __forceinline__ void phase14(const Params& p, char* smem) {
    g8::StaticOrder S; S.init(TX, 1024, gridDim.x, blockIdx.x);
    g8::EpiF32 E{p.mix, 1024};
    g8::gemm_phase((LAS unsigned char*)smem, p.merged, p.WoT, 1024, 1024, 1024, S, E);
}

__device__ __forceinline__ void phase15(const Params& p, char* smem) {
    const int tid = tidx(), wave = tid >> 6, lane = tid & 63;
    const int gw = blockIdx.x * 8 + wave, nw = gridDim.x * 8;
    const float* g1 = p.mod + 2048; const float* sh2 = p.mod + 3072; const float* sc2 = p.mod + 4096;
    for (int t = gw; t < TX; t += nw) {
        float4 mv[4], xm[4]; float ss = 0.f;
#pragma unroll
        for (int i = 0; i < 4; ++i) { mv[i] = *(const float4*)(p.mix + (size_t)t * 1024 + i * 256 + lane * 4); ss += mv[i].x * mv[i].x + mv[i].y * mv[i].y + mv[i].z * mv[i].z + mv[i].w * mv[i].w; }
        ss = wsum(ss);
        const float rs = rsqrtf(ss * (1.f / 1024.f) + 1e-6f);
        float s2 = 0.f;
#pragma unroll
        for (int i = 0; i < 4; ++i) {
            const int col = i * 256 + lane * 4;
            const float4 xv = *(const float4*)(p.x + (size_t)t * 1024 + col);
            const float4 gn = *(const float4*)(p.n_post_mix + col), gg = *(const float4*)(g1 + col);
            xm[i].x = xv.x + gg.x * (mv[i].x * rs * gn.x); xm[i].y = xv.y + gg.y * (mv[i].y * rs * gn.y);
            xm[i].z = xv.z + gg.z * (mv[i].z * rs * gn.z); xm[i].w = xv.w + gg.w * (mv[i].w * rs * gn.w);
            *(float4*)(p.x_mid + (size_t)t * 1024 + col) = xm[i];
            s2 += xm[i].x * xm[i].x + xm[i].y * xm[i].y + xm[i].z * xm[i].z + xm[i].w * xm[i].w;
        }
        s2 = wsum(s2);
        const float rs2 = rsqrtf(s2 * (1.f / 1024.f) + 1e-6f);
#pragma unroll
        for (int i = 0; i < 4; ++i) {
            const int col = i * 256 + lane * 4;
            const float4 gn = *(const float4*)(p.n_pre_ffn + col), sc = *(const float4*)(sc2 + col), sh = *(const float4*)(sh2 + col);
            float h[4];
            h[0] = xm[i].x * rs2 * gn.x * (1.f + sc.x) + sh.x; h[1] = xm[i].y * rs2 * gn.y * (1.f + sc.y) + sh.y;
            h[2] = xm[i].z * rs2 * gn.z * (1.f + sc.z) + sh.z; h[3] = xm[i].w * rs2 * gn.w * (1.f + sc.w) + sh.w;
            uint2 hi; hi.x = pack2(h[0], h[1]); hi.y = pack2(h[2], h[3]);
            *(uint2*)(p.Ahl + (size_t)t * 1024 + col) = hi;
        }
    }
}

__device__ __forceinline__ void phase16(const Params& p, char* smem) {
    for (int u = blockIdx.x; u < 256; u += gridDim.x) {
        const int mt = u >> 1, nt = u & 1;
        APlain ap{p.Ahl + (size_t)mt * 128 * 1024, 1024}; BPlain bp{p.RtT + (size_t)nt * 128 * 1024, 1024};
        float* outp = p.logits + (size_t)mt * 128 * 256 + nt * 128;
        gemm_tile<128, 128, 4, 2>(ap, bp, 1024, smem, [&](const auto& acc, int r0, int c0) {
#pragma unroll
            for (int mi = 0; mi < 2; ++mi)
#pragma unroll
                for (int ni = 0; ni < 4; ++ni) *(f32x4*)(outp + (size_t)(r0 + mi * 16) * 256 + c0 + ni * 16) = acc[mi][ni];
        });
    }
}

__device__ __forceinline__ void phase17(const Params& p, char* smem) {
    const int tid = tidx(), wave = tid >> 6, lane = tid & 63;
    int* hist = (int*)smem;
    if (tid < 256) hist[tid] = 0;
    __syncthreads();
    const int TPB = TX / gridDim.x;
    constexpr int NTK = 4;
    for (int ti = wave * NTK; ti < TPB; ti += 8 * NTK) {
        const int t0 = blockIdx.x * TPB + ti;
        float sc[NTK][4], key[NTK][4], mys[NTK], ssum[NTK]; int mye[NTK];
#pragma unroll
        for (int n = 0; n < NTK; ++n) {
            mys[n] = 0.f; ssum[n] = 0.f; mye[n] = 0;
#pragma unroll
            for (int i = 0; i < 4; ++i) { const int e = lane + 64 * i; sc[n][i] = sigm(p.logits[(size_t)(t0 + n) * 256 + e]); key[n][i] = sc[n][i] + p.router_bias[e]; }
        }
#pragma unroll 1
        for (int k = 0; k < 8; ++k) {
            float bv[NTK]; int be[NTK];
#pragma unroll
            for (int n = 0; n < NTK; ++n) { bv[n] = -1e30f; be[n] = 1 << 20;
#pragma unroll
                for (int i = 0; i < 4; ++i) if (key[n][i] > bv[n]) { bv[n] = key[n][i]; be[n] = lane + 64 * i; } }
#pragma unroll
            for (int o = 32; o; o >>= 1) {
#pragma unroll
                for (int n = 0; n < NTK; ++n) {
                    const float ov = __shfl_xor(bv[n], o, 64); const int oe = __shfl_xor(be[n], o, 64);
                    if (ov > bv[n] || (ov == bv[n] && oe < be[n])) { bv[n] = ov; be[n] = oe; }
                }
            }
#pragma unroll
            for (int n = 0; n < NTK; ++n) {
                float sv = 0.f;
                if ((be[n] & 63) == lane) {
#pragma unroll
                    for (int i = 0; i < 4; ++i) if ((be[n] >> 6) == i) { sv = sc[n][i]; key[n][i] = -1e30f; }
                }
                sv = __shfl(sv, be[n] & 63, 64);
                ssum[n] += sv;
                if (lane == k) { mys[n] = sv; mye[n] = be[n]; }
            }
        }
        if (lane < 8) {
#pragma unroll
            for (int n = 0; n < NTK; ++n) {
                const int t = t0 + n;
                const int pos = atomicAdd(&hist[mye[n]], 1);
                p.tok_e[t * 8 + lane] = mye[n]; p.tok_pos[t * 8 + lane] = pos; p.tok_w[t * 8 + lane] = mys[n] / ssum[n] * 2.5f;
            }
        }
    }
    __syncthreads();
    if (tid < 256) p.bh[blockIdx.x * 256 + tid] = hist[tid];
}

__device__ __forceinline__ void phase18(const Params& p, char* smem) {
    const int tid = tidx();
    int* ps = (int*)smem;
    int* xs = ps + 260;
    int* cntL = xs + 260;
    int* baseL = cntL + 256;
    int* part = baseL + 256;
    {
        const int e = tid & 255, half = tid >> 8, G = gridDim.x, b0 = half * (G >> 1), b1 = b0 + (G >> 1);
        int tot = 0, bef = 0;
        for (int bb = b0; bb < b1; bb += 16) {
            int v[16];
#pragma unroll
            for (int i = 0; i < 16; ++i) v[i] = p.bh[(bb + i) * 256 + e];
#pragma unroll
            for (int i = 0; i < 16; ++i) { tot += v[i]; bef += (bb + i < (int)blockIdx.x) ? v[i] : 0; }
        }
        part[half * 256 + e] = tot; part[512 + half * 256 + e] = bef;
    }
    __syncthreads();
    if (tid < 256) { cntL[tid] = part[tid] + part[256 + tid]; baseL[tid] = part[512 + tid] + part[768 + tid]; }
    __syncthreads();
    if (tid < 64) {
        int c[4], tot = 0, ttot = 0;
#pragma unroll
        for (int q = 0; q < 4; ++q) { c[q] = cntL[tid * 4 + q]; tot += c[q]; ttot += (c[q] + 255) >> 8; }
        int incl = tot, tincl = ttot;
#pragma unroll
        for (int o = 1; o < 64; o <<= 1) { const int v = __shfl_up(incl, o, 64), tv = __shfl_up(tincl, o, 64); if (tid >= o) { incl += v; tincl += tv; } }
        int ex = incl - tot, tex = tincl - ttot;
#pragma unroll
        for (int q = 0; q < 4; ++q) { ps[tid * 4 + q] = ex; xs[tid * 4 + q] = tex; ex += c[q]; tex += (c[q] + 255) >> 8; }
        if (tid == 63) { ps[256] = incl; xs[256] = tincl; }
    }
    __syncthreads();
    if (blockIdx.x == 0) {
        const int nx = xs[256];
        if (tid == 0) *p.ntiles = nx + 64;
        for (int e = tid; e < 256; e += NT) {
            const int c = ps[e + 1] - ps[e];
            for (int t = 0; t < ((c + 255) >> 8); ++t) { int* x = p.xt + (xs[e] + t) * 4; x[0] = e; x[1] = ps[e] + 256 * t; x[2] = min(256, c - 256 * t); x[3] = 0; }
        }
        if (tid < 64) { int* x = p.xt + (nx + tid) * 4; x[0] = 256; x[1] = 131072 + 256 * tid; x[2] = 256; x[3] = 0; }
        if (tid < 256) p.slot_tk[NSLOT + tid] = 0;
    }
    const int TPB = TX / gridDim.x;
    for (int li = tid; li < TPB * 8; li += NT) {
        const int i = blockIdx.x * TPB * 8 + li, e = p.tok_e[i];
        p.slot_tk[ps[e] + baseL[e] + p.tok_pos[i]] = (i >> 3) * 9 + (i & 7);
    }
    for (int t = blockIdx.x * NT + tid; t < TX; t += gridDim.x * NT) p.slot_tk[131072 + t] = t * 9 + 8;
}

__device__ __forceinline__ void phase19(const Params& p, char* smem) {
    const int nun = *p.ntiles * 2;
    const int lb = (blockIdx.x & 7) * (gridDim.x >> 3) + (blockIdx.x >> 3);
    g8::EpiGU E{p.act};
    g8::gemm_phase_xg((LAS unsigned char*)smem, p.Ahl, p.slot_tk, p.xt, p.BtW, nun, lb, (int)gridDim.x, E);
}

__device__ __forceinline__ void phase20(const Params& p, char* smem) {
    const int nun = *p.ntiles * 4;
    const int lb = (blockIdx.x & 7) * (gridDim.x >> 3) + (blockIdx.x >> 3);
    for (int u = lb; u < nun; u += gridDim.x) {
        const int* x = p.xt + (u >> 2) * 4; const int nt = u & 3;
        const int e = x[0], row0 = x[1], nrows = x[2];
        APlain ap{p.act + (size_t)row0 * 256, 256};
        BKN bp{(e < 256 ? p.exp_w_down + (size_t)e * 262144 : p.sh_w_down) + nt * 256, 1024};
        const int* stk = p.slot_tk + row0;
        gemm_tile<256, 256, 2, 4>(ap, bp, 256, smem, [&](const auto& acc, int r0, int c0) {
#pragma unroll
            for (int mi = 0; mi < 8; ++mi) {
                const int r = r0 + mi * 16;
                if (r < nrows) {
                    bf16_t* d = p.yk + (size_t)stk[r] * 1024 + nt * 256 + c0;
#pragma unroll
                    for (int ni = 0; ni < 4; ++ni) {
                        uint2 ov; ov.x = pack2(acc[mi][ni][0], acc[mi][ni][1]); ov.y = pack2(acc[mi][ni][2], acc[mi][ni][3]);
                        *(uint2*)(d + ni * 16) = ov;
                    }
                }
            }
        });
    }
}

__device__ __forceinline__ void phase21(const Params& p, char* smem) {
    const int tid = tidx(), wave = tid >> 6, lane = tid & 63;
    const int gw = blockIdx.x * 8 + wave, nw = gridDim.x * 8;
    const float* g2 = p.mod + 5120;
    for (int t = gw; t < TX; t += nw) {
        float w[9];
#pragma unroll
        for (int k = 0; k < 8; ++k) w[k] = p.tok_w[t * 8 + k];
        w[8] = 1.f;
        float4 mo[4]; float ss = 0.f;
#pragma unroll
        for (int i = 0; i < 4; ++i) {
            const int col = i * 256 + lane * 4;
            float a0 = 0.f, a1 = 0.f, a2 = 0.f, a3 = 0.f;
#pragma unroll
            for (int k = 0; k < 9; ++k) {
                const uint2 v = *(const uint2*)(p.yk + ((size_t)t * 9 + k) * 1024 + col);
                a0 += w[k] * __uint_as_float(v.x << 16); a1 += w[k] * __uint_as_float(v.x & 0xffff0000u); a2 += w[k] * __uint_as_float(v.y << 16); a3 += w[k] * __uint_as_float(v.y & 0xffff0000u);
            }
            mo[i] = make_float4(a0, a1, a2, a3);
            ss += a0 * a0 + a1 * a1 + a2 * a2 + a3 * a3;
        }
        ss = wsum(ss);
        const float rs = rsqrtf(ss * (1.f / 1024.f) + 1e-6f);
#pragma unroll
        for (int i = 0; i < 4; ++i) {
            const int col = i * 256 + lane * 4;
            const float4 xm = *(const float4*)(p.x_mid + (size_t)t * 1024 + col);
            const float4 gn = *(const float4*)(p.n_post_ffn + col), gg = *(const float4*)(g2 + col);
            float4 o;
            o.x = xm.x + gg.x * (mo[i].x * rs * gn.x); o.y = xm.y + gg.y * (mo[i].y * rs * gn.y);
            o.z = xm.z + gg.z * (mo[i].z * rs * gn.z); o.w = xm.w + gg.w * (mo[i].w * rs * gn.w);
            *(float4*)(p.out + (size_t)t * 1024 + col) = o;
        }
    }
}

constexpr int NPHASE = 22;
template <int PH> __device__ __forceinline__ void run_phase(const Params& p, char* smem) {
    if constexpr (PH == 0) phase0(p, smem);
    else if constexpr (PH == 1) phase1(p, smem);
    else if constexpr (PH == 2) phase2(p, smem);
    else if constexpr (PH == 3) phase3(p, smem);
    else if constexpr (PH == 4) phase4(p, smem);
    else if constexpr (PH == 5) phase5(p, smem);
    else if constexpr (PH == 6) phase6(p, smem);
    else if constexpr (PH == 7) phase7(p, smem);
    else if constexpr (PH == 8) phase8(p, smem);
    else if constexpr (PH == 9) phase9(p, smem);
    else if constexpr (PH == 10) phase10(p, smem);
    else if constexpr (PH == 11) phase11(p, smem);
    else if constexpr (PH == 12) phase12(p, smem);
    else if constexpr (PH == 13) phase13(p, smem);
    else if constexpr (PH == 14) phase14(p, smem);
    else if constexpr (PH == 15) phase15(p, smem);
    else if constexpr (PH == 16) phase16(p, smem);
    else if constexpr (PH == 17) phase17(p, smem);
    else if constexpr (PH == 18) phase18(p, smem);
    else if constexpr (PH == 19) phase19(p, smem);
    else if constexpr (PH == 20) phase20(p, smem);
    else phase21(p, smem);
}

template <int PH> __global__ void __launch_bounds__(NT, 2) k_phase(Params p) {
    extern __shared__ __attribute__((aligned(16))) char smem[];
    run_phase<PH>(p, smem);
}

template <int PH> __device__ __forceinline__ void mega_run(const Params& p, char* smem, const XcdBarrier& bar) {
    run_phase<PH>(p, smem);
    if constexpr (((PROBE_MASK) >> PH) & 1u) { xcd_barrier(bar); run_phase<PH>(p, smem); }
    if constexpr (PH + 1 < NPHASE) { xcd_barrier(bar); mega_run<PH + 1>(p, smem, bar); }
}
__global__ void __launch_bounds__(NT, 2) k_mega(Params p) {
    extern __shared__ __attribute__((aligned(16))) char smem[];
    uint4* xbw = (uint4*)(smem + 8 * TILE_BYTES);
    if (tidx() == 0) *xbw = make_uint4(0u, 0u, 0u, 0u);
    __syncthreads();
    XcdBarrier bar = xcd_barrier_post(p.bar, (volatile LAS unsigned*)xbw);
    mega_run<0>(p, smem, bar);
}

template <int PH> static void launch_phases(const Params& p, int grid, hipStream_t stream) {
    static bool attr = false;
    if (!attr) { (void)hipFuncSetAttribute((const void*)k_phase<PH>, hipFuncAttributeMaxDynamicSharedMemorySize, LDS_BYTES); attr = true; }
    hipLaunchKernelGGL(k_phase<PH>, dim3(grid), dim3(NT), LDS_BYTES, stream, p);
    if constexpr (PH + 1 < NPHASE) launch_phases<PH + 1>(p, grid, stream);
}

extern "C" void kernel_launch(void* const* d_in, const int* in_sizes, int n_in, void* d_out, int out_size, void* d_ws, size_t ws_size, hipStream_t stream) {
    static int grid = 0;
    if (grid == 0) {
        int dev = 0, cus = 0, per_cu = 0;
        (void)hipGetDevice(&dev); (void)hipDeviceGetAttribute(&cus, hipDeviceAttributeMultiprocessorCount, dev);
        (void)hipFuncSetAttribute((const void*)k_mega, hipFuncAttributeMaxDynamicSharedMemorySize, LDS_BYTES);
        (void)hipOccupancyMaxActiveBlocksPerMultiprocessor(&per_cu, (const void*)k_mega, NT, LDS_BYTES);
        (void)hipGetLastError();
        if (cus <= 0) cus = 256;
        grid = cus;
    }
    Params p{};
    const float** pin = (const float**)&p.x;
    for (int i = 0; i < 36; ++i) pin[i] = (const float*)d_in[i];
    p.out = (float*)d_out;
    char* ws = (char*)d_ws; size_t off = 0;
    auto alloc = [&](size_t bytes) { size_t o = off; off += (bytes + 255) & ~(size_t)255; return ws + o; };
    p.bar = (unsigned*)alloc(XCD_BAR_WORDS * 4); p.cnt = (int*)alloc(256 * 4);
    const size_t zero_bytes = off;
    p.slot_tk = (int*)alloc((size_t)(NSLOT + 256) * 4); p.bh = (int*)alloc(1024 * 256 * 4);
    p.xt = (int*)alloc(NXT_MAX * 16); p.ntiles = (int*)alloc(256);
    p.tok_e = (int*)alloc((size_t)TX * 8 * 4); p.tok_pos = (int*)alloc((size_t)TX * 8 * 4); p.tok_w = (float*)alloc((size_t)TX * 8 * 4);
    p.modp = (float*)alloc(16 * 2 * 6144 * 4); p.mod = (float*)alloc(2 * 6144 * 4);
    p.WinT = (bf16_t*)alloc((size_t)INC * 1024 * 2); p.WaT = (bf16_t*)alloc(1024 * 512 * 2); p.WbT = (bf16_t*)alloc(1024 * 1024 * 2); p.WoT = (bf16_t*)alloc(1024 * 1024 * 2);
    p.RtT = (bf16_t*)alloc(256 * 3072 * 2); p.ShGU = (bf16_t*)alloc(512 * 1024 * 2); p.ShD = (bf16_t*)alloc(1024 * 256 * 2);
    p.WupT = (bf16_t*)alloc(1024 * 64 * 2); p.AupT = (bf16_t*)alloc(1024 * 64 * 2); p.GupT = (bf16_t*)alloc(512 * 128 * 2);
    p.ya_in = (bf16_t*)alloc((size_t)TX * 512 * 2); p.yb_in = (bf16_t*)alloc((size_t)TX * 1024 * 2);
    p.BtW = (bf16_t*)alloc((size_t)257 * 512 * 1024 * 2);
    char* RA = alloc((size_t)TE * INC * 2);
    p.proj = (bf16_t*)RA;
    { size_t o = 0; auto sub = [&](size_t b) { char* r = RA + o; o += (b + 255) & ~(size_t)255; return r; };
      p.act = (bf16_t*)sub(((size_t)NSLOT + 256) * 256 * 2); p.logits = (float*)sub((size_t)TX * 256 * 4); }
    const size_t surv = (size_t)TE * 512 * 2 * 5 + (size_t)2 * TX * 512 * 2 + 4096;
    const size_t rtmp = 424935424 - 68157440 + 65536;
    char* RB = alloc(surv + rtmp);
    { size_t o = 0; auto sub = [&](size_t b) { char* r = RB + o; o += (b + 255) & ~(size_t)255; return r; };
      p.Rr = (bf16_t*)sub((size_t)TE * 512 * 2); p.Vv = (bf16_t*)sub((size_t)TE * 512 * 2); p.KD = (bf16_t*)sub((size_t)2 * TE * 512 * 2); p.G = (bf16_t*)sub((size_t)TE * 512 * 2);
      p.O = (bf16_t*)sub((size_t)2 * TX * 512 * 2);
      const size_t o_t = o;
      p.Kk = (bf16_t*)sub((size_t)TE * 512 * 2); p.Aa = (bf16_t*)sub((size_t)TE * 512 * 2); p.Bd = (bf16_t*)sub((size_t)2 * TE * 512 * 2);
      p.Wd = (float*)sub((size_t)2 * TE * 512 * 4); p.TW = (bf16_t*)sub((size_t)TE * 64 * 2); p.XA = (bf16_t*)sub((size_t)TE * 64 * 2); p.SG = (bf16_t*)sub((size_t)TE * 128 * 2);
      p.PH = (float*)sub((size_t)127 * 16 * 2 * 4096 * 4); p.Sst = (float*)sub((size_t)128 * 16 * 4096 * 4);
      p.Zz = (bf16_t*)sub((size_t)RNC * 16 * RL * 64 * 2); p.YH = (bf16_t*)sub((size_t)RNC * 16 * RL * 64 * 2);
      p.hn = (bf16_t*)p.PH;
      o = o_t;
      p.Qr = (bf16_t*)sub((size_t)NCH * 4 * 128 * 128 * 2); p.Kr = (bf16_t*)sub((size_t)NCH * 4 * 128 * 128 * 2); p.KTz = (bf16_t*)sub((size_t)NCH * 4 * 2 * 128 * 128 * 2);
      p.A3 = (bf16_t*)sub((size_t)NCH * 4 * 128 * 384 * 2); p.B3 = (bf16_t*)sub((size_t)NCH * 4 * 256 * 384 * 2);
      p.KVT = (bf16_t*)sub((size_t)NCH * 4 * 2 * 256 * 128 * 2); p.Y = (float*)sub((size_t)TX * 1024 * 4);
      o = 0;
      p.x_mid = (float*)sub((size_t)TX * 1024 * 4); p.Ahl = (bf16_t*)sub((size_t)TX * 1024 * 2);
      p.yk = (bf16_t*)sub((size_t)TX * 9 * 1024 * 2);
      char* yk0 = (char*)p.yk; p.mergedA = (float*)yk0; p.merged = (bf16_t*)(yk0 + (size_t)TX * 1024 * 4); p.mix = (float*)(yk0 + (size_t)TX * 1024 * 6);
    }
    if (off > ws_size) { fprintf(stderr, "kernel_launch: workspace too small: need %zu have %zu\n", off, ws_size); return; }
    int j = 0;
    p.jobs[j++] = TJob{p.w_in, p.WinT, 1024, INC, 1024, 0, 0, 0};
    p.jobs[j++] = TJob{p.w_branch_a, p.WaT, 512, 1024, 512, 0, 0, 0};
    p.jobs[j++] = TJob{p.w_branch_b, p.WbT, 1024, 1024, 1024, 0, 0, 0};
    p.jobs[j++] = TJob{p.w_out, p.WoT, 1024, 1024, 1024, 0, 0, 0};
    p.jobs[j++] = TJob{p.router_w, p.RtT, 1024, 256, 1024, 0, 0, 0};
    p.jobs[j++] = TJob{p.rwkv_g_up, p.GupT, 0, 0, 128, 0, 0, 0};
    p.jobs[j++] = TJob{p.rwkv_g_up, p.GupT, 0, 0, 128, 0, 0, 0};
    p.jobs[j++] = TJob{p.rwkv_g_up, p.GupT, 0, 0, 128, 0, 0, 0};
    p.jobs[j++] = TJob{p.rwkv_w_up, p.WupT, 64, 512, 64, 0, 0, 0};
    p.jobs[j++] = TJob{p.rwkv_w_up + 64 * 512, p.WupT, 64, 512, 64, 0, 512, 0};
    p.jobs[j++] = TJob{p.rwkv_a_up, p.AupT, 64, 512, 64, 0, 0, 0};
    p.jobs[j++] = TJob{p.rwkv_a_up + 64 * 512, p.AupT, 64, 512, 64, 0, 512, 0};
    p.jobs[j++] = TJob{p.rwkv_g_up, p.GupT, 128, 512, 128, 0, 0, 0};
    p.jobs[j++] = TJob{p.rwkv_g_up, p.GupT, 0, 0, 128, 0, 0, 0};
    (void)hipMemsetAsync(ws, 0, zero_bytes, stream);
#if MK_ONE_LAUNCH
    hipLaunchKernelGGL(k_mega, dim3(grid), dim3(NT), LDS_BYTES, stream, p);
#else
    launch_phases<0>(p, grid, stream);
#endif
}
```

```cpp
#include <hip/hip_runtime.h>
#include <stdint.h>
#include <stdio.h>

#ifndef MK_ONE_LAUNCH
#define MK_ONE_LAUNCH 1
#endif
#ifndef ROUTER_K
#define ROUTER_K 1024
#endif
#ifndef PROBE_MASK
#define PROBE_MASK 0u
#endif

typedef unsigned short bf16_t;
typedef short bf16x8 __attribute__((ext_vector_type(8)));
typedef float f32x4 __attribute__((ext_vector_type(4)));
typedef float f32x2 __attribute__((ext_vector_type(2)));

#define NT 512
constexpr int TX = 16384, TC = 256, TE = 16640, DM = 1024, INC = 6912;
constexpr int NCH = 130;
constexpr int RL = 130, RNC = 128;
constexpr int TSTR = 144;
constexpr int TILE_BYTES = 128 * TSTR;
constexpr int LDS_BYTES = 8 * TILE_BYTES + 1024;
constexpr int NSLOT = 131072 + 16384;
constexpr int NXT_MAX = 768 + 64;

#define XB_TMO      128
#define XB_XCNT(j)  (256  + 64 * (j))
#define XB_XSUB(j)  (1280 + 64 * (j))
#define XB_XGEN(j)  (2304 + 64 * (j))
#define XB_TOP      3328
#define XB_TOPGEN   3392
#define XCD_BAR_WORDS 3456
#define XB_SPIN_CAP (1u << 18)
#define LAS __attribute__((address_space(3)))

__device__ __forceinline__ unsigned xb_ld(unsigned* p)              { return __hip_atomic_load(p, __ATOMIC_RELAXED, __HIP_MEMORY_SCOPE_AGENT); }
__device__ __forceinline__ unsigned xb_add(unsigned* p, unsigned v) { return __hip_atomic_fetch_add(p, v, __ATOMIC_RELAXED, __HIP_MEMORY_SCOPE_AGENT); }
__device__ __forceinline__ unsigned xb_xcc_id() { return (unsigned)__builtin_amdgcn_s_getreg((3 << 11) | 20) & 0xFu; }
#define XB_SPIN(cond, bar) do { unsigned _sp = 0; while (cond) { __builtin_amdgcn_s_sleep(1); \
    if ((++_sp & 255u) == 0u) { if (xb_ld(&(bar)[XB_TMO])) break; if (_sp > XB_SPIN_CAP) { atomicAdd(&(bar)[XB_TMO], 1u); break; } } } } while (0)

struct XcdBarrier { unsigned* bar; unsigned x; volatile LAS unsigned* st; };

__device__ __forceinline__ XcdBarrier xcd_barrier_post(unsigned* bar, volatile LAS unsigned* st) {
    XcdBarrier b; b.bar = bar; b.x = xb_xcc_id(); b.st = st;
    if (threadIdx.x == 0) (void)xb_add(&bar[XB_XCNT(b.x)], 1u);
    return b;
}
__device__ __forceinline__ void xcd_barrier_complete(unsigned* bar, unsigned x, unsigned& nloc, unsigned& nx) {
    const unsigned G = gridDim.x * gridDim.y * gridDim.z;
    unsigned sum, cnt, mine, sp = 0u;
    for (;;) {
        sum = 0u; cnt = 0u; mine = 0u;
#pragma unroll
        for (unsigned j = 0; j < 16; ++j) { const unsigned c = xb_ld(&bar[XB_XCNT(j)]); sum += c; cnt += (c > 0u) ? 1u : 0u; mine = (j == x) ? c : mine; }
        if (sum == G) break;
        __builtin_amdgcn_s_sleep(1);
        if ((++sp & 255u) == 0u) { if (xb_ld(&bar[XB_TMO])) break; if (sp > XB_SPIN_CAP) { atomicAdd(&bar[XB_TMO], 1u); break; } }
    }
    nloc = mine > 0u ? mine : 1u; nx = cnt > 0u ? cnt : 1u;
}
__device__ __forceinline__ void xcd_barrier(const XcdBarrier& b) {
    asm volatile("s_waitcnt vmcnt(0)" ::: "memory");
    __syncthreads();
    if (threadIdx.x == 0) {
        unsigned* bar = b.bar;
        __builtin_amdgcn_s_waitcnt(0);
        unsigned nloc = b.st[0], nx = b.st[1];
        if (nloc == 0u) { xcd_barrier_complete(bar, b.x, nloc, nx); b.st[0] = nloc; b.st[1] = nx; }
        const unsigned old = xb_add(&bar[XB_XSUB(b.x)], 1u);
        const unsigned gen = old / nloc;
        if (old + 1u == (gen + 1u) * nloc) {
            __builtin_amdgcn_fence(__ATOMIC_RELEASE, "agent");
            asm volatile("s_waitcnt vmcnt(0)" ::: "memory");
            const unsigned og = xb_add(&bar[XB_TOP], 1u);
            const unsigned tg = og / nx;
            if (og + 1u == (tg + 1u) * nx) xb_add(&bar[XB_TOPGEN], 1u);
            else XB_SPIN(xb_ld(&bar[XB_TOPGEN]) == tg, bar);
            __builtin_amdgcn_fence(__ATOMIC_ACQUIRE, "agent");
            xb_add(&bar[XB_XGEN(b.x)], 1u);
            asm volatile("s_waitcnt vmcnt(0)" ::: "memory");
        } else {
            XB_SPIN(xb_ld(&bar[XB_XGEN(b.x)]) == gen, bar);
            __builtin_amdgcn_fence(__ATOMIC_ACQUIRE, "agent");
            asm volatile("s_waitcnt vmcnt(0)" ::: "memory");
        }
    }
    __syncthreads();
}

struct TJob { const float* src; bf16_t* dst; int K, N, dld, mode, rowoff, coloff; };
constexpr int NJOB = 14;

struct Params {
    const float *x, *c, *ctx, *c_ctx, *w_mod, *b_mod, *n_pre_mix, *n_post_mix, *n_pre_ffn, *n_post_ffn,
        *w_in, *shift_mu, *rwkv_w0, *rwkv_w_up, *rwkv_a0, *rwkv_a_up, *rwkv_g_up, *rwkv_k_k, *rwkv_k_a, *rwkv_r_k,
        *rwkv_ln_w, *rwkv_ln_b, *w_branch_a, *ret_decay_logit, *ret_ln_w, *ret_ln_b, *w_branch_b, *w_out,
        *router_w, *router_bias, *exp_w_gate, *exp_w_up, *exp_w_down, *sh_w_gate, *sh_w_up, *sh_w_down;
    float* out;
    unsigned* bar; int* cnt; int* bh; int* slot_tk; int* xt; int* ntiles; int* tok_e; int* tok_pos; float* tok_w;
    float* modp; float* mod;
    bf16_t *WinT, *WaT, *WbT, *WoT, *RtT, *ShGU, *ShD, *WupT, *AupT, *GupT;
    bf16_t *hn, *proj, *BtW;
    bf16_t *Rr, *Vv, *KD, *G, *O;
    bf16_t *Kk, *Aa, *Bd, *TW, *XA, *SG;
    float *Wd, *PH, *Sst; bf16_t *Zz, *YH;
    bf16_t *Qr, *Kr, *KTz, *A3, *B3;
    bf16_t* KVT; float* Y;
    bf16_t *ya_in, *yb_in, *merged, *Ahl, *act, *yk;
    float *mergedA, *x_mid, *logits; bf16_t* mix;
    TJob jobs[NJOB];
};

__device__ __forceinline__ int tidx() { int t = threadIdx.x; asm volatile("" : "+v"(t)); return t; }
__device__ __forceinline__ float bf2f(bf16_t v) { return __uint_as_float(((unsigned)v) << 16); }
__device__ __forceinline__ unsigned pack2(float lo, float hi) { unsigned r; asm("v_cvt_pk_bf16_f32 %0, %1, %2" : "=v"(r) : "v"(lo), "v"(hi)); return r; }
__device__ __forceinline__ bf16_t f2bf(float f) { return (bf16_t)(pack2(f, f) & 0xffffu); }
__device__ __forceinline__ void unpack8(const uint4& v, float (&f)[8]) {
    f[0] = __uint_as_float(v.x << 16); f[1] = __uint_as_float(v.x & 0xffff0000u); f[2] = __uint_as_float(v.y << 16); f[3] = __uint_as_float(v.y & 0xffff0000u);
    f[4] = __uint_as_float(v.z << 16); f[5] = __uint_as_float(v.z & 0xffff0000u); f[6] = __uint_as_float(v.w << 16); f[7] = __uint_as_float(v.w & 0xffff0000u); }
__device__ __forceinline__ uint4 pack8(const float (&f)[8]) { uint4 o; o.x = pack2(f[0], f[1]); o.y = pack2(f[2], f[3]); o.z = pack2(f[4], f[5]); o.w = pack2(f[6], f[7]); return o; }
__device__ __forceinline__ float wsum(float v) {
#pragma unroll
    for (int o = 32; o; o >>= 1) v += __shfl_xor(v, o, 64);
    return v;
}
__device__ __forceinline__ float sigm(float z) { return 1.f / (1.f + __expf(-z)); }
__device__ __forceinline__ int row_of(int dir, int s) { return dir == 0 ? s : (s < 256 ? 255 - s : 16895 - s); }

struct APlain { const bf16_t* base; int ld;
    __device__ __forceinline__ const char* bptr() const { return (const char*)base; }
    __device__ __forceinline__ unsigned rowoff(int r) const { return (unsigned)(r * ld) * 2u; } };
struct AGather { const bf16_t* base; int ld; const int* idx;
    __device__ __forceinline__ const char* bptr() const { return (const char*)base; }
    __device__ __forceinline__ unsigned rowoff(int r) const { const int tok = idx[r] / 9; return (unsigned)(tok * ld) * 2u; } };
struct BPlain { static constexpr int MODE = 0; const bf16_t* base; int ldv;
    __device__ __forceinline__ const char* bptr() const { return (const char*)base; }
    __device__ __forceinline__ unsigned rowoff(int n) const { return (unsigned)(n * ldv) * 2u; }
    __device__ __forceinline__ const float* colptr(int) const { return nullptr; }
    __device__ __forceinline__ long ld() const { return ldv; }
    __device__ __forceinline__ int lrow(int, int) const { return 0; } };
struct BKN { static constexpr int MODE = 1; const float* base; long ldv;
    __device__ __forceinline__ const char* bptr() const { return nullptr; }
    __device__ __forceinline__ unsigned rowoff(int) const { return 0u; }
    __device__ __forceinline__ const float* colptr(int n4) const { return base + n4 * 4; }
    __device__ __forceinline__ long ld() const { return ldv; }
    __device__ __forceinline__ int lrow(int n4, int j) const { return n4 * 4 + j; } };
struct BKNGU { static constexpr int MODE = 1; const float* g; const float* u;
    __device__ __forceinline__ const char* bptr() const { return nullptr; }
    __device__ __forceinline__ unsigned rowoff(int) const { return 0u; }
    __device__ __forceinline__ const float* colptr(int n4) const { return ((n4 >> 5) ? u : g) + (n4 & 31) * 4; }
    __device__ __forceinline__ long ld() const { return 256; }
    __device__ __forceinline__ int lrow(int n4, int j) const { int sc = (n4 & 31) * 4 + j; return (sc >> 4) * 32 + (n4 >> 5) * 16 + (sc & 15); } };

__device__ __forceinline__ float f4e(const float4& v, int j) { return j == 0 ? v.x : (j == 1 ? v.y : (j == 2 ? v.z : v.w)); }
#define GC_REP4(N, X) do { if constexpr ((N) > 0) { X(0); } if constexpr ((N) > 1) { X(1); } if constexpr ((N) > 2) { X(2); } if constexpr ((N) > 3) { X(3); } } while (0)
#define GC_REP8(N, X) do { X(0); X(1); X(2); X(3); if constexpr ((N) > 4) { X(4); X(5); X(6); X(7); } } while (0)
#define GC_AOFF(i) aoff##i = ap.rowoff(lrow + 64 * i) + lseg * 16
#define GC_BOFF(i) boff##i = bp.rowoff(lrow + 64 * i) + lseg * 16
#define GC_LA(i) ra##i = *(const uint4*)(abase + (aoff##i + kt_ * 128))
#define GC_LB(i) rb##i = *(const uint4*)(bbase + (boff##i + kt_ * 128))
#define GC_LF(i) rf##i = *(const float4*)(bfp + ((long)kt_ * 64 + i) * bld)
#define GC_SA(i) *(uint4*)(As_ + (lrow + 64 * i) * TSTR + lseg * 16) = ra##i
#define GC_SB(i) *(uint4*)(Bs_ + (lrow + 64 * i) * TSTR + lseg * 16) = rb##i
#define GC_GLOAD(KT) do { const int kt_ = (KT); GC_REP4(AL, GC_LA); \
    if constexpr (BP::MODE == 0) { GC_REP4(BL, GC_LB); } else { GC_REP8(KPT, GC_LF); } } while (0)
#define GC_SF(j) do { char* d_ = Bs_ + bp.lrow(n4, j) * TSTR + kq * KPT * 2; \
        if constexpr (KPT == 4) *(uint2*)d_ = make_uint2(pack2(f4e(rf0, j), f4e(rf1, j)), pack2(f4e(rf2, j), f4e(rf3, j))); \
        else *(uint4*)d_ = make_uint4(pack2(f4e(rf0, j), f4e(rf1, j)), pack2(f4e(rf2, j), f4e(rf3, j)), pack2(f4e(rf4, j), f4e(rf5, j)), pack2(f4e(rf6, j), f4e(rf7, j))); } while (0)
#define GC_LSTORE(BUF) do { char* As_ = smem + (BUF) * STAGE; char* Bs_ = As_ + ABYTES; GC_REP4(AL, GC_SA); \
    if constexpr (BP::MODE == 0) { GC_REP4(BL, GC_SB); } else { GC_SF(0); GC_SF(1); GC_SF(2); GC_SF(3); } } while (0)

template <int BM, int BN, int WGM, int WGN, class AP, class BP>
__device__ __forceinline__ void gemm_core(f32x4 (&acc)[BM / WGM / 16][BN / WGN / 16], const AP& ap, const BP& bp, const int K, char* smem) {
    constexpr int TM = BM / WGM, TN = BN / WGN, MI = TM / 16, NI = TN / 16;
    constexpr int ABYTES = BM * TSTR, STAGE = (BM + BN) * TSTR;
    constexpr int AL = BM / 64, BL = BN / 64;
    constexpr int KPT = BN / 32, NQ = BN / 4;
    const int tid = tidx(), wave = tid >> 6, lane = tid & 63, fr = lane & 15, fq = lane >> 4;
    const int wm = wave / WGN, wn = wave % WGN;
    const int lrow = tid >> 3, lseg = tid & 7;
    const char* abase = ap.bptr(); const char* bbase = bp.bptr();
    unsigned aoff0 = 0, aoff1 = 0, aoff2 = 0, aoff3 = 0, boff0 = 0, boff1 = 0, boff2 = 0, boff3 = 0;
    uint4 ra0, ra1, ra2, ra3, rb0, rb1, rb2, rb3; float4 rf0, rf1, rf2, rf3, rf4, rf5, rf6, rf7;
    GC_REP4(AL, GC_AOFF);
    const float* bfp = nullptr;
    const int kq = tid / NQ, n4 = tid % NQ; const long bld = bp.ld();
    if constexpr (BP::MODE == 0) { GC_REP4(BL, GC_BOFF); } else { bfp = bp.colptr(n4) + (long)(kq * KPT) * bld; }
    int nk = K >> 6;
    asm volatile("" : "+s"(nk));
    GC_GLOAD(0); GC_LSTORE(0); __syncthreads();
    for (int kt = 0; kt < nk; ++kt) {
        if (kt + 1 < nk) GC_GLOAD(kt + 1);
        const char* As = smem + (kt & 1) * STAGE; const char* Bs = As + ABYTES;
#pragma unroll
        for (int ks = 0; ks < 2; ++ks) {
            bf16x8 af[MI], bfr[NI];
#pragma unroll
            for (int mi = 0; mi < MI; ++mi) af[mi] = *(const bf16x8*)(As + (wm * TM + mi * 16 + fr) * TSTR + ks * 64 + fq * 16);
#pragma unroll
            for (int ni = 0; ni < NI; ++ni) bfr[ni] = *(const bf16x8*)(Bs + (wn * TN + ni * 16 + fr) * TSTR + ks * 64 + fq * 16);
#pragma unroll
            for (int mi = 0; mi < MI; ++mi)
#pragma unroll
                for (int ni = 0; ni < NI; ++ni) acc[mi][ni] = __builtin_amdgcn_mfma_f32_16x16x32_bf16(bfr[ni], af[mi], acc[mi][ni], 0, 0, 0);
        }
        if (kt + 1 < nk) GC_LSTORE((kt + 1) & 1);
        __syncthreads();
    }
}
template <int BM, int BN, int WGM, int WGN, class AP, class BP, class EPI>
__device__ __forceinline__ void gemm_tile(const AP& ap, const BP& bp, const int K, char* smem, const EPI& epi) {
    constexpr int TM = BM / WGM, TN = BN / WGN, MI = TM / 16, NI = TN / 16;
    f32x4 acc[MI][NI];
#pragma unroll
    for (int mi = 0; mi < MI; ++mi)
#pragma unroll
        for (int ni = 0; ni < NI; ++ni) acc[mi][ni] = (f32x4){0.f, 0.f, 0.f, 0.f};
    gemm_core<BM, BN, WGM, WGN>(acc, ap, bp, K, smem);
    const int wave = tidx() >> 6, lane = tidx() & 63;
    epi(acc, (wave / WGN) * TM + (lane & 15), (wave % WGN) * TN + (lane >> 4) * 4);
}

namespace g8 {
constexpr int BM = 256, BK = 64, HALF = 128, HTB = HALF * BK * 2, NXCD = 8, WGM = 8;
__device__ __forceinline__ int lds_byte(int r, int c) { const int st = (r >> 4) * 2 + (c >> 5), rr = r & 15, cc = c & 31, ob = rr * 64 + cc * 2; return st * 1024 + (ob ^ (((ob >> 9) & 1) << 5)); }
__device__ __forceinline__ void stage_rc(int b, int& R, int& C) { const int st = b / 1024, sb = b % 1024, swz = sb ^ (((sb >> 9) & 1) << 5); R = (st >> 1) * 16 + swz / 64; C = (st & 1) * 32 + (swz % 64) / 2; }
__device__ __forceinline__ int perm32(int rho) { const int n = rho >> 4, i = rho & 15; return 8 * (i >> 2) + 4 * n + (i & 3); }
struct Unit { int pm, pn; };
struct StaticOrder {
    int nM, nN, nwg, G, c;
    __device__ void init(int M, int N, int G_, int c_) { nM = M / BM; nN = N / BM; nwg = nM * nN; G = G_; c = c_; }
    __device__ bool next(int i, Unit& u) const {
        const long L = (long)i * G + c; if (L >= nwg) return false;
        int wgid = (int)L; { const int q = nwg / NXCD, r = nwg % NXCD, xcd = wgid % NXCD, off = wgid / NXCD; wgid = (xcd < r ? xcd * (q + 1) : r * (q + 1) + (xcd - r) * q) + off; }
        const int nig = WGM * nN, gid = wgid / nig, fm = gid * WGM, gsz = (nM - fm) < WGM ? (nM - fm) : WGM;
        u.pm = fm + ((wgid % nig) % gsz); u.pn = (wgid % nig) / gsz; return true;
    }
};
template <class Epi, class Sched>
__device__ __forceinline__ void gemm_phase(LAS unsigned char* lds, const bf16_t* Ag, const bf16_t* Btg, const int lda, const int ldb, const int K, const Sched& S, const Epi& E) {
    int tid = threadIdx.x; asm volatile("" : "+v"(tid));
    const int wid = __builtin_amdgcn_readfirstlane(tid >> 6), lane = tid & 63, wr = wid >> 2, wc = wid & 3, fr = lane & 15, fq = lane >> 4;
    const int nt = K / BK;
    unsigned voffA[2], voffB[2];
#pragma unroll
    for (int i = 0; i < 2; ++i) { int R, C; stage_rc(tid * 16 + i * 8192, R, C); const int Rb = Epi::PERM ? ((R & ~31) + perm32(R & 31)) : R;
        voffA[i] = (unsigned)(R * lda + C) * 2u; voffB[i] = (unsigned)(Rb * ldb + C) * 2u; }
    const size_t kstep = (size_t)(BK * 2);
    const size_t hstepA = (size_t)HALF * lda * 2, hstepB = (size_t)HALF * ldb * 2;
    const size_t tstepA = 2 * hstepA, tstepB = 2 * hstepB;
    const unsigned ldsw = (unsigned)wid * 1024u;
    const int aoff = lds_byte(wr * 64 + fr, fq * 8), boff = lds_byte(wc * 32 + fr, fq * 8);
#define PG8_SA(b, h) (((b) * 2 + (h)) * HTB)
#define PG8_SB(b, h) ((4 + (b) * 2 + (h)) * HTB)
#define PG8_STAGE(bufoff, gbase, voff) do { _Pragma("unroll") for (int _i = 0; _i < 2; ++_i) \
        __builtin_amdgcn_global_load_lds((const unsigned*)((const char*)(gbase) + (voff)[_i]), (LAS unsigned*)(lds + (bufoff) + ldsw + _i * 8192), 16, 0, 0); } while (0)
#define PG8_LDA(dst, b, h) do { _Pragma("unroll") for (int m = 0; m < 4; ++m) _Pragma("unroll") for (int k = 0; k < 2; ++k) dst[m][k] = *(const LAS bf16x8*)(lds + PG8_SA(b, h) + aoff + m * 2048 + k * 1024); } while (0)
#define PG8_LDB(dst, b, h) do { _Pragma("unroll") for (int n = 0; n < 2; ++n) _Pragma("unroll") for (int k = 0; k < 2; ++k) dst[n][k] = *(const LAS bf16x8*)(lds + PG8_SB(b, h) + boff + n * 2048 + k * 1024); } while (0)
#define PG8_MMA(ai, bj, At, Bt) do { __builtin_amdgcn_s_setprio(1); _Pragma("unroll") for (int m = 0; m < 4; ++m) _Pragma("unroll") for (int n = 0; n < 2; ++n) _Pragma("unroll") for (int k = 0; k < 2; ++k) \
        acc[ai][bj][m][n] = __builtin_amdgcn_mfma_f32_16x16x32_bf16(Bt[n][k], At[m][k], acc[ai][bj][m][n], 0, 0, 0); __builtin_amdgcn_s_setprio(0); } while (0)
#define PG8_WAIT_V(n) asm volatile("s_waitcnt vmcnt(" #n ")" ::: "memory")
#define PG8_WAIT_L(n) asm volatile("s_waitcnt lgkmcnt(" #n ")" ::: "memory")
#define PG8_BAR __builtin_amdgcn_s_barrier()
#define PG8_SCHED __builtin_amdgcn_sched_barrier(0)
    Unit cur, nxt; int ui = 0;
    if (!S.next(0, cur)) return;
    f32x4 acc[2][2][4][2];
#pragma unroll
    for (int a = 0; a < 2; ++a)
#pragma unroll
        for (int b = 0; b < 2; ++b)
#pragma unroll
            for (int m = 0; m < 4; ++m)
#pragma unroll
                for (int n = 0; n < 2; ++n) acc[a][b][m][n] = (f32x4){0.f, 0.f, 0.f, 0.f};
    bf16x8 At[4][2], B0[2][2], B1[2][2];
    const char* cA = (const char*)Ag + (size_t)cur.pm * tstepA; const char* cB = (const char*)Btg + (size_t)cur.pn * tstepB;
    PG8_STAGE(PG8_SB(0, 0), cB, voffB); PG8_STAGE(PG8_SA(0, 0), cA, voffA); PG8_STAGE(PG8_SB(0, 1), cB + hstepB, voffB); PG8_STAGE(PG8_SA(0, 1), cA + hstepA, voffA);
    if (wr == 1) PG8_BAR;
    PG8_WAIT_V(4); PG8_BAR;
    PG8_STAGE(PG8_SB(1, 0), cB + kstep, voffB); PG8_STAGE(PG8_SA(1, 0), cA + kstep, voffA); PG8_STAGE(PG8_SB(1, 1), cB + hstepB + kstep, voffB);
    PG8_WAIT_V(6); PG8_BAR;
    for (;;) {
        const bool has_next = S.next(ui + 1, nxt);
        const char* nA = has_next ? (const char*)Ag + (size_t)nxt.pm * tstepA : cA; const char* nB = has_next ? (const char*)Btg + (size_t)nxt.pn * tstepB : cB;
        for (int t = 0; t < nt; t += 2) {
            const bool last = (t == nt - 2);
            const char* a1 = cA + (size_t)(t + 1) * kstep;
            const char* a2 = last ? nA : cA + (size_t)(t + 2) * kstep; const char* b2 = last ? nB : cB + (size_t)(t + 2) * kstep;
            const char* a3 = a2 + kstep; const char* b3 = b2 + kstep;
            PG8_LDB(B0, 0, 0); PG8_SCHED; PG8_LDA(At, 0, 0); PG8_STAGE(PG8_SA(1, 1), a1 + hstepA, voffA);
            PG8_WAIT_L(8); PG8_BAR; PG8_WAIT_L(0); PG8_MMA(0, 0, At, B0); PG8_BAR; PG8_SCHED;
            PG8_LDB(B1, 0, 1); PG8_STAGE(PG8_SB(0, 0), b2, voffB);
            PG8_BAR; PG8_WAIT_L(0); PG8_MMA(0, 1, At, B1); PG8_BAR;
            PG8_LDA(At, 0, 1); PG8_STAGE(PG8_SA(0, 0), a2, voffA);
            PG8_BAR; PG8_WAIT_L(0); PG8_MMA(1, 0, At, B0); PG8_BAR; PG8_SCHED;
            PG8_STAGE(PG8_SB(0, 1), b2 + hstepB, voffB);
            PG8_WAIT_V(6); PG8_BAR; PG8_MMA(1, 1, At, B1); PG8_BAR;
            PG8_LDB(B0, 1, 0); PG8_SCHED; PG8_LDA(At, 1, 0); PG8_STAGE(PG8_SA(0, 1), a2 + hstepA, voffA);
            PG8_WAIT_L(8); PG8_BAR; PG8_WAIT_L(0); PG8_MMA(0, 0, At, B0); PG8_BAR; PG8_SCHED;
            PG8_LDB(B1, 1, 1); PG8_STAGE(PG8_SB(1, 0), b3, voffB);
            PG8_BAR; PG8_WAIT_L(0); PG8_MMA(0, 1, At, B1); PG8_BAR;
            PG8_LDA(At, 1, 1); PG8_STAGE(PG8_SA(1, 0), a3, voffA);
            PG8_BAR; PG8_WAIT_L(0); PG8_MMA(1, 0, At, B0); PG8_BAR; PG8_SCHED;
            PG8_STAGE(PG8_SB(1, 1), b3 + hstepB, voffB);
            PG8_WAIT_V(6); PG8_BAR; PG8_MMA(1, 1, At, B1); PG8_BAR;
        }
        E(acc, cur, wr, wc, fr, fq);
        if (!has_next) break;
#pragma unroll
        for (int a = 0; a < 2; ++a)
#pragma unroll
            for (int b = 0; b < 2; ++b)
#pragma unroll
                for (int m = 0; m < 4; ++m)
#pragma unroll
                    for (int n = 0; n < 2; ++n) acc[a][b][m][n] = (f32x4){0.f, 0.f, 0.f, 0.f};
        cur = nxt; cA = nA; cB = nB; ++ui;
    }
    PG8_WAIT_V(0);
    if (wr == 0) PG8_BAR;
    PG8_BAR;
#undef PG8_SA
#undef PG8_SB
#undef PG8_STAGE
#undef PG8_LDA
#undef PG8_LDB
#undef PG8_MMA
#undef PG8_WAIT_V
#undef PG8_WAIT_L
#undef PG8_BAR
#undef PG8_SCHED
}
struct EpiF32 {
    static constexpr bool PERM = false;
    float* C; int ldc;
    __device__ __forceinline__ void operator()(const f32x4 (&acc)[2][2][4][2], const Unit& u, int wr, int wc, int fr, int fq) const {
        const int row0 = u.pm * BM + wr * 64 + fr, col0 = u.pn * BM + wc * 32 + 4 * fq;
#pragma unroll
        for (int ai = 0; ai < 2; ++ai)
#pragma unroll
            for (int m = 0; m < 4; ++m) { float* rowp = C + (size_t)(row0 + ai * HALF + m * 16) * ldc + col0;
#pragma unroll
                for (int bj = 0; bj < 2; ++bj)
#pragma unroll
                    for (int n = 0; n < 2; ++n) *(f32x4*)(rowp + bj * HALF + n * 16) = acc[ai][bj][m][n]; }
    }
};
struct EpiBf16 {
    static constexpr bool PERM = true;
    bf16_t* O; int ldc;
    __device__ __forceinline__ void operator()(const f32x4 (&acc)[2][2][4][2], const Unit& u, int wr, int wc, int fr, int fq) const {
        const int row0 = u.pm * BM + wr * 64 + fr, col0 = u.pn * BM + wc * 32 + 8 * fq;
#pragma unroll
        for (int ai = 0; ai < 2; ++ai)
#pragma unroll
            for (int m = 0; m < 4; ++m) { bf16_t* rowp = O + (size_t)(row0 + ai * HALF + m * 16) * ldc + col0;
#pragma unroll
                for (int bj = 0; bj < 2; ++bj) { const f32x4 v0 = acc[ai][bj][m][0], v1 = acc[ai][bj][m][1];
                    uint4 o; o.x = pack2(v0[0], v0[1]); o.y = pack2(v0[2], v0[3]); o.z = pack2(v1[0], v1[1]); o.w = pack2(v1[2], v1[3]);
                    *(uint4*)(rowp + bj * HALF) = o; } }
    }
};
struct XUnit { int row0, nrows, e, nt; };
template <class Epi>
__device__ __forceinline__ void gemm_phase_xg(LAS unsigned char* lds, const bf16_t* Ag, const int* slot_tk, const int* xt, const bf16_t* BtW, const int nun, const int lb, const int G, const Epi& E) {
    int tid = threadIdx.x; asm volatile("" : "+v"(tid));
    const int wid = __builtin_amdgcn_readfirstlane(tid >> 6), lane = tid & 63, wr = wid >> 2, wc = wid & 3, fr = lane & 15, fq = lane >> 4;
    constexpr int K = 1024, nt = K / BK;
    unsigned voffB[2];
#pragma unroll
    for (int i = 0; i < 2; ++i) { int R, C; stage_rc(tid * 16 + i * 8192, R, C); voffB[i] = (unsigned)(R * K + C) * 2u; }
    const size_t kstep = (size_t)(BK * 2), hstepB = (size_t)HALF * K * 2;
    const unsigned ldsw = (unsigned)wid * 1024u;
    const int aoff = lds_byte(wr * 64 + fr, fq * 8), boff = lds_byte(wc * 32 + fr, fq * 8);
#define PG8_SA(b, h) (((b) * 2 + (h)) * HTB)
#define PG8_SB(b, h) ((4 + (b) * 2 + (h)) * HTB)
#define PG8_STAGE(bufoff, gbase, voff) do { _Pragma("unroll") for (int _i = 0; _i < 2; ++_i) \
        __builtin_amdgcn_global_load_lds((const unsigned*)((const char*)(gbase) + (voff)[_i]), (LAS unsigned*)(lds + (bufoff) + ldsw + _i * 8192), 16, 0, 0); } while (0)
#define PG8_LDA(dst, b, h) do { _Pragma("unroll") for (int m = 0; m < 4; ++m) _Pragma("unroll") for (int k = 0; k < 2; ++k) dst[m][k] = *(const LAS bf16x8*)(lds + PG8_SA(b, h) + aoff + m * 2048 + k * 1024); } while (0)
#define PG8_LDB(dst, b, h) do { _Pragma("unroll") for (int n = 0; n < 2; ++n) _Pragma("unroll") for (int k = 0; k < 2; ++k) dst[n][k] = *(const LAS bf16x8*)(lds + PG8_SB(b, h) + boff + n * 2048 + k * 1024); } while (0)
#define PG8_MMA(ai, bj, At, Bt) do { __builtin_amdgcn_s_setprio(1); _Pragma("unroll") for (int m = 0; m < 4; ++m) _Pragma("unroll") for (int n = 0; n < 2; ++n) _Pragma("unroll") for (int k = 0; k < 2; ++k) \
        acc[ai][bj][m][n] = __builtin_amdgcn_mfma_f32_16x16x32_bf16(Bt[n][k], At[m][k], acc[ai][bj][m][n], 0, 0, 0); __builtin_amdgcn_s_setprio(0); } while (0)
#define PG8_WAIT_V(n) asm volatile("s_waitcnt vmcnt(" #n ")" ::: "memory")
#define PG8_WAIT_L(n) asm volatile("s_waitcnt lgkmcnt(" #n ")" ::: "memory")
#define PG8_BAR __builtin_amdgcn_s_barrier()
#define PG8_SCHED __builtin_amdgcn_sched_barrier(0)
#define XG_UNIT(I, U) ((lb + (I) * G) < nun ? ((U).row0 = xt[((lb + (I) * G) >> 1) * 4 + 1], (U).nrows = xt[((lb + (I) * G) >> 1) * 4 + 2], (U).e = xt[((lb + (I) * G) >> 1) * 4], (U).nt = (lb + (I) * G) & 1, true) : false)
#define XG_AVOFF(U, V0, V1) do { int t_ = threadIdx.x; asm volatile("" : "+v"(t_)); _Pragma("unroll") for (int _i = 0; _i < 2; ++_i) { int R_, C_; stage_rc(t_ * 16 + _i * 8192, R_, C_); \
        V0[_i] = (unsigned)(slot_tk[(U).row0 + R_] / 9) * 2048u + (unsigned)C_ * 2u; V1[_i] = (unsigned)(slot_tk[(U).row0 + 128 + R_] / 9) * 2048u + (unsigned)C_ * 2u; } } while (0)
    XUnit cur, nxt; int ui = 0;
    if (!XG_UNIT(0, cur)) return;
    f32x4 acc[2][2][4][2];
#pragma unroll
    for (int a = 0; a < 2; ++a)
#pragma unroll
        for (int b = 0; b < 2; ++b)
#pragma unroll
            for (int m = 0; m < 4; ++m)
#pragma unroll
                for (int n = 0; n < 2; ++n) acc[a][b][m][n] = (f32x4){0.f, 0.f, 0.f, 0.f};
    bf16x8 At[4][2], B0[2][2], B1[2][2];
    unsigned vC0[2], vC1[2], vN1[2];
    XG_AVOFF(cur, vC0, vC1);
    const char* cA = (const char*)Ag;
    const char* cB = (const char*)(BtW + ((size_t)cur.e * 512 + cur.nt * 256) * K);
    PG8_STAGE(PG8_SB(0, 0), cB, voffB); PG8_STAGE(PG8_SA(0, 0), cA, vC0); PG8_STAGE(PG8_SB(0, 1), cB + hstepB, voffB); PG8_STAGE(PG8_SA(0, 1), cA, vC1);
    if (wr == 1) PG8_BAR;
    PG8_WAIT_V(4); PG8_BAR;
    PG8_STAGE(PG8_SB(1, 0), cB + kstep, voffB); PG8_STAGE(PG8_SA(1, 0), cA + kstep, vC0); PG8_STAGE(PG8_SB(1, 1), cB + hstepB + kstep, voffB);
    PG8_WAIT_V(6); PG8_BAR;
    for (;;) {
        const bool has_next = XG_UNIT(ui + 1, nxt);
        if (!has_next) nxt = cur;
        const char* nB = (const char*)(BtW + ((size_t)nxt.e * 512 + nxt.nt * 256) * K);
        for (int t = 0; t < nt; t += 2) {
            const bool last = (t == nt - 2);
            if (last) XG_AVOFF(nxt, vC0, vN1);
            const char* a1 = cA + (size_t)(t + 1) * kstep;
            const char* a2 = last ? cA : cA + (size_t)(t + 2) * kstep; const char* b2 = last ? nB : cB + (size_t)(t + 2) * kstep;
            const char* a3 = a2 + kstep; const char* b3 = b2 + kstep;
            PG8_LDB(B0, 0, 0); PG8_SCHED; PG8_LDA(At, 0, 0); PG8_STAGE(PG8_SA(1, 1), a1, vC1);
            if (last) { vC1[0] = vN1[0]; vC1[1] = vN1[1]; }
            PG8_WAIT_L(8); PG8_BAR; PG8_WAIT_L(0); PG8_MMA(0, 0, At, B0); PG8_BAR; PG8_SCHED;
            PG8_LDB(B1, 0, 1); PG8_STAGE(PG8_SB(0, 0), b2, voffB);
            PG8_BAR; PG8_WAIT_L(0); PG8_MMA(0, 1, At, B1); PG8_BAR;
            PG8_LDA(At, 0, 1); PG8_STAGE(PG8_SA(0, 0), a2, vC0);
            PG8_BAR; PG8_WAIT_L(0); PG8_MMA(1, 0, At, B0); PG8_BAR; PG8_SCHED;
            PG8_STAGE(PG8_SB(0, 1), b2 + hstepB, voffB);
            PG8_WAIT_V(6); PG8_BAR; PG8_MMA(1, 1, At, B1); PG8_BAR;
            PG8_LDB(B0, 1, 0); PG8_SCHED; PG8_LDA(At, 1, 0); PG8_STAGE(PG8_SA(0, 1), a2, vC1);
            PG8_WAIT_L(8); PG8_BAR; PG8_WAIT_L(0); PG8_MMA(0, 0, At, B0); PG8_BAR; PG8_SCHED;
            PG8_LDB(B1, 1, 1); PG8_STAGE(PG8_SB(1, 0), b3, voffB);
            PG8_BAR; PG8_WAIT_L(0); PG8_MMA(0, 1, At, B1); PG8_BAR;
            PG8_LDA(At, 1, 1); PG8_STAGE(PG8_SA(1, 0), a3, vC0);
            PG8_BAR; PG8_WAIT_L(0); PG8_MMA(1, 0, At, B0); PG8_BAR; PG8_SCHED;
            PG8_STAGE(PG8_SB(1, 1), b3 + hstepB, voffB);
            PG8_WAIT_V(6); PG8_BAR; PG8_MMA(1, 1, At, B1); PG8_BAR;
        }
        E(acc, cur, wr, wc, fr, fq);
        if (!has_next) break;
#pragma unroll
        for (int a = 0; a < 2; ++a)
#pragma unroll
            for (int b = 0; b < 2; ++b)
#pragma unroll
                for (int m = 0; m < 4; ++m)
#pragma unroll
                    for (int n = 0; n < 2; ++n) acc[a][b][m][n] = (f32x4){0.f, 0.f, 0.f, 0.f};
        cur = nxt; cB = nB; ++ui;
    }
    PG8_WAIT_V(0);
    if (wr == 0) PG8_BAR;
    PG8_BAR;
#undef PG8_SA
#undef PG8_SB
#undef PG8_STAGE
#undef PG8_LDA
#undef PG8_LDB
#undef PG8_MMA
#undef PG8_WAIT_V
#undef PG8_WAIT_L
#undef PG8_BAR
#undef PG8_SCHED
#undef XG_UNIT
#undef XG_AVOFF
}
struct EpiGU {
    bf16_t* act;
    __device__ __forceinline__ void operator()(const f32x4 (&acc)[2][2][4][2], const XUnit& u, int wr, int wc, int fr, int fq) const {
        const int r0 = wr * 64 + fr;
#pragma unroll
        for (int ai = 0; ai < 2; ++ai)
#pragma unroll
            for (int m = 0; m < 4; ++m) { const int r = r0 + ai * HALF + m * 16;
                if (r < u.nrows) { bf16_t* rowp = act + (size_t)(u.row0 + r) * 256 + u.nt * 128 + wc * 16 + fq * 4;
#pragma unroll
                    for (int bj = 0; bj < 2; ++bj) { const f32x4 g = acc[ai][bj][m][0], up = acc[ai][bj][m][1];
                        uint2 o; o.x = pack2(g[0] * sigm(g[0]) * up[0], g[1] * sigm(g[1]) * up[1]); o.y = pack2(g[2] * sigm(g[2]) * up[2], g[3] * sigm(g[3]) * up[3]);
                        *(uint2*)(rowp + bj * 64) = o; } } }
    }
};
}

template <class DescF, class EpiF>
__device__ __forceinline__ void stream_gemm128(char* smem, const int nunits, const DescF& desc, const EpiF& epi) {
    constexpr int STAGE = 2 * TILE_BYTES;
    const int tid = tidx(), wave = tid >> 6, lane = tid & 63, fr = lane & 15, fq = lane >> 4;
    const int wm = wave >> 1, wn = wave & 1;
    const int lrow = tid >> 3, lseg = tid & 7, G = gridDim.x;
    if ((int)blockIdx.x >= nunits) return;
    uint4 ra0, ra1, rb0, rb1;
    const char* la = nullptr; const char* lbp = nullptr; unsigned lao0 = 0, lao1 = 0, lbo0 = 0, lbo1 = 0;
    int lu = blockIdx.x, lkt = 0, lnk = 0;
    int cu = blockIdx.x, ckt = 0, cnk = 0;
#define SG_DESC() do { const bf16_t* A_; const bf16_t* B_; int lda_, ldb_; desc(lu, A_, B_, lda_, ldb_, lnk); la = (const char*)A_; lbp = (const char*)B_; \
        lao0 = (unsigned)(lrow * lda_) * 2u + lseg * 16; lao1 = (unsigned)((lrow + 64) * lda_) * 2u + lseg * 16; lbo0 = (unsigned)(lrow * ldb_) * 2u + lseg * 16; lbo1 = (unsigned)((lrow + 64) * ldb_) * 2u + lseg * 16; } while (0)
#define SG_LOAD() do { ra0 = *(const uint4*)(la + (lao0 + lkt * 128)); ra1 = *(const uint4*)(la + (lao1 + lkt * 128)); rb0 = *(const uint4*)(lbp + (lbo0 + lkt * 128)); rb1 = *(const uint4*)(lbp + (lbo1 + lkt * 128)); } while (0)
#define SG_STORE(ST) do { char* As_ = smem + (ST) * STAGE; char* Bs_ = As_ + TILE_BYTES; \
        *(uint4*)(As_ + lrow * TSTR + lseg * 16) = ra0; *(uint4*)(As_ + (lrow + 64) * TSTR + lseg * 16) = ra1; *(uint4*)(Bs_ + lrow * TSTR + lseg * 16) = rb0; *(uint4*)(Bs_ + (lrow + 64) * TSTR + lseg * 16) = rb1; } while (0)
#define SG_ADV() do { if (++lkt == lnk) { lkt = 0; lu += G; if (lu < nunits) SG_DESC(); } } while (0)
    f32x4 acc[2][4];
#pragma unroll
    for (int mi = 0; mi < 2; ++mi)
#pragma unroll
        for (int ni = 0; ni < 4; ++ni) acc[mi][ni] = (f32x4){0.f, 0.f, 0.f, 0.f};
    SG_DESC(); cnk = lnk;
    SG_LOAD(); SG_STORE(0); SG_ADV(); __syncthreads();
    for (int s = 0; cu < nunits; ++s) {
        const bool more = lu < nunits;
        if (more) SG_LOAD();
        const char* As = smem + (s & 1) * STAGE; const char* Bs = As + TILE_BYTES;
#pragma unroll
        for (int ks = 0; ks < 2; ++ks) {
            bf16x8 af[2], bfr[4];
#pragma unroll
            for (int mi = 0; mi < 2; ++mi) af[mi] = *(const bf16x8*)(As + (wm * 32 + mi * 16 + fr) * TSTR + ks * 64 + fq * 16);
#pragma unroll
            for (int ni = 0; ni < 4; ++ni) bfr[ni] = *(const bf16x8*)(Bs + (wn * 64 + ni * 16 + fr) * TSTR + ks * 64 + fq * 16);
#pragma unroll
            for (int mi = 0; mi < 2; ++mi)
#pragma unroll
                for (int ni = 0; ni < 4; ++ni) acc[mi][ni] = __builtin_amdgcn_mfma_f32_16x16x32_bf16(bfr[ni], af[mi], acc[mi][ni], 0, 0, 0);
        }
        if (++ckt == cnk) {
            epi(cu, acc, wm * 32 + fr, wn * 64 + fq * 4);
#pragma unroll
            for (int mi = 0; mi < 2; ++mi)
#pragma unroll
                for (int ni = 0; ni < 4; ++ni) acc[mi][ni] = (f32x4){0.f, 0.f, 0.f, 0.f};
            ckt = 0; cu += G;
            if (cu < nunits) { const bf16_t* A_; const bf16_t* B_; int lda_, ldb_; desc(cu, A_, B_, lda_, ldb_, cnk); }
        }
        if (more) { SG_STORE((s + 1) & 1); SG_ADV(); }
        __syncthreads();
    }
#undef SG_DESC
#undef SG_LOAD
#undef SG_STORE
#undef SG_ADV
}

__device__ __forceinline__ void conv_gu_tiles(const Params& p, char* smem, int w0, int nw, int t_begin, int t_end) {
    const int tid = tidx(), wave = tid >> 6, lane = tid & 63;
    bf16_t* T = (bf16_t*)smem + wave * (2 * 16 * 72);
    for (int tau = t_begin + w0 * 2; tau < t_end; tau += nw * 2) {
        float4 v[2][4];
#pragma unroll
        for (int h = 0; h < 2; ++h) {
            const int tt = tau + h < t_end ? tau + h : tau;
            const int m = tt >> 8, kb = (tt >> 4) & 15, nb = tt & 15, e = m >> 1, sel = m & 1;
            const float* src = (sel ? (e < 256 ? p.exp_w_up + (size_t)e * 262144 : p.sh_w_up) : (e < 256 ? p.exp_w_gate + (size_t)e * 262144 : p.sh_w_gate)) + (size_t)(kb * 64 + lane) * 256 + nb * 16;
#pragma unroll
            for (int i = 0; i < 4; ++i) v[h][i] = *(const float4*)(src + i * 4);
        }
#pragma unroll
        for (int h = 0; h < 2; ++h) {
            if (tau + h >= t_end) break;
            const int tt = tau + h;
            const int m = tt >> 8, kb = (tt >> 4) & 15, nb = tt & 15, e = m >> 1, sel = m & 1;
            bf16_t* Th = T + h * (16 * 72);
#pragma unroll
            for (int i = 0; i < 4; ++i) { Th[(i * 4 + 0) * 72 + lane] = f2bf(v[h][i].x); Th[(i * 4 + 1) * 72 + lane] = f2bf(v[h][i].y); Th[(i * 4 + 2) * 72 + lane] = f2bf(v[h][i].z); Th[(i * 4 + 3) * 72 + lane] = f2bf(v[h][i].w); }
            const int q = lane >> 2, seg = lane & 3;
            const uint4 o0 = *(const uint4*)(Th + q * 72 + seg * 16), o1 = *(const uint4*)(Th + q * 72 + seg * 16 + 8);
            const int rho = (nb >> 3) * 256 + ((nb >> 2) & 1) * 128 + (nb & 3) * 32 + sel * 16 + q;
            bf16_t* d = p.BtW + ((size_t)e * 512 + rho) * 1024 + kb * 64 + seg * 16;
            *(uint4*)d = o0; *(uint4*)(d + 8) = o1;
        }
    }
}

__device__ __forceinline__ void phase0(const Params& p, char* smem) {
    const int tid = tidx(), wave = tid >> 6, lane = tid & 63;
    const int gw = blockIdx.x * 8 + wave, nw = gridDim.x * 8;
    for (int u = gw; u < 1536; u += nw) {
        const int cb = u % 96, ks = u / 96, j = cb * 64 + lane;
        float a0 = 0.f, a1 = 0.f;
#pragma unroll 1
        for (int k0 = ks * 64; k0 < ks * 64 + 64; k0 += 16) {
            float w[16];
#pragma unroll
            for (int i = 0; i < 16; ++i) w[i] = p.w_mod[(size_t)(k0 + i) * 6144 + j];
#pragma unroll
            for (int i = 0; i < 16; ++i) { const float c0 = p.c[k0 + i], c1 = p.c_ctx[k0 + i]; a0 += c0 * sigm(c0) * w[i]; a1 += c1 * sigm(c1) * w[i]; }
        }
        p.modp[(ks * 2 + 0) * 6144 + j] = a0; p.modp[(ks * 2 + 1) * 6144 + j] = a1;
    }
    float* T = (float*)smem;
    int total = 0;
    for (int j = 0; j < NJOB; ++j) total += (p.jobs[j].K >> 6) * (p.jobs[j].N >> 6);
    for (int u = blockIdx.x; u < total; u += gridDim.x) {
        int j = 0, r = u;
        for (;; ++j) { const int n = (p.jobs[j].K >> 6) * (p.jobs[j].N >> 6); if (r < n) break; r -= n; }
        const TJob jb = p.jobs[j];
        const int ntn = jb.N >> 6, kt = r / ntn, nt = r % ntn, k0 = kt * 64, n0 = nt * 64;
        {
            const int kk = tid >> 4, c4 = (tid & 15) * 4;
#pragma unroll
            for (int i = 0; i < 2; ++i) {
                const int k = kk + 32 * i;
                const float4 v = *(const float4*)(jb.src + (size_t)(k0 + k) * jb.N + n0 + c4);
                T[k * 65 + c4 + 0] = v.x; T[k * 65 + c4 + 1] = v.y; T[k * 65 + c4 + 2] = v.z; T[k * 65 + c4 + 3] = v.w;
            }
        }
        __syncthreads();
        {
            const int n = tid >> 3, ks = (tid & 7) * 8;
            float v[8];
#pragma unroll
            for (int q = 0; q < 8; ++q) v[q] = T[(ks + q) * 65 + n];
            const int ng = n0 + n;
            int drow = jb.rowoff + ng;
            if (jb.mode == 2) drow = (ng >> 4) * 32 + (ng & 15) + jb.rowoff;
            uint4 hi; hi.x = pack2(v[0], v[1]); hi.y = pack2(v[2], v[3]); hi.z = pack2(v[4], v[5]); hi.w = pack2(v[6], v[7]);
            bf16_t* d = jb.dst + (size_t)drow * jb.dld + jb.coloff + k0 + ks;
            *(uint4*)d = hi;
            if (jb.mode == 1) {
                float l[8];
#pragma unroll
                for (int q = 0; q < 8; ++q) l[q] = v[q] - bf2f(f2bf(v[q]));
                uint4 lo; lo.x = pack2(l[0], l[1]); lo.y = pack2(l[2], l[3]); lo.z = pack2(l[4], l[5]); lo.w = pack2(l[6], l[7]);
                *(uint4*)(d + 1024) = hi; *(uint4*)(d + 2048) = lo;
            }
        }
        __syncthreads();
    }
}

__device__ __forceinline__ void phase1(const Params& p, char* smem) {
    const int tid = tidx(), wave = tid >> 6, lane = tid & 63;
    float* L = (float*)smem;
    for (int idx = tid; idx < 4096; idx += NT) {
        const int v = idx >> 11, which = (idx >> 10) & 1, col = idx & 1023;
        float s = p.b_mod[which * 1024 + col];
        for (int ks = 0; ks < 16; ++ks) s += p.modp[(ks * 2 + v) * 6144 + which * 1024 + col];
        L[idx] = s;
    }
    for (int idx = blockIdx.x * NT + tid; idx < 2 * 6144; idx += gridDim.x * NT) {
        const int v = idx / 6144, j = idx % 6144;
        float sm = p.b_mod[j];
#pragma unroll
        for (int ks = 0; ks < 16; ++ks) sm += p.modp[(ks * 2 + v) * 6144 + j];
        p.mod[idx] = sm;
    }
    __syncthreads();
    const int gw = blockIdx.x * 8 + wave, nw = gridDim.x * 8;
    for (int r0 = gw; r0 < TE; r0 += 2 * nw) {
        float4 xv[2][4]; float ss[2];
#pragma unroll
        for (int h = 0; h < 2; ++h) {
            const int r = r0 + h * nw < TE ? r0 + h * nw : r0;
            const float* src = r < 256 ? p.ctx + (size_t)r * 1024 : p.x + (size_t)(r - 256) * 1024;
            ss[h] = 0.f;
#pragma unroll
            for (int i = 0; i < 4; ++i) { xv[h][i] = *(const float4*)(src + i * 256 + lane * 4); ss[h] += xv[h][i].x * xv[h][i].x + xv[h][i].y * xv[h][i].y + xv[h][i].z * xv[h][i].z + xv[h][i].w * xv[h][i].w; }
        }
#pragma unroll
        for (int h = 0; h < 2; ++h) {
            const int r = r0 + h * nw;
            if (r >= TE) break;
            const int v = r < 256 ? 1 : 0;
            const float rs = rsqrtf(wsum(ss[h]) * (1.f / 1024.f) + 1e-6f);
#pragma unroll
            for (int i = 0; i < 4; ++i) {
                const int col = i * 256 + lane * 4;
                const float4 g = *(const float4*)(p.n_pre_mix + col);
                const float* sh = L + v * 2048 + col; const float* sc = L + v * 2048 + 1024 + col;
                const float y0 = xv[h][i].x * rs * g.x * (1.f + sc[0]) + sh[0];
                const float y1 = xv[h][i].y * rs * g.y * (1.f + sc[1]) + sh[1];
                const float y2 = xv[h][i].z * rs * g.z * (1.f + sc[2]) + sh[2];
                const float y3 = xv[h][i].w * rs * g.w * (1.f + sc[3]) + sh[3];
                uint2 o; o.x = pack2(y0, y1); o.y = pack2(y2, y3);
                *(uint2*)(p.hn + (size_t)r * 1024 + col) = o;
            }
        }
    }
}

__device__ __forceinline__ void phase2(const Params& p, char* smem) {
    g8::StaticOrder S; S.init(TE, INC, gridDim.x, blockIdx.x);
    g8::EpiBf16 E{p.proj, INC};
    g8::gemm_phase((LAS unsigned char*)smem, p.hn, p.WinT, 1024, 1024, 1024, S, E);
}

__device__ __forceinline__ void phase3(const Params& p, char* smem) {
    const int tid = tidx(), wave = tid >> 6, lane = tid & 63;
    const int gw = blockIdx.x * 8 + wave, nw = gridDim.x * 8;
    float mu0[3][8], mu1[3][8], kkw[8], lm0[4], lm1[4];
#pragma unroll
    for (int a = 0; a < 3; ++a)
#pragma unroll
        for (int q = 0; q < 8; ++q) { mu0[a][q] = p.shift_mu[a * 512 + lane * 8 + q]; mu1[a][q] = p.shift_mu[1792 + a * 512 + lane * 8 + q]; }
#pragma unroll
    for (int q = 0; q < 8; ++q) kkw[q] = p.rwkv_k_k[lane * 8 + q];
#pragma unroll
    for (int q = 0; q < 4; ++q) { lm0[q] = p.shift_mu[1536 + lane * 4 + q]; lm1[q] = p.shift_mu[1792 + 1536 + lane * 4 + q]; }
    for (int t = gw; t < TE; t += nw) {
        const bool hp = (t != 0 && t != 256), hn_ = (t != 255 && t != TE - 1);
        const bf16_t* pr = p.proj + (size_t)t * INC;
        uint4 q0[3], qm[3], qn[3]; uint2 l0, lm = make_uint2(0, 0), ln = make_uint2(0, 0);
#pragma unroll
        for (int a = 0; a < 3; ++a) {
            q0[a] = *(const uint4*)(pr + a * 512 + lane * 8);
            qm[a] = hp ? *(const uint4*)(pr + a * 512 + lane * 8 - INC) : make_uint4(0, 0, 0, 0);
            qn[a] = hn_ ? *(const uint4*)(pr + a * 512 + lane * 8 + INC) : make_uint4(0, 0, 0, 0);
        }
        l0 = *(const uint2*)(pr + 1536 + lane * 4);
        if (hp) lm = *(const uint2*)(pr + 1536 + lane * 4 - INC);
        if (hn_) ln = *(const uint2*)(pr + 1536 + lane * 4 + INC);
        float val[3][8];
#pragma unroll
        for (int a = 0; a < 3; ++a) {
            float f0[8], fm[8], fn[8]; unpack8(q0[a], f0); unpack8(qm[a], fm); unpack8(qn[a], fn);
#pragma unroll
            for (int q = 0; q < 8; ++q) val[a][q] = f0[q] + mu0[a][q] * (fm[q] - f0[q]) + mu1[a][q] * (fn[q] - f0[q]);
        }
        float kkv[8], n2 = 0.f;
#pragma unroll
        for (int q = 0; q < 8; ++q) { kkv[q] = val[1][q] * kkw[q]; n2 += kkv[q] * kkv[q]; }
        n2 += __shfl_xor(n2, 1, 64); n2 += __shfl_xor(n2, 2, 64); n2 += __shfl_xor(n2, 4, 64);
        const float inv = -1.f / fmaxf(sqrtf(n2), 1e-12f);
#pragma unroll
        for (int q = 0; q < 8; ++q) kkv[q] *= inv;
        const size_t o = (size_t)t * 512 + lane * 8;
        *(uint4*)(p.Rr + o) = pack8(val[0]); *(uint4*)(p.Kk + o) = pack8(val[1]); *(uint4*)(p.Vv + o) = pack8(val[2]); *(uint4*)(p.Aa + o) = pack8(kkv);
        {
            float v[4];
            const unsigned w0[2] = {l0.x, l0.y}, wm[2] = {lm.x, lm.y}, wn[2] = {ln.x, ln.y};
#pragma unroll
            for (int q = 0; q < 4; ++q) {
                const float p0 = (q & 1) ? __uint_as_float(w0[q >> 1] & 0xffff0000u) : __uint_as_float(w0[q >> 1] << 16);
                const float pm = (q & 1) ? __uint_as_float(wm[q >> 1] & 0xffff0000u) : __uint_as_float(wm[q >> 1] << 16);
                const float pn = (q & 1) ? __uint_as_float(wn[q >> 1] & 0xffff0000u) : __uint_as_float(wn[q >> 1] << 16);
                v[q] = p0 + lm0[q] * (pm - p0) + lm1[q] * (pn - p0);
            }
            if (lane < 16) {
                uint2 ov; ov.x = pack2(tanhf(v[0]), tanhf(v[1])); ov.y = pack2(tanhf(v[2]), tanhf(v[3]));
                *(uint2*)(p.TW + (size_t)t * 64 + lane * 4) = ov;
            } else if (lane < 32) {
                uint2 ov; ov.x = pack2(v[0], v[1]); ov.y = pack2(v[2], v[3]);
                *(uint2*)(p.XA + (size_t)t * 64 + (lane - 16) * 4) = ov;
            } else {
                uint2 ov; ov.x = pack2(sigm(v[0]), sigm(v[1])); ov.y = pack2(sigm(v[2]), sigm(v[3]));
                *(uint2*)(p.SG + (size_t)t * 128 + (lane - 32) * 4) = ov;
            }
        }
    }
}

__device__ __forceinline__ void phase4(const Params& p, char* smem) {
    stream_gemm128(smem, 130 * 20,
        [&](int u, const bf16_t*& A, const bf16_t*& B, int& lda, int& ldb, int& nk) {
            const int mt = u / 20, q = u % 20;
            if (q < 8) { A = p.TW + (size_t)mt * 128 * 64; B = p.WupT + (size_t)q * 128 * 64; lda = 64; ldb = 64; nk = 1; }
            else if (q < 16) { A = p.XA + (size_t)mt * 128 * 64; B = p.AupT + (size_t)(q - 8) * 128 * 64; lda = 64; ldb = 64; nk = 1; }
            else { A = p.SG + (size_t)mt * 128 * 128; B = p.GupT + (size_t)(q - 16) * 128 * 128; lda = 128; ldb = 128; nk = 2; }
        },
        [&](int u, const f32x4 (&acc)[2][4], int r0, int c0) {
            const int mt = u / 20, q = u % 20;
            if (q < 8) {
#pragma unroll
                for (int mi = 0; mi < 2; ++mi)
#pragma unroll
                    for (int ni = 0; ni < 4; ++ni) {
                        const int t = mt * 128 + r0 + mi * 16, cc = q * 128 + c0 + ni * 16, d = cc >> 9, c = cc & 511;
                        float4 o; float* op = (float*)&o;
#pragma unroll
                        for (int j = 0; j < 4; ++j) { const float z = p.rwkv_w0[d * 512 + c + j] + acc[mi][ni][j]; op[j] = __expf(-0.60653066f * sigm(z)); }
                        *(float4*)(p.Wd + ((size_t)d * TE + t) * 512 + c) = o;
                    }
            } else if (q < 16) {
                const int qq = q - 8;
#pragma unroll
                for (int mi = 0; mi < 2; ++mi)
#pragma unroll
                    for (int ni = 0; ni < 4; ++ni) {
                        const int t = mt * 128 + r0 + mi * 16, cc = qq * 128 + c0 + ni * 16, d = cc >> 9, c = cc & 511;
                        const uint2 av = *(const uint2*)(p.Aa + (size_t)t * 512 + c), kv = *(const uint2*)(p.Kk + (size_t)t * 512 + c);
                        const bf16_t* ae = (const bf16_t*)&av; const bf16_t* ke = (const bf16_t*)&kv;
                        float bo[4], ko[4];
#pragma unroll
                        for (int j = 0; j < 4; ++j) {
                            const float ad = sigm(p.rwkv_a0[d * 512 + c + j] + acc[mi][ni][j]);
                            bo[j] = -bf2f(ae[j]) * ad;
                            ko[j] = bf2f(ke[j]) * (1.f + (ad - 1.f) * p.rwkv_k_a[c + j]);
                        }
                        uint2 o1, o2; o1.x = pack2(bo[0], bo[1]); o1.y = pack2(bo[2], bo[3]); o2.x = pack2(ko[0], ko[1]); o2.y = pack2(ko[2], ko[3]);
                        *(uint2*)(p.Bd + ((size_t)d * TE + t) * 512 + c) = o1;
                        *(uint2*)(p.KD + ((size_t)d * TE + t) * 512 + c) = o2;
                    }
            } else {
                const int qq = q - 16;
#pragma unroll
                for (int mi = 0; mi < 2; ++mi)
#pragma unroll
                    for (int ni = 0; ni < 4; ++ni) {
                        const int t = mt * 128 + r0 + mi * 16, c = qq * 128 + c0 + ni * 16;
                        uint2 o; o.x = pack2(acc[mi][ni][0], acc[mi][ni][1]); o.y = pack2(acc[mi][ni][2], acc[mi][ni][3]);
                        *(uint2*)(p.G + (size_t)t * 512 + c) = o;
                    }
            }
        });
}

__device__ __forceinline__ void phase5(const Params& p, char* smem) {
    const int tid = tidx(), wave = __builtin_amdgcn_readfirstlane(tid >> 6), lane = tid & 63;
    constexpr int SB = 5, NA = 6, NSB = RL / SB;
    float* L = (float*)(smem + wave * (2 * SB * NA * 64 * 4 + 16 * 72 * 2));
    bf16_t* CT = (bf16_t*)(L + 2 * SB * NA * 64);
    for (int q = blockIdx.x * 8 + wave; q < RNC * 16; q += gridDim.x * 8) {
        const int j = q >> 4, hd = q & 15, dir = hd >> 3, h = hd & 7;
        const float* gW = p.Wd + (size_t)dir * TE * 512; const bf16_t* gB = p.Bd + (size_t)dir * TE * 512; const bf16_t* gK = p.KD + (size_t)dir * TE * 512;
        const bf16_t* gA = p.Aa; const bf16_t* gV = p.Vv; const bf16_t* gR = p.Rr;
        const unsigned lofs = (unsigned)(h * 64 + lane);
        bf16_t* gZ = p.Zz + (size_t)q * (RL * 64) + lane; bf16_t* gY = p.YH + (size_t)q * (RL * 64) + lane;
        f32x2 sP[32], sH[32];
        int ln = lane; asm volatile("" : "+v"(ln));
#pragma unroll
        for (int k = 0; k < 32; ++k) { sP[k] = (f32x2){(2 * k == ln) ? 1.f : 0.f, (2 * k + 1 == ln) ? 1.f : 0.f}; sH[k] = (f32x2){0.f, 0.f}; }
        for (int sb = 0; sb < NSB; ++sb) {
            {
                float st[SB][NA];
#pragma unroll
                for (int i = 0; i < SB; ++i) {
                    const unsigned g = (unsigned)row_of(dir, j * RL + sb * SB + i) * 512u + lofs;
                    st[i][0] = gW[g]; st[i][1] = bf2f(gA[g]); st[i][2] = bf2f(gB[g]); st[i][3] = bf2f(gK[g]); st[i][4] = bf2f(gV[g]); st[i][5] = bf2f(gR[g]);
                }
                float* d = L + (sb & 1) * (SB * NA * 64) + lane;
#pragma unroll
                for (int i = 0; i < SB; ++i)
#pragma unroll
                    for (int a = 0; a < NA; ++a) d[(i * NA + a) * 64] = st[i][a];
            }
            const float* Lb = L + (sb & 1) * (SB * NA * 64);
            float4 cv[3][4]; const int ctau = q * 65 + sb * 3;
#pragma unroll
            for (int h = 0; h < 3; ++h) {
                int tt = ctau + h; if (sb * 3 + h >= 65 || tt >= 514 * 256) tt = 0;
                const int m = tt >> 8, kb = (tt >> 4) & 15, nb = tt & 15, e = m >> 1, sel = m & 1;
                const float* src = (sel ? (e < 256 ? p.exp_w_up + (size_t)e * 262144 : p.sh_w_up) : (e < 256 ? p.exp_w_gate + (size_t)e * 262144 : p.sh_w_gate)) + (size_t)(kb * 64 + lane) * 256 + nb * 16;
#pragma unroll
                for (int i = 0; i < 4; ++i) cv[h][i] = *(const float4*)(src + i * 4);
            }
#pragma unroll 1
            for (int i = 0; i < SB; ++i) {
                const float* W = Lb + (i * NA) * 64; const float* A = W + 64; const float* B = W + 128; const float* KDv = W + 192; const float* R = W + 320;
                const float vl = W[256 + lane];
                f32x2 dh0 = {0.f, 0.f}, dh1 = {0.f, 0.f}, dp0 = {0.f, 0.f}, dp1 = {0.f, 0.f};
                f32x4 rw[2], rb[2], rk[2], rr[2];
                rw[0] = *(const f32x4*)(W); rb[0] = *(const f32x4*)(B); rk[0] = *(const f32x4*)(KDv); rr[0] = *(const f32x4*)(R);
#pragma unroll
                for (int c = 0; c < 4; ++c) {
                    const f32x4 ac0 = *(const f32x4*)(A + c * 16), ac1 = *(const f32x4*)(A + c * 16 + 4), ac2 = *(const f32x4*)(A + c * 16 + 8), ac3 = *(const f32x4*)(A + c * 16 + 12);
                    const int k = c * 8;
                    dh0 += sH[k] * ac0.lo; dh1 += sH[k + 1] * ac0.hi; dp0 += sP[k] * ac0.lo; dp1 += sP[k + 1] * ac0.hi;
                    dh0 += sH[k + 2] * ac1.lo; dh1 += sH[k + 3] * ac1.hi; dp0 += sP[k + 2] * ac1.lo; dp1 += sP[k + 3] * ac1.hi;
                    dh0 += sH[k + 4] * ac2.lo; dh1 += sH[k + 5] * ac2.hi; dp0 += sP[k + 4] * ac2.lo; dp1 += sP[k + 5] * ac2.hi;
                    dh0 += sH[k + 6] * ac3.lo; dh1 += sH[k + 7] * ac3.hi; dp0 += sP[k + 6] * ac3.lo; dp1 += sP[k + 7] * ac3.hi;
                    __builtin_amdgcn_sched_barrier(0);
                }
                const float saHs = (dh0.x + dh0.y) + (dh1.x + dh1.y), saPs = (dp0.x + dp0.y) + (dp1.x + dp1.y);
                const f32x2 saH = {saHs, saHs}, saP = {saPs, saPs}, vl2 = {vl, vl};
                f32x2 y0 = {0.f, 0.f}, y1 = {0.f, 0.f}, z0 = {0.f, 0.f}, z1 = {0.f, 0.f};
#pragma unroll
                for (int g = 0; g < 16; ++g) {
                    if (g + 1 < 16) { rw[(g + 1) & 1] = *(const f32x4*)(W + 4 * g + 4); rb[(g + 1) & 1] = *(const f32x4*)(B + 4 * g + 4); rk[(g + 1) & 1] = *(const f32x4*)(KDv + 4 * g + 4); rr[(g + 1) & 1] = *(const f32x4*)(R + 4 * g + 4); }
                    const f32x4 cw = rw[g & 1], cb = rb[g & 1], ck = rk[g & 1], cr = rr[g & 1];
                    const int k = 2 * g;
                    sH[k]     = sH[k]     * cw.lo + (saH * cb.lo + vl2 * ck.lo);
                    sH[k + 1] = sH[k + 1] * cw.hi + (saH * cb.hi + vl2 * ck.hi);
                    sP[k]     = sP[k]     * cw.lo + saP * cb.lo;
                    sP[k + 1] = sP[k + 1] * cw.hi + saP * cb.hi;
                    y0 += sH[k] * cr.lo; y1 += sH[k + 1] * cr.hi;
                    z0 += sP[k] * cr.lo; z1 += sP[k + 1] * cr.hi;
                    __builtin_amdgcn_sched_barrier(0);
                }
                const int t = sb * SB + i;
                gZ[t * 64] = f2bf((z0.x + z0.y) + (z1.x + z1.y)); gY[t * 64] = f2bf((y0.x + y0.y) + (y1.x + y1.y));
            }
#pragma unroll
            for (int h = 0; h < 3; ++h) {
                const int tt = ctau + h;
                if (sb * 3 + h < 65 && tt < 514 * 256) {
                    const int m = tt >> 8, kb = (tt >> 4) & 15, nb = tt & 15, e = m >> 1, sel = m & 1;
#pragma unroll
                    for (int i = 0; i < 4; ++i) {
                        const unsigned p01 = pack2(cv[h][i].x, cv[h][i].y), p23 = pack2(cv[h][i].z, cv[h][i].w);
                        CT[(i * 4 + 0) * 72 + lane] = (bf16_t)(p01 & 0xffffu); CT[(i * 4 + 1) * 72 + lane] = (bf16_t)(p01 >> 16);
                        CT[(i * 4 + 2) * 72 + lane] = (bf16_t)(p23 & 0xffffu); CT[(i * 4 + 3) * 72 + lane] = (bf16_t)(p23 >> 16);
                    }
                    const int cq = lane >> 2, seg = lane & 3;
                    const uint4 o0 = *(const uint4*)(CT + cq * 72 + seg * 16), o1 = *(const uint4*)(CT + cq * 72 + seg * 16 + 8);
                    const int rho = (nb >> 3) * 256 + ((nb >> 2) & 1) * 128 + (nb & 3) * 32 + sel * 16 + cq;
                    bf16_t* d = p.BtW + ((size_t)e * 512 + rho) * 1024 + kb * 64 + seg * 16;
                    *(uint4*)d = o0; *(uint4*)(d + 8) = o1;
                }
            }
        }
        if (j < RNC - 1) {
            float* dP = p.PH + (((size_t)(j * 16 + hd) * 2 + 0) * 64 + lane) * 64;
            float* dH = p.PH + (((size_t)(j * 16 + hd) * 2 + 1) * 64 + lane) * 64;
#pragma unroll
            for (int k = 0; k < 32; k += 2) { *(float4*)(dP + 2 * k) = make_float4(sP[k].x, sP[k].y, sP[k + 1].x, sP[k + 1].y); *(float4*)(dH + 2 * k) = make_float4(sH[k].x, sH[k].y, sH[k + 1].x, sH[k + 1].y); }
        }
    }
}

__device__ __forceinline__ void phase6(const Params& p, char* smem) {
    const int tid = threadIdx.x, wave = __builtin_amdgcn_readfirstlane(tid >> 6), lane = tid & 63;
    if (blockIdx.x >= 256) return;
    const int hd = blockIdx.x >> 4, rb0 = (blockIdx.x & 15) * 4, r0 = rb0 + (wave & 3);
    LAS unsigned char* lds = (LAS unsigned char*)smem;
    constexpr int SLOT = 17408, NJ = RNC - 1;
    const char* pbase = (const char*)(p.PH + (size_t)hd * 2 * 4096);
    float s0 = 0.f;
#define CH_ISSUE(J) do { const char* src_ = pbase + (size_t)(J) * 524288; const unsigned so_ = (unsigned)(((J) & 7) * SLOT); \
        _Pragma("unroll") for (int q_ = 0; q_ < 4; ++q_) __builtin_amdgcn_global_load_lds((const unsigned*)(src_ + ((wave - 4) * 4 + q_) * 1024 + lane * 16), (LAS unsigned*)(lds + so_ + ((wave - 4) * 4 + q_) * 1024), 16, 0, 0); \
        if (wave == 7) __builtin_amdgcn_global_load_lds((const unsigned*)(src_ + 16384 + rb0 * 256 + lane * 16), (LAS unsigned*)(lds + so_ + 16384), 16, 0, 0); } while (0)
    if (wave >= 4) { CH_ISSUE(0); CH_ISSUE(1); CH_ISSUE(2); CH_ISSUE(3); CH_ISSUE(4); CH_ISSUE(5); CH_ISSUE(6); }
    for (int j = 0; j < RNC; ++j) {
        if (wave < 4) p.Sst[((size_t)(j * 16 + hd) * 64 + r0) * 64 + lane] = s0;
        if (j == NJ) break;
        if (wave >= 4) {
            if (j + 6 >= NJ) asm volatile("s_waitcnt vmcnt(0)" ::: "memory");
            else if (wave == 7) asm volatile("s_waitcnt vmcnt(30)" ::: "memory");
            else asm volatile("s_waitcnt vmcnt(24)" ::: "memory");
        }
        asm volatile("s_waitcnt lgkmcnt(0)" ::: "memory"); __builtin_amdgcn_s_barrier(); asm volatile("" ::: "memory");
        if (wave >= 4) { if (j + 7 < NJ) CH_ISSUE(j + 7); }
        else {
            const float* Pc = (const float*)(smem + (j & 7) * SLOT);
            f32x2 n0 = {Pc[4096 + wave * 64 + lane], 0.f}, n1 = {0.f, 0.f};
#pragma unroll
            for (int k = 0; k < 64; k += 4) {
                const f32x2 a0 = {__int_as_float(__builtin_amdgcn_readlane(__float_as_int(s0), k)), __int_as_float(__builtin_amdgcn_readlane(__float_as_int(s0), k + 1))};
                const f32x2 a1 = {__int_as_float(__builtin_amdgcn_readlane(__float_as_int(s0), k + 2)), __int_as_float(__builtin_amdgcn_readlane(__float_as_int(s0), k + 3))};
                const f32x2 p0 = {Pc[k * 64 + lane], Pc[(k + 1) * 64 + lane]}, p1 = {Pc[(k + 2) * 64 + lane], Pc[(k + 3) * 64 + lane]};
                n0 += a0 * p0; n1 += a1 * p1;
            }
            s0 = (n0.x + n0.y) + (n1.x + n1.y);
        }
    }
#undef CH_ISSUE
    __syncthreads();
}

__device__ __forceinline__ void phase7(const Params& p, char* smem) {
    const int tid = tidx(), wave = __builtin_amdgcn_readfirstlane(tid >> 6), lane = tid & 63;
    constexpr int SB = 10, NSB = RL / SB;
    float* L = (float*)smem + wave * (SB * 64);
    for (int q = 16 + blockIdx.x * 8 + wave; q < RNC * 16; q += gridDim.x * 8) {
        const int j = q >> 4, hd = q & 15, dir = hd >> 3, h = hd & 7;
        f32x2 s[32];
        {
            const float* src = p.Sst + ((size_t)(j * 16 + hd) * 64 + lane) * 64;
#pragma unroll
            for (int k = 0; k < 32; k += 2) { const f32x4 v = *(const f32x4*)(src + 2 * k); s[k] = v.lo; s[k + 1] = v.hi; }
        }
        const bf16_t* gZ = p.Zz + (size_t)q * (RL * 64) + lane; const bf16_t* gY = p.YH + (size_t)q * (RL * 64) + lane;
        bf16_t* gO = p.O + (size_t)dir * TX * 512 + h * 64 + lane;
        float zz[SB], yy[SB];
#pragma unroll
        for (int i = 0; i < SB; ++i) { zz[i] = bf2f(gZ[i * 64]); yy[i] = bf2f(gY[i * 64]); }
        for (int sb = 0; sb < NSB; ++sb) {
            float yc[SB];
#pragma unroll
            for (int i = 0; i < SB; ++i) { L[i * 64 + lane] = zz[i]; yc[i] = yy[i]; }
            { const int nsb = sb + 1 < NSB ? sb + 1 : sb;
#pragma unroll
              for (int i = 0; i < SB; ++i) { zz[i] = bf2f(gZ[(nsb * SB + i) * 64]); yy[i] = bf2f(gY[(nsb * SB + i) * 64]); } }
#pragma unroll
            for (int i = 0; i < SB; ++i) {
                const float* Z = L + i * 64;
                f32x2 y0 = {yc[i], 0.f}, y1 = {0.f, 0.f};
#pragma unroll
                for (int k = 0; k < 32; k += 2) { const f32x4 z = *(const f32x4*)(Z + 2 * k); y0 += s[k] * z.lo; y1 += s[k + 1] * z.hi; }
                const int row = row_of(dir, j * RL + sb * SB + i);
                if (row >= 256) gO[(size_t)(row - 256) * 512] = f2bf((y0.x + y0.y) + (y1.x + y1.y));
            }
        }
    }
}

__device__ __forceinline__ void phase8(const Params& p, char* smem) {
    const int tid = tidx();
    bf16_t* LT = (bf16_t*)smem;
    constexpr int LTS = 136;
    for (int u = blockIdx.x; u < NCH * 4; u += gridDim.x) {
        const int c = u < 512 ? 2 + (u >> 2) : ((u - 512) >> 2), hh = u & 3;
        const int upart = c >= 2 ? 2 : 3;
        const float g0 = sigm(p.ret_decay_logit[hh]), g1 = sigm(p.ret_decay_logit[4 + hh]);
        const float l0 = log2f(g0), l1 = log2f(g1);
        const int n = tid >> 2, part = tid & 3, half = part >> 1, fb = (part & 1) * 16;
        const int t = c * 128 + n;
        const bool lat = c >= 2;
        float pos = 0.f;
        if (lat) { const int tl = t - 256; pos = (float)(half == 0 ? (tl >> 6) : (tl & 63)); }
        const bf16_t* pr = p.proj + (size_t)t * INC;
        float cs[16], sn[16];
#pragma unroll
        for (int f = 0; f < 16; ++f) {
            if (lat) { const float inv = exp2f(-(float)(fb + f) * (13.287712379549449f / 32.f)); sincosf(pos * inv, &sn[f], &cs[f]); }
            else { cs[f] = 1.f; sn[f] = 0.f; }
        }
        const size_t ch = (size_t)(c * 4 + hh);
        if (upart == 2) {
            const int cb = 1792 + hh * 128 + half * 64 + fb;
            uint4 v1a = *(const uint4*)(pr + cb), v1b = *(const uint4*)(pr + cb + 8), v2a = *(const uint4*)(pr + cb + 32), v2b = *(const uint4*)(pr + cb + 40);
            bf16_t x1[16], x2[16];
            *(uint4*)&x1[0] = v1a; *(uint4*)&x1[8] = v1b; *(uint4*)&x2[0] = v2a; *(uint4*)&x2[8] = v2b;
            float o1[16], o2[16];
#pragma unroll
            for (int f = 0; f < 16; ++f) { const float a = bf2f(x1[f]), b = bf2f(x2[f]); o1[f] = a * cs[f] - b * sn[f]; o2[f] = a * sn[f] + b * cs[f]; }
            const float xf = exp2f(l0 * (float)(n + 1)), xb = exp2f(l1 * (float)(128 - n));
            bf16_t* qd = p.Qr + (ch * 128 + n) * 128 + half * 64 + fb;
            bf16_t* ad = p.A3 + (ch * 128 + n) * 384 + 128 + half * 64 + fb;
#pragma unroll
            for (int f = 0; f < 16; f += 2) {
                *(unsigned*)(qd + f) = pack2(o1[f], o1[f + 1]); *(unsigned*)(qd + 32 + f) = pack2(o2[f], o2[f + 1]);
                *(unsigned*)(ad + f) = pack2(o1[f] * xf, o1[f + 1] * xf); *(unsigned*)(ad + 32 + f) = pack2(o2[f] * xf, o2[f + 1] * xf);
                *(unsigned*)(ad + 128 + f) = pack2(o1[f] * xb, o1[f + 1] * xb); *(unsigned*)(ad + 128 + 32 + f) = pack2(o2[f] * xb, o2[f + 1] * xb);
            }
        }
        if (upart != 1) {
            const int cb = 2304 + hh * 128 + half * 64 + fb;
            uint4 v1a = *(const uint4*)(pr + cb), v1b = *(const uint4*)(pr + cb + 8), v2a = *(const uint4*)(pr + cb + 32), v2b = *(const uint4*)(pr + cb + 40);
            bf16_t x1[16], x2[16];
            *(uint4*)&x1[0] = v1a; *(uint4*)&x1[8] = v1b; *(uint4*)&x2[0] = v2a; *(uint4*)&x2[8] = v2b;
            const float sc = 0.08838834764831845f;
            bf16_t* kd = p.Kr + (ch * 128 + n) * 128 + half * 64 + fb;
            __syncthreads();
#pragma unroll
            for (int f = 0; f < 16; ++f) {
                const float a = bf2f(x1[f]) * sc, b = bf2f(x2[f]) * sc;
                const float o1 = a * cs[f] - b * sn[f], o2 = a * sn[f] + b * cs[f];
                const bf16_t h1 = f2bf(o1), h2 = f2bf(o2);
                kd[f] = h1; kd[32 + f] = h2;
                LT[(half * 64 + fb + f) * LTS + n] = h1; LT[(half * 64 + fb + f + 32) * LTS + n] = h2;
            }
            __syncthreads();
            const int d = tid >> 2, ms = (tid & 3) * 32;
#pragma unroll
            for (int dir = 0; dir < 2; ++dir) {
                bf16_t* od = p.KTz + ((ch * 2 + dir) * 128 + d) * 128 + ms;
#pragma unroll
                for (int m = 0; m < 32; m += 2) {
                    const int mm = ms + m;
                    const float z0 = dir == 0 ? exp2f(l0 * (float)(127 - mm)) : exp2f(l1 * (float)mm);
                    const float z1 = dir == 0 ? exp2f(l0 * (float)(126 - mm)) : exp2f(l1 * (float)(mm + 1));
                    *(unsigned*)(od + m) = pack2(bf2f(LT[d * LTS + mm]) * z0, bf2f(LT[d * LTS + mm + 1]) * z1);
                }
            }
        }
#pragma unroll 1
        for (int eh = (upart != 0 ? 0 : 2); eh < 2; ++eh) {
            __syncthreads();
            const int cb = 2816 + hh * 256 + eh * 128 + part * 32;
            bf16_t xv[32];
#pragma unroll
            for (int q = 0; q < 4; ++q) *(uint4*)&xv[q * 8] = *(const uint4*)(pr + cb + q * 8);
#pragma unroll
            for (int f = 0; f < 32; ++f) LT[(part * 32 + f) * LTS + n] = xv[f];
            __syncthreads();
            const int e = tid >> 2, ms = (tid & 3) * 32;
            bf16_t* od = p.B3 + (ch * 256 + eh * 128 + e) * 384 + ms;
#pragma unroll
            for (int m = 0; m < 32; m += 8) *(uint4*)(od + m) = *(const uint4*)(LT + e * LTS + ms + m);
        }
        __syncthreads();
    }
}

__device__ __forceinline__ void phase9(const Params& p, char* smem) {
    stream_gemm128(smem, 512 + 2080,
        [&](int u, const bf16_t*& A, const bf16_t*& B, int& lda, int& ldb, int& nk) {
            if (u < 512) { const size_t ch = (size_t)((2 + (u >> 2)) * 4 + (u & 3)); A = p.Qr + ch * 128 * 128; B = p.Kr + ch * 128 * 128; lda = 128; ldb = 128; nk = 2; }
            else { const int v = u - 512, mt = v & 1, dir = (v >> 1) & 1, chh = v >> 2; A = p.B3 + ((size_t)chh * 256 + mt * 128) * 384; B = p.KTz + ((size_t)chh * 2 + dir) * 128 * 128; lda = 384; ldb = 128; nk = 2; }
        },
        [&](int u, const f32x4 (&acc)[2][4], int r0, int c0) {
            if (u < 512) {
                const int hh = u & 3; const size_t ch = (size_t)((2 + (u >> 2)) * 4 + hh);
                const float l0 = log2f(sigm(p.ret_decay_logit[hh])), l1 = log2f(sigm(p.ret_decay_logit[4 + hh]));
                bf16_t* outp = p.A3 + ch * 128 * 384;
#pragma unroll
                for (int mi = 0; mi < 2; ++mi)
#pragma unroll
                    for (int ni = 0; ni < 4; ++ni) {
                        const int n = r0 + mi * 16, m0 = c0 + ni * 16;
                        float o[4];
#pragma unroll
                        for (int j = 0; j < 4; ++j) {
                            const int m = m0 + j;
                            float w = 0.f;
                            if (n >= m) w += exp2f(l0 * (float)(n - m));
                            if (m >= n) w += exp2f(l1 * (float)(m - n));
                            o[j] = acc[mi][ni][j] * w;
                        }
                        uint2 ov; ov.x = pack2(o[0], o[1]); ov.y = pack2(o[2], o[3]);
                        *(uint2*)(outp + (size_t)n * 384 + m0) = ov;
                    }
            } else {
                const int v = u - 512, mt = v & 1, dir = (v >> 1) & 1, chh = v >> 2;
                bf16_t* outp = p.KVT + (((size_t)chh * 2 + dir) * 256 + mt * 128) * 128;
#pragma unroll
                for (int mi = 0; mi < 2; ++mi)
#pragma unroll
                    for (int ni = 0; ni < 4; ++ni) { uint2 o; o.x = pack2(acc[mi][ni][0], acc[mi][ni][1]); o.y = pack2(acc[mi][ni][2], acc[mi][ni][3]);
                        *(uint2*)(outp + (size_t)(r0 + mi * 16) * 128 + c0 + ni * 16) = o; }
            }
        });
}

__device__ __forceinline__ void phase10(const Params& p, char* smem) {
    for (int idx = blockIdx.x * NT + tidx(); idx < 131072; idx += gridDim.x * NT) {
        const int hh = idx >> 15, dir = (idx >> 14) & 1, e = (idx >> 6) & 255, d = (idx & 63) * 2;
        const float g = sigm(p.ret_decay_logit[dir * 4 + hh]);
        const float g128 = exp2f(128.f * log2f(g));
        float R0 = 0.f, R1 = 0.f;
        const bf16_t* kvb = p.KVT + ((size_t)(hh * 2 + dir) * 256 + e) * 128 + d;
        bf16_t* rtb = p.B3 + ((size_t)hh * 256 + e) * 384 + 128 + dir * 128 + d;
        for (int s0 = 0; s0 < NCH; s0 += 13) {
            unsigned kv[13];
#pragma unroll
            for (int i = 0; i < 13; ++i) { const int sc = s0 + i, c = dir == 0 ? sc : (sc < 2 ? 1 - sc : 131 - sc); kv[i] = *(const unsigned*)(kvb + (size_t)c * 262144); }
#pragma unroll
            for (int i = 0; i < 13; ++i) {
                const int sc = s0 + i, c = dir == 0 ? sc : (sc < 2 ? 1 - sc : 131 - sc);
                if (c >= 2) *(unsigned*)(rtb + (size_t)c * 393216) = pack2(R0, R1);
                R0 = g128 * R0 + __uint_as_float(kv[i] << 16); R1 = g128 * R1 + __uint_as_float(kv[i] & 0xffff0000u);
            }
        }
    }
}

__device__ __forceinline__ void phase11(const Params& p, char* smem) {
    stream_gemm128(smem, 1024,
        [&](int u, const bf16_t*& A, const bf16_t*& B, int& lda, int& ldb, int& nk) {
            const int nt = u & 1, chh = 8 + (u >> 1);
            A = p.A3 + (size_t)chh * 128 * 384; B = p.B3 + ((size_t)chh * 256 + nt * 128) * 384; lda = 384; ldb = 384; nk = 6;
        },
        [&](int u, const f32x4 (&acc)[2][4], int r0, int c0) {
            const int nt = u & 1, chh = 8 + (u >> 1), c = chh >> 2, hh = chh & 3;
            float* outp = p.Y + (size_t)((c - 2) * 128) * 1024 + hh * 256 + nt * 128;
#pragma unroll
            for (int mi = 0; mi < 2; ++mi)
#pragma unroll
                for (int ni = 0; ni < 4; ++ni) *(f32x4*)(outp + (size_t)(r0 + mi * 16) * 1024 + c0 + ni * 16) = acc[mi][ni];
        });
}

__device__ __forceinline__ void phase12(const Params& p, char* smem) {
    const int tid = tidx(), wave = tid >> 6, lane = tid & 63;
    const int gw = blockIdx.x * 8 + wave, nw = gridDim.x * 8;
    float lw[8], lb[8], rk[8];
#pragma unroll
    for (int q = 0; q < 8; ++q) { lw[q] = p.rwkv_ln_w[lane * 8 + q]; lb[q] = p.rwkv_ln_b[lane * 8 + q]; rk[q] = p.rwkv_r_k[lane * 8 + q]; }
    for (int t = gw; t < TX; t += nw) {
        const size_t te = (size_t)(t + 256) * 512 + lane * 8;
        const uint4 uof = *(const uint4*)(p.O + (size_t)t * 512 + lane * 8), uob = *(const uint4*)(p.O + ((size_t)TX + t) * 512 + lane * 8);
        const uint4 ur = *(const uint4*)(p.Rr + te), uk0 = *(const uint4*)(p.KD + te), uk1 = *(const uint4*)(p.KD + (size_t)TE * 512 + te), uv = *(const uint4*)(p.Vv + te), ug = *(const uint4*)(p.G + te);
        const float* yp = p.Y + (size_t)t * 1024 + lane * 16;
        const float4 y0 = *(const float4*)(yp), y1 = *(const float4*)(yp + 4), y2 = *(const float4*)(yp + 8), y3 = *(const float4*)(yp + 12);
        const bf16_t* gbp = p.proj + (size_t)(t + 256) * INC + 3840 + lane * 16;
        const uint4 ugb0 = *(const uint4*)(gbp), ugb1 = *(const uint4*)(gbp + 8);
        {
            float of[8], ob[8], r[8], k0[8], k1[8], v[8], gg[8], o[8];
            unpack8(uof, of); unpack8(uob, ob); unpack8(ur, r); unpack8(uk0, k0); unpack8(uk1, k1); unpack8(uv, v); unpack8(ug, gg);
            float sm = 0.f, bs = 0.f;
#pragma unroll
            for (int q = 0; q < 8; ++q) { o[q] = of[q] + ob[q]; sm += o[q]; bs += r[q] * (k0[q] + k1[q]) * rk[q]; }
            sm += __shfl_xor(sm, 1, 64); sm += __shfl_xor(sm, 2, 64); sm += __shfl_xor(sm, 4, 64);
            bs += __shfl_xor(bs, 1, 64); bs += __shfl_xor(bs, 2, 64); bs += __shfl_xor(bs, 4, 64);
            const float mu = sm * (1.f / 64.f);
            float vs = 0.f;
#pragma unroll
            for (int q = 0; q < 8; ++q) { o[q] -= mu; vs += o[q] * o[q]; }
            vs += __shfl_xor(vs, 1, 64); vs += __shfl_xor(vs, 2, 64); vs += __shfl_xor(vs, 4, 64);
            const float rs = rsqrtf(vs * (1.f / 64.f) + 64e-5f);
            float ya[8];
#pragma unroll
            for (int q = 0; q < 8; ++q) ya[q] = (o[q] * rs * lw[q] + lb[q] + bs * v[q]) * gg[q];
            *(uint4*)(p.ya_in + (size_t)t * 512 + lane * 8) = pack8(ya);
        }
        {
            float y[16] = {y0.x, y0.y, y0.z, y0.w, y1.x, y1.y, y1.z, y1.w, y2.x, y2.y, y2.z, y2.w, y3.x, y3.y, y3.z, y3.w};
            float sm = 0.f;
#pragma unroll
            for (int q = 0; q < 16; ++q) sm += y[q];
            sm += __shfl_xor(sm, 1, 64); sm += __shfl_xor(sm, 2, 64); sm += __shfl_xor(sm, 4, 64); sm += __shfl_xor(sm, 8, 64);
            const float mu = sm * (1.f / 256.f);
            float vs = 0.f;
#pragma unroll
            for (int q = 0; q < 16; ++q) { y[q] -= mu; vs += y[q] * y[q]; }
            vs += __shfl_xor(vs, 1, 64); vs += __shfl_xor(vs, 2, 64); vs += __shfl_xor(vs, 4, 64); vs += __shfl_xor(vs, 8, 64);
            const float rs = rsqrtf(vs * (1.f / 256.f) + 1e-5f);
            float gb[16]; { float t0[8], t1[8]; unpack8(ugb0, t0); unpack8(ugb1, t1);
#pragma unroll
                for (int q = 0; q < 8; ++q) { gb[q] = t0[q]; gb[8 + q] = t1[q]; } }
            float o0[8], o1[8];
#pragma unroll
            for (int q = 0; q < 16; ++q) {
                const int c = lane * 16 + q;
                const float ov = (y[q] * rs * p.ret_ln_w[c] + p.ret_ln_b[c]) * (gb[q] * sigm(gb[q]));
                if (q < 8) o0[q] = ov; else o1[q - 8] = ov;
            }
            bf16_t* d = p.yb_in + (size_t)t * 1024 + lane * 16;
            *(uint4*)d = pack8(o0); *(uint4*)(d + 8) = pack8(o1);
        }
    }
}

__device__ __forceinline__ void phase13(const Params& p, char* smem) {
    for (int u = blockIdx.x; u < 512; u += gridDim.x) {
        const int mt = u >> 2, nt = u & 3;
        f32x4 acca[4][4], accb[4][4];
#pragma unroll
        for (int mi = 0; mi < 4; ++mi)
#pragma unroll
            for (int ni = 0; ni < 4; ++ni) { acca[mi][ni] = (f32x4){0.f, 0.f, 0.f, 0.f}; accb[mi][ni] = (f32x4){0.f, 0.f, 0.f, 0.f}; }
        { APlain ap{p.ya_in + (size_t)mt * 128 * 512, 512}; BPlain bp{p.WaT + (size_t)nt * 256 * 512, 512};
          gemm_core<128, 256, 2, 4>(acca, ap, bp, 512, smem); }
        { APlain ap{p.yb_in + (size_t)mt * 128 * 1024, 1024}; BPlain bp{p.WbT + (size_t)nt * 256 * 1024, 1024};
          gemm_core<128, 256, 2, 4>(accb, ap, bp, 1024, smem); }
        const int wave = tidx() >> 6, lane = tidx() & 63;
        const int r0 = (wave >> 2) * 64 + (lane & 15), c0 = (wave & 3) * 64 + (lane >> 4) * 4;
#pragma unroll
        for (int mi = 0; mi < 4; ++mi)
#pragma unroll
            for (int ni = 0; ni < 4; ++ni) {
                const int t = mt * 128 + r0 + mi * 16, c = nt * 256 + c0 + ni * 16;
                const bf16_t* gp = p.proj + (size_t)(t + 256) * INC + c;
                const uint2 ga = *(const uint2*)(gp + 4864), gb = *(const uint2*)(gp + 5888);
                float o[4];
                o[0] = sigm(__uint_as_float(ga.x << 16)) * acca[mi][ni][0] + sigm(__uint_as_float(gb.x << 16)) * accb[mi][ni][0];
                o[1] = sigm(__uint_as_float(ga.x & 0xffff0000u)) * acca[mi][ni][1] + sigm(__uint_as_float(gb.x & 0xffff0000u)) * accb[mi][ni][1];
                o[2] = sigm(__uint_as_float(ga.y << 16)) * acca[mi][ni][2] + sigm(__uint_as_float(gb.y << 16)) * accb[mi][ni][2];
                o[3] = sigm(__uint_as_float(ga.y & 0xffff0000u)) * acca[mi][ni][3] + sigm(__uint_as_float(gb.y & 0xffff0000u)) * accb[mi][ni][3];
                uint2 ov; ov.x = pack2(o[0], o[1]); ov.y = pack2(o[2], o[3]);
                *(uint2*)(p.merged + (size_t)t * 1024 + c) = ov;
            }
    }
}
__device__ __forceinline__ void phase14(const Params& p, char* smem) {
    g8::StaticOrder S; S.init(TX, 1024, gridDim.x, blockIdx.x);
    g8::EpiBf16 E{p.mix, 1024};
    g8::gemm_phase((LAS unsigned char*)smem, p.merged, p.WoT, 1024, 1024, 1024, S, E);
}

__device__ __forceinline__ void phase15(const Params& p, char* smem) {
    const int tid = tidx(), wave = tid >> 6, lane = tid & 63;
    const int gw = blockIdx.x * 8 + wave, nw = gridDim.x * 8;
    const float* g1 = p.mod + 2048; const float* sh2 = p.mod + 3072; const float* sc2 = p.mod + 4096;
    for (int t = gw; t < TX; t += nw) {
        float4 mv[4], xm[4]; float ss = 0.f;
#pragma unroll
        for (int i = 0; i < 4; ++i) { const uint2 mb = *(const uint2*)(p.mix + (size_t)t * 1024 + i * 256 + lane * 4);
            mv[i] = make_float4(__uint_as_float(mb.x << 16), __uint_as_float(mb.x & 0xffff0000u), __uint_as_float(mb.y << 16), __uint_as_float(mb.y & 0xffff0000u));
            ss += mv[i].x * mv[i].x + mv[i].y * mv[i].y + mv[i].z * mv[i].z + mv[i].w * mv[i].w; }
        ss = wsum(ss);
        const float rs = rsqrtf(ss * (1.f / 1024.f) + 1e-6f);
        float s2 = 0.f;
#pragma unroll
        for (int i = 0; i < 4; ++i) {
            const int col = i * 256 + lane * 4;
            const float4 xv = *(const float4*)(p.x + (size_t)t * 1024 + col);
            const float4 gn = *(const float4*)(p.n_post_mix + col), gg = *(const float4*)(g1 + col);
            xm[i].x = xv.x + gg.x * (mv[i].x * rs * gn.x); xm[i].y = xv.y + gg.y * (mv[i].y * rs * gn.y);
            xm[i].z = xv.z + gg.z * (mv[i].z * rs * gn.z); xm[i].w = xv.w + gg.w * (mv[i].w * rs * gn.w);
            *(float4*)(p.x_mid + (size_t)t * 1024 + col) = xm[i];
            s2 += xm[i].x * xm[i].x + xm[i].y * xm[i].y + xm[i].z * xm[i].z + xm[i].w * xm[i].w;
        }
        s2 = wsum(s2);
        const float rs2 = rsqrtf(s2 * (1.f / 1024.f) + 1e-6f);
#pragma unroll
        for (int i = 0; i < 4; ++i) {
            const int col = i * 256 + lane * 4;
            const float4 gn = *(const float4*)(p.n_pre_ffn + col), sc = *(const float4*)(sc2 + col), sh = *(const float4*)(sh2 + col);
            float h[4];
            h[0] = xm[i].x * rs2 * gn.x * (1.f + sc.x) + sh.x; h[1] = xm[i].y * rs2 * gn.y * (1.f + sc.y) + sh.y;
            h[2] = xm[i].z * rs2 * gn.z * (1.f + sc.z) + sh.z; h[3] = xm[i].w * rs2 * gn.w * (1.f + sc.w) + sh.w;
            uint2 hi; hi.x = pack2(h[0], h[1]); hi.y = pack2(h[2], h[3]);
            *(uint2*)(p.Ahl + (size_t)t * 1024 + col) = hi;
        }
    }
}

__device__ __forceinline__ void phase16(const Params& p, char* smem) {
    for (int u = blockIdx.x; u < 256; u += gridDim.x) {
        const int mt = u >> 1, nt = u & 1;
        APlain ap{p.Ahl + (size_t)mt * 128 * 1024, 1024}; BPlain bp{p.RtT + (size_t)nt * 128 * 1024, 1024};
        float* outp = p.logits + (size_t)mt * 128 * 256 + nt * 128;
        gemm_tile<128, 128, 4, 2>(ap, bp, 1024, smem, [&](const auto& acc, int r0, int c0) {
#pragma unroll
            for (int mi = 0; mi < 2; ++mi)
#pragma unroll
                for (int ni = 0; ni < 4; ++ni) *(f32x4*)(outp + (size_t)(r0 + mi * 16) * 256 + c0 + ni * 16) = acc[mi][ni];
        });
    }
}

__device__ __forceinline__ void phase17(const Params& p, char* smem) {
    const int tid = tidx(), wave = tid >> 6, lane = tid & 63;
    int* hist = (int*)smem;
    if (tid < 256) hist[tid] = 0;
    __syncthreads();
    const int TPB = TX / gridDim.x;
    constexpr int NTK = 4;
    for (int ti = wave * NTK; ti < TPB; ti += 8 * NTK) {
        const int t0 = blockIdx.x * TPB + ti;
        float sc[NTK][4], key[NTK][4], mys[NTK], ssum[NTK]; int mye[NTK];
#pragma unroll
        for (int n = 0; n < NTK; ++n) {
            mys[n] = 0.f; ssum[n] = 0.f; mye[n] = 0;
#pragma unroll
            for (int i = 0; i < 4; ++i) { const int e = lane + 64 * i; sc[n][i] = sigm(p.logits[(size_t)(t0 + n) * 256 + e]); key[n][i] = sc[n][i] + p.router_bias[e]; }
        }
#pragma unroll 1
        for (int k = 0; k < 8; ++k) {
            float bv[NTK]; int be[NTK];
#pragma unroll
            for (int n = 0; n < NTK; ++n) { bv[n] = -1e30f; be[n] = 1 << 20;
#pragma unroll
                for (int i = 0; i < 4; ++i) if (key[n][i] > bv[n]) { bv[n] = key[n][i]; be[n] = lane + 64 * i; } }
#pragma unroll
            for (int o = 32; o; o >>= 1) {
#pragma unroll
                for (int n = 0; n < NTK; ++n) {
                    const float ov = __shfl_xor(bv[n], o, 64); const int oe = __shfl_xor(be[n], o, 64);
                    if (ov > bv[n] || (ov == bv[n] && oe < be[n])) { bv[n] = ov; be[n] = oe; }
                }
            }
#pragma unroll
            for (int n = 0; n < NTK; ++n) {
                float sv = 0.f;
                if ((be[n] & 63) == lane) {
#pragma unroll
                    for (int i = 0; i < 4; ++i) if ((be[n] >> 6) == i) { sv = sc[n][i]; key[n][i] = -1e30f; }
                }
                sv = __shfl(sv, be[n] & 63, 64);
                ssum[n] += sv;
                if (lane == k) { mys[n] = sv; mye[n] = be[n]; }
            }
        }
        if (lane < 8) {
#pragma unroll
            for (int n = 0; n < NTK; ++n) {
                const int t = t0 + n;
                const int pos = atomicAdd(&hist[mye[n]], 1);
                p.tok_e[t * 8 + lane] = mye[n]; p.tok_pos[t * 8 + lane] = pos; p.tok_w[t * 8 + lane] = mys[n] / ssum[n] * 2.5f;
            }
        }
    }
    __syncthreads();
    if (tid < 256) p.bh[blockIdx.x * 256 + tid] = hist[tid];
}

__device__ __forceinline__ void phase18(const Params& p, char* smem) {
    const int tid = tidx();
    int* ps = (int*)smem;
    int* xs = ps + 260;
    int* cntL = xs + 260;
    int* baseL = cntL + 256;
    int* part = baseL + 256;
    {
        const int e = tid & 255, half = tid >> 8, G = gridDim.x, b0 = half * (G >> 1), b1 = b0 + (G >> 1);
        int tot = 0, bef = 0;
        for (int bb = b0; bb < b1; bb += 16) {
            int v[16];
#pragma unroll
            for (int i = 0; i < 16; ++i) v[i] = p.bh[(bb + i) * 256 + e];
#pragma unroll
            for (int i = 0; i < 16; ++i) { tot += v[i]; bef += (bb + i < (int)blockIdx.x) ? v[i] : 0; }
        }
        part[half * 256 + e] = tot; part[512 + half * 256 + e] = bef;
    }
    __syncthreads();
    if (tid < 256) { cntL[tid] = part[tid] + part[256 + tid]; baseL[tid] = part[512 + tid] + part[768 + tid]; }
    __syncthreads();
    if (tid < 64) {
        int c[4], tot = 0, ttot = 0;
#pragma unroll
        for (int q = 0; q < 4; ++q) { c[q] = cntL[tid * 4 + q]; tot += c[q]; ttot += (c[q] + 255) >> 8; }
        int incl = tot, tincl = ttot;
#pragma unroll
        for (int o = 1; o < 64; o <<= 1) { const int v = __shfl_up(incl, o, 64), tv = __shfl_up(tincl, o, 64); if (tid >= o) { incl += v; tincl += tv; } }
        int ex = incl - tot, tex = tincl - ttot;
#pragma unroll
        for (int q = 0; q < 4; ++q) { ps[tid * 4 + q] = ex; xs[tid * 4 + q] = tex; ex += c[q]; tex += (c[q] + 255) >> 8; }
        if (tid == 63) { ps[256] = incl; xs[256] = tincl; }
    }
    __syncthreads();
    if (blockIdx.x == 0) {
        const int nx = xs[256];
        if (tid == 0) *p.ntiles = nx + 64;
        for (int e = tid; e < 256; e += NT) {
            const int c = ps[e + 1] - ps[e];
            for (int t = 0; t < ((c + 255) >> 8); ++t) { int* x = p.xt + (xs[e] + t) * 4; x[0] = e; x[1] = ps[e] + 256 * t; x[2] = min(256, c - 256 * t); x[3] = 0; }
        }
        if (tid < 64) { int* x = p.xt + (nx + tid) * 4; x[0] = 256; x[1] = 131072 + 256 * tid; x[2] = 256; x[3] = 0; }
        if (tid < 256) p.slot_tk[NSLOT + tid] = 0;
    }
    const int TPB = TX / gridDim.x;
    for (int li = tid; li < TPB * 8; li += NT) {
        const int i = blockIdx.x * TPB * 8 + li, e = p.tok_e[i];
        p.slot_tk[ps[e] + baseL[e] + p.tok_pos[i]] = (i >> 3) * 9 + (i & 7);
    }
    for (int t = blockIdx.x * NT + tid; t < TX; t += gridDim.x * NT) p.slot_tk[131072 + t] = t * 9 + 8;
}

__device__ __forceinline__ void phase19(const Params& p, char* smem) {
    const int nun = *p.ntiles * 2;
    const int lb = (blockIdx.x & 7) * (gridDim.x >> 3) + (blockIdx.x >> 3);
    g8::EpiGU E{p.act};
    g8::gemm_phase_xg((LAS unsigned char*)smem, p.Ahl, p.slot_tk, p.xt, p.BtW, nun, lb, (int)gridDim.x, E);
}

__device__ __forceinline__ void phase20(const Params& p, char* smem) {
    constexpr int BM = 256, BN = 256, WGN = 4, TM = 128, TN = 64, MI = 8, NI = 4;
    constexpr int ABYTES = BM * TSTR, STAGE = (BM + BN) * TSTR, AL = 4, KPT = 8, NQ = 64;
    using BP = BKN; const BKN bp{nullptr, 1024};
    constexpr int BL = 4; uint4 rb0 = {}, rb1 = {}, rb2 = {}, rb3 = {}; const char* bbase = nullptr; const unsigned boff0 = 0, boff1 = 0, boff2 = 0, boff3 = 0;
    const int nun = *p.ntiles * 4, G = gridDim.x;
    const int lb = (blockIdx.x & 7) * (G >> 3) + (blockIdx.x >> 3);
    if (lb >= nun) return;
    const int nsteps = ((nun - lb + G - 1) / G) * 4;
    const int tid = tidx(), wave = tid >> 6, lane = tid & 63, fr = lane & 15, fq = lane >> 4;
    const int wm = wave / WGN, wn = wave % WGN;
    const int lrow = tid >> 3, lseg = tid & 7;
    const unsigned aoff0 = (unsigned)(lrow * 512) + lseg * 16, aoff1 = aoff0 + 64 * 512, aoff2 = aoff0 + 128 * 512, aoff3 = aoff0 + 192 * 512;
    const int kq = tid / NQ, n4 = tid % NQ; const long bld = 1024;
    uint4 ra0, ra1, ra2, ra3; float4 rf0, rf1, rf2, rf3, rf4, rf5, rf6, rf7;
    const char* abase = nullptr; const float* bfp = nullptr;
#define P20_UNIT(R) do { const int* x_ = p.xt + ((lb + (R) * G) >> 2) * 4; const int nt_ = (lb + (R) * G) & 3; const int e_ = x_[0]; \
        abase = (const char*)(p.act + (size_t)x_[1] * 256); \
        bfp = (e_ < 256 ? p.exp_w_down + (size_t)e_ * 262144 : p.sh_w_down) + nt_ * 256 + n4 * 4 + (long)(kq * KPT) * bld; } while (0)
    f32x4 acc[MI][NI];
#pragma unroll
    for (int mi = 0; mi < MI; ++mi)
#pragma unroll
        for (int ni = 0; ni < NI; ++ni) acc[mi][ni] = (f32x4){0.f, 0.f, 0.f, 0.f};
    P20_UNIT(0); GC_GLOAD(0); GC_LSTORE(0); __syncthreads();
    for (int s = 0; s < nsteps; ++s) {
        if (s + 1 < nsteps) { if (((s + 1) & 3) == 0) P20_UNIT((s + 1) >> 2); GC_GLOAD((s + 1) & 3); }
        const char* As = smem + (s & 1) * STAGE; const char* Bs = As + ABYTES;
#pragma unroll
        for (int ks = 0; ks < 2; ++ks) {
            bf16x8 af[MI], bfr[NI];
#pragma unroll
            for (int mi = 0; mi < MI; ++mi) af[mi] = *(const bf16x8*)(As + (wm * TM + mi * 16 + fr) * TSTR + ks * 64 + fq * 16);
#pragma unroll
            for (int ni = 0; ni < NI; ++ni) bfr[ni] = *(const bf16x8*)(Bs + (wn * TN + ni * 16 + fr) * TSTR + ks * 64 + fq * 16);
#pragma unroll
            for (int mi = 0; mi < MI; ++mi)
#pragma unroll
                for (int ni = 0; ni < NI; ++ni) acc[mi][ni] = __builtin_amdgcn_mfma_f32_16x16x32_bf16(bfr[ni], af[mi], acc[mi][ni], 0, 0, 0);
            __builtin_amdgcn_sched_barrier(0);
        }
        if ((s & 3) == 3) {
            const int u = lb + (s >> 2) * G; const int* x = p.xt + (u >> 2) * 4; const int nt = u & 3;
            const int row0 = x[1], nrows = x[2];
            const int* stk = p.slot_tk + row0;
            const int r0 = wm * TM + fr, c0 = wn * TN + fq * 4;
#pragma unroll
            for (int mi = 0; mi < MI; ++mi) {
                const int r = r0 + mi * 16;
                if (r < nrows) {
                    bf16_t* d = p.yk + (size_t)stk[r] * 1024 + nt * 256 + c0;
#pragma unroll
                    for (int ni = 0; ni < NI; ++ni) {
                        uint2 ov; ov.x = pack2(acc[mi][ni][0], acc[mi][ni][1]); ov.y = pack2(acc[mi][ni][2], acc[mi][ni][3]);
                        *(uint2*)(d + ni * 16) = ov;
                    }
                }
#pragma unroll
                for (int ni = 0; ni < NI; ++ni) acc[mi][ni] = (f32x4){0.f, 0.f, 0.f, 0.f};
            }
        }
        if (s + 1 < nsteps) GC_LSTORE((s + 1) & 1);
        __syncthreads();
    }
#undef P20_UNIT
}

__device__ __forceinline__ void phase21(const Params& p, char* smem) {
    const int tid = tidx(), wave = tid >> 6, lane = tid & 63;
    const int gw = blockIdx.x * 8 + wave, nw = gridDim.x * 8;
    const float* g2 = p.mod + 5120;
    for (int t = gw; t < TX; t += nw) {
        float w[9];
#pragma unroll
        for (int k = 0; k < 8; ++k) w[k] = p.tok_w[t * 8 + k];
        w[8] = 1.f;
        float4 mo[4]; float ss = 0.f;
#pragma unroll
        for (int i = 0; i < 4; ++i) {
            const int col = i * 256 + lane * 4;
            float a0 = 0.f, a1 = 0.f, a2 = 0.f, a3 = 0.f;
#pragma unroll
            for (int k = 0; k < 9; ++k) {
                const uint2 v = *(const uint2*)(p.yk + ((size_t)t * 9 + k) * 1024 + col);
                a0 += w[k] * __uint_as_float(v.x << 16); a1 += w[k] * __uint_as_float(v.x & 0xffff0000u); a2 += w[k] * __uint_as_float(v.y << 16); a3 += w[k] * __uint_as_float(v.y & 0xffff0000u);
            }
            mo[i] = make_float4(a0, a1, a2, a3);
            ss += a0 * a0 + a1 * a1 + a2 * a2 + a3 * a3;
        }
        ss = wsum(ss);
        const float rs = rsqrtf(ss * (1.f / 1024.f) + 1e-6f);
#pragma unroll
        for (int i = 0; i < 4; ++i) {
            const int col = i * 256 + lane * 4;
            const float4 xm = *(const float4*)(p.x_mid + (size_t)t * 1024 + col);
            const float4 gn = *(const float4*)(p.n_post_ffn + col), gg = *(const float4*)(g2 + col);
            float4 o;
            o.x = xm.x + gg.x * (mo[i].x * rs * gn.x); o.y = xm.y + gg.y * (mo[i].y * rs * gn.y);
            o.z = xm.z + gg.z * (mo[i].z * rs * gn.z); o.w = xm.w + gg.w * (mo[i].w * rs * gn.w);
            *(float4*)(p.out + (size_t)t * 1024 + col) = o;
        }
    }
}

constexpr int NPHASE = 22;
template <int PH> __device__ __forceinline__ void run_phase(const Params& p, char* smem) {
    if constexpr (PH == 0) phase0(p, smem);
    else if constexpr (PH == 1) phase1(p, smem);
    else if constexpr (PH == 2) phase2(p, smem);
    else if constexpr (PH == 3) phase3(p, smem);
    else if constexpr (PH == 4) phase4(p, smem);
    else if constexpr (PH == 5) phase5(p, smem);
    else if constexpr (PH == 6) phase6(p, smem);
    else if constexpr (PH == 7) phase7(p, smem);
    else if constexpr (PH == 8) phase8(p, smem);
    else if constexpr (PH == 9) phase9(p, smem);
    else if constexpr (PH == 10) phase10(p, smem);
    else if constexpr (PH == 11) phase11(p, smem);
    else if constexpr (PH == 12) phase12(p, smem);
    else if constexpr (PH == 13) phase13(p, smem);
    else if constexpr (PH == 14) phase14(p, smem);
    else if constexpr (PH == 15) phase15(p, smem);
    else if constexpr (PH == 16) phase16(p, smem);
    else if constexpr (PH == 17) phase17(p, smem);
    else if constexpr (PH == 18) phase18(p, smem);
    else if constexpr (PH == 19) phase19(p, smem);
    else if constexpr (PH == 20) phase20(p, smem);
    else phase21(p, smem);
}

template <int PH> __global__ void __launch_bounds__(NT, 2) k_phase(Params p) {
    extern __shared__ __attribute__((aligned(16))) char smem[];
    run_phase<PH>(p, smem);
}

template <int PH> __device__ __forceinline__ void mega_run(const Params& p, char* smem, const XcdBarrier& bar) {
    run_phase<PH>(p, smem);
    if constexpr (((PROBE_MASK) >> PH) & 1u) { xcd_barrier(bar); run_phase<PH>(p, smem); }
    if constexpr (PH + 1 < NPHASE) { xcd_barrier(bar); mega_run<PH + 1>(p, smem, bar); }
}
__global__ void __launch_bounds__(NT, 2) k_mega(Params p) {
    extern __shared__ __attribute__((aligned(16))) char smem[];
    uint4* xbw = (uint4*)(smem + 8 * TILE_BYTES);
    if (tidx() == 0) *xbw = make_uint4(0u, 0u, 0u, 0u);
    __syncthreads();
    XcdBarrier bar = xcd_barrier_post(p.bar, (volatile LAS unsigned*)xbw);
    mega_run<0>(p, smem, bar);
}

template <int PH> static void launch_phases(const Params& p, int grid, hipStream_t stream) {
    static bool attr = false;
    if (!attr) { (void)hipFuncSetAttribute((const void*)k_phase<PH>, hipFuncAttributeMaxDynamicSharedMemorySize, LDS_BYTES); attr = true; }
    hipLaunchKernelGGL(k_phase<PH>, dim3(grid), dim3(NT), LDS_BYTES, stream, p);
    if constexpr (PH + 1 < NPHASE) launch_phases<PH + 1>(p, grid, stream);
}

extern "C" void kernel_launch(void* const* d_in, const int* in_sizes, int n_in, void* d_out, int out_size, void* d_ws, size_t ws_size, hipStream_t stream) {
    static int grid = 0;
    if (grid == 0) {
        int dev = 0, cus = 0, per_cu = 0;
        (void)hipGetDevice(&dev); (void)hipDeviceGetAttribute(&cus, hipDeviceAttributeMultiprocessorCount, dev);
        (void)hipFuncSetAttribute((const void*)k_mega, hipFuncAttributeMaxDynamicSharedMemorySize, LDS_BYTES);
        (void)hipOccupancyMaxActiveBlocksPerMultiprocessor(&per_cu, (const void*)k_mega, NT, LDS_BYTES);
        (void)hipGetLastError();
        if (cus <= 0) cus = 256;
        grid = cus;
    }
    Params p{};
    const float** pin = (const float**)&p.x;
    for (int i = 0; i < 36; ++i) pin[i] = (const float*)d_in[i];
    p.out = (float*)d_out;
    char* ws = (char*)d_ws; size_t off = 0;
    auto alloc = [&](size_t bytes) { size_t o = off; off += (bytes + 255) & ~(size_t)255; return ws + o; };
    p.bar = (unsigned*)alloc(XCD_BAR_WORDS * 4); p.cnt = (int*)alloc(256 * 4);
    const size_t zero_bytes = off;
    p.slot_tk = (int*)alloc((size_t)(NSLOT + 256) * 4); p.bh = (int*)alloc(1024 * 256 * 4);
    p.xt = (int*)alloc(NXT_MAX * 16); p.ntiles = (int*)alloc(256);
    p.tok_e = (int*)alloc((size_t)TX * 8 * 4); p.tok_pos = (int*)alloc((size_t)TX * 8 * 4); p.tok_w = (float*)alloc((size_t)TX * 8 * 4);
    p.modp = (float*)alloc(16 * 2 * 6144 * 4); p.mod = (float*)alloc(2 * 6144 * 4);
    p.WinT = (bf16_t*)alloc((size_t)INC * 1024 * 2); p.WaT = (bf16_t*)alloc(1024 * 512 * 2); p.WbT = (bf16_t*)alloc(1024 * 1024 * 2); p.WoT = (bf16_t*)alloc(1024 * 1024 * 2);
    p.RtT = (bf16_t*)alloc(256 * 3072 * 2); p.ShGU = (bf16_t*)alloc(512 * 1024 * 2); p.ShD = (bf16_t*)alloc(1024 * 256 * 2);
    p.WupT = (bf16_t*)alloc(1024 * 64 * 2); p.AupT = (bf16_t*)alloc(1024 * 64 * 2); p.GupT = (bf16_t*)alloc(512 * 128 * 2);
    p.ya_in = (bf16_t*)alloc((size_t)TX * 512 * 2); p.yb_in = (bf16_t*)alloc((size_t)TX * 1024 * 2);
    p.BtW = (bf16_t*)alloc((size_t)257 * 512 * 1024 * 2);
    char* RA = alloc((size_t)TE * INC * 2);
    p.proj = (bf16_t*)RA;
    { size_t o = 0; auto sub = [&](size_t b) { char* r = RA + o; o += (b + 255) & ~(size_t)255; return r; };
      p.act = (bf16_t*)sub(((size_t)NSLOT + 256) * 256 * 2); p.logits = (float*)sub((size_t)TX * 256 * 4); }
    const size_t surv = (size_t)TE * 512 * 2 * 5 + (size_t)2 * TX * 512 * 2 + 4096;
    const size_t rtmp = 424935424 - 68157440 + 65536;
    char* RB = alloc(surv + rtmp);
    { size_t o = 0; auto sub = [&](size_t b) { char* r = RB + o; o += (b + 255) & ~(size_t)255; return r; };
      p.Rr = (bf16_t*)sub((size_t)TE * 512 * 2); p.Vv = (bf16_t*)sub((size_t)TE * 512 * 2); p.KD = (bf16_t*)sub((size_t)2 * TE * 512 * 2); p.G = (bf16_t*)sub((size_t)TE * 512 * 2);
      p.O = (bf16_t*)sub((size_t)2 * TX * 512 * 2);
      const size_t o_t = o;
      p.Kk = (bf16_t*)sub((size_t)TE * 512 * 2); p.Aa = (bf16_t*)sub((size_t)TE * 512 * 2); p.Bd = (bf16_t*)sub((size_t)2 * TE * 512 * 2);
      p.Wd = (float*)sub((size_t)2 * TE * 512 * 4); p.TW = (bf16_t*)sub((size_t)TE * 64 * 2); p.XA = (bf16_t*)sub((size_t)TE * 64 * 2); p.SG = (bf16_t*)sub((size_t)TE * 128 * 2);
      p.PH = (float*)sub((size_t)127 * 16 * 2 * 4096 * 4); p.Sst = (float*)sub((size_t)128 * 16 * 4096 * 4);
      p.Zz = (bf16_t*)sub((size_t)RNC * 16 * RL * 64 * 2); p.YH = (bf16_t*)sub((size_t)RNC * 16 * RL * 64 * 2);
      p.hn = (bf16_t*)p.PH;
      o = o_t;
      p.Qr = (bf16_t*)sub((size_t)NCH * 4 * 128 * 128 * 2); p.Kr = (bf16_t*)sub((size_t)NCH * 4 * 128 * 128 * 2); p.KTz = (bf16_t*)sub((size_t)NCH * 4 * 2 * 128 * 128 * 2);
      p.A3 = (bf16_t*)sub((size_t)NCH * 4 * 128 * 384 * 2); p.B3 = (bf16_t*)sub((size_t)NCH * 4 * 256 * 384 * 2);
      p.KVT = (bf16_t*)sub((size_t)NCH * 4 * 2 * 256 * 128 * 2); p.Y = (float*)sub((size_t)TX * 1024 * 4);
      o = 0;
      p.x_mid = (float*)sub((size_t)TX * 1024 * 4); p.Ahl = (bf16_t*)sub((size_t)TX * 1024 * 2);
      p.yk = (bf16_t*)sub((size_t)TX * 9 * 1024 * 2);
      char* yk0 = (char*)p.yk; p.mergedA = (float*)yk0; p.merged = (bf16_t*)(yk0 + (size_t)TX * 1024 * 4); p.mix = (bf16_t*)(yk0 + (size_t)TX * 1024 * 6);
    }
    if (off > ws_size) { fprintf(stderr, "kernel_launch: workspace too small: need %zu have %zu\n", off, ws_size); return; }
    int j = 0;
    p.jobs[j++] = TJob{p.w_in, p.WinT, 1024, INC, 1024, 0, 0, 0};
    p.jobs[j++] = TJob{p.w_branch_a, p.WaT, 512, 1024, 512, 0, 0, 0};
    p.jobs[j++] = TJob{p.w_branch_b, p.WbT, 1024, 1024, 1024, 0, 0, 0};
    p.jobs[j++] = TJob{p.w_out, p.WoT, 1024, 1024, 1024, 0, 0, 0};
    p.jobs[j++] = TJob{p.router_w, p.RtT, 1024, 256, 1024, 0, 0, 0};
    p.jobs[j++] = TJob{p.rwkv_g_up, p.GupT, 0, 0, 128, 0, 0, 0};
    p.jobs[j++] = TJob{p.rwkv_g_up, p.GupT, 0, 0, 128, 0, 0, 0};
    p.jobs[j++] = TJob{p.rwkv_g_up, p.GupT, 0, 0, 128, 0, 0, 0};
    p.jobs[j++] = TJob{p.rwkv_w_up, p.WupT, 64, 512, 64, 0, 0, 0};
    p.jobs[j++] = TJob{p.rwkv_w_up + 64 * 512, p.WupT, 64, 512, 64, 0, 512, 0};
    p.jobs[j++] = TJob{p.rwkv_a_up, p.AupT, 64, 512, 64, 0, 0, 0};
    p.jobs[j++] = TJob{p.rwkv_a_up + 64 * 512, p.AupT, 64, 512, 64, 0, 512, 0};
    p.jobs[j++] = TJob{p.rwkv_g_up, p.GupT, 128, 512, 128, 0, 0, 0};
    p.jobs[j++] = TJob{p.rwkv_g_up, p.GupT, 0, 0, 128, 0, 0, 0};
    (void)hipMemsetAsync(ws, 0, zero_bytes, stream);
#if MK_ONE_LAUNCH
    hipLaunchKernelGGL(k_mega, dim3(grid), dim3(NT), LDS_BYTES, stream, p);
#else
    launch_phases<0>(p, grid, stream);
#endif
}
```

```cpp
#include <hip/hip_runtime.h>
#include <stdint.h>
#include <stdio.h>

#ifndef MK_ONE_LAUNCH
#define MK_ONE_LAUNCH 1
#endif
#ifndef ROUTER_K
#define ROUTER_K 1024
#endif
#ifndef PROBE_MASK
#define PROBE_MASK 0u
#endif

typedef unsigned short bf16_t;
typedef short bf16x8 __attribute__((ext_vector_type(8)));
typedef float f32x4 __attribute__((ext_vector_type(4)));
typedef float f32x2 __attribute__((ext_vector_type(2)));

#define NT 512
constexpr int TX = 16384, TC = 256, TE = 16640, DM = 1024, INC = 6912;
constexpr int NCH = 130;
constexpr int RL = 130, RNC = 128;
constexpr int TSTR = 144;
constexpr int TILE_BYTES = 128 * TSTR;
constexpr int LDS_BYTES = 8 * TILE_BYTES + 1024;
constexpr int NSLOT = 131072 + 16384;
constexpr int NXT_MAX = 768 + 64;

#define XB_TMO      128
#define XB_XCNT(j)  (256  + 64 * (j))
#define XB_XSUB(j)  (1280 + 64 * (j))
#define XB_XGEN(j)  (2304 + 64 * (j))
#define XB_TOP      3328
#define XB_TOPGEN   3392
#define XCD_BAR_WORDS 3456
#define XB_SPIN_CAP (1u << 18)
#define LAS __attribute__((address_space(3)))

__device__ __forceinline__ unsigned xb_ld(unsigned* p)              { return __hip_atomic_load(p, __ATOMIC_RELAXED, __HIP_MEMORY_SCOPE_AGENT); }
__device__ __forceinline__ unsigned xb_add(unsigned* p, unsigned v) { return __hip_atomic_fetch_add(p, v, __ATOMIC_RELAXED, __HIP_MEMORY_SCOPE_AGENT); }
__device__ __forceinline__ unsigned xb_xcc_id() { return (unsigned)__builtin_amdgcn_s_getreg((3 << 11) | 20) & 0xFu; }
#define XB_SPIN(cond, bar) do { unsigned _sp = 0; while (cond) { __builtin_amdgcn_s_sleep(1); \
    if ((++_sp & 255u) == 0u) { if (xb_ld(&(bar)[XB_TMO])) break; if (_sp > XB_SPIN_CAP) { atomicAdd(&(bar)[XB_TMO], 1u); break; } } } } while (0)

struct XcdBarrier { unsigned* bar; unsigned x; volatile LAS unsigned* st; };

__device__ __forceinline__ XcdBarrier xcd_barrier_post(unsigned* bar, volatile LAS unsigned* st) {
    XcdBarrier b; b.bar = bar; b.x = xb_xcc_id(); b.st = st;
    if (threadIdx.x == 0) (void)xb_add(&bar[XB_XCNT(b.x)], 1u);
    return b;
}
__device__ __forceinline__ void xcd_barrier_complete(unsigned* bar, unsigned x, unsigned& nloc, unsigned& nx) {
    const unsigned G = gridDim.x * gridDim.y * gridDim.z;
    unsigned sum, cnt, mine, sp = 0u;
    for (;;) {
        sum = 0u; cnt = 0u; mine = 0u;
#pragma unroll
        for (unsigned j = 0; j < 16; ++j) { const unsigned c = xb_ld(&bar[XB_XCNT(j)]); sum += c; cnt += (c > 0u) ? 1u : 0u; mine = (j == x) ? c : mine; }
        if (sum == G) break;
        __builtin_amdgcn_s_sleep(1);
        if ((++sp & 255u) == 0u) { if (xb_ld(&bar[XB_TMO])) break; if (sp > XB_SPIN_CAP) { atomicAdd(&bar[XB_TMO], 1u); break; } }
    }
    nloc = mine > 0u ? mine : 1u; nx = cnt > 0u ? cnt : 1u;
}
__device__ __forceinline__ void xcd_barrier(const XcdBarrier& b) {
    asm volatile("s_waitcnt vmcnt(0)" ::: "memory");
    __syncthreads();
    if (threadIdx.x == 0) {
        unsigned* bar = b.bar;
        __builtin_amdgcn_s_waitcnt(0);
        unsigned nloc = b.st[0], nx = b.st[1];
        if (nloc == 0u) { xcd_barrier_complete(bar, b.x, nloc, nx); b.st[0] = nloc; b.st[1] = nx; }
        const unsigned old = xb_add(&bar[XB_XSUB(b.x)], 1u);
        const unsigned gen = old / nloc;
        if (old + 1u == (gen + 1u) * nloc) {
            __builtin_amdgcn_fence(__ATOMIC_RELEASE, "agent");
            asm volatile("s_waitcnt vmcnt(0)" ::: "memory");
            const unsigned og = xb_add(&bar[XB_TOP], 1u);
            const unsigned tg = og / nx;
            if (og + 1u == (tg + 1u) * nx) xb_add(&bar[XB_TOPGEN], 1u);
            else XB_SPIN(xb_ld(&bar[XB_TOPGEN]) == tg, bar);
            __builtin_amdgcn_fence(__ATOMIC_ACQUIRE, "agent");
            xb_add(&bar[XB_XGEN(b.x)], 1u);
            asm volatile("s_waitcnt vmcnt(0)" ::: "memory");
        } else {
            XB_SPIN(xb_ld(&bar[XB_XGEN(b.x)]) == gen, bar);
            __builtin_amdgcn_fence(__ATOMIC_ACQUIRE, "agent");
            asm volatile("s_waitcnt vmcnt(0)" ::: "memory");
        }
    }
    __syncthreads();
}

struct TJob { const float* src; bf16_t* dst; int K, N, dld, mode, rowoff, coloff; };
constexpr int NJOB = 14;

struct Params {
    const float *x, *c, *ctx, *c_ctx, *w_mod, *b_mod, *n_pre_mix, *n_post_mix, *n_pre_ffn, *n_post_ffn,
        *w_in, *shift_mu, *rwkv_w0, *rwkv_w_up, *rwkv_a0, *rwkv_a_up, *rwkv_g_up, *rwkv_k_k, *rwkv_k_a, *rwkv_r_k,
        *rwkv_ln_w, *rwkv_ln_b, *w_branch_a, *ret_decay_logit, *ret_ln_w, *ret_ln_b, *w_branch_b, *w_out,
        *router_w, *router_bias, *exp_w_gate, *exp_w_up, *exp_w_down, *sh_w_gate, *sh_w_up, *sh_w_down;
    float* out;
    unsigned* bar; int* cnt; int* bh; int* slot_tk; int* xt; int* ntiles; int* tok_e; int* tok_pos; float* tok_w;
    float* modp; float* mod;
    bf16_t *WinT, *WaT, *WbT, *WoT, *RtT, *ShGU, *ShD, *WupT, *AupT, *GupT;
    bf16_t *hn, *proj, *BtW;
    bf16_t *Rr, *Vv, *KD, *G, *O;
    bf16_t *Kk, *Aa, *Bd, *TW, *XA, *SG;
    float *Wd, *PH, *Sst; bf16_t *Zz, *YH;
    bf16_t *Qr, *Kr, *KTz, *A3, *B3;
    bf16_t* KVT; float* Y;
    bf16_t *ya_in, *yb_in, *merged, *Ahl, *act, *yk;
    float *mergedA, *x_mid, *logits; bf16_t* mix;
    TJob jobs[NJOB];
};

__device__ __forceinline__ int tidx() { int t = threadIdx.x; asm volatile("" : "+v"(t)); return t; }
__device__ __forceinline__ float bf2f(bf16_t v) { return __uint_as_float(((unsigned)v) << 16); }
__device__ __forceinline__ unsigned pack2(float lo, float hi) { unsigned r; asm("v_cvt_pk_bf16_f32 %0, %1, %2" : "=v"(r) : "v"(lo), "v"(hi)); return r; }
__device__ __forceinline__ bf16_t f2bf(float f) { return (bf16_t)(pack2(f, f) & 0xffffu); }
__device__ __forceinline__ void unpack8(const uint4& v, float (&f)[8]) {
    f[0] = __uint_as_float(v.x << 16); f[1] = __uint_as_float(v.x & 0xffff0000u); f[2] = __uint_as_float(v.y << 16); f[3] = __uint_as_float(v.y & 0xffff0000u);
    f[4] = __uint_as_float(v.z << 16); f[5] = __uint_as_float(v.z & 0xffff0000u); f[6] = __uint_as_float(v.w << 16); f[7] = __uint_as_float(v.w & 0xffff0000u); }
__device__ __forceinline__ uint4 pack8(const float (&f)[8]) { uint4 o; o.x = pack2(f[0], f[1]); o.y = pack2(f[2], f[3]); o.z = pack2(f[4], f[5]); o.w = pack2(f[6], f[7]); return o; }
__device__ __forceinline__ float dpp_f(float v, const int ctrl_unused) { return v; }
#define DPP_ADD(v, CTRL) ((v) + __int_as_float(__builtin_amdgcn_update_dpp(0, __float_as_int(v), CTRL, 0xf, 0xf, false)))
__device__ __forceinline__ float sum8(float v) { v = DPP_ADD(v, 0xB1); v = DPP_ADD(v, 0x4E); v = DPP_ADD(v, 0x141); return v; }
__device__ __forceinline__ float sum16(float v) { v = sum8(v); v = DPP_ADD(v, 0x140); return v; }
__device__ __forceinline__ float wsum(float v) {
    v = sum16(v);
    const float a = __int_as_float(__builtin_amdgcn_readlane(__float_as_int(v), 0)), b = __int_as_float(__builtin_amdgcn_readlane(__float_as_int(v), 16));
    const float c = __int_as_float(__builtin_amdgcn_readlane(__float_as_int(v), 32)), d = __int_as_float(__builtin_amdgcn_readlane(__float_as_int(v), 48));
    return (a + b) + (c + d);
}
__device__ __forceinline__ unsigned wave_umax(unsigned v) {
    v = max(v, (unsigned)__builtin_amdgcn_update_dpp(0, (int)v, 0x111, 0xf, 0xf, false));
    v = max(v, (unsigned)__builtin_amdgcn_update_dpp(0, (int)v, 0x112, 0xf, 0xf, false));
    v = max(v, (unsigned)__builtin_amdgcn_update_dpp(0, (int)v, 0x114, 0xf, 0xf, false));
    v = max(v, (unsigned)__builtin_amdgcn_update_dpp(0, (int)v, 0x118, 0xf, 0xf, false));
    v = max(v, (unsigned)__builtin_amdgcn_update_dpp(0, (int)v, 0x142, 0xa, 0xf, false));
    v = max(v, (unsigned)__builtin_amdgcn_update_dpp(0, (int)v, 0x143, 0xc, 0xf, false));
    return (unsigned)__builtin_amdgcn_readlane((int)v, 63);
}
__device__ __forceinline__ float sigm(float z) { return 1.f / (1.f + __expf(-z)); }
__device__ __forceinline__ int row_of(int dir, int s) { return dir == 0 ? s : (s < 256 ? 255 - s : 16895 - s); }

struct APlain { const bf16_t* base; int ld;
    __device__ __forceinline__ const char* bptr() const { return (const char*)base; }
    __device__ __forceinline__ unsigned rowoff(int r) const { return (unsigned)(r * ld) * 2u; } };
struct AGather { const bf16_t* base; int ld; const int* idx;
    __device__ __forceinline__ const char* bptr() const { return (const char*)base; }
    __device__ __forceinline__ unsigned rowoff(int r) const { const int tok = idx[r] / 9; return (unsigned)(tok * ld) * 2u; } };
struct BPlain { static constexpr int MODE = 0; const bf16_t* base; int ldv;
    __device__ __forceinline__ const char* bptr() const { return (const char*)base; }
    __device__ __forceinline__ unsigned rowoff(int n) const { return (unsigned)(n * ldv) * 2u; }
    __device__ __forceinline__ const float* colptr(int) const { return nullptr; }
    __device__ __forceinline__ long ld() const { return ldv; }
    __device__ __forceinline__ int lrow(int, int) const { return 0; } };
struct BKN { static constexpr int MODE = 1; const float* base; long ldv;
    __device__ __forceinline__ const char* bptr() const { return nullptr; }
    __device__ __forceinline__ unsigned rowoff(int) const { return 0u; }
    __device__ __forceinline__ const float* colptr(int n4) const { return base + n4 * 4; }
    __device__ __forceinline__ long ld() const { return ldv; }
    __device__ __forceinline__ int lrow(int n4, int j) const { return n4 * 4 + j; } };
struct BKNGU { static constexpr int MODE = 1; const float* g; const float* u;
    __device__ __forceinline__ const char* bptr() const { return nullptr; }
    __device__ __forceinline__ unsigned rowoff(int) const { return 0u; }
    __device__ __forceinline__ const float* colptr(int n4) const { return ((n4 >> 5) ? u : g) + (n4 & 31) * 4; }
    __device__ __forceinline__ long ld() const { return 256; }
    __device__ __forceinline__ int lrow(int n4, int j) const { int sc = (n4 & 31) * 4 + j; return (sc >> 4) * 32 + (n4 >> 5) * 16 + (sc & 15); } };

__device__ __forceinline__ float f4e(const float4& v, int j) { return j == 0 ? v.x : (j == 1 ? v.y : (j == 2 ? v.z : v.w)); }
#define GC_REP4(N, X) do { if constexpr ((N) > 0) { X(0); } if constexpr ((N) > 1) { X(1); } if constexpr ((N) > 2) { X(2); } if constexpr ((N) > 3) { X(3); } } while (0)
#define GC_REP8(N, X) do { X(0); X(1); X(2); X(3); if constexpr ((N) > 4) { X(4); X(5); X(6); X(7); } } while (0)
#define GC_AOFF(i) aoff##i = ap.rowoff(lrow + 64 * i) + lseg * 16
#define GC_BOFF(i) boff##i = bp.rowoff(lrow + 64 * i) + lseg * 16
#define GC_LA(i) ra##i = *(const uint4*)(abase + (aoff##i + kt_ * 128))
#define GC_LB(i) rb##i = *(const uint4*)(bbase + (boff##i + kt_ * 128))
#define GC_LF(i) rf##i = *(const float4*)(bfp + ((long)kt_ * 64 + i) * bld)
#define GC_SA(i) *(uint4*)(As_ + (lrow + 64 * i) * TSTR + lseg * 16) = ra##i
#define GC_SB(i) *(uint4*)(Bs_ + (lrow + 64 * i) * TSTR + lseg * 16) = rb##i
#define GC_GLOAD(KT) do { const int kt_ = (KT); GC_REP4(AL, GC_LA); \
    if constexpr (BP::MODE == 0) { GC_REP4(BL, GC_LB); } else { GC_REP8(KPT, GC_LF); } } while (0)
#define GC_SF(j) do { char* d_ = Bs_ + bp.lrow(n4, j) * TSTR + kq * KPT * 2; \
        if constexpr (KPT == 4) *(uint2*)d_ = make_uint2(pack2(f4e(rf0, j), f4e(rf1, j)), pack2(f4e(rf2, j), f4e(rf3, j))); \
        else *(uint4*)d_ = make_uint4(pack2(f4e(rf0, j), f4e(rf1, j)), pack2(f4e(rf2, j), f4e(rf3, j)), pack2(f4e(rf4, j), f4e(rf5, j)), pack2(f4e(rf6, j), f4e(rf7, j))); } while (0)
#define GC_LSTORE(BUF) do { char* As_ = smem + (BUF) * STAGE; char* Bs_ = As_ + ABYTES; GC_REP4(AL, GC_SA); \
    if constexpr (BP::MODE == 0) { GC_REP4(BL, GC_SB); } else { GC_SF(0); GC_SF(1); GC_SF(2); GC_SF(3); } } while (0)

template <int BM, int BN, int WGM, int WGN, class AP, class BP>
__device__ __forceinline__ void gemm_core(f32x4 (&acc)[BM / WGM / 16][BN / WGN / 16], const AP& ap, const BP& bp, const int K, char* smem) {
    constexpr int TM = BM / WGM, TN = BN / WGN, MI = TM / 16, NI = TN / 16;
    constexpr int ABYTES = BM * TSTR, STAGE = (BM + BN) * TSTR;
    constexpr int AL = BM / 64, BL = BN / 64;
    constexpr int KPT = BN / 32, NQ = BN / 4;
    const int tid = tidx(), wave = tid >> 6, lane = tid & 63, fr = lane & 15, fq = lane >> 4;
    const int wm = wave / WGN, wn = wave % WGN;
    const int lrow = tid >> 3, lseg = tid & 7;
    const char* abase = ap.bptr(); const char* bbase = bp.bptr();
    unsigned aoff0 = 0, aoff1 = 0, aoff2 = 0, aoff3 = 0, boff0 = 0, boff1 = 0, boff2 = 0, boff3 = 0;
    uint4 ra0, ra1, ra2, ra3, rb0, rb1, rb2, rb3; float4 rf0, rf1, rf2, rf3, rf4, rf5, rf6, rf7;
    GC_REP4(AL, GC_AOFF);
    const float* bfp = nullptr;
    const int kq = tid / NQ, n4 = tid % NQ; const long bld = bp.ld();
    if constexpr (BP::MODE == 0) { GC_REP4(BL, GC_BOFF); } else { bfp = bp.colptr(n4) + (long)(kq * KPT) * bld; }
    int nk = K >> 6;
    asm volatile("" : "+s"(nk));
    GC_GLOAD(0); GC_LSTORE(0); __syncthreads();
    for (int kt = 0; kt < nk; ++kt) {
        if (kt + 1 < nk) GC_GLOAD(kt + 1);
        const char* As = smem + (kt & 1) * STAGE; const char* Bs = As + ABYTES;
#pragma unroll
        for (int ks = 0; ks < 2; ++ks) {
            bf16x8 af[MI], bfr[NI];
#pragma unroll
            for (int mi = 0; mi < MI; ++mi) af[mi] = *(const bf16x8*)(As + (wm * TM + mi * 16 + fr) * TSTR + ks * 64 + fq * 16);
#pragma unroll
            for (int ni = 0; ni < NI; ++ni) bfr[ni] = *(const bf16x8*)(Bs + (wn * TN + ni * 16 + fr) * TSTR + ks * 64 + fq * 16);
#pragma unroll
            for (int mi = 0; mi < MI; ++mi)
#pragma unroll
                for (int ni = 0; ni < NI; ++ni) acc[mi][ni] = __builtin_amdgcn_mfma_f32_16x16x32_bf16(bfr[ni], af[mi], acc[mi][ni], 0, 0, 0);
        }
        if (kt + 1 < nk) GC_LSTORE((kt + 1) & 1);
        __syncthreads();
    }
}
template <int BM, int BN, int WGM, int WGN, class AP, class BP, class EPI>
__device__ __forceinline__ void gemm_tile(const AP& ap, const BP& bp, const int K, char* smem, const EPI& epi) {
    constexpr int TM = BM / WGM, TN = BN / WGN, MI = TM / 16, NI = TN / 16;
    f32x4 acc[MI][NI];
#pragma unroll
    for (int mi = 0; mi < MI; ++mi)
#pragma unroll
        for (int ni = 0; ni < NI; ++ni) acc[mi][ni] = (f32x4){0.f, 0.f, 0.f, 0.f};
    gemm_core<BM, BN, WGM, WGN>(acc, ap, bp, K, smem);
    const int wave = tidx() >> 6, lane = tidx() & 63;
    epi(acc, (wave / WGN) * TM + (lane & 15), (wave % WGN) * TN + (lane >> 4) * 4);
}

namespace g8 {
constexpr int BM = 256, BK = 64, HALF = 128, HTB = HALF * BK * 2, NXCD = 8, WGM = 8;
__device__ __forceinline__ int lds_byte(int r, int c) { const int st = (r >> 4) * 2 + (c >> 5), rr = r & 15, cc = c & 31, ob = rr * 64 + cc * 2; return st * 1024 + (ob ^ (((ob >> 9) & 1) << 5)); }
__device__ __forceinline__ void stage_rc(int b, int& R, int& C) { const int st = b / 1024, sb = b % 1024, swz = sb ^ (((sb >> 9) & 1) << 5); R = (st >> 1) * 16 + swz / 64; C = (st & 1) * 32 + (swz % 64) / 2; }
__device__ __forceinline__ int perm32(int rho) { const int n = rho >> 4, i = rho & 15; return 8 * (i >> 2) + 4 * n + (i & 3); }
struct Unit { int pm, pn; };
struct StaticOrder {
    int nM, nN, nwg, G, c;
    __device__ void init(int M, int N, int G_, int c_) { nM = M / BM; nN = N / BM; nwg = nM * nN; G = G_; c = c_; }
    __device__ bool next(int i, Unit& u) const {
        const long L = (long)i * G + c; if (L >= nwg) return false;
        int wgid = (int)L; { const int q = nwg / NXCD, r = nwg % NXCD, xcd = wgid % NXCD, off = wgid / NXCD; wgid = (xcd < r ? xcd * (q + 1) : r * (q + 1) + (xcd - r) * q) + off; }
        const int nig = WGM * nN, gid = wgid / nig, fm = gid * WGM, gsz = (nM - fm) < WGM ? (nM - fm) : WGM;
        u.pm = fm + ((wgid % nig) % gsz); u.pn = (wgid % nig) / gsz; return true;
    }
};
template <class Epi, class Sched>
__device__ __forceinline__ void gemm_phase(LAS unsigned char* lds, const bf16_t* Ag, const bf16_t* Btg, const int lda, const int ldb, const int K, const Sched& S, const Epi& E) {
    int tid = threadIdx.x; asm volatile("" : "+v"(tid));
    const int wid = __builtin_amdgcn_readfirstlane(tid >> 6), lane = tid & 63, wr = wid >> 2, wc = wid & 3, fr = lane & 15, fq = lane >> 4;
    const int nt = K / BK;
    unsigned voffA[2], voffB[2];
#pragma unroll
    for (int i = 0; i < 2; ++i) { int R, C; stage_rc(tid * 16 + i * 8192, R, C); const int Rb = Epi::PERM ? ((R & ~31) + perm32(R & 31)) : R;
        voffA[i] = (unsigned)(R * lda + C) * 2u; voffB[i] = (unsigned)(Rb * ldb + C) * 2u; }
    const size_t kstep = (size_t)(BK * 2);
    const size_t hstepA = (size_t)HALF * lda * 2, hstepB = (size_t)HALF * ldb * 2;
    const size_t tstepA = 2 * hstepA, tstepB = 2 * hstepB;
    const unsigned ldsw = (unsigned)wid * 1024u;
    const int aoff = lds_byte(wr * 64 + fr, fq * 8), boff = lds_byte(wc * 32 + fr, fq * 8);
#define PG8_SA(b, h) (((b) * 2 + (h)) * HTB)
#define PG8_SB(b, h) ((4 + (b) * 2 + (h)) * HTB)
#define PG8_STAGE(bufoff, gbase, voff) do { _Pragma("unroll") for (int _i = 0; _i < 2; ++_i) \
        __builtin_amdgcn_global_load_lds((const unsigned*)((const char*)(gbase) + (voff)[_i]), (LAS unsigned*)(lds + (bufoff) + ldsw + _i * 8192), 16, 0, 0); } while (0)
#define PG8_LDA(dst, b, h) do { _Pragma("unroll") for (int m = 0; m < 4; ++m) _Pragma("unroll") for (int k = 0; k < 2; ++k) dst[m][k] = *(const LAS bf16x8*)(lds + PG8_SA(b, h) + aoff + m * 2048 + k * 1024); } while (0)
#define PG8_LDB(dst, b, h) do { _Pragma("unroll") for (int n = 0; n < 2; ++n) _Pragma("unroll") for (int k = 0; k < 2; ++k) dst[n][k] = *(const LAS bf16x8*)(lds + PG8_SB(b, h) + boff + n * 2048 + k * 1024); } while (0)
#define PG8_MMA(ai, bj, At, Bt) do { __builtin_amdgcn_s_setprio(1); _Pragma("unroll") for (int m = 0; m < 4; ++m) _Pragma("unroll") for (int n = 0; n < 2; ++n) _Pragma("unroll") for (int k = 0; k < 2; ++k) \
        acc[ai][bj][m][n] = __builtin_amdgcn_mfma_f32_16x16x32_bf16(Bt[n][k], At[m][k], acc[ai][bj][m][n], 0, 0, 0); __builtin_amdgcn_s_setprio(0); } while (0)
#define PG8_WAIT_V(n) asm volatile("s_waitcnt vmcnt(" #n ")" ::: "memory")
#define PG8_WAIT_L(n) asm volatile("s_waitcnt lgkmcnt(" #n ")" ::: "memory")
#define PG8_BAR __builtin_amdgcn_s_barrier()
#define PG8_SCHED __builtin_amdgcn_sched_barrier(0)
    Unit cur, nxt; int ui = 0;
    if (!S.next(0, cur)) return;
    f32x4 acc[2][2][4][2];
#pragma unroll
    for (int a = 0; a < 2; ++a)
#pragma unroll
        for (int b = 0; b < 2; ++b)
#pragma unroll
            for (int m = 0; m < 4; ++m)
#pragma unroll
                for (int n = 0; n < 2; ++n) acc[a][b][m][n] = (f32x4){0.f, 0.f, 0.f, 0.f};
    bf16x8 At[4][2], B0[2][2], B1[2][2];
    const char* cA = (const char*)Ag + (size_t)cur.pm * tstepA; const char* cB = (const char*)Btg + (size_t)cur.pn * tstepB;
    PG8_STAGE(PG8_SB(0, 0), cB, voffB); PG8_STAGE(PG8_SA(0, 0), cA, voffA); PG8_STAGE(PG8_SB(0, 1), cB + hstepB, voffB); PG8_STAGE(PG8_SA(0, 1), cA + hstepA, voffA);
    if (wr == 1) PG8_BAR;
    PG8_WAIT_V(4); PG8_BAR;
    PG8_STAGE(PG8_SB(1, 0), cB + kstep, voffB); PG8_STAGE(PG8_SA(1, 0), cA + kstep, voffA); PG8_STAGE(PG8_SB(1, 1), cB + hstepB + kstep, voffB);
    PG8_WAIT_V(6); PG8_BAR;
    for (;;) {
        const bool has_next = S.next(ui + 1, nxt);
        const char* nA = has_next ? (const char*)Ag + (size_t)nxt.pm * tstepA : cA; const char* nB = has_next ? (const char*)Btg + (size_t)nxt.pn * tstepB : cB;
        for (int t = 0; t < nt; t += 2) {
            const bool last = (t == nt - 2);
            const char* a1 = cA + (size_t)(t + 1) * kstep;
            const char* a2 = last ? nA : cA + (size_t)(t + 2) * kstep; const char* b2 = last ? nB : cB + (size_t)(t + 2) * kstep;
            const char* a3 = a2 + kstep; const char* b3 = b2 + kstep;
            PG8_LDB(B0, 0, 0); PG8_SCHED; PG8_LDA(At, 0, 0); PG8_STAGE(PG8_SA(1, 1), a1 + hstepA, voffA);
            PG8_WAIT_L(8); PG8_BAR; PG8_WAIT_L(0); PG8_MMA(0, 0, At, B0); PG8_BAR; PG8_SCHED;
            PG8_LDB(B1, 0, 1); PG8_STAGE(PG8_SB(0, 0), b2, voffB);
            PG8_BAR; PG8_WAIT_L(0); PG8_MMA(0, 1, At, B1); PG8_BAR;
            PG8_LDA(At, 0, 1); PG8_STAGE(PG8_SA(0, 0), a2, voffA);
            PG8_BAR; PG8_WAIT_L(0); PG8_MMA(1, 0, At, B0); PG8_BAR; PG8_SCHED;
            PG8_STAGE(PG8_SB(0, 1), b2 + hstepB, voffB);
            PG8_WAIT_V(6); PG8_BAR; PG8_MMA(1, 1, At, B1); PG8_BAR;
            PG8_LDB(B0, 1, 0); PG8_SCHED; PG8_LDA(At, 1, 0); PG8_STAGE(PG8_SA(0, 1), a2 + hstepA, voffA);
            PG8_WAIT_L(8); PG8_BAR; PG8_WAIT_L(0); PG8_MMA(0, 0, At, B0); PG8_BAR; PG8_SCHED;
            PG8_LDB(B1, 1, 1); PG8_STAGE(PG8_SB(1, 0), b3, voffB);
            PG8_BAR; PG8_WAIT_L(0); PG8_MMA(0, 1, At, B1); PG8_BAR;
            PG8_LDA(At, 1, 1); PG8_STAGE(PG8_SA(1, 0), a3, voffA);
            PG8_BAR; PG8_WAIT_L(0); PG8_MMA(1, 0, At, B0); PG8_BAR; PG8_SCHED;
            PG8_STAGE(PG8_SB(1, 1), b3 + hstepB, voffB);
            PG8_WAIT_V(6); PG8_BAR; PG8_MMA(1, 1, At, B1); PG8_BAR;
        }
        E(acc, cur, wr, wc, fr, fq);
        if (!has_next) break;
#pragma unroll
        for (int a = 0; a < 2; ++a)
#pragma unroll
            for (int b = 0; b < 2; ++b)
#pragma unroll
                for (int m = 0; m < 4; ++m)
#pragma unroll
                    for (int n = 0; n < 2; ++n) acc[a][b][m][n] = (f32x4){0.f, 0.f, 0.f, 0.f};
        cur = nxt; cA = nA; cB = nB; ++ui;
    }
    PG8_WAIT_V(0);
    if (wr == 0) PG8_BAR;
    PG8_BAR;
#undef PG8_SA
#undef PG8_SB
#undef PG8_STAGE
#undef PG8_LDA
#undef PG8_LDB
#undef PG8_MMA
#undef PG8_WAIT_V
#undef PG8_WAIT_L
#undef PG8_BAR
#undef PG8_SCHED
}
struct EpiF32 {
    static constexpr bool PERM = false;
    float* C; int ldc;
    __device__ __forceinline__ void operator()(const f32x4 (&acc)[2][2][4][2], const Unit& u, int wr, int wc, int fr, int fq) const {
        const int row0 = u.pm * BM + wr * 64 + fr, col0 = u.pn * BM + wc * 32 + 4 * fq;
#pragma unroll
        for (int ai = 0; ai < 2; ++ai)
#pragma unroll
            for (int m = 0; m < 4; ++m) { float* rowp = C + (size_t)(row0 + ai * HALF + m * 16) * ldc + col0;
#pragma unroll
                for (int bj = 0; bj < 2; ++bj)
#pragma unroll
                    for (int n = 0; n < 2; ++n) *(f32x4*)(rowp + bj * HALF + n * 16) = acc[ai][bj][m][n]; }
    }
};
struct EpiBf16 {
    static constexpr bool PERM = true;
    bf16_t* O; int ldc;
    __device__ __forceinline__ void operator()(const f32x4 (&acc)[2][2][4][2], const Unit& u, int wr, int wc, int fr, int fq) const {
        const int row0 = u.pm * BM + wr * 64 + fr, col0 = u.pn * BM + wc * 32 + 8 * fq;
#pragma unroll
        for (int ai = 0; ai < 2; ++ai)
#pragma unroll
            for (int m = 0; m < 4; ++m) { bf16_t* rowp = O + (size_t)(row0 + ai * HALF + m * 16) * ldc + col0;
#pragma unroll
                for (int bj = 0; bj < 2; ++bj) { const f32x4 v0 = acc[ai][bj][m][0], v1 = acc[ai][bj][m][1];
                    uint4 o; o.x = pack2(v0[0], v0[1]); o.y = pack2(v0[2], v0[3]); o.z = pack2(v1[0], v1[1]); o.w = pack2(v1[2], v1[3]);
                    *(uint4*)(rowp + bj * HALF) = o; } }
    }
};
struct XUnit { int row0, nrows, e, nt; };
template <class Epi>
__device__ __forceinline__ void gemm_phase_xg(LAS unsigned char* lds, const bf16_t* Ag, const int* slot_tk, const int* xt, const bf16_t* BtW, const int nun, const int lb, const int G, const Epi& E) {
    int tid = threadIdx.x; asm volatile("" : "+v"(tid));
    const int wid = __builtin_amdgcn_readfirstlane(tid >> 6), lane = tid & 63, wr = wid >> 2, wc = wid & 3, fr = lane & 15, fq = lane >> 4;
    constexpr int K = 1024, nt = K / BK;
    unsigned voffB[2];
#pragma unroll
    for (int i = 0; i < 2; ++i) { int R, C; stage_rc(tid * 16 + i * 8192, R, C); voffB[i] = (unsigned)(R * K + C) * 2u; }
    const size_t kstep = (size_t)(BK * 2), hstepB = (size_t)HALF * K * 2;
    const unsigned ldsw = (unsigned)wid * 1024u;
    const int aoff = lds_byte(wr * 64 + fr, fq * 8), boff = lds_byte(wc * 32 + fr, fq * 8);
#define PG8_SA(b, h) (((b) * 2 + (h)) * HTB)
#define PG8_SB(b, h) ((4 + (b) * 2 + (h)) * HTB)
#define PG8_STAGE(bufoff, gbase, voff) do { _Pragma("unroll") for (int _i = 0; _i < 2; ++_i) \
        __builtin_amdgcn_global_load_lds((const unsigned*)((const char*)(gbase) + (voff)[_i]), (LAS unsigned*)(lds + (bufoff) + ldsw + _i * 8192), 16, 0, 0); } while (0)
#define PG8_LDA(dst, b, h) do { _Pragma("unroll") for (int m = 0; m < 4; ++m) _Pragma("unroll") for (int k = 0; k < 2; ++k) dst[m][k] = *(const LAS bf16x8*)(lds + PG8_SA(b, h) + aoff + m * 2048 + k * 1024); } while (0)
#define PG8_LDB(dst, b, h) do { _Pragma("unroll") for (int n = 0; n < 2; ++n) _Pragma("unroll") for (int k = 0; k < 2; ++k) dst[n][k] = *(const LAS bf16x8*)(lds + PG8_SB(b, h) + boff + n * 2048 + k * 1024); } while (0)
#define PG8_MMA(ai, bj, At, Bt) do { __builtin_amdgcn_s_setprio(1); _Pragma("unroll") for (int m = 0; m < 4; ++m) _Pragma("unroll") for (int n = 0; n < 2; ++n) _Pragma("unroll") for (int k = 0; k < 2; ++k) \
        acc[ai][bj][m][n] = __builtin_amdgcn_mfma_f32_16x16x32_bf16(Bt[n][k], At[m][k], acc[ai][bj][m][n], 0, 0, 0); __builtin_amdgcn_s_setprio(0); } while (0)
#define PG8_WAIT_V(n) asm volatile("s_waitcnt vmcnt(" #n ")" ::: "memory")
#define PG8_WAIT_L(n) asm volatile("s_waitcnt lgkmcnt(" #n ")" ::: "memory")
#define PG8_BAR __builtin_amdgcn_s_barrier()
#define PG8_SCHED __builtin_amdgcn_sched_barrier(0)
#define XG_UNIT(I, U) ((lb + (I) * G) < nun ? ((U).row0 = xt[((lb + (I) * G) >> 1) * 4 + 1], (U).nrows = xt[((lb + (I) * G) >> 1) * 4 + 2], (U).e = xt[((lb + (I) * G) >> 1) * 4], (U).nt = (lb + (I) * G) & 1, true) : false)
#define XG_AVOFF(U, V0, V1) do { int t_ = threadIdx.x; asm volatile("" : "+v"(t_)); _Pragma("unroll") for (int _i = 0; _i < 2; ++_i) { int R_, C_; stage_rc(t_ * 16 + _i * 8192, R_, C_); \
        V0[_i] = (unsigned)(slot_tk[(U).row0 + R_] / 9) * 2048u + (unsigned)C_ * 2u; V1[_i] = (unsigned)(slot_tk[(U).row0 + 128 + R_] / 9) * 2048u + (unsigned)C_ * 2u; } } while (0)
    XUnit cur, nxt; int ui = 0;
    if (!XG_UNIT(0, cur)) return;
    f32x4 acc[2][2][4][2];
#pragma unroll
    for (int a = 0; a < 2; ++a)
#pragma unroll
        for (int b = 0; b < 2; ++b)
#pragma unroll
            for (int m = 0; m < 4; ++m)
#pragma unroll
                for (int n = 0; n < 2; ++n) acc[a][b][m][n] = (f32x4){0.f, 0.f, 0.f, 0.f};
    bf16x8 At[4][2], B0[2][2], B1[2][2];
    unsigned vC0[2], vC1[2], vN1[2];
    XG_AVOFF(cur, vC0, vC1);
    const char* cA = (const char*)Ag;
    const char* cB = (const char*)(BtW + ((size_t)cur.e * 512 + cur.nt * 256) * K);
    PG8_STAGE(PG8_SB(0, 0), cB, voffB); PG8_STAGE(PG8_SA(0, 0), cA, vC0); PG8_STAGE(PG8_SB(0, 1), cB + hstepB, voffB); PG8_STAGE(PG8_SA(0, 1), cA, vC1);
    if (wr == 1) PG8_BAR;
    PG8_WAIT_V(4); PG8_BAR;
    PG8_STAGE(PG8_SB(1, 0), cB + kstep, voffB); PG8_STAGE(PG8_SA(1, 0), cA + kstep, vC0); PG8_STAGE(PG8_SB(1, 1), cB + hstepB + kstep, voffB);
    PG8_WAIT_V(6); PG8_BAR;
    for (;;) {
        const bool has_next = XG_UNIT(ui + 1, nxt);
        if (!has_next) nxt = cur;
        const char* nB = (const char*)(BtW + ((size_t)nxt.e * 512 + nxt.nt * 256) * K);
        for (int t = 0; t < nt; t += 2) {
            const bool last = (t == nt - 2);
            if (last) XG_AVOFF(nxt, vC0, vN1);
            const char* a1 = cA + (size_t)(t + 1) * kstep;
            const char* a2 = last ? cA : cA + (size_t)(t + 2) * kstep; const char* b2 = last ? nB : cB + (size_t)(t + 2) * kstep;
            const char* a3 = a2 + kstep; const char* b3 = b2 + kstep;
            PG8_LDB(B0, 0, 0); PG8_SCHED; PG8_LDA(At, 0, 0); PG8_STAGE(PG8_SA(1, 1), a1, vC1);
            if (last) { vC1[0] = vN1[0]; vC1[1] = vN1[1]; }
            PG8_WAIT_L(8); PG8_BAR; PG8_WAIT_L(0); PG8_MMA(0, 0, At, B0); PG8_BAR; PG8_SCHED;
            PG8_LDB(B1, 0, 1); PG8_STAGE(PG8_SB(0, 0), b2, voffB);
            PG8_BAR; PG8_WAIT_L(0); PG8_MMA(0, 1, At, B1); PG8_BAR;
            PG8_LDA(At, 0, 1); PG8_STAGE(PG8_SA(0, 0), a2, vC0);
            PG8_BAR; PG8_WAIT_L(0); PG8_MMA(1, 0, At, B0); PG8_BAR; PG8_SCHED;
            PG8_STAGE(PG8_SB(0, 1), b2 + hstepB, voffB);
            PG8_WAIT_V(6); PG8_BAR; PG8_MMA(1, 1, At, B1); PG8_BAR;
            PG8_LDB(B0, 1, 0); PG8_SCHED; PG8_LDA(At, 1, 0); PG8_STAGE(PG8_SA(0, 1), a2, vC1);
            PG8_WAIT_L(8); PG8_BAR; PG8_WAIT_L(0); PG8_MMA(0, 0, At, B0); PG8_BAR; PG8_SCHED;
            PG8_LDB(B1, 1, 1); PG8_STAGE(PG8_SB(1, 0), b3, voffB);
            PG8_BAR; PG8_WAIT_L(0); PG8_MMA(0, 1, At, B1); PG8_BAR;
            PG8_LDA(At, 1, 1); PG8_STAGE(PG8_SA(1, 0), a3, vC0);
            PG8_BAR; PG8_WAIT_L(0); PG8_MMA(1, 0, At, B0); PG8_BAR; PG8_SCHED;
            PG8_STAGE(PG8_SB(1, 1), b3 + hstepB, voffB);
            PG8_WAIT_V(6); PG8_BAR; PG8_MMA(1, 1, At, B1); PG8_BAR;
        }
        E(acc, cur, wr, wc, fr, fq);
        if (!has_next) break;
#pragma unroll
        for (int a = 0; a < 2; ++a)
#pragma unroll
            for (int b = 0; b < 2; ++b)
#pragma unroll
                for (int m = 0; m < 4; ++m)
#pragma unroll
                    for (int n = 0; n < 2; ++n) acc[a][b][m][n] = (f32x4){0.f, 0.f, 0.f, 0.f};
        cur = nxt; cB = nB; ++ui;
    }
    PG8_WAIT_V(0);
    if (wr == 0) PG8_BAR;
    PG8_BAR;
#undef PG8_SA
#undef PG8_SB
#undef PG8_STAGE
#undef PG8_LDA
#undef PG8_LDB
#undef PG8_MMA
#undef PG8_WAIT_V
#undef PG8_WAIT_L
#undef PG8_BAR
#undef PG8_SCHED
#undef XG_UNIT
#undef XG_AVOFF
}
struct EpiGU {
    bf16_t* act;
    __device__ __forceinline__ void operator()(const f32x4 (&acc)[2][2][4][2], const XUnit& u, int wr, int wc, int fr, int fq) const {
        const int r0 = wr * 64 + fr;
#pragma unroll
        for (int ai = 0; ai < 2; ++ai)
#pragma unroll
            for (int m = 0; m < 4; ++m) { const int r = r0 + ai * HALF + m * 16;
                if (r < u.nrows) { bf16_t* rowp = act + (size_t)(u.row0 + r) * 256 + u.nt * 128 + wc * 16 + fq * 4;
#pragma unroll
                    for (int bj = 0; bj < 2; ++bj) { const f32x4 g = acc[ai][bj][m][0], up = acc[ai][bj][m][1];
                        uint2 o; o.x = pack2(g[0] * sigm(g[0]) * up[0], g[1] * sigm(g[1]) * up[1]); o.y = pack2(g[2] * sigm(g[2]) * up[2], g[3] * sigm(g[3]) * up[3]);
                        *(uint2*)(rowp + bj * 64) = o; } } }
    }
};
}

template <class DescF, class EpiF>
__device__ __forceinline__ void stream_gemm128(char* smem, const int nunits, const DescF& desc, const EpiF& epi) {
    constexpr int STAGE = 2 * TILE_BYTES;
    const int tid = tidx(), wave = tid >> 6, lane = tid & 63, fr = lane & 15, fq = lane >> 4;
    const int wm = wave >> 1, wn = wave & 1;
    const int lrow = tid >> 3, lseg = tid & 7, G = gridDim.x;
    if ((int)blockIdx.x >= nunits) return;
    uint4 ra0, ra1, rb0, rb1;
    const char* la = nullptr; const char* lbp = nullptr; unsigned lao0 = 0, lao1 = 0, lbo0 = 0, lbo1 = 0;
    int lu = blockIdx.x, lkt = 0, lnk = 0;
    int cu = blockIdx.x, ckt = 0, cnk = 0;
#define SG_DESC() do { const bf16_t* A_; const bf16_t* B_; int lda_, ldb_; desc(lu, A_, B_, lda_, ldb_, lnk); la = (const char*)A_; lbp = (const char*)B_; \
        lao0 = (unsigned)(lrow * lda_) * 2u + lseg * 16; lao1 = (unsigned)((lrow + 64) * lda_) * 2u + lseg * 16; lbo0 = (unsigned)(lrow * ldb_) * 2u + lseg * 16; lbo1 = (unsigned)((lrow + 64) * ldb_) * 2u + lseg * 16; } while (0)
#define SG_LOAD() do { ra0 = *(const uint4*)(la + (lao0 + lkt * 128)); ra1 = *(const uint4*)(la + (lao1 + lkt * 128)); rb0 = *(const uint4*)(lbp + (lbo0 + lkt * 128)); rb1 = *(const uint4*)(lbp + (lbo1 + lkt * 128)); } while (0)
#define SG_STORE(ST) do { char* As_ = smem + (ST) * STAGE; char* Bs_ = As_ + TILE_BYTES; \
        *(uint4*)(As_ + lrow * TSTR + lseg * 16) = ra0; *(uint4*)(As_ + (lrow + 64) * TSTR + lseg * 16) = ra1; *(uint4*)(Bs_ + lrow * TSTR + lseg * 16) = rb0; *(uint4*)(Bs_ + (lrow + 64) * TSTR + lseg * 16) = rb1; } while (0)
#define SG_ADV() do { if (++lkt == lnk) { lkt = 0; lu += G; if (lu < nunits) SG_DESC(); } } while (0)
    f32x4 acc[2][4];
#pragma unroll
    for (int mi = 0; mi < 2; ++mi)
#pragma unroll
        for (int ni = 0; ni < 4; ++ni) acc[mi][ni] = (f32x4){0.f, 0.f, 0.f, 0.f};
    SG_DESC(); cnk = lnk;
    SG_LOAD(); SG_STORE(0); SG_ADV(); __syncthreads();
    for (int s = 0; cu < nunits; ++s) {
        const bool more = lu < nunits;
        if (more) SG_LOAD();
        const char* As = smem + (s & 1) * STAGE; const char* Bs = As + TILE_BYTES;
#pragma unroll
        for (int ks = 0; ks < 2; ++ks) {
            bf16x8 af[2], bfr[4];
#pragma unroll
            for (int mi = 0; mi < 2; ++mi) af[mi] = *(const bf16x8*)(As + (wm * 32 + mi * 16 + fr) * TSTR + ks * 64 + fq * 16);
#pragma unroll
            for (int ni = 0; ni < 4; ++ni) bfr[ni] = *(const bf16x8*)(Bs + (wn * 64 + ni * 16 + fr) * TSTR + ks * 64 + fq * 16);
#pragma unroll
            for (int mi = 0; mi < 2; ++mi)
#pragma unroll
                for (int ni = 0; ni < 4; ++ni) acc[mi][ni] = __builtin_amdgcn_mfma_f32_16x16x32_bf16(bfr[ni], af[mi], acc[mi][ni], 0, 0, 0);
        }
        if (++ckt == cnk) {
            epi(cu, acc, wm * 32 + fr, wn * 64 + fq * 4);
#pragma unroll
            for (int mi = 0; mi < 2; ++mi)
#pragma unroll
                for (int ni = 0; ni < 4; ++ni) acc[mi][ni] = (f32x4){0.f, 0.f, 0.f, 0.f};
            ckt = 0; cu += G;
            if (cu < nunits) { const bf16_t* A_; const bf16_t* B_; int lda_, ldb_; desc(cu, A_, B_, lda_, ldb_, cnk); }
        }
        if (more) { SG_STORE((s + 1) & 1); SG_ADV(); }
        __syncthreads();
    }
#undef SG_DESC
#undef SG_LOAD
#undef SG_STORE
#undef SG_ADV
}

__device__ __forceinline__ void conv_gu_tiles(const Params& p, char* smem, int w0, int nw, int t_begin, int t_end) {
    const int tid = tidx(), wave = tid >> 6, lane = tid & 63;
    bf16_t* T = (bf16_t*)smem + wave * (2 * 16 * 72);
    for (int tau = t_begin + w0 * 2; tau < t_end; tau += nw * 2) {
        float4 v[2][4];
#pragma unroll
        for (int h = 0; h < 2; ++h) {
            const int tt = tau + h < t_end ? tau + h : tau;
            const int m = tt >> 8, kb = (tt >> 4) & 15, nb = tt & 15, e = m >> 1, sel = m & 1;
            const float* src = (sel ? (e < 256 ? p.exp_w_up + (size_t)e * 262144 : p.sh_w_up) : (e < 256 ? p.exp_w_gate + (size_t)e * 262144 : p.sh_w_gate)) + (size_t)(kb * 64 + lane) * 256 + nb * 16;
#pragma unroll
            for (int i = 0; i < 4; ++i) v[h][i] = *(const float4*)(src + i * 4);
        }
#pragma unroll
        for (int h = 0; h < 2; ++h) {
            if (tau + h >= t_end) break;
            const int tt = tau + h;
            const int m = tt >> 8, kb = (tt >> 4) & 15, nb = tt & 15, e = m >> 1, sel = m & 1;
            bf16_t* Th = T + h * (16 * 72);
#pragma unroll
            for (int i = 0; i < 4; ++i) { Th[(i * 4 + 0) * 72 + lane] = f2bf(v[h][i].x); Th[(i * 4 + 1) * 72 + lane] = f2bf(v[h][i].y); Th[(i * 4 + 2) * 72 + lane] = f2bf(v[h][i].z); Th[(i * 4 + 3) * 72 + lane] = f2bf(v[h][i].w); }
            const int q = lane >> 2, seg = lane & 3;
            const uint4 o0 = *(const uint4*)(Th + q * 72 + seg * 16), o1 = *(const uint4*)(Th + q * 72 + seg * 16 + 8);
            const int rho = (nb >> 3) * 256 + ((nb >> 2) & 1) * 128 + (nb & 3) * 32 + sel * 16 + q;
            bf16_t* d = p.BtW + ((size_t)e * 512 + rho) * 1024 + kb * 64 + seg * 16;
            *(uint4*)d = o0; *(uint4*)(d + 8) = o1;
        }
    }
}

__device__ __forceinline__ void phase0(const Params& p, char* smem) {
    const int tid = tidx(), wave = tid >> 6, lane = tid & 63;
    const int gw = blockIdx.x * 8 + wave, nw = gridDim.x * 8;
    for (int u = gw; u < 1536; u += nw) {
        const int cb = u % 96, ks = u / 96, j = cb * 64 + lane;
        float a0 = 0.f, a1 = 0.f;
#pragma unroll 1
        for (int k0 = ks * 64; k0 < ks * 64 + 64; k0 += 16) {
            float w[16];
#pragma unroll
            for (int i = 0; i < 16; ++i) w[i] = p.w_mod[(size_t)(k0 + i) * 6144 + j];
#pragma unroll
            for (int i = 0; i < 16; ++i) { const float c0 = p.c[k0 + i], c1 = p.c_ctx[k0 + i]; a0 += c0 * sigm(c0) * w[i]; a1 += c1 * sigm(c1) * w[i]; }
        }
        p.modp[(ks * 2 + 0) * 6144 + j] = a0; p.modp[(ks * 2 + 1) * 6144 + j] = a1;
    }
    float* T = (float*)smem;
    int total = 0;
    for (int j = 0; j < NJOB; ++j) total += (p.jobs[j].K >> 6) * (p.jobs[j].N >> 6);
    for (int u = blockIdx.x; u < total; u += gridDim.x) {
        int j = 0, r = u;
        for (;; ++j) { const int n = (p.jobs[j].K >> 6) * (p.jobs[j].N >> 6); if (r < n) break; r -= n; }
        const TJob jb = p.jobs[j];
        const int ntn = jb.N >> 6, kt = r / ntn, nt = r % ntn, k0 = kt * 64, n0 = nt * 64;
        {
            const int kk = tid >> 4, c4 = (tid & 15) * 4;
#pragma unroll
            for (int i = 0; i < 2; ++i) {
                const int k = kk + 32 * i;
                const float4 v = *(const float4*)(jb.src + (size_t)(k0 + k) * jb.N + n0 + c4);
                T[k * 65 + c4 + 0] = v.x; T[k * 65 + c4 + 1] = v.y; T[k * 65 + c4 + 2] = v.z; T[k * 65 + c4 + 3] = v.w;
            }
        }
        __syncthreads();
        {
            const int n = tid >> 3, ks = (tid & 7) * 8;
            float v[8];
#pragma unroll
            for (int q = 0; q < 8; ++q) v[q] = T[(ks + q) * 65 + n];
            const int ng = n0 + n;
            int drow = jb.rowoff + ng;
            if (jb.mode == 2) drow = (ng >> 4) * 32 + (ng & 15) + jb.rowoff;
            uint4 hi; hi.x = pack2(v[0], v[1]); hi.y = pack2(v[2], v[3]); hi.z = pack2(v[4], v[5]); hi.w = pack2(v[6], v[7]);
            bf16_t* d = jb.dst + (size_t)drow * jb.dld + jb.coloff + k0 + ks;
            *(uint4*)d = hi;
            if (jb.mode == 1) {
                float l[8];
#pragma unroll
                for (int q = 0; q < 8; ++q) l[q] = v[q] - bf2f(f2bf(v[q]));
                uint4 lo; lo.x = pack2(l[0], l[1]); lo.y = pack2(l[2], l[3]); lo.z = pack2(l[4], l[5]); lo.w = pack2(l[6], l[7]);
                *(uint4*)(d + 1024) = hi; *(uint4*)(d + 2048) = lo;
            }
        }
        __syncthreads();
    }
}

__device__ __forceinline__ void phase1(const Params& p, char* smem) {
    const int tid = tidx(), wave = tid >> 6, lane = tid & 63;
    float* L = (float*)smem;
    for (int idx = tid; idx < 4096; idx += NT) {
        const int v = idx >> 11, which = (idx >> 10) & 1, col = idx & 1023;
        float s = p.b_mod[which * 1024 + col];
        for (int ks = 0; ks < 16; ++ks) s += p.modp[(ks * 2 + v) * 6144 + which * 1024 + col];
        L[idx] = s;
    }
    for (int idx = blockIdx.x * NT + tid; idx < 2 * 6144; idx += gridDim.x * NT) {
        const int v = idx / 6144, j = idx % 6144;
        float sm = p.b_mod[j];
#pragma unroll
        for (int ks = 0; ks < 16; ++ks) sm += p.modp[(ks * 2 + v) * 6144 + j];
        p.mod[idx] = sm;
    }
    __syncthreads();
    const int gw = blockIdx.x * 8 + wave, nw = gridDim.x * 8;
    for (int r0 = gw; r0 < TE; r0 += 2 * nw) {
        float4 xv[2][4]; float ss[2];
#pragma unroll
        for (int h = 0; h < 2; ++h) {
            const int r = r0 + h * nw < TE ? r0 + h * nw : r0;
            const float* src = r < 256 ? p.ctx + (size_t)r * 1024 : p.x + (size_t)(r - 256) * 1024;
            ss[h] = 0.f;
#pragma unroll
            for (int i = 0; i < 4; ++i) { xv[h][i] = *(const float4*)(src + i * 256 + lane * 4); ss[h] += xv[h][i].x * xv[h][i].x + xv[h][i].y * xv[h][i].y + xv[h][i].z * xv[h][i].z + xv[h][i].w * xv[h][i].w; }
        }
#pragma unroll
        for (int h = 0; h < 2; ++h) {
            const int r = r0 + h * nw;
            if (r >= TE) break;
            const int v = r < 256 ? 1 : 0;
            const float rs = rsqrtf(wsum(ss[h]) * (1.f / 1024.f) + 1e-6f);
#pragma unroll
            for (int i = 0; i < 4; ++i) {
                const int col = i * 256 + lane * 4;
                const float4 g = *(const float4*)(p.n_pre_mix + col);
                const float* sh = L + v * 2048 + col; const float* sc = L + v * 2048 + 1024 + col;
                const float y0 = xv[h][i].x * rs * g.x * (1.f + sc[0]) + sh[0];
                const float y1 = xv[h][i].y * rs * g.y * (1.f + sc[1]) + sh[1];
                const float y2 = xv[h][i].z * rs * g.z * (1.f + sc[2]) + sh[2];
                const float y3 = xv[h][i].w * rs * g.w * (1.f + sc[3]) + sh[3];
                uint2 o; o.x = pack2(y0, y1); o.y = pack2(y2, y3);
                *(uint2*)(p.hn + (size_t)r * 1024 + col) = o;
            }
        }
    }
}

__device__ __forceinline__ void phase2(const Params& p, char* smem) {
    g8::StaticOrder S; S.init(TE, INC, gridDim.x, blockIdx.x);
    g8::EpiBf16 E{p.proj, INC};
    g8::gemm_phase((LAS unsigned char*)smem, p.hn, p.WinT, 1024, 1024, 1024, S, E);
}

__device__ __forceinline__ void phase3(const Params& p, char* smem) {
    const int tid = tidx(), wave = tid >> 6, lane = tid & 63;
    const int gw = blockIdx.x * 8 + wave, nw = gridDim.x * 8;
    float mu0[3][8], mu1[3][8], kkw[8], lm0[4], lm1[4];
#pragma unroll
    for (int a = 0; a < 3; ++a)
#pragma unroll
        for (int q = 0; q < 8; ++q) { mu0[a][q] = p.shift_mu[a * 512 + lane * 8 + q]; mu1[a][q] = p.shift_mu[1792 + a * 512 + lane * 8 + q]; }
#pragma unroll
    for (int q = 0; q < 8; ++q) kkw[q] = p.rwkv_k_k[lane * 8 + q];
#pragma unroll
    for (int q = 0; q < 4; ++q) { lm0[q] = p.shift_mu[1536 + lane * 4 + q]; lm1[q] = p.shift_mu[1792 + 1536 + lane * 4 + q]; }
    for (int t = gw; t < TE; t += nw) {
        const bool hp = (t != 0 && t != 256), hn_ = (t != 255 && t != TE - 1);
        const bf16_t* pr = p.proj + (size_t)t * INC;
        uint4 q0[3], qm[3], qn[3]; uint2 l0, lm = make_uint2(0, 0), ln = make_uint2(0, 0);
#pragma unroll
        for (int a = 0; a < 3; ++a) {
            q0[a] = *(const uint4*)(pr + a * 512 + lane * 8);
            qm[a] = hp ? *(const uint4*)(pr + a * 512 + lane * 8 - INC) : make_uint4(0, 0, 0, 0);
            qn[a] = hn_ ? *(const uint4*)(pr + a * 512 + lane * 8 + INC) : make_uint4(0, 0, 0, 0);
        }
        l0 = *(const uint2*)(pr + 1536 + lane * 4);
        if (hp) lm = *(const uint2*)(pr + 1536 + lane * 4 - INC);
        if (hn_) ln = *(const uint2*)(pr + 1536 + lane * 4 + INC);
        float val[3][8];
#pragma unroll
        for (int a = 0; a < 3; ++a) {
            float f0[8], fm[8], fn[8]; unpack8(q0[a], f0); unpack8(qm[a], fm); unpack8(qn[a], fn);
#pragma unroll
            for (int q = 0; q < 8; ++q) val[a][q] = f0[q] + mu0[a][q] * (fm[q] - f0[q]) + mu1[a][q] * (fn[q] - f0[q]);
        }
        float kkv[8], n2 = 0.f;
#pragma unroll
        for (int q = 0; q < 8; ++q) { kkv[q] = val[1][q] * kkw[q]; n2 += kkv[q] * kkv[q]; }
        n2 = sum8(n2);
        const float inv = -1.f / fmaxf(sqrtf(n2), 1e-12f);
#pragma unroll
        for (int q = 0; q < 8; ++q) kkv[q] *= inv;
        const size_t o = (size_t)t * 512 + lane * 8;
        *(uint4*)(p.Rr + o) = pack8(val[0]); *(uint4*)(p.Kk + o) = pack8(val[1]); *(uint4*)(p.Vv + o) = pack8(val[2]); *(uint4*)(p.Aa + o) = pack8(kkv);
        {
            float v[4];
            const unsigned w0[2] = {l0.x, l0.y}, wm[2] = {lm.x, lm.y}, wn[2] = {ln.x, ln.y};
#pragma unroll
            for (int q = 0; q < 4; ++q) {
                const float p0 = (q & 1) ? __uint_as_float(w0[q >> 1] & 0xffff0000u) : __uint_as_float(w0[q >> 1] << 16);
                const float pm = (q & 1) ? __uint_as_float(wm[q >> 1] & 0xffff0000u) : __uint_as_float(wm[q >> 1] << 16);
                const float pn = (q & 1) ? __uint_as_float(wn[q >> 1] & 0xffff0000u) : __uint_as_float(wn[q >> 1] << 16);
                v[q] = p0 + lm0[q] * (pm - p0) + lm1[q] * (pn - p0);
            }
            if (lane < 16) {
                uint2 ov; ov.x = pack2(tanhf(v[0]), tanhf(v[1])); ov.y = pack2(tanhf(v[2]), tanhf(v[3]));
                *(uint2*)(p.TW + (size_t)t * 64 + lane * 4) = ov;
            } else if (lane < 32) {
                uint2 ov; ov.x = pack2(v[0], v[1]); ov.y = pack2(v[2], v[3]);
                *(uint2*)(p.XA + (size_t)t * 64 + (lane - 16) * 4) = ov;
            } else {
                uint2 ov; ov.x = pack2(sigm(v[0]), sigm(v[1])); ov.y = pack2(sigm(v[2]), sigm(v[3]));
                *(uint2*)(p.SG + (size_t)t * 128 + (lane - 32) * 4) = ov;
            }
        }
    }
}

__device__ __forceinline__ void phase4(const Params& p, char* smem) {
    stream_gemm128(smem, 130 * 20,
        [&](int u, const bf16_t*& A, const bf16_t*& B, int& lda, int& ldb, int& nk) {
            const int mt = u / 20, q = u % 20;
            if (q < 8) { A = p.TW + (size_t)mt * 128 * 64; B = p.WupT + (size_t)q * 128 * 64; lda = 64; ldb = 64; nk = 1; }
            else if (q < 16) { A = p.XA + (size_t)mt * 128 * 64; B = p.AupT + (size_t)(q - 8) * 128 * 64; lda = 64; ldb = 64; nk = 1; }
            else { A = p.SG + (size_t)mt * 128 * 128; B = p.GupT + (size_t)(q - 16) * 128 * 128; lda = 128; ldb = 128; nk = 2; }
        },
        [&](int u, const f32x4 (&acc)[2][4], int r0, int c0) {
            const int mt = u / 20, q = u % 20;
            if (q < 8) {
#pragma unroll
                for (int mi = 0; mi < 2; ++mi)
#pragma unroll
                    for (int ni = 0; ni < 4; ++ni) {
                        const int t = mt * 128 + r0 + mi * 16, cc = q * 128 + c0 + ni * 16, d = cc >> 9, c = cc & 511;
                        float4 o; float* op = (float*)&o;
#pragma unroll
                        for (int j = 0; j < 4; ++j) { const float z = p.rwkv_w0[d * 512 + c + j] + acc[mi][ni][j]; op[j] = __expf(-0.60653066f * sigm(z)); }
                        *(float4*)(p.Wd + ((size_t)d * TE + t) * 512 + c) = o;
                    }
            } else if (q < 16) {
                const int qq = q - 8;
#pragma unroll
                for (int mi = 0; mi < 2; ++mi)
#pragma unroll
                    for (int ni = 0; ni < 4; ++ni) {
                        const int t = mt * 128 + r0 + mi * 16, cc = qq * 128 + c0 + ni * 16, d = cc >> 9, c = cc & 511;
                        const uint2 av = *(const uint2*)(p.Aa + (size_t)t * 512 + c), kv = *(const uint2*)(p.Kk + (size_t)t * 512 + c);
                        const bf16_t* ae = (const bf16_t*)&av; const bf16_t* ke = (const bf16_t*)&kv;
                        float bo[4], ko[4];
#pragma unroll
                        for (int j = 0; j < 4; ++j) {
                            const float ad = sigm(p.rwkv_a0[d * 512 + c + j] + acc[mi][ni][j]);
                            bo[j] = -bf2f(ae[j]) * ad;
                            ko[j] = bf2f(ke[j]) * (1.f + (ad - 1.f) * p.rwkv_k_a[c + j]);
                        }
                        uint2 o1, o2; o1.x = pack2(bo[0], bo[1]); o1.y = pack2(bo[2], bo[3]); o2.x = pack2(ko[0], ko[1]); o2.y = pack2(ko[2], ko[3]);
                        *(uint2*)(p.Bd + ((size_t)d * TE + t) * 512 + c) = o1;
                        *(uint2*)(p.KD + ((size_t)d * TE + t) * 512 + c) = o2;
                    }
            } else {
                const int qq = q - 16;
#pragma unroll
                for (int mi = 0; mi < 2; ++mi)
#pragma unroll
                    for (int ni = 0; ni < 4; ++ni) {
                        const int t = mt * 128 + r0 + mi * 16, c = qq * 128 + c0 + ni * 16;
                        uint2 o; o.x = pack2(acc[mi][ni][0], acc[mi][ni][1]); o.y = pack2(acc[mi][ni][2], acc[mi][ni][3]);
                        *(uint2*)(p.G + (size_t)t * 512 + c) = o;
                    }
            }
        });
}

__device__ __forceinline__ void phase5(const Params& p, char* smem) {
    const int tid = tidx(), wave = __builtin_amdgcn_readfirstlane(tid >> 6), lane = tid & 63;
    constexpr int SB = 5, NA = 6, NSB = RL / SB;
    float* L = (float*)(smem + wave * (2 * SB * NA * 64 * 4 + 16 * 72 * 2));
    bf16_t* CT = (bf16_t*)(L + 2 * SB * NA * 64);
    for (int q = blockIdx.x * 8 + wave; q < RNC * 16; q += gridDim.x * 8) {
        const int j = q >> 4, hd = q & 15, dir = hd >> 3, h = hd & 7;
        const float* gW = p.Wd + (size_t)dir * TE * 512; const bf16_t* gB = p.Bd + (size_t)dir * TE * 512; const bf16_t* gK = p.KD + (size_t)dir * TE * 512;
        const bf16_t* gA = p.Aa; const bf16_t* gV = p.Vv; const bf16_t* gR = p.Rr;
        const unsigned lofs = (unsigned)(h * 64 + lane);
        bf16_t* gZ = p.Zz + (size_t)q * (RL * 64) + lane; bf16_t* gY = p.YH + (size_t)q * (RL * 64) + lane;
        f32x2 sP[32], sH[32];
        int ln = lane; asm volatile("" : "+v"(ln));
#pragma unroll
        for (int k = 0; k < 32; ++k) { sP[k] = (f32x2){(2 * k == ln) ? 1.f : 0.f, (2 * k + 1 == ln) ? 1.f : 0.f}; sH[k] = (f32x2){0.f, 0.f}; }
        for (int sb = 0; sb < NSB; ++sb) {
            {
                float st[SB][NA];
#pragma unroll
                for (int i = 0; i < SB; ++i) {
                    const unsigned g = (unsigned)row_of(dir, j * RL + sb * SB + i) * 512u + lofs;
                    st[i][0] = gW[g]; st[i][1] = bf2f(gA[g]); st[i][2] = bf2f(gB[g]); st[i][3] = bf2f(gK[g]); st[i][4] = bf2f(gV[g]); st[i][5] = bf2f(gR[g]);
                }
                float* d = L + (sb & 1) * (SB * NA * 64) + lane;
#pragma unroll
                for (int i = 0; i < SB; ++i)
#pragma unroll
                    for (int a = 0; a < NA; ++a) d[(i * NA + a) * 64] = st[i][a];
            }
            const float* Lb = L + (sb & 1) * (SB * NA * 64);
            float4 cv[3][4]; const int ctau = q * 65 + sb * 3;
#pragma unroll
            for (int h = 0; h < 3; ++h) {
                int tt = ctau + h; if (sb * 3 + h >= 65 || tt >= 514 * 256) tt = 0;
                const int m = tt >> 8, kb = (tt >> 4) & 15, nb = tt & 15, e = m >> 1, sel = m & 1;
                const float* src = (sel ? (e < 256 ? p.exp_w_up + (size_t)e * 262144 : p.sh_w_up) : (e < 256 ? p.exp_w_gate + (size_t)e * 262144 : p.sh_w_gate)) + (size_t)(kb * 64 + lane) * 256 + nb * 16;
#pragma unroll
                for (int i = 0; i < 4; ++i) cv[h][i] = *(const float4*)(src + i * 4);
            }
#pragma unroll 1
            for (int i = 0; i < SB; ++i) {
                const float* W = Lb + (i * NA) * 64; const float* A = W + 64; const float* B = W + 128; const float* KDv = W + 192; const float* R = W + 320;
                const float vl = W[256 + lane];
                f32x2 dh0 = {0.f, 0.f}, dh1 = {0.f, 0.f}, dp0 = {0.f, 0.f}, dp1 = {0.f, 0.f};
                f32x4 rw[2], rb[2], rk[2], rr[2];
                rw[0] = *(const f32x4*)(W); rb[0] = *(const f32x4*)(B); rk[0] = *(const f32x4*)(KDv); rr[0] = *(const f32x4*)(R);
#pragma unroll
                for (int c = 0; c < 4; ++c) {
                    const f32x4 ac0 = *(const f32x4*)(A + c * 16), ac1 = *(const f32x4*)(A + c * 16 + 4), ac2 = *(const f32x4*)(A + c * 16 + 8), ac3 = *(const f32x4*)(A + c * 16 + 12);
                    const int k = c * 8;
                    dh0 += sH[k] * ac0.lo; dh1 += sH[k + 1] * ac0.hi; dp0 += sP[k] * ac0.lo; dp1 += sP[k + 1] * ac0.hi;
                    dh0 += sH[k + 2] * ac1.lo; dh1 += sH[k + 3] * ac1.hi; dp0 += sP[k + 2] * ac1.lo; dp1 += sP[k + 3] * ac1.hi;
                    dh0 += sH[k + 4] * ac2.lo; dh1 += sH[k + 5] * ac2.hi; dp0 += sP[k + 4] * ac2.lo; dp1 += sP[k + 5] * ac2.hi;
                    dh0 += sH[k + 6] * ac3.lo; dh1 += sH[k + 7] * ac3.hi; dp0 += sP[k + 6] * ac3.lo; dp1 += sP[k + 7] * ac3.hi;
                    __builtin_amdgcn_sched_barrier(0);
                }
                const float saHs = (dh0.x + dh0.y) + (dh1.x + dh1.y), saPs = (dp0.x + dp0.y) + (dp1.x + dp1.y);
                const f32x2 saH = {saHs, saHs}, saP = {saPs, saPs}, vl2 = {vl, vl};
                f32x2 y0 = {0.f, 0.f}, y1 = {0.f, 0.f}, z0 = {0.f, 0.f}, z1 = {0.f, 0.f};
#pragma unroll
                for (int g = 0; g < 16; ++g) {
                    if (g + 1 < 16) { rw[(g + 1) & 1] = *(const f32x4*)(W + 4 * g + 4); rb[(g + 1) & 1] = *(const f32x4*)(B + 4 * g + 4); rk[(g + 1) & 1] = *(const f32x4*)(KDv + 4 * g + 4); rr[(g + 1) & 1] = *(const f32x4*)(R + 4 * g + 4); }
                    const f32x4 cw = rw[g & 1], cb = rb[g & 1], ck = rk[g & 1], cr = rr[g & 1];
                    const int k = 2 * g;
                    sH[k]     = sH[k]     * cw.lo + (saH * cb.lo + vl2 * ck.lo);
                    sH[k + 1] = sH[k + 1] * cw.hi + (saH * cb.hi + vl2 * ck.hi);
                    sP[k]     = sP[k]     * cw.lo + saP * cb.lo;
                    sP[k + 1] = sP[k + 1] * cw.hi + saP * cb.hi;
                    y0 += sH[k] * cr.lo; y1 += sH[k + 1] * cr.hi;
                    z0 += sP[k] * cr.lo; z1 += sP[k + 1] * cr.hi;
                    __builtin_amdgcn_sched_barrier(0);
                }
                const int t = sb * SB + i;
                gZ[t * 64] = f2bf((z0.x + z0.y) + (z1.x + z1.y)); gY[t * 64] = f2bf((y0.x + y0.y) + (y1.x + y1.y));
            }
#pragma unroll
            for (int h = 0; h < 3; ++h) {
                const int tt = ctau + h;
                if (sb * 3 + h < 65 && tt < 514 * 256) {
                    const int m = tt >> 8, kb = (tt >> 4) & 15, nb = tt & 15, e = m >> 1, sel = m & 1;
#pragma unroll
                    for (int i = 0; i < 4; ++i) {
                        const unsigned p01 = pack2(cv[h][i].x, cv[h][i].y), p23 = pack2(cv[h][i].z, cv[h][i].w);
                        CT[(i * 4 + 0) * 72 + lane] = (bf16_t)(p01 & 0xffffu); CT[(i * 4 + 1) * 72 + lane] = (bf16_t)(p01 >> 16);
                        CT[(i * 4 + 2) * 72 + lane] = (bf16_t)(p23 & 0xffffu); CT[(i * 4 + 3) * 72 + lane] = (bf16_t)(p23 >> 16);
                    }
                    const int cq = lane >> 2, seg = lane & 3;
                    const uint4 o0 = *(const uint4*)(CT + cq * 72 + seg * 16), o1 = *(const uint4*)(CT + cq * 72 + seg * 16 + 8);
                    const int rho = (nb >> 3) * 256 + ((nb >> 2) & 1) * 128 + (nb & 3) * 32 + sel * 16 + cq;
                    bf16_t* d = p.BtW + ((size_t)e * 512 + rho) * 1024 + kb * 64 + seg * 16;
                    *(uint4*)d = o0; *(uint4*)(d + 8) = o1;
                }
            }
        }
        if (j < RNC - 1) {
            float* dP = p.PH + (((size_t)(j * 16 + hd) * 2 + 0) * 64 + lane) * 64;
            float* dH = p.PH + (((size_t)(j * 16 + hd) * 2 + 1) * 64 + lane) * 64;
#pragma unroll
            for (int k = 0; k < 32; k += 2) { *(float4*)(dP + 2 * k) = make_float4(sP[k].x, sP[k].y, sP[k + 1].x, sP[k + 1].y); *(float4*)(dH + 2 * k) = make_float4(sH[k].x, sH[k].y, sH[k + 1].x, sH[k + 1].y); }
        }
    }
}

__device__ __forceinline__ void phase6(const Params& p, char* smem) {
    const int tid = threadIdx.x, wave = __builtin_amdgcn_readfirstlane(tid >> 6), lane = tid & 63;
    if (blockIdx.x >= 256) return;
    const int hd = blockIdx.x >> 4, rb0 = (blockIdx.x & 15) * 4, r0 = rb0 + (wave & 3);
    LAS unsigned char* lds = (LAS unsigned char*)smem;
    constexpr int SLOT = 17408, NJ = RNC - 1;
    const char* pbase = (const char*)(p.PH + (size_t)hd * 2 * 4096);
    float s0 = 0.f;
#define CH_ISSUE(J) do { const char* src_ = pbase + (size_t)(J) * 524288; const unsigned so_ = (unsigned)(((J) & 7) * SLOT); \
        _Pragma("unroll") for (int q_ = 0; q_ < 4; ++q_) __builtin_amdgcn_global_load_lds((const unsigned*)(src_ + ((wave - 4) * 4 + q_) * 1024 + lane * 16), (LAS unsigned*)(lds + so_ + ((wave - 4) * 4 + q_) * 1024), 16, 0, 0); \
        if (wave == 7) __builtin_amdgcn_global_load_lds((const unsigned*)(src_ + 16384 + rb0 * 256 + lane * 16), (LAS unsigned*)(lds + so_ + 16384), 16, 0, 0); } while (0)
    if (wave >= 4) { CH_ISSUE(0); CH_ISSUE(1); CH_ISSUE(2); CH_ISSUE(3); CH_ISSUE(4); CH_ISSUE(5); CH_ISSUE(6); }
    for (int j = 0; j < RNC; ++j) {
        if (wave < 4) p.Sst[((size_t)(j * 16 + hd) * 64 + r0) * 64 + lane] = s0;
        if (j == NJ) break;
        if (wave >= 4) {
            if (j + 6 >= NJ) asm volatile("s_waitcnt vmcnt(0)" ::: "memory");
            else if (wave == 7) asm volatile("s_waitcnt vmcnt(30)" ::: "memory");
            else asm volatile("s_waitcnt vmcnt(24)" ::: "memory");
        }
        asm volatile("s_waitcnt lgkmcnt(0)" ::: "memory"); __builtin_amdgcn_s_barrier(); asm volatile("" ::: "memory");
        if (wave >= 4) { if (j + 7 < NJ) CH_ISSUE(j + 7); }
        else {
            const float* Pc = (const float*)(smem + (j & 7) * SLOT);
            f32x2 n0 = {Pc[4096 + wave * 64 + lane], 0.f}, n1 = {0.f, 0.f};
#pragma unroll
            for (int k = 0; k < 64; k += 4) {
                const f32x2 a0 = {__int_as_float(__builtin_amdgcn_readlane(__float_as_int(s0), k)), __int_as_float(__builtin_amdgcn_readlane(__float_as_int(s0), k + 1))};
                const f32x2 a1 = {__int_as_float(__builtin_amdgcn_readlane(__float_as_int(s0), k + 2)), __int_as_float(__builtin_amdgcn_readlane(__float_as_int(s0), k + 3))};
                const f32x2 p0 = {Pc[k * 64 + lane], Pc[(k + 1) * 64 + lane]}, p1 = {Pc[(k + 2) * 64 + lane], Pc[(k + 3) * 64 + lane]};
                n0 += a0 * p0; n1 += a1 * p1;
            }
            s0 = (n0.x + n0.y) + (n1.x + n1.y);
        }
    }
#undef CH_ISSUE
    __syncthreads();
}

__device__ __forceinline__ void phase7(const Params& p, char* smem) {
    const int tid = tidx(), wave = __builtin_amdgcn_readfirstlane(tid >> 6), lane = tid & 63;
    constexpr int SB = 10, NSB = RL / SB;
    float* L = (float*)smem + wave * (SB * 64);
    for (int q = 16 + blockIdx.x * 8 + wave; q < RNC * 16; q += gridDim.x * 8) {
        const int j = q >> 4, hd = q & 15, dir = hd >> 3, h = hd & 7;
        f32x2 s[32];
        {
            const float* src = p.Sst + ((size_t)(j * 16 + hd) * 64 + lane) * 64;
#pragma unroll
            for (int k = 0; k < 32; k += 2) { const f32x4 v = *(const f32x4*)(src + 2 * k); s[k] = v.lo; s[k + 1] = v.hi; }
        }
        const bf16_t* gZ = p.Zz + (size_t)q * (RL * 64) + lane; const bf16_t* gY = p.YH + (size_t)q * (RL * 64) + lane;
        bf16_t* gO = p.O + (size_t)dir * TX * 512 + h * 64 + lane;
        float zz[SB], yy[SB];
#pragma unroll
        for (int i = 0; i < SB; ++i) { zz[i] = bf2f(gZ[i * 64]); yy[i] = bf2f(gY[i * 64]); }
        for (int sb = 0; sb < NSB; ++sb) {
            float yc[SB];
#pragma unroll
            for (int i = 0; i < SB; ++i) { L[i * 64 + lane] = zz[i]; yc[i] = yy[i]; }
            { const int nsb = sb + 1 < NSB ? sb + 1 : sb;
#pragma unroll
              for (int i = 0; i < SB; ++i) { zz[i] = bf2f(gZ[(nsb * SB + i) * 64]); yy[i] = bf2f(gY[(nsb * SB + i) * 64]); } }
#pragma unroll
            for (int i = 0; i < SB; ++i) {
                const float* Z = L + i * 64;
                f32x2 y0 = {yc[i], 0.f}, y1 = {0.f, 0.f};
#pragma unroll
                for (int k = 0; k < 32; k += 2) { const f32x4 z = *(const f32x4*)(Z + 2 * k); y0 += s[k] * z.lo; y1 += s[k + 1] * z.hi; }
                const int row = row_of(dir, j * RL + sb * SB + i);
                if (row >= 256) gO[(size_t)(row - 256) * 512] = f2bf((y0.x + y0.y) + (y1.x + y1.y));
            }
        }
    }
}

__device__ __forceinline__ void phase8(const Params& p, char* smem) {
    const int tid = tidx();
    bf16_t* LT = (bf16_t*)smem;
    constexpr int LTS = 136;
    for (int u = blockIdx.x; u < NCH * 4; u += gridDim.x) {
        const int c = u < 512 ? 2 + (u >> 2) : ((u - 512) >> 2), hh = u & 3;
        const int upart = c >= 2 ? 2 : 3;
        const float g0 = sigm(p.ret_decay_logit[hh]), g1 = sigm(p.ret_decay_logit[4 + hh]);
        const float l0 = log2f(g0), l1 = log2f(g1);
        const int n = tid >> 2, part = tid & 3, half = part >> 1, fb = (part & 1) * 16;
        const int t = c * 128 + n;
        const bool lat = c >= 2;
        float pos = 0.f;
        if (lat) { const int tl = t - 256; pos = (float)(half == 0 ? (tl >> 6) : (tl & 63)); }
        const bf16_t* pr = p.proj + (size_t)t * INC;
        float cs[16], sn[16];
#pragma unroll
        for (int f = 0; f < 16; ++f) {
            if (lat) { const float inv = exp2f(-(float)(fb + f) * (13.287712379549449f / 32.f)); sincosf(pos * inv, &sn[f], &cs[f]); }
            else { cs[f] = 1.f; sn[f] = 0.f; }
        }
        const size_t ch = (size_t)(c * 4 + hh);
        uint4 kq1a, kq1b, kq2a, kq2b, vv0[4], vv1[4];
        { const int cbk = 2304 + hh * 128 + half * 64 + fb;
          kq1a = *(const uint4*)(pr + cbk); kq1b = *(const uint4*)(pr + cbk + 8); kq2a = *(const uint4*)(pr + cbk + 32); kq2b = *(const uint4*)(pr + cbk + 40);
          const int cbv = 2816 + hh * 256 + part * 32;
#pragma unroll
          for (int q = 0; q < 4; ++q) { vv0[q] = *(const uint4*)(pr + cbv + q * 8); vv1[q] = *(const uint4*)(pr + cbv + 128 + q * 8); } }
        if (upart == 2) {
            const int cb = 1792 + hh * 128 + half * 64 + fb;
            uint4 v1a = *(const uint4*)(pr + cb), v1b = *(const uint4*)(pr + cb + 8), v2a = *(const uint4*)(pr + cb + 32), v2b = *(const uint4*)(pr + cb + 40);
            bf16_t x1[16], x2[16];
            *(uint4*)&x1[0] = v1a; *(uint4*)&x1[8] = v1b; *(uint4*)&x2[0] = v2a; *(uint4*)&x2[8] = v2b;
            float o1[16], o2[16];
#pragma unroll
            for (int f = 0; f < 16; ++f) { const float a = bf2f(x1[f]), b = bf2f(x2[f]); o1[f] = a * cs[f] - b * sn[f]; o2[f] = a * sn[f] + b * cs[f]; }
            const float xf = exp2f(l0 * (float)(n + 1)), xb = exp2f(l1 * (float)(128 - n));
            bf16_t* qd = p.Qr + (ch * 128 + n) * 128 + half * 64 + fb;
            bf16_t* ad = p.A3 + (ch * 128 + n) * 384 + 128 + half * 64 + fb;
#pragma unroll
            for (int f = 0; f < 16; f += 2) {
                *(unsigned*)(qd + f) = pack2(o1[f], o1[f + 1]); *(unsigned*)(qd + 32 + f) = pack2(o2[f], o2[f + 1]);
                *(unsigned*)(ad + f) = pack2(o1[f] * xf, o1[f + 1] * xf); *(unsigned*)(ad + 32 + f) = pack2(o2[f] * xf, o2[f + 1] * xf);
                *(unsigned*)(ad + 128 + f) = pack2(o1[f] * xb, o1[f + 1] * xb); *(unsigned*)(ad + 128 + 32 + f) = pack2(o2[f] * xb, o2[f + 1] * xb);
            }
        }
        if (upart != 1) {
            const uint4 v1a = kq1a, v1b = kq1b, v2a = kq2a, v2b = kq2b;
            bf16_t x1[16], x2[16];
            *(uint4*)&x1[0] = v1a; *(uint4*)&x1[8] = v1b; *(uint4*)&x2[0] = v2a; *(uint4*)&x2[8] = v2b;
            const float sc = 0.08838834764831845f;
            bf16_t* kd = p.Kr + (ch * 128 + n) * 128 + half * 64 + fb;
            __syncthreads();
#pragma unroll
            for (int f = 0; f < 16; ++f) {
                const float a = bf2f(x1[f]) * sc, b = bf2f(x2[f]) * sc;
                const float o1 = a * cs[f] - b * sn[f], o2 = a * sn[f] + b * cs[f];
                const bf16_t h1 = f2bf(o1), h2 = f2bf(o2);
                kd[f] = h1; kd[32 + f] = h2;
                LT[(half * 64 + fb + f) * LTS + n] = h1; LT[(half * 64 + fb + f + 32) * LTS + n] = h2;
            }
            __syncthreads();
            const int d = tid >> 2, ms = (tid & 3) * 32;
#pragma unroll
            for (int dir = 0; dir < 2; ++dir) {
                bf16_t* od = p.KTz + ((ch * 2 + dir) * 128 + d) * 128 + ms;
#pragma unroll
                for (int m = 0; m < 32; m += 2) {
                    const int mm = ms + m;
                    const float z0 = dir == 0 ? exp2f(l0 * (float)(127 - mm)) : exp2f(l1 * (float)mm);
                    const float z1 = dir == 0 ? exp2f(l0 * (float)(126 - mm)) : exp2f(l1 * (float)(mm + 1));
                    *(unsigned*)(od + m) = pack2(bf2f(LT[d * LTS + mm]) * z0, bf2f(LT[d * LTS + mm + 1]) * z1);
                }
            }
        }
#pragma unroll 1
        for (int eh = (upart != 0 ? 0 : 2); eh < 2; ++eh) {
            __syncthreads();
            const int cb = 2816 + hh * 256 + eh * 128 + part * 32;
            bf16_t xv[32];
#pragma unroll
            for (int q = 0; q < 4; ++q) *(uint4*)&xv[q * 8] = eh == 0 ? vv0[q] : vv1[q];
#pragma unroll
            for (int f = 0; f < 32; ++f) LT[(part * 32 + f) * LTS + n] = xv[f];
            __syncthreads();
            const int e = tid >> 2, ms = (tid & 3) * 32;
            bf16_t* od = p.B3 + (ch * 256 + eh * 128 + e) * 384 + ms;
#pragma unroll
            for (int m = 0; m < 32; m += 8) *(uint4*)(od + m) = *(const uint4*)(LT + e * LTS + ms + m);
        }
        __syncthreads();
    }
}

__device__ __forceinline__ void phase9(const Params& p, char* smem) {
    stream_gemm128(smem, 512 + 2080,
        [&](int u, const bf16_t*& A, const bf16_t*& B, int& lda, int& ldb, int& nk) {
            if (u < 512) { const size_t ch = (size_t)((2 + (u >> 2)) * 4 + (u & 3)); A = p.Qr + ch * 128 * 128; B = p.Kr + ch * 128 * 128; lda = 128; ldb = 128; nk = 2; }
            else { const int v = u - 512, mt = v & 1, dir = (v >> 1) & 1, chh = v >> 2; A = p.B3 + ((size_t)chh * 256 + mt * 128) * 384; B = p.KTz + ((size_t)chh * 2 + dir) * 128 * 128; lda = 384; ldb = 128; nk = 2; }
        },
        [&](int u, const f32x4 (&acc)[2][4], int r0, int c0) {
            if (u < 512) {
                const int hh = u & 3; const size_t ch = (size_t)((2 + (u >> 2)) * 4 + hh);
                const float l0 = log2f(sigm(p.ret_decay_logit[hh])), l1 = log2f(sigm(p.ret_decay_logit[4 + hh]));
                bf16_t* outp = p.A3 + ch * 128 * 384;
#pragma unroll
                for (int mi = 0; mi < 2; ++mi)
#pragma unroll
                    for (int ni = 0; ni < 4; ++ni) {
                        const int n = r0 + mi * 16, m0 = c0 + ni * 16;
                        float o[4];
#pragma unroll
                        for (int j = 0; j < 4; ++j) {
                            const int m = m0 + j;
                            float w = 0.f;
                            if (n >= m) w += exp2f(l0 * (float)(n - m));
                            if (m >= n) w += exp2f(l1 * (float)(m - n));
                            o[j] = acc[mi][ni][j] * w;
                        }
                        uint2 ov; ov.x = pack2(o[0], o[1]); ov.y = pack2(o[2], o[3]);
                        *(uint2*)(outp + (size_t)n * 384 + m0) = ov;
                    }
            } else {
                const int v = u - 512, mt = v & 1, dir = (v >> 1) & 1, chh = v >> 2;
                bf16_t* outp = p.KVT + (((size_t)chh * 2 + dir) * 256 + mt * 128) * 128;
#pragma unroll
                for (int mi = 0; mi < 2; ++mi)
#pragma unroll
                    for (int ni = 0; ni < 4; ++ni) { uint2 o; o.x = pack2(acc[mi][ni][0], acc[mi][ni][1]); o.y = pack2(acc[mi][ni][2], acc[mi][ni][3]);
                        *(uint2*)(outp + (size_t)(r0 + mi * 16) * 128 + c0 + ni * 16) = o; }
            }
        });
}

__device__ __forceinline__ void phase10(const Params& p, char* smem) {
    for (int idx = blockIdx.x * NT + tidx(); idx < 131072; idx += gridDim.x * NT) {
        const int hh = idx >> 15, dir = (idx >> 14) & 1, e = (idx >> 6) & 255, d = (idx & 63) * 2;
        const float g = sigm(p.ret_decay_logit[dir * 4 + hh]);
        const float g128 = exp2f(128.f * log2f(g));
        float R0 = 0.f, R1 = 0.f;
        const bf16_t* kvb = p.KVT + ((size_t)(hh * 2 + dir) * 256 + e) * 128 + d;
        bf16_t* rtb = p.B3 + ((size_t)hh * 256 + e) * 384 + 128 + dir * 128 + d;
        for (int s0 = 0; s0 < NCH; s0 += 13) {
            unsigned kv[13];
#pragma unroll
            for (int i = 0; i < 13; ++i) { const int sc = s0 + i, c = dir == 0 ? sc : (sc < 2 ? 1 - sc : 131 - sc); kv[i] = *(const unsigned*)(kvb + (size_t)c * 262144); }
#pragma unroll
            for (int i = 0; i < 13; ++i) {
                const int sc = s0 + i, c = dir == 0 ? sc : (sc < 2 ? 1 - sc : 131 - sc);
                if (c >= 2) *(unsigned*)(rtb + (size_t)c * 393216) = pack2(R0, R1);
                R0 = g128 * R0 + __uint_as_float(kv[i] << 16); R1 = g128 * R1 + __uint_as_float(kv[i] & 0xffff0000u);
            }
        }
    }
}

__device__ __forceinline__ void phase11(const Params& p, char* smem) {
    stream_gemm128(smem, 1024,
        [&](int u, const bf16_t*& A, const bf16_t*& B, int& lda, int& ldb, int& nk) {
            const int nt = u & 1, chh = 8 + (u >> 1);
            A = p.A3 + (size_t)chh * 128 * 384; B = p.B3 + ((size_t)chh * 256 + nt * 128) * 384; lda = 384; ldb = 384; nk = 6;
        },
        [&](int u, const f32x4 (&acc)[2][4], int r0, int c0) {
            const int nt = u & 1, chh = 8 + (u >> 1), c = chh >> 2, hh = chh & 3;
            float* outp = p.Y + (size_t)((c - 2) * 128) * 1024 + hh * 256 + nt * 128;
#pragma unroll
            for (int mi = 0; mi < 2; ++mi)
#pragma unroll
                for (int ni = 0; ni < 4; ++ni) *(f32x4*)(outp + (size_t)(r0 + mi * 16) * 1024 + c0 + ni * 16) = acc[mi][ni];
        });
}

__device__ __forceinline__ void phase12(const Params& p, char* smem) {
    const int tid = tidx(), wave = tid >> 6, lane = tid & 63;
    const int gw = blockIdx.x * 8 + wave, nw = gridDim.x * 8;
    float lw[8], lb[8], rk[8];
#pragma unroll
    for (int q = 0; q < 8; ++q) { lw[q] = p.rwkv_ln_w[lane * 8 + q]; lb[q] = p.rwkv_ln_b[lane * 8 + q]; rk[q] = p.rwkv_r_k[lane * 8 + q]; }
    for (int t = gw; t < TX; t += nw) {
        const size_t te = (size_t)(t + 256) * 512 + lane * 8;
        const uint4 uof = *(const uint4*)(p.O + (size_t)t * 512 + lane * 8), uob = *(const uint4*)(p.O + ((size_t)TX + t) * 512 + lane * 8);
        const uint4 ur = *(const uint4*)(p.Rr + te), uk0 = *(const uint4*)(p.KD + te), uk1 = *(const uint4*)(p.KD + (size_t)TE * 512 + te), uv = *(const uint4*)(p.Vv + te), ug = *(const uint4*)(p.G + te);
        const float* yp = p.Y + (size_t)t * 1024 + lane * 16;
        const float4 y0 = *(const float4*)(yp), y1 = *(const float4*)(yp + 4), y2 = *(const float4*)(yp + 8), y3 = *(const float4*)(yp + 12);
        const bf16_t* gbp = p.proj + (size_t)(t + 256) * INC + 3840 + lane * 16;
        const uint4 ugb0 = *(const uint4*)(gbp), ugb1 = *(const uint4*)(gbp + 8);
        {
            float of[8], ob[8], r[8], k0[8], k1[8], v[8], gg[8], o[8];
            unpack8(uof, of); unpack8(uob, ob); unpack8(ur, r); unpack8(uk0, k0); unpack8(uk1, k1); unpack8(uv, v); unpack8(ug, gg);
            float sm = 0.f, bs = 0.f;
#pragma unroll
            for (int q = 0; q < 8; ++q) { o[q] = of[q] + ob[q]; sm += o[q]; bs += r[q] * (k0[q] + k1[q]) * rk[q]; }
            sm = sum8(sm); bs = sum8(bs);
            const float mu = sm * (1.f / 64.f);
            float vs = 0.f;
#pragma unroll
            for (int q = 0; q < 8; ++q) { o[q] -= mu; vs += o[q] * o[q]; }
            vs = sum8(vs);
            const float rs = rsqrtf(vs * (1.f / 64.f) + 64e-5f);
            float ya[8];
#pragma unroll
            for (int q = 0; q < 8; ++q) ya[q] = (o[q] * rs * lw[q] + lb[q] + bs * v[q]) * gg[q];
            *(uint4*)(p.ya_in + (size_t)t * 512 + lane * 8) = pack8(ya);
        }
        {
            float y[16] = {y0.x, y0.y, y0.z, y0.w, y1.x, y1.y, y1.z, y1.w, y2.x, y2.y, y2.z, y2.w, y3.x, y3.y, y3.z, y3.w};
            float sm = 0.f;
#pragma unroll
            for (int q = 0; q < 16; ++q) sm += y[q];
            sm = sum16(sm);
            const float mu = sm * (1.f / 256.f);
            float vs = 0.f;
#pragma unroll
            for (int q = 0; q < 16; ++q) { y[q] -= mu; vs += y[q] * y[q]; }
            vs = sum16(vs);
            const float rs = rsqrtf(vs * (1.f / 256.f) + 1e-5f);
            float gb[16]; { float t0[8], t1[8]; unpack8(ugb0, t0); unpack8(ugb1, t1);
#pragma unroll
                for (int q = 0; q < 8; ++q) { gb[q] = t0[q]; gb[8 + q] = t1[q]; } }
            float o0[8], o1[8];
#pragma unroll
            for (int q = 0; q < 16; ++q) {
                const int c = lane * 16 + q;
                const float ov = (y[q] * rs * p.ret_ln_w[c] + p.ret_ln_b[c]) * (gb[q] * sigm(gb[q]));
                if (q < 8) o0[q] = ov; else o1[q - 8] = ov;
            }
            bf16_t* d = p.yb_in + (size_t)t * 1024 + lane * 16;
            *(uint4*)d = pack8(o0); *(uint4*)(d + 8) = pack8(o1);
        }
    }
}

__device__ __forceinline__ void phase13(const Params& p, char* smem) {
    for (int u = blockIdx.x; u < 512; u += gridDim.x) {
        const int mt = u >> 2, nt = u & 3;
        f32x4 acca[4][4], accb[4][4];
#pragma unroll
        for (int mi = 0; mi < 4; ++mi)
#pragma unroll
            for (int ni = 0; ni < 4; ++ni) { acca[mi][ni] = (f32x4){0.f, 0.f, 0.f, 0.f}; accb[mi][ni] = (f32x4){0.f, 0.f, 0.f, 0.f}; }
        { APlain ap{p.ya_in + (size_t)mt * 128 * 512, 512}; BPlain bp{p.WaT + (size_t)nt * 256 * 512, 512};
          gemm_core<128, 256, 2, 4>(acca, ap, bp, 512, smem); }
        { APlain ap{p.yb_in + (size_t)mt * 128 * 1024, 1024}; BPlain bp{p.WbT + (size_t)nt * 256 * 1024, 1024};
          gemm_core<128, 256, 2, 4>(accb, ap, bp, 1024, smem); }
        const int wave = tidx() >> 6, lane = tidx() & 63;
        const int r0 = (wave >> 2) * 64 + (lane & 15), c0 = (wave & 3) * 64 + (lane >> 4) * 4;
#pragma unroll
        for (int mi = 0; mi < 4; ++mi)
#pragma unroll
            for (int ni = 0; ni < 4; ++ni) {
                const int t = mt * 128 + r0 + mi * 16, c = nt * 256 + c0 + ni * 16;
                const bf16_t* gp = p.proj + (size_t)(t + 256) * INC + c;
                const uint2 ga = *(const uint2*)(gp + 4864), gb = *(const uint2*)(gp + 5888);
                float o[4];
                o[0] = sigm(__uint_as_float(ga.x << 16)) * acca[mi][ni][0] + sigm(__uint_as_float(gb.x << 16)) * accb[mi][ni][0];
                o[1] = sigm(__uint_as_float(ga.x & 0xffff0000u)) * acca[mi][ni][1] + sigm(__uint_as_float(gb.x & 0xffff0000u)) * accb[mi][ni][1];
                o[2] = sigm(__uint_as_float(ga.y << 16)) * acca[mi][ni][2] + sigm(__uint_as_float(gb.y << 16)) * accb[mi][ni][2];
                o[3] = sigm(__uint_as_float(ga.y & 0xffff0000u)) * acca[mi][ni][3] + sigm(__uint_as_float(gb.y & 0xffff0000u)) * accb[mi][ni][3];
                uint2 ov; ov.x = pack2(o[0], o[1]); ov.y = pack2(o[2], o[3]);
                *(uint2*)(p.merged + (size_t)t * 1024 + c) = ov;
            }
    }
}
__device__ __forceinline__ void phase14(const Params& p, char* smem) {
    g8::StaticOrder S; S.init(TX, 1024, gridDim.x, blockIdx.x);
    g8::EpiBf16 E{p.mix, 1024};
    g8::gemm_phase((LAS unsigned char*)smem, p.merged, p.WoT, 1024, 1024, 1024, S, E);
}

__device__ __forceinline__ void phase15(const Params& p, char* smem) {
    const int tid = tidx(), wave = tid >> 6, lane = tid & 63;
    const int gw = blockIdx.x * 8 + wave, nw = gridDim.x * 8;
    const float* g1 = p.mod + 2048; const float* sh2 = p.mod + 3072; const float* sc2 = p.mod + 4096;
    for (int t = gw; t < TX; t += nw) {
        float4 mv[4], xm[4]; float ss = 0.f;
#pragma unroll
        for (int i = 0; i < 4; ++i) { const uint2 mb = *(const uint2*)(p.mix + (size_t)t * 1024 + i * 256 + lane * 4);
            mv[i] = make_float4(__uint_as_float(mb.x << 16), __uint_as_float(mb.x & 0xffff0000u), __uint_as_float(mb.y << 16), __uint_as_float(mb.y & 0xffff0000u));
            ss += mv[i].x * mv[i].x + mv[i].y * mv[i].y + mv[i].z * mv[i].z + mv[i].w * mv[i].w; }
        ss = wsum(ss);
        const float rs = rsqrtf(ss * (1.f / 1024.f) + 1e-6f);
        float s2 = 0.f;
#pragma unroll
        for (int i = 0; i < 4; ++i) {
            const int col = i * 256 + lane * 4;
            const float4 xv = *(const float4*)(p.x + (size_t)t * 1024 + col);
            const float4 gn = *(const float4*)(p.n_post_mix + col), gg = *(const float4*)(g1 + col);
            xm[i].x = xv.x + gg.x * (mv[i].x * rs * gn.x); xm[i].y = xv.y + gg.y * (mv[i].y * rs * gn.y);
            xm[i].z = xv.z + gg.z * (mv[i].z * rs * gn.z); xm[i].w = xv.w + gg.w * (mv[i].w * rs * gn.w);
            *(float4*)(p.x_mid + (size_t)t * 1024 + col) = xm[i];
            s2 += xm[i].x * xm[i].x + xm[i].y * xm[i].y + xm[i].z * xm[i].z + xm[i].w * xm[i].w;
        }
        s2 = wsum(s2);
        const float rs2 = rsqrtf(s2 * (1.f / 1024.f) + 1e-6f);
#pragma unroll
        for (int i = 0; i < 4; ++i) {
            const int col = i * 256 + lane * 4;
            const float4 gn = *(const float4*)(p.n_pre_ffn + col), sc = *(const float4*)(sc2 + col), sh = *(const float4*)(sh2 + col);
            float h[4];
            h[0] = xm[i].x * rs2 * gn.x * (1.f + sc.x) + sh.x; h[1] = xm[i].y * rs2 * gn.y * (1.f + sc.y) + sh.y;
            h[2] = xm[i].z * rs2 * gn.z * (1.f + sc.z) + sh.z; h[3] = xm[i].w * rs2 * gn.w * (1.f + sc.w) + sh.w;
            uint2 hi; hi.x = pack2(h[0], h[1]); hi.y = pack2(h[2], h[3]);
            *(uint2*)(p.Ahl + (size_t)t * 1024 + col) = hi;
        }
    }
}

__device__ __forceinline__ void phase16(const Params& p, char* smem) {
    for (int u = blockIdx.x; u < 256; u += gridDim.x) {
        const int mt = u >> 1, nt = u & 1;
        APlain ap{p.Ahl + (size_t)mt * 128 * 1024, 1024}; BPlain bp{p.RtT + (size_t)nt * 128 * 1024, 1024};
        float* outp = p.logits + (size_t)mt * 128 * 256 + nt * 128;
        gemm_tile<128, 128, 4, 2>(ap, bp, 1024, smem, [&](const auto& acc, int r0, int c0) {
#pragma unroll
            for (int mi = 0; mi < 2; ++mi)
#pragma unroll
                for (int ni = 0; ni < 4; ++ni) *(f32x4*)(outp + (size_t)(r0 + mi * 16) * 256 + c0 + ni * 16) = acc[mi][ni];
        });
    }
}

__device__ __forceinline__ void phase17(const Params& p, char* smem) {
    const int tid = tidx(), wave = tid >> 6, lane = tid & 63;
    int* hist = (int*)smem;
    if (tid < 256) hist[tid] = 0;
    __syncthreads();
    const int TPB = TX / gridDim.x;
    for (int ti = wave; ti < TPB; ti += 8) {
        const int t = blockIdx.x * TPB + ti;
        float sc[4]; unsigned key[4];
#pragma unroll
        for (int i = 0; i < 4; ++i) {
            const int e = lane + 64 * i; sc[i] = sigm(p.logits[(size_t)t * 256 + e]);
            const unsigned b = __float_as_uint(sc[i] + p.router_bias[e]);
            const unsigned o = b ^ ((b >> 31) ? 0xffffffffu : 0x80000000u);
            key[i] = (o & 0xffffff00u) | (unsigned)(255 - e);
        }
        float mys = 0.f, ssum = 0.f; int mye = 0;
#pragma unroll
        for (int k = 0; k < 8; ++k) {
            const unsigned best = wave_umax(max(max(key[0], key[1]), max(key[2], key[3])));
            const int e = 255 - (int)(best & 255u), slot = e >> 6, owner = e & 63;
            const float sel = slot == 0 ? sc[0] : (slot == 1 ? sc[1] : (slot == 2 ? sc[2] : sc[3]));
            const float sv = __int_as_float(__builtin_amdgcn_readlane(__float_as_int(sel), owner));
            if (lane == owner) {
#pragma unroll
                for (int i = 0; i < 4; ++i) if (slot == i) key[i] = 0u;
            }
            ssum += sv;
            if (lane == k) { mys = sv; mye = e; }
        }
        if (lane < 8) {
            const int pos = atomicAdd(&hist[mye], 1);
            p.tok_e[t * 8 + lane] = mye; p.tok_pos[t * 8 + lane] = pos; p.tok_w[t * 8 + lane] = mys / ssum * 2.5f;
        }
    }
    __syncthreads();
    if (tid < 256) p.bh[blockIdx.x * 256 + tid] = hist[tid];
}

__device__ __forceinline__ void phase18(const Params& p, char* smem) {
    const int tid = tidx();
    int* ps = (int*)smem;
    int* xs = ps + 260;
    int* cntL = xs + 260;
    int* baseL = cntL + 256;
    int* part = baseL + 256;
    {
        const int e = tid & 255, half = tid >> 8, G = gridDim.x, b0 = half * (G >> 1), b1 = b0 + (G >> 1);
        int tot = 0, bef = 0;
        for (int bb = b0; bb < b1; bb += 16) {
            int v[16];
#pragma unroll
            for (int i = 0; i < 16; ++i) v[i] = p.bh[(bb + i) * 256 + e];
#pragma unroll
            for (int i = 0; i < 16; ++i) { tot += v[i]; bef += (bb + i < (int)blockIdx.x) ? v[i] : 0; }
        }
        part[half * 256 + e] = tot; part[512 + half * 256 + e] = bef;
    }
    __syncthreads();
    if (tid < 256) { cntL[tid] = part[tid] + part[256 + tid]; baseL[tid] = part[512 + tid] + part[768 + tid]; }
    __syncthreads();
    if (tid < 64) {
        int c[4], tot = 0, ttot = 0;
#pragma unroll
        for (int q = 0; q < 4; ++q) { c[q] = cntL[tid * 4 + q]; tot += c[q]; ttot += (c[q] + 255) >> 8; }
        int incl = tot, tincl = ttot;
#pragma unroll
        for (int o = 1; o < 64; o <<= 1) { const int v = __shfl_up(incl, o, 64), tv = __shfl_up(tincl, o, 64); if (tid >= o) { incl += v; tincl += tv; } }
        int ex = incl - tot, tex = tincl - ttot;
#pragma unroll
        for (int q = 0; q < 4; ++q) { ps[tid * 4 + q] = ex; xs[tid * 4 + q] = tex; ex += c[q]; tex += (c[q] + 255) >> 8; }
        if (tid == 63) { ps[256] = incl; xs[256] = tincl; }
    }
    __syncthreads();
    if (blockIdx.x == 0) {
        const int nx = xs[256];
        if (tid == 0) *p.ntiles = nx + 64;
        for (int e = tid; e < 256; e += NT) {
            const int c = ps[e + 1] - ps[e];
            for (int t = 0; t < ((c + 255) >> 8); ++t) { int* x = p.xt + (xs[e] + t) * 4; x[0] = e; x[1] = ps[e] + 256 * t; x[2] = min(256, c - 256 * t); x[3] = 0; }
        }
        if (tid < 64) { int* x = p.xt + (nx + tid) * 4; x[0] = 256; x[1] = 131072 + 256 * tid; x[2] = 256; x[3] = 0; }
        if (tid < 256) p.slot_tk[NSLOT + tid] = 0;
    }
    const int TPB = TX / gridDim.x;
    for (int li = tid; li < TPB * 8; li += NT) {
        const int i = blockIdx.x * TPB * 8 + li, e = p.tok_e[i];
        p.slot_tk[ps[e] + baseL[e] + p.tok_pos[i]] = (i >> 3) * 9 + (i & 7);
    }
    for (int t = blockIdx.x * NT + tid; t < TX; t += gridDim.x * NT) p.slot_tk[131072 + t] = t * 9 + 8;
}

__device__ __forceinline__ void phase19(const Params& p, char* smem) {
    const int nun = *p.ntiles * 2;
    const int lb = (blockIdx.x & 7) * (gridDim.x >> 3) + (blockIdx.x >> 3);
    g8::EpiGU E{p.act};
    g8::gemm_phase_xg((LAS unsigned char*)smem, p.Ahl, p.slot_tk, p.xt, p.BtW, nun, lb, (int)gridDim.x, E);
}

__device__ __forceinline__ void phase20(const Params& p, char* smem) {
    constexpr int BM = 256, BN = 256, WGN = 4, TM = 128, TN = 64, MI = 8, NI = 4;
    constexpr int ABYTES = BM * TSTR, STAGE = (BM + BN) * TSTR, AL = 4, KPT = 8, NQ = 64;
    using BP = BKN; const BKN bp{nullptr, 1024};
    constexpr int BL = 4; uint4 rb0 = {}, rb1 = {}, rb2 = {}, rb3 = {}; const char* bbase = nullptr; const unsigned boff0 = 0, boff1 = 0, boff2 = 0, boff3 = 0;
    const int nun = *p.ntiles * 4, G = gridDim.x;
    const int lb = (blockIdx.x & 7) * (G >> 3) + (blockIdx.x >> 3);
    if (lb >= nun) return;
    const int nsteps = ((nun - lb + G - 1) / G) * 4;
    const int tid = tidx(), wave = tid >> 6, lane = tid & 63, fr = lane & 15, fq = lane >> 4;
    const int wm = wave / WGN, wn = wave % WGN;
    const int lrow = tid >> 3, lseg = tid & 7;
    const unsigned aoff0 = (unsigned)(lrow * 512) + lseg * 16, aoff1 = aoff0 + 64 * 512, aoff2 = aoff0 + 128 * 512, aoff3 = aoff0 + 192 * 512;
    const int kq = tid / NQ, n4 = tid % NQ; const long bld = 1024;
    uint4 ra0, ra1, ra2, ra3; float4 rf0, rf1, rf2, rf3, rf4, rf5, rf6, rf7;
    const char* abase = nullptr; const float* bfp = nullptr;
#define P20_UNIT(R) do { const int* x_ = p.xt + ((lb + (R) * G) >> 2) * 4; const int nt_ = (lb + (R) * G) & 3; const int e_ = x_[0]; \
        abase = (const char*)(p.act + (size_t)x_[1] * 256); \
        bfp = (e_ < 256 ? p.exp_w_down + (size_t)e_ * 262144 : p.sh_w_down) + nt_ * 256 + n4 * 4 + (long)(kq * KPT) * bld; } while (0)
    f32x4 acc[MI][NI];
#pragma unroll
    for (int mi = 0; mi < MI; ++mi)
#pragma unroll
        for (int ni = 0; ni < NI; ++ni) acc[mi][ni] = (f32x4){0.f, 0.f, 0.f, 0.f};
    P20_UNIT(0); GC_GLOAD(0); GC_LSTORE(0); __syncthreads();
    for (int s = 0; s < nsteps; ++s) {
        if (s + 1 < nsteps) { if (((s + 1) & 3) == 0) P20_UNIT((s + 1) >> 2); GC_GLOAD((s + 1) & 3); }
        const char* As = smem + (s & 1) * STAGE; const char* Bs = As + ABYTES;
#pragma unroll
        for (int ks = 0; ks < 2; ++ks) {
            bf16x8 af[MI], bfr[NI];
#pragma unroll
            for (int mi = 0; mi < MI; ++mi) af[mi] = *(const bf16x8*)(As + (wm * TM + mi * 16 + fr) * TSTR + ks * 64 + fq * 16);
#pragma unroll
            for (int ni = 0; ni < NI; ++ni) bfr[ni] = *(const bf16x8*)(Bs + (wn * TN + ni * 16 + fr) * TSTR + ks * 64 + fq * 16);
#pragma unroll
            for (int mi = 0; mi < MI; ++mi)
#pragma unroll
                for (int ni = 0; ni < NI; ++ni) acc[mi][ni] = __builtin_amdgcn_mfma_f32_16x16x32_bf16(bfr[ni], af[mi], acc[mi][ni], 0, 0, 0);
            __builtin_amdgcn_sched_barrier(0);
        }
        if ((s & 3) == 3) {
            const int u = lb + (s >> 2) * G; const int* x = p.xt + (u >> 2) * 4; const int nt = u & 3;
            const int row0 = x[1], nrows = x[2];
            const int* stk = p.slot_tk + row0;
            const int r0 = wm * TM + fr, c0 = wn * TN + fq * 4;
#pragma unroll
            for (int mi = 0; mi < MI; ++mi) {
                const int r = r0 + mi * 16;
                if (r < nrows) {
                    bf16_t* d = p.yk + (size_t)stk[r] * 1024 + nt * 256 + c0;
#pragma unroll
                    for (int ni = 0; ni < NI; ++ni) {
                        uint2 ov; ov.x = pack2(acc[mi][ni][0], acc[mi][ni][1]); ov.y = pack2(acc[mi][ni][2], acc[mi][ni][3]);
                        *(uint2*)(d + ni * 16) = ov;
                    }
                }
#pragma unroll
                for (int ni = 0; ni < NI; ++ni) acc[mi][ni] = (f32x4){0.f, 0.f, 0.f, 0.f};
            }
        }
        if (s + 1 < nsteps) GC_LSTORE((s + 1) & 1);
        __syncthreads();
    }
#undef P20_UNIT
}

__device__ __forceinline__ void phase21(const Params& p, char* smem) {
    const int tid = tidx(), wave = tid >> 6, lane = tid & 63;
    const int gw = blockIdx.x * 8 + wave, nw = gridDim.x * 8;
    const float* g2 = p.mod + 5120;
    for (int t = gw; t < TX; t += nw) {
        float w[9];
#pragma unroll
        for (int k = 0; k < 8; ++k) w[k] = p.tok_w[t * 8 + k];
        w[8] = 1.f;
        float4 mo[4]; float ss = 0.f;
#pragma unroll
        for (int i = 0; i < 4; ++i) {
            const int col = i * 256 + lane * 4;
            float a0 = 0.f, a1 = 0.f, a2 = 0.f, a3 = 0.f;
#pragma unroll
            for (int k = 0; k < 9; ++k) {
                const uint2 v = *(const uint2*)(p.yk + ((size_t)t * 9 + k) * 1024 + col);
                a0 += w[k] * __uint_as_float(v.x << 16); a1 += w[k] * __uint_as_float(v.x & 0xffff0000u); a2 += w[k] * __uint_as_float(v.y << 16); a3 += w[k] * __uint_as_float(v.y & 0xffff0000u);
            }
            mo[i] = make_float4(a0, a1, a2, a3);
            ss += a0 * a0 + a1 * a1 + a2 * a2 + a3 * a3;
        }
        ss = wsum(ss);
        const float rs = rsqrtf(ss * (1.f / 1024.f) + 1e-6f);
#pragma unroll
        for (int i = 0; i < 4; ++i) {
            const int col = i * 256 + lane * 4;
            const float4 xm = *(const float4*)(p.x_mid + (size_t)t * 1024 + col);
            const float4 gn = *(const float4*)(p.n_post_ffn + col), gg = *(const float4*)(g2 + col);
            float4 o;
            o.x = xm.x + gg.x * (mo[i].x * rs * gn.x); o.y = xm.y + gg.y * (mo[i].y * rs * gn.y);
            o.z = xm.z + gg.z * (mo[i].z * rs * gn.z); o.w = xm.w + gg.w * (mo[i].w * rs * gn.w);
            *(float4*)(p.out + (size_t)t * 1024 + col) = o;
        }
    }
}

constexpr int NPHASE = 22;
template <int PH> __device__ __forceinline__ void run_phase(const Params& p, char* smem) {
    if constexpr (PH == 0) phase0(p, smem);
    else if constexpr (PH == 1) phase1(p, smem);
    else if constexpr (PH == 2) phase2(p, smem);
    else if constexpr (PH == 3) phase3(p, smem);
    else if constexpr (PH == 4) phase4(p, smem);
    else if constexpr (PH == 5) phase5(p, smem);
    else if constexpr (PH == 6) phase6(p, smem);
    else if constexpr (PH == 7) phase7(p, smem);
    else if constexpr (PH == 8) phase8(p, smem);
    else if constexpr (PH == 9) phase9(p, smem);
    else if constexpr (PH == 10) phase10(p, smem);
    else if constexpr (PH == 11) phase11(p, smem);
    else if constexpr (PH == 12) phase12(p, smem);
    else if constexpr (PH == 13) phase13(p, smem);
    else if constexpr (PH == 14) phase14(p, smem);
    else if constexpr (PH == 15) phase15(p, smem);
    else if constexpr (PH == 16) phase16(p, smem);
    else if constexpr (PH == 17) phase17(p, smem);
    else if constexpr (PH == 18) phase18(p, smem);
    else if constexpr (PH == 19) phase19(p, smem);
    else if constexpr (PH == 20) phase20(p, smem);
    else phase21(p, smem);
}

template <int PH> __global__ void __launch_bounds__(NT, 2) k_phase(Params p) {
    extern __shared__ __attribute__((aligned(16))) char smem[];
    run_phase<PH>(p, smem);
}

template <int PH> __device__ __forceinline__ void mega_run(const Params& p, char* smem, const XcdBarrier& bar) {
    run_phase<PH>(p, smem);
    if constexpr (((PROBE_MASK) >> PH) & 1u) { xcd_barrier(bar); run_phase<PH>(p, smem); }
    if constexpr (PH + 1 < NPHASE) { xcd_barrier(bar); mega_run<PH + 1>(p, smem, bar); }
}
__global__ void __launch_bounds__(NT, 2) k_mega(Params p) {
    extern __shared__ __attribute__((aligned(16))) char smem[];
    uint4* xbw = (uint4*)(smem + 8 * TILE_BYTES);
    if (tidx() == 0) *xbw = make_uint4(0u, 0u, 0u, 0u);
    __syncthreads();
    XcdBarrier bar = xcd_barrier_post(p.bar, (volatile LAS unsigned*)xbw);
    mega_run<0>(p, smem, bar);
}

template <int PH> static void launch_phases(const Params& p, int grid, hipStream_t stream) {
    static bool attr = false;
    if (!attr) { (void)hipFuncSetAttribute((const void*)k_phase<PH>, hipFuncAttributeMaxDynamicSharedMemorySize, LDS_BYTES); attr = true; }
    hipLaunchKernelGGL(k_phase<PH>, dim3(grid), dim3(NT), LDS_BYTES, stream, p);
    if constexpr (PH + 1 < NPHASE) launch_phases<PH + 1>(p, grid, stream);
}

extern "C" void kernel_launch(void* const* d_in, const int* in_sizes, int n_in, void* d_out, int out_size, void* d_ws, size_t ws_size, hipStream_t stream) {
    static int grid = 0;
    if (grid == 0) {
        int dev = 0, cus = 0, per_cu = 0;
        (void)hipGetDevice(&dev); (void)hipDeviceGetAttribute(&cus, hipDeviceAttributeMultiprocessorCount, dev);
        (void)hipFuncSetAttribute((const void*)k_mega, hipFuncAttributeMaxDynamicSharedMemorySize, LDS_BYTES);
        (void)hipOccupancyMaxActiveBlocksPerMultiprocessor(&per_cu, (const void*)k_mega, NT, LDS_BYTES);
        (void)hipGetLastError();
        if (cus <= 0) cus = 256;
        grid = cus;
    }
    Params p{};
    const float** pin = (const float**)&p.x;
    for (int i = 0; i < 36; ++i) pin[i] = (const float*)d_in[i];
    p.out = (float*)d_out;
    char* ws = (char*)d_ws; size_t off = 0;
    auto alloc = [&](size_t bytes) { size_t o = off; off += (bytes + 255) & ~(size_t)255; return ws + o; };
    p.bar = (unsigned*)alloc(XCD_BAR_WORDS * 4); p.cnt = (int*)alloc(256 * 4);
    const size_t zero_bytes = off;
    p.slot_tk = (int*)alloc((size_t)(NSLOT + 256) * 4); p.bh = (int*)alloc(1024 * 256 * 4);
    p.xt = (int*)alloc(NXT_MAX * 16); p.ntiles = (int*)alloc(256);
    p.tok_e = (int*)alloc((size_t)TX * 8 * 4); p.tok_pos = (int*)alloc((size_t)TX * 8 * 4); p.tok_w = (float*)alloc((size_t)TX * 8 * 4);
    p.modp = (float*)alloc(16 * 2 * 6144 * 4); p.mod = (float*)alloc(2 * 6144 * 4);
    p.WinT = (bf16_t*)alloc((size_t)INC * 1024 * 2); p.WaT = (bf16_t*)alloc(1024 * 512 * 2); p.WbT = (bf16_t*)alloc(1024 * 1024 * 2); p.WoT = (bf16_t*)alloc(1024 * 1024 * 2);
    p.RtT = (bf16_t*)alloc(256 * 3072 * 2); p.ShGU = (bf16_t*)alloc(512 * 1024 * 2); p.ShD = (bf16_t*)alloc(1024 * 256 * 2);
    p.WupT = (bf16_t*)alloc(1024 * 64 * 2); p.AupT = (bf16_t*)alloc(1024 * 64 * 2); p.GupT = (bf16_t*)alloc(512 * 128 * 2);
    p.ya_in = (bf16_t*)alloc((size_t)TX * 512 * 2); p.yb_in = (bf16_t*)alloc((size_t)TX * 1024 * 2);
    p.BtW = (bf16_t*)alloc((size_t)257 * 512 * 1024 * 2);
    char* RA = alloc((size_t)TE * INC * 2);
    p.proj = (bf16_t*)RA;
    { size_t o = 0; auto sub = [&](size_t b) { char* r = RA + o; o += (b + 255) & ~(size_t)255; return r; };
      p.act = (bf16_t*)sub(((size_t)NSLOT + 256) * 256 * 2); p.logits = (float*)sub((size_t)TX * 256 * 4); }
    const size_t surv = (size_t)TE * 512 * 2 * 5 + (size_t)2 * TX * 512 * 2 + 4096;
    const size_t rtmp = 424935424 - 68157440 + 65536;
    char* RB = alloc(surv + rtmp);
    { size_t o = 0; auto sub = [&](size_t b) { char* r = RB + o; o += (b + 255) & ~(size_t)255; return r; };
      p.Rr = (bf16_t*)sub((size_t)TE * 512 * 2); p.Vv = (bf16_t*)sub((size_t)TE * 512 * 2); p.KD = (bf16_t*)sub((size_t)2 * TE * 512 * 2); p.G = (bf16_t*)sub((size_t)TE * 512 * 2);
      p.O = (bf16_t*)sub((size_t)2 * TX * 512 * 2);
      const size_t o_t = o;
      p.Kk = (bf16_t*)sub((size_t)TE * 512 * 2); p.Aa = (bf16_t*)sub((size_t)TE * 512 * 2); p.Bd = (bf16_t*)sub((size_t)2 * TE * 512 * 2);
      p.Wd = (float*)sub((size_t)2 * TE * 512 * 4); p.TW = (bf16_t*)sub((size_t)TE * 64 * 2); p.XA = (bf16_t*)sub((size_t)TE * 64 * 2); p.SG = (bf16_t*)sub((size_t)TE * 128 * 2);
      p.PH = (float*)sub((size_t)127 * 16 * 2 * 4096 * 4); p.Sst = (float*)sub((size_t)128 * 16 * 4096 * 4);
      p.Zz = (bf16_t*)sub((size_t)RNC * 16 * RL * 64 * 2); p.YH = (bf16_t*)sub((size_t)RNC * 16 * RL * 64 * 2);
      p.hn = (bf16_t*)p.PH;
      o = o_t;
      p.Qr = (bf16_t*)sub((size_t)NCH * 4 * 128 * 128 * 2); p.Kr = (bf16_t*)sub((size_t)NCH * 4 * 128 * 128 * 2); p.KTz = (bf16_t*)sub((size_t)NCH * 4 * 2 * 128 * 128 * 2);
      p.A3 = (bf16_t*)sub((size_t)NCH * 4 * 128 * 384 * 2); p.B3 = (bf16_t*)sub((size_t)NCH * 4 * 256 * 384 * 2);
      p.KVT = (bf16_t*)sub((size_t)NCH * 4 * 2 * 256 * 128 * 2); p.Y = (float*)sub((size_t)TX * 1024 * 4);
      o = 0;
      p.x_mid = (float*)sub((size_t)TX * 1024 * 4); p.Ahl = (bf16_t*)sub((size_t)TX * 1024 * 2);
      p.yk = (bf16_t*)sub((size_t)TX * 9 * 1024 * 2);
      char* yk0 = (char*)p.yk; p.mergedA = (float*)yk0; p.merged = (bf16_t*)(yk0 + (size_t)TX * 1024 * 4); p.mix = (bf16_t*)(yk0 + (size_t)TX * 1024 * 6);
    }
    if (off > ws_size) { fprintf(stderr, "kernel_launch: workspace too small: need %zu have %zu\n", off, ws_size); return; }
    int j = 0;
    p.jobs[j++] = TJob{p.w_in, p.WinT, 1024, INC, 1024, 0, 0, 0};
    p.jobs[j++] = TJob{p.w_branch_a, p.WaT, 512, 1024, 512, 0, 0, 0};
    p.jobs[j++] = TJob{p.w_branch_b, p.WbT, 1024, 1024, 1024, 0, 0, 0};
    p.jobs[j++] = TJob{p.w_out, p.WoT, 1024, 1024, 1024, 0, 0, 0};
    p.jobs[j++] = TJob{p.router_w, p.RtT, 1024, 256, 1024, 0, 0, 0};
    p.jobs[j++] = TJob{p.rwkv_g_up, p.GupT, 0, 0, 128, 0, 0, 0};
    p.jobs[j++] = TJob{p.rwkv_g_up, p.GupT, 0, 0, 128, 0, 0, 0};
    p.jobs[j++] = TJob{p.rwkv_g_up, p.GupT, 0, 0, 128, 0, 0, 0};
    p.jobs[j++] = TJob{p.rwkv_w_up, p.WupT, 64, 512, 64, 0, 0, 0};
    p.jobs[j++] = TJob{p.rwkv_w_up + 64 * 512, p.WupT, 64, 512, 64, 0, 512, 0};
    p.jobs[j++] = TJob{p.rwkv_a_up, p.AupT, 64, 512, 64, 0, 0, 0};
    p.jobs[j++] = TJob{p.rwkv_a_up + 64 * 512, p.AupT, 64, 512, 64, 0, 512, 0};
    p.jobs[j++] = TJob{p.rwkv_g_up, p.GupT, 128, 512, 128, 0, 0, 0};
    p.jobs[j++] = TJob{p.rwkv_g_up, p.GupT, 0, 0, 128, 0, 0, 0};
    (void)hipMemsetAsync(ws, 0, zero_bytes, stream);
#if MK_ONE_LAUNCH
    hipLaunchKernelGGL(k_mega, dim3(grid), dim3(NT), LDS_BYTES, stream, p);
#else
    launch_phases<0>(p, grid, stream);
#endif
}
```

```cpp
#include <hip/hip_runtime.h>
#include <stdint.h>
#include <stdio.h>

#ifndef MK_ONE_LAUNCH
#define MK_ONE_LAUNCH 1
#endif
#ifndef ROUTER_K
#define ROUTER_K 1024
#endif
#ifndef PROBE_MASK
#define PROBE_MASK 0u
#endif

typedef unsigned short bf16_t;
typedef short bf16x8 __attribute__((ext_vector_type(8)));
typedef float f32x4 __attribute__((ext_vector_type(4)));
typedef float f32x2 __attribute__((ext_vector_type(2)));

#define NT 512
constexpr int TX = 16384, TC = 256, TE = 16640, DM = 1024, INC = 6912;
constexpr int NCH = 130;
constexpr int RL = 130, RNC = 128;
constexpr int TSTR = 144;
constexpr int TILE_BYTES = 128 * TSTR;
constexpr int LDS_BYTES = 8 * TILE_BYTES + 1024;
constexpr int NSLOT = 131072 + 16384;
constexpr int NXT_MAX = 768 + 64;

#define XB_TMO      128
#define XB_XCNT(j)  (256  + 64 * (j))
#define XB_XSUB(j)  (1280 + 64 * (j))
#define XB_XGEN(j)  (2304 + 64 * (j))
#define XB_TOP      3328
#define XB_TOPGEN   3392
#define XCD_BAR_WORDS 3456
#define XB_SPIN_CAP (1u << 18)
#define LAS __attribute__((address_space(3)))

__device__ __forceinline__ unsigned xb_ld(unsigned* p)              { return __hip_atomic_load(p, __ATOMIC_RELAXED, __HIP_MEMORY_SCOPE_AGENT); }
__device__ __forceinline__ unsigned xb_add(unsigned* p, unsigned v) { return __hip_atomic_fetch_add(p, v, __ATOMIC_RELAXED, __HIP_MEMORY_SCOPE_AGENT); }
__device__ __forceinline__ unsigned xb_xcc_id() { return (unsigned)__builtin_amdgcn_s_getreg((3 << 11) | 20) & 0xFu; }
#define XB_SPIN(cond, bar) do { unsigned _sp = 0; while (cond) { __builtin_amdgcn_s_sleep(1); \
    if ((++_sp & 255u) == 0u) { if (xb_ld(&(bar)[XB_TMO])) break; if (_sp > XB_SPIN_CAP) { atomicAdd(&(bar)[XB_TMO], 1u); break; } } } } while (0)

struct XcdBarrier { unsigned* bar; unsigned x; volatile LAS unsigned* st; };

__device__ __forceinline__ XcdBarrier xcd_barrier_post(unsigned* bar, volatile LAS unsigned* st) {
    XcdBarrier b; b.bar = bar; b.x = xb_xcc_id(); b.st = st;
    if (threadIdx.x == 0) (void)xb_add(&bar[XB_XCNT(b.x)], 1u);
    return b;
}
__device__ __forceinline__ void xcd_barrier_complete(unsigned* bar, unsigned x, unsigned& nloc, unsigned& nx) {
    const unsigned G = gridDim.x * gridDim.y * gridDim.z;
    unsigned sum, cnt, mine, sp = 0u;
    for (;;) {
        sum = 0u; cnt = 0u; mine = 0u;
#pragma unroll
        for (unsigned j = 0; j < 16; ++j) { const unsigned c = xb_ld(&bar[XB_XCNT(j)]); sum += c; cnt += (c > 0u) ? 1u : 0u; mine = (j == x) ? c : mine; }
        if (sum == G) break;
        __builtin_amdgcn_s_sleep(1);
        if ((++sp & 255u) == 0u) { if (xb_ld(&bar[XB_TMO])) break; if (sp > XB_SPIN_CAP) { atomicAdd(&bar[XB_TMO], 1u); break; } }
    }
    nloc = mine > 0u ? mine : 1u; nx = cnt > 0u ? cnt : 1u;
}
__device__ __forceinline__ void xcd_barrier(const XcdBarrier& b) {
    asm volatile("s_waitcnt vmcnt(0)" ::: "memory");
    __syncthreads();
    if (threadIdx.x == 0) {
        unsigned* bar = b.bar;
        __builtin_amdgcn_s_waitcnt(0);
        unsigned nloc = b.st[0], nx = b.st[1];
        if (nloc == 0u) { xcd_barrier_complete(bar, b.x, nloc, nx); b.st[0] = nloc; b.st[1] = nx; }
        const unsigned old = xb_add(&bar[XB_XSUB(b.x)], 1u);
        const unsigned gen = old / nloc;
        if (old + 1u == (gen + 1u) * nloc) {
            __builtin_amdgcn_fence(__ATOMIC_RELEASE, "agent");
            asm volatile("s_waitcnt vmcnt(0)" ::: "memory");
            const unsigned og = xb_add(&bar[XB_TOP], 1u);
            const unsigned tg = og / nx;
            if (og + 1u == (tg + 1u) * nx) xb_add(&bar[XB_TOPGEN], 1u);
            else XB_SPIN(xb_ld(&bar[XB_TOPGEN]) == tg, bar);
            __builtin_amdgcn_fence(__ATOMIC_ACQUIRE, "agent");
            xb_add(&bar[XB_XGEN(b.x)], 1u);
            asm volatile("s_waitcnt vmcnt(0)" ::: "memory");
        } else {
            XB_SPIN(xb_ld(&bar[XB_XGEN(b.x)]) == gen, bar);
            __builtin_amdgcn_fence(__ATOMIC_ACQUIRE, "agent");
            asm volatile("s_waitcnt vmcnt(0)" ::: "memory");
        }
    }
    __syncthreads();
}

struct TJob { const float* src; bf16_t* dst; int K, N, dld, mode, rowoff, coloff; };
constexpr int NJOB = 14;

struct Params {
    const float *x, *c, *ctx, *c_ctx, *w_mod, *b_mod, *n_pre_mix, *n_post_mix, *n_pre_ffn, *n_post_ffn,
        *w_in, *shift_mu, *rwkv_w0, *rwkv_w_up, *rwkv_a0, *rwkv_a_up, *rwkv_g_up, *rwkv_k_k, *rwkv_k_a, *rwkv_r_k,
        *rwkv_ln_w, *rwkv_ln_b, *w_branch_a, *ret_decay_logit, *ret_ln_w, *ret_ln_b, *w_branch_b, *w_out,
        *router_w, *router_bias, *exp_w_gate, *exp_w_up, *exp_w_down, *sh_w_gate, *sh_w_up, *sh_w_down;
    float* out;
    unsigned* bar; int* cnt; int* bh; int* slot_tk; int* xt; int* ntiles; int* tok_e; int* tok_pos; float* tok_w;
    float* modp; float* mod;
    bf16_t *WinT, *WaT, *WbT, *WoT, *RtT, *ShGU, *ShD, *WupT, *AupT, *GupT;
    bf16_t *hn, *proj, *BtW;
    bf16_t *Rr, *Vv, *KD, *G, *O;
    bf16_t *Kk, *Aa, *Bd, *TW, *XA, *SG;
    float *Wd, *PH, *Sst; bf16_t *Zz, *YH;
    bf16_t *Qr, *Kr, *KTz, *A3, *B3;
    bf16_t* KVT; float* Y;
    bf16_t *ya_in, *yb_in, *merged, *Ahl, *act, *yk;
    float *mergedA, *x_mid, *logits; bf16_t* mix;
    TJob jobs[NJOB];
};

__device__ __forceinline__ int tidx() { int t = threadIdx.x; asm volatile("" : "+v"(t)); return t; }
__device__ __forceinline__ float bf2f(bf16_t v) { return __uint_as_float(((unsigned)v) << 16); }
__device__ __forceinline__ unsigned pack2(float lo, float hi) { unsigned r; asm("v_cvt_pk_bf16_f32 %0, %1, %2" : "=v"(r) : "v"(lo), "v"(hi)); return r; }
__device__ __forceinline__ bf16_t f2bf(float f) { return (bf16_t)(pack2(f, f) & 0xffffu); }
__device__ __forceinline__ void unpack8(const uint4& v, float (&f)[8]) {
    f[0] = __uint_as_float(v.x << 16); f[1] = __uint_as_float(v.x & 0xffff0000u); f[2] = __uint_as_float(v.y << 16); f[3] = __uint_as_float(v.y & 0xffff0000u);
    f[4] = __uint_as_float(v.z << 16); f[5] = __uint_as_float(v.z & 0xffff0000u); f[6] = __uint_as_float(v.w << 16); f[7] = __uint_as_float(v.w & 0xffff0000u); }
__device__ __forceinline__ uint4 pack8(const float (&f)[8]) { uint4 o; o.x = pack2(f[0], f[1]); o.y = pack2(f[2], f[3]); o.z = pack2(f[4], f[5]); o.w = pack2(f[6], f[7]); return o; }
__device__ __forceinline__ float dpp_f(float v, const int ctrl_unused) { return v; }
#define DPP_ADD(v, CTRL) ((v) + __int_as_float(__builtin_amdgcn_update_dpp(0, __float_as_int(v), CTRL, 0xf, 0xf, false)))
__device__ __forceinline__ float sum8(float v) { v = DPP_ADD(v, 0xB1); v = DPP_ADD(v, 0x4E); v = DPP_ADD(v, 0x141); return v; }
__device__ __forceinline__ float sum16(float v) { v = sum8(v); v = DPP_ADD(v, 0x140); return v; }
__device__ __forceinline__ float wsum(float v) {
    v = sum16(v);
    const float a = __int_as_float(__builtin_amdgcn_readlane(__float_as_int(v), 0)), b = __int_as_float(__builtin_amdgcn_readlane(__float_as_int(v), 16));
    const float c = __int_as_float(__builtin_amdgcn_readlane(__float_as_int(v), 32)), d = __int_as_float(__builtin_amdgcn_readlane(__float_as_int(v), 48));
    return (a + b) + (c + d);
}
__device__ __forceinline__ unsigned wave_umax(unsigned v) {
    v = max(v, (unsigned)__builtin_amdgcn_update_dpp(0, (int)v, 0x111, 0xf, 0xf, false));
    v = max(v, (unsigned)__builtin_amdgcn_update_dpp(0, (int)v, 0x112, 0xf, 0xf, false));
    v = max(v, (unsigned)__builtin_amdgcn_update_dpp(0, (int)v, 0x114, 0xf, 0xf, false));
    v = max(v, (unsigned)__builtin_amdgcn_update_dpp(0, (int)v, 0x118, 0xf, 0xf, false));
    v = max(v, (unsigned)__builtin_amdgcn_update_dpp(0, (int)v, 0x142, 0xa, 0xf, false));
    v = max(v, (unsigned)__builtin_amdgcn_update_dpp(0, (int)v, 0x143, 0xc, 0xf, false));
    return (unsigned)__builtin_amdgcn_readlane((int)v, 63);
}
__device__ __forceinline__ float sigm(float z) { return 1.f / (1.f + __expf(-z)); }
__device__ __forceinline__ int row_of(int dir, int s) { return dir == 0 ? s : (s < 256 ? 255 - s : 16895 - s); }

struct APlain { const bf16_t* base; int ld;
    __device__ __forceinline__ const char* bptr() const { return (const char*)base; }
    __device__ __forceinline__ unsigned rowoff(int r) const { return (unsigned)(r * ld) * 2u; } };
struct AGather { const bf16_t* base; int ld; const int* idx;
    __device__ __forceinline__ const char* bptr() const { return (const char*)base; }
    __device__ __forceinline__ unsigned rowoff(int r) const { const int tok = idx[r] / 9; return (unsigned)(tok * ld) * 2u; } };
struct BPlain { static constexpr int MODE = 0; const bf16_t* base; int ldv;
    __device__ __forceinline__ const char* bptr() const { return (const char*)base; }
    __device__ __forceinline__ unsigned rowoff(int n) const { return (unsigned)(n * ldv) * 2u; }
    __device__ __forceinline__ const float* colptr(int) const { return nullptr; }
    __device__ __forceinline__ long ld() const { return ldv; }
    __device__ __forceinline__ int lrow(int, int) const { return 0; } };
struct BKN { static constexpr int MODE = 1; const float* base; long ldv;
    __device__ __forceinline__ const char* bptr() const { return nullptr; }
    __device__ __forceinline__ unsigned rowoff(int) const { return 0u; }
    __device__ __forceinline__ const float* colptr(int n4) const { return base + n4 * 4; }
    __device__ __forceinline__ long ld() const { return ldv; }
    __device__ __forceinline__ int lrow(int n4, int j) const { return n4 * 4 + j; } };
struct BKNGU { static constexpr int MODE = 1; const float* g; const float* u;
    __device__ __forceinline__ const char* bptr() const { return nullptr; }
    __device__ __forceinline__ unsigned rowoff(int) const { return 0u; }
    __device__ __forceinline__ const float* colptr(int n4) const { return ((n4 >> 5) ? u : g) + (n4 & 31) * 4; }
    __device__ __forceinline__ long ld() const { return 256; }
    __device__ __forceinline__ int lrow(int n4, int j) const { int sc = (n4 & 31) * 4 + j; return (sc >> 4) * 32 + (n4 >> 5) * 16 + (sc & 15); } };

__device__ __forceinline__ float f4e(const float4& v, int j) { return j == 0 ? v.x : (j == 1 ? v.y : (j == 2 ? v.z : v.w)); }
#define GC_REP4(N, X) do { if constexpr ((N) > 0) { X(0); } if constexpr ((N) > 1) { X(1); } if constexpr ((N) > 2) { X(2); } if constexpr ((N) > 3) { X(3); } } while (0)
#define GC_REP8(N, X) do { X(0); X(1); X(2); X(3); if constexpr ((N) > 4) { X(4); X(5); X(6); X(7); } } while (0)
#define GC_AOFF(i) aoff##i = ap.rowoff(lrow + 64 * i) + lseg * 16
#define GC_BOFF(i) boff##i = bp.rowoff(lrow + 64 * i) + lseg * 16
#define GC_LA(i) ra##i = *(const uint4*)(abase + (aoff##i + kt_ * 128))
#define GC_LB(i) rb##i = *(const uint4*)(bbase + (boff##i + kt_ * 128))
#define GC_LF(i) rf##i = *(const float4*)(bfp + ((long)kt_ * 64 + i) * bld)
#define GC_SA(i) *(uint4*)(As_ + (lrow + 64 * i) * TSTR + lseg * 16) = ra##i
#define GC_SB(i) *(uint4*)(Bs_ + (lrow + 64 * i) * TSTR + lseg * 16) = rb##i
#define GC_GLOAD(KT) do { const int kt_ = (KT); GC_REP4(AL, GC_LA); \
    if constexpr (BP::MODE == 0) { GC_REP4(BL, GC_LB); } else { GC_REP8(KPT, GC_LF); } } while (0)
#define GC_SF(j) do { char* d_ = Bs_ + bp.lrow(n4, j) * TSTR + kq * KPT * 2; \
        if constexpr (KPT == 4) *(uint2*)d_ = make_uint2(pack2(f4e(rf0, j), f4e(rf1, j)), pack2(f4e(rf2, j), f4e(rf3, j))); \
        else *(uint4*)d_ = make_uint4(pack2(f4e(rf0, j), f4e(rf1, j)), pack2(f4e(rf2, j), f4e(rf3, j)), pack2(f4e(rf4, j), f4e(rf5, j)), pack2(f4e(rf6, j), f4e(rf7, j))); } while (0)
#define GC_LSTORE(BUF) do { char* As_ = smem + (BUF) * STAGE; char* Bs_ = As_ + ABYTES; GC_REP4(AL, GC_SA); \
    if constexpr (BP::MODE == 0) { GC_REP4(BL, GC_SB); } else { GC_SF(0); GC_SF(1); GC_SF(2); GC_SF(3); } } while (0)

template <int BM, int BN, int WGM, int WGN, class AP, class BP>
__device__ __forceinline__ void gemm_core(f32x4 (&acc)[BM / WGM / 16][BN / WGN / 16], const AP& ap, const BP& bp, const int K, char* smem) {
    constexpr int TM = BM / WGM, TN = BN / WGN, MI = TM / 16, NI = TN / 16;
    constexpr int ABYTES = BM * TSTR, STAGE = (BM + BN) * TSTR;
    constexpr int AL = BM / 64, BL = BN / 64;
    constexpr int KPT = BN / 32, NQ = BN / 4;
    const int tid = tidx(), wave = tid >> 6, lane = tid & 63, fr = lane & 15, fq = lane >> 4;
    const int wm = wave / WGN, wn = wave % WGN;
    const int lrow = tid >> 3, lseg = tid & 7;
    const char* abase = ap.bptr(); const char* bbase = bp.bptr();
    unsigned aoff0 = 0, aoff1 = 0, aoff2 = 0, aoff3 = 0, boff0 = 0, boff1 = 0, boff2 = 0, boff3 = 0;
    uint4 ra0, ra1, ra2, ra3, rb0, rb1, rb2, rb3; float4 rf0, rf1, rf2, rf3, rf4, rf5, rf6, rf7;
    GC_REP4(AL, GC_AOFF);
    const float* bfp = nullptr;
    const int kq = tid / NQ, n4 = tid % NQ; const long bld = bp.ld();
    if constexpr (BP::MODE == 0) { GC_REP4(BL, GC_BOFF); } else { bfp = bp.colptr(n4) + (long)(kq * KPT) * bld; }
    int nk = K >> 6;
    asm volatile("" : "+s"(nk));
    GC_GLOAD(0); GC_LSTORE(0); __syncthreads();
    for (int kt = 0; kt < nk; ++kt) {
        if (kt + 1 < nk) GC_GLOAD(kt + 1);
        const char* As = smem + (kt & 1) * STAGE; const char* Bs = As + ABYTES;
#pragma unroll
        for (int ks = 0; ks < 2; ++ks) {
            bf16x8 af[MI], bfr[NI];
#pragma unroll
            for (int mi = 0; mi < MI; ++mi) af[mi] = *(const bf16x8*)(As + (wm * TM + mi * 16 + fr) * TSTR + ks * 64 + fq * 16);
#pragma unroll
            for (int ni = 0; ni < NI; ++ni) bfr[ni] = *(const bf16x8*)(Bs + (wn * TN + ni * 16 + fr) * TSTR + ks * 64 + fq * 16);
#pragma unroll
            for (int mi = 0; mi < MI; ++mi)
#pragma unroll
                for (int ni = 0; ni < NI; ++ni) acc[mi][ni] = __builtin_amdgcn_mfma_f32_16x16x32_bf16(bfr[ni], af[mi], acc[mi][ni], 0, 0, 0);
        }
        if (kt + 1 < nk) GC_LSTORE((kt + 1) & 1);
        __syncthreads();
    }
}
template <int BM, int BN, int WGM, int WGN, class AP, class BP, class EPI>
__device__ __forceinline__ void gemm_tile(const AP& ap, const BP& bp, const int K, char* smem, const EPI& epi) {
    constexpr int TM = BM / WGM, TN = BN / WGN, MI = TM / 16, NI = TN / 16;
    f32x4 acc[MI][NI];
#pragma unroll
    for (int mi = 0; mi < MI; ++mi)
#pragma unroll
        for (int ni = 0; ni < NI; ++ni) acc[mi][ni] = (f32x4){0.f, 0.f, 0.f, 0.f};
    gemm_core<BM, BN, WGM, WGN>(acc, ap, bp, K, smem);
    const int wave = tidx() >> 6, lane = tidx() & 63;
    epi(acc, (wave / WGN) * TM + (lane & 15), (wave % WGN) * TN + (lane >> 4) * 4);
}

namespace g8 {
constexpr int BM = 256, BK = 64, HALF = 128, HTB = HALF * BK * 2, NXCD = 8, WGM = 8;
__device__ __forceinline__ int lds_byte(int r, int c) { const int st = (r >> 4) * 2 + (c >> 5), rr = r & 15, cc = c & 31, ob = rr * 64 + cc * 2; return st * 1024 + (ob ^ (((ob >> 9) & 1) << 5)); }
__device__ __forceinline__ void stage_rc(int b, int& R, int& C) { const int st = b / 1024, sb = b % 1024, swz = sb ^ (((sb >> 9) & 1) << 5); R = (st >> 1) * 16 + swz / 64; C = (st & 1) * 32 + (swz % 64) / 2; }
__device__ __forceinline__ int perm32(int rho) { const int n = rho >> 4, i = rho & 15; return 8 * (i >> 2) + 4 * n + (i & 3); }
struct Unit { int pm, pn; };
struct StaticOrder {
    int nM, nN, nwg, G, c;
    __device__ void init(int M, int N, int G_, int c_) { nM = M / BM; nN = N / BM; nwg = nM * nN; G = G_; c = c_; }
    __device__ bool next(int i, Unit& u) const {
        const long L = (long)i * G + c; if (L >= nwg) return false;
        int wgid = (int)L; { const int q = nwg / NXCD, r = nwg % NXCD, xcd = wgid % NXCD, off = wgid / NXCD; wgid = (xcd < r ? xcd * (q + 1) : r * (q + 1) + (xcd - r) * q) + off; }
        const int nig = WGM * nN, gid = wgid / nig, fm = gid * WGM, gsz = (nM - fm) < WGM ? (nM - fm) : WGM;
        u.pm = fm + ((wgid % nig) % gsz); u.pn = (wgid % nig) / gsz; return true;
    }
};
template <class Epi, class Sched>
__device__ __forceinline__ void gemm_phase(LAS unsigned char* lds, const bf16_t* Ag, const bf16_t* Btg, const int lda, const int ldb, const int K, const Sched& S, const Epi& E) {
    int tid = threadIdx.x; asm volatile("" : "+v"(tid));
    const int wid = __builtin_amdgcn_readfirstlane(tid >> 6), lane = tid & 63, wr = wid >> 2, wc = wid & 3, fr = lane & 15, fq = lane >> 4;
    const int nt = K / BK;
    unsigned voffA[2], voffB[2];
#pragma unroll
    for (int i = 0; i < 2; ++i) { int R, C; stage_rc(tid * 16 + i * 8192, R, C); const int Rb = Epi::PERM ? ((R & ~31) + perm32(R & 31)) : R;
        voffA[i] = (unsigned)(R * lda + C) * 2u; voffB[i] = (unsigned)(Rb * ldb + C) * 2u; }
    const size_t kstep = (size_t)(BK * 2);
    const size_t hstepA = (size_t)HALF * lda * 2, hstepB = (size_t)HALF * ldb * 2;
    const size_t tstepA = 2 * hstepA, tstepB = 2 * hstepB;
    const unsigned ldsw = (unsigned)wid * 1024u;
    const int aoff = lds_byte(wr * 64 + fr, fq * 8), boff = lds_byte(wc * 32 + fr, fq * 8);
#define PG8_SA(b, h) (((b) * 2 + (h)) * HTB)
#define PG8_SB(b, h) ((4 + (b) * 2 + (h)) * HTB)
#define PG8_STAGE(bufoff, gbase, voff) do { _Pragma("unroll") for (int _i = 0; _i < 2; ++_i) \
        __builtin_amdgcn_global_load_lds((const unsigned*)((const char*)(gbase) + (voff)[_i]), (LAS unsigned*)(lds + (bufoff) + ldsw + _i * 8192), 16, 0, 0); } while (0)
#define PG8_LDA(dst, b, h) do { _Pragma("unroll") for (int m = 0; m < 4; ++m) _Pragma("unroll") for (int k = 0; k < 2; ++k) dst[m][k] = *(const LAS bf16x8*)(lds + PG8_SA(b, h) + aoff + m * 2048 + k * 1024); } while (0)
#define PG8_LDB(dst, b, h) do { _Pragma("unroll") for (int n = 0; n < 2; ++n) _Pragma("unroll") for (int k = 0; k < 2; ++k) dst[n][k] = *(const LAS bf16x8*)(lds + PG8_SB(b, h) + boff + n * 2048 + k * 1024); } while (0)
#define PG8_MMA(ai, bj, At, Bt) do { __builtin_amdgcn_s_setprio(1); _Pragma("unroll") for (int m = 0; m < 4; ++m) _Pragma("unroll") for (int n = 0; n < 2; ++n) _Pragma("unroll") for (int k = 0; k < 2; ++k) \
        acc[ai][bj][m][n] = __builtin_amdgcn_mfma_f32_16x16x32_bf16(Bt[n][k], At[m][k], acc[ai][bj][m][n], 0, 0, 0); __builtin_amdgcn_s_setprio(0); } while (0)
#define PG8_WAIT_V(n) asm volatile("s_waitcnt vmcnt(" #n ")" ::: "memory")
#define PG8_WAIT_L(n) asm volatile("s_waitcnt lgkmcnt(" #n ")" ::: "memory")
#define PG8_BAR __builtin_amdgcn_s_barrier()
#define PG8_SCHED __builtin_amdgcn_sched_barrier(0)
    Unit cur, nxt; int ui = 0;
    if (!S.next(0, cur)) return;
    f32x4 acc[2][2][4][2];
#pragma unroll
    for (int a = 0; a < 2; ++a)
#pragma unroll
        for (int b = 0; b < 2; ++b)
#pragma unroll
            for (int m = 0; m < 4; ++m)
#pragma unroll
                for (int n = 0; n < 2; ++n) acc[a][b][m][n] = (f32x4){0.f, 0.f, 0.f, 0.f};
    bf16x8 At[4][2], B0[2][2], B1[2][2];
    const char* cA = (const char*)Ag + (size_t)cur.pm * tstepA; const char* cB = (const char*)Btg + (size_t)cur.pn * tstepB;
    PG8_STAGE(PG8_SB(0, 0), cB, voffB); PG8_STAGE(PG8_SA(0, 0), cA, voffA); PG8_STAGE(PG8_SB(0, 1), cB + hstepB, voffB); PG8_STAGE(PG8_SA(0, 1), cA + hstepA, voffA);
    if (wr == 1) PG8_BAR;
    PG8_WAIT_V(4); PG8_BAR;
    PG8_STAGE(PG8_SB(1, 0), cB + kstep, voffB); PG8_STAGE(PG8_SA(1, 0), cA + kstep, voffA); PG8_STAGE(PG8_SB(1, 1), cB + hstepB + kstep, voffB);
    PG8_WAIT_V(6); PG8_BAR;
    for (;;) {
        const bool has_next = S.next(ui + 1, nxt);
        const char* nA = has_next ? (const char*)Ag + (size_t)nxt.pm * tstepA : cA; const char* nB = has_next ? (const char*)Btg + (size_t)nxt.pn * tstepB : cB;
        for (int t = 0; t < nt; t += 2) {
            const bool last = (t == nt - 2);
            const char* a1 = cA + (size_t)(t + 1) * kstep;
            const char* a2 = last ? nA : cA + (size_t)(t + 2) * kstep; const char* b2 = last ? nB : cB + (size_t)(t + 2) * kstep;
            const char* a3 = a2 + kstep; const char* b3 = b2 + kstep;
            PG8_LDB(B0, 0, 0); PG8_SCHED; PG8_LDA(At, 0, 0); PG8_STAGE(PG8_SA(1, 1), a1 + hstepA, voffA);
            PG8_WAIT_L(8); PG8_BAR; PG8_WAIT_L(0); PG8_MMA(0, 0, At, B0); PG8_BAR; PG8_SCHED;
            PG8_LDB(B1, 0, 1); PG8_STAGE(PG8_SB(0, 0), b2, voffB);
            PG8_BAR; PG8_WAIT_L(0); PG8_MMA(0, 1, At, B1); PG8_BAR;
            PG8_LDA(At, 0, 1); PG8_STAGE(PG8_SA(0, 0), a2, voffA);
            PG8_BAR; PG8_WAIT_L(0); PG8_MMA(1, 0, At, B0); PG8_BAR; PG8_SCHED;
            PG8_STAGE(PG8_SB(0, 1), b2 + hstepB, voffB);
            PG8_WAIT_V(6); PG8_BAR; PG8_MMA(1, 1, At, B1); PG8_BAR;
            PG8_LDB(B0, 1, 0); PG8_SCHED; PG8_LDA(At, 1, 0); PG8_STAGE(PG8_SA(0, 1), a2 + hstepA, voffA);
            PG8_WAIT_L(8); PG8_BAR; PG8_WAIT_L(0); PG8_MMA(0, 0, At, B0); PG8_BAR; PG8_SCHED;
            PG8_LDB(B1, 1, 1); PG8_STAGE(PG8_SB(1, 0), b3, voffB);
            PG8_BAR; PG8_WAIT_L(0); PG8_MMA(0, 1, At, B1); PG8_BAR;
            PG8_LDA(At, 1, 1); PG8_STAGE(PG8_SA(1, 0), a3, voffA);
            PG8_BAR; PG8_WAIT_L(0); PG8_MMA(1, 0, At, B0); PG8_BAR; PG8_SCHED;
            PG8_STAGE(PG8_SB(1, 1), b3 + hstepB, voffB);
            PG8_WAIT_V(6); PG8_BAR; PG8_MMA(1, 1, At, B1); PG8_BAR;
        }
        E(acc, cur, wr, wc, fr, fq);
        if (!has_next) break;
#pragma unroll
        for (int a = 0; a < 2; ++a)
#pragma unroll
            for (int b = 0; b < 2; ++b)
#pragma unroll
                for (int m = 0; m < 4; ++m)
#pragma unroll
                    for (int n = 0; n < 2; ++n) acc[a][b][m][n] = (f32x4){0.f, 0.f, 0.f, 0.f};
        cur = nxt; cA = nA; cB = nB; ++ui;
    }
    PG8_WAIT_V(0);
    if (wr == 0) PG8_BAR;
    PG8_BAR;
#undef PG8_SA
#undef PG8_SB
#undef PG8_STAGE
#undef PG8_LDA
#undef PG8_LDB
#undef PG8_MMA
#undef PG8_WAIT_V
#undef PG8_WAIT_L
#undef PG8_BAR
#undef PG8_SCHED
}
struct EpiF32 {
    static constexpr bool PERM = false;
    float* C; int ldc;
    __device__ __forceinline__ void operator()(const f32x4 (&acc)[2][2][4][2], const Unit& u, int wr, int wc, int fr, int fq) const {
        const int row0 = u.pm * BM + wr * 64 + fr, col0 = u.pn * BM + wc * 32 + 4 * fq;
#pragma unroll
        for (int ai = 0; ai < 2; ++ai)
#pragma unroll
            for (int m = 0; m < 4; ++m) { float* rowp = C + (size_t)(row0 + ai * HALF + m * 16) * ldc + col0;
#pragma unroll
                for (int bj = 0; bj < 2; ++bj)
#pragma unroll
                    for (int n = 0; n < 2; ++n) *(f32x4*)(rowp + bj * HALF + n * 16) = acc[ai][bj][m][n]; }
    }
};
struct EpiBf16 {
    static constexpr bool PERM = true;
    bf16_t* O; int ldc;
    __device__ __forceinline__ void operator()(const f32x4 (&acc)[2][2][4][2], const Unit& u, int wr, int wc, int fr, int fq) const {
        const int row0 = u.pm * BM + wr * 64 + fr, col0 = u.pn * BM + wc * 32 + 8 * fq;
#pragma unroll
        for (int ai = 0; ai < 2; ++ai)
#pragma unroll
            for (int m = 0; m < 4; ++m) { bf16_t* rowp = O + (size_t)(row0 + ai * HALF + m * 16) * ldc + col0;
#pragma unroll
                for (int bj = 0; bj < 2; ++bj) { const f32x4 v0 = acc[ai][bj][m][0], v1 = acc[ai][bj][m][1];
                    uint4 o; o.x = pack2(v0[0], v0[1]); o.y = pack2(v0[2], v0[3]); o.z = pack2(v1[0], v1[1]); o.w = pack2(v1[2], v1[3]);
                    *(uint4*)(rowp + bj * HALF) = o; } }
    }
};
struct XUnit { int row0, nrows, e, nt; };
template <class Epi>
__device__ __forceinline__ void gemm_phase_xg(LAS unsigned char* lds, const bf16_t* Ag, const int* slot_tk, const int* xt, const bf16_t* BtW, const int nun, const int lb, const int G, const Epi& E) {
    int tid = threadIdx.x; asm volatile("" : "+v"(tid));
    const int wid = __builtin_amdgcn_readfirstlane(tid >> 6), lane = tid & 63, wr = wid >> 2, wc = wid & 3, fr = lane & 15, fq = lane >> 4;
    constexpr int K = 1024, nt = K / BK;
    unsigned voffB[2];
#pragma unroll
    for (int i = 0; i < 2; ++i) { int R, C; stage_rc(tid * 16 + i * 8192, R, C); voffB[i] = (unsigned)(R * K + C) * 2u; }
    const size_t kstep = (size_t)(BK * 2), hstepB = (size_t)HALF * K * 2;
    const unsigned ldsw = (unsigned)wid * 1024u;
    const int aoff = lds_byte(wr * 64 + fr, fq * 8), boff = lds_byte(wc * 32 + fr, fq * 8);
#define PG8_SA(b, h) (((b) * 2 + (h)) * HTB)
#define PG8_SB(b, h) ((4 + (b) * 2 + (h)) * HTB)
#define PG8_STAGE(bufoff, gbase, voff) do { _Pragma("unroll") for (int _i = 0; _i < 2; ++_i) \
        __builtin_amdgcn_global_load_lds((const unsigned*)((const char*)(gbase) + (voff)[_i]), (LAS unsigned*)(lds + (bufoff) + ldsw + _i * 8192), 16, 0, 0); } while (0)
#define PG8_LDA(dst, b, h) do { _Pragma("unroll") for (int m = 0; m < 4; ++m) _Pragma("unroll") for (int k = 0; k < 2; ++k) dst[m][k] = *(const LAS bf16x8*)(lds + PG8_SA(b, h) + aoff + m * 2048 + k * 1024); } while (0)
#define PG8_LDB(dst, b, h) do { _Pragma("unroll") for (int n = 0; n < 2; ++n) _Pragma("unroll") for (int k = 0; k < 2; ++k) dst[n][k] = *(const LAS bf16x8*)(lds + PG8_SB(b, h) + boff + n * 2048 + k * 1024); } while (0)
#define PG8_MMA(ai, bj, At, Bt) do { __builtin_amdgcn_s_setprio(1); _Pragma("unroll") for (int m = 0; m < 4; ++m) _Pragma("unroll") for (int n = 0; n < 2; ++n) _Pragma("unroll") for (int k = 0; k < 2; ++k) \
        acc[ai][bj][m][n] = __builtin_amdgcn_mfma_f32_16x16x32_bf16(Bt[n][k], At[m][k], acc[ai][bj][m][n], 0, 0, 0); __builtin_amdgcn_s_setprio(0); } while (0)
#define PG8_WAIT_V(n) asm volatile("s_waitcnt vmcnt(" #n ")" ::: "memory")
#define PG8_WAIT_L(n) asm volatile("s_waitcnt lgkmcnt(" #n ")" ::: "memory")
#define PG8_BAR __builtin_amdgcn_s_barrier()
#define PG8_SCHED __builtin_amdgcn_sched_barrier(0)
#define XG_UNIT(I, U) ((lb + (I) * G) < nun ? ((U).row0 = xt[((lb + (I) * G) >> 1) * 4 + 1], (U).nrows = xt[((lb + (I) * G) >> 1) * 4 + 2], (U).e = xt[((lb + (I) * G) >> 1) * 4], (U).nt = (lb + (I) * G) & 1, true) : false)
#define XG_AVOFF(U, V0, V1) do { int t_ = threadIdx.x; asm volatile("" : "+v"(t_)); _Pragma("unroll") for (int _i = 0; _i < 2; ++_i) { int R_, C_; stage_rc(t_ * 16 + _i * 8192, R_, C_); \
        V0[_i] = (unsigned)(slot_tk[(U).row0 + R_] / 9) * 2048u + (unsigned)C_ * 2u; V1[_i] = (unsigned)(slot_tk[(U).row0 + 128 + R_] / 9) * 2048u + (unsigned)C_ * 2u; } } while (0)
    XUnit cur, nxt; int ui = 0;
    if (!XG_UNIT(0, cur)) return;
    f32x4 acc[2][2][4][2];
#pragma unroll
    for (int a = 0; a < 2; ++a)
#pragma unroll
        for (int b = 0; b < 2; ++b)
#pragma unroll
            for (int m = 0; m < 4; ++m)
#pragma unroll
                for (int n = 0; n < 2; ++n) acc[a][b][m][n] = (f32x4){0.f, 0.f, 0.f, 0.f};
    bf16x8 At[4][2], B0[2][2], B1[2][2];
    unsigned vC0[2], vC1[2], vN1[2];
    XG_AVOFF(cur, vC0, vC1);
    const char* cA = (const char*)Ag;
    const char* cB = (const char*)(BtW + ((size_t)cur.e * 512 + cur.nt * 256) * K);
    PG8_STAGE(PG8_SB(0, 0), cB, voffB); PG8_STAGE(PG8_SA(0, 0), cA, vC0); PG8_STAGE(PG8_SB(0, 1), cB + hstepB, voffB); PG8_STAGE(PG8_SA(0, 1), cA, vC1);
    if (wr == 1) PG8_BAR;
    PG8_WAIT_V(4); PG8_BAR;
    PG8_STAGE(PG8_SB(1, 0), cB + kstep, voffB); PG8_STAGE(PG8_SA(1, 0), cA + kstep, vC0); PG8_STAGE(PG8_SB(1, 1), cB + hstepB + kstep, voffB);
    PG8_WAIT_V(6); PG8_BAR;
    for (;;) {
        const bool has_next = XG_UNIT(ui + 1, nxt);
        if (!has_next) nxt = cur;
        const char* nB = (const char*)(BtW + ((size_t)nxt.e * 512 + nxt.nt * 256) * K);
        for (int t = 0; t < nt; t += 2) {
            const bool last = (t == nt - 2);
            if (last) XG_AVOFF(nxt, vC0, vN1);
            const char* a1 = cA + (size_t)(t + 1) * kstep;
            const char* a2 = last ? cA : cA + (size_t)(t + 2) * kstep; const char* b2 = last ? nB : cB + (size_t)(t + 2) * kstep;
            const char* a3 = a2 + kstep; const char* b3 = b2 + kstep;
            PG8_LDB(B0, 0, 0); PG8_SCHED; PG8_LDA(At, 0, 0); PG8_STAGE(PG8_SA(1, 1), a1, vC1);
            if (last) { vC1[0] = vN1[0]; vC1[1] = vN1[1]; }
            PG8_WAIT_L(8); PG8_BAR; PG8_WAIT_L(0); PG8_MMA(0, 0, At, B0); PG8_BAR; PG8_SCHED;
            PG8_LDB(B1, 0, 1); PG8_STAGE(PG8_SB(0, 0), b2, voffB);
            PG8_BAR; PG8_WAIT_L(0); PG8_MMA(0, 1, At, B1); PG8_BAR;
            PG8_LDA(At, 0, 1); PG8_STAGE(PG8_SA(0, 0), a2, vC0);
            PG8_BAR; PG8_WAIT_L(0); PG8_MMA(1, 0, At, B0); PG8_BAR; PG8_SCHED;
            PG8_STAGE(PG8_SB(0, 1), b2 + hstepB, voffB);
            PG8_WAIT_V(6); PG8_BAR; PG8_MMA(1, 1, At, B1); PG8_BAR;
            PG8_LDB(B0, 1, 0); PG8_SCHED; PG8_LDA(At, 1, 0); PG8_STAGE(PG8_SA(0, 1), a2, vC1);
            PG8_WAIT_L(8); PG8_BAR; PG8_WAIT_L(0); PG8_MMA(0, 0, At, B0); PG8_BAR; PG8_SCHED;
            PG8_LDB(B1, 1, 1); PG8_STAGE(PG8_SB(1, 0), b3, voffB);
            PG8_BAR; PG8_WAIT_L(0); PG8_MMA(0, 1, At, B1); PG8_BAR;
            PG8_LDA(At, 1, 1); PG8_STAGE(PG8_SA(1, 0), a3, vC0);
            PG8_BAR; PG8_WAIT_L(0); PG8_MMA(1, 0, At, B0); PG8_BAR; PG8_SCHED;
            PG8_STAGE(PG8_SB(1, 1), b3 + hstepB, voffB);
            PG8_WAIT_V(6); PG8_BAR; PG8_MMA(1, 1, At, B1); PG8_BAR;
        }
        E(acc, cur, wr, wc, fr, fq);
        if (!has_next) break;
#pragma unroll
        for (int a = 0; a < 2; ++a)
#pragma unroll
            for (int b = 0; b < 2; ++b)
#pragma unroll
                for (int m = 0; m < 4; ++m)
#pragma unroll
                    for (int n = 0; n < 2; ++n) acc[a][b][m][n] = (f32x4){0.f, 0.f, 0.f, 0.f};
        cur = nxt; cB = nB; ++ui;
    }
    PG8_WAIT_V(0);
    if (wr == 0) PG8_BAR;
    PG8_BAR;
#undef PG8_SA
#undef PG8_SB
#undef PG8_STAGE
#undef PG8_LDA
#undef PG8_LDB
#undef PG8_MMA
#undef PG8_WAIT_V
#undef PG8_WAIT_L
#undef PG8_BAR
#undef PG8_SCHED
#undef XG_UNIT
#undef XG_AVOFF
}
struct EpiGU {
    bf16_t* act;
    __device__ __forceinline__ void operator()(const f32x4 (&acc)[2][2][4][2], const XUnit& u, int wr, int wc, int fr, int fq) const {
        const int r0 = wr * 64 + fr;
#pragma unroll
        for (int ai = 0; ai < 2; ++ai)
#pragma unroll
            for (int m = 0; m < 4; ++m) { const int r = r0 + ai * HALF + m * 16;
                if (r < u.nrows) { bf16_t* rowp = act + (size_t)(u.row0 + r) * 256 + u.nt * 128 + wc * 16 + fq * 4;
#pragma unroll
                    for (int bj = 0; bj < 2; ++bj) { const f32x4 g = acc[ai][bj][m][0], up = acc[ai][bj][m][1];
                        uint2 o; o.x = pack2(g[0] * sigm(g[0]) * up[0], g[1] * sigm(g[1]) * up[1]); o.y = pack2(g[2] * sigm(g[2]) * up[2], g[3] * sigm(g[3]) * up[3]);
                        *(uint2*)(rowp + bj * 64) = o; } } }
    }
};
}

template <class DescF, class EpiF>
__device__ __forceinline__ void stream_gemm128(char* smem, const int nunits, const DescF& desc, const EpiF& epi) {
    constexpr int STAGE = 2 * TILE_BYTES;
    const int tid = tidx(), wave = tid >> 6, lane = tid & 63, fr = lane & 15, fq = lane >> 4;
    const int wm = wave >> 1, wn = wave & 1;
    const int lrow = tid >> 3, lseg = tid & 7, G = gridDim.x;
    if ((int)blockIdx.x >= nunits) return;
    uint4 ra0, ra1, rb0, rb1;
    const char* la = nullptr; const char* lbp = nullptr; unsigned lao0 = 0, lao1 = 0, lbo0 = 0, lbo1 = 0;
    int lu = blockIdx.x, lkt = 0, lnk = 0;
    int cu = blockIdx.x, ckt = 0, cnk = 0;
#define SG_DESC() do { const bf16_t* A_; const bf16_t* B_; int lda_, ldb_; desc(lu, A_, B_, lda_, ldb_, lnk); la = (const char*)A_; lbp = (const char*)B_; \
        lao0 = (unsigned)(lrow * lda_) * 2u + lseg * 16; lao1 = (unsigned)((lrow + 64) * lda_) * 2u + lseg * 16; lbo0 = (unsigned)(lrow * ldb_) * 2u + lseg * 16; lbo1 = (unsigned)((lrow + 64) * ldb_) * 2u + lseg * 16; } while (0)
#define SG_LOAD() do { ra0 = *(const uint4*)(la + (lao0 + lkt * 128)); ra1 = *(const uint4*)(la + (lao1 + lkt * 128)); rb0 = *(const uint4*)(lbp + (lbo0 + lkt * 128)); rb1 = *(const uint4*)(lbp + (lbo1 + lkt * 128)); } while (0)
#define SG_STORE(ST) do { char* As_ = smem + (ST) * STAGE; char* Bs_ = As_ + TILE_BYTES; \
        *(uint4*)(As_ + lrow * TSTR + lseg * 16) = ra0; *(uint4*)(As_ + (lrow + 64) * TSTR + lseg * 16) = ra1; *(uint4*)(Bs_ + lrow * TSTR + lseg * 16) = rb0; *(uint4*)(Bs_ + (lrow + 64) * TSTR + lseg * 16) = rb1; } while (0)
#define SG_ADV() do { if (++lkt == lnk) { lkt = 0; lu += G; if (lu < nunits) SG_DESC(); } } while (0)
    f32x4 acc[2][4];
#pragma unroll
    for (int mi = 0; mi < 2; ++mi)
#pragma unroll
        for (int ni = 0; ni < 4; ++ni) acc[mi][ni] = (f32x4){0.f, 0.f, 0.f, 0.f};
    SG_DESC(); cnk = lnk;
    SG_LOAD(); SG_STORE(0); SG_ADV(); __syncthreads();
    for (int s = 0; cu < nunits; ++s) {
        const bool more = lu < nunits;
        if (more) SG_LOAD();
        const char* As = smem + (s & 1) * STAGE; const char* Bs = As + TILE_BYTES;
#pragma unroll
        for (int ks = 0; ks < 2; ++ks) {
            bf16x8 af[2], bfr[4];
#pragma unroll
            for (int mi = 0; mi < 2; ++mi) af[mi] = *(const bf16x8*)(As + (wm * 32 + mi * 16 + fr) * TSTR + ks * 64 + fq * 16);
#pragma unroll
            for (int ni = 0; ni < 4; ++ni) bfr[ni] = *(const bf16x8*)(Bs + (wn * 64 + ni * 16 + fr) * TSTR + ks * 64 + fq * 16);
#pragma unroll
            for (int mi = 0; mi < 2; ++mi)
#pragma unroll
                for (int ni = 0; ni < 4; ++ni) acc[mi][ni] = __builtin_amdgcn_mfma_f32_16x16x32_bf16(bfr[ni], af[mi], acc[mi][ni], 0, 0, 0);
        }
        if (++ckt == cnk) {
            epi(cu, acc, wm * 32 + fr, wn * 64 + fq * 4);
#pragma unroll
            for (int mi = 0; mi < 2; ++mi)
#pragma unroll
                for (int ni = 0; ni < 4; ++ni) acc[mi][ni] = (f32x4){0.f, 0.f, 0.f, 0.f};
            ckt = 0; cu += G;
            if (cu < nunits) { const bf16_t* A_; const bf16_t* B_; int lda_, ldb_; desc(cu, A_, B_, lda_, ldb_, cnk); }
        }
        if (more) { SG_STORE((s + 1) & 1); SG_ADV(); }
        __syncthreads();
    }
#undef SG_DESC
#undef SG_LOAD
#undef SG_STORE
#undef SG_ADV
}

__device__ __forceinline__ void conv_gu_tiles(const Params& p, char* smem, int w0, int nw, int t_begin, int t_end) {
    const int tid = tidx(), wave = tid >> 6, lane = tid & 63;
    bf16_t* T = (bf16_t*)smem + wave * (2 * 16 * 72);
    for (int tau = t_begin + w0 * 2; tau < t_end; tau += nw * 2) {
        float4 v[2][4];
#pragma unroll
        for (int h = 0; h < 2; ++h) {
            const int tt = tau + h < t_end ? tau + h : tau;
            const int m = tt >> 8, kb = (tt >> 4) & 15, nb = tt & 15, e = m >> 1, sel = m & 1;
            const float* src = (sel ? (e < 256 ? p.exp_w_up + (size_t)e * 262144 : p.sh_w_up) : (e < 256 ? p.exp_w_gate + (size_t)e * 262144 : p.sh_w_gate)) + (size_t)(kb * 64 + lane) * 256 + nb * 16;
#pragma unroll
            for (int i = 0; i < 4; ++i) v[h][i] = *(const float4*)(src + i * 4);
        }
#pragma unroll
        for (int h = 0; h < 2; ++h) {
            if (tau + h >= t_end) break;
            const int tt = tau + h;
            const int m = tt >> 8, kb = (tt >> 4) & 15, nb = tt & 15, e = m >> 1, sel = m & 1;
            bf16_t* Th = T + h * (16 * 72);
#pragma unroll
            for (int i = 0; i < 4; ++i) { Th[(i * 4 + 0) * 72 + lane] = f2bf(v[h][i].x); Th[(i * 4 + 1) * 72 + lane] = f2bf(v[h][i].y); Th[(i * 4 + 2) * 72 + lane] = f2bf(v[h][i].z); Th[(i * 4 + 3) * 72 + lane] = f2bf(v[h][i].w); }
            const int q = lane >> 2, seg = lane & 3;
            const uint4 o0 = *(const uint4*)(Th + q * 72 + seg * 16), o1 = *(const uint4*)(Th + q * 72 + seg * 16 + 8);
            const int rho = (nb >> 3) * 256 + ((nb >> 2) & 1) * 128 + (nb & 3) * 32 + sel * 16 + q;
            bf16_t* d = p.BtW + ((size_t)e * 512 + rho) * 1024 + kb * 64 + seg * 16;
            *(uint4*)d = o0; *(uint4*)(d + 8) = o1;
        }
    }
}

__device__ __forceinline__ void phase0(const Params& p, char* smem) {
    const int tid = tidx(), wave = tid >> 6, lane = tid & 63;
    const int gw = blockIdx.x * 8 + wave, nw = gridDim.x * 8;
    for (int u = gw; u < 1536; u += nw) {
        const int cb = u % 96, ks = u / 96, j = cb * 64 + lane;
        float a0 = 0.f, a1 = 0.f;
#pragma unroll 1
        for (int k0 = ks * 64; k0 < ks * 64 + 64; k0 += 16) {
            float w[16];
#pragma unroll
            for (int i = 0; i < 16; ++i) w[i] = p.w_mod[(size_t)(k0 + i) * 6144 + j];
#pragma unroll
            for (int i = 0; i < 16; ++i) { const float c0 = p.c[k0 + i], c1 = p.c_ctx[k0 + i]; a0 += c0 * sigm(c0) * w[i]; a1 += c1 * sigm(c1) * w[i]; }
        }
        p.modp[(ks * 2 + 0) * 6144 + j] = a0; p.modp[(ks * 2 + 1) * 6144 + j] = a1;
    }
    float* T = (float*)smem;
    int total = 0;
    for (int j = 0; j < NJOB; ++j) total += (p.jobs[j].K >> 6) * (p.jobs[j].N >> 6);
    for (int u = blockIdx.x; u < total; u += gridDim.x) {
        int j = 0, r = u;
        for (;; ++j) { const int n = (p.jobs[j].K >> 6) * (p.jobs[j].N >> 6); if (r < n) break; r -= n; }
        const TJob jb = p.jobs[j];
        const int ntn = jb.N >> 6, kt = r / ntn, nt = r % ntn, k0 = kt * 64, n0 = nt * 64;
        {
            const int kk = tid >> 4, c4 = (tid & 15) * 4;
#pragma unroll
            for (int i = 0; i < 2; ++i) {
                const int k = kk + 32 * i;
                const float4 v = *(const float4*)(jb.src + (size_t)(k0 + k) * jb.N + n0 + c4);
                T[k * 65 + c4 + 0] = v.x; T[k * 65 + c4 + 1] = v.y; T[k * 65 + c4 + 2] = v.z; T[k * 65 + c4 + 3] = v.w;
            }
        }
        __syncthreads();
        {
            const int n = tid >> 3, ks = (tid & 7) * 8;
            float v[8];
#pragma unroll
            for (int q = 0; q < 8; ++q) v[q] = T[(ks + q) * 65 + n];
            const int ng = n0 + n;
            int drow = jb.rowoff + ng;
            if (jb.mode == 2) drow = (ng >> 4) * 32 + (ng & 15) + jb.rowoff;
            uint4 hi; hi.x = pack2(v[0], v[1]); hi.y = pack2(v[2], v[3]); hi.z = pack2(v[4], v[5]); hi.w = pack2(v[6], v[7]);
            bf16_t* d = jb.dst + (size_t)drow * jb.dld + jb.coloff + k0 + ks;
            *(uint4*)d = hi;
            if (jb.mode == 1) {
                float l[8];
#pragma unroll
                for (int q = 0; q < 8; ++q) l[q] = v[q] - bf2f(f2bf(v[q]));
                uint4 lo; lo.x = pack2(l[0], l[1]); lo.y = pack2(l[2], l[3]); lo.z = pack2(l[4], l[5]); lo.w = pack2(l[6], l[7]);
                *(uint4*)(d + 1024) = hi; *(uint4*)(d + 2048) = lo;
            }
        }
        __syncthreads();
    }
}

__device__ __forceinline__ void phase1(const Params& p, char* smem) {
    const int tid = tidx(), wave = tid >> 6, lane = tid & 63;
    float* L = (float*)smem;
    for (int idx = tid; idx < 4096; idx += NT) {
        const int v = idx >> 11, which = (idx >> 10) & 1, col = idx & 1023;
        float s = p.b_mod[which * 1024 + col];
        for (int ks = 0; ks < 16; ++ks) s += p.modp[(ks * 2 + v) * 6144 + which * 1024 + col];
        L[idx] = s;
    }
    for (int idx = blockIdx.x * NT + tid; idx < 2 * 6144; idx += gridDim.x * NT) {
        const int v = idx / 6144, j = idx % 6144;
        float sm = p.b_mod[j];
#pragma unroll
        for (int ks = 0; ks < 16; ++ks) sm += p.modp[(ks * 2 + v) * 6144 + j];
        p.mod[idx] = sm;
    }
    __syncthreads();
    const int gw = blockIdx.x * 8 + wave, nw = gridDim.x * 8;
    for (int r0 = gw; r0 < TE; r0 += 2 * nw) {
        float4 xv[2][4]; float ss[2];
#pragma unroll
        for (int h = 0; h < 2; ++h) {
            const int r = r0 + h * nw < TE ? r0 + h * nw : r0;
            const float* src = r < 256 ? p.ctx + (size_t)r * 1024 : p.x + (size_t)(r - 256) * 1024;
            ss[h] = 0.f;
#pragma unroll
            for (int i = 0; i < 4; ++i) { xv[h][i] = *(const float4*)(src + i * 256 + lane * 4); ss[h] += xv[h][i].x * xv[h][i].x + xv[h][i].y * xv[h][i].y + xv[h][i].z * xv[h][i].z + xv[h][i].w * xv[h][i].w; }
        }
#pragma unroll
        for (int h = 0; h < 2; ++h) {
            const int r = r0 + h * nw;
            if (r >= TE) break;
            const int v = r < 256 ? 1 : 0;
            const float rs = rsqrtf(wsum(ss[h]) * (1.f / 1024.f) + 1e-6f);
#pragma unroll
            for (int i = 0; i < 4; ++i) {
                const int col = i * 256 + lane * 4;
                const float4 g = *(const float4*)(p.n_pre_mix + col);
                const float* sh = L + v * 2048 + col; const float* sc = L + v * 2048 + 1024 + col;
                const float y0 = xv[h][i].x * rs * g.x * (1.f + sc[0]) + sh[0];
                const float y1 = xv[h][i].y * rs * g.y * (1.f + sc[1]) + sh[1];
                const float y2 = xv[h][i].z * rs * g.z * (1.f + sc[2]) + sh[2];
                const float y3 = xv[h][i].w * rs * g.w * (1.f + sc[3]) + sh[3];
                uint2 o; o.x = pack2(y0, y1); o.y = pack2(y2, y3);
                *(uint2*)(p.hn + (size_t)r * 1024 + col) = o;
            }
        }
    }
}

__device__ __forceinline__ void phase2(const Params& p, char* smem) {
    g8::StaticOrder S; S.init(TE, INC, gridDim.x, blockIdx.x);
    g8::EpiBf16 E{p.proj, INC};
    g8::gemm_phase((LAS unsigned char*)smem, p.hn, p.WinT, 1024, 1024, 1024, S, E);
}

__device__ __forceinline__ void phase3(const Params& p, char* smem) {
    const int tid = tidx(), wave = tid >> 6, lane = tid & 63;
    const int gw = blockIdx.x * 8 + wave, nw = gridDim.x * 8;
    float mu0[3][8], mu1[3][8], kkw[8], lm0[4], lm1[4];
#pragma unroll
    for (int a = 0; a < 3; ++a)
#pragma unroll
        for (int q = 0; q < 8; ++q) { mu0[a][q] = p.shift_mu[a * 512 + lane * 8 + q]; mu1[a][q] = p.shift_mu[1792 + a * 512 + lane * 8 + q]; }
#pragma unroll
    for (int q = 0; q < 8; ++q) kkw[q] = p.rwkv_k_k[lane * 8 + q];
#pragma unroll
    for (int q = 0; q < 4; ++q) { lm0[q] = p.shift_mu[1536 + lane * 4 + q]; lm1[q] = p.shift_mu[1792 + 1536 + lane * 4 + q]; }
    for (int t = gw; t < TE; t += nw) {
        const bool hp = (t != 0 && t != 256), hn_ = (t != 255 && t != TE - 1);
        const bf16_t* pr = p.proj + (size_t)t * INC;
        uint4 q0[3], qm[3], qn[3]; uint2 l0, lm = make_uint2(0, 0), ln = make_uint2(0, 0);
#pragma unroll
        for (int a = 0; a < 3; ++a) {
            q0[a] = *(const uint4*)(pr + a * 512 + lane * 8);
            qm[a] = hp ? *(const uint4*)(pr + a * 512 + lane * 8 - INC) : make_uint4(0, 0, 0, 0);
            qn[a] = hn_ ? *(const uint4*)(pr + a * 512 + lane * 8 + INC) : make_uint4(0, 0, 0, 0);
        }
        l0 = *(const uint2*)(pr + 1536 + lane * 4);
        if (hp) lm = *(const uint2*)(pr + 1536 + lane * 4 - INC);
        if (hn_) ln = *(const uint2*)(pr + 1536 + lane * 4 + INC);
        float val[3][8];
#pragma unroll
        for (int a = 0; a < 3; ++a) {
            float f0[8], fm[8], fn[8]; unpack8(q0[a], f0); unpack8(qm[a], fm); unpack8(qn[a], fn);
#pragma unroll
            for (int q = 0; q < 8; ++q) val[a][q] = f0[q] + mu0[a][q] * (fm[q] - f0[q]) + mu1[a][q] * (fn[q] - f0[q]);
        }
        float kkv[8], n2 = 0.f;
#pragma unroll
        for (int q = 0; q < 8; ++q) { kkv[q] = val[1][q] * kkw[q]; n2 += kkv[q] * kkv[q]; }
        n2 = sum8(n2);
        const float inv = -1.f / fmaxf(sqrtf(n2), 1e-12f);
#pragma unroll
        for (int q = 0; q < 8; ++q) kkv[q] *= inv;
        const size_t o = (size_t)t * 512 + lane * 8;
        *(uint4*)(p.Rr + o) = pack8(val[0]); *(uint4*)(p.Kk + o) = pack8(val[1]); *(uint4*)(p.Vv + o) = pack8(val[2]); *(uint4*)(p.Aa + o) = pack8(kkv);
        {
            float v[4];
            const unsigned w0[2] = {l0.x, l0.y}, wm[2] = {lm.x, lm.y}, wn[2] = {ln.x, ln.y};
#pragma unroll
            for (int q = 0; q < 4; ++q) {
                const float p0 = (q & 1) ? __uint_as_float(w0[q >> 1] & 0xffff0000u) : __uint_as_float(w0[q >> 1] << 16);
                const float pm = (q & 1) ? __uint_as_float(wm[q >> 1] & 0xffff0000u) : __uint_as_float(wm[q >> 1] << 16);
                const float pn = (q & 1) ? __uint_as_float(wn[q >> 1] & 0xffff0000u) : __uint_as_float(wn[q >> 1] << 16);
                v[q] = p0 + lm0[q] * (pm - p0) + lm1[q] * (pn - p0);
            }
            if (lane < 16) {
                uint2 ov; ov.x = pack2(tanhf(v[0]), tanhf(v[1])); ov.y = pack2(tanhf(v[2]), tanhf(v[3]));
                *(uint2*)(p.TW + (size_t)t * 64 + lane * 4) = ov;
            } else if (lane < 32) {
                uint2 ov; ov.x = pack2(v[0], v[1]); ov.y = pack2(v[2], v[3]);
                *(uint2*)(p.XA + (size_t)t * 64 + (lane - 16) * 4) = ov;
            } else {
                uint2 ov; ov.x = pack2(sigm(v[0]), sigm(v[1])); ov.y = pack2(sigm(v[2]), sigm(v[3]));
                *(uint2*)(p.SG + (size_t)t * 128 + (lane - 32) * 4) = ov;
            }
        }
    }
}

__device__ __forceinline__ void phase4(const Params& p, char* smem) {
    stream_gemm128(smem, 130 * 20,
        [&](int u, const bf16_t*& A, const bf16_t*& B, int& lda, int& ldb, int& nk) {
            const int mt = u / 20, q = u % 20;
            if (q < 8) { A = p.TW + (size_t)mt * 128 * 64; B = p.WupT + (size_t)q * 128 * 64; lda = 64; ldb = 64; nk = 1; }
            else if (q < 16) { A = p.XA + (size_t)mt * 128 * 64; B = p.AupT + (size_t)(q - 8) * 128 * 64; lda = 64; ldb = 64; nk = 1; }
            else { A = p.SG + (size_t)mt * 128 * 128; B = p.GupT + (size_t)(q - 16) * 128 * 128; lda = 128; ldb = 128; nk = 2; }
        },
        [&](int u, const f32x4 (&acc)[2][4], int r0, int c0) {
            const int mt = u / 20, q = u % 20;
            if (q < 8) {
#pragma unroll
                for (int mi = 0; mi < 2; ++mi)
#pragma unroll
                    for (int ni = 0; ni < 4; ++ni) {
                        const int t = mt * 128 + r0 + mi * 16, cc = q * 128 + c0 + ni * 16, d = cc >> 9, c = cc & 511;
                        float4 o; float* op = (float*)&o;
#pragma unroll
                        for (int j = 0; j < 4; ++j) { const float z = p.rwkv_w0[d * 512 + c + j] + acc[mi][ni][j]; op[j] = __expf(-0.60653066f * sigm(z)); }
                        *(float4*)(p.Wd + ((size_t)d * TE + t) * 512 + c) = o;
                    }
            } else if (q < 16) {
                const int qq = q - 8;
#pragma unroll
                for (int mi = 0; mi < 2; ++mi)
#pragma unroll
                    for (int ni = 0; ni < 4; ++ni) {
                        const int t = mt * 128 + r0 + mi * 16, cc = qq * 128 + c0 + ni * 16, d = cc >> 9, c = cc & 511;
                        const uint2 av = *(const uint2*)(p.Aa + (size_t)t * 512 + c), kv = *(const uint2*)(p.Kk + (size_t)t * 512 + c);
                        const bf16_t* ae = (const bf16_t*)&av; const bf16_t* ke = (const bf16_t*)&kv;
                        float bo[4], ko[4];
#pragma unroll
                        for (int j = 0; j < 4; ++j) {
                            const float ad = sigm(p.rwkv_a0[d * 512 + c + j] + acc[mi][ni][j]);
                            bo[j] = -bf2f(ae[j]) * ad;
                            ko[j] = bf2f(ke[j]) * (1.f + (ad - 1.f) * p.rwkv_k_a[c + j]);
                        }
                        uint2 o1, o2; o1.x = pack2(bo[0], bo[1]); o1.y = pack2(bo[2], bo[3]); o2.x = pack2(ko[0], ko[1]); o2.y = pack2(ko[2], ko[3]);
                        *(uint2*)(p.Bd + ((size_t)d * TE + t) * 512 + c) = o1;
                        *(uint2*)(p.KD + ((size_t)d * TE + t) * 512 + c) = o2;
                    }
            } else {
                const int qq = q - 16;
#pragma unroll
                for (int mi = 0; mi < 2; ++mi)
#pragma unroll
                    for (int ni = 0; ni < 4; ++ni) {
                        const int t = mt * 128 + r0 + mi * 16, c = qq * 128 + c0 + ni * 16;
                        uint2 o; o.x = pack2(acc[mi][ni][0], acc[mi][ni][1]); o.y = pack2(acc[mi][ni][2], acc[mi][ni][3]);
                        *(uint2*)(p.G + (size_t)t * 512 + c) = o;
                    }
            }
        });
}

__device__ __forceinline__ void phase5(const Params& p, char* smem) {
    const int tid = tidx(), wave = __builtin_amdgcn_readfirstlane(tid >> 6), lane = tid & 63;
    constexpr int SB = 5, NA = 6, NSB = RL / SB;
    float* L = (float*)(smem + wave * (2 * SB * NA * 64 * 4 + 16 * 72 * 2));
    bf16_t* CT = (bf16_t*)(L + 2 * SB * NA * 64);
    for (int q = blockIdx.x * 8 + wave; q < RNC * 16; q += gridDim.x * 8) {
        const int j = q >> 4, hd = q & 15, dir = hd >> 3, h = hd & 7;
        const float* gW = p.Wd + (size_t)dir * TE * 512; const bf16_t* gB = p.Bd + (size_t)dir * TE * 512; const bf16_t* gK = p.KD + (size_t)dir * TE * 512;
        const bf16_t* gA = p.Aa; const bf16_t* gV = p.Vv; const bf16_t* gR = p.Rr;
        const unsigned lofs = (unsigned)(h * 64 + lane);
        bf16_t* gZ = p.Zz + (size_t)q * (RL * 64) + lane; bf16_t* gY = p.YH + (size_t)q * (RL * 64) + lane;
        f32x2 sP[32], sH[32];
        int ln = lane; asm volatile("" : "+v"(ln));
#pragma unroll
        for (int k = 0; k < 32; ++k) { sP[k] = (f32x2){(2 * k == ln) ? 1.f : 0.f, (2 * k + 1 == ln) ? 1.f : 0.f}; sH[k] = (f32x2){0.f, 0.f}; }
        for (int sb = 0; sb < NSB; ++sb) {
            {
                float st[SB][NA];
#pragma unroll
                for (int i = 0; i < SB; ++i) {
                    const unsigned g = (unsigned)row_of(dir, j * RL + sb * SB + i) * 512u + lofs;
                    st[i][0] = gW[g]; st[i][1] = bf2f(gA[g]); st[i][2] = bf2f(gB[g]); st[i][3] = bf2f(gK[g]); st[i][4] = bf2f(gV[g]); st[i][5] = bf2f(gR[g]);
                }
                float* d = L + (sb & 1) * (SB * NA * 64) + lane;
#pragma unroll
                for (int i = 0; i < SB; ++i)
#pragma unroll
                    for (int a = 0; a < NA; ++a) d[(i * NA + a) * 64] = st[i][a];
            }
            const float* Lb = L + (sb & 1) * (SB * NA * 64);
            float4 cv[3][4]; const int ctau = q * 65 + sb * 3;
#pragma unroll
            for (int h = 0; h < 3; ++h) {
                int tt = ctau + h; if (sb * 3 + h >= 65 || tt >= 514 * 256) tt = 0;
                const int m = tt >> 8, kb = (tt >> 4) & 15, nb = tt & 15, e = m >> 1, sel = m & 1;
                const float* src = (sel ? (e < 256 ? p.exp_w_up + (size_t)e * 262144 : p.sh_w_up) : (e < 256 ? p.exp_w_gate + (size_t)e * 262144 : p.sh_w_gate)) + (size_t)(kb * 64 + lane) * 256 + nb * 16;
#pragma unroll
                for (int i = 0; i < 4; ++i) cv[h][i] = *(const float4*)(src + i * 4);
            }
#pragma unroll 1
            for (int i = 0; i < SB; ++i) {
                const float* W = Lb + (i * NA) * 64; const float* A = W + 64; const float* B = W + 128; const float* KDv = W + 192; const float* R = W + 320;
                const float vl = W[256 + lane];
                f32x2 dh0 = {0.f, 0.f}, dh1 = {0.f, 0.f}, dp0 = {0.f, 0.f}, dp1 = {0.f, 0.f};
                f32x4 rw[2], rb[2], rk[2], rr[2];
                rw[0] = *(const f32x4*)(W); rb[0] = *(const f32x4*)(B); rk[0] = *(const f32x4*)(KDv); rr[0] = *(const f32x4*)(R);
#pragma unroll
                for (int c = 0; c < 4; ++c) {
                    const f32x4 ac0 = *(const f32x4*)(A + c * 16), ac1 = *(const f32x4*)(A + c * 16 + 4), ac2 = *(const f32x4*)(A + c * 16 + 8), ac3 = *(const f32x4*)(A + c * 16 + 12);
                    const int k = c * 8;
                    dh0 += sH[k] * ac0.lo; dh1 += sH[k + 1] * ac0.hi; dp0 += sP[k] * ac0.lo; dp1 += sP[k + 1] * ac0.hi;
                    dh0 += sH[k + 2] * ac1.lo; dh1 += sH[k + 3] * ac1.hi; dp0 += sP[k + 2] * ac1.lo; dp1 += sP[k + 3] * ac1.hi;
                    dh0 += sH[k + 4] * ac2.lo; dh1 += sH[k + 5] * ac2.hi; dp0 += sP[k + 4] * ac2.lo; dp1 += sP[k + 5] * ac2.hi;
                    dh0 += sH[k + 6] * ac3.lo; dh1 += sH[k + 7] * ac3.hi; dp0 += sP[k + 6] * ac3.lo; dp1 += sP[k + 7] * ac3.hi;
                    __builtin_amdgcn_sched_barrier(0);
                }
                const float saHs = (dh0.x + dh0.y) + (dh1.x + dh1.y), saPs = (dp0.x + dp0.y) + (dp1.x + dp1.y);
                const f32x2 saH = {saHs, saHs}, saP = {saPs, saPs}, vl2 = {vl, vl};
                f32x2 y0 = {0.f, 0.f}, y1 = {0.f, 0.f}, z0 = {0.f, 0.f}, z1 = {0.f, 0.f};
#pragma unroll
                for (int g = 0; g < 16; ++g) {
                    if (g + 1 < 16) { rw[(g + 1) & 1] = *(const f32x4*)(W + 4 * g + 4); rb[(g + 1) & 1] = *(const f32x4*)(B + 4 * g + 4); rk[(g + 1) & 1] = *(const f32x4*)(KDv + 4 * g + 4); rr[(g + 1) & 1] = *(const f32x4*)(R + 4 * g + 4); }
                    const f32x4 cw = rw[g & 1], cb = rb[g & 1], ck = rk[g & 1], cr = rr[g & 1];
                    const int k = 2 * g;
                    sH[k]     = sH[k]     * cw.lo + (saH * cb.lo + vl2 * ck.lo);
                    sH[k + 1] = sH[k + 1] * cw.hi + (saH * cb.hi + vl2 * ck.hi);
                    sP[k]     = sP[k]     * cw.lo + saP * cb.lo;
                    sP[k + 1] = sP[k + 1] * cw.hi + saP * cb.hi;
                    y0 += sH[k] * cr.lo; y1 += sH[k + 1] * cr.hi;
                    z0 += sP[k] * cr.lo; z1 += sP[k + 1] * cr.hi;
                    __builtin_amdgcn_sched_barrier(0);
                }
                const int t = sb * SB + i;
                gZ[t * 64] = f2bf((z0.x + z0.y) + (z1.x + z1.y)); gY[t * 64] = f2bf((y0.x + y0.y) + (y1.x + y1.y));
            }
#pragma unroll
            for (int h = 0; h < 3; ++h) {
                const int tt = ctau + h;
                if (sb * 3 + h < 65 && tt < 514 * 256) {
                    const int m = tt >> 8, kb = (tt >> 4) & 15, nb = tt & 15, e = m >> 1, sel = m & 1;
#pragma unroll
                    for (int i = 0; i < 4; ++i) {
                        const unsigned p01 = pack2(cv[h][i].x, cv[h][i].y), p23 = pack2(cv[h][i].z, cv[h][i].w);
                        CT[(i * 4 + 0) * 72 + lane] = (bf16_t)(p01 & 0xffffu); CT[(i * 4 + 1) * 72 + lane] = (bf16_t)(p01 >> 16);
                        CT[(i * 4 + 2) * 72 + lane] = (bf16_t)(p23 & 0xffffu); CT[(i * 4 + 3) * 72 + lane] = (bf16_t)(p23 >> 16);
                    }
                    const int cq = lane >> 2, seg = lane & 3;
                    const uint4 o0 = *(const uint4*)(CT + cq * 72 + seg * 16), o1 = *(const uint4*)(CT + cq * 72 + seg * 16 + 8);
                    const int rho = (nb >> 3) * 256 + ((nb >> 2) & 1) * 128 + (nb & 3) * 32 + sel * 16 + cq;
                    bf16_t* d = p.BtW + ((size_t)e * 512 + rho) * 1024 + kb * 64 + seg * 16;
                    *(uint4*)d = o0; *(uint4*)(d + 8) = o1;
                }
            }
        }
        if (j < RNC - 1) {
            float* dP = p.PH + (((size_t)(j * 16 + hd) * 2 + 0) * 64 + lane) * 64;
            float* dH = p.PH + (((size_t)(j * 16 + hd) * 2 + 1) * 64 + lane) * 64;
#pragma unroll
            for (int k = 0; k < 32; k += 2) { *(float4*)(dP + 2 * k) = make_float4(sP[k].x, sP[k].y, sP[k + 1].x, sP[k + 1].y); *(float4*)(dH + 2 * k) = make_float4(sH[k].x, sH[k].y, sH[k + 1].x, sH[k + 1].y); }
        }
    }
}

__device__ __forceinline__ void phase6(const Params& p, char* smem) {
    const int tid = threadIdx.x, wave = __builtin_amdgcn_readfirstlane(tid >> 6), lane = tid & 63;
    if (blockIdx.x >= 256) return;
    const int hd = blockIdx.x >> 4, rb0 = (blockIdx.x & 15) * 4, r0 = rb0 + (wave & 3);
    LAS unsigned char* lds = (LAS unsigned char*)smem;
    constexpr int SLOT = 17408, NJ = RNC - 1;
    const char* pbase = (const char*)(p.PH + (size_t)hd * 2 * 4096);
    float s0 = 0.f;
#define CH_ISSUE(J) do { const char* src_ = pbase + (size_t)(J) * 524288; const unsigned so_ = (unsigned)(((J) & 7) * SLOT); \
        _Pragma("unroll") for (int q_ = 0; q_ < 4; ++q_) __builtin_amdgcn_global_load_lds((const unsigned*)(src_ + ((wave - 4) * 4 + q_) * 1024 + lane * 16), (LAS unsigned*)(lds + so_ + ((wave - 4) * 4 + q_) * 1024), 16, 0, 0); \
        if (wave == 7) __builtin_amdgcn_global_load_lds((const unsigned*)(src_ + 16384 + rb0 * 256 + lane * 16), (LAS unsigned*)(lds + so_ + 16384), 16, 0, 0); } while (0)
    if (wave >= 4) { CH_ISSUE(0); CH_ISSUE(1); CH_ISSUE(2); CH_ISSUE(3); CH_ISSUE(4); CH_ISSUE(5); CH_ISSUE(6); }
    for (int j = 0; j < RNC; ++j) {
        if (wave < 4) p.Sst[((size_t)(j * 16 + hd) * 64 + r0) * 64 + lane] = s0;
        if (j == NJ) break;
        if (wave >= 4) {
            if (j + 6 >= NJ) asm volatile("s_waitcnt vmcnt(0)" ::: "memory");
            else if (wave == 7) asm volatile("s_waitcnt vmcnt(30)" ::: "memory");
            else asm volatile("s_waitcnt vmcnt(24)" ::: "memory");
        }
        asm volatile("s_waitcnt lgkmcnt(0)" ::: "memory"); __builtin_amdgcn_s_barrier(); asm volatile("" ::: "memory");
        if (wave >= 4) { if (j + 7 < NJ) CH_ISSUE(j + 7); }
        else {
            const float* Pc = (const float*)(smem + (j & 7) * SLOT);
            float pv[64];
#pragma unroll
            for (int k = 0; k < 64; ++k) pv[k] = Pc[k * 64 + lane];
            f32x2 n0 = {Pc[4096 + wave * 64 + lane], 0.f}, n1 = {0.f, 0.f}, n2 = {0.f, 0.f}, n3 = {0.f, 0.f};
#pragma unroll
            for (int k = 0; k < 64; k += 8) {
                const f32x2 a0 = {__int_as_float(__builtin_amdgcn_readlane(__float_as_int(s0), k)), __int_as_float(__builtin_amdgcn_readlane(__float_as_int(s0), k + 1))};
                const f32x2 a1 = {__int_as_float(__builtin_amdgcn_readlane(__float_as_int(s0), k + 2)), __int_as_float(__builtin_amdgcn_readlane(__float_as_int(s0), k + 3))};
                const f32x2 a2 = {__int_as_float(__builtin_amdgcn_readlane(__float_as_int(s0), k + 4)), __int_as_float(__builtin_amdgcn_readlane(__float_as_int(s0), k + 5))};
                const f32x2 a3 = {__int_as_float(__builtin_amdgcn_readlane(__float_as_int(s0), k + 6)), __int_as_float(__builtin_amdgcn_readlane(__float_as_int(s0), k + 7))};
                n0 += a0 * (f32x2){pv[k], pv[k + 1]}; n1 += a1 * (f32x2){pv[k + 2], pv[k + 3]}; n2 += a2 * (f32x2){pv[k + 4], pv[k + 5]}; n3 += a3 * (f32x2){pv[k + 6], pv[k + 7]};
            }
            s0 = ((n0.x + n0.y) + (n1.x + n1.y)) + ((n2.x + n2.y) + (n3.x + n3.y));
        }
    }
#undef CH_ISSUE
    __syncthreads();
}

__device__ __forceinline__ void phase7(const Params& p, char* smem) {
    const int tid = tidx(), wave = __builtin_amdgcn_readfirstlane(tid >> 6), lane = tid & 63;
    constexpr int SB = 10, NSB = RL / SB;
    float* L = (float*)smem + wave * (SB * 64);
    for (int q = 16 + blockIdx.x * 8 + wave; q < RNC * 16; q += gridDim.x * 8) {
        const int j = q >> 4, hd = q & 15, dir = hd >> 3, h = hd & 7;
        f32x2 s[32];
        {
            const float* src = p.Sst + ((size_t)(j * 16 + hd) * 64 + lane) * 64;
#pragma unroll
            for (int k = 0; k < 32; k += 2) { const f32x4 v = *(const f32x4*)(src + 2 * k); s[k] = v.lo; s[k + 1] = v.hi; }
        }
        const bf16_t* gZ = p.Zz + (size_t)q * (RL * 64) + lane; const bf16_t* gY = p.YH + (size_t)q * (RL * 64) + lane;
        bf16_t* gO = p.O + (size_t)dir * TX * 512 + h * 64 + lane;
        float zz[SB], yy[SB];
#pragma unroll
        for (int i = 0; i < SB; ++i) { zz[i] = bf2f(gZ[i * 64]); yy[i] = bf2f(gY[i * 64]); }
        for (int sb = 0; sb < NSB; ++sb) {
            float yc[SB];
#pragma unroll
            for (int i = 0; i < SB; ++i) { L[i * 64 + lane] = zz[i]; yc[i] = yy[i]; }
            { const int nsb = sb + 1 < NSB ? sb + 1 : sb;
#pragma unroll
              for (int i = 0; i < SB; ++i) { zz[i] = bf2f(gZ[(nsb * SB + i) * 64]); yy[i] = bf2f(gY[(nsb * SB + i) * 64]); } }
#pragma unroll
            for (int i = 0; i < SB; ++i) {
                const float* Z = L + i * 64;
                f32x2 y0 = {yc[i], 0.f}, y1 = {0.f, 0.f};
#pragma unroll
                for (int k = 0; k < 32; k += 2) { const f32x4 z = *(const f32x4*)(Z + 2 * k); y0 += s[k] * z.lo; y1 += s[k + 1] * z.hi; }
                const int row = row_of(dir, j * RL + sb * SB + i);
                if (row >= 256) gO[(size_t)(row - 256) * 512] = f2bf((y0.x + y0.y) + (y1.x + y1.y));
            }
        }
    }
}

__device__ __forceinline__ void phase8(const Params& p, char* smem) {
    const int tid = tidx();
    bf16_t* LT = (bf16_t*)smem;
    constexpr int LTS = 136;
    for (int u = blockIdx.x; u < NCH * 4; u += gridDim.x) {
        const int c = u < 512 ? 2 + (u >> 2) : ((u - 512) >> 2), hh = u & 3;
        const int upart = c >= 2 ? 2 : 3;
        const float g0 = sigm(p.ret_decay_logit[hh]), g1 = sigm(p.ret_decay_logit[4 + hh]);
        const float l0 = log2f(g0), l1 = log2f(g1);
        const int n = tid >> 2, part = tid & 3, half = part >> 1, fb = (part & 1) * 16;
        const int t = c * 128 + n;
        const bool lat = c >= 2;
        float pos = 0.f;
        if (lat) { const int tl = t - 256; pos = (float)(half == 0 ? (tl >> 6) : (tl & 63)); }
        const bf16_t* pr = p.proj + (size_t)t * INC;
        float cs[16], sn[16];
#pragma unroll
        for (int f = 0; f < 16; ++f) {
            if (lat) { const float inv = exp2f(-(float)(fb + f) * (13.287712379549449f / 32.f)); sincosf(pos * inv, &sn[f], &cs[f]); }
            else { cs[f] = 1.f; sn[f] = 0.f; }
        }
        const size_t ch = (size_t)(c * 4 + hh);
        uint4 kq1a, kq1b, kq2a, kq2b, vv0[4], vv1[4];
        { const int cbk = 2304 + hh * 128 + half * 64 + fb;
          kq1a = *(const uint4*)(pr + cbk); kq1b = *(const uint4*)(pr + cbk + 8); kq2a = *(const uint4*)(pr + cbk + 32); kq2b = *(const uint4*)(pr + cbk + 40);
          const int cbv = 2816 + hh * 256 + part * 32;
#pragma unroll
          for (int q = 0; q < 4; ++q) { vv0[q] = *(const uint4*)(pr + cbv + q * 8); vv1[q] = *(const uint4*)(pr + cbv + 128 + q * 8); } }
        if (upart == 2) {
            const int cb = 1792 + hh * 128 + half * 64 + fb;
            uint4 v1a = *(const uint4*)(pr + cb), v1b = *(const uint4*)(pr + cb + 8), v2a = *(const uint4*)(pr + cb + 32), v2b = *(const uint4*)(pr + cb + 40);
            bf16_t x1[16], x2[16];
            *(uint4*)&x1[0] = v1a; *(uint4*)&x1[8] = v1b; *(uint4*)&x2[0] = v2a; *(uint4*)&x2[8] = v2b;
            float o1[16], o2[16];
#pragma unroll
            for (int f = 0; f < 16; ++f) { const float a = bf2f(x1[f]), b = bf2f(x2[f]); o1[f] = a * cs[f] - b * sn[f]; o2[f] = a * sn[f] + b * cs[f]; }
            const float xf = exp2f(l0 * (float)(n + 1)), xb = exp2f(l1 * (float)(128 - n));
            bf16_t* qd = p.Qr + (ch * 128 + n) * 128 + half * 64 + fb;
            bf16_t* ad = p.A3 + (ch * 128 + n) * 384 + 128 + half * 64 + fb;
#pragma unroll
            for (int f = 0; f < 16; f += 2) {
                *(unsigned*)(qd + f) = pack2(o1[f], o1[f + 1]); *(unsigned*)(qd + 32 + f) = pack2(o2[f], o2[f + 1]);
                *(unsigned*)(ad + f) = pack2(o1[f] * xf, o1[f + 1] * xf); *(unsigned*)(ad + 32 + f) = pack2(o2[f] * xf, o2[f + 1] * xf);
                *(unsigned*)(ad + 128 + f) = pack2(o1[f] * xb, o1[f + 1] * xb); *(unsigned*)(ad + 128 + 32 + f) = pack2(o2[f] * xb, o2[f + 1] * xb);
            }
        }
        if (upart != 1) {
            const uint4 v1a = kq1a, v1b = kq1b, v2a = kq2a, v2b = kq2b;
            bf16_t x1[16], x2[16];
            *(uint4*)&x1[0] = v1a; *(uint4*)&x1[8] = v1b; *(uint4*)&x2[0] = v2a; *(uint4*)&x2[8] = v2b;
            const float sc = 0.08838834764831845f;
            bf16_t* kd = p.Kr + (ch * 128 + n) * 128 + half * 64 + fb;
            __syncthreads();
#pragma unroll
            for (int f = 0; f < 16; ++f) {
                const float a = bf2f(x1[f]) * sc, b = bf2f(x2[f]) * sc;
                const float o1 = a * cs[f] - b * sn[f], o2 = a * sn[f] + b * cs[f];
                const bf16_t h1 = f2bf(o1), h2 = f2bf(o2);
                kd[f] = h1; kd[32 + f] = h2;
                LT[(half * 64 + fb + f) * LTS + n] = h1; LT[(half * 64 + fb + f + 32) * LTS + n] = h2;
            }
            __syncthreads();
            const int d = tid >> 2, ms = (tid & 3) * 32;
#pragma unroll
            for (int dir = 0; dir < 2; ++dir) {
                bf16_t* od = p.KTz + ((ch * 2 + dir) * 128 + d) * 128 + ms;
#pragma unroll
                for (int m = 0; m < 32; m += 2) {
                    const int mm = ms + m;
                    const float z0 = dir == 0 ? exp2f(l0 * (float)(127 - mm)) : exp2f(l1 * (float)mm);
                    const float z1 = dir == 0 ? exp2f(l0 * (float)(126 - mm)) : exp2f(l1 * (float)(mm + 1));
                    *(unsigned*)(od + m) = pack2(bf2f(LT[d * LTS + mm]) * z0, bf2f(LT[d * LTS + mm + 1]) * z1);
                }
            }
        }
#pragma unroll 1
        for (int eh = (upart != 0 ? 0 : 2); eh < 2; ++eh) {
            __syncthreads();
            const int cb = 2816 + hh * 256 + eh * 128 + part * 32;
            bf16_t xv[32];
#pragma unroll
            for (int q = 0; q < 4; ++q) *(uint4*)&xv[q * 8] = eh == 0 ? vv0[q] : vv1[q];
#pragma unroll
            for (int f = 0; f < 32; ++f) LT[(part * 32 + f) * LTS + n] = xv[f];
            __syncthreads();
            const int e = tid >> 2, ms = (tid & 3) * 32;
            bf16_t* od = p.B3 + (ch * 256 + eh * 128 + e) * 384 + ms;
#pragma unroll
            for (int m = 0; m < 32; m += 8) *(uint4*)(od + m) = *(const uint4*)(LT + e * LTS + ms + m);
        }
        __syncthreads();
    }
}

__device__ __forceinline__ void phase9(const Params& p, char* smem) {
    stream_gemm128(smem, 512 + 2080,
        [&](int u, const bf16_t*& A, const bf16_t*& B, int& lda, int& ldb, int& nk) {
            if (u < 512) { const size_t ch = (size_t)((2 + (u >> 2)) * 4 + (u & 3)); A = p.Qr + ch * 128 * 128; B = p.Kr + ch * 128 * 128; lda = 128; ldb = 128; nk = 2; }
            else { const int v = u - 512, mt = v & 1, dir = (v >> 1) & 1, chh = v >> 2; A = p.B3 + ((size_t)chh * 256 + mt * 128) * 384; B = p.KTz + ((size_t)chh * 2 + dir) * 128 * 128; lda = 384; ldb = 128; nk = 2; }
        },
        [&](int u, const f32x4 (&acc)[2][4], int r0, int c0) {
            if (u < 512) {
                const int hh = u & 3; const size_t ch = (size_t)((2 + (u >> 2)) * 4 + hh);
                const float l0 = log2f(sigm(p.ret_decay_logit[hh])), l1 = log2f(sigm(p.ret_decay_logit[4 + hh]));
                bf16_t* outp = p.A3 + ch * 128 * 384;
#pragma unroll
                for (int mi = 0; mi < 2; ++mi)
#pragma unroll
                    for (int ni = 0; ni < 4; ++ni) {
                        const int n = r0 + mi * 16, m0 = c0 + ni * 16;
                        float o[4];
#pragma unroll
                        for (int j = 0; j < 4; ++j) {
                            const int m = m0 + j;
                            float w = 0.f;
                            if (n >= m) w += exp2f(l0 * (float)(n - m));
                            if (m >= n) w += exp2f(l1 * (float)(m - n));
                            o[j] = acc[mi][ni][j] * w;
                        }
                        uint2 ov; ov.x = pack2(o[0], o[1]); ov.y = pack2(o[2], o[3]);
                        *(uint2*)(outp + (size_t)n * 384 + m0) = ov;
                    }
            } else {
                const int v = u - 512, mt = v & 1, dir = (v >> 1) & 1, chh = v >> 2;
                bf16_t* outp = p.KVT + (((size_t)chh * 2 + dir) * 256 + mt * 128) * 128;
#pragma unroll
                for (int mi = 0; mi < 2; ++mi)
#pragma unroll
                    for (int ni = 0; ni < 4; ++ni) { uint2 o; o.x = pack2(acc[mi][ni][0], acc[mi][ni][1]); o.y = pack2(acc[mi][ni][2], acc[mi][ni][3]);
                        *(uint2*)(outp + (size_t)(r0 + mi * 16) * 128 + c0 + ni * 16) = o; }
            }
        });
}

__device__ __forceinline__ void phase10(const Params& p, char* smem) {
    for (int idx = blockIdx.x * NT + tidx(); idx < 131072; idx += gridDim.x * NT) {
        const int hh = idx >> 15, dir = (idx >> 14) & 1, e = (idx >> 6) & 255, d = (idx & 63) * 2;
        const float g = sigm(p.ret_decay_logit[dir * 4 + hh]);
        const float g128 = exp2f(128.f * log2f(g));
        float R0 = 0.f, R1 = 0.f;
        const bf16_t* kvb = p.KVT + ((size_t)(hh * 2 + dir) * 256 + e) * 128 + d;
        bf16_t* rtb = p.B3 + ((size_t)hh * 256 + e) * 384 + 128 + dir * 128 + d;
        for (int s0 = 0; s0 < NCH; s0 += 13) {
            unsigned kv[13];
#pragma unroll
            for (int i = 0; i < 13; ++i) { const int sc = s0 + i, c = dir == 0 ? sc : (sc < 2 ? 1 - sc : 131 - sc); kv[i] = *(const unsigned*)(kvb + (size_t)c * 262144); }
#pragma unroll
            for (int i = 0; i < 13; ++i) {
                const int sc = s0 + i, c = dir == 0 ? sc : (sc < 2 ? 1 - sc : 131 - sc);
                if (c >= 2) *(unsigned*)(rtb + (size_t)c * 393216) = pack2(R0, R1);
                R0 = g128 * R0 + __uint_as_float(kv[i] << 16); R1 = g128 * R1 + __uint_as_float(kv[i] & 0xffff0000u);
            }
        }
    }
}

__device__ __forceinline__ void phase11(const Params& p, char* smem) {
    stream_gemm128(smem, 1024,
        [&](int u, const bf16_t*& A, const bf16_t*& B, int& lda, int& ldb, int& nk) {
            const int nt = u & 1, chh = 8 + (u >> 1);
            A = p.A3 + (size_t)chh * 128 * 384; B = p.B3 + ((size_t)chh * 256 + nt * 128) * 384; lda = 384; ldb = 384; nk = 6;
        },
        [&](int u, const f32x4 (&acc)[2][4], int r0, int c0) {
            const int nt = u & 1, chh = 8 + (u >> 1), c = chh >> 2, hh = chh & 3;
            float* outp = p.Y + (size_t)((c - 2) * 128) * 1024 + hh * 256 + nt * 128;
#pragma unroll
            for (int mi = 0; mi < 2; ++mi)
#pragma unroll
                for (int ni = 0; ni < 4; ++ni) *(f32x4*)(outp + (size_t)(r0 + mi * 16) * 1024 + c0 + ni * 16) = acc[mi][ni];
        });
}

__device__ __forceinline__ void phase12(const Params& p, char* smem) {
    const int tid = tidx(), wave = tid >> 6, lane = tid & 63;
    const int gw = blockIdx.x * 8 + wave, nw = gridDim.x * 8;
    float lw[8], lb[8], rk[8];
#pragma unroll
    for (int q = 0; q < 8; ++q) { lw[q] = p.rwkv_ln_w[lane * 8 + q]; lb[q] = p.rwkv_ln_b[lane * 8 + q]; rk[q] = p.rwkv_r_k[lane * 8 + q]; }
    for (int t = gw; t < TX; t += nw) {
        const size_t te = (size_t)(t + 256) * 512 + lane * 8;
        const uint4 uof = *(const uint4*)(p.O + (size_t)t * 512 + lane * 8), uob = *(const uint4*)(p.O + ((size_t)TX + t) * 512 + lane * 8);
        const uint4 ur = *(const uint4*)(p.Rr + te), uk0 = *(const uint4*)(p.KD + te), uk1 = *(const uint4*)(p.KD + (size_t)TE * 512 + te), uv = *(const uint4*)(p.Vv + te), ug = *(const uint4*)(p.G + te);
        const float* yp = p.Y + (size_t)t * 1024 + lane * 16;
        const float4 y0 = *(const float4*)(yp), y1 = *(const float4*)(yp + 4), y2 = *(const float4*)(yp + 8), y3 = *(const float4*)(yp + 12);
        const bf16_t* gbp = p.proj + (size_t)(t + 256) * INC + 3840 + lane * 16;
        const uint4 ugb0 = *(const uint4*)(gbp), ugb1 = *(const uint4*)(gbp + 8);
        {
            float of[8], ob[8], r[8], k0[8], k1[8], v[8], gg[8], o[8];
            unpack8(uof, of); unpack8(uob, ob); unpack8(ur, r); unpack8(uk0, k0); unpack8(uk1, k1); unpack8(uv, v); unpack8(ug, gg);
            float sm = 0.f, bs = 0.f;
#pragma unroll
            for (int q = 0; q < 8; ++q) { o[q] = of[q] + ob[q]; sm += o[q]; bs += r[q] * (k0[q] + k1[q]) * rk[q]; }
            sm = sum8(sm); bs = sum8(bs);
            const float mu = sm * (1.f / 64.f);
            float vs = 0.f;
#pragma unroll
            for (int q = 0; q < 8; ++q) { o[q] -= mu; vs += o[q] * o[q]; }
            vs = sum8(vs);
            const float rs = rsqrtf(vs * (1.f / 64.f) + 64e-5f);
            float ya[8];
#pragma unroll
            for (int q = 0; q < 8; ++q) ya[q] = (o[q] * rs * lw[q] + lb[q] + bs * v[q]) * gg[q];
            *(uint4*)(p.ya_in + (size_t)t * 512 + lane * 8) = pack8(ya);
        }
        {
            float y[16] = {y0.x, y0.y, y0.z, y0.w, y1.x, y1.y, y1.z, y1.w, y2.x, y2.y, y2.z, y2.w, y3.x, y3.y, y3.z, y3.w};
            float sm = 0.f;
#pragma unroll
            for (int q = 0; q < 16; ++q) sm += y[q];
            sm = sum16(sm);
            const float mu = sm * (1.f / 256.f);
            float vs = 0.f;
#pragma unroll
            for (int q = 0; q < 16; ++q) { y[q] -= mu; vs += y[q] * y[q]; }
            vs = sum16(vs);
            const float rs = rsqrtf(vs * (1.f / 256.f) + 1e-5f);
            float gb[16]; { float t0[8], t1[8]; unpack8(ugb0, t0); unpack8(ugb1, t1);
#pragma unroll
                for (int q = 0; q < 8; ++q) { gb[q] = t0[q]; gb[8 + q] = t1[q]; } }
            float o0[8], o1[8];
#pragma unroll
            for (int q = 0; q < 16; ++q) {
                const int c = lane * 16 + q;
                const float ov = (y[q] * rs * p.ret_ln_w[c] + p.ret_ln_b[c]) * (gb[q] * sigm(gb[q]));
                if (q < 8) o0[q] = ov; else o1[q - 8] = ov;
            }
            bf16_t* d = p.yb_in + (size_t)t * 1024 + lane * 16;
            *(uint4*)d = pack8(o0); *(uint4*)(d + 8) = pack8(o1);
        }
    }
}

__device__ __forceinline__ void phase13(const Params& p, char* smem) {
    for (int u = blockIdx.x; u < 512; u += gridDim.x) {
        const int mt = u >> 2, nt = u & 3;
        f32x4 acca[4][4], accb[4][4];
#pragma unroll
        for (int mi = 0; mi < 4; ++mi)
#pragma unroll
            for (int ni = 0; ni < 4; ++ni) { acca[mi][ni] = (f32x4){0.f, 0.f, 0.f, 0.f}; accb[mi][ni] = (f32x4){0.f, 0.f, 0.f, 0.f}; }
        { APlain ap{p.ya_in + (size_t)mt * 128 * 512, 512}; BPlain bp{p.WaT + (size_t)nt * 256 * 512, 512};
          gemm_core<128, 256, 2, 4>(acca, ap, bp, 512, smem); }
        { APlain ap{p.yb_in + (size_t)mt * 128 * 1024, 1024}; BPlain bp{p.WbT + (size_t)nt * 256 * 1024, 1024};
          gemm_core<128, 256, 2, 4>(accb, ap, bp, 1024, smem); }
        const int wave = tidx() >> 6, lane = tidx() & 63;
        const int r0 = (wave >> 2) * 64 + (lane & 15), c0 = (wave & 3) * 64 + (lane >> 4) * 4;
#pragma unroll
        for (int mi = 0; mi < 4; ++mi)
#pragma unroll
            for (int ni = 0; ni < 4; ++ni) {
                const int t = mt * 128 + r0 + mi * 16, c = nt * 256 + c0 + ni * 16;
                const bf16_t* gp = p.proj + (size_t)(t + 256) * INC + c;
                const uint2 ga = *(const uint2*)(gp + 4864), gb = *(const uint2*)(gp + 5888);
                float o[4];
                o[0] = sigm(__uint_as_float(ga.x << 16)) * acca[mi][ni][0] + sigm(__uint_as_float(gb.x << 16)) * accb[mi][ni][0];
                o[1] = sigm(__uint_as_float(ga.x & 0xffff0000u)) * acca[mi][ni][1] + sigm(__uint_as_float(gb.x & 0xffff0000u)) * accb[mi][ni][1];
                o[2] = sigm(__uint_as_float(ga.y << 16)) * acca[mi][ni][2] + sigm(__uint_as_float(gb.y << 16)) * accb[mi][ni][2];
                o[3] = sigm(__uint_as_float(ga.y & 0xffff0000u)) * acca[mi][ni][3] + sigm(__uint_as_float(gb.y & 0xffff0000u)) * accb[mi][ni][3];
                uint2 ov; ov.x = pack2(o[0], o[1]); ov.y = pack2(o[2], o[3]);
                *(uint2*)(p.merged + (size_t)t * 1024 + c) = ov;
            }
    }
}
__device__ __forceinline__ void phase14(const Params& p, char* smem) {
    g8::StaticOrder S; S.init(TX, 1024, gridDim.x, blockIdx.x);
    g8::EpiBf16 E{p.mix, 1024};
    g8::gemm_phase((LAS unsigned char*)smem, p.merged, p.WoT, 1024, 1024, 1024, S, E);
}

__device__ __forceinline__ void phase15(const Params& p, char* smem) {
    const int tid = tidx(), wave = tid >> 6, lane = tid & 63;
    const int gw = blockIdx.x * 8 + wave, nw = gridDim.x * 8;
    const float* g1 = p.mod + 2048; const float* sh2 = p.mod + 3072; const float* sc2 = p.mod + 4096;
    for (int t = gw; t < TX; t += nw) {
        float4 mv[4], xm[4]; float ss = 0.f;
#pragma unroll
        for (int i = 0; i < 4; ++i) { const uint2 mb = *(const uint2*)(p.mix + (size_t)t * 1024 + i * 256 + lane * 4);
            mv[i] = make_float4(__uint_as_float(mb.x << 16), __uint_as_float(mb.x & 0xffff0000u), __uint_as_float(mb.y << 16), __uint_as_float(mb.y & 0xffff0000u));
            ss += mv[i].x * mv[i].x + mv[i].y * mv[i].y + mv[i].z * mv[i].z + mv[i].w * mv[i].w; }
        ss = wsum(ss);
        const float rs = rsqrtf(ss * (1.f / 1024.f) + 1e-6f);
        float s2 = 0.f;
#pragma unroll
        for (int i = 0; i < 4; ++i) {
            const int col = i * 256 + lane * 4;
            const float4 xv = *(const float4*)(p.x + (size_t)t * 1024 + col);
            const float4 gn = *(const float4*)(p.n_post_mix + col), gg = *(const float4*)(g1 + col);
            xm[i].x = xv.x + gg.x * (mv[i].x * rs * gn.x); xm[i].y = xv.y + gg.y * (mv[i].y * rs * gn.y);
            xm[i].z = xv.z + gg.z * (mv[i].z * rs * gn.z); xm[i].w = xv.w + gg.w * (mv[i].w * rs * gn.w);
            *(float4*)(p.x_mid + (size_t)t * 1024 + col) = xm[i];
            s2 += xm[i].x * xm[i].x + xm[i].y * xm[i].y + xm[i].z * xm[i].z + xm[i].w * xm[i].w;
        }
        s2 = wsum(s2);
        const float rs2 = rsqrtf(s2 * (1.f / 1024.f) + 1e-6f);
#pragma unroll
        for (int i = 0; i < 4; ++i) {
            const int col = i * 256 + lane * 4;
            const float4 gn = *(const float4*)(p.n_pre_ffn + col), sc = *(const float4*)(sc2 + col), sh = *(const float4*)(sh2 + col);
            float h[4];
            h[0] = xm[i].x * rs2 * gn.x * (1.f + sc.x) + sh.x; h[1] = xm[i].y * rs2 * gn.y * (1.f + sc.y) + sh.y;
            h[2] = xm[i].z * rs2 * gn.z * (1.f + sc.z) + sh.z; h[3] = xm[i].w * rs2 * gn.w * (1.f + sc.w) + sh.w;
            uint2 hi; hi.x = pack2(h[0], h[1]); hi.y = pack2(h[2], h[3]);
            *(uint2*)(p.Ahl + (size_t)t * 1024 + col) = hi;
        }
    }
}

__device__ __forceinline__ void phase16(const Params& p, char* smem) {
    for (int u = blockIdx.x; u < 256; u += gridDim.x) {
        const int mt = u >> 1, nt = u & 1;
        APlain ap{p.Ahl + (size_t)mt * 128 * 1024, 1024}; BPlain bp{p.RtT + (size_t)nt * 128 * 1024, 1024};
        float* outp = p.logits + (size_t)mt * 128 * 256 + nt * 128;
        gemm_tile<128, 128, 4, 2>(ap, bp, 1024, smem, [&](const auto& acc, int r0, int c0) {
#pragma unroll
            for (int mi = 0; mi < 2; ++mi)
#pragma unroll
                for (int ni = 0; ni < 4; ++ni) *(f32x4*)(outp + (size_t)(r0 + mi * 16) * 256 + c0 + ni * 16) = acc[mi][ni];
        });
    }
}

__device__ __forceinline__ void phase17(const Params& p, char* smem) {
    const int tid = tidx(), wave = tid >> 6, lane = tid & 63;
    int* hist = (int*)smem;
    if (tid < 256) hist[tid] = 0;
    __syncthreads();
    const int TPB = TX / gridDim.x;
    for (int ti = wave; ti < TPB; ti += 8) {
        const int t = blockIdx.x * TPB + ti;
        float sc[4]; unsigned key[4];
#pragma unroll
        for (int i = 0; i < 4; ++i) {
            const int e = lane + 64 * i; sc[i] = sigm(p.logits[(size_t)t * 256 + e]);
            const unsigned b = __float_as_uint(sc[i] + p.router_bias[e]);
            const unsigned o = b ^ ((b >> 31) ? 0xffffffffu : 0x80000000u);
            key[i] = (o & 0xffffff00u) | (unsigned)(255 - e);
        }
        float mys = 0.f, ssum = 0.f; int mye = 0;
#pragma unroll
        for (int k = 0; k < 8; ++k) {
            const unsigned best = wave_umax(max(max(key[0], key[1]), max(key[2], key[3])));
            const int e = 255 - (int)(best & 255u), slot = e >> 6, owner = e & 63;
            const float sel = slot == 0 ? sc[0] : (slot == 1 ? sc[1] : (slot == 2 ? sc[2] : sc[3]));
            const float sv = __int_as_float(__builtin_amdgcn_readlane(__float_as_int(sel), owner));
            if (lane == owner) {
#pragma unroll
                for (int i = 0; i < 4; ++i) if (slot == i) key[i] = 0u;
            }
            ssum += sv;
            if (lane == k) { mys = sv; mye = e; }
        }
        if (lane < 8) {
            const int pos = atomicAdd(&hist[mye], 1);
            p.tok_e[t * 8 + lane] = mye; p.tok_pos[t * 8 + lane] = pos; p.tok_w[t * 8 + lane] = mys / ssum * 2.5f;
        }
    }
    __syncthreads();
    if (tid < 256) p.bh[blockIdx.x * 256 + tid] = hist[tid];
}

__device__ __forceinline__ void phase18(const Params& p, char* smem) {
    const int tid = tidx();
    int* ps = (int*)smem;
    int* xs = ps + 260;
    int* cntL = xs + 260;
    int* baseL = cntL + 256;
    int* part = baseL + 256;
    {
        const int e = tid & 255, half = tid >> 8, G = gridDim.x, b0 = half * (G >> 1), b1 = b0 + (G >> 1);
        int tot = 0, bef = 0;
        for (int bb = b0; bb < b1; bb += 16) {
            int v[16];
#pragma unroll
            for (int i = 0; i < 16; ++i) v[i] = p.bh[(bb + i) * 256 + e];
#pragma unroll
            for (int i = 0; i < 16; ++i) { tot += v[i]; bef += (bb + i < (int)blockIdx.x) ? v[i] : 0; }
        }
        part[half * 256 + e] = tot; part[512 + half * 256 + e] = bef;
    }
    __syncthreads();
    if (tid < 256) { cntL[tid] = part[tid] + part[256 + tid]; baseL[tid] = part[512 + tid] + part[768 + tid]; }
    __syncthreads();
    if (tid < 64) {
        int c[4], tot = 0, ttot = 0;
#pragma unroll
        for (int q = 0; q < 4; ++q) { c[q] = cntL[tid * 4 + q]; tot += c[q]; ttot += (c[q] + 255) >> 8; }
        int incl = tot, tincl = ttot;
#pragma unroll
        for (int o = 1; o < 64; o <<= 1) { const int v = __shfl_up(incl, o, 64), tv = __shfl_up(tincl, o, 64); if (tid >= o) { incl += v; tincl += tv; } }
        int ex = incl - tot, tex = tincl - ttot;
#pragma unroll
        for (int q = 0; q < 4; ++q) { ps[tid * 4 + q] = ex; xs[tid * 4 + q] = tex; ex += c[q]; tex += (c[q] + 255) >> 8; }
        if (tid == 63) { ps[256] = incl; xs[256] = tincl; }
    }
    __syncthreads();
    if (blockIdx.x == 0) {
        const int nx = xs[256];
        if (tid == 0) *p.ntiles = nx + 64;
        for (int e = tid; e < 256; e += NT) {
            const int c = ps[e + 1] - ps[e];
            for (int t = 0; t < ((c + 255) >> 8); ++t) { int* x = p.xt + (xs[e] + t) * 4; x[0] = e; x[1] = ps[e] + 256 * t; x[2] = min(256, c - 256 * t); x[3] = 0; }
        }
        if (tid < 64) { int* x = p.xt + (nx + tid) * 4; x[0] = 256; x[1] = 131072 + 256 * tid; x[2] = 256; x[3] = 0; }
        if (tid < 256) p.slot_tk[NSLOT + tid] = 0;
    }
    const int TPB = TX / gridDim.x;
    for (int li = tid; li < TPB * 8; li += NT) {
        const int i = blockIdx.x * TPB * 8 + li, e = p.tok_e[i];
        p.slot_tk[ps[e] + baseL[e] + p.tok_pos[i]] = (i >> 3) * 9 + (i & 7);
    }
    for (int t = blockIdx.x * NT + tid; t < TX; t += gridDim.x * NT) p.slot_tk[131072 + t] = t * 9 + 8;
}

__device__ __forceinline__ void phase19(const Params& p, char* smem) {
    const int nun = *p.ntiles * 2;
    const int lb = (blockIdx.x & 7) * (gridDim.x >> 3) + (blockIdx.x >> 3);
    g8::EpiGU E{p.act};
    g8::gemm_phase_xg((LAS unsigned char*)smem, p.Ahl, p.slot_tk, p.xt, p.BtW, nun, lb, (int)gridDim.x, E);
}

__device__ __forceinline__ void phase20(const Params& p, char* smem) {
    constexpr int BM = 256, BN = 256, WGN = 4, TM = 128, TN = 64, MI = 8, NI = 4;
    constexpr int ABYTES = BM * TSTR, STAGE = (BM + BN) * TSTR, AL = 4, KPT = 8, NQ = 64;
    using BP = BKN; const BKN bp{nullptr, 1024};
    constexpr int BL = 4; uint4 rb0 = {}, rb1 = {}, rb2 = {}, rb3 = {}; const char* bbase = nullptr; const unsigned boff0 = 0, boff1 = 0, boff2 = 0, boff3 = 0;
    const int nun = *p.ntiles * 4, G = gridDim.x;
    const int lb = (blockIdx.x & 7) * (G >> 3) + (blockIdx.x >> 3);
    if (lb >= nun) return;
    const int nsteps = ((nun - lb + G - 1) / G) * 4;
    const int tid = tidx(), wave = tid >> 6, lane = tid & 63, fr = lane & 15, fq = lane >> 4;
    const int wm = wave / WGN, wn = wave % WGN;
    const int lrow = tid >> 3, lseg = tid & 7;
    const unsigned aoff0 = (unsigned)(lrow * 512) + lseg * 16, aoff1 = aoff0 + 64 * 512, aoff2 = aoff0 + 128 * 512, aoff3 = aoff0 + 192 * 512;
    const int kq = tid / NQ, n4 = tid % NQ; const long bld = 1024;
    uint4 ra0, ra1, ra2, ra3; float4 rf0, rf1, rf2, rf3, rf4, rf5, rf6, rf7;
    const char* abase = nullptr; const float* bfp = nullptr;
#define P20_UNIT(R) do { const int* x_ = p.xt + ((lb + (R) * G) >> 2) * 4; const int nt_ = (lb + (R) * G) & 3; const int e_ = x_[0]; \
        abase = (const char*)(p.act + (size_t)x_[1] * 256); \
        bfp = (e_ < 256 ? p.exp_w_down + (size_t)e_ * 262144 : p.sh_w_down) + nt_ * 256 + n4 * 4 + (long)(kq * KPT) * bld; } while (0)
    f32x4 acc[MI][NI];
#pragma unroll
    for (int mi = 0; mi < MI; ++mi)
#pragma unroll
        for (int ni = 0; ni < NI; ++ni) acc[mi][ni] = (f32x4){0.f, 0.f, 0.f, 0.f};
    P20_UNIT(0); GC_GLOAD(0); GC_LSTORE(0); __syncthreads();
    for (int s = 0; s < nsteps; ++s) {
        if (s + 1 < nsteps) { if (((s + 1) & 3) == 0) P20_UNIT((s + 1) >> 2); GC_GLOAD((s + 1) & 3); }
        const char* As = smem + (s & 1) * STAGE; const char* Bs = As + ABYTES;
#pragma unroll
        for (int ks = 0; ks < 2; ++ks) {
            bf16x8 af[MI], bfr[NI];
#pragma unroll
            for (int mi = 0; mi < MI; ++mi) af[mi] = *(const bf16x8*)(As + (wm * TM + mi * 16 + fr) * TSTR + ks * 64 + fq * 16);
#pragma unroll
            for (int ni = 0; ni < NI; ++ni) bfr[ni] = *(const bf16x8*)(Bs + (wn * TN + ni * 16 + fr) * TSTR + ks * 64 + fq * 16);
#pragma unroll
            for (int mi = 0; mi < MI; ++mi)
#pragma unroll
                for (int ni = 0; ni < NI; ++ni) acc[mi][ni] = __builtin_amdgcn_mfma_f32_16x16x32_bf16(bfr[ni], af[mi], acc[mi][ni], 0, 0, 0);
            __builtin_amdgcn_sched_barrier(0);
        }
        if ((s & 3) == 3) {
            const int u = lb + (s >> 2) * G; const int* x = p.xt + (u >> 2) * 4; const int nt = u & 3;
            const int row0 = x[1], nrows = x[2];
            const int* stk = p.slot_tk + row0;
            const int r0 = wm * TM + fr, c0 = wn * TN + fq * 4;
#pragma unroll
            for (int mi = 0; mi < MI; ++mi) {
                const int r = r0 + mi * 16;
                if (r < nrows) {
                    bf16_t* d = p.yk + (size_t)stk[r] * 1024 + nt * 256 + c0;
#pragma unroll
                    for (int ni = 0; ni < NI; ++ni) {
                        uint2 ov; ov.x = pack2(acc[mi][ni][0], acc[mi][ni][1]); ov.y = pack2(acc[mi][ni][2], acc[mi][ni][3]);
                        *(uint2*)(d + ni * 16) = ov;
                    }
                }
#pragma unroll
                for (int ni = 0; ni < NI; ++ni) acc[mi][ni] = (f32x4){0.f, 0.f, 0.f, 0.f};
            }
        }
        if (s + 1 < nsteps) GC_LSTORE((s + 1) & 1);
        __syncthreads();
    }
#undef P20_UNIT
}

__device__ __forceinline__ void phase21(const Params& p, char* smem) {
    const int tid = tidx(), wave = tid >> 6, lane = tid & 63;
    const int gw = blockIdx.x * 8 + wave, nw = gridDim.x * 8;
    const float* g2 = p.mod + 5120;
    for (int t = gw; t < TX; t += nw) {
        float w[9];
#pragma unroll
        for (int k = 0; k < 8; ++k) w[k] = p.tok_w[t * 8 + k];
        w[8] = 1.f;
        float4 mo[4]; float ss = 0.f;
#pragma unroll
        for (int i = 0; i < 4; ++i) {
            const int col = i * 256 + lane * 4;
            float a0 = 0.f, a1 = 0.f, a2 = 0.f, a3 = 0.f;
#pragma unroll
            for (int k = 0; k < 9; ++k) {
                const uint2 v = *(const uint2*)(p.yk + ((size_t)t * 9 + k) * 1024 + col);
                a0 += w[k] * __uint_as_float(v.x << 16); a1 += w[k] * __uint_as_float(v.x & 0xffff0000u); a2 += w[k] * __uint_as_float(v.y << 16); a3 += w[k] * __uint_as_float(v.y & 0xffff0000u);
            }
            mo[i] = make_float4(a0, a1, a2, a3);
            ss += a0 * a0 + a1 * a1 + a2 * a2 + a3 * a3;
        }
        ss = wsum(ss);
        const float rs = rsqrtf(ss * (1.f / 1024.f) + 1e-6f);
#pragma unroll
        for (int i = 0; i < 4; ++i) {
            const int col = i * 256 + lane * 4;
            const float4 xm = *(const float4*)(p.x_mid + (size_t)t * 1024 + col);
            const float4 gn = *(const float4*)(p.n_post_ffn + col), gg = *(const float4*)(g2 + col);
            float4 o;
            o.x = xm.x + gg.x * (mo[i].x * rs * gn.x); o.y = xm.y + gg.y * (mo[i].y * rs * gn.y);
            o.z = xm.z + gg.z * (mo[i].z * rs * gn.z); o.w = xm.w + gg.w * (mo[i].w * rs * gn.w);
            *(float4*)(p.out + (size_t)t * 1024 + col) = o;
        }
    }
}

__device__ __forceinline__ void phase7_8(const Params& p, char* smem) { phase7(p, smem); __syncthreads(); phase8(p, smem); }
constexpr int NPHASE = 21;
template <int PH> __device__ __forceinline__ void run_phase(const Params& p, char* smem) {
    if constexpr (PH == 0) phase0(p, smem);
    else if constexpr (PH == 1) phase1(p, smem);
    else if constexpr (PH == 2) phase2(p, smem);
    else if constexpr (PH == 3) phase3(p, smem);
    else if constexpr (PH == 4) phase4(p, smem);
    else if constexpr (PH == 5) phase5(p, smem);
    else if constexpr (PH == 6) phase6(p, smem);
    else if constexpr (PH == 7) phase7_8(p, smem);
    else if constexpr (PH == 8) phase9(p, smem);
    else if constexpr (PH == 9) phase10(p, smem);
    else if constexpr (PH == 10) phase11(p, smem);
    else if constexpr (PH == 11) phase12(p, smem);
    else if constexpr (PH == 12) phase13(p, smem);
    else if constexpr (PH == 13) phase14(p, smem);
    else if constexpr (PH == 14) phase15(p, smem);
    else if constexpr (PH == 15) phase16(p, smem);
    else if constexpr (PH == 16) phase17(p, smem);
    else if constexpr (PH == 17) phase18(p, smem);
    else if constexpr (PH == 18) phase19(p, smem);
    else if constexpr (PH == 19) phase20(p, smem);
    else phase21(p, smem);
}

template <int PH> __global__ void __launch_bounds__(NT, 2) k_phase(Params p) {
    extern __shared__ __attribute__((aligned(16))) char smem[];
    run_phase<PH>(p, smem);
}

template <int PH> __device__ __forceinline__ void mega_run(const Params& p, char* smem, const XcdBarrier& bar) {
    run_phase<PH>(p, smem);
    if constexpr (((PROBE_MASK) >> PH) & 1u) { xcd_barrier(bar); run_phase<PH>(p, smem); }
    if constexpr (PH + 1 < NPHASE) { xcd_barrier(bar); mega_run<PH + 1>(p, smem, bar); }
}
__global__ void __launch_bounds__(NT, 2) k_mega(Params p) {
    extern __shared__ __attribute__((aligned(16))) char smem[];
    uint4* xbw = (uint4*)(smem + 8 * TILE_BYTES);
    if (tidx() == 0) *xbw = make_uint4(0u, 0u, 0u, 0u);
    __syncthreads();
    XcdBarrier bar = xcd_barrier_post(p.bar, (volatile LAS unsigned*)xbw);
    mega_run<0>(p, smem, bar);
}

template <int PH> static void launch_phases(const Params& p, int grid, hipStream_t stream) {
    static bool attr = false;
    if (!attr) { (void)hipFuncSetAttribute((const void*)k_phase<PH>, hipFuncAttributeMaxDynamicSharedMemorySize, LDS_BYTES); attr = true; }
    hipLaunchKernelGGL(k_phase<PH>, dim3(grid), dim3(NT), LDS_BYTES, stream, p);
    if constexpr (PH + 1 < NPHASE) launch_phases<PH + 1>(p, grid, stream);
}

extern "C" void kernel_launch(void* const* d_in, const int* in_sizes, int n_in, void* d_out, int out_size, void* d_ws, size_t ws_size, hipStream_t stream) {
    static int grid = 0;
    if (grid == 0) {
        int dev = 0, cus = 0, per_cu = 0;
        (void)hipGetDevice(&dev); (void)hipDeviceGetAttribute(&cus, hipDeviceAttributeMultiprocessorCount, dev);
        (void)hipFuncSetAttribute((const void*)k_mega, hipFuncAttributeMaxDynamicSharedMemorySize, LDS_BYTES);
        (void)hipOccupancyMaxActiveBlocksPerMultiprocessor(&per_cu, (const void*)k_mega, NT, LDS_BYTES);
        (void)hipGetLastError();
        if (cus <= 0) cus = 256;
        grid = cus;
    }
    Params p{};
    const float** pin = (const float**)&p.x;
    for (int i = 0; i < 36; ++i) pin[i] = (const float*)d_in[i];
    p.out = (float*)d_out;
    char* ws = (char*)d_ws; size_t off = 0;
    auto alloc = [&](size_t bytes) { size_t o = off; off += (bytes + 255) & ~(size_t)255; return ws + o; };
    p.bar = (unsigned*)alloc(XCD_BAR_WORDS * 4); p.cnt = (int*)alloc(256 * 4);
    const size_t zero_bytes = off;
    p.slot_tk = (int*)alloc((size_t)(NSLOT + 256) * 4); p.bh = (int*)alloc(1024 * 256 * 4);
    p.xt = (int*)alloc(NXT_MAX * 16); p.ntiles = (int*)alloc(256);
    p.tok_e = (int*)alloc((size_t)TX * 8 * 4); p.tok_pos = (int*)alloc((size_t)TX * 8 * 4); p.tok_w = (float*)alloc((size_t)TX * 8 * 4);
    p.modp = (float*)alloc(16 * 2 * 6144 * 4); p.mod = (float*)alloc(2 * 6144 * 4);
    p.WinT = (bf16_t*)alloc((size_t)INC * 1024 * 2); p.WaT = (bf16_t*)alloc(1024 * 512 * 2); p.WbT = (bf16_t*)alloc(1024 * 1024 * 2); p.WoT = (bf16_t*)alloc(1024 * 1024 * 2);
    p.RtT = (bf16_t*)alloc(256 * 3072 * 2); p.ShGU = (bf16_t*)alloc(512 * 1024 * 2); p.ShD = (bf16_t*)alloc(1024 * 256 * 2);
    p.WupT = (bf16_t*)alloc(1024 * 64 * 2); p.AupT = (bf16_t*)alloc(1024 * 64 * 2); p.GupT = (bf16_t*)alloc(512 * 128 * 2);
    p.ya_in = (bf16_t*)alloc((size_t)TX * 512 * 2); p.yb_in = (bf16_t*)alloc((size_t)TX * 1024 * 2);
    p.BtW = (bf16_t*)alloc((size_t)257 * 512 * 1024 * 2);
    char* RA = alloc((size_t)TE * INC * 2);
    p.proj = (bf16_t*)RA;
    { size_t o = 0; auto sub = [&](size_t b) { char* r = RA + o; o += (b + 255) & ~(size_t)255; return r; };
      p.act = (bf16_t*)sub(((size_t)NSLOT + 256) * 256 * 2); p.logits = (float*)sub((size_t)TX * 256 * 4); }
    const size_t surv = (size_t)TE * 512 * 2 * 5 + (size_t)2 * TX * 512 * 2 + 4096;
    const size_t rtmp = 424935424 - 68157440 + 65536;
    char* RB = alloc(surv + rtmp);
    { size_t o = 0; auto sub = [&](size_t b) { char* r = RB + o; o += (b + 255) & ~(size_t)255; return r; };
      p.Rr = (bf16_t*)sub((size_t)TE * 512 * 2); p.Vv = (bf16_t*)sub((size_t)TE * 512 * 2); p.KD = (bf16_t*)sub((size_t)2 * TE * 512 * 2); p.G = (bf16_t*)sub((size_t)TE * 512 * 2);
      p.O = (bf16_t*)sub((size_t)2 * TX * 512 * 2);
      const size_t o_t = o;
      p.Kk = (bf16_t*)sub((size_t)TE * 512 * 2); p.Aa = (bf16_t*)sub((size_t)TE * 512 * 2); p.Bd = (bf16_t*)sub((size_t)2 * TE * 512 * 2);
      p.Wd = (float*)sub((size_t)2 * TE * 512 * 4); p.TW = (bf16_t*)sub((size_t)TE * 64 * 2); p.XA = (bf16_t*)sub((size_t)TE * 64 * 2); p.SG = (bf16_t*)sub((size_t)TE * 128 * 2);
      p.PH = (float*)sub((size_t)127 * 16 * 2 * 4096 * 4);
      { const size_t prep_end = o_t + (size_t)NCH * 4 * 128 * 128 * 2 * 2 + (size_t)NCH * 4 * 2 * 128 * 128 * 2 + (size_t)NCH * 4 * 128 * 384 * 2 + (size_t)NCH * 4 * 256 * 384 * 2 + 4096;
        if (o < prep_end) o = (prep_end + 255) & ~(size_t)255; }
      p.Sst = (float*)sub((size_t)128 * 16 * 4096 * 4);
      p.Zz = (bf16_t*)sub((size_t)RNC * 16 * RL * 64 * 2); p.YH = (bf16_t*)sub((size_t)RNC * 16 * RL * 64 * 2);
      p.hn = (bf16_t*)p.PH;
      o = o_t;
      p.Qr = (bf16_t*)sub((size_t)NCH * 4 * 128 * 128 * 2); p.Kr = (bf16_t*)sub((size_t)NCH * 4 * 128 * 128 * 2); p.KTz = (bf16_t*)sub((size_t)NCH * 4 * 2 * 128 * 128 * 2);
      p.A3 = (bf16_t*)sub((size_t)NCH * 4 * 128 * 384 * 2); p.B3 = (bf16_t*)sub((size_t)NCH * 4 * 256 * 384 * 2);
      p.KVT = (bf16_t*)sub((size_t)NCH * 4 * 2 * 256 * 128 * 2); p.Y = (float*)sub((size_t)TX * 1024 * 4);
      o = 0;
      p.x_mid = (float*)sub((size_t)TX * 1024 * 4); p.Ahl = (bf16_t*)sub((size_t)TX * 1024 * 2);
      p.yk = (bf16_t*)sub((size_t)TX * 9 * 1024 * 2);
      char* yk0 = (char*)p.yk; p.mergedA = (float*)yk0; p.merged = (bf16_t*)(yk0 + (size_t)TX * 1024 * 4); p.mix = (bf16_t*)(yk0 + (size_t)TX * 1024 * 6);
    }
    if (off > ws_size) { fprintf(stderr, "kernel_launch: workspace too small: need %zu have %zu\n", off, ws_size); return; }
    int j = 0;
    p.jobs[j++] = TJob{p.w_in, p.WinT, 1024, INC, 1024, 0, 0, 0};
    p.jobs[j++] = TJob{p.w_branch_a, p.WaT, 512, 1024, 512, 0, 0, 0};
    p.jobs[j++] = TJob{p.w_branch_b, p.WbT, 1024, 1024, 1024, 0, 0, 0};
    p.jobs[j++] = TJob{p.w_out, p.WoT, 1024, 1024, 1024, 0, 0, 0};
    p.jobs[j++] = TJob{p.router_w, p.RtT, 1024, 256, 1024, 0, 0, 0};
    p.jobs[j++] = TJob{p.rwkv_g_up, p.GupT, 0, 0, 128, 0, 0, 0};
    p.jobs[j++] = TJob{p.rwkv_g_up, p.GupT, 0, 0, 128, 0, 0, 0};
    p.jobs[j++] = TJob{p.rwkv_g_up, p.GupT, 0, 0, 128, 0, 0, 0};
    p.jobs[j++] = TJob{p.rwkv_w_up, p.WupT, 64, 512, 64, 0, 0, 0};
    p.jobs[j++] = TJob{p.rwkv_w_up + 64 * 512, p.WupT, 64, 512, 64, 0, 512, 0};
    p.jobs[j++] = TJob{p.rwkv_a_up, p.AupT, 64, 512, 64, 0, 0, 0};
    p.jobs[j++] = TJob{p.rwkv_a_up + 64 * 512, p.AupT, 64, 512, 64, 0, 512, 0};
    p.jobs[j++] = TJob{p.rwkv_g_up, p.GupT, 128, 512, 128, 0, 0, 0};
    p.jobs[j++] = TJob{p.rwkv_g_up, p.GupT, 0, 0, 128, 0, 0, 0};
    (void)hipMemsetAsync(ws, 0, zero_bytes, stream);
#if MK_ONE_LAUNCH
    hipLaunchKernelGGL(k_mega, dim3(grid), dim3(NT), LDS_BYTES, stream, p);
#else
    launch_phases<0>(p, grid, stream);
#endif
}
```

```cpp
#include <hip/hip_runtime.h>
#include <stdint.h>
#include <stdio.h>

#ifndef MK_ONE_LAUNCH
#define MK_ONE_LAUNCH 1
#endif
#ifndef ROUTER_K
#define ROUTER_K 1024
#endif
#ifndef PROBE_MASK
#define PROBE_MASK 0u
#endif

typedef unsigned short bf16_t;
typedef short bf16x8 __attribute__((ext_vector_type(8)));
typedef float f32x4 __attribute__((ext_vector_type(4)));
typedef float f32x2 __attribute__((ext_vector_type(2)));
typedef float f32x16 __attribute__((ext_vector_type(16)));
typedef float f32x32 __attribute__((ext_vector_type(32)));

#define NT 512
constexpr int TX = 16384, TC = 256, TE = 16640, DM = 1024, INC = 6912;
constexpr int NCH = 130;
constexpr int RL = 130, RNC = 128;
constexpr int TSTR = 144;
constexpr int TILE_BYTES = 128 * TSTR;
constexpr int LDS_BYTES = 8 * TILE_BYTES + 1024;
constexpr int NSLOT = 131072 + 16384;
constexpr int NXT_MAX = 768 + 64;

#define XB_TMO      128
#define XB_XCNT(j)  (256  + 64 * (j))
#define XB_XSUB(j)  (1280 + 64 * (j))
#define XB_XGEN(j)  (2304 + 64 * (j))
#define XB_TOP      3328
#define XB_TOPGEN   3392
#define XCD_BAR_WORDS 3456
#define XB_SPIN_CAP (1u << 18)
#define LAS __attribute__((address_space(3)))

__device__ __forceinline__ unsigned xb_ld(unsigned* p)              { return __hip_atomic_load(p, __ATOMIC_RELAXED, __HIP_MEMORY_SCOPE_AGENT); }
__device__ __forceinline__ unsigned xb_add(unsigned* p, unsigned v) { return __hip_atomic_fetch_add(p, v, __ATOMIC_RELAXED, __HIP_MEMORY_SCOPE_AGENT); }
__device__ __forceinline__ unsigned xb_xcc_id() { return (unsigned)__builtin_amdgcn_s_getreg((3 << 11) | 20) & 0xFu; }
#define XB_SPIN(cond, bar) do { unsigned _sp = 0; while (cond) { __builtin_amdgcn_s_sleep(1); \
    if ((++_sp & 255u) == 0u) { if (xb_ld(&(bar)[XB_TMO])) break; if (_sp > XB_SPIN_CAP) { atomicAdd(&(bar)[XB_TMO], 1u); break; } } } } while (0)

struct XcdBarrier { unsigned* bar; unsigned x; volatile LAS unsigned* st; };

__device__ __forceinline__ XcdBarrier xcd_barrier_post(unsigned* bar, volatile LAS unsigned* st) {
    XcdBarrier b; b.bar = bar; b.x = xb_xcc_id(); b.st = st;
    if (threadIdx.x == 0) (void)xb_add(&bar[XB_XCNT(b.x)], 1u);
    return b;
}
__device__ __forceinline__ void xcd_barrier_complete(unsigned* bar, unsigned x, unsigned& nloc, unsigned& nx) {
    const unsigned G = gridDim.x * gridDim.y * gridDim.z;
    unsigned sum, cnt, mine, sp = 0u;
    for (;;) {
        sum = 0u; cnt = 0u; mine = 0u;
#pragma unroll
        for (unsigned j = 0; j < 16; ++j) { const unsigned c = xb_ld(&bar[XB_XCNT(j)]); sum += c; cnt += (c > 0u) ? 1u : 0u; mine = (j == x) ? c : mine; }
        if (sum == G) break;
        __builtin_amdgcn_s_sleep(1);
        if ((++sp & 255u) == 0u) { if (xb_ld(&bar[XB_TMO])) break; if (sp > XB_SPIN_CAP) { atomicAdd(&bar[XB_TMO], 1u); break; } }
    }
    nloc = mine > 0u ? mine : 1u; nx = cnt > 0u ? cnt : 1u;
}
__device__ __forceinline__ void xcd_barrier(const XcdBarrier& b) {
    asm volatile("s_waitcnt vmcnt(0)" ::: "memory");
    __syncthreads();
    if (threadIdx.x == 0) {
        unsigned* bar = b.bar;
        __builtin_amdgcn_s_waitcnt(0);
        unsigned nloc = b.st[0], nx = b.st[1];
        if (nloc == 0u) { xcd_barrier_complete(bar, b.x, nloc, nx); b.st[0] = nloc; b.st[1] = nx; }
        const unsigned old = xb_add(&bar[XB_XSUB(b.x)], 1u);
        const unsigned gen = old / nloc;
        if (old + 1u == (gen + 1u) * nloc) {
            __builtin_amdgcn_fence(__ATOMIC_RELEASE, "agent");
            asm volatile("s_waitcnt vmcnt(0)" ::: "memory");
            const unsigned og = xb_add(&bar[XB_TOP], 1u);
            const unsigned tg = og / nx;
            if (og + 1u == (tg + 1u) * nx) xb_add(&bar[XB_TOPGEN], 1u);
            else XB_SPIN(xb_ld(&bar[XB_TOPGEN]) == tg, bar);
            __builtin_amdgcn_fence(__ATOMIC_ACQUIRE, "agent");
            xb_add(&bar[XB_XGEN(b.x)], 1u);
            asm volatile("s_waitcnt vmcnt(0)" ::: "memory");
        } else {
            XB_SPIN(xb_ld(&bar[XB_XGEN(b.x)]) == gen, bar);
            __builtin_amdgcn_fence(__ATOMIC_ACQUIRE, "agent");
            asm volatile("s_waitcnt vmcnt(0)" ::: "memory");
        }
    }
    __syncthreads();
}

struct TJob { const float* src; bf16_t* dst; int K, N, dld, mode, rowoff, coloff; };
constexpr int NJOB = 14;

struct Params {
    const float *x, *c, *ctx, *c_ctx, *w_mod, *b_mod, *n_pre_mix, *n_post_mix, *n_pre_ffn, *n_post_ffn,
        *w_in, *shift_mu, *rwkv_w0, *rwkv_w_up, *rwkv_a0, *rwkv_a_up, *rwkv_g_up, *rwkv_k_k, *rwkv_k_a, *rwkv_r_k,
        *rwkv_ln_w, *rwkv_ln_b, *w_branch_a, *ret_decay_logit, *ret_ln_w, *ret_ln_b, *w_branch_b, *w_out,
        *router_w, *router_bias, *exp_w_gate, *exp_w_up, *exp_w_down, *sh_w_gate, *sh_w_up, *sh_w_down;
    float* out;
    unsigned* bar; int* cnt; int* bh; int* slot_tk; int* xt; int* ntiles; int* tok_e; int* tok_pos; float* tok_w;
    float* modp; float* mod;
    bf16_t *WinT, *WaT, *WbT, *WoT, *RtT, *ShGU, *ShD, *WupT, *AupT, *GupT;
    bf16_t *hn, *proj, *BtW;
    bf16_t *Rr, *Vv, *KD, *G, *O;
    bf16_t *Kk, *Aa, *Bd, *TW, *XA, *SG;
    float *PH; bf16_t *Wd; bf16_t *Sst; bf16_t *Zz, *YH;
    bf16_t *Qr, *Kr, *KTz, *A3, *B3;
    bf16_t* KVT; bf16_t* Y;
    bf16_t *ya_in, *yb_in, *merged, *Ahl, *act, *yk;
    float *mergedA, *logits; bf16_t* x_mid; bf16_t* mix;
    TJob jobs[NJOB];
};

__device__ __forceinline__ int tidx() { int t = threadIdx.x; asm volatile("" : "+v"(t)); return t; }
__device__ __forceinline__ float bf2f(bf16_t v) { return __uint_as_float(((unsigned)v) << 16); }
__device__ __forceinline__ unsigned pack2(float lo, float hi) { unsigned r; asm("v_cvt_pk_bf16_f32 %0, %1, %2" : "=v"(r) : "v"(lo), "v"(hi)); return r; }
__device__ __forceinline__ bf16_t f2bf(float f) { return (bf16_t)(pack2(f, f) & 0xffffu); }
typedef __bf16 bf16x2v __attribute__((ext_vector_type(2)));
__device__ __forceinline__ bf16_t f2bf_vis(float f) { const f32x2 v = {f, f}; return (bf16_t)(__builtin_bit_cast(unsigned, __builtin_convertvector(v, bf16x2v)) & 0xffffu); }
__device__ __forceinline__ void unpack8(const uint4& v, float (&f)[8]) {
    f[0] = __uint_as_float(v.x << 16); f[1] = __uint_as_float(v.x & 0xffff0000u); f[2] = __uint_as_float(v.y << 16); f[3] = __uint_as_float(v.y & 0xffff0000u);
    f[4] = __uint_as_float(v.z << 16); f[5] = __uint_as_float(v.z & 0xffff0000u); f[6] = __uint_as_float(v.w << 16); f[7] = __uint_as_float(v.w & 0xffff0000u); }
__device__ __forceinline__ uint4 pack8(const float (&f)[8]) { uint4 o; o.x = pack2(f[0], f[1]); o.y = pack2(f[2], f[3]); o.z = pack2(f[4], f[5]); o.w = pack2(f[6], f[7]); return o; }
__device__ __forceinline__ float dpp_f(float v, const int ctrl_unused) { return v; }
#define DPP_ADD(v, CTRL) ((v) + __int_as_float(__builtin_amdgcn_update_dpp(0, __float_as_int(v), CTRL, 0xf, 0xf, false)))
__device__ __forceinline__ float sum8(float v) { v = DPP_ADD(v, 0xB1); v = DPP_ADD(v, 0x4E); v = DPP_ADD(v, 0x141); return v; }
__device__ __forceinline__ float sum16(float v) { v = sum8(v); v = DPP_ADD(v, 0x140); return v; }
__device__ __forceinline__ float wsum(float v) {
    v = sum16(v);
    const float a = __int_as_float(__builtin_amdgcn_readlane(__float_as_int(v), 0)), b = __int_as_float(__builtin_amdgcn_readlane(__float_as_int(v), 16));
    const float c = __int_as_float(__builtin_amdgcn_readlane(__float_as_int(v), 32)), d = __int_as_float(__builtin_amdgcn_readlane(__float_as_int(v), 48));
    return (a + b) + (c + d);
}
__device__ __forceinline__ unsigned wave_umax(unsigned v) {
    v = max(v, (unsigned)__builtin_amdgcn_update_dpp(0, (int)v, 0x111, 0xf, 0xf, false));
    v = max(v, (unsigned)__builtin_amdgcn_update_dpp(0, (int)v, 0x112, 0xf, 0xf, false));
    v = max(v, (unsigned)__builtin_amdgcn_update_dpp(0, (int)v, 0x114, 0xf, 0xf, false));
    v = max(v, (unsigned)__builtin_amdgcn_update_dpp(0, (int)v, 0x118, 0xf, 0xf, false));
    v = max(v, (unsigned)__builtin_amdgcn_update_dpp(0, (int)v, 0x142, 0xa, 0xf, false));
    v = max(v, (unsigned)__builtin_amdgcn_update_dpp(0, (int)v, 0x143, 0xc, 0xf, false));
    return (unsigned)__builtin_amdgcn_readlane((int)v, 63);
}
__device__ __forceinline__ float sigm(float z) { return 1.f / (1.f + __expf(-z)); }
__device__ __forceinline__ int row_of(int dir, int s) { return dir == 0 ? s : (s < 256 ? 255 - s : 16895 - s); }

struct APlain { const bf16_t* base; int ld;
    __device__ __forceinline__ const char* bptr() const { return (const char*)base; }
    __device__ __forceinline__ unsigned rowoff(int r) const { return (unsigned)(r * ld) * 2u; } };
struct AGather { const bf16_t* base; int ld; const int* idx;
    __device__ __forceinline__ const char* bptr() const { return (const char*)base; }
    __device__ __forceinline__ unsigned rowoff(int r) const { const int tok = idx[r] / 9; return (unsigned)(tok * ld) * 2u; } };
struct BPlain { static constexpr int MODE = 0; const bf16_t* base; int ldv;
    __device__ __forceinline__ const char* bptr() const { return (const char*)base; }
    __device__ __forceinline__ unsigned rowoff(int n) const { return (unsigned)(n * ldv) * 2u; }
    __device__ __forceinline__ const float* colptr(int) const { return nullptr; }
    __device__ __forceinline__ long ld() const { return ldv; }
    __device__ __forceinline__ int lrow(int, int) const { return 0; } };
struct BKN { static constexpr int MODE = 1; const float* base; long ldv;
    __device__ __forceinline__ const char* bptr() const { return nullptr; }
    __device__ __forceinline__ unsigned rowoff(int) const { return 0u; }
    __device__ __forceinline__ const float* colptr(int n4) const { return base + n4 * 4; }
    __device__ __forceinline__ long ld() const { return ldv; }
    __device__ __forceinline__ int lrow(int n4, int j) const { return n4 * 4 + j; } };
struct BKNGU { static constexpr int MODE = 1; const float* g; const float* u;
    __device__ __forceinline__ const char* bptr() const { return nullptr; }
    __device__ __forceinline__ unsigned rowoff(int) const { return 0u; }
    __device__ __forceinline__ const float* colptr(int n4) const { return ((n4 >> 5) ? u : g) + (n4 & 31) * 4; }
    __device__ __forceinline__ long ld() const { return 256; }
    __device__ __forceinline__ int lrow(int n4, int j) const { int sc = (n4 & 31) * 4 + j; return (sc >> 4) * 32 + (n4 >> 5) * 16 + (sc & 15); } };

__device__ __forceinline__ float f4e(const float4& v, int j) { return j == 0 ? v.x : (j == 1 ? v.y : (j == 2 ? v.z : v.w)); }
#define GC_REP4(N, X) do { if constexpr ((N) > 0) { X(0); } if constexpr ((N) > 1) { X(1); } if constexpr ((N) > 2) { X(2); } if constexpr ((N) > 3) { X(3); } } while (0)
#define GC_REP8(N, X) do { X(0); X(1); X(2); X(3); if constexpr ((N) > 4) { X(4); X(5); X(6); X(7); } } while (0)
#define GC_AOFF(i) aoff##i = ap.rowoff(lrow + 64 * i) + lseg * 16
#define GC_BOFF(i) boff##i = bp.rowoff(lrow + 64 * i) + lseg * 16
#define GC_LA(i) ra##i = *(const uint4*)(abase + (aoff##i + kt_ * 128))
#define GC_LB(i) rb##i = *(const uint4*)(bbase + (boff##i + kt_ * 128))
#define GC_LF(i) rf##i = *(const float4*)(bfp + ((long)kt_ * 64 + i) * bld)
#define GC_SA(i) *(uint4*)(As_ + (lrow + 64 * i) * TSTR + lseg * 16) = ra##i
#define GC_SB(i) *(uint4*)(Bs_ + (lrow + 64 * i) * TSTR + lseg * 16) = rb##i
#define GC_GLOAD(KT) do { const int kt_ = (KT); GC_REP4(AL, GC_LA); \
    if constexpr (BP::MODE == 0) { GC_REP4(BL, GC_LB); } else { GC_REP8(KPT, GC_LF); } } while (0)
#define GC_SF(j) do { char* d_ = Bs_ + bp.lrow(n4, j) * TSTR + kq * KPT * 2; \
        if constexpr (KPT == 4) *(uint2*)d_ = make_uint2(pack2(f4e(rf0, j), f4e(rf1, j)), pack2(f4e(rf2, j), f4e(rf3, j))); \
        else *(uint4*)d_ = make_uint4(pack2(f4e(rf0, j), f4e(rf1, j)), pack2(f4e(rf2, j), f4e(rf3, j)), pack2(f4e(rf4, j), f4e(rf5, j)), pack2(f4e(rf6, j), f4e(rf7, j))); } while (0)
#define GC_LSTORE(BUF) do { char* As_ = smem + (BUF) * STAGE; char* Bs_ = As_ + ABYTES; GC_REP4(AL, GC_SA); \
    if constexpr (BP::MODE == 0) { GC_REP4(BL, GC_SB); } else { GC_SF(0); GC_SF(1); GC_SF(2); GC_SF(3); } } while (0)

template <int BM, int BN, int WGM, int WGN, bool PAIR = false, class AP, class BP>
__device__ __forceinline__ void gemm_core(f32x4 (&acc)[BM / WGM / 16][BN / WGN / 16], const AP& ap, const BP& bp, const int K, char* smem) {
    constexpr int TM = BM / WGM, TN = BN / WGN, MI = TM / 16, NI = TN / 16;
    constexpr int ABYTES = BM * TSTR, STAGE = (BM + BN) * TSTR;
    constexpr int AL = BM / 64, BL = BN / 64;
    constexpr int KPT = BN / 32, NQ = BN / 4;
    const int tid = tidx(), wave = tid >> 6, lane = tid & 63, fr = lane & 15, fq = lane >> 4;
    const int wm = wave / WGN, wn = wave % WGN;
    const int lrow = tid >> 3, lseg = tid & 7;
    const char* abase = ap.bptr(); const char* bbase = bp.bptr();
    unsigned aoff0 = 0, aoff1 = 0, aoff2 = 0, aoff3 = 0, boff0 = 0, boff1 = 0, boff2 = 0, boff3 = 0;
    uint4 ra0, ra1, ra2, ra3, rb0, rb1, rb2, rb3; float4 rf0, rf1, rf2, rf3, rf4, rf5, rf6, rf7;
    GC_REP4(AL, GC_AOFF);
    const float* bfp = nullptr;
    const int kq = tid / NQ, n4 = tid % NQ; const long bld = bp.ld();
    if constexpr (BP::MODE == 0) { GC_REP4(BL, GC_BOFF); } else { bfp = bp.colptr(n4) + (long)(kq * KPT) * bld; }
    int nk = K >> 6;
    asm volatile("" : "+s"(nk));
    GC_GLOAD(0); GC_LSTORE(0); __syncthreads();
    for (int kt = 0; kt < nk; ++kt) {
        if (kt + 1 < nk) GC_GLOAD(kt + 1);
        const char* As = smem + (kt & 1) * STAGE; const char* Bs = As + ABYTES;
#pragma unroll
        for (int ks = 0; ks < 2; ++ks) {
            bf16x8 af[MI], bfr[NI];
#pragma unroll
            for (int mi = 0; mi < MI; ++mi) af[mi] = *(const bf16x8*)(As + (wm * TM + mi * 16 + fr) * TSTR + ks * 64 + fq * 16);
#pragma unroll
            for (int ni = 0; ni < NI; ++ni) bfr[ni] = *(const bf16x8*)(Bs + (wn * TN + (PAIR ? (ni >> 1) * 32 + (fr >> 2) * 8 + (ni & 1) * 4 + (fr & 3) : ni * 16 + fr)) * TSTR + ks * 64 + fq * 16);
#pragma unroll
            for (int mi = 0; mi < MI; ++mi)
#pragma unroll
                for (int ni = 0; ni < NI; ++ni) acc[mi][ni] = __builtin_amdgcn_mfma_f32_16x16x32_bf16(bfr[ni], af[mi], acc[mi][ni], 0, 0, 0);
        }
        if (kt + 1 < nk) GC_LSTORE((kt + 1) & 1);
        __syncthreads();
    }
}
template <int BM, int BN, int WGM, int WGN, class AP, class BP, class EPI>
__device__ __forceinline__ void gemm_tile(const AP& ap, const BP& bp, const int K, char* smem, const EPI& epi) {
    constexpr int TM = BM / WGM, TN = BN / WGN, MI = TM / 16, NI = TN / 16;
    f32x4 acc[MI][NI];
#pragma unroll
    for (int mi = 0; mi < MI; ++mi)
#pragma unroll
        for (int ni = 0; ni < NI; ++ni) acc[mi][ni] = (f32x4){0.f, 0.f, 0.f, 0.f};
    gemm_core<BM, BN, WGM, WGN>(acc, ap, bp, K, smem);
    const int wave = tidx() >> 6, lane = tidx() & 63;
    epi(acc, (wave / WGN) * TM + (lane & 15), (wave % WGN) * TN + (lane >> 4) * 4);
}

namespace g8 {
constexpr int BM = 256, BK = 64, HALF = 128, HTB = HALF * BK * 2, NXCD = 8, WGM = 8;
__device__ __forceinline__ int lds_byte(int r, int c) { const int st = (r >> 4) * 2 + (c >> 5), rr = r & 15, cc = c & 31, ob = rr * 64 + cc * 2; return st * 1024 + (ob ^ (((ob >> 9) & 1) << 5)); }
__device__ __forceinline__ void stage_rc(int b, int& R, int& C) { const int st = b / 1024, sb = b % 1024, swz = sb ^ (((sb >> 9) & 1) << 5); R = (st >> 1) * 16 + swz / 64; C = (st & 1) * 32 + (swz % 64) / 2; }
__device__ __forceinline__ int perm32(int rho) { const int n = rho >> 4, i = rho & 15; return 8 * (i >> 2) + 4 * n + (i & 3); }
struct Unit { int pm, pn; };
struct StaticOrder {
    int nM, nN, nwg, G, c;
    __device__ void init(int M, int N, int G_, int c_) { nM = M / BM; nN = N / BM; nwg = nM * nN; G = G_; c = c_; }
    __device__ bool next(int i, Unit& u) const {
        const long L = (long)i * G + c; if (L >= nwg) return false;
        int wgid = (int)L; { const int q = nwg / NXCD, r = nwg % NXCD, xcd = wgid % NXCD, off = wgid / NXCD; wgid = (xcd < r ? xcd * (q + 1) : r * (q + 1) + (xcd - r) * q) + off; }
        const int nig = WGM * nN, gid = wgid / nig, fm = gid * WGM, gsz = (nM - fm) < WGM ? (nM - fm) : WGM;
        u.pm = fm + ((wgid % nig) % gsz); u.pn = (wgid % nig) / gsz; return true;
    }
};
template <class Epi, class Sched>
__device__ __forceinline__ void gemm_phase(LAS unsigned char* lds, const bf16_t* Ag, const bf16_t* Btg, const int lda, const int ldb, const int K, const Sched& S, const Epi& E) {
    int tid = threadIdx.x; asm volatile("" : "+v"(tid));
    const int wid = __builtin_amdgcn_readfirstlane(tid >> 6), lane = tid & 63, wr = wid >> 2, wc = wid & 3, fr = lane & 15, fq = lane >> 4;
    const int nt = K / BK;
    unsigned voffA[2], voffB[2];
#pragma unroll
    for (int i = 0; i < 2; ++i) { int R, C; stage_rc(tid * 16 + i * 8192, R, C); const int Rb = Epi::PERM ? ((R & ~31) + perm32(R & 31)) : R;
        voffA[i] = (unsigned)(R * lda + C) * 2u; voffB[i] = (unsigned)(Rb * ldb + C) * 2u; }
    const size_t kstep = (size_t)(BK * 2);
    const size_t hstepA = (size_t)HALF * lda * 2, hstepB = (size_t)HALF * ldb * 2;
    const size_t tstepA = 2 * hstepA, tstepB = 2 * hstepB;
    const unsigned ldsw = (unsigned)wid * 1024u;
    const int aoff = lds_byte(wr * 64 + fr, fq * 8), boff = lds_byte(wc * 32 + fr, fq * 8);
#define PG8_SA(b, h) (((b) * 2 + (h)) * HTB)
#define PG8_SB(b, h) ((4 + (b) * 2 + (h)) * HTB)
#define PG8_STAGE(bufoff, gbase, voff) do { _Pragma("unroll") for (int _i = 0; _i < 2; ++_i) \
        __builtin_amdgcn_global_load_lds((const unsigned*)((const char*)(gbase) + (voff)[_i]), (LAS unsigned*)(lds + (bufoff) + ldsw + _i * 8192), 16, 0, 0); } while (0)
#define PG8_LDA(dst, b, h) do { _Pragma("unroll") for (int m = 0; m < 4; ++m) _Pragma("unroll") for (int k = 0; k < 2; ++k) dst[m][k] = *(const LAS bf16x8*)(lds + PG8_SA(b, h) + aoff + m * 2048 + k * 1024); } while (0)
#define PG8_LDB(dst, b, h) do { _Pragma("unroll") for (int n = 0; n < 2; ++n) _Pragma("unroll") for (int k = 0; k < 2; ++k) dst[n][k] = *(const LAS bf16x8*)(lds + PG8_SB(b, h) + boff + n * 2048 + k * 1024); } while (0)
#define PG8_MMA(ai, bj, At, Bt) do { __builtin_amdgcn_s_setprio(1); _Pragma("unroll") for (int m = 0; m < 4; ++m) _Pragma("unroll") for (int n = 0; n < 2; ++n) _Pragma("unroll") for (int k = 0; k < 2; ++k) \
        acc[ai][bj][m][n] = __builtin_amdgcn_mfma_f32_16x16x32_bf16(Bt[n][k], At[m][k], acc[ai][bj][m][n], 0, 0, 0); __builtin_amdgcn_s_setprio(0); } while (0)
#define PG8_WAIT_V(n) asm volatile("s_waitcnt vmcnt(" #n ")" ::: "memory")
#define PG8_WAIT_L(n) asm volatile("s_waitcnt lgkmcnt(" #n ")" ::: "memory")
#define PG8_BAR __builtin_amdgcn_s_barrier()
#define PG8_SCHED __builtin_amdgcn_sched_barrier(0)
    Unit cur, nxt; int ui = 0;
    if (!S.next(0, cur)) return;
    f32x4 acc[2][2][4][2];
#pragma unroll
    for (int a = 0; a < 2; ++a)
#pragma unroll
        for (int b = 0; b < 2; ++b)
#pragma unroll
            for (int m = 0; m < 4; ++m)
#pragma unroll
                for (int n = 0; n < 2; ++n) acc[a][b][m][n] = (f32x4){0.f, 0.f, 0.f, 0.f};
    bf16x8 At[4][2], B0[2][2], B1[2][2];
    const char* cA = (const char*)Ag + (size_t)cur.pm * tstepA; const char* cB = (const char*)Btg + (size_t)cur.pn * tstepB;
    PG8_STAGE(PG8_SB(0, 0), cB, voffB); PG8_STAGE(PG8_SA(0, 0), cA, voffA); PG8_STAGE(PG8_SB(0, 1), cB + hstepB, voffB); PG8_STAGE(PG8_SA(0, 1), cA + hstepA, voffA);
    if (wr == 1) PG8_BAR;
    PG8_WAIT_V(4); PG8_BAR;
    PG8_STAGE(PG8_SB(1, 0), cB + kstep, voffB); PG8_STAGE(PG8_SA(1, 0), cA + kstep, voffA); PG8_STAGE(PG8_SB(1, 1), cB + hstepB + kstep, voffB);
    PG8_WAIT_V(6); PG8_BAR;
    for (;;) {
        const bool has_next = S.next(ui + 1, nxt);
        const char* nA = has_next ? (const char*)Ag + (size_t)nxt.pm * tstepA : cA; const char* nB = has_next ? (const char*)Btg + (size_t)nxt.pn * tstepB : cB;
        for (int t = 0; t < nt; t += 2) {
            const bool last = (t == nt - 2);
            const char* a1 = cA + (size_t)(t + 1) * kstep;
            const char* a2 = last ? nA : cA + (size_t)(t + 2) * kstep; const char* b2 = last ? nB : cB + (size_t)(t + 2) * kstep;
            const char* a3 = a2 + kstep; const char* b3 = b2 + kstep;
            PG8_LDB(B0, 0, 0); PG8_SCHED; PG8_LDA(At, 0, 0); PG8_STAGE(PG8_SA(1, 1), a1 + hstepA, voffA);
            PG8_WAIT_L(8); PG8_BAR; PG8_WAIT_L(0); PG8_MMA(0, 0, At, B0); PG8_BAR; PG8_SCHED;
            PG8_LDB(B1, 0, 1); PG8_STAGE(PG8_SB(0, 0), b2, voffB);
            PG8_BAR; PG8_WAIT_L(0); PG8_MMA(0, 1, At, B1); PG8_BAR;
            PG8_LDA(At, 0, 1); PG8_STAGE(PG8_SA(0, 0), a2, voffA);
            PG8_BAR; PG8_WAIT_L(0); PG8_MMA(1, 0, At, B0); PG8_BAR; PG8_SCHED;
            PG8_STAGE(PG8_SB(0, 1), b2 + hstepB, voffB);
            PG8_WAIT_V(6); PG8_BAR; PG8_MMA(1, 1, At, B1); PG8_BAR;
            PG8_LDB(B0, 1, 0); PG8_SCHED; PG8_LDA(At, 1, 0); PG8_STAGE(PG8_SA(0, 1), a2 + hstepA, voffA);
            PG8_WAIT_L(8); PG8_BAR; PG8_WAIT_L(0); PG8_MMA(0, 0, At, B0); PG8_BAR; PG8_SCHED;
            PG8_LDB(B1, 1, 1); PG8_STAGE(PG8_SB(1, 0), b3, voffB);
            PG8_BAR; PG8_WAIT_L(0); PG8_MMA(0, 1, At, B1); PG8_BAR;
            PG8_LDA(At, 1, 1); PG8_STAGE(PG8_SA(1, 0), a3, voffA);
            PG8_BAR; PG8_WAIT_L(0); PG8_MMA(1, 0, At, B0); PG8_BAR; PG8_SCHED;
            PG8_STAGE(PG8_SB(1, 1), b3 + hstepB, voffB);
            PG8_WAIT_V(6); PG8_BAR; PG8_MMA(1, 1, At, B1); PG8_BAR;
        }
        E(acc, cur, wr, wc, fr, fq);
        if (!has_next) break;
#pragma unroll
        for (int a = 0; a < 2; ++a)
#pragma unroll
            for (int b = 0; b < 2; ++b)
#pragma unroll
                for (int m = 0; m < 4; ++m)
#pragma unroll
                    for (int n = 0; n < 2; ++n) acc[a][b][m][n] = (f32x4){0.f, 0.f, 0.f, 0.f};
        cur = nxt; cA = nA; cB = nB; ++ui;
    }
    PG8_WAIT_V(0);
    if (wr == 0) PG8_BAR;
    PG8_BAR;
#undef PG8_SA
#undef PG8_SB
#undef PG8_STAGE
#undef PG8_LDA
#undef PG8_LDB
#undef PG8_MMA
#undef PG8_WAIT_V
#undef PG8_WAIT_L
#undef PG8_BAR
#undef PG8_SCHED
}
struct EpiF32 {
    static constexpr bool PERM = false;
    float* C; int ldc;
    __device__ __forceinline__ void operator()(const f32x4 (&acc)[2][2][4][2], const Unit& u, int wr, int wc, int fr, int fq) const {
        const int row0 = u.pm * BM + wr * 64 + fr, col0 = u.pn * BM + wc * 32 + 4 * fq;
#pragma unroll
        for (int ai = 0; ai < 2; ++ai)
#pragma unroll
            for (int m = 0; m < 4; ++m) { float* rowp = C + (size_t)(row0 + ai * HALF + m * 16) * ldc + col0;
#pragma unroll
                for (int bj = 0; bj < 2; ++bj)
#pragma unroll
                    for (int n = 0; n < 2; ++n) *(f32x4*)(rowp + bj * HALF + n * 16) = acc[ai][bj][m][n]; }
    }
};
struct EpiBf16 {
    static constexpr bool PERM = true;
    bf16_t* O; int ldc;
    __device__ __forceinline__ void operator()(const f32x4 (&acc)[2][2][4][2], const Unit& u, int wr, int wc, int fr, int fq) const {
        const int row0 = u.pm * BM + wr * 64 + fr, col0 = u.pn * BM + wc * 32 + 8 * fq;
#pragma unroll
        for (int ai = 0; ai < 2; ++ai)
#pragma unroll
            for (int m = 0; m < 4; ++m) { bf16_t* rowp = O + (size_t)(row0 + ai * HALF + m * 16) * ldc + col0;
#pragma unroll
                for (int bj = 0; bj < 2; ++bj) { const f32x4 v0 = acc[ai][bj][m][0], v1 = acc[ai][bj][m][1];
                    uint4 o; o.x = pack2(v0[0], v0[1]); o.y = pack2(v0[2], v0[3]); o.z = pack2(v1[0], v1[1]); o.w = pack2(v1[2], v1[3]);
                    *(uint4*)(rowp + bj * HALF) = o; } }
    }
};
struct XUnit { int row0, nrows, e, nt; };
template <class Epi>
__device__ __forceinline__ void gemm_phase_xg(LAS unsigned char* lds, const bf16_t* Ag, const int* slot_tk, const int* xt, const bf16_t* BtW, const int nun, const int lb, const int G, const Epi& E) {
    int tid = threadIdx.x; asm volatile("" : "+v"(tid));
    const int wid = __builtin_amdgcn_readfirstlane(tid >> 6), lane = tid & 63, wr = wid >> 2, wc = wid & 3, fr = lane & 15, fq = lane >> 4;
    constexpr int K = 1024, nt = K / BK;
    unsigned voffB[2];
#pragma unroll
    for (int i = 0; i < 2; ++i) { int R, C; stage_rc(tid * 16 + i * 8192, R, C); voffB[i] = (unsigned)(R * K + C) * 2u; }
    const size_t kstep = (size_t)(BK * 2), hstepB = (size_t)HALF * K * 2;
    const unsigned ldsw = (unsigned)wid * 1024u;
    const int aoff = lds_byte(wr * 64 + fr, fq * 8), boff = lds_byte(wc * 32 + fr, fq * 8);
#define PG8_SA(b, h) (((b) * 2 + (h)) * HTB)
#define PG8_SB(b, h) ((4 + (b) * 2 + (h)) * HTB)
#define PG8_STAGE(bufoff, gbase, voff) do { _Pragma("unroll") for (int _i = 0; _i < 2; ++_i) \
        __builtin_amdgcn_global_load_lds((const unsigned*)((const char*)(gbase) + (voff)[_i]), (LAS unsigned*)(lds + (bufoff) + ldsw + _i * 8192), 16, 0, 0); } while (0)
#define PG8_LDA(dst, b, h) do { _Pragma("unroll") for (int m = 0; m < 4; ++m) _Pragma("unroll") for (int k = 0; k < 2; ++k) dst[m][k] = *(const LAS bf16x8*)(lds + PG8_SA(b, h) + aoff + m * 2048 + k * 1024); } while (0)
#define PG8_LDB(dst, b, h) do { _Pragma("unroll") for (int n = 0; n < 2; ++n) _Pragma("unroll") for (int k = 0; k < 2; ++k) dst[n][k] = *(const LAS bf16x8*)(lds + PG8_SB(b, h) + boff + n * 2048 + k * 1024); } while (0)
#define PG8_MMA(ai, bj, At, Bt) do { __builtin_amdgcn_s_setprio(1); _Pragma("unroll") for (int m = 0; m < 4; ++m) _Pragma("unroll") for (int n = 0; n < 2; ++n) _Pragma("unroll") for (int k = 0; k < 2; ++k) \
        acc[ai][bj][m][n] = __builtin_amdgcn_mfma_f32_16x16x32_bf16(Bt[n][k], At[m][k], acc[ai][bj][m][n], 0, 0, 0); __builtin_amdgcn_s_setprio(0); } while (0)
#define PG8_WAIT_V(n) asm volatile("s_waitcnt vmcnt(" #n ")" ::: "memory")
#define PG8_WAIT_L(n) asm volatile("s_waitcnt lgkmcnt(" #n ")" ::: "memory")
#define PG8_BAR __builtin_amdgcn_s_barrier()
#define PG8_SCHED __builtin_amdgcn_sched_barrier(0)
#define XG_UNIT(I, U) ((lb + (I) * G) < nun ? ((U).row0 = xt[((lb + (I) * G) >> 1) * 4 + 1], (U).nrows = xt[((lb + (I) * G) >> 1) * 4 + 2], (U).e = xt[((lb + (I) * G) >> 1) * 4], (U).nt = (lb + (I) * G) & 1, true) : false)
#define XG_AVOFF(U, V0, V1) do { int t_ = threadIdx.x; asm volatile("" : "+v"(t_)); _Pragma("unroll") for (int _i = 0; _i < 2; ++_i) { int R_, C_; stage_rc(t_ * 16 + _i * 8192, R_, C_); \
        V0[_i] = (unsigned)(slot_tk[(U).row0 + R_] / 9) * 2048u + (unsigned)C_ * 2u; V1[_i] = (unsigned)(slot_tk[(U).row0 + 128 + R_] / 9) * 2048u + (unsigned)C_ * 2u; } } while (0)
    XUnit cur, nxt; int ui = 0;
    if (!XG_UNIT(0, cur)) return;
    f32x4 acc[2][2][4][2];
#pragma unroll
    for (int a = 0; a < 2; ++a)
#pragma unroll
        for (int b = 0; b < 2; ++b)
#pragma unroll
            for (int m = 0; m < 4; ++m)
#pragma unroll
                for (int n = 0; n < 2; ++n) acc[a][b][m][n] = (f32x4){0.f, 0.f, 0.f, 0.f};
    bf16x8 At[4][2], B0[2][2], B1[2][2];
    unsigned vC0[2], vC1[2], vN1[2];
    XG_AVOFF(cur, vC0, vC1);
    const char* cA = (const char*)Ag;
    const char* cB = (const char*)(BtW + ((size_t)cur.e * 512 + cur.nt * 256) * K);
    PG8_STAGE(PG8_SB(0, 0), cB, voffB); PG8_STAGE(PG8_SA(0, 0), cA, vC0); PG8_STAGE(PG8_SB(0, 1), cB + hstepB, voffB); PG8_STAGE(PG8_SA(0, 1), cA, vC1);
    if (wr == 1) PG8_BAR;
    PG8_WAIT_V(4); PG8_BAR;
    PG8_STAGE(PG8_SB(1, 0), cB + kstep, voffB); PG8_STAGE(PG8_SA(1, 0), cA + kstep, vC0); PG8_STAGE(PG8_SB(1, 1), cB + hstepB + kstep, voffB);
    PG8_WAIT_V(6); PG8_BAR;
    for (;;) {
        const bool has_next = XG_UNIT(ui + 1, nxt);
        if (!has_next) nxt = cur;
        const char* nB = (const char*)(BtW + ((size_t)nxt.e * 512 + nxt.nt * 256) * K);
        for (int t = 0; t < nt; t += 2) {
            const bool last = (t == nt - 2);
            if (last) XG_AVOFF(nxt, vC0, vN1);
            const char* a1 = cA + (size_t)(t + 1) * kstep;
            const char* a2 = last ? cA : cA + (size_t)(t + 2) * kstep; const char* b2 = last ? nB : cB + (size_t)(t + 2) * kstep;
            const char* a3 = a2 + kstep; const char* b3 = b2 + kstep;
            PG8_LDB(B0, 0, 0); PG8_SCHED; PG8_LDA(At, 0, 0); PG8_STAGE(PG8_SA(1, 1), a1, vC1);
            if (last) { vC1[0] = vN1[0]; vC1[1] = vN1[1]; }
            PG8_WAIT_L(8); PG8_BAR; PG8_WAIT_L(0); PG8_MMA(0, 0, At, B0); PG8_BAR; PG8_SCHED;
            PG8_LDB(B1, 0, 1); PG8_STAGE(PG8_SB(0, 0), b2, voffB);
            PG8_BAR; PG8_WAIT_L(0); PG8_MMA(0, 1, At, B1); PG8_BAR;
            PG8_LDA(At, 0, 1); PG8_STAGE(PG8_SA(0, 0), a2, vC0);
            PG8_BAR; PG8_WAIT_L(0); PG8_MMA(1, 0, At, B0); PG8_BAR; PG8_SCHED;
            PG8_STAGE(PG8_SB(0, 1), b2 + hstepB, voffB);
            PG8_WAIT_V(6); PG8_BAR; PG8_MMA(1, 1, At, B1); PG8_BAR;
            PG8_LDB(B0, 1, 0); PG8_SCHED; PG8_LDA(At, 1, 0); PG8_STAGE(PG8_SA(0, 1), a2, vC1);
            PG8_WAIT_L(8); PG8_BAR; PG8_WAIT_L(0); PG8_MMA(0, 0, At, B0); PG8_BAR; PG8_SCHED;
            PG8_LDB(B1, 1, 1); PG8_STAGE(PG8_SB(1, 0), b3, voffB);
            PG8_BAR; PG8_WAIT_L(0); PG8_MMA(0, 1, At, B1); PG8_BAR;
            PG8_LDA(At, 1, 1); PG8_STAGE(PG8_SA(1, 0), a3, vC0);
            PG8_BAR; PG8_WAIT_L(0); PG8_MMA(1, 0, At, B0); PG8_BAR; PG8_SCHED;
            PG8_STAGE(PG8_SB(1, 1), b3 + hstepB, voffB);
            PG8_WAIT_V(6); PG8_BAR; PG8_MMA(1, 1, At, B1); PG8_BAR;
        }
        E(acc, cur, wr, wc, fr, fq);
        if (!has_next) break;
#pragma unroll
        for (int a = 0; a < 2; ++a)
#pragma unroll
            for (int b = 0; b < 2; ++b)
#pragma unroll
                for (int m = 0; m < 4; ++m)
#pragma unroll
                    for (int n = 0; n < 2; ++n) acc[a][b][m][n] = (f32x4){0.f, 0.f, 0.f, 0.f};
        cur = nxt; cB = nB; ++ui;
    }
    PG8_WAIT_V(0);
    if (wr == 0) PG8_BAR;
    PG8_BAR;
#undef PG8_SA
#undef PG8_SB
#undef PG8_STAGE
#undef PG8_LDA
#undef PG8_LDB
#undef PG8_MMA
#undef PG8_WAIT_V
#undef PG8_WAIT_L
#undef PG8_BAR
#undef PG8_SCHED
#undef XG_UNIT
#undef XG_AVOFF
}
struct EpiGU {
    bf16_t* act;
    __device__ __forceinline__ void operator()(const f32x4 (&acc)[2][2][4][2], const XUnit& u, int wr, int wc, int fr, int fq) const {
        const int r0 = wr * 64 + fr;
#pragma unroll
        for (int ai = 0; ai < 2; ++ai)
#pragma unroll
            for (int m = 0; m < 4; ++m) { const int r = r0 + ai * HALF + m * 16;
                if (r < u.nrows) { bf16_t* rowp = act + (size_t)(u.row0 + r) * 256 + u.nt * 128 + wc * 16 + fq * 4;
#pragma unroll
                    for (int bj = 0; bj < 2; ++bj) { const f32x4 g = acc[ai][bj][m][0], up = acc[ai][bj][m][1];
                        uint2 o; o.x = pack2(g[0] * sigm(g[0]) * up[0], g[1] * sigm(g[1]) * up[1]); o.y = pack2(g[2] * sigm(g[2]) * up[2], g[3] * sigm(g[3]) * up[3]);
                        *(uint2*)(rowp + bj * 64) = o; } } }
    }
};
}

template <bool PAIR, class DescF, class EpiF>
__device__ __forceinline__ void stream_gemm128(char* smem, const int nunits, const DescF& desc, const EpiF& epi) {
    constexpr int STAGE = 2 * TILE_BYTES;
    const int tid = tidx(), wave = tid >> 6, lane = tid & 63, fr = lane & 15, fq = lane >> 4;
    const int wm = wave >> 1, wn = wave & 1;
    const int lrow = tid >> 3, lseg = tid & 7, G = gridDim.x;
    if ((int)blockIdx.x >= nunits) return;
    uint4 ra0, ra1, rb0, rb1;
    const char* la = nullptr; const char* lbp = nullptr; unsigned lao0 = 0, lao1 = 0, lbo0 = 0, lbo1 = 0;
    int lu = blockIdx.x, lkt = 0, lnk = 0;
    int cu = blockIdx.x, ckt = 0, cnk = 0;
#define SG_DESC() do { const bf16_t* A_; const bf16_t* B_; int lda_, ldb_; desc(lu, A_, B_, lda_, ldb_, lnk); la = (const char*)A_; lbp = (const char*)B_; \
        lao0 = (unsigned)(lrow * lda_) * 2u + lseg * 16; lao1 = (unsigned)((lrow + 64) * lda_) * 2u + lseg * 16; lbo0 = (unsigned)(lrow * ldb_) * 2u + lseg * 16; lbo1 = (unsigned)((lrow + 64) * ldb_) * 2u + lseg * 16; } while (0)
#define SG_LOAD() do { ra0 = *(const uint4*)(la + (lao0 + lkt * 128)); ra1 = *(const uint4*)(la + (lao1 + lkt * 128)); rb0 = *(const uint4*)(lbp + (lbo0 + lkt * 128)); rb1 = *(const uint4*)(lbp + (lbo1 + lkt * 128)); } while (0)
#define SG_STORE(ST) do { char* As_ = smem + (ST) * STAGE; char* Bs_ = As_ + TILE_BYTES; \
        *(uint4*)(As_ + lrow * TSTR + lseg * 16) = ra0; *(uint4*)(As_ + (lrow + 64) * TSTR + lseg * 16) = ra1; *(uint4*)(Bs_ + lrow * TSTR + lseg * 16) = rb0; *(uint4*)(Bs_ + (lrow + 64) * TSTR + lseg * 16) = rb1; } while (0)
#define SG_ADV() do { if (++lkt == lnk) { lkt = 0; lu += G; if (lu < nunits) SG_DESC(); } } while (0)
    f32x4 acc[2][4];
#pragma unroll
    for (int mi = 0; mi < 2; ++mi)
#pragma unroll
        for (int ni = 0; ni < 4; ++ni) acc[mi][ni] = (f32x4){0.f, 0.f, 0.f, 0.f};
    SG_DESC(); cnk = lnk;
    SG_LOAD(); SG_STORE(0); SG_ADV(); __syncthreads();
    for (int s = 0; cu < nunits; ++s) {
        const bool more = lu < nunits;
        if (more) SG_LOAD();
        const char* As = smem + (s & 1) * STAGE; const char* Bs = As + TILE_BYTES;
#pragma unroll
        for (int ks = 0; ks < 2; ++ks) {
            bf16x8 af[2], bfr[4];
#pragma unroll
            for (int mi = 0; mi < 2; ++mi) af[mi] = *(const bf16x8*)(As + (wm * 32 + mi * 16 + fr) * TSTR + ks * 64 + fq * 16);
#pragma unroll
            for (int ni = 0; ni < 4; ++ni) bfr[ni] = *(const bf16x8*)(Bs + (wn * 64 + (PAIR ? (ni >> 1) * 32 + (fr >> 2) * 8 + (ni & 1) * 4 + (fr & 3) : ni * 16 + fr)) * TSTR + ks * 64 + fq * 16);
#pragma unroll
            for (int mi = 0; mi < 2; ++mi)
#pragma unroll
                for (int ni = 0; ni < 4; ++ni) acc[mi][ni] = __builtin_amdgcn_mfma_f32_16x16x32_bf16(bfr[ni], af[mi], acc[mi][ni], 0, 0, 0);
        }
        if (++ckt == cnk) {
            asm volatile("s_nop 15");
            epi(cu, acc, wm * 32 + fr, wn * 64 + fq * (PAIR ? 8 : 4));
#pragma unroll
            for (int mi = 0; mi < 2; ++mi)
#pragma unroll
                for (int ni = 0; ni < 4; ++ni) acc[mi][ni] = (f32x4){0.f, 0.f, 0.f, 0.f};
            ckt = 0; cu += G;
            if (cu < nunits) { const bf16_t* A_; const bf16_t* B_; int lda_, ldb_; desc(cu, A_, B_, lda_, ldb_, cnk); }
        }
        if (more) { SG_STORE((s + 1) & 1); SG_ADV(); }
        __syncthreads();
    }
#undef SG_DESC
#undef SG_LOAD
#undef SG_STORE
#undef SG_ADV
}

__device__ __forceinline__ void conv_gu_tiles(const Params& p, char* smem, int w0, int nw, int t_begin, int t_end) {
    const int tid = tidx(), wave = tid >> 6, lane = tid & 63;
    bf16_t* T = (bf16_t*)smem + wave * (2 * 16 * 72);
    for (int tau = t_begin + w0 * 2; tau < t_end; tau += nw * 2) {
        float4 v[2][4];
#pragma unroll
        for (int h = 0; h < 2; ++h) {
            const int tt = tau + h < t_end ? tau + h : tau;
            const int m = tt >> 8, kb = (tt >> 4) & 15, nb = tt & 15, e = m >> 1, sel = m & 1;
            const float* src = (sel ? (e < 256 ? p.exp_w_up + (size_t)e * 262144 : p.sh_w_up) : (e < 256 ? p.exp_w_gate + (size_t)e * 262144 : p.sh_w_gate)) + (size_t)(kb * 64 + lane) * 256 + nb * 16;
#pragma unroll
            for (int i = 0; i < 4; ++i) v[h][i] = *(const float4*)(src + i * 4);
        }
#pragma unroll
        for (int h = 0; h < 2; ++h) {
            if (tau + h >= t_end) break;
            const int tt = tau + h;
            const int m = tt >> 8, kb = (tt >> 4) & 15, nb = tt & 15, e = m >> 1, sel = m & 1;
            bf16_t* Th = T + h * (16 * 72);
#pragma unroll
            for (int i = 0; i < 4; ++i) { Th[(i * 4 + 0) * 72 + lane] = f2bf(v[h][i].x); Th[(i * 4 + 1) * 72 + lane] = f2bf(v[h][i].y); Th[(i * 4 + 2) * 72 + lane] = f2bf(v[h][i].z); Th[(i * 4 + 3) * 72 + lane] = f2bf(v[h][i].w); }
            const int q = lane >> 2, seg = lane & 3;
            const uint4 o0 = *(const uint4*)(Th + q * 72 + seg * 16), o1 = *(const uint4*)(Th + q * 72 + seg * 16 + 8);
            const int rho = (nb >> 3) * 256 + ((nb >> 2) & 1) * 128 + (nb & 3) * 32 + sel * 16 + q;
            bf16_t* d = p.BtW + ((size_t)e * 512 + rho) * 1024 + kb * 64 + seg * 16;
            *(uint4*)d = o0; *(uint4*)(d + 8) = o1;
        }
    }
}

__device__ __forceinline__ void phase0(const Params& p, char* smem) {
    const int tid = tidx(), wave = tid >> 6, lane = tid & 63;
    const int gw = blockIdx.x * 8 + wave, nw = gridDim.x * 8;
    for (int u = gw; u < 1536; u += nw) {
        const int cb = u % 96, ks = u / 96, j = cb * 64 + lane;
        float a0 = 0.f, a1 = 0.f;
#pragma unroll 1
        for (int k0 = ks * 64; k0 < ks * 64 + 64; k0 += 16) {
            float w[16];
#pragma unroll
            for (int i = 0; i < 16; ++i) w[i] = p.w_mod[(size_t)(k0 + i) * 6144 + j];
#pragma unroll
            for (int i = 0; i < 16; ++i) { const float c0 = p.c[k0 + i], c1 = p.c_ctx[k0 + i]; a0 += c0 * sigm(c0) * w[i]; a1 += c1 * sigm(c1) * w[i]; }
        }
        p.modp[(ks * 2 + 0) * 6144 + j] = a0; p.modp[(ks * 2 + 1) * 6144 + j] = a1;
    }
    float* T = (float*)smem;
    int total = 0;
    for (int j = 0; j < NJOB; ++j) total += (p.jobs[j].K >> 6) * (p.jobs[j].N >> 6);
    for (int u = blockIdx.x; u < total; u += gridDim.x) {
        int j = 0, r = u;
        for (;; ++j) { const int n = (p.jobs[j].K >> 6) * (p.jobs[j].N >> 6); if (r < n) break; r -= n; }
        const TJob jb = p.jobs[j];
        const int ntn = jb.N >> 6, kt = r / ntn, nt = r % ntn, k0 = kt * 64, n0 = nt * 64;
        {
            const int kk = tid >> 4, c4 = (tid & 15) * 4;
#pragma unroll
            for (int i = 0; i < 2; ++i) {
                const int k = kk + 32 * i;
                const float4 v = *(const float4*)(jb.src + (size_t)(k0 + k) * jb.N + n0 + c4);
                T[k * 65 + c4 + 0] = v.x; T[k * 65 + c4 + 1] = v.y; T[k * 65 + c4 + 2] = v.z; T[k * 65 + c4 + 3] = v.w;
            }
        }
        __syncthreads();
        {
            const int n = tid >> 3, ks = (tid & 7) * 8;
            float v[8];
#pragma unroll
            for (int q = 0; q < 8; ++q) v[q] = T[(ks + q) * 65 + n];
            const int ng = n0 + n;
            int drow = jb.rowoff + ng;
            if (jb.mode == 2) drow = (ng >> 4) * 32 + (ng & 15) + jb.rowoff;
            uint4 hi; hi.x = pack2(v[0], v[1]); hi.y = pack2(v[2], v[3]); hi.z = pack2(v[4], v[5]); hi.w = pack2(v[6], v[7]);
            bf16_t* d = jb.dst + (size_t)drow * jb.dld + jb.coloff + k0 + ks;
            *(uint4*)d = hi;
            if (jb.mode == 1) {
                float l[8];
#pragma unroll
                for (int q = 0; q < 8; ++q) l[q] = v[q] - bf2f(f2bf(v[q]));
                uint4 lo; lo.x = pack2(l[0], l[1]); lo.y = pack2(l[2], l[3]); lo.z = pack2(l[4], l[5]); lo.w = pack2(l[6], l[7]);
                *(uint4*)(d + 1024) = hi; *(uint4*)(d + 2048) = lo;
            }
        }
        __syncthreads();
    }
}

__device__ __forceinline__ void phase1(const Params& p, char* smem) {
    const int tid = tidx(), wave = tid >> 6, lane = tid & 63;
    float* L = (float*)smem;
    for (int idx = tid; idx < 4096; idx += NT) {
        const int v = idx >> 11, which = (idx >> 10) & 1, col = idx & 1023;
        float s = p.b_mod[which * 1024 + col];
        for (int ks = 0; ks < 16; ++ks) s += p.modp[(ks * 2 + v) * 6144 + which * 1024 + col];
        L[idx] = s;
    }
    for (int idx = blockIdx.x * NT + tid; idx < 2 * 6144; idx += gridDim.x * NT) {
        const int v = idx / 6144, j = idx % 6144;
        float sm = p.b_mod[j];
#pragma unroll
        for (int ks = 0; ks < 16; ++ks) sm += p.modp[(ks * 2 + v) * 6144 + j];
        p.mod[idx] = sm;
    }
    __syncthreads();
    const int gw = blockIdx.x * 8 + wave, nw = gridDim.x * 8;
    for (int r0 = gw; r0 < TE; r0 += 2 * nw) {
        float4 xv[2][4]; float ss[2];
#pragma unroll
        for (int h = 0; h < 2; ++h) {
            const int r = r0 + h * nw < TE ? r0 + h * nw : r0;
            const float* src = r < 256 ? p.ctx + (size_t)r * 1024 : p.x + (size_t)(r - 256) * 1024;
            ss[h] = 0.f;
#pragma unroll
            for (int i = 0; i < 4; ++i) { xv[h][i] = *(const float4*)(src + i * 256 + lane * 4); ss[h] += xv[h][i].x * xv[h][i].x + xv[h][i].y * xv[h][i].y + xv[h][i].z * xv[h][i].z + xv[h][i].w * xv[h][i].w; }
        }
#pragma unroll
        for (int h = 0; h < 2; ++h) {
            const int r = r0 + h * nw;
            if (r >= TE) break;
            const int v = r < 256 ? 1 : 0;
            const float rs = rsqrtf(wsum(ss[h]) * (1.f / 1024.f) + 1e-6f);
#pragma unroll
            for (int i = 0; i < 4; ++i) {
                const int col = i * 256 + lane * 4;
                const float4 g = *(const float4*)(p.n_pre_mix + col);
                const float* sh = L + v * 2048 + col; const float* sc = L + v * 2048 + 1024 + col;
                const float y0 = xv[h][i].x * rs * g.x * (1.f + sc[0]) + sh[0];
                const float y1 = xv[h][i].y * rs * g.y * (1.f + sc[1]) + sh[1];
                const float y2 = xv[h][i].z * rs * g.z * (1.f + sc[2]) + sh[2];
                const float y3 = xv[h][i].w * rs * g.w * (1.f + sc[3]) + sh[3];
                uint2 o; o.x = pack2(y0, y1); o.y = pack2(y2, y3);
                *(uint2*)(p.hn + (size_t)r * 1024 + col) = o;
            }
        }
    }
}

__device__ __forceinline__ void phase2(const Params& p, char* smem) {
    g8::StaticOrder S; S.init(TE, INC, gridDim.x, blockIdx.x);
    g8::EpiBf16 E{p.proj, INC};
    g8::gemm_phase((LAS unsigned char*)smem, p.hn, p.WinT, 1024, 1024, 1024, S, E);
}

__device__ __forceinline__ void phase3(const Params& p, char* smem) {
    const int tid = tidx(), wave = tid >> 6, lane = tid & 63;
    const int gw = blockIdx.x * 8 + wave, nw = gridDim.x * 8;
    float mu0[3][8], mu1[3][8], kkw[8], lm0[4], lm1[4];
#pragma unroll
    for (int a = 0; a < 3; ++a)
#pragma unroll
        for (int q = 0; q < 8; ++q) { mu0[a][q] = p.shift_mu[a * 512 + lane * 8 + q]; mu1[a][q] = p.shift_mu[1792 + a * 512 + lane * 8 + q]; }
#pragma unroll
    for (int q = 0; q < 8; ++q) kkw[q] = p.rwkv_k_k[lane * 8 + q];
#pragma unroll
    for (int q = 0; q < 4; ++q) { lm0[q] = p.shift_mu[1536 + lane * 4 + q]; lm1[q] = p.shift_mu[1792 + 1536 + lane * 4 + q]; }
    for (int t = gw; t < TE; t += nw) {
        const bool hp = (t != 0 && t != 256), hn_ = (t != 255 && t != TE - 1);
        const bf16_t* pr = p.proj + (size_t)t * INC;
        uint4 q0[3], qm[3], qn[3]; uint2 l0, lm = make_uint2(0, 0), ln = make_uint2(0, 0);
#pragma unroll
        for (int a = 0; a < 3; ++a) {
            q0[a] = *(const uint4*)(pr + a * 512 + lane * 8);
            qm[a] = hp ? *(const uint4*)(pr + a * 512 + lane * 8 - INC) : make_uint4(0, 0, 0, 0);
            qn[a] = hn_ ? *(const uint4*)(pr + a * 512 + lane * 8 + INC) : make_uint4(0, 0, 0, 0);
        }
        l0 = *(const uint2*)(pr + 1536 + lane * 4);
        if (hp) lm = *(const uint2*)(pr + 1536 + lane * 4 - INC);
        if (hn_) ln = *(const uint2*)(pr + 1536 + lane * 4 + INC);
        float val[3][8];
#pragma unroll
        for (int a = 0; a < 3; ++a) {
            float f0[8], fm[8], fn[8]; unpack8(q0[a], f0); unpack8(qm[a], fm); unpack8(qn[a], fn);
#pragma unroll
            for (int q = 0; q < 8; ++q) val[a][q] = f0[q] + mu0[a][q] * (fm[q] - f0[q]) + mu1[a][q] * (fn[q] - f0[q]);
        }
        float kkv[8], n2 = 0.f;
#pragma unroll
        for (int q = 0; q < 8; ++q) { kkv[q] = val[1][q] * kkw[q]; n2 += kkv[q] * kkv[q]; }
        n2 = sum8(n2);
        const float inv = -1.f / fmaxf(sqrtf(n2), 1e-12f);
#pragma unroll
        for (int q = 0; q < 8; ++q) kkv[q] *= inv;
        const size_t o = (size_t)t * 512 + lane * 8;
        *(uint4*)(p.Rr + o) = pack8(val[0]); *(uint4*)(p.Kk + o) = pack8(val[1]); *(uint4*)(p.Vv + o) = pack8(val[2]); *(uint4*)(p.Aa + o) = pack8(kkv);
        {
            float v[4];
            const unsigned w0[2] = {l0.x, l0.y}, wm[2] = {lm.x, lm.y}, wn[2] = {ln.x, ln.y};
#pragma unroll
            for (int q = 0; q < 4; ++q) {
                const float p0 = (q & 1) ? __uint_as_float(w0[q >> 1] & 0xffff0000u) : __uint_as_float(w0[q >> 1] << 16);
                const float pm = (q & 1) ? __uint_as_float(wm[q >> 1] & 0xffff0000u) : __uint_as_float(wm[q >> 1] << 16);
                const float pn = (q & 1) ? __uint_as_float(wn[q >> 1] & 0xffff0000u) : __uint_as_float(wn[q >> 1] << 16);
                v[q] = p0 + lm0[q] * (pm - p0) + lm1[q] * (pn - p0);
            }
            if (lane < 16) {
                uint2 ov; ov.x = pack2(tanhf(v[0]), tanhf(v[1])); ov.y = pack2(tanhf(v[2]), tanhf(v[3]));
                *(uint2*)(p.TW + (size_t)t * 64 + lane * 4) = ov;
            } else if (lane < 32) {
                uint2 ov; ov.x = pack2(v[0], v[1]); ov.y = pack2(v[2], v[3]);
                *(uint2*)(p.XA + (size_t)t * 64 + (lane - 16) * 4) = ov;
            } else {
                uint2 ov; ov.x = pack2(sigm(v[0]), sigm(v[1])); ov.y = pack2(sigm(v[2]), sigm(v[3]));
                *(uint2*)(p.SG + (size_t)t * 128 + (lane - 32) * 4) = ov;
            }
        }
    }
}

__device__ __forceinline__ void phase4(const Params& p, char* smem) {
    stream_gemm128<true>(smem, 130 * 20,
        [&](int u, const bf16_t*& A, const bf16_t*& B, int& lda, int& ldb, int& nk) {
            const int mt = u / 20, q = u % 20;
            if (q < 8) { A = p.TW + (size_t)mt * 128 * 64; B = p.WupT + (size_t)q * 128 * 64; lda = 64; ldb = 64; nk = 1; }
            else if (q < 16) { A = p.XA + (size_t)mt * 128 * 64; B = p.AupT + (size_t)(q - 8) * 128 * 64; lda = 64; ldb = 64; nk = 1; }
            else { A = p.SG + (size_t)mt * 128 * 128; B = p.GupT + (size_t)(q - 16) * 128 * 128; lda = 128; ldb = 128; nk = 2; }
        },
        [&](int u, const f32x4 (&acc)[2][4], int r0, int c0) {
            const int mt = u / 20, q = u % 20;
            if (q < 8) {
#pragma unroll
                for (int mi = 0; mi < 2; ++mi)
#pragma unroll
                    for (int pr = 0; pr < 2; ++pr) {
                        const int t = mt * 128 + r0 + mi * 16, cc = q * 128 + c0 + pr * 32, d = cc >> 9, c = cc & 511;
                        float o[8];
#pragma unroll
                        for (int e = 0; e < 8; ++e) { const float z = p.rwkv_w0[d * 512 + c + e] + acc[mi][2 * pr + (e >> 2)][e & 3]; o[e] = -0.60653066f * sigm(z); }
                        uint4 ov; ov.x = pack2(o[0], o[1]); ov.y = pack2(o[2], o[3]); ov.z = pack2(o[4], o[5]); ov.w = pack2(o[6], o[7]);
                        *(uint4*)(p.Wd + ((size_t)d * TE + t) * 512 + c) = ov;
                    }
            } else if (q < 16) {
                const int qq = q - 8;
#pragma unroll
                for (int mi = 0; mi < 2; ++mi)
#pragma unroll
                    for (int pr = 0; pr < 2; ++pr) {
                        const int t = mt * 128 + r0 + mi * 16, cc = qq * 128 + c0 + pr * 32, d = cc >> 9, c = cc & 511;
                        const uint4 av = *(const uint4*)(p.Aa + (size_t)t * 512 + c), kv = *(const uint4*)(p.Kk + (size_t)t * 512 + c);
                        const bf16_t* ae = (const bf16_t*)&av; const bf16_t* ke = (const bf16_t*)&kv;
                        float bo[8], ko[8];
#pragma unroll
                        for (int e = 0; e < 8; ++e) {
                            const float ad = sigm(p.rwkv_a0[d * 512 + c + e] + acc[mi][2 * pr + (e >> 2)][e & 3]);
                            bo[e] = -bf2f(ae[e]) * ad;
                            ko[e] = bf2f(ke[e]) * (1.f + (ad - 1.f) * p.rwkv_k_a[c + e]);
                        }
                        uint4 o1, o2; o1.x = pack2(bo[0], bo[1]); o1.y = pack2(bo[2], bo[3]); o1.z = pack2(bo[4], bo[5]); o1.w = pack2(bo[6], bo[7]);
                        o2.x = pack2(ko[0], ko[1]); o2.y = pack2(ko[2], ko[3]); o2.z = pack2(ko[4], ko[5]); o2.w = pack2(ko[6], ko[7]);
                        *(uint4*)(p.Bd + ((size_t)d * TE + t) * 512 + c) = o1;
                        *(uint4*)(p.KD + ((size_t)d * TE + t) * 512 + c) = o2;
                    }
            } else {
                const int qq = q - 16;
#pragma unroll
                for (int mi = 0; mi < 2; ++mi)
#pragma unroll
                    for (int pr = 0; pr < 2; ++pr) {
                        const int t = mt * 128 + r0 + mi * 16, c = qq * 128 + c0 + pr * 32;
                        uint4 o; o.x = pack2(acc[mi][2 * pr][0], acc[mi][2 * pr][1]); o.y = pack2(acc[mi][2 * pr][2], acc[mi][2 * pr][3]);
                        o.z = pack2(acc[mi][2 * pr + 1][0], acc[mi][2 * pr + 1][1]); o.w = pack2(acc[mi][2 * pr + 1][2], acc[mi][2 * pr + 1][3]);
                        *(uint4*)(p.G + (size_t)t * 512 + c) = o;
                    }
            }
        });
}

typedef unsigned u32x4 __attribute__((ext_vector_type(4)));
#define P5_SWAP(x, y, o0, o1) do { const auto sw_ = __builtin_amdgcn_permlane32_swap((x), (y), false, false); o0 = sw_[0]; o1 = sw_[1]; } while (0)
#define P5_B8(T, o) __builtin_bit_cast(bf16x8, (u32x4){pack2(T[(o)], T[(o) + 1]), pack2(T[(o) + 2], T[(o) + 3]), pack2(T[(o) + 4], T[(o) + 5]), pack2(T[(o) + 6], T[(o) + 7])})
__device__ __forceinline__ bf16x8 p5_op(const bf16_t* img, int row, int cb) {
    const uint2 lo = *(const uint2*)(img + row * 64 + cb), hi = *(const uint2*)(img + row * 64 + cb + 8);
    const u32x4 q = {lo.x, lo.y, hi.x, hi.y};
    return __builtin_bit_cast(bf16x8, q);
}
#define P5_GPASS(T00, T01, T10, T11, Wv, Yv) do {                                                                                      \
        f32x16 G0, G1;                                                                                                                 \
        _Pragma("unroll") for (int r = 0; r < 16; ++r) { G0[r] = 0.f; G1[r] = 0.f; }                                                   \
        G0 = __builtin_amdgcn_mfma_f32_32x32x16_bf16(Aop[0], P5_B8(T00, 0), G0, 0, 0, 0); G1 = __builtin_amdgcn_mfma_f32_32x32x16_bf16(Aop[0], P5_B8(T01, 0), G1, 0, 0, 0); \
        G0 = __builtin_amdgcn_mfma_f32_32x32x16_bf16(Aop[1], P5_B8(T00, 8), G0, 0, 0, 0); G1 = __builtin_amdgcn_mfma_f32_32x32x16_bf16(Aop[1], P5_B8(T01, 8), G1, 0, 0, 0); \
        G0 = __builtin_amdgcn_mfma_f32_32x32x16_bf16(Aop[2], P5_B8(T10, 0), G0, 0, 0, 0); G1 = __builtin_amdgcn_mfma_f32_32x32x16_bf16(Aop[2], P5_B8(T11, 0), G1, 0, 0, 0); \
        G0 = __builtin_amdgcn_mfma_f32_32x32x16_bf16(Aop[3], P5_B8(T10, 8), G0, 0, 0, 0); G1 = __builtin_amdgcn_mfma_f32_32x32x16_bf16(Aop[3], P5_B8(T11, 8), G1, 0, 0, 0); \
        unsigned x_, y_;                                                                                                               \
        P5_SWAP(__float_as_uint(G0[0]), __float_as_uint(G1[0]), x_, y_); Wv[0] = __uint_as_float(x_); Wv[4] = __uint_as_float(y_);     \
        P5_SWAP(__float_as_uint(G0[1]), __float_as_uint(G1[1]), x_, y_); Wv[1] = __uint_as_float(x_);                                  \
        P5_SWAP(__float_as_uint(G0[2]), __float_as_uint(G1[2]), x_, y_); Wv[2] = __uint_as_float(x_);                                  \
        P5_SWAP(__float_as_uint(G0[3]), __float_as_uint(G1[3]), x_, y_); Wv[3] = __uint_as_float(x_);                                  \
        P5_SWAP(__float_as_uint(G0[4]), __float_as_uint(G1[4]), x_, y_); Yv[0] = __uint_as_float(x_); Yv[4] = __uint_as_float(y_);     \
        P5_SWAP(__float_as_uint(G0[5]), __float_as_uint(G1[5]), x_, y_); Yv[1] = __uint_as_float(x_);                                  \
        P5_SWAP(__float_as_uint(G0[6]), __float_as_uint(G1[6]), x_, y_); Yv[2] = __uint_as_float(x_);                                  \
        P5_SWAP(__float_as_uint(G0[7]), __float_as_uint(G1[7]), x_, y_); Yv[3] = __uint_as_float(x_);                                  \
        asm volatile("" :: "v"(G0), "v"(G1), "v"(x_), "v"(y_));                 \
    } while (0)
__device__ __forceinline__ void phase5(const Params& p, char* smem) {
    const int tid = tidx(), wave = __builtin_amdgcn_readfirstlane(tid >> 6), lane = tid & 63, hf = lane >> 5, cl = lane & 31;
    constexpr int SB = 5, NSB = RL / SB;
    constexpr int WLDS = 2048 + 2048 + 256 + 1024 + 3 * 4096;
    char* Wl = smem + wave * WLDS;
    bf16_t* AR = (bf16_t*)Wl; bf16_t* BK = (bf16_t*)(Wl + 2048); float* DV = (float*)(Wl + 4096); float* TT = (float*)(Wl + 4352); bf16_t* CT = (bf16_t*)Wl;
    LAS unsigned char* rawl = (LAS unsigned char*)smem + wave * WLDS + 5376;
    const float* RAW = (const float*)(Wl + 5376);
    for (int q = blockIdx.x * 8 + wave; q < RNC * 16; q += gridDim.x * 8) {
        const int j = q >> 4, hd = q & 15, dir = hd >> 3, h = hd & 7;
        const bf16_t* gW = p.Wd + (size_t)dir * TE * 512; const bf16_t* gB = p.Bd + (size_t)dir * TE * 512; const bf16_t* gK = p.KD + (size_t)dir * TE * 512;
        const unsigned lofs = (unsigned)(h * 64 + lane);
        const unsigned zoff = (unsigned)(q * (RL * 64) + lane);
        f32x16 TH00, TH01, TH10, TH11, TP00, TP01, TP10, TP11;
        { int c2 = cl, h2 = hf; asm volatile("" : "+v"(c2), "+v"(h2));
#pragma unroll
          for (int r = 0; r < 16; ++r) {
              const float id = (((r & 3) + 8 * (r >> 2) + 4 * h2) == c2) ? 1.f : 0.f;
              TH00[r] = 0.f; TH01[r] = 0.f; TH10[r] = 0.f; TH11[r] = 0.f; TP00[r] = id; TP11[r] = id; TP01[r] = 0.f; TP10[r] = 0.f;
          } }
        bf16_t w[SB], ar[SB], br[SB], kr[SB], vr[SB], rr[SB];
#define P5_LOAD(SBI) _Pragma("unroll") for (int i = 0; i < SB; ++i) {                                                                  \
            int s_ = j * RL + (SBI) * SB + i; s_ = s_ < RNC * RL ? s_ : RNC * RL - 1;                                                  \
            const unsigned g = (unsigned)row_of(dir, s_) * 512u + lofs;                                                                \
            w[i] = gW[g]; ar[i] = p.Aa[g]; br[i] = gB[g]; kr[i] = gK[g]; vr[i] = p.Vv[g]; rr[i] = p.Rr[g]; }
#define P5_DMA(SBI) _Pragma("unroll") for (int h = 0; h < 3; ++h) {                                                                    \
            int tt = q * 65 + (SBI) * 3 + h; if ((SBI) * 3 + h >= 65 || tt >= 514 * 256) tt = 0;                                       \
            const int m = tt >> 8, kb = (tt >> 4) & 15, nb = tt & 15, e = m >> 1, sel = m & 1;                                         \
            const float* src = (sel ? (e < 256 ? p.exp_w_up + (size_t)e * 262144 : p.sh_w_up) : (e < 256 ? p.exp_w_gate + (size_t)e * 262144 : p.sh_w_gate)) + (size_t)(kb * 64 + (lane >> 2)) * 256 + nb * 16 + (lane & 3) * 4; \
            _Pragma("unroll") for (int i = 0; i < 4; ++i) __builtin_amdgcn_global_load_lds((const unsigned*)(src + i * 16 * 256), (LAS unsigned*)(rawl + h * 4096 + i * 1024), 16, 0, 0); }
        P5_LOAD(0)
        asm volatile("" ::: "memory");
        P5_DMA(0)
        for (int sb = 0; sb < NSB; ++sb) {
            const int ctau = q * 65 + sb * 3;
            float vv[SB]; unsigned bp[3], kp[3];
            {
                float a[SB], b[SB], kd[SB], r[SB], bh[SB], kh[SB];
#pragma unroll
                for (int i = 0; i < SB; ++i) { a[i] = bf2f(ar[i]); b[i] = bf2f(br[i]); kd[i] = bf2f(kr[i]); vv[i] = bf2f(vr[i]); r[i] = bf2f(rr[i]); }
                float D = 1.f;
#pragma unroll
                for (int i = 0; i < SB; ++i) {
                    const float ah = D * a[i];
                    D *= __expf(bf2f(w[i]));
                    const float inv = __builtin_amdgcn_rcpf(D);
                    bh[i] = b[i] * inv; kh[i] = kd[i] * inv;
                    const unsigned par = pack2(ah, D * r[i]), pbk = pack2(bh[i], kh[i]);
                    AR[i * 64 + lane] = (bf16_t)(par & 0xffffu); AR[(8 + i) * 64 + lane] = (bf16_t)(par >> 16);
                    BK[i * 64 + lane] = (bf16_t)(pbk & 0xffffu); BK[(8 + i) * 64 + lane] = (bf16_t)(pbk >> 16);
                }
                DV[lane] = D;
                bp[0] = pack2(bh[0], bh[1]); bp[1] = pack2(bh[2], bh[3]); bp[2] = pack2(bh[4], 0.f);
                kp[0] = pack2(kh[0], kh[1]); kp[1] = pack2(kh[2], kh[3]); kp[2] = pack2(kh[4], 0.f);
            }
            asm volatile("" ::: "memory");
            bf16x8 Aop[4];
            { const int arow = cl & 15;
#pragma unroll
              for (int m = 0; m < 4; ++m) Aop[m] = p5_op(AR, arow, (m >> 1) * 32 + (m & 1) * 16 + 4 * hf); }
            float WH[SB], YH0[SB], WP[SB], YP0[SB];
            P5_GPASS(TH00, TH01, TH10, TH11, WH, YH0);
            P5_GPASS(TP00, TP01, TP10, TP11, WP, YP0);
            {
                f32x16 NM;
#pragma unroll
                for (int r = 0; r < 16; ++r) NM[r] = 0.f;
                const int arow = cl & 15;
#pragma unroll
                for (int m = 0; m < 4; ++m) NM = __builtin_amdgcn_mfma_f32_32x32x16_bf16(p5_op(BK, arow, (m >> 1) * 32 + (m & 1) * 16 + 4 * hf), Aop[m], NM, 0, 0, 0);
                if (cl < 16) {
                    *(f32x4*)(TT + cl * 16 + 4 * hf) = (f32x4){NM[0], NM[1], NM[2], NM[3]};
                    *(f32x4*)(TT + cl * 16 + 8 + 4 * hf) = (f32x4){NM[4], NM[5], NM[6], NM[7]};
                }
                asm volatile("s_nop 0" :: "v"(NM) : "memory");
            }
            asm volatile("" ::: "memory");
            float uH[SB], uP[SB];
#pragma unroll
            for (int t = 0; t < SB; ++t) {
                const f32x4 nb = *(const f32x4*)(TT + t * 16), nk = *(const f32x4*)(TT + t * 16 + 8);
                const f32x4 mb = *(const f32x4*)(TT + (8 + t) * 16), mk = *(const f32x4*)(TT + (8 + t) * 16 + 8);
                float u = WH[t], up = WP[t];
#pragma unroll
                for (int s = 0; s < t; ++s) { u = __builtin_fmaf(uH[s], nb[s], u); u = __builtin_fmaf(vv[s], nk[s], u); up = __builtin_fmaf(uP[s], nb[s], up); }
                uH[t] = u; uP[t] = up;
                float y = YH0[t], z = YP0[t];
#pragma unroll
                for (int s = 0; s <= t; ++s) {
                    const float mbs = s < 4 ? mb[s & 3] : TT[(8 + t) * 16 + 4], mks = s < 4 ? mk[s & 3] : TT[(8 + t) * 16 + 12];
                    y = __builtin_fmaf(uH[s], mbs, y); y = __builtin_fmaf(vv[s], mks, y); z = __builtin_fmaf(uP[s], mbs, z);
                }
                const int tg = sb * SB + t;
                p.Zz[zoff + (unsigned)(tg * 64)] = f2bf(z); p.YH[zoff + (unsigned)(tg * 64)] = f2bf(y);
            }
            {
                unsigned a0[4], a1[4], b0[4], b1[4], c0[4], c1[4];
                const unsigned upk[3] = {pack2(uH[0], uH[1]), pack2(uH[2], uH[3]), pack2(uH[4], 0.f)};
                const unsigned vpk[3] = {pack2(vv[0], vv[1]), pack2(vv[2], vv[3]), pack2(vv[4], 0.f)};
                const unsigned ppk[3] = {pack2(uP[0], uP[1]), pack2(uP[2], uP[3]), pack2(uP[4], 0.f)};
#pragma unroll
                for (int e = 0; e < 3; ++e) {
                    P5_SWAP(bp[e], kp[e], a0[e], a1[e]);
                    P5_SWAP(upk[e], vpk[e], b0[e], b1[e]);
                    P5_SWAP(ppk[e], 0u, c0[e], c1[e]);
                }
                a0[3] = 0u; a1[3] = 0u; b0[3] = 0u; b1[3] = 0u; c0[3] = 0u; c1[3] = 0u;
                const bf16x8 A0 = __builtin_bit_cast(bf16x8, (u32x4){a0[0], a0[1], a0[2], a0[3]}), A1 = __builtin_bit_cast(bf16x8, (u32x4){a1[0], a1[1], a1[2], a1[3]});
                const bf16x8 B0 = __builtin_bit_cast(bf16x8, (u32x4){b0[0], b0[1], b0[2], b0[3]}), B1 = __builtin_bit_cast(bf16x8, (u32x4){b1[0], b1[1], b1[2], b1[3]});
                const bf16x8 C0 = __builtin_bit_cast(bf16x8, (u32x4){c0[0], c0[1], c0[2], c0[3]}), C1 = __builtin_bit_cast(bf16x8, (u32x4){c1[0], c1[1], c1[2], c1[3]});
                TH00 = __builtin_amdgcn_mfma_f32_32x32x16_bf16(A0, B0, TH00, 0, 0, 0); TH01 = __builtin_amdgcn_mfma_f32_32x32x16_bf16(A0, B1, TH01, 0, 0, 0);
                TH10 = __builtin_amdgcn_mfma_f32_32x32x16_bf16(A1, B0, TH10, 0, 0, 0); TH11 = __builtin_amdgcn_mfma_f32_32x32x16_bf16(A1, B1, TH11, 0, 0, 0);
                TP00 = __builtin_amdgcn_mfma_f32_32x32x16_bf16(A0, C0, TP00, 0, 0, 0); TP01 = __builtin_amdgcn_mfma_f32_32x32x16_bf16(A0, C1, TP01, 0, 0, 0);
                TP10 = __builtin_amdgcn_mfma_f32_32x32x16_bf16(A1, C0, TP10, 0, 0, 0); TP11 = __builtin_amdgcn_mfma_f32_32x32x16_bf16(A1, C1, TP11, 0, 0, 0);
            }
            {
#pragma unroll
                for (int g = 0; g < 4; ++g) {
                    const f32x4 d0 = *(const f32x4*)(DV + 8 * g + 4 * hf), d1 = *(const f32x4*)(DV + 32 + 8 * g + 4 * hf);
#pragma unroll
                    for (int e = 0; e < 4; ++e) {
                        TH00[4 * g + e] *= d0[e]; TH01[4 * g + e] *= d0[e]; TP00[4 * g + e] *= d0[e]; TP01[4 * g + e] *= d0[e];
                        TH10[4 * g + e] *= d1[e]; TH11[4 * g + e] *= d1[e]; TP10[4 * g + e] *= d1[e]; TP11[4 * g + e] *= d1[e];
                    }
                }
            }
            asm volatile("s_waitcnt vmcnt(0)" ::: "memory");
            P5_LOAD(sb + 1)
            asm volatile("" ::: "memory");
#pragma unroll
            for (int h = 0; h < 3; ++h) {
                const int tt = ctau + h;
                if (sb * 3 + h < 65 && tt < 514 * 256) {
                    const int m = tt >> 8, kb = (tt >> 4) & 15, nb = tt & 15, e = m >> 1, sel = m & 1;
#pragma unroll
                    for (int i = 0; i < 4; ++i) {
                        const int pc = (i + (lane >> 2)) & 3;
                        const f32x4 c4 = *(const f32x4*)(RAW + h * 1024 + lane * 16 + pc * 4);
                        const unsigned p01 = pack2(c4[0], c4[1]), p23 = pack2(c4[2], c4[3]);
                        bf16_t* ct = CT + pc * (4 * 72) + lane;
                        ct[0 * 72] = (bf16_t)(p01 & 0xffffu); ct[1 * 72] = (bf16_t)(p01 >> 16);
                        ct[2 * 72] = (bf16_t)(p23 & 0xffffu); ct[3 * 72] = (bf16_t)(p23 >> 16);
                    }
                    const int cq = lane >> 2, seg = lane & 3;
                    const uint4 o0 = *(const uint4*)(CT + cq * 72 + seg * 16), o1 = *(const uint4*)(CT + cq * 72 + seg * 16 + 8);
                    const int rho = (nb >> 3) * 256 + ((nb >> 2) & 1) * 128 + (nb & 3) * 32 + sel * 16 + cq;
                    bf16_t* d = p.BtW + ((size_t)e * 512 + rho) * 1024 + kb * 64 + seg * 16;
                    *(uint4*)d = o0; *(uint4*)(d + 8) = o1;
                }
            }
            asm volatile("s_waitcnt lgkmcnt(0)" ::: "memory");
            P5_DMA(sb + 1)
        }
#undef P5_LOAD
#undef P5_DMA
        if (j < RNC - 1) {
            float* dP = p.PH + ((size_t)(j * 16 + hd) * 2 + 0) * 4096; float* dH = dP + 4096;
            int l3 = lane; asm volatile("" : "+v"(l3)); const int ob = (l3 & 31) * 64 + 4 * (l3 >> 5);
#pragma unroll
            for (int g = 0; g < 4; ++g) {
                const int o0 = ob + 8 * g;
                *(float4*)(dH + o0) = make_float4(TH00[4 * g], TH00[4 * g + 1], TH00[4 * g + 2], TH00[4 * g + 3]);
                *(float4*)(dH + o0 + 2048) = make_float4(TH01[4 * g], TH01[4 * g + 1], TH01[4 * g + 2], TH01[4 * g + 3]);
                *(float4*)(dH + o0 + 32) = make_float4(TH10[4 * g], TH10[4 * g + 1], TH10[4 * g + 2], TH10[4 * g + 3]);
                *(float4*)(dH + o0 + 2048 + 32) = make_float4(TH11[4 * g], TH11[4 * g + 1], TH11[4 * g + 2], TH11[4 * g + 3]);
                *(float4*)(dP + o0) = make_float4(TP00[4 * g], TP00[4 * g + 1], TP00[4 * g + 2], TP00[4 * g + 3]);
                *(float4*)(dP + o0 + 2048) = make_float4(TP01[4 * g], TP01[4 * g + 1], TP01[4 * g + 2], TP01[4 * g + 3]);
                *(float4*)(dP + o0 + 32) = make_float4(TP10[4 * g], TP10[4 * g + 1], TP10[4 * g + 2], TP10[4 * g + 3]);
                *(float4*)(dP + o0 + 2048 + 32) = make_float4(TP11[4 * g], TP11[4 * g + 1], TP11[4 * g + 2], TP11[4 * g + 3]);
            }
        }
    }
}
#undef P5_GPASS
#undef P5_B8
#undef P5_SWAP

__device__ __forceinline__ void phase6(const Params& p, char* smem) {
    const int tid = threadIdx.x, wave = __builtin_amdgcn_readfirstlane(tid >> 6), lane = tid & 63;
    if (blockIdx.x >= 256) return;
    const int hd = blockIdx.x >> 4, rb0 = (blockIdx.x & 15) * 4, r0 = rb0 + (wave & 3);
    LAS unsigned char* lds = (LAS unsigned char*)smem;
    constexpr int SLOT = 17408, NJ = RNC - 1;
    const char* pbase = (const char*)(p.PH + (size_t)hd * 2 * 4096);
    float s0 = 0.f;
#define CH_ISSUE(J) do { const char* src_ = pbase + (size_t)(J) * 524288; const unsigned so_ = (unsigned)(((J) & 7) * SLOT); \
        _Pragma("unroll") for (int q_ = 0; q_ < 4; ++q_) __builtin_amdgcn_global_load_lds((const unsigned*)(src_ + ((wave - 4) * 4 + q_) * 1024 + lane * 16), (LAS unsigned*)(lds + so_ + ((wave - 4) * 4 + q_) * 1024), 16, 0, 0); \
        if (wave == 7) __builtin_amdgcn_global_load_lds((const unsigned*)(src_ + 16384 + rb0 * 256 + lane * 16), (LAS unsigned*)(lds + so_ + 16384), 16, 0, 0); } while (0)
    if (wave >= 4) { CH_ISSUE(0); CH_ISSUE(1); CH_ISSUE(2); CH_ISSUE(3); CH_ISSUE(4); CH_ISSUE(5); CH_ISSUE(6); }
    for (int j = 0; j < RNC; ++j) {
        if (wave < 4) p.Sst[((size_t)(j * 16 + hd) * 64 + r0) * 64 + lane] = f2bf(s0);
        if (j == NJ) break;
        if (wave >= 4) {
            if (j + 6 >= NJ) asm volatile("s_waitcnt vmcnt(0)" ::: "memory");
            else if (wave == 7) asm volatile("s_waitcnt vmcnt(30)" ::: "memory");
            else asm volatile("s_waitcnt vmcnt(24)" ::: "memory");
        }
        asm volatile("s_waitcnt lgkmcnt(0)" ::: "memory"); __builtin_amdgcn_s_barrier(); asm volatile("" ::: "memory");
        if (wave >= 4) { if (j + 7 < NJ) CH_ISSUE(j + 7); }
        else {
            const float* Pc = (const float*)(smem + (j & 7) * SLOT);
            float pv[64];
#pragma unroll
            for (int k = 0; k < 64; ++k) pv[k] = Pc[k * 64 + lane];
            f32x2 n0 = {Pc[4096 + wave * 64 + lane], 0.f}, n1 = {0.f, 0.f}, n2 = {0.f, 0.f}, n3 = {0.f, 0.f};
#pragma unroll
            for (int k = 0; k < 64; k += 8) {
                const f32x2 a0 = {__int_as_float(__builtin_amdgcn_readlane(__float_as_int(s0), k)), __int_as_float(__builtin_amdgcn_readlane(__float_as_int(s0), k + 1))};
                const f32x2 a1 = {__int_as_float(__builtin_amdgcn_readlane(__float_as_int(s0), k + 2)), __int_as_float(__builtin_amdgcn_readlane(__float_as_int(s0), k + 3))};
                const f32x2 a2 = {__int_as_float(__builtin_amdgcn_readlane(__float_as_int(s0), k + 4)), __int_as_float(__builtin_amdgcn_readlane(__float_as_int(s0), k + 5))};
                const f32x2 a3 = {__int_as_float(__builtin_amdgcn_readlane(__float_as_int(s0), k + 6)), __int_as_float(__builtin_amdgcn_readlane(__float_as_int(s0), k + 7))};
                n0 += a0 * (f32x2){pv[k], pv[k + 1]}; n1 += a1 * (f32x2){pv[k + 2], pv[k + 3]}; n2 += a2 * (f32x2){pv[k + 4], pv[k + 5]}; n3 += a3 * (f32x2){pv[k + 6], pv[k + 7]};
            }
            s0 = ((n0.x + n0.y) + (n1.x + n1.y)) + ((n2.x + n2.y) + (n3.x + n3.y));
        }
    }
#undef CH_ISSUE
    __syncthreads();
}

__device__ __forceinline__ void phase7(const Params& p, char* smem) {
    const int tid = tidx(), wave = __builtin_amdgcn_readfirstlane(tid >> 6), lane = tid & 63, hf = lane >> 5, cl = lane & 31;
    for (int q = 16 + blockIdx.x * 8 + wave; q < RNC * 16; q += gridDim.x * 8) {
        const int j = q >> 4, hd = q & 15, dir = hd >> 3, h = hd & 7;
        bf16x8 Bop[2][4];
#pragma unroll
        for (int vt = 0; vt < 2; ++vt)
#pragma unroll
            for (int m = 0; m < 4; ++m) {
                Bop[vt][m] = *(const bf16x8*)(p.Sst + ((size_t)(j * 16 + hd) * 64 + vt * 32 + cl) * 64 + 16 * m + 8 * hf);
            }
        const bf16_t* gZ = p.Zz + (size_t)q * (RL * 64); const bf16_t* gY = p.YH + (size_t)q * (RL * 64);
        bf16_t* gO = p.O + (size_t)dir * TX * 512 + h * 64;
#pragma unroll
        for (int mt = 0; mt < 5; ++mt) {
            int ta = 32 * mt + cl; ta = ta < RL ? ta : RL - 1;
            bf16x8 Aop[4];
#pragma unroll
            for (int m = 0; m < 4; ++m) Aop[m] = *(const bf16x8*)(gZ + ta * 64 + 16 * m + 8 * hf);
#pragma unroll
            for (int vt = 0; vt < 2; ++vt) {
                f32x16 acc;
#pragma unroll
                for (int r = 0; r < 16; ++r) {
                    const int t = 32 * mt + (r & 3) + 8 * (r >> 2) + 4 * hf;
                    acc[r] = bf2f(gY[(t < RL ? t : RL - 1) * 64 + vt * 32 + cl]);
                }
#pragma unroll
                for (int m = 0; m < 4; ++m) acc = __builtin_amdgcn_mfma_f32_32x32x16_bf16(Aop[m], Bop[vt][m], acc, 0, 0, 0);
#pragma unroll
                for (int r = 0; r < 16; ++r) {
                    const int t = 32 * mt + (r & 3) + 8 * (r >> 2) + 4 * hf;
                    const int row = row_of(dir, j * RL + (t < RL ? t : RL - 1));
                    if (t < RL && row >= 256) gO[(size_t)(row - 256) * 512 + vt * 32 + cl] = f2bf_vis(acc[r]);
                }
            }
        }
    }
}

__device__ __forceinline__ void phase8(const Params& p, char* smem) {
    const int tid = tidx();
    bf16_t* LT = (bf16_t*)smem;
    constexpr int LTS = 136;
    for (int u = blockIdx.x; u < NCH * 4; u += gridDim.x) {
        const int c = u < 512 ? 2 + (u >> 2) : ((u - 512) >> 2), hh = u & 3;
        const int upart = c >= 2 ? 2 : 3;
        const float g0 = sigm(p.ret_decay_logit[hh]), g1 = sigm(p.ret_decay_logit[4 + hh]);
        const float l0 = log2f(g0), l1 = log2f(g1);
        const int n = tid >> 2, part = tid & 3, half = part >> 1, fb = (part & 1) * 16;
        const int t = c * 128 + n;
        const bool lat = c >= 2;
        float pos = 0.f;
        if (lat) { const int tl = t - 256; pos = (float)(half == 0 ? (tl >> 6) : (tl & 63)); }
        const bf16_t* pr = p.proj + (size_t)t * INC;
        float cs[16], sn[16];
#pragma unroll
        for (int f = 0; f < 16; ++f) {
            if (lat) { const float inv = exp2f(-(float)(fb + f) * (13.287712379549449f / 32.f)); sincosf(pos * inv, &sn[f], &cs[f]); }
            else { cs[f] = 1.f; sn[f] = 0.f; }
        }
        const size_t ch = (size_t)(c * 4 + hh);
        uint4 kq1a, kq1b, kq2a, kq2b;
        { const int cbk = 2304 + hh * 128 + half * 64 + fb;
          kq1a = *(const uint4*)(pr + cbk); kq1b = *(const uint4*)(pr + cbk + 8); kq2a = *(const uint4*)(pr + cbk + 32); kq2b = *(const uint4*)(pr + cbk + 40); }
        if (upart == 2) {
            const int cb = 1792 + hh * 128 + half * 64 + fb;
            uint4 v1a = *(const uint4*)(pr + cb), v1b = *(const uint4*)(pr + cb + 8), v2a = *(const uint4*)(pr + cb + 32), v2b = *(const uint4*)(pr + cb + 40);
            bf16_t x1[16], x2[16];
            *(uint4*)&x1[0] = v1a; *(uint4*)&x1[8] = v1b; *(uint4*)&x2[0] = v2a; *(uint4*)&x2[8] = v2b;
            float o1[16], o2[16];
#pragma unroll
            for (int f = 0; f < 16; ++f) { const float a = bf2f(x1[f]), b = bf2f(x2[f]); o1[f] = a * cs[f] - b * sn[f]; o2[f] = a * sn[f] + b * cs[f]; }
            const float xf = exp2f(l0 * (float)(n + 1)), xb = exp2f(l1 * (float)(128 - n));
            bf16_t* qd = p.Qr + (ch * 128 + n) * 128 + half * 64 + fb;
            bf16_t* ad = p.A3 + (ch * 128 + n) * 384 + 128 + half * 64 + fb;
#define ST8(D, V, O, SC) do { uint4 o_; o_.x = pack2(V[(O)] * (SC), V[(O) + 1] * (SC)); o_.y = pack2(V[(O) + 2] * (SC), V[(O) + 3] * (SC)); o_.z = pack2(V[(O) + 4] * (SC), V[(O) + 5] * (SC)); o_.w = pack2(V[(O) + 6] * (SC), V[(O) + 7] * (SC)); *(uint4*)(D) = o_; } while (0)
#pragma unroll
            for (int hq = 0; hq < 2; ++hq) {
                ST8(qd + hq * 8, o1, hq * 8, 1.f); ST8(qd + 32 + hq * 8, o2, hq * 8, 1.f);
                ST8(ad + hq * 8, o1, hq * 8, xf); ST8(ad + 32 + hq * 8, o2, hq * 8, xf);
                ST8(ad + 128 + hq * 8, o1, hq * 8, xb); ST8(ad + 128 + 32 + hq * 8, o2, hq * 8, xb);
            }
        }
        if (upart != 1) {
            const uint4 v1a = kq1a, v1b = kq1b, v2a = kq2a, v2b = kq2b;
            bf16_t x1[16], x2[16];
            *(uint4*)&x1[0] = v1a; *(uint4*)&x1[8] = v1b; *(uint4*)&x2[0] = v2a; *(uint4*)&x2[8] = v2b;
            const float sc = 0.08838834764831845f;
            bf16_t* kd = p.Kr + (ch * 128 + n) * 128 + half * 64 + fb;
            __syncthreads();
            float k1[16], k2[16];
#pragma unroll
            for (int f = 0; f < 16; ++f) {
                const float a = bf2f(x1[f]) * sc, b = bf2f(x2[f]) * sc;
                k1[f] = a * cs[f] - b * sn[f]; k2[f] = a * sn[f] + b * cs[f];
                LT[(half * 64 + fb + f) * LTS + n] = f2bf(k1[f]); LT[(half * 64 + fb + f + 32) * LTS + n] = f2bf(k2[f]);
            }
#pragma unroll
            for (int hq = 0; hq < 2; ++hq) {
                float t1[8], t2[8];
#pragma unroll
                for (int f = 0; f < 8; ++f) { t1[f] = k1[hq * 8 + f]; t2[f] = k2[hq * 8 + f]; }
                *(uint4*)(kd + hq * 8) = pack8(t1); *(uint4*)(kd + 32 + hq * 8) = pack8(t2);
            }
            __syncthreads();
            const int d = tid >> 2, ms = (tid & 3) * 32;
#pragma unroll
            for (int dir = 0; dir < 2; ++dir) {
                bf16_t* od = p.KTz + ((ch * 2 + dir) * 128 + d) * 128 + ms;
#pragma unroll
                for (int m8 = 0; m8 < 32; m8 += 8) {
                    float kz[8], kin[8]; unpack8(*(const uint4*)(LT + d * LTS + ms + m8), kin);
#pragma unroll
                    for (int m = 0; m < 8; ++m) { const int mm = ms + m8 + m; kz[m] = kin[m] * (dir == 0 ? exp2f(l0 * (float)(127 - mm)) : exp2f(l1 * (float)mm)); }
                    *(uint4*)(od + m8) = pack8(kz);
                }
            }
        }
#pragma unroll 1
        for (int eh = (upart != 0 ? 0 : 2); eh < 2; ++eh) {
            __syncthreads();
            const int cb = 2816 + hh * 256 + eh * 128 + part * 32;
            bf16_t xv[32];
#pragma unroll
            for (int q = 0; q < 4; ++q) *(uint4*)&xv[q * 8] = *(const uint4*)(pr + cb + q * 8);
#pragma unroll
            for (int f = 0; f < 32; ++f) LT[(part * 32 + f) * LTS + n] = xv[f];
            __syncthreads();
            const int e = tid >> 2, ms = (tid & 3) * 32;
            bf16_t* od = p.B3 + (ch * 256 + eh * 128 + e) * 384 + ms;
#pragma unroll
            for (int m = 0; m < 32; m += 8) *(uint4*)(od + m) = *(const uint4*)(LT + e * LTS + ms + m);
        }
        __syncthreads();
    }
}

__device__ __forceinline__ void phase9(const Params& p, char* smem) {
    stream_gemm128<true>(smem, 512 + 2080,
        [&](int u, const bf16_t*& A, const bf16_t*& B, int& lda, int& ldb, int& nk) {
            if (u < 512) { const size_t ch = (size_t)((2 + (u >> 2)) * 4 + (u & 3)); A = p.Qr + ch * 128 * 128; B = p.Kr + ch * 128 * 128; lda = 128; ldb = 128; nk = 2; }
            else { const int v = u - 512, mt = v & 1, dir = (v >> 1) & 1, chh = v >> 2; A = p.B3 + ((size_t)chh * 256 + mt * 128) * 384; B = p.KTz + ((size_t)chh * 2 + dir) * 128 * 128; lda = 384; ldb = 128; nk = 2; }
        },
        [&](int u, const f32x4 (&acc)[2][4], int r0, int c0) {
            if (u < 512) {
                const int hh = u & 3; const size_t ch = (size_t)((2 + (u >> 2)) * 4 + hh);
                const float l0 = log2f(sigm(p.ret_decay_logit[hh])), l1 = log2f(sigm(p.ret_decay_logit[4 + hh]));
                bf16_t* outp = p.A3 + ch * 128 * 384;
#pragma unroll
                for (int mi = 0; mi < 2; ++mi)
#pragma unroll
                    for (int pr = 0; pr < 2; ++pr) {
                        const int n = r0 + mi * 16, m0 = c0 + pr * 32;
                        float o[8];
#pragma unroll
                        for (int e = 0; e < 8; ++e) {
                            const int m = m0 + e;
                            float w = 0.f;
                            if (n >= m) w += exp2f(l0 * (float)(n - m));
                            if (m >= n) w += exp2f(l1 * (float)(m - n));
                            o[e] = acc[mi][2 * pr + (e >> 2)][e & 3] * w;
                        }
                        uint4 ov; ov.x = pack2(o[0], o[1]); ov.y = pack2(o[2], o[3]); ov.z = pack2(o[4], o[5]); ov.w = pack2(o[6], o[7]);
                        *(uint4*)(outp + (size_t)n * 384 + m0) = ov;
                    }
            } else {
                const int v = u - 512, mt = v & 1, dir = (v >> 1) & 1, chh = v >> 2;
                bf16_t* outp = p.KVT + (((size_t)chh * 2 + dir) * 256 + mt * 128) * 128;
#pragma unroll
                for (int mi = 0; mi < 2; ++mi)
#pragma unroll
                    for (int pr = 0; pr < 2; ++pr) { uint4 o; o.x = pack2(acc[mi][2 * pr][0], acc[mi][2 * pr][1]); o.y = pack2(acc[mi][2 * pr][2], acc[mi][2 * pr][3]);
                        o.z = pack2(acc[mi][2 * pr + 1][0], acc[mi][2 * pr + 1][1]); o.w = pack2(acc[mi][2 * pr + 1][2], acc[mi][2 * pr + 1][3]);
                        *(uint4*)(outp + (size_t)(r0 + mi * 16) * 128 + c0 + pr * 32) = o; }
            }
        });
}

__device__ __forceinline__ void phase10(const Params& p, char* smem) {
    for (int idx = blockIdx.x * NT + tidx(); idx < 131072; idx += gridDim.x * NT) {
        const int hh = idx >> 15, dir = (idx >> 14) & 1, e = (idx >> 6) & 255, d = (idx & 63) * 2;
        const float g = sigm(p.ret_decay_logit[dir * 4 + hh]);
        const float g128 = exp2f(128.f * log2f(g));
        float R0 = 0.f, R1 = 0.f;
        const bf16_t* kvb = p.KVT + ((size_t)(hh * 2 + dir) * 256 + e) * 128 + d;
        bf16_t* rtb = p.B3 + ((size_t)hh * 256 + e) * 384 + 128 + dir * 128 + d;
        for (int s0 = 0; s0 < NCH; s0 += 13) {
            unsigned kv[13];
#pragma unroll
            for (int i = 0; i < 13; ++i) { const int sc = s0 + i, c = dir == 0 ? sc : (sc < 2 ? 1 - sc : 131 - sc); kv[i] = *(const unsigned*)(kvb + (size_t)c * 262144); }
#pragma unroll
            for (int i = 0; i < 13; ++i) {
                const int sc = s0 + i, c = dir == 0 ? sc : (sc < 2 ? 1 - sc : 131 - sc);
                if (c >= 2) *(unsigned*)(rtb + (size_t)c * 393216) = pack2(R0, R1);
                R0 = g128 * R0 + __uint_as_float(kv[i] << 16); R1 = g128 * R1 + __uint_as_float(kv[i] & 0xffff0000u);
            }
        }
    }
}

__device__ __forceinline__ void phase11(const Params& p, char* smem) {
    stream_gemm128<true>(smem, 1024,
        [&](int u, const bf16_t*& A, const bf16_t*& B, int& lda, int& ldb, int& nk) {
            const int nt = u & 1, chh = 8 + (u >> 1);
            A = p.A3 + (size_t)chh * 128 * 384; B = p.B3 + ((size_t)chh * 256 + nt * 128) * 384; lda = 384; ldb = 384; nk = 6;
        },
        [&](int u, const f32x4 (&acc)[2][4], int r0, int c0) {
            const int nt = u & 1, chh = 8 + (u >> 1), c = chh >> 2, hh = chh & 3;
            bf16_t* outp = p.Y + (size_t)((c - 2) * 128) * 1024 + hh * 256 + nt * 128;
#pragma unroll
            for (int mi = 0; mi < 2; ++mi)
#pragma unroll
                for (int pr = 0; pr < 2; ++pr) { uint4 o; o.x = pack2(acc[mi][2 * pr][0], acc[mi][2 * pr][1]); o.y = pack2(acc[mi][2 * pr][2], acc[mi][2 * pr][3]);
                    o.z = pack2(acc[mi][2 * pr + 1][0], acc[mi][2 * pr + 1][1]); o.w = pack2(acc[mi][2 * pr + 1][2], acc[mi][2 * pr + 1][3]);
                    *(uint4*)(outp + (size_t)(r0 + mi * 16) * 1024 + c0 + pr * 32) = o; }
        });
}

__device__ __forceinline__ void phase12(const Params& p, char* smem) {
    const int tid = tidx(), wave = tid >> 6, lane = tid & 63;
    const int gw = blockIdx.x * 8 + wave, nw = gridDim.x * 8;
    float lw[8], lb[8], rk[8];
#pragma unroll
    for (int q = 0; q < 8; ++q) { lw[q] = p.rwkv_ln_w[lane * 8 + q]; lb[q] = p.rwkv_ln_b[lane * 8 + q]; rk[q] = p.rwkv_r_k[lane * 8 + q]; }
    for (int t = gw; t < TX; t += nw) {
        const size_t te = (size_t)(t + 256) * 512 + lane * 8;
        const uint4 uof = *(const uint4*)(p.O + (size_t)t * 512 + lane * 8), uob = *(const uint4*)(p.O + ((size_t)TX + t) * 512 + lane * 8);
        const uint4 ur = *(const uint4*)(p.Rr + te), uk0 = *(const uint4*)(p.KD + te), uk1 = *(const uint4*)(p.KD + (size_t)TE * 512 + te), uv = *(const uint4*)(p.Vv + te), ug = *(const uint4*)(p.G + te);
        const bf16_t* yp = p.Y + (size_t)t * 1024 + lane * 16;
        const uint4 uy0 = *(const uint4*)(yp), uy1 = *(const uint4*)(yp + 8);
        const bf16_t* gbp = p.proj + (size_t)(t + 256) * INC + 3840 + lane * 16;
        const uint4 ugb0 = *(const uint4*)(gbp), ugb1 = *(const uint4*)(gbp + 8);
        {
            float of[8], ob[8], r[8], k0[8], k1[8], v[8], gg[8], o[8];
            unpack8(uof, of); unpack8(uob, ob); unpack8(ur, r); unpack8(uk0, k0); unpack8(uk1, k1); unpack8(uv, v); unpack8(ug, gg);
            float sm = 0.f, bs = 0.f;
#pragma unroll
            for (int q = 0; q < 8; ++q) { o[q] = of[q] + ob[q]; sm += o[q]; bs += r[q] * (k0[q] + k1[q]) * rk[q]; }
            sm = sum8(sm); bs = sum8(bs);
            const float mu = sm * (1.f / 64.f);
            float vs = 0.f;
#pragma unroll
            for (int q = 0; q < 8; ++q) { o[q] -= mu; vs += o[q] * o[q]; }
            vs = sum8(vs);
            const float rs = rsqrtf(vs * (1.f / 64.f) + 64e-5f);
            float ya[8];
#pragma unroll
            for (int q = 0; q < 8; ++q) ya[q] = (o[q] * rs * lw[q] + lb[q] + bs * v[q]) * gg[q];
            *(uint4*)(p.ya_in + (size_t)t * 512 + lane * 8) = pack8(ya);
        }
        {
            float y[16]; { float ylo[8], yhi[8]; unpack8(uy0, ylo); unpack8(uy1, yhi);
#pragma unroll
              for (int q = 0; q < 8; ++q) { y[q] = ylo[q]; y[8 + q] = yhi[q]; } }
            float sm = 0.f;
#pragma unroll
            for (int q = 0; q < 16; ++q) sm += y[q];
            sm = sum16(sm);
            const float mu = sm * (1.f / 256.f);
            float vs = 0.f;
#pragma unroll
            for (int q = 0; q < 16; ++q) { y[q] -= mu; vs += y[q] * y[q]; }
            vs = sum16(vs);
            const float rs = rsqrtf(vs * (1.f / 256.f) + 1e-5f);
            float gb[16]; { float t0[8], t1[8]; unpack8(ugb0, t0); unpack8(ugb1, t1);
#pragma unroll
                for (int q = 0; q < 8; ++q) { gb[q] = t0[q]; gb[8 + q] = t1[q]; } }
            float o0[8], o1[8];
#pragma unroll
            for (int q = 0; q < 16; ++q) {
                const int c = lane * 16 + q;
                const float ov = (y[q] * rs * p.ret_ln_w[c] + p.ret_ln_b[c]) * (gb[q] * sigm(gb[q]));
                if (q < 8) o0[q] = ov; else o1[q - 8] = ov;
            }
            bf16_t* d = p.yb_in + (size_t)t * 1024 + lane * 16;
            *(uint4*)d = pack8(o0); *(uint4*)(d + 8) = pack8(o1);
        }
    }
}

__device__ __forceinline__ void phase13(const Params& p, char* smem) {
    for (int u = blockIdx.x; u < 512; u += gridDim.x) {
        const int mt = u >> 2, nt = u & 3;
        f32x4 acca[4][4], accb[4][4];
#pragma unroll
        for (int mi = 0; mi < 4; ++mi)
#pragma unroll
            for (int ni = 0; ni < 4; ++ni) { acca[mi][ni] = (f32x4){0.f, 0.f, 0.f, 0.f}; accb[mi][ni] = (f32x4){0.f, 0.f, 0.f, 0.f}; }
        { APlain ap{p.ya_in + (size_t)mt * 128 * 512, 512}; BPlain bp{p.WaT + (size_t)nt * 256 * 512, 512};
          gemm_core<128, 256, 2, 4, true>(acca, ap, bp, 512, smem); }
        { APlain ap{p.yb_in + (size_t)mt * 128 * 1024, 1024}; BPlain bp{p.WbT + (size_t)nt * 256 * 1024, 1024};
          gemm_core<128, 256, 2, 4, true>(accb, ap, bp, 1024, smem); }
        const int wave = tidx() >> 6, lane = tidx() & 63;
        const int r0 = (wave >> 2) * 64 + (lane & 15), c0 = (wave & 3) * 64 + (lane >> 4) * 8;
#pragma unroll
        for (int mi = 0; mi < 4; ++mi)
#pragma unroll
            for (int pr = 0; pr < 2; ++pr) {
                const int t = mt * 128 + r0 + mi * 16, c = nt * 256 + c0 + pr * 32;
                const bf16_t* gp = p.proj + (size_t)(t + 256) * INC + c;
                const uint4 ga = *(const uint4*)(gp + 4864), gb = *(const uint4*)(gp + 5888);
                float fa[8], fb[8], o[8];
                unpack8(ga, fa); unpack8(gb, fb);
#pragma unroll
                for (int e = 0; e < 8; ++e) o[e] = sigm(fa[e]) * acca[mi][2 * pr + (e >> 2)][e & 3] + sigm(fb[e]) * accb[mi][2 * pr + (e >> 2)][e & 3];
                uint4 ov; ov.x = pack2(o[0], o[1]); ov.y = pack2(o[2], o[3]); ov.z = pack2(o[4], o[5]); ov.w = pack2(o[6], o[7]);
                *(uint4*)(p.merged + (size_t)t * 1024 + c) = ov;
            }
    }
}
__device__ __forceinline__ void phase14(const Params& p, char* smem) {
    g8::StaticOrder S; S.init(TX, 1024, gridDim.x, blockIdx.x);
    g8::EpiBf16 E{p.mix, 1024};
    g8::gemm_phase((LAS unsigned char*)smem, p.merged, p.WoT, 1024, 1024, 1024, S, E);
}

__device__ __forceinline__ void phase15(const Params& p, char* smem) {
    const int tid = tidx(), wave = tid >> 6, lane = tid & 63;
    const int gw = blockIdx.x * 8 + wave, nw = gridDim.x * 8;
    const float* g1 = p.mod + 2048; const float* sh2 = p.mod + 3072; const float* sc2 = p.mod + 4096;
    for (int t = gw; t < TX; t += nw) {
        float4 mv[4], xm[4]; float ss = 0.f;
#pragma unroll
        for (int i = 0; i < 4; ++i) { const uint2 mb = *(const uint2*)(p.mix + (size_t)t * 1024 + i * 256 + lane * 4);
            mv[i] = make_float4(__uint_as_float(mb.x << 16), __uint_as_float(mb.x & 0xffff0000u), __uint_as_float(mb.y << 16), __uint_as_float(mb.y & 0xffff0000u));
            ss += mv[i].x * mv[i].x + mv[i].y * mv[i].y + mv[i].z * mv[i].z + mv[i].w * mv[i].w; }
        ss = wsum(ss);
        const float rs = rsqrtf(ss * (1.f / 1024.f) + 1e-6f);
        float s2 = 0.f;
#pragma unroll
        for (int i = 0; i < 4; ++i) {
            const int col = i * 256 + lane * 4;
            const float4 xv = *(const float4*)(p.x + (size_t)t * 1024 + col);
            const float4 gn = *(const float4*)(p.n_post_mix + col), gg = *(const float4*)(g1 + col);
            xm[i].x = xv.x + gg.x * (mv[i].x * rs * gn.x); xm[i].y = xv.y + gg.y * (mv[i].y * rs * gn.y);
            xm[i].z = xv.z + gg.z * (mv[i].z * rs * gn.z); xm[i].w = xv.w + gg.w * (mv[i].w * rs * gn.w);
            { uint2 xo; xo.x = pack2(xm[i].x, xm[i].y); xo.y = pack2(xm[i].z, xm[i].w); *(uint2*)(p.x_mid + (size_t)t * 1024 + col) = xo; }
            s2 += xm[i].x * xm[i].x + xm[i].y * xm[i].y + xm[i].z * xm[i].z + xm[i].w * xm[i].w;
        }
        s2 = wsum(s2);
        const float rs2 = rsqrtf(s2 * (1.f / 1024.f) + 1e-6f);
#pragma unroll
        for (int i = 0; i < 4; ++i) {
            const int col = i * 256 + lane * 4;
            const float4 gn = *(const float4*)(p.n_pre_ffn + col), sc = *(const float4*)(sc2 + col), sh = *(const float4*)(sh2 + col);
            float h[4];
            h[0] = xm[i].x * rs2 * gn.x * (1.f + sc.x) + sh.x; h[1] = xm[i].y * rs2 * gn.y * (1.f + sc.y) + sh.y;
            h[2] = xm[i].z * rs2 * gn.z * (1.f + sc.z) + sh.z; h[3] = xm[i].w * rs2 * gn.w * (1.f + sc.w) + sh.w;
            uint2 hi; hi.x = pack2(h[0], h[1]); hi.y = pack2(h[2], h[3]);
            *(uint2*)(p.Ahl + (size_t)t * 1024 + col) = hi;
        }
    }
}

__device__ __forceinline__ void phase16(const Params& p, char* smem) {
    for (int u = blockIdx.x; u < 256; u += gridDim.x) {
        const int mt = u >> 1, nt = u & 1;
        APlain ap{p.Ahl + (size_t)mt * 128 * 1024, 1024}; BPlain bp{p.RtT + (size_t)nt * 128 * 1024, 1024};
        float* outp = p.logits + (size_t)mt * 128 * 256 + nt * 128;
        gemm_tile<128, 128, 4, 2>(ap, bp, 1024, smem, [&](const auto& acc, int r0, int c0) {
#pragma unroll
            for (int mi = 0; mi < 2; ++mi)
#pragma unroll
                for (int ni = 0; ni < 4; ++ni) *(f32x4*)(outp + (size_t)(r0 + mi * 16) * 256 + c0 + ni * 16) = acc[mi][ni];
        });
    }
}

__device__ __forceinline__ void phase17(const Params& p, char* smem) {
    const int tid = tidx(), wave = tid >> 6, lane = tid & 63;
    int* hist = (int*)smem;
    if (tid < 256) hist[tid] = 0;
    __syncthreads();
    const int TPB = TX / gridDim.x;
    for (int ti = wave; ti < TPB; ti += 8) {
        const int t = blockIdx.x * TPB + ti;
        float sc[4]; unsigned key[4];
#pragma unroll
        for (int i = 0; i < 4; ++i) {
            const int e = lane + 64 * i; sc[i] = sigm(p.logits[(size_t)t * 256 + e]);
            const unsigned b = __float_as_uint(sc[i] + p.router_bias[e]);
            const unsigned o = b ^ ((b >> 31) ? 0xffffffffu : 0x80000000u);
            key[i] = (o & 0xffffff00u) | (unsigned)(255 - e);
        }
        float mys = 0.f, ssum = 0.f; int mye = 0;
#pragma unroll
        for (int k = 0; k < 8; ++k) {
            const unsigned best = wave_umax(max(max(key[0], key[1]), max(key[2], key[3])));
            const int e = 255 - (int)(best & 255u), slot = e >> 6, owner = e & 63;
            const float sel = slot == 0 ? sc[0] : (slot == 1 ? sc[1] : (slot == 2 ? sc[2] : sc[3]));
            const float sv = __int_as_float(__builtin_amdgcn_readlane(__float_as_int(sel), owner));
            if (lane == owner) {
#pragma unroll
                for (int i = 0; i < 4; ++i) if (slot == i) key[i] = 0u;
            }
            ssum += sv;
            if (lane == k) { mys = sv; mye = e; }
        }
        if (lane < 8) {
            const int pos = atomicAdd(&hist[mye], 1);
            p.tok_e[t * 8 + lane] = mye; p.tok_pos[t * 8 + lane] = pos; p.tok_w[t * 8 + lane] = mys / ssum * 2.5f;
        }
    }
    __syncthreads();
    if (tid < 256) p.bh[blockIdx.x * 256 + tid] = hist[tid];
}

__device__ __forceinline__ void phase18(const Params& p, char* smem) {
    const int tid = tidx();
    int* ps = (int*)smem;
    int* xs = ps + 260;
    int* cntL = xs + 260;
    int* baseL = cntL + 256;
    int* part = baseL + 256;
    {
        const int e = tid & 255, half = tid >> 8, G = gridDim.x, b0 = half * (G >> 1), b1 = b0 + (G >> 1);
        int tot = 0, bef = 0;
        for (int bb = b0; bb < b1; bb += 16) {
            int v[16];
#pragma unroll
            for (int i = 0; i < 16; ++i) v[i] = p.bh[(bb + i) * 256 + e];
#pragma unroll
            for (int i = 0; i < 16; ++i) { tot += v[i]; bef += (bb + i < (int)blockIdx.x) ? v[i] : 0; }
        }
        part[half * 256 + e] = tot; part[512 + half * 256 + e] = bef;
    }
    __syncthreads();
    if (tid < 256) { cntL[tid] = part[tid] + part[256 + tid]; baseL[tid] = part[512 + tid] + part[768 + tid]; }
    __syncthreads();
    if (tid < 64) {
        int c[4], tot = 0, ttot = 0;
#pragma unroll
        for (int q = 0; q < 4; ++q) { c[q] = cntL[tid * 4 + q]; tot += c[q]; ttot += (c[q] + 255) >> 8; }
        int incl = tot, tincl = ttot;
#pragma unroll
        for (int o = 1; o < 64; o <<= 1) { const int v = __shfl_up(incl, o, 64), tv = __shfl_up(tincl, o, 64); if (tid >= o) { incl += v; tincl += tv; } }
        int ex = incl - tot, tex = tincl - ttot;
#pragma unroll
        for (int q = 0; q < 4; ++q) { ps[tid * 4 + q] = ex; xs[tid * 4 + q] = tex; ex += c[q]; tex += (c[q] + 255) >> 8; }
        if (tid == 63) { ps[256] = incl; xs[256] = tincl; }
    }
    __syncthreads();
    if (blockIdx.x == 0) {
        const int nx = xs[256];
        if (tid == 0) *p.ntiles = nx + 64;
        for (int e = tid; e < 256; e += NT) {
            const int c = ps[e + 1] - ps[e];
            for (int t = 0; t < ((c + 255) >> 8); ++t) { int* x = p.xt + (xs[e] + t) * 4; x[0] = e; x[1] = ps[e] + 256 * t; x[2] = min(256, c - 256 * t); x[3] = 0; }
        }
        if (tid < 64) { int* x = p.xt + (nx + tid) * 4; x[0] = 256; x[1] = 131072 + 256 * tid; x[2] = 256; x[3] = 0; }
        if (tid < 256) p.slot_tk[NSLOT + tid] = 0;
    }
    const int TPB = TX / gridDim.x;
    for (int li = tid; li < TPB * 8; li += NT) {
        const int i = blockIdx.x * TPB * 8 + li, e = p.tok_e[i];
        p.slot_tk[ps[e] + baseL[e] + p.tok_pos[i]] = (i >> 3) * 9 + (i & 7);
    }
    for (int t = blockIdx.x * NT + tid; t < TX; t += gridDim.x * NT) p.slot_tk[131072 + t] = t * 9 + 8;
}

__device__ __forceinline__ void phase19(const Params& p, char* smem) {
    const int nun = *p.ntiles * 2;
    const int lb = (blockIdx.x & 7) * (gridDim.x >> 3) + (blockIdx.x >> 3);
    g8::EpiGU E{p.act};
    g8::gemm_phase_xg((LAS unsigned char*)smem, p.Ahl, p.slot_tk, p.xt, p.BtW, nun, lb, (int)gridDim.x, E);
}

__device__ __forceinline__ void phase20(const Params& p, char* smem) {
    constexpr int BM = 256, BN = 256, WGN = 4, TM = 128, TN = 64, MI = 8, NI = 4;
    constexpr int ABYTES = BM * TSTR, STAGE = (BM + BN) * TSTR, AL = 4, KPT = 8, NQ = 64;
    using BP = BKN; const BKN bp{nullptr, 1024};
    constexpr int BL = 4; uint4 rb0 = {}, rb1 = {}, rb2 = {}, rb3 = {}; const char* bbase = nullptr; const unsigned boff0 = 0, boff1 = 0, boff2 = 0, boff3 = 0;
    const int nun = *p.ntiles * 4, G = gridDim.x;
    const int lb = (blockIdx.x & 7) * (G >> 3) + (blockIdx.x >> 3);
    if (lb >= nun) return;
    const int nsteps = ((nun - lb + G - 1) / G) * 4;
    const int tid = tidx(), wave = tid >> 6, lane = tid & 63, fr = lane & 15, fq = lane >> 4;
    const int wm = wave / WGN, wn = wave % WGN;
    const int lrow = tid >> 3, lseg = tid & 7;
    const unsigned aoff0 = (unsigned)(lrow * 512) + lseg * 16, aoff1 = aoff0 + 64 * 512, aoff2 = aoff0 + 128 * 512, aoff3 = aoff0 + 192 * 512;
    const int kq = tid / NQ, n4 = tid % NQ; const long bld = 1024;
    uint4 ra0, ra1, ra2, ra3; float4 rf0, rf1, rf2, rf3, rf4, rf5, rf6, rf7;
    const char* abase = nullptr; const float* bfp = nullptr;
#define P20_UNIT(R) do { const int* x_ = p.xt + ((lb + (R) * G) >> 2) * 4; const int nt_ = (lb + (R) * G) & 3; const int e_ = x_[0]; \
        abase = (const char*)(p.act + (size_t)x_[1] * 256); \
        bfp = (e_ < 256 ? p.exp_w_down + (size_t)e_ * 262144 : p.sh_w_down) + nt_ * 256 + n4 * 4 + (long)(kq * KPT) * bld; } while (0)
    f32x4 acc[MI][NI];
#pragma unroll
    for (int mi = 0; mi < MI; ++mi)
#pragma unroll
        for (int ni = 0; ni < NI; ++ni) acc[mi][ni] = (f32x4){0.f, 0.f, 0.f, 0.f};
    P20_UNIT(0); GC_GLOAD(0); GC_LSTORE(0); __syncthreads();
    int srow[MI];
    for (int s = 0; s < nsteps; ++s) {
        if ((s & 3) == 0) {
            const int u = lb + (s >> 2) * G; const int* x = p.xt + (u >> 2) * 4;
            const int row0 = x[1], nrows = x[2]; const int r0 = wm * TM + fr;
#pragma unroll
            for (int mi = 0; mi < MI; ++mi) srow[mi] = (r0 + mi * 16 < nrows) ? p.slot_tk[row0 + r0 + mi * 16] : -1;
        }
        if (s + 1 < nsteps) { if (((s + 1) & 3) == 0) P20_UNIT((s + 1) >> 2); GC_GLOAD((s + 1) & 3); }
        const char* As = smem + (s & 1) * STAGE; const char* Bs = As + ABYTES;
#pragma unroll
        for (int ks = 0; ks < 2; ++ks) {
            bf16x8 af[MI], bfr[NI];
#pragma unroll
            for (int mi = 0; mi < MI; ++mi) af[mi] = *(const bf16x8*)(As + (wm * TM + mi * 16 + fr) * TSTR + ks * 64 + fq * 16);
#pragma unroll
            for (int ni = 0; ni < NI; ++ni) bfr[ni] = *(const bf16x8*)(Bs + (wn * TN + (ni >> 1) * 32 + (fr >> 2) * 8 + (ni & 1) * 4 + (fr & 3)) * TSTR + ks * 64 + fq * 16);
#pragma unroll
            for (int mi = 0; mi < MI; ++mi)
#pragma unroll
                for (int ni = 0; ni < NI; ++ni) acc[mi][ni] = __builtin_amdgcn_mfma_f32_16x16x32_bf16(bfr[ni], af[mi], acc[mi][ni], 0, 0, 0);
            __builtin_amdgcn_sched_barrier(0);
        }
        if ((s & 3) == 3) {
            asm volatile("s_nop 15");
            const int u = lb + (s >> 2) * G; const int nt = u & 3;
            const int c0 = wn * TN + fq * 8;
#pragma unroll
            for (int mi = 0; mi < MI; ++mi) {
                if (srow[mi] >= 0) {
                    bf16_t* d = p.yk + (size_t)srow[mi] * 1024 + nt * 256 + c0;
#pragma unroll
                    for (int pr = 0; pr < NI / 2; ++pr) {
                        uint4 ov; ov.x = pack2(acc[mi][2 * pr][0], acc[mi][2 * pr][1]); ov.y = pack2(acc[mi][2 * pr][2], acc[mi][2 * pr][3]);
                        ov.z = pack2(acc[mi][2 * pr + 1][0], acc[mi][2 * pr + 1][1]); ov.w = pack2(acc[mi][2 * pr + 1][2], acc[mi][2 * pr + 1][3]);
                        *(uint4*)(d + pr * 32) = ov;
                    }
                }
#pragma unroll
                for (int ni = 0; ni < NI; ++ni) acc[mi][ni] = (f32x4){0.f, 0.f, 0.f, 0.f};
            }
        }
        if (s + 1 < nsteps) GC_LSTORE((s + 1) & 1);
        __syncthreads();
    }
#undef P20_UNIT
}

__device__ __forceinline__ void phase21(const Params& p, char* smem) {
    const int tid = tidx(), wave = tid >> 6, lane = tid & 63;
    const int gw = blockIdx.x * 8 + wave, nw = gridDim.x * 8;
    const float* g2 = p.mod + 5120;
    for (int t = gw; t < TX; t += nw) {
        float w[9];
#pragma unroll
        for (int k = 0; k < 8; ++k) w[k] = p.tok_w[t * 8 + k];
        w[8] = 1.f;
        float4 mo[4]; float ss = 0.f;
#pragma unroll
        for (int i = 0; i < 4; ++i) {
            const int col = i * 256 + lane * 4;
            float a0 = 0.f, a1 = 0.f, a2 = 0.f, a3 = 0.f;
#pragma unroll
            for (int k = 0; k < 9; ++k) {
                const uint2 v = *(const uint2*)(p.yk + ((size_t)t * 9 + k) * 1024 + col);
                a0 += w[k] * __uint_as_float(v.x << 16); a1 += w[k] * __uint_as_float(v.x & 0xffff0000u); a2 += w[k] * __uint_as_float(v.y << 16); a3 += w[k] * __uint_as_float(v.y & 0xffff0000u);
            }
            mo[i] = make_float4(a0, a1, a2, a3);
            ss += a0 * a0 + a1 * a1 + a2 * a2 + a3 * a3;
        }
        ss = wsum(ss);
        const float rs = rsqrtf(ss * (1.f / 1024.f) + 1e-6f);
#pragma unroll
        for (int i = 0; i < 4; ++i) {
            const int col = i * 256 + lane * 4;
            const uint2 xb = *(const uint2*)(p.x_mid + (size_t)t * 1024 + col);
            const float4 xm = make_float4(__uint_as_float(xb.x << 16), __uint_as_float(xb.x & 0xffff0000u), __uint_as_float(xb.y << 16), __uint_as_float(xb.y & 0xffff0000u));
            const float4 gn = *(const float4*)(p.n_post_ffn + col), gg = *(const float4*)(g2 + col);
            float4 o;
            o.x = xm.x + gg.x * (mo[i].x * rs * gn.x); o.y = xm.y + gg.y * (mo[i].y * rs * gn.y);
            o.z = xm.z + gg.z * (mo[i].z * rs * gn.z); o.w = xm.w + gg.w * (mo[i].w * rs * gn.w);
            *(float4*)(p.out + (size_t)t * 1024 + col) = o;
        }
    }
}

__device__ __forceinline__ void phase7_8(const Params& p, char* smem) { phase7(p, smem); __syncthreads(); phase8(p, smem); }
constexpr int NPHASE = 21;
template <int PH> __device__ __forceinline__ void run_phase(const Params& p, char* smem) {
    if constexpr (PH == 0) phase0(p, smem);
    else if constexpr (PH == 1) phase1(p, smem);
    else if constexpr (PH == 2) phase2(p, smem);
    else if constexpr (PH == 3) phase3(p, smem);
    else if constexpr (PH == 4) phase4(p, smem);
    else if constexpr (PH == 5) phase5(p, smem);
    else if constexpr (PH == 6) phase6(p, smem);
    else if constexpr (PH == 7) phase7_8(p, smem);
    else if constexpr (PH == 8) phase9(p, smem);
    else if constexpr (PH == 9) phase10(p, smem);
    else if constexpr (PH == 10) phase11(p, smem);
    else if constexpr (PH == 11) phase12(p, smem);
    else if constexpr (PH == 12) phase13(p, smem);
    else if constexpr (PH == 13) phase14(p, smem);
    else if constexpr (PH == 14) phase15(p, smem);
    else if constexpr (PH == 15) phase16(p, smem);
    else if constexpr (PH == 16) phase17(p, smem);
    else if constexpr (PH == 17) phase18(p, smem);
    else if constexpr (PH == 18) phase19(p, smem);
    else if constexpr (PH == 19) phase20(p, smem);
    else phase21(p, smem);
}

template <int PH> __global__ void __launch_bounds__(NT, 2) k_phase(Params p) {
    extern __shared__ __attribute__((aligned(16))) char smem[];
    run_phase<PH>(p, smem);
}

template <int PH> __device__ __forceinline__ void mega_run(const Params& p, char* smem, const XcdBarrier& bar) {
    run_phase<PH>(p, smem);
    if constexpr (((PROBE_MASK) >> PH) & 1u) { xcd_barrier(bar); run_phase<PH>(p, smem); }
    if constexpr (PH + 1 < NPHASE) { xcd_barrier(bar); mega_run<PH + 1>(p, smem, bar); }
}
__global__ void __launch_bounds__(NT, 2) k_mega(Params p) {
    extern __shared__ __attribute__((aligned(16))) char smem[];
    uint4* xbw = (uint4*)(smem + 8 * TILE_BYTES);
    if (tidx() == 0) *xbw = make_uint4(0u, 0u, 0u, 0u);
    __syncthreads();
    XcdBarrier bar = xcd_barrier_post(p.bar, (volatile LAS unsigned*)xbw);
    mega_run<0>(p, smem, bar);
}

template <int PH> static void launch_phases(const Params& p, int grid, hipStream_t stream) {
    static bool attr = false;
    if (!attr) { (void)hipFuncSetAttribute((const void*)k_phase<PH>, hipFuncAttributeMaxDynamicSharedMemorySize, LDS_BYTES); attr = true; }
    hipLaunchKernelGGL(k_phase<PH>, dim3(grid), dim3(NT), LDS_BYTES, stream, p);
    if constexpr (PH + 1 < NPHASE) launch_phases<PH + 1>(p, grid, stream);
}

extern "C" void kernel_launch(void* const* d_in, const int* in_sizes, int n_in, void* d_out, int out_size, void* d_ws, size_t ws_size, hipStream_t stream) {
    static int grid = 0;
    if (grid == 0) {
        int dev = 0, cus = 0, per_cu = 0;
        (void)hipGetDevice(&dev); (void)hipDeviceGetAttribute(&cus, hipDeviceAttributeMultiprocessorCount, dev);
        (void)hipFuncSetAttribute((const void*)k_mega, hipFuncAttributeMaxDynamicSharedMemorySize, LDS_BYTES);
        (void)hipOccupancyMaxActiveBlocksPerMultiprocessor(&per_cu, (const void*)k_mega, NT, LDS_BYTES);
        (void)hipGetLastError();
        if (cus <= 0) cus = 256;
        grid = cus;
    }
    Params p{};
    const float** pin = (const float**)&p.x;
    for (int i = 0; i < 36; ++i) pin[i] = (const float*)d_in[i];
    p.out = (float*)d_out;
    char* ws = (char*)d_ws; size_t off = 0;
    auto alloc = [&](size_t bytes) { size_t o = off; off += (bytes + 255) & ~(size_t)255; return ws + o; };
    p.bar = (unsigned*)alloc(XCD_BAR_WORDS * 4); p.cnt = (int*)alloc(256 * 4);
    const size_t zero_bytes = off;
    p.slot_tk = (int*)alloc((size_t)(NSLOT + 256) * 4); p.bh = (int*)alloc(1024 * 256 * 4);
    p.xt = (int*)alloc(NXT_MAX * 16); p.ntiles = (int*)alloc(256);
    p.tok_e = (int*)alloc((size_t)TX * 8 * 4); p.tok_pos = (int*)alloc((size_t)TX * 8 * 4); p.tok_w = (float*)alloc((size_t)TX * 8 * 4);
    p.modp = (float*)alloc(16 * 2 * 6144 * 4); p.mod = (float*)alloc(2 * 6144 * 4);
    p.WinT = (bf16_t*)alloc((size_t)INC * 1024 * 2); p.WaT = (bf16_t*)alloc(1024 * 512 * 2); p.WbT = (bf16_t*)alloc(1024 * 1024 * 2); p.WoT = (bf16_t*)alloc(1024 * 1024 * 2);
    p.RtT = (bf16_t*)alloc(256 * 3072 * 2); p.ShGU = (bf16_t*)alloc(512 * 1024 * 2); p.ShD = (bf16_t*)alloc(1024 * 256 * 2);
    p.WupT = (bf16_t*)alloc(1024 * 64 * 2); p.AupT = (bf16_t*)alloc(1024 * 64 * 2); p.GupT = (bf16_t*)alloc(512 * 128 * 2);
    p.ya_in = (bf16_t*)alloc((size_t)TX * 512 * 2); p.yb_in = (bf16_t*)alloc((size_t)TX * 1024 * 2);
    p.BtW = (bf16_t*)alloc((size_t)257 * 512 * 1024 * 2);
    char* RA = alloc((size_t)TE * INC * 2);
    p.proj = (bf16_t*)RA;
    { size_t o = 0; auto sub = [&](size_t b) { char* r = RA + o; o += (b + 255) & ~(size_t)255; return r; };
      p.act = (bf16_t*)sub(((size_t)NSLOT + 256) * 256 * 2); p.logits = (float*)sub((size_t)TX * 256 * 4); }
    const size_t surv = (size_t)TE * 512 * 2 * 5 + (size_t)2 * TX * 512 * 2 + 4096;
    const size_t rtmp = 424935424 - 68157440 + 65536;
    char* RB = alloc(surv + rtmp);
    { size_t o = 0; auto sub = [&](size_t b) { char* r = RB + o; o += (b + 255) & ~(size_t)255; return r; };
      p.Rr = (bf16_t*)sub((size_t)TE * 512 * 2); p.Vv = (bf16_t*)sub((size_t)TE * 512 * 2); p.KD = (bf16_t*)sub((size_t)2 * TE * 512 * 2); p.G = (bf16_t*)sub((size_t)TE * 512 * 2);
      p.O = (bf16_t*)sub((size_t)2 * TX * 512 * 2);
      const size_t o_t = o;
      p.Kk = (bf16_t*)sub((size_t)TE * 512 * 2); p.Aa = (bf16_t*)sub((size_t)TE * 512 * 2); p.Bd = (bf16_t*)sub((size_t)2 * TE * 512 * 2);
      p.Wd = (bf16_t*)sub((size_t)2 * TE * 512 * 4); p.TW = (bf16_t*)sub((size_t)TE * 64 * 2); p.XA = (bf16_t*)sub((size_t)TE * 64 * 2); p.SG = (bf16_t*)sub((size_t)TE * 128 * 2);
      p.PH = (float*)sub((size_t)127 * 16 * 2 * 4096 * 4);
      { const size_t prep_end = o_t + (size_t)NCH * 4 * 128 * 128 * 2 * 2 + (size_t)NCH * 4 * 2 * 128 * 128 * 2 + (size_t)NCH * 4 * 128 * 384 * 2 + (size_t)NCH * 4 * 256 * 384 * 2 + 4096;
        if (o < prep_end) o = (prep_end + 255) & ~(size_t)255; }
      p.Sst = (bf16_t*)sub((size_t)128 * 16 * 4096 * 4);
      p.Zz = (bf16_t*)sub((size_t)RNC * 16 * RL * 64 * 2); p.YH = (bf16_t*)sub((size_t)RNC * 16 * RL * 64 * 2);
      p.hn = (bf16_t*)p.PH;
      o = o_t;
      p.Qr = (bf16_t*)sub((size_t)NCH * 4 * 128 * 128 * 2); p.Kr = (bf16_t*)sub((size_t)NCH * 4 * 128 * 128 * 2); p.KTz = (bf16_t*)sub((size_t)NCH * 4 * 2 * 128 * 128 * 2);
      p.A3 = (bf16_t*)sub((size_t)NCH * 4 * 128 * 384 * 2); p.B3 = (bf16_t*)sub((size_t)NCH * 4 * 256 * 384 * 2);
      p.KVT = (bf16_t*)sub((size_t)NCH * 4 * 2 * 256 * 128 * 2); p.Y = (bf16_t*)sub((size_t)TX * 1024 * 4);
      o = 0;
      p.x_mid = (bf16_t*)sub((size_t)TX * 1024 * 4); p.Ahl = (bf16_t*)sub((size_t)TX * 1024 * 2);
      p.yk = (bf16_t*)sub((size_t)TX * 9 * 1024 * 2);
      char* yk0 = (char*)p.yk; p.mergedA = (float*)yk0; p.merged = (bf16_t*)(yk0 + (size_t)TX * 1024 * 4); p.mix = (bf16_t*)(yk0 + (size_t)TX * 1024 * 6);
    }
    if (off > ws_size) { fprintf(stderr, "kernel_launch: workspace too small: need %zu have %zu\n", off, ws_size); return; }
    int j = 0;
    p.jobs[j++] = TJob{p.w_in, p.WinT, 1024, INC, 1024, 0, 0, 0};
    p.jobs[j++] = TJob{p.w_branch_a, p.WaT, 512, 1024, 512, 0, 0, 0};
    p.jobs[j++] = TJob{p.w_branch_b, p.WbT, 1024, 1024, 1024, 0, 0, 0};
    p.jobs[j++] = TJob{p.w_out, p.WoT, 1024, 1024, 1024, 0, 0, 0};
    p.jobs[j++] = TJob{p.router_w, p.RtT, 1024, 256, 1024, 0, 0, 0};
    p.jobs[j++] = TJob{p.rwkv_g_up, p.GupT, 0, 0, 128, 0, 0, 0};
    p.jobs[j++] = TJob{p.rwkv_g_up, p.GupT, 0, 0, 128, 0, 0, 0};
    p.jobs[j++] = TJob{p.rwkv_g_up, p.GupT, 0, 0, 128, 0, 0, 0};
    p.jobs[j++] = TJob{p.rwkv_w_up, p.WupT, 64, 512, 64, 0, 0, 0};
    p.jobs[j++] = TJob{p.rwkv_w_up + 64 * 512, p.WupT, 64, 512, 64, 0, 512, 0};
    p.jobs[j++] = TJob{p.rwkv_a_up, p.AupT, 64, 512, 64, 0, 0, 0};
    p.jobs[j++] = TJob{p.rwkv_a_up + 64 * 512, p.AupT, 64, 512, 64, 0, 512, 0};
    p.jobs[j++] = TJob{p.rwkv_g_up, p.GupT, 128, 512, 128, 0, 0, 0};
    p.jobs[j++] = TJob{p.rwkv_g_up, p.GupT, 0, 0, 128, 0, 0, 0};
    (void)hipMemsetAsync(ws, 0, zero_bytes, stream);
#if MK_ONE_LAUNCH
    hipLaunchKernelGGL(k_mega, dim3(grid), dim3(NT), LDS_BYTES, stream, p);
#else
    launch_phases<0>(p, grid, stream);
#endif
}
```
